# Optimizing an MI355X kernel written in HIP

```python
import jax, jax.numpy as jnp
from jax import lax
import numpy as np

D_MODEL = 1024
BATCH = 4
SEQ = 8192
DEPTH = 1
DEC_BATCH = 16
DEC_SEQ = 32
PAST_LEN = 2048

CHUNK = 64
EPS = 1e-6
ROPE_BASE = 10000.0
H_RET = 4
W_RET = D_MODEL // 2
DH_RET = W_RET // H_RET
H_ML = 4
W_ML = D_MODEL // 2
DH_ML = W_ML // H_ML
CONV_W = 4
PEER_HEADS = 8
N_KEYS = 128
N_EXPERTS = N_KEYS * N_KEYS
PEER_TOPK = 16
PEER_DQ = 256
PEER_DQ_HALF = PEER_DQ // 2
PEER_BLOCK = 256
D_PLE = 256
N_IN = 4 * W_RET + 3 * W_ML + 2 * H_ML + 2 * D_MODEL

kernel_name = "hybrid_retention_mlstm_peer_stream_step"


def rmsnorm(x, g):
    xf = x.astype(jnp.float32)
    y = xf * lax.rsqrt(jnp.mean(xf * xf, axis=-1, keepdims=True) + EPS)
    return (y * g.astype(jnp.float32)).astype(x.dtype)


def head_rmsnorm(y, g):
    B, T, H, d = y.shape
    y = y * lax.rsqrt(jnp.mean(y * y, axis=-1, keepdims=True) + EPS)
    return y.reshape(B, T, H * d) * g.astype(jnp.float32)


def rope(x, pos):
    half = x.shape[-1] // 2
    inv = ROPE_BASE ** (-jnp.arange(half, dtype=jnp.float32) / half)
    ang = pos.astype(jnp.float32)[:, None] * inv[None, :]
    cos = jnp.cos(ang)[None, :, None, :]
    sin = jnp.sin(ang)[None, :, None, :]
    x1, x2 = x[..., :half], x[..., half:]
    return jnp.concatenate([x1 * cos - x2 * sin, x1 * sin + x2 * cos], axis=-1)


def split_cols(z):
    sizes = (W_RET, W_RET, W_RET, W_RET, W_ML, W_ML, W_ML, H_ML, H_ML, D_MODEL, D_MODEL)
    out = []
    off = 0
    for s in sizes:
        out.append(z[..., off:off + s])
        off += s
    return out


def causal_conv(x, buf, w, b):
    T = x.shape[1]
    xp = jnp.concatenate([buf, x], axis=1)
    y = b + xp[:, 0:T] * w[0]
    for j in range(1, CONV_W):
        y = y + xp[:, j:j + T] * w[j]
    return y, xp[:, T:]


def retention_chunkwise(q, k, v, s0):
    B, T, H, dk = q.shape
    dv = v.shape[-1]
    L = min(CHUNK, T)
    nc = T // L
    to_c = lambda t: t.reshape(B, nc, L, H, t.shape[-1]).transpose(0, 3, 1, 2, 4)
    q, k, v = to_c(q), to_c(k), to_c(v)
    lg = jnp.log1p(-jnp.exp2(-5.0 - jnp.arange(H, dtype=jnp.float32)))
    idx = jnp.arange(L, dtype=jnp.float32)
    diff = idx[:, None] - idx[None, :]
    dmask = jnp.where(diff >= 0, jnp.exp(lg[:, None, None] * jnp.maximum(diff, 0.0)), 0.0)
    scores = jnp.einsum('bhcid,bhcsd->bhcis', q, k) * dmask[None, :, None]
    o = jnp.einsum('bhcis,bhcse->bhcie', scores, v)
    w_end = jnp.exp(lg[:, None] * (L - 1 - idx)[None, :])
    ds = jnp.einsum('bhcsd,bhcse->bhcde', k * w_end[None, :, None, :, None], v)
    g_chunk = jnp.exp(lg * L)[None, :, None, None]

    def step(s, ds_c):
        return g_chunk * s + ds_c, s

    s_fin, s_prev = lax.scan(step, s0, jnp.moveaxis(ds, 2, 0))
    s_prev = jnp.moveaxis(s_prev, 0, 2)
    w_read = jnp.exp(lg[:, None] * (idx + 1.0)[None, :])
    o = o + jnp.einsum('bhcid,bhcde->bhcie', q * w_read[None, :, None, :, None], s_prev)
    return o.transpose(0, 2, 3, 1, 4).reshape(B, T, H, dv), s_fin


def mlstm_chunkwise(q, k, v, ig, fg, c0, n0, m0):
    B, T, H, dk = q.shape
    L = min(CHUNK, T)
    nc = T // L
    to_c = lambda t: t.reshape(B, nc, L, H, t.shape[-1]).transpose(1, 0, 3, 2, 4)
    to_cg = lambda t: t.reshape(B, nc, L, H).transpose(1, 0, 3, 2)
    causal = jnp.tril(jnp.ones((L, L), dtype=bool))

    def step(carry, xs):
        c, n, m = carry
        qc, kc, vc, ic, lfc = xs
        F = jnp.cumsum(lfc, axis=-1)
        log_d = jnp.where(causal, ic[..., None, :] + F[..., :, None] - F[..., None, :], -jnp.inf)
        inter = m[..., None] + F
        m_t = jnp.maximum(inter, jnp.max(log_d, axis=-1))
        dw = jnp.exp(log_d - m_t[..., None])
        a = jnp.exp(inter - m_t)
        s = jnp.einsum('bhid,bhsd->bhis', qc, kc) * dw
        num = jnp.einsum('bhis,bhse->bhie', s, vc) + a[..., None] * jnp.einsum('bhid,bhde->bhie', qc, c)
        den = jnp.sum(s, axis=-1) + a * jnp.einsum('bhid,bhd->bhi', qc, n)
        hc = num / jnp.maximum(jnp.abs(den), jnp.exp(-m_t))[..., None]
        m_new = m_t[..., -1]
        w_end = jnp.exp(ic + F[..., -1:] - F - m_new[..., None])
        a_end = jnp.exp(m + F[..., -1] - m_new)
        kw = kc * w_end[..., None]
        c_new = a_end[..., None, None] * c + jnp.einsum('bhsd,bhse->bhde', kw, vc)
        n_new = a_end[..., None] * n + jnp.sum(kw, axis=-2)
        return (c_new, n_new, m_new), hc

    logf = jax.nn.log_sigmoid(fg)
    (c, n, m), h = lax.scan(step, (c0, n0, m0), (to_c(q), to_c(k), to_c(v), to_cg(ig), to_cg(logf)))
    h = h.transpose(1, 0, 3, 2, 4).reshape(B, T, H, -1)
    return h, c, n, m


def peer_ffn(h, w_pq, peer_keys, peer_u, peer_v):
    B, T, D = h.shape
    n = B * T
    nb = -(-n // PEER_BLOCK)
    flat = jnp.pad(h.reshape(n, D), ((0, nb * PEER_BLOCK - n), (0, 0)))

    def one_block(xb):
        q = (xb @ w_pq).reshape(PEER_BLOCK, PEER_HEADS, 2, PEER_DQ_HALF)
        s = jnp.einsum('tnhd,nhkd->tnhk', q, peer_keys).astype(jnp.float32)
        s1, i1 = lax.top_k(s[:, :, 0], PEER_TOPK)
        s2, i2 = lax.top_k(s[:, :, 1], PEER_TOPK)
        cand = (s1[..., :, None] + s2[..., None, :]).reshape(PEER_BLOCK, PEER_HEADS, PEER_TOPK * PEER_TOPK)
        sc, ci = lax.top_k(cand, PEER_TOPK)
        e = (jnp.take_along_axis(i1, ci // PEER_TOPK, axis=-1) * N_KEYS
             + jnp.take_along_axis(i2, ci % PEER_TOPK, axis=-1))
        g = jax.nn.softmax(sc, axis=-1)
        act = jax.nn.gelu(jnp.einsum('td,tnkd->tnk', xb, peer_u[e]).astype(jnp.float32), approximate=False)
        return jnp.einsum('tnk,tnkd->td', (g * act).astype(xb.dtype), peer_v[e])

    out = lax.map(one_block, flat.reshape(nb, PEER_BLOCK, D))
    return out.reshape(nb * PEER_BLOCK, D)[:n].reshape(B, T, D)


def hybrid_layer(x, p, pos, s_ret, c_ml, n_ml, m_ml, conv_buf,
                 g_mix, w_in, g_ret_gn, w_mq, w_mk, conv_w, conv_b, b_i, b_f, g_ml_gn, w_skip,
                 w_up_r, w_up_m, w_out, g_ffn, w_pq, peer_keys, peer_u, peer_v, g_ple, w_pg, w_ple):
    B, T, _ = x.shape
    f32 = jnp.float32
    dt = x.dtype
    h = rmsnorm(x, g_mix)
    z = h @ w_in
    q_r, k_r, v_r, gt_r, xm, v_m, o_m, i_m, f_m, gate_r, gate_m = split_cols(z)
    heads = lambda t, H: t.astype(f32).reshape(B, T, H, -1)
    q_r = rope(heads(q_r, H_RET), pos)
    k_r = rope(heads(k_r, H_RET), pos) * (DH_RET ** -0.5)
    o_ret, s_ret_new = retention_chunkwise(q_r, k_r, heads(v_r, H_RET), s_ret.astype(f32))
    y_r = jax.nn.silu(gt_r.astype(f32)) * head_rmsnorm(o_ret, g_ret_gn)
    xc, conv_new = causal_conv(xm, conv_buf.astype(dt), conv_w, conv_b)
    c = jax.nn.silu(xc.astype(f32))
    ch = c.reshape(B, T, H_ML, DH_ML)
    q_m = jnp.einsum('bthd,hde->bthe', ch, w_mq.astype(f32))
    k_m = jnp.einsum('bthd,hde->bthe', ch, w_mk.astype(f32)) * (DH_ML ** -0.5)
    ig = i_m.astype(f32) + b_i.astype(f32)
    fg = f_m.astype(f32) + b_f.astype(f32)
    h_m, c_new, n_new, m_new = mlstm_chunkwise(q_m, k_m, heads(v_m, H_ML), ig, fg,
                                               c_ml.astype(f32), n_ml.astype(f32), m_ml.astype(f32))
    y_m = jax.nn.sigmoid(o_m.astype(f32)) * (head_rmsnorm(h_m, g_ml_gn) + w_skip.astype(f32) * c)
    merged = (jax.nn.sigmoid(gate_r) * (y_r.astype(dt) @ w_up_r)
              + jax.nn.sigmoid(gate_m) * (y_m.astype(dt) @ w_up_m))
    x = x + merged @ w_out
    x = x + peer_ffn(rmsnorm(x, g_ffn), w_pq, peer_keys, peer_u, peer_v)
    x = x + (p @ w_ple) * jax.nn.sigmoid(rmsnorm(x, g_ple) @ w_pg)
    return x, s_ret_new, c_new, n_new, m_new, conv_new


def setup_inputs(seed: int = 0) -> dict:
    key = jax.random.key(seed)
    ks = jax.random.split(key, 32)
    f32 = jnp.float32
    nrm = lambda k, shape, scale: scale * jax.random.normal(k, shape, f32)
    gain = lambda k, shape: 1.0 + 0.05 * jax.random.normal(k, shape, f32)
    return {
        "x_prompt": nrm(ks[0], (BATCH, SEQ, D_MODEL), 1.0),
        "x_sample": nrm(ks[1], (DEC_BATCH, DEC_SEQ, D_MODEL), 1.0),
        "p_prompt": nrm(ks[2], (DEPTH, BATCH, SEQ, D_PLE), 1.0),
        "p_sample": nrm(ks[3], (DEPTH, DEC_BATCH, DEC_SEQ, D_PLE), 1.0),
        "state_ret": nrm(ks[4], (DEPTH, DEC_BATCH, H_RET, DH_RET, DH_RET), 0.5),
        "state_mlstm_C": nrm(ks[5], (DEPTH, DEC_BATCH, H_ML, DH_ML, DH_ML), 0.3),
        "state_mlstm_n": nrm(ks[6], (DEPTH, DEC_BATCH, H_ML, DH_ML), 0.3),
        "state_mlstm_m": nrm(ks[7], (DEPTH, DEC_BATCH, H_ML), 1.0),
        "state_conv": nrm(ks[8], (DEPTH, DEC_BATCH, CONV_W - 1, W_ML), 1.0),
        "g_mix": gain(ks[9], (DEPTH, D_MODEL)),
        "w_in": nrm(ks[10], (DEPTH, D_MODEL, N_IN), D_MODEL ** -0.5),
        "g_ret_gn": gain(ks[11], (DEPTH, W_RET)),
        "w_mq": nrm(ks[12], (DEPTH, H_ML, DH_ML, DH_ML), DH_ML ** -0.5),
        "w_mk": nrm(ks[13], (DEPTH, H_ML, DH_ML, DH_ML), DH_ML ** -0.5),
        "conv_w": nrm(ks[14], (DEPTH, CONV_W, W_ML), CONV_W ** -0.5),
        "conv_b": nrm(ks[15], (DEPTH, W_ML), 0.02),
        "b_i": nrm(ks[16], (DEPTH, H_ML), 0.1),
        "b_f": jnp.linspace(3.0, 6.0, H_ML, dtype=f32)[None, :] + nrm(ks[17], (DEPTH, H_ML), 0.1),
        "g_ml_gn": gain(ks[18], (DEPTH, W_ML)),
        "w_skip": gain(ks[19], (DEPTH, W_ML)),
        "w_up_r": nrm(ks[20], (DEPTH, W_RET, D_MODEL), W_RET ** -0.5),
        "w_up_m": nrm(ks[21], (DEPTH, W_ML, D_MODEL), W_ML ** -0.5),
        "w_out": nrm(ks[22], (DEPTH, D_MODEL, D_MODEL), D_MODEL ** -0.5),
        "g_ffn": gain(ks[23], (DEPTH, D_MODEL)),
        "w_pq": nrm(ks[24], (DEPTH, D_MODEL, PEER_HEADS * PEER_DQ), D_MODEL ** -0.5),
        "peer_keys": nrm(ks[25], (DEPTH, PEER_HEADS, 2, N_KEYS, PEER_DQ_HALF), PEER_DQ_HALF ** -0.5),
        "peer_u": nrm(ks[26], (DEPTH, N_EXPERTS, D_MODEL), D_MODEL ** -0.5),
        "peer_v": nrm(ks[27], (DEPTH, N_EXPERTS, D_MODEL), 0.1),
        "g_ple": gain(ks[28], (DEPTH, D_MODEL)),
        "w_pg": nrm(ks[29], (DEPTH, D_MODEL, D_MODEL), D_MODEL ** -0.5),
        "w_ple": nrm(ks[30], (DEPTH, D_PLE, D_MODEL), D_PLE ** -0.5),
        "g_final": gain(ks[31], (D_MODEL,)),
    }


def reference(x_prompt, x_sample, p_prompt, p_sample, state_ret, state_mlstm_C, state_mlstm_n,
              state_mlstm_m, state_conv, g_mix, w_in, g_ret_gn, w_mq, w_mk, conv_w, conv_b, b_i, b_f,
              g_ml_gn, w_skip, w_up_r, w_up_m, w_out, g_ffn, w_pq, peer_keys, peer_u, peer_v,
              g_ple, w_pg, w_ple, g_final):
    f32 = jnp.float32
    Bp = x_prompt.shape[0]
    pos_p = jnp.arange(x_prompt.shape[1], dtype=jnp.int32)
    pos_s = PAST_LEN + jnp.arange(x_sample.shape[1], dtype=jnp.int32)
    z_ret = jnp.zeros((Bp, H_RET, DH_RET, DH_RET), f32)
    z_c = jnp.zeros((Bp, H_ML, DH_ML, DH_ML), f32)
    z_n = jnp.zeros((Bp, H_ML, DH_ML), f32)
    z_m = jnp.zeros((Bp, H_ML), f32)
    z_buf = jnp.zeros((Bp, CONV_W - 1, W_ML), x_prompt.dtype)
    hp, hs = x_prompt, x_sample
    rp, cp, np_, mp, bp = [], [], [], [], []
    rs, cs, ns, ms, bs = [], [], [], [], []
    for l in range(DEPTH):
        lw = (g_mix[l], w_in[l], g_ret_gn[l], w_mq[l], w_mk[l], conv_w[l], conv_b[l], b_i[l], b_f[l],
              g_ml_gn[l], w_skip[l], w_up_r[l], w_up_m[l], w_out[l], g_ffn[l], w_pq[l], peer_keys[l],
              peer_u[l], peer_v[l], g_ple[l], w_pg[l], w_ple[l])
        hp, a1, a2, a3, a4, a5 = hybrid_layer(hp, p_prompt[l], pos_p, z_ret, z_c, z_n, z_m, z_buf, *lw)
        rp.append(a1); cp.append(a2); np_.append(a3); mp.append(a4); bp.append(a5)
        hs, b1, b2, b3, b4, b5 = hybrid_layer(hs, p_sample[l], pos_s, state_ret[l], state_mlstm_C[l],
                                              state_mlstm_n[l], state_mlstm_m[l], state_conv[l], *lw)
        rs.append(b1); cs.append(b2); ns.append(b3); ms.append(b4); bs.append(b5)
    y_prompt = rmsnorm(hp, g_final)
    y_sample = rmsnorm(hs, g_final)
    ret_p = jnp.stack(rp).astype(state_ret.dtype)
    c_p = jnp.stack(cp).astype(state_mlstm_C.dtype)
    n_p = jnp.stack(np_).astype(state_mlstm_n.dtype)
    m_p = jnp.stack(mp).astype(state_mlstm_m.dtype)
    conv_p = jnp.stack(bp).astype(state_conv.dtype)
    ret_s = jnp.stack(rs).astype(state_ret.dtype)
    c_s = jnp.stack(cs).astype(state_mlstm_C.dtype)
    n_s = jnp.stack(ns).astype(state_mlstm_n.dtype)
    m_s = jnp.stack(ms).astype(state_mlstm_m.dtype)
    conv_s = jnp.stack(bs).astype(state_conv.dtype)
    return (y_prompt, y_sample, ret_p, c_p, n_p, m_p, conv_p, ret_s, c_s, n_s, m_s, conv_s)
```

```cpp
#include <hip/hip_runtime.h>
#include <hip/hip_cooperative_groups.h>
#include <cstdio>
namespace cg = cooperative_groups;

typedef unsigned short bfu;
typedef __attribute__((ext_vector_type(8))) short bf16x8;
typedef __attribute__((ext_vector_type(16))) float f32x16;

#define MT 33280
#define MP 32768
#define NTHREADS 256
#define EPS 1e-6f

struct Params {
  const float *xp, *xs, *pp, *ps, *st_ret, *st_C, *st_n, *st_m, *st_conv, *g_mix, *w_in, *g_ret_gn, *w_mq,
      *w_mk, *conv_w, *conv_b, *b_i, *b_f, *g_ml_gn, *w_skip, *w_up_r, *w_up_m, *w_out, *g_ffn, *w_pq,
      *peer_keys, *peer_u, *peer_v, *g_ple, *w_pg, *w_ple, *g_final;
  float* out;
  char* ws;
};

constexpr size_t O_WT_IN = 0;
constexpr size_t O_WT_UPR = O_WT_IN + 5632ull * 1024 * 2;
constexpr size_t O_WT_UPM = O_WT_UPR + 1024ull * 512 * 2;
constexpr size_t O_WT_OUT = O_WT_UPM + 1024ull * 512 * 2;
constexpr size_t O_WT_PQ = O_WT_OUT + 1024ull * 1024 * 2;
constexpr size_t O_WT_PG = O_WT_PQ + 2048ull * 1024 * 2;
constexpr size_t O_WT_PLE = O_WT_PG + 1024ull * 1024 * 2;
constexpr size_t O_KEYS = O_WT_PLE + 1024ull * 256 * 2;
constexpr size_t O_WT_MQ = O_KEYS + 16ull * 128 * 128 * 2;
constexpr size_t O_WT_MK = O_WT_MQ + 4ull * 128 * 128 * 2;
constexpr size_t O_COS = O_WT_MK + 4ull * 128 * 128 * 2;
constexpr size_t O_SIN = O_COS + 8192ull * 64 * 4;
constexpr size_t O_FQ = O_SIN + 8192ull * 64 * 4;
constexpr size_t O_UQ = O_FQ + (size_t)MT * 16;
constexpr size_t O_CMQ = O_UQ + (size_t)MT * 16;
constexpr size_t O_FL = O_CMQ + (size_t)MT * 16;
constexpr size_t O_UC = O_FL + 16384;
constexpr size_t O_AEND = O_UC + 16384;
constexpr size_t O_MCS = O_AEND + 16384;
constexpr size_t O_DN = O_MCS + 16384;
constexpr size_t O_DSS = O_DN + 2112ull * 128 * 4;
constexpr size_t O_GPRE = O_DSS + 2ull * 64 * 16384 * 2;
constexpr size_t O_BAR = O_GPRE + (size_t)MT * 32;
constexpr size_t O_SMALL_END = O_BAR + 16384;
constexpr size_t SLOT0 = 40ull << 20;
constexpr size_t USZ = (size_t)MT * 512 * 2;
static_assert(O_SMALL_END <= SLOT0, "small region overflow");
#define SLOT(i) (SLOT0 + (size_t)(i) * USZ)
constexpr size_t SB_T = 16ull * 128 * 8192;

constexpr size_t OO_Y = 0;
constexpr size_t OO_RETP = (size_t)MT * 1024;
constexpr size_t OO_CP = OO_RETP + 262144;
constexpr size_t OO_NP = OO_CP + 262144;
constexpr size_t OO_MP = OO_NP + 2048;
constexpr size_t OO_CONVP = OO_MP + 16;
constexpr size_t OO_RETS = OO_CONVP + 6144;
constexpr size_t OO_CS = OO_RETS + 1048576;
constexpr size_t OO_NS = OO_CS + 1048576;
constexpr size_t OO_MS = OO_NS + 8192;
constexpr size_t OO_CONVS = OO_MS + 64;

constexpr int SMEM_BYTES = 81152;

__device__ __forceinline__ bfu f2bf(float f) {
  unsigned u = __float_as_uint(f);
  u += 0x7fffu + ((u >> 16) & 1u);
  return (bfu)(u >> 16);
}
__device__ __forceinline__ float bf2f(bfu b) { return __uint_as_float(((unsigned)b) << 16); }
__device__ __forceinline__ unsigned pack2(float a, float b) { return (unsigned)f2bf(a) | ((unsigned)f2bf(b) << 16); }
__device__ __forceinline__ void unpack8(uint4 v, float* f) {
  f[0] = bf2f(v.x & 0xffff); f[1] = bf2f(v.x >> 16); f[2] = bf2f(v.y & 0xffff); f[3] = bf2f(v.y >> 16);
  f[4] = bf2f(v.z & 0xffff); f[5] = bf2f(v.z >> 16); f[6] = bf2f(v.w & 0xffff); f[7] = bf2f(v.w >> 16);
}
__device__ __forceinline__ uint4 pack8(const float* f) {
  uint4 o; o.x = pack2(f[0], f[1]); o.y = pack2(f[2], f[3]); o.z = pack2(f[4], f[5]); o.w = pack2(f[6], f[7]);
  return o;
}
__device__ __forceinline__ float wave_sum(float v) {
#pragma unroll
  for (int o = 32; o > 0; o >>= 1) v += __shfl_xor(v, o);
  return v;
}
__device__ __forceinline__ float wave_max(float v) {
#pragma unroll
  for (int o = 32; o > 0; o >>= 1) v = fmaxf(v, __shfl_xor(v, o));
  return v;
}
__device__ __forceinline__ float dpp_ror_add(float s, const int ctrl_sel) {
  int v = __float_as_int(s);
  int t;
  if (ctrl_sel == 8) t = __builtin_amdgcn_update_dpp(0, v, 0x128, 0xf, 0xf, false);
  else if (ctrl_sel == 4) t = __builtin_amdgcn_update_dpp(0, v, 0x124, 0xf, 0xf, false);
  else if (ctrl_sel == 2) t = __builtin_amdgcn_update_dpp(0, v, 0x122, 0xf, 0xf, false);
  else t = __builtin_amdgcn_update_dpp(0, v, 0x121, 0xf, 0xf, false);
  return s + __int_as_float(t);
}
__device__ __forceinline__ float reduce4(float p0, float p1, float p2, float p3) {
  auto r = __builtin_amdgcn_permlane32_swap(__float_as_int(p0), __float_as_int(p2), false, false);
  float sA = __int_as_float(r[0]) + __int_as_float(r[1]);
  r = __builtin_amdgcn_permlane32_swap(__float_as_int(p1), __float_as_int(p3), false, false);
  float sB = __int_as_float(r[0]) + __int_as_float(r[1]);
  r = __builtin_amdgcn_permlane16_swap(__float_as_int(sA), __float_as_int(sB), false, false);
  float s = __int_as_float(r[0]) + __int_as_float(r[1]);
  s = dpp_ror_add(s, 8); s = dpp_ror_add(s, 4); s = dpp_ror_add(s, 2); s = dpp_ror_add(s, 1);
  return s;
}
__device__ __forceinline__ float sigmoidf_(float x) { return 1.f / (1.f + __expf(-x)); }
__device__ __forceinline__ const float* xrow(const Params& P, int r) {
  return r < MP ? P.xp + (size_t)r * 1024 : P.xs + (size_t)(r - MP) * 1024;
}


#define XB_TMO      128
#define XB_XCNT(j)  (256  + 64 * (j))
#define XB_XSUB(j)  (1280 + 64 * (j))
#define XB_XGEN(j)  (2304 + 64 * (j))
#define XB_TOP      3328
#define XB_TOPGEN   3392
#define XCD_BAR_WORDS 3456
#define XB_SPIN_CAP (1u << 22)
#define LAS __attribute__((address_space(3)))
__device__ __forceinline__ unsigned xb_ld(unsigned* p) { return __hip_atomic_load(p, __ATOMIC_RELAXED, __HIP_MEMORY_SCOPE_AGENT); }
__device__ __forceinline__ unsigned xb_add(unsigned* p, unsigned v) { return __hip_atomic_fetch_add(p, v, __ATOMIC_RELAXED, __HIP_MEMORY_SCOPE_AGENT); }
__device__ __forceinline__ unsigned xb_xcc_id() { return (unsigned)__builtin_amdgcn_s_getreg((3 << 11) | 20) & 0xFu; }
#define XB_SPIN(cond, bar) do { unsigned _sp = 0; while (cond) { __builtin_amdgcn_s_sleep(1); \
    if ((++_sp & 255u) == 0u) { if (xb_ld(&(bar)[XB_TMO])) break; if (_sp > XB_SPIN_CAP) { atomicAdd(&(bar)[XB_TMO], 1u); break; } } } } while (0)
struct XcdBarrier { unsigned* bar; unsigned x; volatile LAS unsigned* st; };
__device__ __forceinline__ XcdBarrier xcd_barrier_post(unsigned* bar, volatile LAS unsigned* st) {
  XcdBarrier b; b.bar = bar; b.x = xb_xcc_id(); b.st = st;
  if (threadIdx.x == 0) (void)xb_add(&bar[XB_XCNT(b.x)], 1u);
  return b;
}
__device__ __forceinline__ void xcd_barrier_complete(unsigned* bar, unsigned x, unsigned& nloc, unsigned& nx) {
  const unsigned G = gridDim.x * gridDim.y * gridDim.z;
  unsigned sum, cnt, mine, sp = 0u;
  for (;;) {
    sum = 0u; cnt = 0u; mine = 0u;
#pragma unroll
    for (unsigned j = 0; j < 16; ++j) { const unsigned c = xb_ld(&bar[XB_XCNT(j)]); sum += c; cnt += (c > 0u) ? 1u : 0u; mine = (j == x) ? c : mine; }
    if (sum == G) break;
    __builtin_amdgcn_s_sleep(1);
    if ((++sp & 255u) == 0u) { if (xb_ld(&bar[XB_TMO])) break; if (sp > XB_SPIN_CAP) { atomicAdd(&bar[XB_TMO], 1u); break; } }
  }
  nloc = mine > 0u ? mine : 1u; nx = cnt > 0u ? cnt : 1u;
}
__device__ __forceinline__ void xcd_barrier(const XcdBarrier& b) {
  asm volatile("s_waitcnt vmcnt(0)" ::: "memory");
  __syncthreads();
  if (threadIdx.x == 0) {
    unsigned* bar = b.bar;
    __builtin_amdgcn_s_waitcnt(0);
    unsigned nloc = b.st[0], nx = b.st[1];
    if (nloc == 0u) { xcd_barrier_complete(bar, b.x, nloc, nx); b.st[0] = nloc; b.st[1] = nx; }
    const unsigned old = xb_add(&bar[XB_XSUB(b.x)], 1u);
    const unsigned gen = old / nloc;
    if (old + 1u == (gen + 1u) * nloc) {
      __builtin_amdgcn_fence(__ATOMIC_RELEASE, "agent");
      asm volatile("s_waitcnt vmcnt(0)" ::: "memory");
      const unsigned og = xb_add(&bar[XB_TOP], 1u);
      const unsigned tg = og / nx;
      if (og + 1u == (tg + 1u) * nx) xb_add(&bar[XB_TOPGEN], 1u);
      else XB_SPIN(xb_ld(&bar[XB_TOPGEN]) == tg, bar);
      __builtin_amdgcn_fence(__ATOMIC_ACQUIRE, "agent");
      xb_add(&bar[XB_XGEN(b.x)], 1u);
      asm volatile("s_waitcnt vmcnt(0)" ::: "memory");
    } else {
      XB_SPIN(xb_ld(&bar[XB_XGEN(b.x)]) == gen, bar);
      __builtin_amdgcn_fence(__ATOMIC_ACQUIRE, "agent");
      asm volatile("s_waitcnt vmcnt(0)" ::: "memory");
    }
  }
  __syncthreads();
}

__device__ __forceinline__ void gemm_acc(f32x16 (&acc)[2][2], const bfu* __restrict__ A, int lda,
                                         const bfu* __restrict__ Bt, int ldb, int K, bfu* sA, bfu* sB) {
  const int tid = threadIdx.x, lane = tid & 63, w = tid >> 6, wm = w & 1, wn = w >> 1;
  const int lr = tid >> 3, lkc = (tid & 7) * 8;
  const bfu* Ap = A + (size_t)lr * lda + lkc;
  const bfu* Bp = Bt + (size_t)lr * ldb + lkc;
  const size_t a32 = (size_t)32 * lda, b32 = (size_t)32 * ldb;
  uint4 ra0, ra1, ra2, ra3, rb0, rb1, rb2, rb3;
#define GLOAD(k)                                                                  \
  ra0 = *(const uint4*)(Ap + (k)); ra1 = *(const uint4*)(Ap + a32 + (k));         \
  ra2 = *(const uint4*)(Ap + 2 * a32 + (k)); ra3 = *(const uint4*)(Ap + 3 * a32 + (k)); \
  rb0 = *(const uint4*)(Bp + (k)); rb1 = *(const uint4*)(Bp + b32 + (k));         \
  rb2 = *(const uint4*)(Bp + 2 * b32 + (k)); rb3 = *(const uint4*)(Bp + 3 * b32 + (k));
  GLOAD(0)
  bfu* sAp = sA + lr * 72 + lkc;
  bfu* sBp = sB + lr * 72 + lkc;
  constexpr int BUF = 2 * 128 * 72;
  __syncthreads();
  *(uint4*)(sAp) = ra0; *(uint4*)(sAp + 32 * 72) = ra1; *(uint4*)(sAp + 64 * 72) = ra2; *(uint4*)(sAp + 96 * 72) = ra3;
  *(uint4*)(sBp) = rb0; *(uint4*)(sBp + 32 * 72) = rb1; *(uint4*)(sBp + 64 * 72) = rb2; *(uint4*)(sBp + 96 * 72) = rb3;
  __syncthreads();
  if (64 < K) { GLOAD(64) }
  int cur = 0;
  for (int k0 = 0; k0 < K; k0 += 64) {
    const bfu* cA = sA + cur * BUF;
    const bfu* cB = sB + cur * BUF;
#pragma unroll
    for (int ks = 0; ks < 4; ++ks) {
      bf16x8 af[2], bfr[2];
#pragma unroll
      for (int mi = 0; mi < 2; ++mi)
        af[mi] = *(const bf16x8*)(cA + (wm * 64 + mi * 32 + (lane & 31)) * 72 + ks * 16 + (lane >> 5) * 8);
#pragma unroll
      for (int ni = 0; ni < 2; ++ni)
        bfr[ni] = *(const bf16x8*)(cB + (wn * 32 + ni * 64 + (lane & 31)) * 72 + ks * 16 + (lane >> 5) * 8);
#pragma unroll
      for (int mi = 0; mi < 2; ++mi)
#pragma unroll
        for (int ni = 0; ni < 2; ++ni)
          acc[mi][ni] = __builtin_amdgcn_mfma_f32_32x32x16_bf16(af[mi], bfr[ni], acc[mi][ni], 0, 0, 0);
    }
    if (k0 + 64 < K) {
      bfu* nA = sAp + (cur ^ 1) * BUF;
      bfu* nB = sBp + (cur ^ 1) * BUF;
      *(uint4*)(nA) = ra0; *(uint4*)(nA + 32 * 72) = ra1; *(uint4*)(nA + 64 * 72) = ra2; *(uint4*)(nA + 96 * 72) = ra3;
      *(uint4*)(nB) = rb0; *(uint4*)(nB + 32 * 72) = rb1; *(uint4*)(nB + 64 * 72) = rb2; *(uint4*)(nB + 96 * 72) = rb3;
      __syncthreads();
      if (k0 + 128 < K) { GLOAD(k0 + 128) }
      cur ^= 1;
    }
  }
}
__device__ __forceinline__ void zero_acc(f32x16 (&acc)[2][2]) {
#pragma unroll
  for (int a = 0; a < 2; ++a)
#pragma unroll
    for (int b = 0; b < 2; ++b)
#pragma unroll
      for (int i = 0; i < 16; ++i) acc[a][b][i] = 0.f;
}
#define EPI_BEGIN                                                      \
  const int e_lane = threadIdx.x & 63, e_w = threadIdx.x >> 6;         \
  const int e_wm = e_w & 1, e_wn = e_w >> 1;                            \
  const int cl = e_wn * 32 + (e_lane & 31);                             \
  _Pragma("unroll") for (int mi = 0; mi < 2; ++mi)                      \
  _Pragma("unroll") for (int q = 0; q < 4; ++q) {                       \
    const int r0 = e_wm * 64 + mi * 32 + q * 8 + 4 * (e_lane >> 5);
#define EPI_END }

#define ST_LD 136
#define ST32_LD 132
__device__ __forceinline__ void copyout_bf16(const bfu* sT, bfu* dst, int ld) {
  const int tid = threadIdx.x;
#pragma unroll
  for (int i = 0; i < 8; ++i) {
    int id = tid + i * 256, row = id >> 4, c8 = (id & 15) * 8;
    *(uint4*)(dst + (size_t)row * ld + c8) = *(const uint4*)(sT + row * ST_LD + c8);
  }
}
__device__ __forceinline__ void stage_rm(bfu* sT, const f32x16 (&acc)[2][2], float sc) {
  EPI_BEGIN
#pragma unroll
    for (int j = 0; j < 4; ++j) {
      sT[(r0 + j) * ST_LD + cl] = f2bf(acc[mi][0][q * 4 + j] * sc);
      sT[(r0 + j) * ST_LD + cl + 64] = f2bf(acc[mi][1][q * 4 + j] * sc);
    }
  EPI_END
}

__device__ __forceinline__ void tile_map(int L, int nM, int nN, int& pm, int& pn) {
  const int nwg = nM * nN;
  const int q = nwg >> 3, r = nwg & 7, xcd = L & 7, off = L >> 3;
  int wgid = (xcd < r ? xcd * (q + 1) : r * (q + 1) + (xcd - r) * q) + off;
  const int nig = 8 * nN, gid = wgid / nig, fm = gid * 8;
  const int gsz = (nM - fm) < 8 ? (nM - fm) : 8;
  pm = fm + (wgid % nig) % gsz;
  pn = (wgid % nig) / gsz;
}
__device__ void transpose_w(const float* __restrict__ src, int K, int N, int src_ld, bfu* __restrict__ dst,
                            int remap, int gtid, int gstride) {
  int total = N * (K / 8);
  for (int i = gtid; i < total; i += gstride) {
    int n = i % N, kg = i / N;
    int col = (remap && n >= 3584) ? n + 8 : n;
    float v[8];
#pragma unroll
    for (int j = 0; j < 8; ++j) v[j] = src[(size_t)(kg * 8 + j) * src_ld + col];
    uint4 o;
    o.x = pack2(v[0], v[1]); o.y = pack2(v[2], v[3]); o.z = pack2(v[4], v[5]); o.w = pack2(v[6], v[7]);
    *(uint4*)(dst + (size_t)n * K + kg * 8) = o;
  }
}
__device__ void transpose_w_lds(const float* __restrict__ src, int K, int N, int src_ld, bfu* __restrict__ dst,
                                int remap, float* st, int boff) {
  const int tid = threadIdx.x;
  const int tilesN = N >> 6, ntile = (K >> 6) * tilesN;
  for (int t = (int)((blockIdx.x + gridDim.x - (boff % gridDim.x)) % gridDim.x); t < ntile; t += gridDim.x) {
    const int kt = t / tilesN, nt = t - kt * tilesN;
    {
      const int row = tid >> 2, c16 = (tid & 3) * 16;
      const int n0 = nt * 64 + c16;
      const int col = (remap && n0 >= 3584) ? n0 + 8 : n0;
      const float* sp = src + (size_t)(kt * 64 + row) * src_ld + col;
#pragma unroll
      for (int j = 0; j < 4; ++j) {
        float4 v = *(const float4*)(sp + j * 4);
        float* d = st + row * 65 + c16 + j * 4;
        d[0] = v.x; d[1] = v.y; d[2] = v.z; d[3] = v.w;
      }
    }
    __syncthreads();
    {
      const int n = tid >> 2, kc = (tid & 3) * 16;
#pragma unroll
      for (int hf = 0; hf < 2; ++hf) {
        float f[8];
#pragma unroll
        for (int j = 0; j < 8; ++j) f[j] = st[(kc + hf * 8 + j) * 65 + n];
        uint4 o;
        o.x = pack2(f[0], f[1]); o.y = pack2(f[2], f[3]); o.z = pack2(f[4], f[5]); o.w = pack2(f[6], f[7]);
        *(uint4*)(dst + (size_t)(nt * 64 + n) * K + kt * 64 + kc + hf * 8) = o;
      }
    }
    __syncthreads();
  }
}
__device__ void convert_bf(const float* __restrict__ src, bfu* __restrict__ dst, size_t n8, int gtid, int gstride) {
  for (size_t i = gtid; i < n8; i += gstride) {
    float4 a = *(const float4*)(src + i * 8), b = *(const float4*)(src + i * 8 + 4);
    uint4 o;
    o.x = pack2(a.x, a.y); o.y = pack2(a.z, a.w); o.z = pack2(b.x, b.y); o.w = pack2(b.z, b.w);
    *(uint4*)(dst + i * 8) = o;
  }
}

__device__ void prep_rows(const Params& P) {
  const int lane = threadIdx.x & 63, w = threadIdx.x >> 6;
  bfu* hbuf = (bfu*)(P.ws + SLOT(0));
  float* gpre = (float*)(P.ws + O_GPRE);
  for (int r = blockIdx.x * 4 + w; r < MT; r += gridDim.x * 4) {
    const float* xr = xrow(P, r);
    float4 v[4];
    float ss = 0.f;
#pragma unroll
    for (int i = 0; i < 4; ++i) {
      v[i] = *(const float4*)(xr + i * 256 + lane * 4);
      ss += v[i].x * v[i].x + v[i].y * v[i].y + v[i].z * v[i].z + v[i].w * v[i].w;
    }
    ss = wave_sum(ss);
    float rstd = rsqrtf(ss * (1.f / 1024.f) + EPS);
    float ga[8];
#pragma unroll
    for (int j = 0; j < 8; ++j) ga[j] = 0.f;
#pragma unroll
    for (int i = 0; i < 4; ++i) {
      float4 g = *(const float4*)(P.g_mix + i * 256 + lane * 4);
      float hv[4] = {v[i].x * rstd * g.x, v[i].y * rstd * g.y, v[i].z * rstd * g.z, v[i].w * rstd * g.w};
      uint2 o; o.x = pack2(hv[0], hv[1]); o.y = pack2(hv[2], hv[3]);
      *(uint2*)(hbuf + (size_t)r * 1024 + i * 256 + lane * 4) = o;
#pragma unroll
      for (int j = 0; j < 4; ++j) {
        const float* wr = P.w_in + (size_t)(i * 256 + lane * 4 + j) * 5640 + 3584;
        float4 w0 = *(const float4*)wr, w1 = *(const float4*)(wr + 4);
        ga[0] += hv[j] * w0.x; ga[1] += hv[j] * w0.y; ga[2] += hv[j] * w0.z; ga[3] += hv[j] * w0.w;
        ga[4] += hv[j] * w1.x; ga[5] += hv[j] * w1.y; ga[6] += hv[j] * w1.z; ga[7] += hv[j] * w1.w;
      }
    }
    float si = reduce4(ga[0], ga[1], ga[2], ga[3]);
    float sf = reduce4(ga[4], ga[5], ga[6], ga[7]);
    if ((lane & 15) == 0) {
      int k = lane >> 4;
      gpre[(size_t)r * 8 + k] = si + P.b_i[k];
      gpre[(size_t)r * 8 + 4 + k] = sf + P.b_f[k];
    }
  }
}
__device__ void gate_scan(const Params& P) {
  const int lane = threadIdx.x & 63, w = threadIdx.x >> 6;
  const float* gpre = (const float*)(P.ws + O_GPRE);
  for (int item = blockIdx.x * 4 + w; item < 528 * 4; item += gridDim.x * 4) {
    int tile = item >> 2, h = item & 3;
    int row0, L;
    if (tile < 512) { row0 = tile * 64; L = 64; } else { row0 = MP + (tile - 512) * 32; L = 32; }
    const int s = lane;
    bool valid = s < L;
    float ig = valid ? gpre[(size_t)(row0 + s) * 8 + h] : -INFINITY;
    float fg = valid ? gpre[(size_t)(row0 + s) * 8 + 4 + h] : 0.f;
    float lf = valid ? (fminf(fg, 0.f) - log1pf(__expf(-fabsf(fg)))) : 0.f;
    float F = lf;
#pragma unroll
    for (int o = 1; o < 64; o <<= 1) { float t = __shfl_up(F, o); if (lane >= o) F += t; }
    float u = valid ? ig - F : -INFINITY;
    float cm = u;
#pragma unroll
    for (int o = 1; o < 64; o <<= 1) { float t = __shfl_up(cm, o); if (lane >= o) cm = fmaxf(cm, t); }
    if (valid) {
      size_t gi = (size_t)(row0 + s) * 4 + h;
      ((float*)(P.ws + O_FQ))[gi] = F;
      ((float*)(P.ws + O_UQ))[gi] = u;
      ((float*)(P.ws + O_CMQ))[gi] = cm;
      if (s == L - 1) {
        ((float*)(P.ws + O_FL))[tile * 4 + h] = F;
        ((float*)(P.ws + O_UC))[tile * 4 + h] = cm;
      }
    }
  }
}

__device__ void phase_prep(const Params& P, char* smem) {
  const int gtid = blockIdx.x * NTHREADS + threadIdx.x, gstride = gridDim.x * NTHREADS;
  prep_rows(P);
  transpose_w_lds(P.w_in, 1024, 5632, 5640, (bfu*)(P.ws + O_WT_IN), 1, (float*)smem, 0);
  transpose_w_lds(P.w_up_r, 512, 1024, 1024, (bfu*)(P.ws + O_WT_UPR), 0, (float*)smem, 1408);
  transpose_w_lds(P.w_up_m, 512, 1024, 1024, (bfu*)(P.ws + O_WT_UPM), 0, (float*)smem, 1536);
  transpose_w_lds(P.w_out, 1024, 1024, 1024, (bfu*)(P.ws + O_WT_OUT), 0, (float*)smem, 1664);
  transpose_w_lds(P.w_pq, 1024, 2048, 2048, (bfu*)(P.ws + O_WT_PQ), 0, (float*)smem, 1920);
  transpose_w_lds(P.w_pg, 1024, 1024, 1024, (bfu*)(P.ws + O_WT_PG), 0, (float*)smem, 2432);
  transpose_w_lds(P.w_ple, 256, 1024, 1024, (bfu*)(P.ws + O_WT_PLE), 0, (float*)smem, 2688);
  for (int h = 0; h < 4; ++h) {
    transpose_w_lds(P.w_mq + h * 16384, 128, 128, 128, (bfu*)(P.ws + O_WT_MQ) + h * 16384, 0, (float*)smem, 2752 + h * 8);
    transpose_w_lds(P.w_mk + h * 16384, 128, 128, 128, (bfu*)(P.ws + O_WT_MK) + h * 16384, 0, (float*)smem, 2756 + h * 8);
  }
  convert_bf(P.peer_keys, (bfu*)(P.ws + O_KEYS), 16 * 128 * 128 / 8, gtid, gstride);
  float* ct = (float*)(P.ws + O_COS); float* st = (float*)(P.ws + O_SIN);
  for (int i = gtid; i < 8192 * 64; i += gstride) {
    int pos = i >> 6, j = i & 63;
    float inv = exp2f(-(float)j * (13.287712379549449f / 64.f));
    float angf = (float)pos * inv;
    double a = (double)angf;
    double k = rint(a * 0.15915494309189535);
    float r = (float)(a - k * 6.283185307179586);
    ct[i] = __cosf(r); st[i] = __sinf(r);
  }
}

__device__ void phase_gemm1(const Params& P, char* smem) {
  bfu* sA = (bfu*)smem; bfu* sB = sA + 128 * 72;
  const bfu* hbuf = (const bfu*)(P.ws + SLOT(0));
  const bfu* wt = (const bfu*)(P.ws + O_WT_IN);
  const float* ct = (const float*)(P.ws + O_COS); const float* stb = (const float*)(P.ws + O_SIN);
  for (int t = blockIdx.x; t < 260 * 44; t += gridDim.x) {
    int mt, nt; tile_map(t, 260, 44, mt, nt);
    f32x16 acc[2][2]; zero_acc(acc);
    gemm_acc(acc, hbuf + (size_t)mt * 128 * 1024, 1024, wt + (size_t)nt * 128 * 1024, 1024, 1024, sA, sB);
    const int rbase = mt * 128;
    const bool prompt = rbase < MP;
    int region = nt >> 2, hh = nt & 3;
    bfu* sT = (bfu*)smem;
    __syncthreads();
    if (region <= 1) {
      float sc = region == 1 ? 0.08838834764831845f : 1.f;
      EPI_BEGIN
#pragma unroll
        for (int j = 0; j < 4; ++j) {
          int rr = rbase + r0 + j;
          int pos = prompt ? (rr & 8191) : 2048 + ((rr - MP) & 31);
          float c = ct[pos * 64 + cl], sn = stb[pos * 64 + cl];
          float a = acc[mi][0][q * 4 + j], b = acc[mi][1][q * 4 + j];
          sT[(r0 + j) * ST_LD + cl] = f2bf((a * c - b * sn) * sc);
          sT[(r0 + j) * ST_LD + cl + 64] = f2bf((a * sn + b * c) * sc);
        }
      EPI_END
      __syncthreads();
      copyout_bf16(sT, (bfu*)(P.ws + SLOT(2 + region)) + (size_t)rbase * 512 + hh * 128, 512);
    } else if (region == 2 || region == 5) {
      EPI_BEGIN
        uint2 va, vb;
        va.x = pack2(acc[mi][0][q * 4 + 0], acc[mi][0][q * 4 + 1]); va.y = pack2(acc[mi][0][q * 4 + 2], acc[mi][0][q * 4 + 3]);
        vb.x = pack2(acc[mi][1][q * 4 + 0], acc[mi][1][q * 4 + 1]); vb.y = pack2(acc[mi][1][q * 4 + 2], acc[mi][1][q * 4 + 3]);
        *(uint2*)(sT + cl * ST_LD + r0) = va;
        *(uint2*)(sT + (cl + 64) * ST_LD + r0) = vb;
      EPI_END
      __syncthreads();
      bfu* dst = (bfu*)(P.ws + SLOT(region == 2 ? 4 : 7));
#pragma unroll
      for (int i = 0; i < 8; ++i) {
        int id = threadIdx.x + i * 256, e = id >> 4, c8 = (id & 15) * 8;
        size_t o;
        if (prompt) { int bb = rbase >> 13, tt = (rbase & 8191) + c8; o = ((size_t)((bb * 4 + hh) * 128 + e)) * 8192 + tt; }
        else { int rs = rbase - MP + c8, bb = rs >> 5, tt = rs & 31; o = SB_T + ((size_t)((bb * 4 + hh) * 128 + e)) * 32 + tt; }
        *(uint4*)(dst + o) = *(const uint4*)(sT + e * ST_LD + c8);
      }
    } else if (region == 3 || region == 4 || region == 6) {
      stage_rm(sT, acc, 1.f);
      __syncthreads();
      copyout_bf16(sT, (bfu*)(P.ws + SLOT(region == 3 ? 5 : (region == 4 ? 6 : 8))) + (size_t)rbase * 512 + hh * 128, 512);
    } else {
      int gi = nt - 28;
      stage_rm(sT, acc, 1.f);
      __syncthreads();
      copyout_bf16(sT, (bfu*)(P.ws + SLOT(gi < 8 ? 9 : 11)) + (size_t)rbase * 1024 + (gi & 7) * 128, 1024);
    }
  }
}

__device__ void phase_conv(const Params& P) {
  const int gtid = blockIdx.x * NTHREADS + threadIdx.x, gstride = gridDim.x * NTHREADS;
  const bfu* xm = (const bfu*)(P.ws + SLOT(6));
  bfu* cb = (bfu*)(P.ws + SLOT(0));
  for (int i = gtid; i < MT * 64; i += gstride) {
    int r = i >> 6, c0 = (i & 63) * 8;
    int t, T, bb; bool prompt = r < MP;
    if (prompt) { bb = r >> 13; t = r & 8191; T = 8192; } else { int rs = r - MP; bb = rs >> 5; t = rs & 31; T = 32; }
    float y[8];
#pragma unroll
    for (int j = 0; j < 8; ++j) y[j] = P.conv_b[c0 + j];
#pragma unroll
    for (int k = 0; k < 4; ++k) {
      int tt = t - 3 + k;
      float xv[8];
      if (tt >= 0) {
        uint4 v = *(const uint4*)(xm + (size_t)(r - 3 + k) * 512 + c0);
        xv[0] = bf2f(v.x & 0xffff); xv[1] = bf2f(v.x >> 16); xv[2] = bf2f(v.y & 0xffff); xv[3] = bf2f(v.y >> 16);
        xv[4] = bf2f(v.z & 0xffff); xv[5] = bf2f(v.z >> 16); xv[6] = bf2f(v.w & 0xffff); xv[7] = bf2f(v.w >> 16);
      } else if (!prompt) {
        const float* sp = P.st_conv + (size_t)(bb * 3 + (tt + 3)) * 512 + c0;
#pragma unroll
        for (int j = 0; j < 8; ++j) xv[j] = sp[j];
      } else {
#pragma unroll
        for (int j = 0; j < 8; ++j) xv[j] = 0.f;
      }
#pragma unroll
      for (int j = 0; j < 8; ++j) y[j] += xv[j] * P.conv_w[k * 512 + c0 + j];
    }
    if (t >= T - 3) {
      uint4 v = *(const uint4*)(xm + (size_t)r * 512 + c0);
      float* dst = (prompt ? P.out + OO_CONVP : P.out + OO_CONVS) + (size_t)(bb * 3 + (t - (T - 3))) * 512 + c0;
      dst[0] = bf2f(v.x & 0xffff); dst[1] = bf2f(v.x >> 16); dst[2] = bf2f(v.y & 0xffff); dst[3] = bf2f(v.y >> 16);
      dst[4] = bf2f(v.z & 0xffff); dst[5] = bf2f(v.z >> 16); dst[6] = bf2f(v.w & 0xffff); dst[7] = bf2f(v.w >> 16);
    }
    uint4 o;
#pragma unroll
    for (int j = 0; j < 8; ++j) y[j] = y[j] * sigmoidf_(y[j]);
    o.x = pack2(y[0], y[1]); o.y = pack2(y[2], y[3]); o.z = pack2(y[4], y[5]); o.w = pack2(y[6], y[7]);
    *(uint4*)(cb + (size_t)r * 512 + c0) = o;
  }
}

__device__ void m_fold(const Params& P) {
  const int gtid = blockIdx.x * NTHREADS + threadIdx.x;
  const float* FL = (const float*)(P.ws + O_FL); const float* UC = (const float*)(P.ws + O_UC);
  float* MCS = (float*)(P.ws + O_MCS);
  if (gtid < 16) {
    int b = gtid >> 2, h = gtid & 3;
    float m = 0.f;
    for (int c = 0; c < 128; c += 8) {
      float fl[8], uc[8];
#pragma unroll
      for (int k = 0; k < 8; ++k) { fl[k] = FL[(b * 128 + c + k) * 4 + h]; uc[k] = UC[(b * 128 + c + k) * 4 + h]; }
#pragma unroll
      for (int k = 0; k < 8; ++k) { MCS[gtid * 128 + c + k] = m; m = fl[k] + fmaxf(m, uc[k]); }
    }
  } else if (gtid < 16 + 64) {
    int bh = gtid - 16;
    MCS[2048 + bh] = P.st_m[bh];
  }
}
__device__ void phase_mqk(const Params& P, char* smem) {
  bfu* sA = (bfu*)smem; bfu* sB = sA + 128 * 72;
  const bfu* cb = (const bfu*)(P.ws + SLOT(0));
  for (int t = blockIdx.x; t < 260 * 8; t += gridDim.x) {
    int mt = t >> 3, which = (t >> 2) & 1, hh = t & 3;
    const bfu* wt = (const bfu*)(P.ws + (which ? O_WT_MK : O_WT_MQ)) + hh * 16384;
    f32x16 acc[2][2]; zero_acc(acc);
    gemm_acc(acc, cb + (size_t)mt * 128 * 512 + hh * 128, 512, wt, 128, 128, sA, sB);
    bfu* dst = (bfu*)(P.ws + SLOT(which ? 13 : 1));
    float sc = which ? 0.08838834764831845f : 1.f;
    bfu* sT = (bfu*)smem;
    __syncthreads();
    stage_rm(sT, acc, sc);
    __syncthreads();
    copyout_bf16(sT, dst + (size_t)mt * 128 * 512 + hh * 128, 512);
  }
}

struct Item { int b, h, c, row0, L, T, chunk, bh; bool prompt; size_t vt_off; };
__device__ __forceinline__ Item decode_item(int idx) {
  Item it;
  if (idx < 2048) {
    it.prompt = true; it.b = idx >> 9; it.h = (idx >> 7) & 3; it.c = idx & 127; it.row0 = it.b * 8192 + it.c * 64;
    it.L = 64; it.T = 8192; it.chunk = it.b * 128 + it.c; it.bh = it.b * 4 + it.h;
    it.vt_off = ((size_t)(it.bh * 128)) * 8192 + it.c * 64;
  } else {
    int si = idx - 2048; it.prompt = false; it.b = si >> 2; it.h = si & 3; it.c = 0; it.row0 = MP + it.b * 32;
    it.L = 32; it.T = 32; it.chunk = 512 + it.b; it.bh = it.b * 4 + it.h;
    it.vt_off = SB_T + ((size_t)(it.bh * 128)) * 32;
  }
  return it;
}
__device__ __forceinline__ bfu* ds_ptr(const Params& P, int mixer, int idx) {
  if (idx < 2048) return (bfu*)P.out + ((size_t)(mixer * 2048 + idx)) * 16384;
  return (bfu*)(P.ws + O_DSS) + ((size_t)(mixer * 64 + (idx - 2048))) * 16384;
}
__device__ __forceinline__ float ret_lg(int h) { return log1pf(-exp2f(-5.f - (float)h)); }

__device__ void phaseA_item(const Params& P, int mixer, int idx, char* smem) {
  const int tid = threadIdx.x, lane = tid & 63, w = tid >> 6, wm = w & 1, wn = w >> 1;
  Item it = decode_item(idx);
  bfu* sK = (bfu*)smem; bfu* sV = sK + 128 * 72;
  float* sw = (float*)(sV + 128 * 72);
  float* sm = sw + 64;
  const int L = it.L, h = it.h;
  const bfu* Ksrc = (const bfu*)(P.ws + SLOT(mixer == 0 ? 3 : 13)) + (size_t)it.row0 * 512 + h * 128;
  const bfu* Vsrc = (const bfu*)(P.ws + SLOT(mixer == 0 ? 4 : 7)) + it.vt_off;
  uint4 kreg[4], vreg[4];
#pragma unroll
  for (int i = 0; i < 4; ++i) {
    int id = tid + i * 256, s = id & 63, dc = (id >> 6) * 8;
    kreg[i] = make_uint4(0, 0, 0, 0);
    if (s < L) kreg[i] = *(const uint4*)(Ksrc + (size_t)s * 512 + dc);
    int e = id >> 3, sc = (id & 7) * 8;
    vreg[i] = make_uint4(0, 0, 0, 0);
    if (sc < L) vreg[i] = *(const uint4*)(Vsrc + (size_t)e * it.T + sc);
  }
  if (mixer == 0) {
    if (tid < 64) { float lg = ret_lg(h); sw[tid] = tid < L ? __expf(lg * (float)(L - 1 - tid)) : 0.f; }
  } else {
    const float* FL = (const float*)(P.ws + O_FL); const float* UC = (const float*)(P.ws + O_UC);
    float mc = ((const float*)(P.ws + O_MCS))[idx];
    float Ml = fmaxf(mc, UC[it.chunk * 4 + h]);
    if (tid < 64) sw[tid] = tid < L ? __expf(((const float*)(P.ws + O_UQ))[(size_t)(it.row0 + tid) * 4 + h] - Ml) : 0.f;
    if (tid == 0) {
      ((float*)(P.ws + O_AEND))[idx] = __expf(mc - Ml);
      if (!it.prompt) P.out[OO_MS + it.bh] = FL[it.chunk * 4 + h] + Ml;
      else if (it.c == 127) P.out[OO_MP + it.bh] = FL[it.chunk * 4 + h] + Ml;
    }
  }
  __syncthreads();
#pragma unroll
  for (int i = 0; i < 4; ++i) {
    int id = tid + i * 256, s = id & 63, dc = (id >> 6) * 8;
    uint4 v = kreg[i];
    float ww = sw[s];
    unsigned vv[4] = {v.x, v.y, v.z, v.w};
#pragma unroll
    for (int j = 0; j < 4; ++j) {
      sK[(dc + 2 * j) * 72 + s] = f2bf(bf2f(vv[j] & 0xffff) * ww);
      sK[(dc + 2 * j + 1) * 72 + s] = f2bf(bf2f(vv[j] >> 16) * ww);
    }
  }
#pragma unroll
  for (int i = 0; i < 4; ++i) {
    int id = tid + i * 256, e = id >> 3, sc = (id & 7) * 8;
    *(uint4*)(sV + e * 72 + sc) = vreg[i];
  }
  __syncthreads();
  f32x16 acc[2][2]; zero_acc(acc);
#pragma unroll
  for (int ks = 0; ks < 4; ++ks) {
    bf16x8 af[2], bfr[2];
#pragma unroll
    for (int mi = 0; mi < 2; ++mi)
      af[mi] = *(const bf16x8*)(sK + (wm * 64 + mi * 32 + (lane & 31)) * 72 + ks * 16 + (lane >> 5) * 8);
#pragma unroll
    for (int ni = 0; ni < 2; ++ni)
      bfr[ni] = *(const bf16x8*)(sV + (wn * 32 + ni * 64 + (lane & 31)) * 72 + ks * 16 + (lane >> 5) * 8);
#pragma unroll
    for (int mi = 0; mi < 2; ++mi)
#pragma unroll
      for (int ni = 0; ni < 2; ++ni)
        acc[mi][ni] = __builtin_amdgcn_mfma_f32_32x32x16_bf16(af[mi], bfr[ni], acc[mi][ni], 0, 0, 0);
  }
  bfu* dS = ds_ptr(P, mixer, idx);
  EPI_BEGIN
#pragma unroll
    for (int ni = 0; ni < 2; ++ni) {
      int e = cl + ni * 64;
      uint2 o; o.x = pack2(acc[mi][ni][q * 4 + 0], acc[mi][ni][q * 4 + 1]); o.y = pack2(acc[mi][ni][q * 4 + 2], acc[mi][ni][q * 4 + 3]);
      *(uint2*)(dS + e * 128 + r0) = o;
    }
  EPI_END
  if (mixer == 1 && tid < 128) {
    float s = 0.f;
#pragma unroll
    for (int j = 0; j < 8; ++j) { float f[8]; unpack8(*(const uint4*)(sK + tid * 72 + j * 8), f);
#pragma unroll
      for (int k = 0; k < 8; ++k) s += f[k]; }
    ((float*)(P.ws + O_DN))[(size_t)idx * 128 + tid] = s;
  }
  __syncthreads();
}

__device__ void phase_scan(const Params& P) {
  const int gtid = blockIdx.x * NTHREADS + threadIdx.x, gstride = gridDim.x * NTHREADS;
  const float* AE = (const float*)(P.ws + O_AEND);
  for (int i = gtid; i < 131072; i += gstride) {
    int mixer = i >> 16, bh = (i >> 12) & 15, eo = (i & 4095) * 4;
    int h = bh & 3;
    float gch = __expf(ret_lg(h) * 64.f);
    float st[4];
#pragma unroll
    for (int j = 0; j < 4; ++j) st[j] = 0.f;
    bfu* base = (bfu*)P.out + ((size_t)(mixer * 2048 + bh * 128)) * 16384 + eo;
    for (int c = 0; c < 128; c += 8) {
      uint2 v[8];
#pragma unroll
      for (int k = 0; k < 8; ++k) v[k] = *(const uint2*)(base + (size_t)(c + k) * 16384);
#pragma unroll
      for (int k = 0; k < 8; ++k) {
        float dec = mixer == 0 ? gch : AE[bh * 128 + c + k];
        float d0 = bf2f(v[k].x & 0xffff), d1 = bf2f(v[k].x >> 16), d2 = bf2f(v[k].y & 0xffff), d3 = bf2f(v[k].y >> 16);
        uint2 o; o.x = pack2(st[0], st[1]); o.y = pack2(st[2], st[3]);
        *(uint2*)(base + (size_t)(c + k) * 16384) = o;
        st[0] = dec * st[0] + d0; st[1] = dec * st[1] + d1; st[2] = dec * st[2] + d2; st[3] = dec * st[3] + d3;
      }
    }
    float* o = P.out + (mixer == 0 ? OO_RETP : OO_CP) + (size_t)bh * 16384;
    int e = eo >> 7, d0i = eo & 127;
#pragma unroll
    for (int j = 0; j < 4; ++j) o[(d0i + j) * 128 + e] = st[j];
  }
  for (int i = gtid; i < 2 * 64 * 2048; i += gstride) {
    int mixer = i >> 17, bh = (i >> 11) & 63, eo = (i & 2047) * 8;
    int h = bh & 3;
    int e = eo >> 7, d0 = eo & 127;
    const float* s0 = (mixer == 0 ? P.st_ret : P.st_C) + (size_t)bh * 16384;
    float st[8];
#pragma unroll
    for (int j = 0; j < 8; ++j) st[j] = s0[(d0 + j) * 128 + e];
    bfu* p = (bfu*)(P.ws + O_DSS) + ((size_t)(mixer * 64 + bh)) * 16384 + eo;
    float d[8]; unpack8(*(const uint4*)p, d);
    *(uint4*)p = pack8(st);
    float dec = mixer == 0 ? __expf(ret_lg(h) * 32.f) : AE[2048 + bh];
    float* o = P.out + (mixer == 0 ? OO_RETS : OO_CS) + (size_t)bh * 16384;
#pragma unroll
    for (int j = 0; j < 8; ++j) o[(d0 + j) * 128 + e] = dec * st[j] + d[j];
  }
  float* DN = (float*)(P.ws + O_DN);
  for (int i = gtid; i < 16 * 128; i += gstride) {
    int bh = i >> 7, d = i & 127;
    float n = 0.f;
    for (int c = 0; c < 128; ++c) {
      size_t o = (size_t)(bh * 128 + c) * 128 + d;
      float v = DN[o]; DN[o] = n; n = AE[bh * 128 + c] * n + v;
    }
    P.out[OO_NP + i] = n;
  }
  for (int i = gtid; i < 64 * 128; i += gstride) {
    int bh = i >> 7, d = i & 127;
    size_t o = (size_t)(2048 + bh) * 128 + d;
    float n0 = P.st_n[i]; float v = DN[o]; DN[o] = n0;
    P.out[OO_NS + i] = AE[2048 + bh] * n0 + v;
  }
}

__device__ void phaseC_item(const Params& P, int mixer, int idx, char* smem) {
  const int tid = threadIdx.x, lane = tid & 63, w = tid >> 6;
  Item it = decode_item(idx);
  const int L = it.L, h = it.h;
  bfu* sQ = (bfu*)smem;
  bfu* sKV = sQ + 64 * 136;
  bfu* sP = sKV + 128 * 72;
  bfu* sS = sP + 64 * 72;
  float* sO = (float*)sS;
  float* sRow = (float*)(sS + 128 * 136);
  const bfu* Qsrc = (const bfu*)(P.ws + SLOT(mixer == 0 ? 2 : 1)) + (size_t)it.row0 * 512 + h * 128;
  const bfu* Ksrc = (const bfu*)(P.ws + SLOT(mixer == 0 ? 3 : 13)) + (size_t)it.row0 * 512 + h * 128;
  const bfu* Vsrc = (const bfu*)(P.ws + SLOT(mixer == 0 ? 4 : 7)) + it.vt_off;
  const bfu* Ssrc = ds_ptr(P, mixer, idx);
  const float lg = ret_lg(h);
  uint4 vpre[4];
#pragma unroll
  for (int i = 0; i < 4; ++i) {
    int id = tid + i * 256, e = id >> 3, sc = (id & 7) * 8;
    vpre[i] = make_uint4(0, 0, 0, 0);
    if (sc < L) vpre[i] = *(const uint4*)(Vsrc + (size_t)e * it.T + sc);
  }
#pragma unroll
  for (int i = 0; i < 4; ++i) {
    int id = tid + i * 256, s = id >> 4, dc = (id & 15) * 8;
    uint4 vq = make_uint4(0, 0, 0, 0), vk = vq;
    if (s < L) { vq = *(const uint4*)(Qsrc + (size_t)s * 512 + dc); vk = *(const uint4*)(Ksrc + (size_t)s * 512 + dc); }
    *(uint4*)(sQ + s * 136 + dc) = vq;
    *(uint4*)(sKV + s * 136 + dc) = vk;
  }
#pragma unroll
  for (int i = 0; i < 8; ++i) {
    int id = tid + i * 256, e = id >> 4, dc = (id & 15) * 8;
    *(uint4*)(sS + e * 136 + dc) = *(const uint4*)(Ssrc + e * 128 + dc);
  }
  if (tid < 64) {
    int i = tid;
    if (mixer == 0) {
      sRow[128 + i] = __expf(lg * (float)(i + 1));
    } else {
      float mc = ((const float*)(P.ws + O_MCS))[idx];
      size_t gi = (size_t)(it.row0 + i) * 4 + h;
      bool valid = i < L;
      float u = valid ? ((const float*)(P.ws + O_UQ))[gi] : -INFINITY;
      float M = valid ? fmaxf(mc, ((const float*)(P.ws + O_CMQ))[gi]) : 0.f;
      float F = valid ? ((const float*)(P.ws + O_FQ))[gi] : 0.f;
      sRow[i] = u; sRow[64 + i] = M; sRow[128 + i] = valid ? __expf(mc - M) : 0.f;
      sRow[256 + i] = __expf(-(F + M));
    }
  }
  __syncthreads();
  {
    const int mi = w & 1, ni = w >> 1;
    f32x16 acc;
#pragma unroll
    for (int i = 0; i < 16; ++i) acc[i] = 0.f;
#pragma unroll 2
    for (int ks = 0; ks < 8; ++ks) {
      bf16x8 af = *(const bf16x8*)(sQ + (mi * 32 + (lane & 31)) * 136 + ks * 16 + (lane >> 5) * 8);
      bf16x8 bfr = *(const bf16x8*)(sKV + (ni * 32 + (lane & 31)) * 136 + ks * 16 + (lane >> 5) * 8);
      acc = __builtin_amdgcn_mfma_f32_32x32x16_bf16(af, bfr, acc, 0, 0, 0);
    }
    const int s = ni * 32 + (lane & 31);
    float us = mixer ? sRow[s] : 0.f;
#pragma unroll
    for (int reg = 0; reg < 16; ++reg) {
      int i = mi * 32 + (reg & 3) + 8 * (reg >> 2) + 4 * (lane >> 5);
      float wgt;
      if (mixer == 0) wgt = (s <= i) ? __expf(lg * (float)(i - s)) : 0.f;
      else wgt = (s <= i && i < L) ? __expf(us - sRow[64 + i]) : 0.f;
      sP[i * 72 + s] = f2bf(acc[reg] * wgt);
    }
  }
  __syncthreads();
#pragma unroll
  for (int i = 0; i < 4; ++i) {
    int id = tid + i * 256, e = id >> 3, sc = (id & 7) * 8;
    *(uint4*)(sKV + e * 72 + sc) = vpre[i];
  }
  __syncthreads();
  f32x16 acc1[2], acc2[2];
  const int mi = w & 1, nj = w >> 1;
#pragma unroll
  for (int t = 0; t < 2; ++t)
#pragma unroll
    for (int i = 0; i < 16; ++i) { acc1[t][i] = 0.f; acc2[t][i] = 0.f; }
#pragma unroll 2
  for (int ks = 0; ks < 4; ++ks) {
    bf16x8 af = *(const bf16x8*)(sP + (mi * 32 + (lane & 31)) * 72 + ks * 16 + (lane >> 5) * 8);
#pragma unroll
    for (int t = 0; t < 2; ++t) {
      bf16x8 bfr = *(const bf16x8*)(sKV + (nj * 64 + t * 32 + (lane & 31)) * 72 + ks * 16 + (lane >> 5) * 8);
      acc1[t] = __builtin_amdgcn_mfma_f32_32x32x16_bf16(af, bfr, acc1[t], 0, 0, 0);
    }
  }
#pragma unroll 2
  for (int ks = 0; ks < 8; ++ks) {
    bf16x8 af = *(const bf16x8*)(sQ + (mi * 32 + (lane & 31)) * 136 + ks * 16 + (lane >> 5) * 8);
#pragma unroll
    for (int t = 0; t < 2; ++t) {
      bf16x8 bfr = *(const bf16x8*)(sS + (nj * 64 + t * 32 + (lane & 31)) * 136 + ks * 16 + (lane >> 5) * 8);
      acc2[t] = __builtin_amdgcn_mfma_f32_32x32x16_bf16(af, bfr, acc2[t], 0, 0, 0);
    }
  }
  if (mixer == 1) {
    int i = tid >> 2, part = tid & 3;
    const float* nprev = (const float*)(P.ws + O_DN) + (size_t)idx * 128;
    float dl = 0.f, qn = 0.f;
#pragma unroll 4
    for (int s = part * 16; s < part * 16 + 16; ++s) dl += bf2f(sP[i * 72 + s]);
#pragma unroll 4
    for (int d = part * 32; d < part * 32 + 32; ++d) qn += bf2f(sQ[i * 136 + d]) * nprev[d];
    dl += __shfl_xor(dl, 1); dl += __shfl_xor(dl, 2);
    qn += __shfl_xor(qn, 1); qn += __shfl_xor(qn, 2);
    if (part == 0) {
      float den = dl + sRow[128 + i] * qn;
      sRow[192 + i] = 1.f / fmaxf(fabsf(den), sRow[256 + i]);
    }
  }
  __syncthreads();
#pragma unroll
  for (int t = 0; t < 2; ++t) {
    int e = nj * 64 + t * 32 + (lane & 31);
#pragma unroll
    for (int reg = 0; reg < 16; ++reg) {
      int i = mi * 32 + (reg & 3) + 8 * (reg >> 2) + 4 * (lane >> 5);
      float o = acc1[t][reg] + sRow[128 + i] * acc2[t][reg];
      if (mixer == 1) o *= sRow[192 + i];
      sO[i * 132 + e] = o;
    }
  }
  __syncthreads();
  {
    int i = tid >> 2, part = tid & 3;
    float ss = 0.f;
#pragma unroll 4
    for (int e = part * 32; e < part * 32 + 32; ++e) { float v = sO[i * 132 + e]; ss += v * v; }
    ss += __shfl_xor(ss, 1); ss += __shfl_xor(ss, 2);
    float rstd = rsqrtf(ss * (1.f / 128.f) + EPS);
    if (i < L) {
      size_t ro = (size_t)(it.row0 + i) * 512 + h * 128 + part * 32;
      const float* so = sO + i * 132 + part * 32;
      if (mixer == 0) {
        bfu* y = (bfu*)(P.ws + SLOT(5)) + ro;
        const float* g = P.g_ret_gn + h * 128 + part * 32;
        uint4 gv[4];
#pragma unroll
        for (int k = 0; k < 4; ++k) gv[k] = *(const uint4*)(y + k * 8);
#pragma unroll
        for (int k = 0; k < 4; ++k) {
          float gt[8], o[8];
          unpack8(gv[k], gt);
#pragma unroll
          for (int j = 0; j < 8; ++j) o[j] = gt[j] * sigmoidf_(gt[j]) * so[k * 8 + j] * rstd * g[k * 8 + j];
          *(uint4*)(y + k * 8) = pack8(o);
        }
      } else {
        bfu* y = (bfu*)(P.ws + SLOT(8)) + ro;
        const bfu* cc = (const bfu*)(P.ws + SLOT(0)) + ro;
        const float* g = P.g_ml_gn + h * 128 + part * 32;
        const float* ws = P.w_skip + h * 128 + part * 32;
        uint4 gv[4], cv[4];
#pragma unroll
        for (int k = 0; k < 4; ++k) { gv[k] = *(const uint4*)(y + k * 8); cv[k] = *(const uint4*)(cc + k * 8); }
#pragma unroll
        for (int k = 0; k < 4; ++k) {
          float gt[8], c8[8], o[8];
          unpack8(gv[k], gt); unpack8(cv[k], c8);
#pragma unroll
          for (int j = 0; j < 8; ++j) o[j] = sigmoidf_(gt[j]) * (so[k * 8 + j] * rstd * g[k * 8 + j] + ws[k * 8 + j] * c8[j]);
          *(uint4*)(y + k * 8) = pack8(o);
        }
      }
    }
  }
  __syncthreads();
}

__device__ void phase_merge(const Params& P, char* smem) {
  bfu* sA = (bfu*)smem; bfu* sB = sA + 128 * 72;
  const bfu* yr = (const bfu*)(P.ws + SLOT(5)); const bfu* ym = (const bfu*)(P.ws + SLOT(8));
  const bfu* gr = (const bfu*)(P.ws + SLOT(9)); const bfu* gm = (const bfu*)(P.ws + SLOT(11));
  bfu* mg = (bfu*)(P.ws + SLOT(6));
  for (int t = blockIdx.x; t < 260 * 8; t += gridDim.x) {
    int mt, nt; tile_map(t, 260, 8, mt, nt);
    f32x16 acc[2][2]; zero_acc(acc);
    bfu* sT = (bfu*)smem;
    const size_t tbase = (size_t)mt * 128 * 1024 + nt * 128;
    uint4 t1[8];
    gemm_acc(acc, yr + (size_t)mt * 128 * 512, 512, (const bfu*)(P.ws + O_WT_UPR) + (size_t)nt * 128 * 512, 512, 512, sA, sB);
    __syncthreads();
    stage_rm(sT, acc, 1.f);
    __syncthreads();
#pragma unroll
    for (int i = 0; i < 8; ++i) {
      int id = threadIdx.x + i * 256, row = id >> 4, c8 = (id & 15) * 8;
      float a[8], g[8];
      unpack8(*(const uint4*)(sT + row * ST_LD + c8), a);
      unpack8(*(const uint4*)(gr + tbase + (size_t)row * 1024 + c8), g);
#pragma unroll
      for (int j = 0; j < 8; ++j) a[j] *= sigmoidf_(g[j]);
      t1[i] = pack8(a);
    }
    zero_acc(acc);
    gemm_acc(acc, ym + (size_t)mt * 128 * 512, 512, (const bfu*)(P.ws + O_WT_UPM) + (size_t)nt * 128 * 512, 512, 512, sA, sB);
    __syncthreads();
    stage_rm(sT, acc, 1.f);
    __syncthreads();
#pragma unroll
    for (int i = 0; i < 8; ++i) {
      int id = threadIdx.x + i * 256, row = id >> 4, c8 = (id & 15) * 8;
      float a[8], g[8], t[8];
      unpack8(*(const uint4*)(sT + row * ST_LD + c8), a);
      unpack8(*(const uint4*)(gm + tbase + (size_t)row * 1024 + c8), g);
      unpack8(t1[i], t);
#pragma unroll
      for (int j = 0; j < 8; ++j) a[j] = t[j] + a[j] * sigmoidf_(g[j]);
      *(uint4*)(mg + tbase + (size_t)row * 1024 + c8) = pack8(a);
    }
  }
}

__device__ void phase_outproj(const Params& P, char* smem) {
  bfu* sA = (bfu*)smem; bfu* sB = sA + 128 * 72;
  const bfu* mg = (const bfu*)(P.ws + SLOT(6));
  for (int t = blockIdx.x; t < 260 * 8; t += gridDim.x) {
    int mt, nt; tile_map(t, 260, 8, mt, nt);
    f32x16 acc[2][2]; zero_acc(acc);
    gemm_acc(acc, mg + (size_t)mt * 128 * 1024, 1024, (const bfu*)(P.ws + O_WT_OUT) + (size_t)nt * 128 * 1024, 1024, 1024, sA, sB);
    float* sT32 = (float*)smem;
    __syncthreads();
    {
      EPI_BEGIN
#pragma unroll
        for (int j = 0; j < 4; ++j) {
          sT32[(r0 + j) * ST32_LD + cl] = acc[mi][0][q * 4 + j];
          sT32[(r0 + j) * ST32_LD + cl + 64] = acc[mi][1][q * 4 + j];
        }
      EPI_END
    }
    __syncthreads();
#pragma unroll
    for (int i = 0; i < 16; ++i) {
      int id = threadIdx.x + i * 256, row = id >> 5, c4 = (id & 31) * 4;
      int r = mt * 128 + row;
      float4 a = *(const float4*)(sT32 + row * ST32_LD + c4);
      float4 x = *(const float4*)(xrow(P, r) + nt * 128 + c4);
      *(float4*)(P.out + (size_t)r * 1024 + nt * 128 + c4) = make_float4(x.x + a.x, x.y + a.y, x.z + a.z, x.w + a.w);
    }
  }
}

__device__ void phase_norm_rows(const Params& P, const float* g, bfu* dst) {
  const int lane = threadIdx.x & 63, w = threadIdx.x >> 6;
  for (int r = blockIdx.x * 4 + w; r < MT; r += gridDim.x * 4) {
    const float* xr = P.out + (size_t)r * 1024;
    float4 v[4]; float ss = 0.f;
#pragma unroll
    for (int i = 0; i < 4; ++i) {
      v[i] = *(const float4*)(xr + i * 256 + lane * 4);
      ss += v[i].x * v[i].x + v[i].y * v[i].y + v[i].z * v[i].z + v[i].w * v[i].w;
    }
    ss = wave_sum(ss);
    float rstd = rsqrtf(ss * (1.f / 1024.f) + EPS);
#pragma unroll
    for (int i = 0; i < 4; ++i) {
      float4 gg = *(const float4*)(g + i * 256 + lane * 4);
      uint2 o; o.x = pack2(v[i].x * rstd * gg.x, v[i].y * rstd * gg.y); o.y = pack2(v[i].z * rstd * gg.z, v[i].w * rstd * gg.w);
      *(uint2*)(dst + (size_t)r * 1024 + i * 256 + lane * 4) = o;
    }
  }
}

__device__ void phase_pq(const Params& P, char* smem) {
  bfu* sA = (bfu*)smem; bfu* sB = sA + 128 * 72;
  const bfu* hq = (const bfu*)(P.ws + SLOT(0));
  bfu* qb = (bfu*)(P.ws + SLOT(9));
  for (int t = blockIdx.x; t < 260 * 16; t += gridDim.x) {
    int mt, nt; tile_map(t, 260, 16, mt, nt);
    f32x16 acc[2][2]; zero_acc(acc);
    gemm_acc(acc, hq + (size_t)mt * 128 * 1024, 1024, (const bfu*)(P.ws + O_WT_PQ) + (size_t)nt * 128 * 1024, 1024, 1024, sA, sB);
    bfu* sT = (bfu*)smem;
    __syncthreads();
    stage_rm(sT, acc, 1.f);
    __syncthreads();
    copyout_bf16(sT, qb + (size_t)mt * 128 * 2048 + nt * 128, 2048);
  }
}

__device__ __forceinline__ float pair_max(float v) {
  auto r = __builtin_amdgcn_permlane32_swap(__float_as_int(v), __float_as_int(v), false, false);
  return fmaxf(__int_as_float(r[0]), __int_as_float(r[1]));
}
__device__ void phase_topk(const Params& P, char* smem) {
  const int tid = threadIdx.x, lane = tid & 63, w = tid >> 6, r32 = lane & 31, hh = lane >> 5;
  unsigned* sL = (unsigned*)smem + w * 1664;
  unsigned* sW = sL + 32 * 33;
  const bfu* qb = (const bfu*)(P.ws + SLOT(9));
  const bfu* keys = (const bfu*)(P.ws + O_KEYS);
  int* ids = (int*)(P.ws + SLOT(4));
  float* gw = (float*)(P.ws + SLOT(13));
  for (int item = blockIdx.x * 4 + w; item < 1040 * 8; item += gridDim.x * 4) {
    const int tg = item >> 3, n = item & 7, rowb = tg * 32;
#pragma unroll 1
    for (int half = 0; half < 2; ++half) {
      f32x16 acc[4];
#pragma unroll
      for (int c = 0; c < 4; ++c)
#pragma unroll
        for (int i = 0; i < 16; ++i) acc[c][i] = 0.f;
      const bfu* kp = keys + (size_t)((n * 2 + half) * 128 + r32) * 128 + hh * 8;
      const bfu* qp = qb + (size_t)(rowb + r32) * 2048 + n * 256 + half * 128 + hh * 8;
#pragma unroll
      for (int ks = 0; ks < 8; ++ks) {
        bf16x8 bfr = *(const bf16x8*)(qp + ks * 16);
#pragma unroll
        for (int c = 0; c < 4; ++c) {
          bf16x8 af = *(const bf16x8*)(kp + (size_t)c * 32 * 128 + ks * 16);
          acc[c] = __builtin_amdgcn_mfma_f32_32x32x16_bf16(af, bfr, acc[c], 0, 0, 0);
        }
      }
      float kk[64];
#pragma unroll
      for (int c = 0; c < 4; ++c)
#pragma unroll
        for (int reg = 0; reg < 16; ++reg) {
          unsigned kidx = c * 32 + (reg & 3) + 8 * (reg >> 2) + 4 * hh;
          kk[c * 16 + reg] = __uint_as_float((__float_as_uint(acc[c][reg]) & ~127u) | kidx);
        }
      float prev = INFINITY;
#pragma unroll 1
      for (int p = 0; p < 16; ++p) {
        float cur = -INFINITY;
#pragma unroll
        for (int t = 0; t < 64; ++t) cur = fmaxf(cur, kk[t] < prev ? kk[t] : -INFINITY);
        cur = pair_max(cur);
        if (hh == 0) sL[r32 * 33 + half * 16 + p] = __float_as_uint(cur);
        prev = cur;
      }
    }
    __builtin_amdgcn_fence(__ATOMIC_RELEASE, "workgroup");
    __builtin_amdgcn_wave_barrier();
    __builtin_amdgcn_fence(__ATOMIC_ACQUIRE, "workgroup");
    float x[4], y[16];
    {
      const unsigned* lx = sL + r32 * 33 + (hh ? 16 : 0);
      const unsigned* ly = sL + r32 * 33 + (hh ? 0 : 16);
#pragma unroll
      for (int i = 0; i < 4; ++i) x[i] = __uint_as_float(lx[i] & ~127u);
#pragma unroll
      for (int j = 0; j < 16; ++j) y[j] = __uint_as_float(ly[j] & ~127u);
    }
    float cd[25];
#define CAND(t, i, j) { float sv = x[i] + y[j]; unsigned code = hh ? ((j) << 4 | (i)) : ((i) << 4 | (j)); \
      cd[t] = __uint_as_float((__float_as_uint(sv) & ~255u) | code); }
    CAND(0, 0, 1) CAND(1, 0, 2) CAND(2, 0, 3) CAND(3, 0, 4) CAND(4, 0, 5) CAND(5, 0, 6) CAND(6, 0, 7) CAND(7, 0, 8)
    CAND(8, 0, 9) CAND(9, 0, 10) CAND(10, 0, 11) CAND(11, 0, 12) CAND(12, 0, 13) CAND(13, 0, 14) CAND(14, 0, 15)
    CAND(15, 1, 2) CAND(16, 1, 3) CAND(17, 1, 4) CAND(18, 1, 5) CAND(19, 1, 6) CAND(20, 1, 7) CAND(21, 2, 3) CAND(22, 2, 4)
    {
      float d0 = hh ? x[2] + y[2] : x[0] + y[0];
      float d1 = hh ? x[3] + y[3] : x[1] + y[1];
      unsigned c0 = hh ? 0x22u : 0x00u, c1 = hh ? 0x33u : 0x11u;
      cd[23] = __uint_as_float((__float_as_uint(d0) & ~255u) | c0);
      cd[24] = __uint_as_float((__float_as_uint(d1) & ~255u) | c1);
    }
    {
      float prev = INFINITY;
#pragma unroll 1
      for (int p = 0; p < 16; ++p) {
        float cur = -INFINITY;
#pragma unroll
        for (int t = 0; t < 25; ++t) cur = fmaxf(cur, cd[t] < prev ? cd[t] : -INFINITY);
        cur = pair_max(cur);
        if (hh == 0) sW[r32 * 17 + p] = __float_as_uint(cur);
        prev = cur;
      }
    }
    __builtin_amdgcn_fence(__ATOMIC_RELEASE, "workgroup");
    __builtin_amdgcn_wave_barrier();
    __builtin_amdgcn_fence(__ATOMIC_ACQUIRE, "workgroup");
    {
      const unsigned* la = sL + r32 * 33;
      unsigned c0 = sW[r32 * 17] & 255u;
      float scmax = __uint_as_float(la[c0 >> 4] & ~127u) + __uint_as_float(la[16 + (c0 & 15)] & ~127u);
      float ex[8]; int ee[8]; float sum = 0.f;
#pragma unroll
      for (int k = 0; k < 8; ++k) {
        unsigned code = sW[r32 * 17 + hh * 8 + k] & 255u;
        unsigned ka = la[code >> 4], kb = la[16 + (code & 15)];
        float sc = __uint_as_float(ka & ~127u) + __uint_as_float(kb & ~127u);
        ex[k] = __expf(sc - scmax);
        ee[k] = (int)((ka & 127u) * 128u + (kb & 127u));
        sum += ex[k];
      }
      sum += __shfl_xor(sum, 32);
      float inv = 1.f / sum;
      size_t o = (size_t)(rowb + r32) * 128 + n * 16 + hh * 8;
      *(int4*)(ids + o) = make_int4(ee[0], ee[1], ee[2], ee[3]);
      *(int4*)(ids + o + 4) = make_int4(ee[4], ee[5], ee[6], ee[7]);
      *(float4*)(gw + o) = make_float4(ex[0] * inv, ex[1] * inv, ex[2] * inv, ex[3] * inv);
      *(float4*)(gw + o + 4) = make_float4(ex[4] * inv, ex[5] * inv, ex[6] * inv, ex[7] * inv);
    }
    __builtin_amdgcn_wave_barrier();
  }
}

typedef float f2v __attribute__((ext_vector_type(2)));
#define U8_SCALE 512.f
#define V8_SCALE 128.f
__device__ void convert_fp8(const float* __restrict__ src, unsigned char* __restrict__ dst, size_t n16, float scale,
                            int gtid, int gstride) {
  for (size_t i = gtid; i < n16; i += gstride) {
    unsigned w[4];
#pragma unroll
    for (int k = 0; k < 4; ++k) {
      float4 a = *(const float4*)(src + i * 16 + k * 4);
      float v0 = fminf(fmaxf(a.x * scale, -448.f), 448.f), v1 = fminf(fmaxf(a.y * scale, -448.f), 448.f);
      float v2 = fminf(fmaxf(a.z * scale, -448.f), 448.f), v3 = fminf(fmaxf(a.w * scale, -448.f), 448.f);
      int t = 0;
      t = __builtin_amdgcn_cvt_pk_fp8_f32(v0, v1, t, false);
      t = __builtin_amdgcn_cvt_pk_fp8_f32(v2, v3, t, true);
      w[k] = (unsigned)t;
    }
    *(uint4*)(dst + i * 16) = make_uint4(w[0], w[1], w[2], w[3]);
  }
}
__device__ __forceinline__ float dot16_fp8(uint4 u, const f2v* x2) {
  f2v acc = __builtin_amdgcn_cvt_pk_f32_fp8((int)u.x, false) * x2[0];
  acc += __builtin_amdgcn_cvt_pk_f32_fp8((int)u.x, true) * x2[1];
  acc += __builtin_amdgcn_cvt_pk_f32_fp8((int)u.y, false) * x2[2];
  acc += __builtin_amdgcn_cvt_pk_f32_fp8((int)u.y, true) * x2[3];
  acc += __builtin_amdgcn_cvt_pk_f32_fp8((int)u.z, false) * x2[4];
  acc += __builtin_amdgcn_cvt_pk_f32_fp8((int)u.z, true) * x2[5];
  acc += __builtin_amdgcn_cvt_pk_f32_fp8((int)u.w, false) * x2[6];
  acc += __builtin_amdgcn_cvt_pk_f32_fp8((int)u.w, true) * x2[7];
  return acc.x + acc.y;
}
__device__ __forceinline__ void axpy16_fp8(f2v* o2, float cf, uint4 v) {
  f2v c = {cf, cf};
  o2[0] += c * __builtin_amdgcn_cvt_pk_f32_fp8((int)v.x, false);
  o2[1] += c * __builtin_amdgcn_cvt_pk_f32_fp8((int)v.x, true);
  o2[2] += c * __builtin_amdgcn_cvt_pk_f32_fp8((int)v.y, false);
  o2[3] += c * __builtin_amdgcn_cvt_pk_f32_fp8((int)v.y, true);
  o2[4] += c * __builtin_amdgcn_cvt_pk_f32_fp8((int)v.z, false);
  o2[5] += c * __builtin_amdgcn_cvt_pk_f32_fp8((int)v.z, true);
  o2[6] += c * __builtin_amdgcn_cvt_pk_f32_fp8((int)v.w, false);
  o2[7] += c * __builtin_amdgcn_cvt_pk_f32_fp8((int)v.w, true);
}
#define PEER_LOAD(u, v, b)                                                                   \
  _Pragma("unroll") for (int k = 0; k < 8; ++k) {                                            \
    int j = (b) * 8 + k;                                                                     \
    int e = __builtin_amdgcn_readlane((b) < 8 ? id0 : id1, j & 63);                          \
    u[k] = *(const uint4*)(U8 + (size_t)e * 1024 + lane * 16);                               \
    v[k] = *(const uint4*)(V8 + (size_t)e * 1024 + lane * 16);                               \
  }
#define PEER_COMP(u, v, b)                                                                   \
  _Pragma("unroll") for (int hf = 0; hf < 2; ++hf) {                                         \
    float s = reduce4(dot16_fp8(u[hf * 4 + 0], x2), dot16_fp8(u[hf * 4 + 1], x2),           \
                      dot16_fp8(u[hf * 4 + 2], x2), dot16_fp8(u[hf * 4 + 3], x2)) * (1.f / U8_SCALE); \
    float act = 0.5f * s * (1.f + erff(s * 0.7071067811865475f));                            \
    float gsel = __shfl((b) < 8 ? g0 : g1, ((b) * 8 + hf * 4 + (lane >> 4)) & 63);           \
    float cfv = act * gsel * (1.f / V8_SCALE);                                               \
    axpy16_fp8(o2, __int_as_float(__builtin_amdgcn_readlane(__float_as_int(cfv), 0)), v[hf * 4 + 0]);  \
    axpy16_fp8(o2, __int_as_float(__builtin_amdgcn_readlane(__float_as_int(cfv), 16)), v[hf * 4 + 1]); \
    axpy16_fp8(o2, __int_as_float(__builtin_amdgcn_readlane(__float_as_int(cfv), 32)), v[hf * 4 + 2]); \
    axpy16_fp8(o2, __int_as_float(__builtin_amdgcn_readlane(__float_as_int(cfv), 48)), v[hf * 4 + 3]); \
  }
__device__ void phase_peer(const Params& P) {
  const int lane = threadIdx.x & 63, w = threadIdx.x >> 6;
  bfu* hq = (bfu*)(P.ws + SLOT(0));
  const unsigned char* U8 = (const unsigned char*)(P.ws + SLOT(2));
  const unsigned char* V8 = (const unsigned char*)(P.ws + SLOT(3));
  const int* ids = (const int*)(P.ws + SLOT(4));
  const float* gw = (const float*)(P.ws + SLOT(13));
  bfu* pbf = (bfu*)(P.ws + SLOT(6));
  for (int r = blockIdx.x * 4 + w; r < MT; r += gridDim.x * 4) {
    f2v x2[8], o2[8];
    {
      uint4 v0 = *(const uint4*)(hq + (size_t)r * 1024 + lane * 16);
      uint4 v1 = *(const uint4*)(hq + (size_t)r * 1024 + lane * 16 + 8);
      float xf[16];
      unpack8(v0, xf); unpack8(v1, xf + 8);
#pragma unroll
      for (int j = 0; j < 8; ++j) { x2[j].x = xf[2 * j]; x2[j].y = xf[2 * j + 1]; o2[j].x = 0.f; o2[j].y = 0.f; }
    }
    int id0 = ids[(size_t)r * 128 + lane], id1 = ids[(size_t)r * 128 + 64 + lane];
    float g0 = gw[(size_t)r * 128 + lane], g1 = gw[(size_t)r * 128 + 64 + lane];
    uint4 uA[8], vA[8], uB[8], vB[8];
    PEER_LOAD(uA, vA, 0)
    for (int b = 0; b < 16; b += 2) {
      PEER_LOAD(uB, vB, b + 1)
      PEER_COMP(uA, vA, b)
      if (b + 2 < 16) { PEER_LOAD(uA, vA, b + 2) }
      PEER_COMP(uB, vB, b + 1)
    }
    float* xr = P.out + (size_t)r * 1024 + lane * 16;
    float x3[16];
    float ss = 0.f;
#pragma unroll
    for (int k = 0; k < 4; ++k) {
      float4 a = *(const float4*)(xr + k * 4);
      x3[k * 4 + 0] = a.x + o2[k * 2].x; x3[k * 4 + 1] = a.y + o2[k * 2].y;
      x3[k * 4 + 2] = a.z + o2[k * 2 + 1].x; x3[k * 4 + 3] = a.w + o2[k * 2 + 1].y;
      *(float4*)(xr + k * 4) = make_float4(x3[k * 4], x3[k * 4 + 1], x3[k * 4 + 2], x3[k * 4 + 3]);
    }
#pragma unroll
    for (int j = 0; j < 16; ++j) ss += x3[j] * x3[j];
    ss = wave_sum(ss);
    float rstd = rsqrtf(ss * (1.f / 1024.f) + EPS);
    float hv[16];
#pragma unroll
    for (int k = 0; k < 4; ++k) {
      float4 ga = *(const float4*)(P.g_ple + lane * 16 + k * 4);
      hv[k * 4] = x3[k * 4] * rstd * ga.x; hv[k * 4 + 1] = x3[k * 4 + 1] * rstd * ga.y;
      hv[k * 4 + 2] = x3[k * 4 + 2] * rstd * ga.z; hv[k * 4 + 3] = x3[k * 4 + 3] * rstd * ga.w;
    }
    *(uint4*)(hq + (size_t)r * 1024 + lane * 16) = pack8(hv);
    *(uint4*)(hq + (size_t)r * 1024 + lane * 16 + 8) = pack8(hv + 8);
    {
      const float* pr = r < MP ? P.pp + (size_t)r * 256 : P.ps + (size_t)(r - MP) * 256;
      float4 a = *(const float4*)(pr + lane * 4);
      uint2 ov; ov.x = pack2(a.x, a.y); ov.y = pack2(a.z, a.w);
      *(uint2*)(pbf + (size_t)r * 256 + lane * 4) = ov;
    }
  }
}

__device__ void phase_ple(const Params& P, char* smem) {
  bfu* sA = (bfu*)smem; bfu* sB = sA + 128 * 72;
  const bfu* hg = (const bfu*)(P.ws + SLOT(0));
  const bfu* pbf = (const bfu*)(P.ws + SLOT(6));
  for (int t = blockIdx.x; t < 260 * 8; t += gridDim.x) {
    int mt, nt; tile_map(t, 260, 8, mt, nt);
    f32x16 acc[2][2]; zero_acc(acc);
    bfu* sT = (bfu*)smem; float* sT32 = (float*)smem;
    uint2 pg[16];
    gemm_acc(acc, hg + (size_t)mt * 128 * 1024, 1024, (const bfu*)(P.ws + O_WT_PG) + (size_t)nt * 128 * 1024, 1024, 1024, sA, sB);
    __syncthreads();
    {
      EPI_BEGIN
#pragma unroll
        for (int j = 0; j < 4; ++j) {
          sT[(r0 + j) * ST_LD + cl] = f2bf(sigmoidf_(acc[mi][0][q * 4 + j]));
          sT[(r0 + j) * ST_LD + cl + 64] = f2bf(sigmoidf_(acc[mi][1][q * 4 + j]));
        }
      EPI_END
    }
    __syncthreads();
#pragma unroll
    for (int i = 0; i < 16; ++i) {
      int id = threadIdx.x + i * 256, row = id >> 5, c4 = (id & 31) * 4;
      pg[i] = *(const uint2*)(sT + row * ST_LD + c4);
    }
    zero_acc(acc);
    gemm_acc(acc, pbf + (size_t)mt * 128 * 256, 256, (const bfu*)(P.ws + O_WT_PLE) + (size_t)nt * 128 * 256, 256, 256, sA, sB);
    __syncthreads();
    {
      EPI_BEGIN
#pragma unroll
        for (int j = 0; j < 4; ++j) {
          sT32[(r0 + j) * ST32_LD + cl] = acc[mi][0][q * 4 + j];
          sT32[(r0 + j) * ST32_LD + cl + 64] = acc[mi][1][q * 4 + j];
        }
      EPI_END
    }
    __syncthreads();
#pragma unroll
    for (int i = 0; i < 16; ++i) {
      int id = threadIdx.x + i * 256, row = id >> 5, c4 = (id & 31) * 4;
      float4 a = *(const float4*)(sT32 + row * ST32_LD + c4);
      float* op = P.out + (size_t)(mt * 128 + row) * 1024 + nt * 128 + c4;
      float4 x = *(const float4*)op;
      float g0 = bf2f(pg[i].x & 0xffff), g1 = bf2f(pg[i].x >> 16), g2 = bf2f(pg[i].y & 0xffff), g3 = bf2f(pg[i].y >> 16);
      *(float4*)op = make_float4(x.x + a.x * g0, x.y + a.y * g1, x.z + a.z * g2, x.w + a.w * g3);
    }
  }
}

__device__ void phase_final(const Params& P) {
  const int lane = threadIdx.x & 63, w = threadIdx.x >> 6;
  for (int r = blockIdx.x * 4 + w; r < MT; r += gridDim.x * 4) {
    float* xr = P.out + (size_t)r * 1024;
    float4 v[4]; float ss = 0.f;
#pragma unroll
    for (int i = 0; i < 4; ++i) {
      v[i] = *(const float4*)(xr + i * 256 + lane * 4);
      ss += v[i].x * v[i].x + v[i].y * v[i].y + v[i].z * v[i].z + v[i].w * v[i].w;
    }
    ss = wave_sum(ss);
    float rstd = rsqrtf(ss * (1.f / 1024.f) + EPS);
#pragma unroll
    for (int i = 0; i < 4; ++i) {
      float4 gg = *(const float4*)(P.g_final + i * 256 + lane * 4);
      *(float4*)(xr + i * 256 + lane * 4) = make_float4(v[i].x * rstd * gg.x, v[i].y * rstd * gg.y, v[i].z * rstd * gg.z, v[i].w * rstd * gg.w);
    }
  }
}

__global__ void __launch_bounds__(NTHREADS, 2) fwd_megakernel(Params P) {
  extern __shared__ __attribute__((aligned(16))) char smem[];
  cg::grid_group grid = cg::this_grid();
  __shared__ uint4 xb_words;
  if (threadIdx.x == 0) xb_words = make_uint4(0u, 0u, 0u, 0u);
  __syncthreads();
  XcdBarrier xb = xcd_barrier_post((unsigned*)(P.ws + O_BAR), (volatile LAS unsigned*)&xb_words);
  if (P.out == nullptr) grid.sync();
  const int gtid = blockIdx.x * NTHREADS + threadIdx.x, gstride = gridDim.x * NTHREADS;
  phase_prep(P, smem);
  xcd_barrier(xb);
  phase_gemm1(P, smem);
  xcd_barrier(xb);
  phase_conv(P);
  gate_scan(P);
  xcd_barrier(xb);
  m_fold(P);
  phase_mqk(P, smem);
  xcd_barrier(xb);
  for (int t = blockIdx.x; t < 4224; t += gridDim.x) phaseA_item(P, t / 2112, t % 2112, smem);
  xcd_barrier(xb);
  phase_scan(P);
  xcd_barrier(xb);
  for (int t = blockIdx.x; t < 4224; t += gridDim.x) phaseC_item(P, t / 2112, t % 2112, smem);
  xcd_barrier(xb);
  phase_merge(P, smem);
  xcd_barrier(xb);
  phase_outproj(P, smem);
  xcd_barrier(xb);
  phase_norm_rows(P, P.g_ffn, (bfu*)(P.ws + SLOT(0)));
  convert_fp8(P.peer_u, (unsigned char*)(P.ws + SLOT(2)), 16384ull * 1024 / 16, U8_SCALE, gtid, gstride);
  convert_fp8(P.peer_v, (unsigned char*)(P.ws + SLOT(3)), 16384ull * 1024 / 16, V8_SCALE, gtid, gstride);
  xcd_barrier(xb);
  phase_pq(P, smem);
  xcd_barrier(xb);
  phase_topk(P, smem);
  xcd_barrier(xb);
  phase_peer(P);
  xcd_barrier(xb);
  phase_ple(P, smem);
  xcd_barrier(xb);
  phase_final(P);
}

extern "C" void kernel_launch(void* const* d_in, const int* in_sizes, int n_in, void* d_out, int out_size,
                              void* d_ws, size_t ws_size, hipStream_t stream) {
  static int grid_blocks = 0;
  if (!grid_blocks) {
    hipFuncSetAttribute((const void*)fwd_megakernel, hipFuncAttributeMaxDynamicSharedMemorySize, SMEM_BYTES);
    int dev = 0, cus = 0, per_cu = 0;
    hipGetDevice(&dev);
    hipDeviceGetAttribute(&cus, hipDeviceAttributeMultiprocessorCount, dev);
    hipOccupancyMaxActiveBlocksPerMultiprocessor(&per_cu, fwd_megakernel, NTHREADS, SMEM_BYTES);
    if (per_cu > 2) per_cu = 2;
    if (per_cu < 1) per_cu = 1;
    grid_blocks = cus * per_cu;
  }
  Params p{};
  const float** pf = (const float**)&p;
  for (int i = 0; i < 32; ++i) pf[i] = (const float*)d_in[i];
  p.out = (float*)d_out;
  p.ws = (char*)d_ws;
  hipMemsetAsync((char*)d_ws + O_BAR, 0, XCD_BAR_WORDS * 4, stream);
  void* args[] = {&p};
  hipError_t e = hipLaunchCooperativeKernel((void*)fwd_megakernel, dim3(grid_blocks), dim3(NTHREADS), args, SMEM_BYTES, stream);
  if (e != hipSuccess) fprintf(stderr, "cooperative launch failed: %s (grid %d)\n", hipGetErrorString(e), grid_blocks);
}
```

```cpp
#include <hip/hip_runtime.h>
#include <hip/hip_cooperative_groups.h>
#include <cstdio>
namespace cg = cooperative_groups;

typedef unsigned short bfu;
typedef __attribute__((ext_vector_type(8))) short bf16x8;
typedef __attribute__((ext_vector_type(16))) float f32x16;

#define MT 33280
#define MP 32768
#define NTHREADS 256
#define EPS 1e-6f

struct Params {
  const float *xp, *xs, *pp, *ps, *st_ret, *st_C, *st_n, *st_m, *st_conv, *g_mix, *w_in, *g_ret_gn, *w_mq,
      *w_mk, *conv_w, *conv_b, *b_i, *b_f, *g_ml_gn, *w_skip, *w_up_r, *w_up_m, *w_out, *g_ffn, *w_pq,
      *peer_keys, *peer_u, *peer_v, *g_ple, *w_pg, *w_ple, *g_final;
  float* out;
  char* ws;
};

constexpr size_t O_WT_IN = 0;
constexpr size_t O_WT_UPR = O_WT_IN + 5632ull * 1024 * 2;
constexpr size_t O_WT_UPM = O_WT_UPR + 1024ull * 512 * 2;
constexpr size_t O_WT_OUT = O_WT_UPM + 1024ull * 512 * 2;
constexpr size_t O_WT_PQ = O_WT_OUT + 1024ull * 1024 * 2;
constexpr size_t O_WT_PG = O_WT_PQ + 2048ull * 1024 * 2;
constexpr size_t O_WT_PLE = O_WT_PG + 1024ull * 1024 * 2;
constexpr size_t O_KEYS = O_WT_PLE + 1024ull * 256 * 2;
constexpr size_t O_WT_MQ = O_KEYS + 16ull * 128 * 128 * 2;
constexpr size_t O_WT_MK = O_WT_MQ + 4ull * 128 * 128 * 2;
constexpr size_t O_COS = O_WT_MK + 4ull * 128 * 128 * 2;
constexpr size_t O_SIN = O_COS + 8192ull * 64 * 4;
constexpr size_t O_FQ = O_SIN + 8192ull * 64 * 4;
constexpr size_t O_UQ = O_FQ + (size_t)MT * 16;
constexpr size_t O_CMQ = O_UQ + (size_t)MT * 16;
constexpr size_t O_FL = O_CMQ + (size_t)MT * 16;
constexpr size_t O_UC = O_FL + 16384;
constexpr size_t O_AEND = O_UC + 16384;
constexpr size_t O_MCS = O_AEND + 16384;
constexpr size_t O_DN = O_MCS + 16384;
constexpr size_t O_DSS = O_DN + 2112ull * 128 * 4;
constexpr size_t O_GPRE = O_DSS + 2ull * 64 * 16384 * 2;
constexpr size_t O_BAR = O_GPRE + (size_t)MT * 32;
constexpr size_t O_SMALL_END = O_BAR + 16384;
constexpr size_t SLOT0 = 40ull << 20;
constexpr size_t USZ = (size_t)MT * 512 * 2;
static_assert(O_SMALL_END <= SLOT0, "small region overflow");
#define SLOT(i) (SLOT0 + (size_t)(i) * USZ)
constexpr size_t SB_T = 16ull * 128 * 8192;

constexpr size_t OO_Y = 0;
constexpr size_t OO_RETP = (size_t)MT * 1024;
constexpr size_t OO_CP = OO_RETP + 262144;
constexpr size_t OO_NP = OO_CP + 262144;
constexpr size_t OO_MP = OO_NP + 2048;
constexpr size_t OO_CONVP = OO_MP + 16;
constexpr size_t OO_RETS = OO_CONVP + 6144;
constexpr size_t OO_CS = OO_RETS + 1048576;
constexpr size_t OO_NS = OO_CS + 1048576;
constexpr size_t OO_MS = OO_NS + 8192;
constexpr size_t OO_CONVS = OO_MS + 64;

constexpr int SMEM_BYTES = 81152;

__device__ __forceinline__ bfu f2bf(float f) {
  unsigned u = __float_as_uint(f);
  u += 0x7fffu + ((u >> 16) & 1u);
  return (bfu)(u >> 16);
}
__device__ __forceinline__ float bf2f(bfu b) { return __uint_as_float(((unsigned)b) << 16); }
__device__ __forceinline__ unsigned pack2(float a, float b) { return (unsigned)f2bf(a) | ((unsigned)f2bf(b) << 16); }
__device__ __forceinline__ void unpack8(uint4 v, float* f) {
  f[0] = bf2f(v.x & 0xffff); f[1] = bf2f(v.x >> 16); f[2] = bf2f(v.y & 0xffff); f[3] = bf2f(v.y >> 16);
  f[4] = bf2f(v.z & 0xffff); f[5] = bf2f(v.z >> 16); f[6] = bf2f(v.w & 0xffff); f[7] = bf2f(v.w >> 16);
}
__device__ __forceinline__ uint4 pack8(const float* f) {
  uint4 o; o.x = pack2(f[0], f[1]); o.y = pack2(f[2], f[3]); o.z = pack2(f[4], f[5]); o.w = pack2(f[6], f[7]);
  return o;
}
__device__ __forceinline__ float wave_sum(float v) {
#pragma unroll
  for (int o = 32; o > 0; o >>= 1) v += __shfl_xor(v, o);
  return v;
}
__device__ __forceinline__ float wave_max(float v) {
#pragma unroll
  for (int o = 32; o > 0; o >>= 1) v = fmaxf(v, __shfl_xor(v, o));
  return v;
}
__device__ __forceinline__ float dpp_ror_add(float s, const int ctrl_sel) {
  int v = __float_as_int(s);
  int t;
  if (ctrl_sel == 8) t = __builtin_amdgcn_update_dpp(0, v, 0x128, 0xf, 0xf, false);
  else if (ctrl_sel == 4) t = __builtin_amdgcn_update_dpp(0, v, 0x124, 0xf, 0xf, false);
  else if (ctrl_sel == 2) t = __builtin_amdgcn_update_dpp(0, v, 0x122, 0xf, 0xf, false);
  else t = __builtin_amdgcn_update_dpp(0, v, 0x121, 0xf, 0xf, false);
  return s + __int_as_float(t);
}
__device__ __forceinline__ float reduce4(float p0, float p1, float p2, float p3) {
  auto r = __builtin_amdgcn_permlane32_swap(__float_as_int(p0), __float_as_int(p2), false, false);
  float sA = __int_as_float(r[0]) + __int_as_float(r[1]);
  r = __builtin_amdgcn_permlane32_swap(__float_as_int(p1), __float_as_int(p3), false, false);
  float sB = __int_as_float(r[0]) + __int_as_float(r[1]);
  r = __builtin_amdgcn_permlane16_swap(__float_as_int(sA), __float_as_int(sB), false, false);
  float s = __int_as_float(r[0]) + __int_as_float(r[1]);
  s = dpp_ror_add(s, 8); s = dpp_ror_add(s, 4); s = dpp_ror_add(s, 2); s = dpp_ror_add(s, 1);
  return s;
}
__device__ __forceinline__ float sigmoidf_(float x) { return 1.f / (1.f + __expf(-x)); }
__device__ __forceinline__ const float* xrow(const Params& P, int r) {
  return r < MP ? P.xp + (size_t)r * 1024 : P.xs + (size_t)(r - MP) * 1024;
}


#define XB_TMO      128
#define XB_XCNT(j)  (256  + 64 * (j))
#define XB_XSUB(j)  (1280 + 64 * (j))
#define XB_XGEN(j)  (2304 + 64 * (j))
#define XB_TOP      3328
#define XB_TOPGEN   3392
#define XCD_BAR_WORDS 3456
#define XB_SPIN_CAP (1u << 22)
#define LAS __attribute__((address_space(3)))
__device__ __forceinline__ unsigned xb_ld(unsigned* p) { return __hip_atomic_load(p, __ATOMIC_RELAXED, __HIP_MEMORY_SCOPE_AGENT); }
__device__ __forceinline__ unsigned xb_add(unsigned* p, unsigned v) { return __hip_atomic_fetch_add(p, v, __ATOMIC_RELAXED, __HIP_MEMORY_SCOPE_AGENT); }
__device__ __forceinline__ unsigned xb_xcc_id() { return (unsigned)__builtin_amdgcn_s_getreg((3 << 11) | 20) & 0xFu; }
#define XB_SPIN(cond, bar) do { unsigned _sp = 0; while (cond) { __builtin_amdgcn_s_sleep(1); \
    if ((++_sp & 255u) == 0u) { if (xb_ld(&(bar)[XB_TMO])) break; if (_sp > XB_SPIN_CAP) { atomicAdd(&(bar)[XB_TMO], 1u); break; } } } } while (0)
struct XcdBarrier { unsigned* bar; unsigned x; volatile LAS unsigned* st; };
__device__ __forceinline__ XcdBarrier xcd_barrier_post(unsigned* bar, volatile LAS unsigned* st) {
  XcdBarrier b; b.bar = bar; b.x = xb_xcc_id(); b.st = st;
  if (threadIdx.x == 0) (void)xb_add(&bar[XB_XCNT(b.x)], 1u);
  return b;
}
__device__ __forceinline__ void xcd_barrier_complete(unsigned* bar, unsigned x, unsigned& nloc, unsigned& nx) {
  const unsigned G = gridDim.x * gridDim.y * gridDim.z;
  unsigned sum, cnt, mine, sp = 0u;
  for (;;) {
    sum = 0u; cnt = 0u; mine = 0u;
#pragma unroll
    for (unsigned j = 0; j < 16; ++j) { const unsigned c = xb_ld(&bar[XB_XCNT(j)]); sum += c; cnt += (c > 0u) ? 1u : 0u; mine = (j == x) ? c : mine; }
    if (sum == G) break;
    __builtin_amdgcn_s_sleep(1);
    if ((++sp & 255u) == 0u) { if (xb_ld(&bar[XB_TMO])) break; if (sp > XB_SPIN_CAP) { atomicAdd(&bar[XB_TMO], 1u); break; } }
  }
  nloc = mine > 0u ? mine : 1u; nx = cnt > 0u ? cnt : 1u;
}
__device__ __forceinline__ void xcd_barrier(const XcdBarrier& b) {
  asm volatile("s_waitcnt vmcnt(0)" ::: "memory");
  __syncthreads();
  if (threadIdx.x == 0) {
    unsigned* bar = b.bar;
    __builtin_amdgcn_s_waitcnt(0);
    unsigned nloc = b.st[0], nx = b.st[1];
    if (nloc == 0u) { xcd_barrier_complete(bar, b.x, nloc, nx); b.st[0] = nloc; b.st[1] = nx; }
    const unsigned old = xb_add(&bar[XB_XSUB(b.x)], 1u);
    const unsigned gen = old / nloc;
    if (old + 1u == (gen + 1u) * nloc) {
      __builtin_amdgcn_fence(__ATOMIC_RELEASE, "agent");
      asm volatile("s_waitcnt vmcnt(0)" ::: "memory");
      const unsigned og = xb_add(&bar[XB_TOP], 1u);
      const unsigned tg = og / nx;
      if (og + 1u == (tg + 1u) * nx) xb_add(&bar[XB_TOPGEN], 1u);
      else XB_SPIN(xb_ld(&bar[XB_TOPGEN]) == tg, bar);
      __builtin_amdgcn_fence(__ATOMIC_ACQUIRE, "agent");
      xb_add(&bar[XB_XGEN(b.x)], 1u);
      asm volatile("s_waitcnt vmcnt(0)" ::: "memory");
    } else {
      XB_SPIN(xb_ld(&bar[XB_XGEN(b.x)]) == gen, bar);
      __builtin_amdgcn_fence(__ATOMIC_ACQUIRE, "agent");
      asm volatile("s_waitcnt vmcnt(0)" ::: "memory");
    }
  }
  __syncthreads();
}

__device__ __forceinline__ void gemm_acc(f32x16 (&acc)[2][2], const bfu* __restrict__ A, int lda,
                                         const bfu* __restrict__ Bt, int ldb, int K, bfu* sA, bfu*  ) {
  const int tid = threadIdx.x, lane = tid & 63, w = tid >> 6, wm = w & 1, wn = w >> 1;
  const int lr = tid >> 3;
  const int kc = ((tid & 7) ^ ((tid >> 4) & 7)) * 8;
  const bfu* Ap = A + (size_t)lr * lda + kc;
  const bfu* Bp = Bt + (size_t)lr * ldb + kc;
  const size_t a32 = (size_t)32 * lda, b32 = (size_t)32 * ldb;
  char* sbase = (char*)sA;
  char* ldst = sbase + tid * 16;
#define GISSUE(stage, k)                                                                                       \
  _Pragma("unroll") for (int i_ = 0; i_ < 4; ++i_) {                                                           \
    __builtin_amdgcn_global_load_lds((const unsigned*)(Ap + i_ * a32 + (k)),                                   \
                                     (LAS unsigned*)(ldst + (stage) * 32768 + i_ * 4096), 16, 0, 0);           \
    __builtin_amdgcn_global_load_lds((const unsigned*)(Bp + i_ * b32 + (k)),                                   \
                                     (LAS unsigned*)(ldst + (stage) * 32768 + 16384 + i_ * 4096), 16, 0, 0);   \
  }
  const int sw = (lane >> 1) & 7, hh = lane >> 5;
  const int rowA = (wm * 64 + (lane & 31)) * 128, rowB = (wn * 32 + (lane & 31)) * 128;
  __syncthreads();
  GISSUE(0, 0)
  int cur = 0;
  for (int k0 = 0; k0 < K; k0 += 64) {
    asm volatile("s_waitcnt vmcnt(0)" ::: "memory");
    __syncthreads();
    if (k0 + 64 < K) { GISSUE(cur ^ 1, k0 + 64) }
    const char* cA = sbase + cur * 32768;
    const char* cB = cA + 16384;
#pragma unroll
    for (int ks = 0; ks < 4; ++ks) {
      const int pos = ((2 * ks + hh) ^ sw) * 16;
      bf16x8 af[2], bfr[2];
#pragma unroll
      for (int mi = 0; mi < 2; ++mi) af[mi] = *(const bf16x8*)(cA + rowA + mi * 32 * 128 + pos);
#pragma unroll
      for (int ni = 0; ni < 2; ++ni) bfr[ni] = *(const bf16x8*)(cB + rowB + ni * 64 * 128 + pos);
#pragma unroll
      for (int mi = 0; mi < 2; ++mi)
#pragma unroll
        for (int ni = 0; ni < 2; ++ni)
          acc[mi][ni] = __builtin_amdgcn_mfma_f32_32x32x16_bf16(af[mi], bfr[ni], acc[mi][ni], 0, 0, 0);
    }
    cur ^= 1;
  }
}
#define gemm_acc1 gemm_acc
__device__ __forceinline__ void zero_acc(f32x16 (&acc)[2][2]) {
#pragma unroll
  for (int a = 0; a < 2; ++a)
#pragma unroll
    for (int b = 0; b < 2; ++b)
#pragma unroll
      for (int i = 0; i < 16; ++i) acc[a][b][i] = 0.f;
}
#define EPI_BEGIN                                                      \
  const int e_lane = threadIdx.x & 63, e_w = threadIdx.x >> 6;         \
  const int e_wm = e_w & 1, e_wn = e_w >> 1;                            \
  const int cl = e_wn * 32 + (e_lane & 31);                             \
  _Pragma("unroll") for (int mi = 0; mi < 2; ++mi)                      \
  _Pragma("unroll") for (int q = 0; q < 4; ++q) {                       \
    const int r0 = e_wm * 64 + mi * 32 + q * 8 + 4 * (e_lane >> 5);
#define EPI_END }

#define ST_LD 136
#define ST32_LD 132
__device__ __forceinline__ void copyout_bf16(const bfu* sT, bfu* dst, int ld) {
  const int tid = threadIdx.x;
#pragma unroll
  for (int i = 0; i < 8; ++i) {
    int id = tid + i * 256, row = id >> 4, c8 = (id & 15) * 8;
    *(uint4*)(dst + (size_t)row * ld + c8) = *(const uint4*)(sT + row * ST_LD + c8);
  }
}
__device__ __forceinline__ void stage_rm(bfu* sT, const f32x16 (&acc)[2][2], float sc) {
  EPI_BEGIN
#pragma unroll
    for (int j = 0; j < 4; ++j) {
      sT[(r0 + j) * ST_LD + cl] = f2bf(acc[mi][0][q * 4 + j] * sc);
      sT[(r0 + j) * ST_LD + cl + 64] = f2bf(acc[mi][1][q * 4 + j] * sc);
    }
  EPI_END
}

__device__ __forceinline__ void tile_map(int L, int nM, int nN, int& pm, int& pn) {
  const int nwg = nM * nN;
  const int q = nwg >> 3, r = nwg & 7, xcd = L & 7, off = L >> 3;
  int wgid = (xcd < r ? xcd * (q + 1) : r * (q + 1) + (xcd - r) * q) + off;
  const int nig = 8 * nN, gid = wgid / nig, fm = gid * 8;
  const int gsz = (nM - fm) < 8 ? (nM - fm) : 8;
  pm = fm + (wgid % nig) % gsz;
  pn = (wgid % nig) / gsz;
}
__device__ void transpose_w(const float* __restrict__ src, int K, int N, int src_ld, bfu* __restrict__ dst,
                            int remap, int gtid, int gstride) {
  int total = N * (K / 8);
  for (int i = gtid; i < total; i += gstride) {
    int n = i % N, kg = i / N;
    int col = (remap && n >= 3584) ? n + 8 : n;
    float v[8];
#pragma unroll
    for (int j = 0; j < 8; ++j) v[j] = src[(size_t)(kg * 8 + j) * src_ld + col];
    uint4 o;
    o.x = pack2(v[0], v[1]); o.y = pack2(v[2], v[3]); o.z = pack2(v[4], v[5]); o.w = pack2(v[6], v[7]);
    *(uint4*)(dst + (size_t)n * K + kg * 8) = o;
  }
}
__device__ void transpose_w_lds(const float* __restrict__ src, int K, int N, int src_ld, bfu* __restrict__ dst,
                                int remap, float* st, int boff) {
  const int tid = threadIdx.x;
  const int tilesN = N >> 6, ntile = (K >> 6) * tilesN;
  for (int t = (int)((blockIdx.x + gridDim.x - (boff % gridDim.x)) % gridDim.x); t < ntile; t += gridDim.x) {
    const int kt = t / tilesN, nt = t - kt * tilesN;
    {
      const int row = tid >> 2, c16 = (tid & 3) * 16;
      const int n0 = nt * 64 + c16;
      const int col = (remap && n0 >= 3584) ? n0 + 8 : n0;
      const float* sp = src + (size_t)(kt * 64 + row) * src_ld + col;
#pragma unroll
      for (int j = 0; j < 4; ++j) {
        float4 v = *(const float4*)(sp + j * 4);
        float* d = st + row * 65 + c16 + j * 4;
        d[0] = v.x; d[1] = v.y; d[2] = v.z; d[3] = v.w;
      }
    }
    __syncthreads();
    {
      const int n = tid >> 2, kc = (tid & 3) * 16;
#pragma unroll
      for (int hf = 0; hf < 2; ++hf) {
        float f[8];
#pragma unroll
        for (int j = 0; j < 8; ++j) f[j] = st[(kc + hf * 8 + j) * 65 + n];
        uint4 o;
        o.x = pack2(f[0], f[1]); o.y = pack2(f[2], f[3]); o.z = pack2(f[4], f[5]); o.w = pack2(f[6], f[7]);
        *(uint4*)(dst + (size_t)(nt * 64 + n) * K + kt * 64 + kc + hf * 8) = o;
      }
    }
    __syncthreads();
  }
}
__device__ void convert_bf(const float* __restrict__ src, bfu* __restrict__ dst, size_t n8, int gtid, int gstride) {
  for (size_t i = gtid; i < n8; i += gstride) {
    float4 a = *(const float4*)(src + i * 8), b = *(const float4*)(src + i * 8 + 4);
    uint4 o;
    o.x = pack2(a.x, a.y); o.y = pack2(a.z, a.w); o.z = pack2(b.x, b.y); o.w = pack2(b.z, b.w);
    *(uint4*)(dst + i * 8) = o;
  }
}

__device__ void prep_rows(const Params& P) {
  const int lane = threadIdx.x & 63, w = threadIdx.x >> 6;
  bfu* hbuf = (bfu*)(P.ws + SLOT(0));
  float* gpre = (float*)(P.ws + O_GPRE);
  for (int r = blockIdx.x * 4 + w; r < MT; r += gridDim.x * 4) {
    const float* xr = xrow(P, r);
    float4 v[4];
    float ss = 0.f;
#pragma unroll
    for (int i = 0; i < 4; ++i) {
      v[i] = *(const float4*)(xr + i * 256 + lane * 4);
      ss += v[i].x * v[i].x + v[i].y * v[i].y + v[i].z * v[i].z + v[i].w * v[i].w;
    }
    ss = wave_sum(ss);
    float rstd = rsqrtf(ss * (1.f / 1024.f) + EPS);
    float ga[8];
#pragma unroll
    for (int j = 0; j < 8; ++j) ga[j] = 0.f;
#pragma unroll
    for (int i = 0; i < 4; ++i) {
      float4 g = *(const float4*)(P.g_mix + i * 256 + lane * 4);
      float hv[4] = {v[i].x * rstd * g.x, v[i].y * rstd * g.y, v[i].z * rstd * g.z, v[i].w * rstd * g.w};
      uint2 o; o.x = pack2(hv[0], hv[1]); o.y = pack2(hv[2], hv[3]);
      *(uint2*)(hbuf + (size_t)r * 1024 + i * 256 + lane * 4) = o;
#pragma unroll
      for (int j = 0; j < 4; ++j) {
        const float* wr = P.w_in + (size_t)(i * 256 + lane * 4 + j) * 5640 + 3584;
        float4 w0 = *(const float4*)wr, w1 = *(const float4*)(wr + 4);
        ga[0] += hv[j] * w0.x; ga[1] += hv[j] * w0.y; ga[2] += hv[j] * w0.z; ga[3] += hv[j] * w0.w;
        ga[4] += hv[j] * w1.x; ga[5] += hv[j] * w1.y; ga[6] += hv[j] * w1.z; ga[7] += hv[j] * w1.w;
      }
    }
    float si = reduce4(ga[0], ga[1], ga[2], ga[3]);
    float sf = reduce4(ga[4], ga[5], ga[6], ga[7]);
    if ((lane & 15) == 0) {
      int k = lane >> 4;
      gpre[(size_t)r * 8 + k] = si + P.b_i[k];
      gpre[(size_t)r * 8 + 4 + k] = sf + P.b_f[k];
    }
  }
}
__device__ void gate_scan(const Params& P) {
  const int lane = threadIdx.x & 63, w = threadIdx.x >> 6;
  const float* gpre = (const float*)(P.ws + O_GPRE);
  for (int item = blockIdx.x * 4 + w; item < 528 * 4; item += gridDim.x * 4) {
    int tile = item >> 2, h = item & 3;
    int row0, L;
    if (tile < 512) { row0 = tile * 64; L = 64; } else { row0 = MP + (tile - 512) * 32; L = 32; }
    const int s = lane;
    bool valid = s < L;
    float ig = valid ? gpre[(size_t)(row0 + s) * 8 + h] : -INFINITY;
    float fg = valid ? gpre[(size_t)(row0 + s) * 8 + 4 + h] : 0.f;
    float lf = valid ? (fminf(fg, 0.f) - log1pf(__expf(-fabsf(fg)))) : 0.f;
    float F = lf;
#pragma unroll
    for (int o = 1; o < 64; o <<= 1) { float t = __shfl_up(F, o); if (lane >= o) F += t; }
    float u = valid ? ig - F : -INFINITY;
    float cm = u;
#pragma unroll
    for (int o = 1; o < 64; o <<= 1) { float t = __shfl_up(cm, o); if (lane >= o) cm = fmaxf(cm, t); }
    if (valid) {
      size_t gi = (size_t)(row0 + s) * 4 + h;
      ((float*)(P.ws + O_FQ))[gi] = F;
      ((float*)(P.ws + O_UQ))[gi] = u;
      ((float*)(P.ws + O_CMQ))[gi] = cm;
      if (s == L - 1) {
        ((float*)(P.ws + O_FL))[tile * 4 + h] = F;
        ((float*)(P.ws + O_UC))[tile * 4 + h] = cm;
      }
    }
  }
}

__device__ void phase_prep(const Params& P, char* smem) {
  const int gtid = blockIdx.x * NTHREADS + threadIdx.x, gstride = gridDim.x * NTHREADS;
  prep_rows(P);
  transpose_w_lds(P.w_in, 1024, 5632, 5640, (bfu*)(P.ws + O_WT_IN), 1, (float*)smem, 0);
  transpose_w_lds(P.w_up_r, 512, 1024, 1024, (bfu*)(P.ws + O_WT_UPR), 0, (float*)smem, 1408);
  transpose_w_lds(P.w_up_m, 512, 1024, 1024, (bfu*)(P.ws + O_WT_UPM), 0, (float*)smem, 1536);
  transpose_w_lds(P.w_out, 1024, 1024, 1024, (bfu*)(P.ws + O_WT_OUT), 0, (float*)smem, 1664);
  transpose_w_lds(P.w_pq, 1024, 2048, 2048, (bfu*)(P.ws + O_WT_PQ), 0, (float*)smem, 1920);
  transpose_w_lds(P.w_pg, 1024, 1024, 1024, (bfu*)(P.ws + O_WT_PG), 0, (float*)smem, 2432);
  transpose_w_lds(P.w_ple, 256, 1024, 1024, (bfu*)(P.ws + O_WT_PLE), 0, (float*)smem, 2688);
  for (int h = 0; h < 4; ++h) {
    transpose_w_lds(P.w_mq + h * 16384, 128, 128, 128, (bfu*)(P.ws + O_WT_MQ) + h * 16384, 0, (float*)smem, 2752 + h * 8);
    transpose_w_lds(P.w_mk + h * 16384, 128, 128, 128, (bfu*)(P.ws + O_WT_MK) + h * 16384, 0, (float*)smem, 2756 + h * 8);
  }
  convert_bf(P.peer_keys, (bfu*)(P.ws + O_KEYS), 16 * 128 * 128 / 8, gtid, gstride);
  float* ct = (float*)(P.ws + O_COS); float* st = (float*)(P.ws + O_SIN);
  for (int i = gtid; i < 8192 * 64; i += gstride) {
    int pos = i >> 6, j = i & 63;
    float inv = exp2f(-(float)j * (13.287712379549449f / 64.f));
    float angf = (float)pos * inv;
    double a = (double)angf;
    double k = rint(a * 0.15915494309189535);
    float r = (float)(a - k * 6.283185307179586);
    ct[i] = __cosf(r); st[i] = __sinf(r);
  }
}

__device__ void phase_gemm1(const Params& P, char* smem) {
  bfu* sA = (bfu*)smem; bfu* sB = sA + 128 * 72;
  const bfu* hbuf = (const bfu*)(P.ws + SLOT(0));
  const bfu* wt = (const bfu*)(P.ws + O_WT_IN);
  const float* ct = (const float*)(P.ws + O_COS); const float* stb = (const float*)(P.ws + O_SIN);
  for (int t = blockIdx.x; t < 260 * 44; t += gridDim.x) {
    int mt, nt; tile_map(t, 260, 44, mt, nt);
    f32x16 acc[2][2]; zero_acc(acc);
    gemm_acc(acc, hbuf + (size_t)mt * 128 * 1024, 1024, wt + (size_t)nt * 128 * 1024, 1024, 1024, sA, sB);
    const int rbase = mt * 128;
    const bool prompt = rbase < MP;
    int region = nt >> 2, hh = nt & 3;
    bfu* sT = (bfu*)smem;
    __syncthreads();
    if (region <= 1) {
      float sc = region == 1 ? 0.08838834764831845f : 1.f;
      EPI_BEGIN
#pragma unroll
        for (int j = 0; j < 4; ++j) {
          int rr = rbase + r0 + j;
          int pos = prompt ? (rr & 8191) : 2048 + ((rr - MP) & 31);
          float c = ct[pos * 64 + cl], sn = stb[pos * 64 + cl];
          float a = acc[mi][0][q * 4 + j], b = acc[mi][1][q * 4 + j];
          sT[(r0 + j) * ST_LD + cl] = f2bf((a * c - b * sn) * sc);
          sT[(r0 + j) * ST_LD + cl + 64] = f2bf((a * sn + b * c) * sc);
        }
      EPI_END
      __syncthreads();
      copyout_bf16(sT, (bfu*)(P.ws + SLOT(2 + region)) + (size_t)rbase * 512 + hh * 128, 512);
    } else if (region == 2 || region == 5) {
      EPI_BEGIN
        uint2 va, vb;
        va.x = pack2(acc[mi][0][q * 4 + 0], acc[mi][0][q * 4 + 1]); va.y = pack2(acc[mi][0][q * 4 + 2], acc[mi][0][q * 4 + 3]);
        vb.x = pack2(acc[mi][1][q * 4 + 0], acc[mi][1][q * 4 + 1]); vb.y = pack2(acc[mi][1][q * 4 + 2], acc[mi][1][q * 4 + 3]);
        *(uint2*)(sT + cl * ST_LD + r0) = va;
        *(uint2*)(sT + (cl + 64) * ST_LD + r0) = vb;
      EPI_END
      __syncthreads();
      bfu* dst = (bfu*)(P.ws + SLOT(region == 2 ? 4 : 7));
#pragma unroll
      for (int i = 0; i < 8; ++i) {
        int id = threadIdx.x + i * 256, e = id >> 4, c8 = (id & 15) * 8;
        size_t o;
        if (prompt) { int bb = rbase >> 13, tt = (rbase & 8191) + c8; o = ((size_t)((bb * 4 + hh) * 128 + e)) * 8192 + tt; }
        else { int rs = rbase - MP + c8, bb = rs >> 5, tt = rs & 31; o = SB_T + ((size_t)((bb * 4 + hh) * 128 + e)) * 32 + tt; }
        *(uint4*)(dst + o) = *(const uint4*)(sT + e * ST_LD + c8);
      }
    } else if (region == 3 || region == 4 || region == 6) {
      stage_rm(sT, acc, 1.f);
      __syncthreads();
      copyout_bf16(sT, (bfu*)(P.ws + SLOT(region == 3 ? 5 : (region == 4 ? 6 : 8))) + (size_t)rbase * 512 + hh * 128, 512);
    } else {
      int gi = nt - 28;
      stage_rm(sT, acc, 1.f);
      __syncthreads();
      copyout_bf16(sT, (bfu*)(P.ws + SLOT(gi < 8 ? 9 : 11)) + (size_t)rbase * 1024 + (gi & 7) * 128, 1024);
    }
  }
}

__device__ void phase_conv(const Params& P) {
  const int gtid = blockIdx.x * NTHREADS + threadIdx.x, gstride = gridDim.x * NTHREADS;
  const bfu* xm = (const bfu*)(P.ws + SLOT(6));
  bfu* cb = (bfu*)(P.ws + SLOT(0));
  for (int i = gtid; i < MT * 64; i += gstride) {
    int r = i >> 6, c0 = (i & 63) * 8;
    int t, T, bb; bool prompt = r < MP;
    if (prompt) { bb = r >> 13; t = r & 8191; T = 8192; } else { int rs = r - MP; bb = rs >> 5; t = rs & 31; T = 32; }
    float y[8];
#pragma unroll
    for (int j = 0; j < 8; ++j) y[j] = P.conv_b[c0 + j];
#pragma unroll
    for (int k = 0; k < 4; ++k) {
      int tt = t - 3 + k;
      float xv[8];
      if (tt >= 0) {
        uint4 v = *(const uint4*)(xm + (size_t)(r - 3 + k) * 512 + c0);
        xv[0] = bf2f(v.x & 0xffff); xv[1] = bf2f(v.x >> 16); xv[2] = bf2f(v.y & 0xffff); xv[3] = bf2f(v.y >> 16);
        xv[4] = bf2f(v.z & 0xffff); xv[5] = bf2f(v.z >> 16); xv[6] = bf2f(v.w & 0xffff); xv[7] = bf2f(v.w >> 16);
      } else if (!prompt) {
        const float* sp = P.st_conv + (size_t)(bb * 3 + (tt + 3)) * 512 + c0;
#pragma unroll
        for (int j = 0; j < 8; ++j) xv[j] = sp[j];
      } else {
#pragma unroll
        for (int j = 0; j < 8; ++j) xv[j] = 0.f;
      }
#pragma unroll
      for (int j = 0; j < 8; ++j) y[j] += xv[j] * P.conv_w[k * 512 + c0 + j];
    }
    if (t >= T - 3) {
      uint4 v = *(const uint4*)(xm + (size_t)r * 512 + c0);
      float* dst = (prompt ? P.out + OO_CONVP : P.out + OO_CONVS) + (size_t)(bb * 3 + (t - (T - 3))) * 512 + c0;
      dst[0] = bf2f(v.x & 0xffff); dst[1] = bf2f(v.x >> 16); dst[2] = bf2f(v.y & 0xffff); dst[3] = bf2f(v.y >> 16);
      dst[4] = bf2f(v.z & 0xffff); dst[5] = bf2f(v.z >> 16); dst[6] = bf2f(v.w & 0xffff); dst[7] = bf2f(v.w >> 16);
    }
    uint4 o;
#pragma unroll
    for (int j = 0; j < 8; ++j) y[j] = y[j] * sigmoidf_(y[j]);
    o.x = pack2(y[0], y[1]); o.y = pack2(y[2], y[3]); o.z = pack2(y[4], y[5]); o.w = pack2(y[6], y[7]);
    *(uint4*)(cb + (size_t)r * 512 + c0) = o;
  }
}

__device__ void m_fold(const Params& P) {
  const int gtid = blockIdx.x * NTHREADS + threadIdx.x;
  const float* FL = (const float*)(P.ws + O_FL); const float* UC = (const float*)(P.ws + O_UC);
  float* MCS = (float*)(P.ws + O_MCS);
  if (gtid < 16) {
    int b = gtid >> 2, h = gtid & 3;
    float m = 0.f;
    for (int c = 0; c < 128; c += 8) {
      float fl[8], uc[8];
#pragma unroll
      for (int k = 0; k < 8; ++k) { fl[k] = FL[(b * 128 + c + k) * 4 + h]; uc[k] = UC[(b * 128 + c + k) * 4 + h]; }
#pragma unroll
      for (int k = 0; k < 8; ++k) { MCS[gtid * 128 + c + k] = m; m = fl[k] + fmaxf(m, uc[k]); }
    }
  } else if (gtid < 16 + 64) {
    int bh = gtid - 16;
    MCS[2048 + bh] = P.st_m[bh];
  }
}
__device__ void phase_mqk(const Params& P, char* smem) {
  bfu* sA = (bfu*)smem; bfu* sB = sA + 128 * 72;
  const bfu* cb = (const bfu*)(P.ws + SLOT(0));
  for (int t = blockIdx.x; t < 260 * 8; t += gridDim.x) {
    int mt = t >> 3, which = (t >> 2) & 1, hh = t & 3;
    const bfu* wt = (const bfu*)(P.ws + (which ? O_WT_MK : O_WT_MQ)) + hh * 16384;
    f32x16 acc[2][2]; zero_acc(acc);
    gemm_acc(acc, cb + (size_t)mt * 128 * 512 + hh * 128, 512, wt, 128, 128, sA, sB);
    bfu* dst = (bfu*)(P.ws + SLOT(which ? 13 : 1));
    float sc = which ? 0.08838834764831845f : 1.f;
    bfu* sT = (bfu*)smem;
    __syncthreads();
    stage_rm(sT, acc, sc);
    __syncthreads();
    copyout_bf16(sT, dst + (size_t)mt * 128 * 512 + hh * 128, 512);
  }
}

struct Item { int b, h, c, row0, L, T, chunk, bh; bool prompt; size_t vt_off; };
__device__ __forceinline__ Item decode_item(int idx) {
  Item it;
  if (idx < 2048) {
    it.prompt = true; it.b = idx >> 9; it.h = (idx >> 7) & 3; it.c = idx & 127; it.row0 = it.b * 8192 + it.c * 64;
    it.L = 64; it.T = 8192; it.chunk = it.b * 128 + it.c; it.bh = it.b * 4 + it.h;
    it.vt_off = ((size_t)(it.bh * 128)) * 8192 + it.c * 64;
  } else {
    int si = idx - 2048; it.prompt = false; it.b = si >> 2; it.h = si & 3; it.c = 0; it.row0 = MP + it.b * 32;
    it.L = 32; it.T = 32; it.chunk = 512 + it.b; it.bh = it.b * 4 + it.h;
    it.vt_off = SB_T + ((size_t)(it.bh * 128)) * 32;
  }
  return it;
}
__device__ __forceinline__ bfu* ds_ptr(const Params& P, int mixer, int idx) {
  if (idx < 2048) return (bfu*)P.out + ((size_t)(mixer * 2048 + idx)) * 16384;
  return (bfu*)(P.ws + O_DSS) + ((size_t)(mixer * 64 + (idx - 2048))) * 16384;
}
__device__ __forceinline__ float ret_lg(int h) { return log1pf(-exp2f(-5.f - (float)h)); }

__device__ void phaseA_item(const Params& P, int mixer, int idx, char* smem) {
  const int tid = threadIdx.x, lane = tid & 63, w = tid >> 6, wm = w & 1, wn = w >> 1;
  Item it = decode_item(idx);
  bfu* sK = (bfu*)smem; bfu* sV = sK + 128 * 72;
  float* sw = (float*)(sV + 128 * 72);
  float* sm = sw + 64;
  const int L = it.L, h = it.h;
  const bfu* Ksrc = (const bfu*)(P.ws + SLOT(mixer == 0 ? 3 : 13)) + (size_t)it.row0 * 512 + h * 128;
  const bfu* Vsrc = (const bfu*)(P.ws + SLOT(mixer == 0 ? 4 : 7)) + it.vt_off;
  uint4 kreg[4], vreg[4];
#pragma unroll
  for (int i = 0; i < 4; ++i) {
    int id = tid + i * 256, s = id & 63, dc = (id >> 6) * 8;
    kreg[i] = make_uint4(0, 0, 0, 0);
    if (s < L) kreg[i] = *(const uint4*)(Ksrc + (size_t)s * 512 + dc);
    int e = id >> 3, sc = (id & 7) * 8;
    vreg[i] = make_uint4(0, 0, 0, 0);
    if (sc < L) vreg[i] = *(const uint4*)(Vsrc + (size_t)e * it.T + sc);
  }
  if (mixer == 0) {
    if (tid < 64) { float lg = ret_lg(h); sw[tid] = tid < L ? __expf(lg * (float)(L - 1 - tid)) : 0.f; }
  } else {
    const float* FL = (const float*)(P.ws + O_FL); const float* UC = (const float*)(P.ws + O_UC);
    float mc = ((const float*)(P.ws + O_MCS))[idx];
    float Ml = fmaxf(mc, UC[it.chunk * 4 + h]);
    if (tid < 64) sw[tid] = tid < L ? __expf(((const float*)(P.ws + O_UQ))[(size_t)(it.row0 + tid) * 4 + h] - Ml) : 0.f;
    if (tid == 0) {
      ((float*)(P.ws + O_AEND))[idx] = __expf(mc - Ml);
      if (!it.prompt) P.out[OO_MS + it.bh] = FL[it.chunk * 4 + h] + Ml;
      else if (it.c == 127) P.out[OO_MP + it.bh] = FL[it.chunk * 4 + h] + Ml;
    }
  }
  __syncthreads();
#pragma unroll
  for (int i = 0; i < 4; ++i) {
    int id = tid + i * 256, s = id & 63, dc = (id >> 6) * 8;
    uint4 v = kreg[i];
    float ww = sw[s];
    unsigned vv[4] = {v.x, v.y, v.z, v.w};
#pragma unroll
    for (int j = 0; j < 4; ++j) {
      sK[(dc + 2 * j) * 72 + s] = f2bf(bf2f(vv[j] & 0xffff) * ww);
      sK[(dc + 2 * j + 1) * 72 + s] = f2bf(bf2f(vv[j] >> 16) * ww);
    }
  }
#pragma unroll
  for (int i = 0; i < 4; ++i) {
    int id = tid + i * 256, e = id >> 3, sc = (id & 7) * 8;
    *(uint4*)(sV + e * 72 + sc) = vreg[i];
  }
  __syncthreads();
  f32x16 acc[2][2]; zero_acc(acc);
#pragma unroll
  for (int ks = 0; ks < 4; ++ks) {
    bf16x8 af[2], bfr[2];
#pragma unroll
    for (int mi = 0; mi < 2; ++mi)
      af[mi] = *(const bf16x8*)(sK + (wm * 64 + mi * 32 + (lane & 31)) * 72 + ks * 16 + (lane >> 5) * 8);
#pragma unroll
    for (int ni = 0; ni < 2; ++ni)
      bfr[ni] = *(const bf16x8*)(sV + (wn * 32 + ni * 64 + (lane & 31)) * 72 + ks * 16 + (lane >> 5) * 8);
#pragma unroll
    for (int mi = 0; mi < 2; ++mi)
#pragma unroll
      for (int ni = 0; ni < 2; ++ni)
        acc[mi][ni] = __builtin_amdgcn_mfma_f32_32x32x16_bf16(af[mi], bfr[ni], acc[mi][ni], 0, 0, 0);
  }
  bfu* dS = ds_ptr(P, mixer, idx);
  EPI_BEGIN
#pragma unroll
    for (int ni = 0; ni < 2; ++ni) {
      int e = cl + ni * 64;
      uint2 o; o.x = pack2(acc[mi][ni][q * 4 + 0], acc[mi][ni][q * 4 + 1]); o.y = pack2(acc[mi][ni][q * 4 + 2], acc[mi][ni][q * 4 + 3]);
      *(uint2*)(dS + e * 128 + r0) = o;
    }
  EPI_END
  if (mixer == 1 && tid < 128) {
    float s = 0.f;
#pragma unroll
    for (int j = 0; j < 8; ++j) { float f[8]; unpack8(*(const uint4*)(sK + tid * 72 + j * 8), f);
#pragma unroll
      for (int k = 0; k < 8; ++k) s += f[k]; }
    ((float*)(P.ws + O_DN))[(size_t)idx * 128 + tid] = s;
  }
  __syncthreads();
}

__device__ void phase_scan(const Params& P) {
  const int gtid = blockIdx.x * NTHREADS + threadIdx.x, gstride = gridDim.x * NTHREADS;
  const float* AE = (const float*)(P.ws + O_AEND);
  for (int i = gtid; i < 131072; i += gstride) {
    int mixer = i >> 16, bh = (i >> 12) & 15, eo = (i & 4095) * 4;
    int h = bh & 3;
    float gch = __expf(ret_lg(h) * 64.f);
    float st[4];
#pragma unroll
    for (int j = 0; j < 4; ++j) st[j] = 0.f;
    bfu* base = (bfu*)P.out + ((size_t)(mixer * 2048 + bh * 128)) * 16384 + eo;
    for (int c = 0; c < 128; c += 8) {
      uint2 v[8];
#pragma unroll
      for (int k = 0; k < 8; ++k) v[k] = *(const uint2*)(base + (size_t)(c + k) * 16384);
#pragma unroll
      for (int k = 0; k < 8; ++k) {
        float dec = mixer == 0 ? gch : AE[bh * 128 + c + k];
        float d0 = bf2f(v[k].x & 0xffff), d1 = bf2f(v[k].x >> 16), d2 = bf2f(v[k].y & 0xffff), d3 = bf2f(v[k].y >> 16);
        uint2 o; o.x = pack2(st[0], st[1]); o.y = pack2(st[2], st[3]);
        *(uint2*)(base + (size_t)(c + k) * 16384) = o;
        st[0] = dec * st[0] + d0; st[1] = dec * st[1] + d1; st[2] = dec * st[2] + d2; st[3] = dec * st[3] + d3;
      }
    }
    float* o = P.out + (mixer == 0 ? OO_RETP : OO_CP) + (size_t)bh * 16384;
    int e = eo >> 7, d0i = eo & 127;
#pragma unroll
    for (int j = 0; j < 4; ++j) o[(d0i + j) * 128 + e] = st[j];
  }
  for (int i = gtid; i < 2 * 64 * 2048; i += gstride) {
    int mixer = i >> 17, bh = (i >> 11) & 63, eo = (i & 2047) * 8;
    int h = bh & 3;
    int e = eo >> 7, d0 = eo & 127;
    const float* s0 = (mixer == 0 ? P.st_ret : P.st_C) + (size_t)bh * 16384;
    float st[8];
#pragma unroll
    for (int j = 0; j < 8; ++j) st[j] = s0[(d0 + j) * 128 + e];
    bfu* p = (bfu*)(P.ws + O_DSS) + ((size_t)(mixer * 64 + bh)) * 16384 + eo;
    float d[8]; unpack8(*(const uint4*)p, d);
    *(uint4*)p = pack8(st);
    float dec = mixer == 0 ? __expf(ret_lg(h) * 32.f) : AE[2048 + bh];
    float* o = P.out + (mixer == 0 ? OO_RETS : OO_CS) + (size_t)bh * 16384;
#pragma unroll
    for (int j = 0; j < 8; ++j) o[(d0 + j) * 128 + e] = dec * st[j] + d[j];
  }
  float* DN = (float*)(P.ws + O_DN);
  for (int i = gtid; i < 16 * 128; i += gstride) {
    int bh = i >> 7, d = i & 127;
    float n = 0.f;
    for (int c = 0; c < 128; ++c) {
      size_t o = (size_t)(bh * 128 + c) * 128 + d;
      float v = DN[o]; DN[o] = n; n = AE[bh * 128 + c] * n + v;
    }
    P.out[OO_NP + i] = n;
  }
  for (int i = gtid; i < 64 * 128; i += gstride) {
    int bh = i >> 7, d = i & 127;
    size_t o = (size_t)(2048 + bh) * 128 + d;
    float n0 = P.st_n[i]; float v = DN[o]; DN[o] = n0;
    P.out[OO_NS + i] = AE[2048 + bh] * n0 + v;
  }
}

__device__ void phaseC_item(const Params& P, int mixer, int idx, char* smem) {
  const int tid = threadIdx.x, lane = tid & 63, w = tid >> 6;
  Item it = decode_item(idx);
  const int L = it.L, h = it.h;
  bfu* sQ = (bfu*)smem;
  bfu* sKV = sQ + 64 * 136;
  bfu* sP = sKV + 128 * 72;
  bfu* sS = sP + 64 * 72;
  float* sO = (float*)sS;
  float* sRow = (float*)(sS + 128 * 136);
  const bfu* Qsrc = (const bfu*)(P.ws + SLOT(mixer == 0 ? 2 : 1)) + (size_t)it.row0 * 512 + h * 128;
  const bfu* Ksrc = (const bfu*)(P.ws + SLOT(mixer == 0 ? 3 : 13)) + (size_t)it.row0 * 512 + h * 128;
  const bfu* Vsrc = (const bfu*)(P.ws + SLOT(mixer == 0 ? 4 : 7)) + it.vt_off;
  const bfu* Ssrc = ds_ptr(P, mixer, idx);
  const float lg = ret_lg(h);
  uint4 vpre[4];
#pragma unroll
  for (int i = 0; i < 4; ++i) {
    int id = tid + i * 256, e = id >> 3, sc = (id & 7) * 8;
    vpre[i] = make_uint4(0, 0, 0, 0);
    if (sc < L) vpre[i] = *(const uint4*)(Vsrc + (size_t)e * it.T + sc);
  }
#pragma unroll
  for (int i = 0; i < 4; ++i) {
    int id = tid + i * 256, s = id >> 4, dc = (id & 15) * 8;
    uint4 vq = make_uint4(0, 0, 0, 0), vk = vq;
    if (s < L) { vq = *(const uint4*)(Qsrc + (size_t)s * 512 + dc); vk = *(const uint4*)(Ksrc + (size_t)s * 512 + dc); }
    *(uint4*)(sQ + s * 136 + dc) = vq;
    *(uint4*)(sKV + s * 136 + dc) = vk;
  }
#pragma unroll
  for (int i = 0; i < 8; ++i) {
    int id = tid + i * 256, e = id >> 4, dc = (id & 15) * 8;
    *(uint4*)(sS + e * 136 + dc) = *(const uint4*)(Ssrc + e * 128 + dc);
  }
  if (tid < 64) {
    int i = tid;
    if (mixer == 0) {
      sRow[128 + i] = __expf(lg * (float)(i + 1));
    } else {
      float mc = ((const float*)(P.ws + O_MCS))[idx];
      size_t gi = (size_t)(it.row0 + i) * 4 + h;
      bool valid = i < L;
      float u = valid ? ((const float*)(P.ws + O_UQ))[gi] : -INFINITY;
      float M = valid ? fmaxf(mc, ((const float*)(P.ws + O_CMQ))[gi]) : 0.f;
      float F = valid ? ((const float*)(P.ws + O_FQ))[gi] : 0.f;
      sRow[i] = u; sRow[64 + i] = M; sRow[128 + i] = valid ? __expf(mc - M) : 0.f;
      sRow[256 + i] = __expf(-(F + M));
    }
  }
  __syncthreads();
  {
    const int mi = w & 1, ni = w >> 1;
    f32x16 acc;
#pragma unroll
    for (int i = 0; i < 16; ++i) acc[i] = 0.f;
#pragma unroll 2
    for (int ks = 0; ks < 8; ++ks) {
      bf16x8 af = *(const bf16x8*)(sQ + (mi * 32 + (lane & 31)) * 136 + ks * 16 + (lane >> 5) * 8);
      bf16x8 bfr = *(const bf16x8*)(sKV + (ni * 32 + (lane & 31)) * 136 + ks * 16 + (lane >> 5) * 8);
      acc = __builtin_amdgcn_mfma_f32_32x32x16_bf16(af, bfr, acc, 0, 0, 0);
    }
    const int s = ni * 32 + (lane & 31);
    float us = mixer ? sRow[s] : 0.f;
#pragma unroll
    for (int reg = 0; reg < 16; ++reg) {
      int i = mi * 32 + (reg & 3) + 8 * (reg >> 2) + 4 * (lane >> 5);
      float wgt;
      if (mixer == 0) wgt = (s <= i) ? __expf(lg * (float)(i - s)) : 0.f;
      else wgt = (s <= i && i < L) ? __expf(us - sRow[64 + i]) : 0.f;
      sP[i * 72 + s] = f2bf(acc[reg] * wgt);
    }
  }
  __syncthreads();
#pragma unroll
  for (int i = 0; i < 4; ++i) {
    int id = tid + i * 256, e = id >> 3, sc = (id & 7) * 8;
    *(uint4*)(sKV + e * 72 + sc) = vpre[i];
  }
  __syncthreads();
  f32x16 acc1[2], acc2[2];
  const int mi = w & 1, nj = w >> 1;
#pragma unroll
  for (int t = 0; t < 2; ++t)
#pragma unroll
    for (int i = 0; i < 16; ++i) { acc1[t][i] = 0.f; acc2[t][i] = 0.f; }
#pragma unroll 2
  for (int ks = 0; ks < 4; ++ks) {
    bf16x8 af = *(const bf16x8*)(sP + (mi * 32 + (lane & 31)) * 72 + ks * 16 + (lane >> 5) * 8);
#pragma unroll
    for (int t = 0; t < 2; ++t) {
      bf16x8 bfr = *(const bf16x8*)(sKV + (nj * 64 + t * 32 + (lane & 31)) * 72 + ks * 16 + (lane >> 5) * 8);
      acc1[t] = __builtin_amdgcn_mfma_f32_32x32x16_bf16(af, bfr, acc1[t], 0, 0, 0);
    }
  }
#pragma unroll 2
  for (int ks = 0; ks < 8; ++ks) {
    bf16x8 af = *(const bf16x8*)(sQ + (mi * 32 + (lane & 31)) * 136 + ks * 16 + (lane >> 5) * 8);
#pragma unroll
    for (int t = 0; t < 2; ++t) {
      bf16x8 bfr = *(const bf16x8*)(sS + (nj * 64 + t * 32 + (lane & 31)) * 136 + ks * 16 + (lane >> 5) * 8);
      acc2[t] = __builtin_amdgcn_mfma_f32_32x32x16_bf16(af, bfr, acc2[t], 0, 0, 0);
    }
  }
  if (mixer == 1) {
    int i = tid >> 2, part = tid & 3;
    const float* nprev = (const float*)(P.ws + O_DN) + (size_t)idx * 128;
    float dl = 0.f, qn = 0.f;
#pragma unroll 4
    for (int s = part * 16; s < part * 16 + 16; ++s) dl += bf2f(sP[i * 72 + s]);
#pragma unroll 4
    for (int d = part * 32; d < part * 32 + 32; ++d) qn += bf2f(sQ[i * 136 + d]) * nprev[d];
    dl += __shfl_xor(dl, 1); dl += __shfl_xor(dl, 2);
    qn += __shfl_xor(qn, 1); qn += __shfl_xor(qn, 2);
    if (part == 0) {
      float den = dl + sRow[128 + i] * qn;
      sRow[192 + i] = 1.f / fmaxf(fabsf(den), sRow[256 + i]);
    }
  }
  __syncthreads();
#pragma unroll
  for (int t = 0; t < 2; ++t) {
    int e = nj * 64 + t * 32 + (lane & 31);
#pragma unroll
    for (int reg = 0; reg < 16; ++reg) {
      int i = mi * 32 + (reg & 3) + 8 * (reg >> 2) + 4 * (lane >> 5);
      float o = acc1[t][reg] + sRow[128 + i] * acc2[t][reg];
      if (mixer == 1) o *= sRow[192 + i];
      sO[i * 132 + e] = o;
    }
  }
  __syncthreads();
  {
    int i = tid >> 2, part = tid & 3;
    float ss = 0.f;
#pragma unroll 4
    for (int e = part * 32; e < part * 32 + 32; ++e) { float v = sO[i * 132 + e]; ss += v * v; }
    ss += __shfl_xor(ss, 1); ss += __shfl_xor(ss, 2);
    float rstd = rsqrtf(ss * (1.f / 128.f) + EPS);
    if (i < L) {
      size_t ro = (size_t)(it.row0 + i) * 512 + h * 128 + part * 32;
      const float* so = sO + i * 132 + part * 32;
      if (mixer == 0) {
        bfu* y = (bfu*)(P.ws + SLOT(5)) + ro;
        const float* g = P.g_ret_gn + h * 128 + part * 32;
        uint4 gv[4];
#pragma unroll
        for (int k = 0; k < 4; ++k) gv[k] = *(const uint4*)(y + k * 8);
#pragma unroll
        for (int k = 0; k < 4; ++k) {
          float gt[8], o[8];
          unpack8(gv[k], gt);
#pragma unroll
          for (int j = 0; j < 8; ++j) o[j] = gt[j] * sigmoidf_(gt[j]) * so[k * 8 + j] * rstd * g[k * 8 + j];
          *(uint4*)(y + k * 8) = pack8(o);
        }
      } else {
        bfu* y = (bfu*)(P.ws + SLOT(8)) + ro;
        const bfu* cc = (const bfu*)(P.ws + SLOT(0)) + ro;
        const float* g = P.g_ml_gn + h * 128 + part * 32;
        const float* ws = P.w_skip + h * 128 + part * 32;
        uint4 gv[4], cv[4];
#pragma unroll
        for (int k = 0; k < 4; ++k) { gv[k] = *(const uint4*)(y + k * 8); cv[k] = *(const uint4*)(cc + k * 8); }
#pragma unroll
        for (int k = 0; k < 4; ++k) {
          float gt[8], c8[8], o[8];
          unpack8(gv[k], gt); unpack8(cv[k], c8);
#pragma unroll
          for (int j = 0; j < 8; ++j) o[j] = sigmoidf_(gt[j]) * (so[k * 8 + j] * rstd * g[k * 8 + j] + ws[k * 8 + j] * c8[j]);
          *(uint4*)(y + k * 8) = pack8(o);
        }
      }
    }
  }
  __syncthreads();
}

__device__ void phase_merge(const Params& P, char* smem) {
  bfu* sA = (bfu*)smem; bfu* sB = sA + 128 * 72;
  const bfu* yr = (const bfu*)(P.ws + SLOT(5)); const bfu* ym = (const bfu*)(P.ws + SLOT(8));
  const bfu* gr = (const bfu*)(P.ws + SLOT(9)); const bfu* gm = (const bfu*)(P.ws + SLOT(11));
  bfu* mg = (bfu*)(P.ws + SLOT(6));
  for (int t = blockIdx.x; t < 260 * 8; t += gridDim.x) {
    int mt, nt; tile_map(t, 260, 8, mt, nt);
    f32x16 acc[2][2]; zero_acc(acc);
    bfu* sT = (bfu*)smem;
    const size_t tbase = (size_t)mt * 128 * 1024 + nt * 128;
    uint4 t1[8];
    gemm_acc(acc, yr + (size_t)mt * 128 * 512, 512, (const bfu*)(P.ws + O_WT_UPR) + (size_t)nt * 128 * 512, 512, 512, sA, sB);
    __syncthreads();
    stage_rm(sT, acc, 1.f);
    __syncthreads();
#pragma unroll
    for (int i = 0; i < 8; ++i) {
      int id = threadIdx.x + i * 256, row = id >> 4, c8 = (id & 15) * 8;
      float a[8], g[8];
      unpack8(*(const uint4*)(sT + row * ST_LD + c8), a);
      unpack8(*(const uint4*)(gr + tbase + (size_t)row * 1024 + c8), g);
#pragma unroll
      for (int j = 0; j < 8; ++j) a[j] *= sigmoidf_(g[j]);
      t1[i] = pack8(a);
    }
    zero_acc(acc);
    gemm_acc(acc, ym + (size_t)mt * 128 * 512, 512, (const bfu*)(P.ws + O_WT_UPM) + (size_t)nt * 128 * 512, 512, 512, sA, sB);
    __syncthreads();
    stage_rm(sT, acc, 1.f);
    __syncthreads();
#pragma unroll
    for (int i = 0; i < 8; ++i) {
      int id = threadIdx.x + i * 256, row = id >> 4, c8 = (id & 15) * 8;
      float a[8], g[8], t[8];
      unpack8(*(const uint4*)(sT + row * ST_LD + c8), a);
      unpack8(*(const uint4*)(gm + tbase + (size_t)row * 1024 + c8), g);
      unpack8(t1[i], t);
#pragma unroll
      for (int j = 0; j < 8; ++j) a[j] = t[j] + a[j] * sigmoidf_(g[j]);
      *(uint4*)(mg + tbase + (size_t)row * 1024 + c8) = pack8(a);
    }
  }
}

__device__ void phase_outproj(const Params& P, char* smem) {
  bfu* sA = (bfu*)smem; bfu* sB = sA + 128 * 72;
  const bfu* mg = (const bfu*)(P.ws + SLOT(6));
  for (int t = blockIdx.x; t < 260 * 8; t += gridDim.x) {
    int mt, nt; tile_map(t, 260, 8, mt, nt);
    f32x16 acc[2][2]; zero_acc(acc);
    gemm_acc(acc, mg + (size_t)mt * 128 * 1024, 1024, (const bfu*)(P.ws + O_WT_OUT) + (size_t)nt * 128 * 1024, 1024, 1024, sA, sB);
    float* sT32 = (float*)smem;
    __syncthreads();
    {
      EPI_BEGIN
#pragma unroll
        for (int j = 0; j < 4; ++j) {
          sT32[(r0 + j) * ST32_LD + cl] = acc[mi][0][q * 4 + j];
          sT32[(r0 + j) * ST32_LD + cl + 64] = acc[mi][1][q * 4 + j];
        }
      EPI_END
    }
    __syncthreads();
#pragma unroll
    for (int i = 0; i < 16; ++i) {
      int id = threadIdx.x + i * 256, row = id >> 5, c4 = (id & 31) * 4;
      int r = mt * 128 + row;
      float4 a = *(const float4*)(sT32 + row * ST32_LD + c4);
      float4 x = *(const float4*)(xrow(P, r) + nt * 128 + c4);
      *(float4*)(P.out + (size_t)r * 1024 + nt * 128 + c4) = make_float4(x.x + a.x, x.y + a.y, x.z + a.z, x.w + a.w);
    }
  }
}

__device__ void phase_norm_rows(const Params& P, const float* g, bfu* dst) {
  const int lane = threadIdx.x & 63, w = threadIdx.x >> 6;
  for (int r = blockIdx.x * 4 + w; r < MT; r += gridDim.x * 4) {
    const float* xr = P.out + (size_t)r * 1024;
    float4 v[4]; float ss = 0.f;
#pragma unroll
    for (int i = 0; i < 4; ++i) {
      v[i] = *(const float4*)(xr + i * 256 + lane * 4);
      ss += v[i].x * v[i].x + v[i].y * v[i].y + v[i].z * v[i].z + v[i].w * v[i].w;
    }
    ss = wave_sum(ss);
    float rstd = rsqrtf(ss * (1.f / 1024.f) + EPS);
#pragma unroll
    for (int i = 0; i < 4; ++i) {
      float4 gg = *(const float4*)(g + i * 256 + lane * 4);
      uint2 o; o.x = pack2(v[i].x * rstd * gg.x, v[i].y * rstd * gg.y); o.y = pack2(v[i].z * rstd * gg.z, v[i].w * rstd * gg.w);
      *(uint2*)(dst + (size_t)r * 1024 + i * 256 + lane * 4) = o;
    }
  }
}

__device__ void phase_pq(const Params& P, char* smem) {
  bfu* sA = (bfu*)smem; bfu* sB = sA + 128 * 72;
  const bfu* hq = (const bfu*)(P.ws + SLOT(0));
  bfu* qb = (bfu*)(P.ws + SLOT(9));
  for (int t = blockIdx.x; t < 260 * 16; t += gridDim.x) {
    int mt, nt; tile_map(t, 260, 16, mt, nt);
    f32x16 acc[2][2]; zero_acc(acc);
    gemm_acc(acc, hq + (size_t)mt * 128 * 1024, 1024, (const bfu*)(P.ws + O_WT_PQ) + (size_t)nt * 128 * 1024, 1024, 1024, sA, sB);
    bfu* sT = (bfu*)smem;
    __syncthreads();
    stage_rm(sT, acc, 1.f);
    __syncthreads();
    copyout_bf16(sT, qb + (size_t)mt * 128 * 2048 + nt * 128, 2048);
  }
}

__device__ __forceinline__ float pair_max(float v) {
  auto r = __builtin_amdgcn_permlane32_swap(__float_as_int(v), __float_as_int(v), false, false);
  return fmaxf(__int_as_float(r[0]), __int_as_float(r[1]));
}
__device__ void phase_topk(const Params& P, char* smem) {
  const int tid = threadIdx.x, lane = tid & 63, w = tid >> 6, r32 = lane & 31, hh = lane >> 5;
  unsigned* sL = (unsigned*)smem + w * 1664;
  unsigned* sW = sL + 32 * 33;
  const bfu* qb = (const bfu*)(P.ws + SLOT(9));
  const bfu* keys = (const bfu*)(P.ws + O_KEYS);
  int* ids = (int*)(P.ws + SLOT(4));
  float* gw = (float*)(P.ws + SLOT(13));
  for (int item = blockIdx.x * 4 + w; item < 1040 * 8; item += gridDim.x * 4) {
    const int tg = item >> 3, n = item & 7, rowb = tg * 32;
#pragma unroll 1
    for (int half = 0; half < 2; ++half) {
      f32x16 acc[4];
#pragma unroll
      for (int c = 0; c < 4; ++c)
#pragma unroll
        for (int i = 0; i < 16; ++i) acc[c][i] = 0.f;
      const bfu* kp = keys + (size_t)((n * 2 + half) * 128 + r32) * 128 + hh * 8;
      const bfu* qp = qb + (size_t)(rowb + r32) * 2048 + n * 256 + half * 128 + hh * 8;
#pragma unroll
      for (int ks = 0; ks < 8; ++ks) {
        bf16x8 bfr = *(const bf16x8*)(qp + ks * 16);
#pragma unroll
        for (int c = 0; c < 4; ++c) {
          bf16x8 af = *(const bf16x8*)(kp + (size_t)c * 32 * 128 + ks * 16);
          acc[c] = __builtin_amdgcn_mfma_f32_32x32x16_bf16(af, bfr, acc[c], 0, 0, 0);
        }
      }
      float kk[64];
#pragma unroll
      for (int c = 0; c < 4; ++c)
#pragma unroll
        for (int reg = 0; reg < 16; ++reg) {
          unsigned kidx = c * 32 + (reg & 3) + 8 * (reg >> 2) + 4 * hh;
          kk[c * 16 + reg] = __uint_as_float((__float_as_uint(acc[c][reg]) & ~127u) | kidx);
        }
      float prev = INFINITY;
#pragma unroll 1
      for (int p = 0; p < 16; ++p) {
        float cur = -INFINITY;
#pragma unroll
        for (int t = 0; t < 64; ++t) cur = fmaxf(cur, kk[t] < prev ? kk[t] : -INFINITY);
        cur = pair_max(cur);
        if (hh == 0) sL[r32 * 33 + half * 16 + p] = __float_as_uint(cur);
        prev = cur;
      }
    }
    __builtin_amdgcn_fence(__ATOMIC_RELEASE, "workgroup");
    __builtin_amdgcn_wave_barrier();
    __builtin_amdgcn_fence(__ATOMIC_ACQUIRE, "workgroup");
    float x[4], y[16];
    {
      const unsigned* lx = sL + r32 * 33 + (hh ? 16 : 0);
      const unsigned* ly = sL + r32 * 33 + (hh ? 0 : 16);
#pragma unroll
      for (int i = 0; i < 4; ++i) x[i] = __uint_as_float(lx[i] & ~127u);
#pragma unroll
      for (int j = 0; j < 16; ++j) y[j] = __uint_as_float(ly[j] & ~127u);
    }
    float cd[25];
#define CAND(t, i, j) { float sv = x[i] + y[j]; unsigned code = hh ? ((j) << 4 | (i)) : ((i) << 4 | (j)); \
      cd[t] = __uint_as_float((__float_as_uint(sv) & ~255u) | code); }
    CAND(0, 0, 1) CAND(1, 0, 2) CAND(2, 0, 3) CAND(3, 0, 4) CAND(4, 0, 5) CAND(5, 0, 6) CAND(6, 0, 7) CAND(7, 0, 8)
    CAND(8, 0, 9) CAND(9, 0, 10) CAND(10, 0, 11) CAND(11, 0, 12) CAND(12, 0, 13) CAND(13, 0, 14) CAND(14, 0, 15)
    CAND(15, 1, 2) CAND(16, 1, 3) CAND(17, 1, 4) CAND(18, 1, 5) CAND(19, 1, 6) CAND(20, 1, 7) CAND(21, 2, 3) CAND(22, 2, 4)
    {
      float d0 = hh ? x[2] + y[2] : x[0] + y[0];
      float d1 = hh ? x[3] + y[3] : x[1] + y[1];
      unsigned c0 = hh ? 0x22u : 0x00u, c1 = hh ? 0x33u : 0x11u;
      cd[23] = __uint_as_float((__float_as_uint(d0) & ~255u) | c0);
      cd[24] = __uint_as_float((__float_as_uint(d1) & ~255u) | c1);
    }
    {
      float prev = INFINITY;
#pragma unroll 1
      for (int p = 0; p < 16; ++p) {
        float cur = -INFINITY;
#pragma unroll
        for (int t = 0; t < 25; ++t) cur = fmaxf(cur, cd[t] < prev ? cd[t] : -INFINITY);
        cur = pair_max(cur);
        if (hh == 0) sW[r32 * 17 + p] = __float_as_uint(cur);
        prev = cur;
      }
    }
    __builtin_amdgcn_fence(__ATOMIC_RELEASE, "workgroup");
    __builtin_amdgcn_wave_barrier();
    __builtin_amdgcn_fence(__ATOMIC_ACQUIRE, "workgroup");
    {
      const unsigned* la = sL + r32 * 33;
      unsigned c0 = sW[r32 * 17] & 255u;
      float scmax = __uint_as_float(la[c0 >> 4] & ~127u) + __uint_as_float(la[16 + (c0 & 15)] & ~127u);
      float ex[8]; int ee[8]; float sum = 0.f;
#pragma unroll
      for (int k = 0; k < 8; ++k) {
        unsigned code = sW[r32 * 17 + hh * 8 + k] & 255u;
        unsigned ka = la[code >> 4], kb = la[16 + (code & 15)];
        float sc = __uint_as_float(ka & ~127u) + __uint_as_float(kb & ~127u);
        ex[k] = __expf(sc - scmax);
        ee[k] = (int)((ka & 127u) * 128u + (kb & 127u));
        sum += ex[k];
      }
      sum += __shfl_xor(sum, 32);
      float inv = 1.f / sum;
      size_t o = (size_t)(rowb + r32) * 128 + n * 16 + hh * 8;
      *(int4*)(ids + o) = make_int4(ee[0], ee[1], ee[2], ee[3]);
      *(int4*)(ids + o + 4) = make_int4(ee[4], ee[5], ee[6], ee[7]);
      *(float4*)(gw + o) = make_float4(ex[0] * inv, ex[1] * inv, ex[2] * inv, ex[3] * inv);
      *(float4*)(gw + o + 4) = make_float4(ex[4] * inv, ex[5] * inv, ex[6] * inv, ex[7] * inv);
    }
    __builtin_amdgcn_wave_barrier();
  }
}

typedef float f2v __attribute__((ext_vector_type(2)));
#define U8_SCALE 512.f
#define V8_SCALE 128.f
__device__ void convert_fp8(const float* __restrict__ src, unsigned char* __restrict__ dst, size_t n16, float scale,
                            int gtid, int gstride) {
  for (size_t i = gtid; i < n16; i += gstride) {
    unsigned w[4];
#pragma unroll
    for (int k = 0; k < 4; ++k) {
      float4 a = *(const float4*)(src + i * 16 + k * 4);
      float v0 = fminf(fmaxf(a.x * scale, -448.f), 448.f), v1 = fminf(fmaxf(a.y * scale, -448.f), 448.f);
      float v2 = fminf(fmaxf(a.z * scale, -448.f), 448.f), v3 = fminf(fmaxf(a.w * scale, -448.f), 448.f);
      int t = 0;
      t = __builtin_amdgcn_cvt_pk_fp8_f32(v0, v1, t, false);
      t = __builtin_amdgcn_cvt_pk_fp8_f32(v2, v3, t, true);
      w[k] = (unsigned)t;
    }
    *(uint4*)(dst + i * 16) = make_uint4(w[0], w[1], w[2], w[3]);
  }
}
__device__ __forceinline__ float dot16_fp8(uint4 u, const f2v* x2) {
  f2v acc = __builtin_amdgcn_cvt_pk_f32_fp8((int)u.x, false) * x2[0];
  acc += __builtin_amdgcn_cvt_pk_f32_fp8((int)u.x, true) * x2[1];
  acc += __builtin_amdgcn_cvt_pk_f32_fp8((int)u.y, false) * x2[2];
  acc += __builtin_amdgcn_cvt_pk_f32_fp8((int)u.y, true) * x2[3];
  acc += __builtin_amdgcn_cvt_pk_f32_fp8((int)u.z, false) * x2[4];
  acc += __builtin_amdgcn_cvt_pk_f32_fp8((int)u.z, true) * x2[5];
  acc += __builtin_amdgcn_cvt_pk_f32_fp8((int)u.w, false) * x2[6];
  acc += __builtin_amdgcn_cvt_pk_f32_fp8((int)u.w, true) * x2[7];
  return acc.x + acc.y;
}
__device__ __forceinline__ void axpy16_fp8(f2v* o2, float cf, uint4 v) {
  f2v c = {cf, cf};
  o2[0] += c * __builtin_amdgcn_cvt_pk_f32_fp8((int)v.x, false);
  o2[1] += c * __builtin_amdgcn_cvt_pk_f32_fp8((int)v.x, true);
  o2[2] += c * __builtin_amdgcn_cvt_pk_f32_fp8((int)v.y, false);
  o2[3] += c * __builtin_amdgcn_cvt_pk_f32_fp8((int)v.y, true);
  o2[4] += c * __builtin_amdgcn_cvt_pk_f32_fp8((int)v.z, false);
  o2[5] += c * __builtin_amdgcn_cvt_pk_f32_fp8((int)v.z, true);
  o2[6] += c * __builtin_amdgcn_cvt_pk_f32_fp8((int)v.w, false);
  o2[7] += c * __builtin_amdgcn_cvt_pk_f32_fp8((int)v.w, true);
}
#define PEER_LOAD(u, v, b)                                                                   \
  _Pragma("unroll") for (int k = 0; k < 8; ++k) {                                            \
    int j = (b) * 8 + k;                                                                     \
    int e = __builtin_amdgcn_readlane((b) < 8 ? id0 : id1, j & 63);                          \
    u[k] = *(const uint4*)(U8 + (size_t)e * 1024 + lane * 16);                               \
    v[k] = *(const uint4*)(V8 + (size_t)e * 1024 + lane * 16);                               \
  }
#define PEER_COMP(u, v, b)                                                                   \
  _Pragma("unroll") for (int hf = 0; hf < 2; ++hf) {                                         \
    float s = reduce4(dot16_fp8(u[hf * 4 + 0], x2), dot16_fp8(u[hf * 4 + 1], x2),           \
                      dot16_fp8(u[hf * 4 + 2], x2), dot16_fp8(u[hf * 4 + 3], x2)) * (1.f / U8_SCALE); \
    float act = 0.5f * s * (1.f + erff(s * 0.7071067811865475f));                            \
    float gsel = __shfl((b) < 8 ? g0 : g1, ((b) * 8 + hf * 4 + (lane >> 4)) & 63);           \
    float cfv = act * gsel * (1.f / V8_SCALE);                                               \
    axpy16_fp8(o2, __int_as_float(__builtin_amdgcn_readlane(__float_as_int(cfv), 0)), v[hf * 4 + 0]);  \
    axpy16_fp8(o2, __int_as_float(__builtin_amdgcn_readlane(__float_as_int(cfv), 16)), v[hf * 4 + 1]); \
    axpy16_fp8(o2, __int_as_float(__builtin_amdgcn_readlane(__float_as_int(cfv), 32)), v[hf * 4 + 2]); \
    axpy16_fp8(o2, __int_as_float(__builtin_amdgcn_readlane(__float_as_int(cfv), 48)), v[hf * 4 + 3]); \
  }
__device__ void phase_peer(const Params& P) {
  const int lane = threadIdx.x & 63, w = threadIdx.x >> 6;
  bfu* hq = (bfu*)(P.ws + SLOT(0));
  const unsigned char* U8 = (const unsigned char*)(P.ws + SLOT(2));
  const unsigned char* V8 = (const unsigned char*)(P.ws + SLOT(3));
  const int* ids = (const int*)(P.ws + SLOT(4));
  const float* gw = (const float*)(P.ws + SLOT(13));
  bfu* pbf = (bfu*)(P.ws + SLOT(6));
  for (int r = blockIdx.x * 4 + w; r < MT; r += gridDim.x * 4) {
    f2v x2[8], o2[8];
    {
      uint4 v0 = *(const uint4*)(hq + (size_t)r * 1024 + lane * 16);
      uint4 v1 = *(const uint4*)(hq + (size_t)r * 1024 + lane * 16 + 8);
      float xf[16];
      unpack8(v0, xf); unpack8(v1, xf + 8);
#pragma unroll
      for (int j = 0; j < 8; ++j) { x2[j].x = xf[2 * j]; x2[j].y = xf[2 * j + 1]; o2[j].x = 0.f; o2[j].y = 0.f; }
    }
    int id0 = ids[(size_t)r * 128 + lane], id1 = ids[(size_t)r * 128 + 64 + lane];
    float g0 = gw[(size_t)r * 128 + lane], g1 = gw[(size_t)r * 128 + 64 + lane];
    uint4 uA[8], vA[8], uB[8], vB[8];
    PEER_LOAD(uA, vA, 0)
    for (int b = 0; b < 16; b += 2) {
      PEER_LOAD(uB, vB, b + 1)
      PEER_COMP(uA, vA, b)
      if (b + 2 < 16) { PEER_LOAD(uA, vA, b + 2) }
      PEER_COMP(uB, vB, b + 1)
    }
    float* xr = P.out + (size_t)r * 1024 + lane * 16;
    float x3[16];
    float ss = 0.f;
#pragma unroll
    for (int k = 0; k < 4; ++k) {
      float4 a = *(const float4*)(xr + k * 4);
      x3[k * 4 + 0] = a.x + o2[k * 2].x; x3[k * 4 + 1] = a.y + o2[k * 2].y;
      x3[k * 4 + 2] = a.z + o2[k * 2 + 1].x; x3[k * 4 + 3] = a.w + o2[k * 2 + 1].y;
      *(float4*)(xr + k * 4) = make_float4(x3[k * 4], x3[k * 4 + 1], x3[k * 4 + 2], x3[k * 4 + 3]);
    }
#pragma unroll
    for (int j = 0; j < 16; ++j) ss += x3[j] * x3[j];
    ss = wave_sum(ss);
    float rstd = rsqrtf(ss * (1.f / 1024.f) + EPS);
    float hv[16];
#pragma unroll
    for (int k = 0; k < 4; ++k) {
      float4 ga = *(const float4*)(P.g_ple + lane * 16 + k * 4);
      hv[k * 4] = x3[k * 4] * rstd * ga.x; hv[k * 4 + 1] = x3[k * 4 + 1] * rstd * ga.y;
      hv[k * 4 + 2] = x3[k * 4 + 2] * rstd * ga.z; hv[k * 4 + 3] = x3[k * 4 + 3] * rstd * ga.w;
    }
    *(uint4*)(hq + (size_t)r * 1024 + lane * 16) = pack8(hv);
    *(uint4*)(hq + (size_t)r * 1024 + lane * 16 + 8) = pack8(hv + 8);
    {
      const float* pr = r < MP ? P.pp + (size_t)r * 256 : P.ps + (size_t)(r - MP) * 256;
      float4 a = *(const float4*)(pr + lane * 4);
      uint2 ov; ov.x = pack2(a.x, a.y); ov.y = pack2(a.z, a.w);
      *(uint2*)(pbf + (size_t)r * 256 + lane * 4) = ov;
    }
  }
}

__device__ void phase_ple(const Params& P, char* smem) {
  bfu* sA = (bfu*)smem; bfu* sB = sA + 128 * 72;
  const bfu* hg = (const bfu*)(P.ws + SLOT(0));
  const bfu* pbf = (const bfu*)(P.ws + SLOT(6));
  for (int t = blockIdx.x; t < 260 * 8; t += gridDim.x) {
    int mt, nt; tile_map(t, 260, 8, mt, nt);
    f32x16 acc[2][2]; zero_acc(acc);
    bfu* sT = (bfu*)smem; float* sT32 = (float*)smem;
    uint2 pg[16];
    gemm_acc(acc, hg + (size_t)mt * 128 * 1024, 1024, (const bfu*)(P.ws + O_WT_PG) + (size_t)nt * 128 * 1024, 1024, 1024, sA, sB);
    __syncthreads();
    {
      EPI_BEGIN
#pragma unroll
        for (int j = 0; j < 4; ++j) {
          sT[(r0 + j) * ST_LD + cl] = f2bf(sigmoidf_(acc[mi][0][q * 4 + j]));
          sT[(r0 + j) * ST_LD + cl + 64] = f2bf(sigmoidf_(acc[mi][1][q * 4 + j]));
        }
      EPI_END
    }
    __syncthreads();
#pragma unroll
    for (int i = 0; i < 16; ++i) {
      int id = threadIdx.x + i * 256, row = id >> 5, c4 = (id & 31) * 4;
      pg[i] = *(const uint2*)(sT + row * ST_LD + c4);
    }
    zero_acc(acc);
    gemm_acc(acc, pbf + (size_t)mt * 128 * 256, 256, (const bfu*)(P.ws + O_WT_PLE) + (size_t)nt * 128 * 256, 256, 256, sA, sB);
    __syncthreads();
    {
      EPI_BEGIN
#pragma unroll
        for (int j = 0; j < 4; ++j) {
          sT32[(r0 + j) * ST32_LD + cl] = acc[mi][0][q * 4 + j];
          sT32[(r0 + j) * ST32_LD + cl + 64] = acc[mi][1][q * 4 + j];
        }
      EPI_END
    }
    __syncthreads();
#pragma unroll
    for (int i = 0; i < 16; ++i) {
      int id = threadIdx.x + i * 256, row = id >> 5, c4 = (id & 31) * 4;
      float4 a = *(const float4*)(sT32 + row * ST32_LD + c4);
      float* op = P.out + (size_t)(mt * 128 + row) * 1024 + nt * 128 + c4;
      float4 x = *(const float4*)op;
      float g0 = bf2f(pg[i].x & 0xffff), g1 = bf2f(pg[i].x >> 16), g2 = bf2f(pg[i].y & 0xffff), g3 = bf2f(pg[i].y >> 16);
      *(float4*)op = make_float4(x.x + a.x * g0, x.y + a.y * g1, x.z + a.z * g2, x.w + a.w * g3);
    }
  }
}

__device__ void phase_final(const Params& P) {
  const int lane = threadIdx.x & 63, w = threadIdx.x >> 6;
  for (int r = blockIdx.x * 4 + w; r < MT; r += gridDim.x * 4) {
    float* xr = P.out + (size_t)r * 1024;
    float4 v[4]; float ss = 0.f;
#pragma unroll
    for (int i = 0; i < 4; ++i) {
      v[i] = *(const float4*)(xr + i * 256 + lane * 4);
      ss += v[i].x * v[i].x + v[i].y * v[i].y + v[i].z * v[i].z + v[i].w * v[i].w;
    }
    ss = wave_sum(ss);
    float rstd = rsqrtf(ss * (1.f / 1024.f) + EPS);
#pragma unroll
    for (int i = 0; i < 4; ++i) {
      float4 gg = *(const float4*)(P.g_final + i * 256 + lane * 4);
      *(float4*)(xr + i * 256 + lane * 4) = make_float4(v[i].x * rstd * gg.x, v[i].y * rstd * gg.y, v[i].z * rstd * gg.z, v[i].w * rstd * gg.w);
    }
  }
}

__global__ void __launch_bounds__(NTHREADS, 2) fwd_megakernel(Params P) {
  extern __shared__ __attribute__((aligned(16))) char smem[];
  cg::grid_group grid = cg::this_grid();
  __shared__ uint4 xb_words;
  if (threadIdx.x == 0) xb_words = make_uint4(0u, 0u, 0u, 0u);
  __syncthreads();
  XcdBarrier xb = xcd_barrier_post((unsigned*)(P.ws + O_BAR), (volatile LAS unsigned*)&xb_words);
  if (P.out == nullptr) grid.sync();
  const int gtid = blockIdx.x * NTHREADS + threadIdx.x, gstride = gridDim.x * NTHREADS;
  phase_prep(P, smem);
  xcd_barrier(xb);
  phase_gemm1(P, smem);
  xcd_barrier(xb);
  phase_conv(P);
  gate_scan(P);
  xcd_barrier(xb);
  m_fold(P);
  phase_mqk(P, smem);
  xcd_barrier(xb);
  for (int t = blockIdx.x; t < 4224; t += gridDim.x) phaseA_item(P, t / 2112, t % 2112, smem);
  xcd_barrier(xb);
  phase_scan(P);
  xcd_barrier(xb);
  for (int t = blockIdx.x; t < 4224; t += gridDim.x) phaseC_item(P, t / 2112, t % 2112, smem);
  xcd_barrier(xb);
  phase_merge(P, smem);
  xcd_barrier(xb);
  phase_outproj(P, smem);
  xcd_barrier(xb);
  phase_norm_rows(P, P.g_ffn, (bfu*)(P.ws + SLOT(0)));
  convert_fp8(P.peer_u, (unsigned char*)(P.ws + SLOT(2)), 16384ull * 1024 / 16, U8_SCALE, gtid, gstride);
  convert_fp8(P.peer_v, (unsigned char*)(P.ws + SLOT(3)), 16384ull * 1024 / 16, V8_SCALE, gtid, gstride);
  xcd_barrier(xb);
  phase_pq(P, smem);
  xcd_barrier(xb);
  phase_topk(P, smem);
  xcd_barrier(xb);
  phase_peer(P);
  xcd_barrier(xb);
  phase_ple(P, smem);
  xcd_barrier(xb);
  phase_final(P);
}

extern "C" void kernel_launch(void* const* d_in, const int* in_sizes, int n_in, void* d_out, int out_size,
                              void* d_ws, size_t ws_size, hipStream_t stream) {
  static int grid_blocks = 0;
  if (!grid_blocks) {
    hipFuncSetAttribute((const void*)fwd_megakernel, hipFuncAttributeMaxDynamicSharedMemorySize, SMEM_BYTES);
    int dev = 0, cus = 0, per_cu = 0;
    hipGetDevice(&dev);
    hipDeviceGetAttribute(&cus, hipDeviceAttributeMultiprocessorCount, dev);
    hipOccupancyMaxActiveBlocksPerMultiprocessor(&per_cu, fwd_megakernel, NTHREADS, SMEM_BYTES);
    if (per_cu > 2) per_cu = 2;
    if (per_cu < 1) per_cu = 1;
    grid_blocks = cus * per_cu;
  }
  Params p{};
  const float** pf = (const float**)&p;
  for (int i = 0; i < 32; ++i) pf[i] = (const float*)d_in[i];
  p.out = (float*)d_out;
  p.ws = (char*)d_ws;
  hipMemsetAsync((char*)d_ws + O_BAR, 0, XCD_BAR_WORDS * 4, stream);
  void* args[] = {&p};
  hipError_t e = hipLaunchCooperativeKernel((void*)fwd_megakernel, dim3(grid_blocks), dim3(NTHREADS), args, SMEM_BYTES, stream);
  if (e != hipSuccess) fprintf(stderr, "cooperative launch failed: %s (grid %d)\n", hipGetErrorString(e), grid_blocks);
}
```

```cpp
#include <hip/hip_runtime.h>
#include <hip/hip_cooperative_groups.h>
#include <cstdio>
namespace cg = cooperative_groups;

typedef unsigned short bfu;
typedef __attribute__((ext_vector_type(8))) short bf16x8;
typedef __attribute__((ext_vector_type(16))) float f32x16;

#define MT 33280
#define MP 32768
#define NTHREADS 256
#define EPS 1e-6f

struct Params {
  const float *xp, *xs, *pp, *ps, *st_ret, *st_C, *st_n, *st_m, *st_conv, *g_mix, *w_in, *g_ret_gn, *w_mq,
      *w_mk, *conv_w, *conv_b, *b_i, *b_f, *g_ml_gn, *w_skip, *w_up_r, *w_up_m, *w_out, *g_ffn, *w_pq,
      *peer_keys, *peer_u, *peer_v, *g_ple, *w_pg, *w_ple, *g_final;
  float* out;
  char* ws;
};

constexpr size_t O_WT_IN = 0;
constexpr size_t O_WT_UPR = O_WT_IN + 5632ull * 1024 * 2;
constexpr size_t O_WT_UPM = O_WT_UPR + 1024ull * 512 * 2;
constexpr size_t O_WT_OUT = O_WT_UPM + 1024ull * 512 * 2;
constexpr size_t O_WT_PQ = O_WT_OUT + 1024ull * 1024 * 2;
constexpr size_t O_WT_PG = O_WT_PQ + 2048ull * 1024 * 2;
constexpr size_t O_WT_PLE = O_WT_PG + 1024ull * 1024 * 2;
constexpr size_t O_KEYS = O_WT_PLE + 1024ull * 256 * 2;
constexpr size_t O_WT_MQ = O_KEYS + 16ull * 128 * 128 * 2;
constexpr size_t O_WT_MK = O_WT_MQ + 4ull * 128 * 128 * 2;
constexpr size_t O_COS = O_WT_MK + 4ull * 128 * 128 * 2;
constexpr size_t O_SIN = O_COS + 8192ull * 64 * 4;
constexpr size_t O_FQ = O_SIN + 8192ull * 64 * 4;
constexpr size_t O_UQ = O_FQ + (size_t)MT * 16;
constexpr size_t O_CMQ = O_UQ + (size_t)MT * 16;
constexpr size_t O_FL = O_CMQ + (size_t)MT * 16;
constexpr size_t O_UC = O_FL + 16384;
constexpr size_t O_AEND = O_UC + 16384;
constexpr size_t O_MCS = O_AEND + 16384;
constexpr size_t O_DN = O_MCS + 16384;
constexpr size_t O_DSS = O_DN + 2112ull * 128 * 4;
constexpr size_t O_GPRE = O_DSS + 2ull * 64 * 16384 * 2;
constexpr size_t O_BAR = O_GPRE + (size_t)MT * 32;
constexpr size_t O_SMALL_END = O_BAR + 16384;
constexpr size_t SLOT0 = 40ull << 20;
constexpr size_t USZ = (size_t)MT * 512 * 2;
static_assert(O_SMALL_END <= SLOT0, "small region overflow");
#define SLOT(i) (SLOT0 + (size_t)(i) * USZ)
constexpr size_t SB_T = 16ull * 128 * 8192;

constexpr size_t OO_Y = 0;
constexpr size_t OO_RETP = (size_t)MT * 1024;
constexpr size_t OO_CP = OO_RETP + 262144;
constexpr size_t OO_NP = OO_CP + 262144;
constexpr size_t OO_MP = OO_NP + 2048;
constexpr size_t OO_CONVP = OO_MP + 16;
constexpr size_t OO_RETS = OO_CONVP + 6144;
constexpr size_t OO_CS = OO_RETS + 1048576;
constexpr size_t OO_NS = OO_CS + 1048576;
constexpr size_t OO_MS = OO_NS + 8192;
constexpr size_t OO_CONVS = OO_MS + 64;

constexpr int SMEM_BYTES = 81152;

__device__ __forceinline__ bfu f2bf(float f) {
  unsigned u = __float_as_uint(f);
  u += 0x7fffu + ((u >> 16) & 1u);
  return (bfu)(u >> 16);
}
__device__ __forceinline__ float bf2f(bfu b) { return __uint_as_float(((unsigned)b) << 16); }
__device__ __forceinline__ unsigned pack2(float a, float b) { return (unsigned)f2bf(a) | ((unsigned)f2bf(b) << 16); }
__device__ __forceinline__ void unpack8(uint4 v, float* f) {
  f[0] = bf2f(v.x & 0xffff); f[1] = bf2f(v.x >> 16); f[2] = bf2f(v.y & 0xffff); f[3] = bf2f(v.y >> 16);
  f[4] = bf2f(v.z & 0xffff); f[5] = bf2f(v.z >> 16); f[6] = bf2f(v.w & 0xffff); f[7] = bf2f(v.w >> 16);
}
__device__ __forceinline__ uint4 pack8(const float* f) {
  uint4 o; o.x = pack2(f[0], f[1]); o.y = pack2(f[2], f[3]); o.z = pack2(f[4], f[5]); o.w = pack2(f[6], f[7]);
  return o;
}
__device__ __forceinline__ float wave_sum(float v) {
#pragma unroll
  for (int o = 32; o > 0; o >>= 1) v += __shfl_xor(v, o);
  return v;
}
__device__ __forceinline__ float wave_max(float v) {
#pragma unroll
  for (int o = 32; o > 0; o >>= 1) v = fmaxf(v, __shfl_xor(v, o));
  return v;
}
__device__ __forceinline__ float dpp_ror_add(float s, const int ctrl_sel) {
  int v = __float_as_int(s);
  int t;
  if (ctrl_sel == 8) t = __builtin_amdgcn_update_dpp(0, v, 0x128, 0xf, 0xf, false);
  else if (ctrl_sel == 4) t = __builtin_amdgcn_update_dpp(0, v, 0x124, 0xf, 0xf, false);
  else if (ctrl_sel == 2) t = __builtin_amdgcn_update_dpp(0, v, 0x122, 0xf, 0xf, false);
  else t = __builtin_amdgcn_update_dpp(0, v, 0x121, 0xf, 0xf, false);
  return s + __int_as_float(t);
}
__device__ __forceinline__ float reduce4(float p0, float p1, float p2, float p3) {
  auto r = __builtin_amdgcn_permlane32_swap(__float_as_int(p0), __float_as_int(p2), false, false);
  float sA = __int_as_float(r[0]) + __int_as_float(r[1]);
  r = __builtin_amdgcn_permlane32_swap(__float_as_int(p1), __float_as_int(p3), false, false);
  float sB = __int_as_float(r[0]) + __int_as_float(r[1]);
  r = __builtin_amdgcn_permlane16_swap(__float_as_int(sA), __float_as_int(sB), false, false);
  float s = __int_as_float(r[0]) + __int_as_float(r[1]);
  s = dpp_ror_add(s, 8); s = dpp_ror_add(s, 4); s = dpp_ror_add(s, 2); s = dpp_ror_add(s, 1);
  return s;
}
__device__ __forceinline__ float sigmoidf_(float x) { return 1.f / (1.f + __expf(-x)); }
__device__ __forceinline__ const float* xrow(const Params& P, int r) {
  return r < MP ? P.xp + (size_t)r * 1024 : P.xs + (size_t)(r - MP) * 1024;
}


#define XB_TMO      128
#define XB_XCNT(j)  (256  + 64 * (j))
#define XB_XSUB(j)  (1280 + 64 * (j))
#define XB_XGEN(j)  (2304 + 64 * (j))
#define XB_TOP      3328
#define XB_TOPGEN   3392
#define XCD_BAR_WORDS 3456
#define XB_SPIN_CAP (1u << 22)
#define LAS __attribute__((address_space(3)))
__device__ __forceinline__ unsigned xb_ld(unsigned* p) { return __hip_atomic_load(p, __ATOMIC_RELAXED, __HIP_MEMORY_SCOPE_AGENT); }
__device__ __forceinline__ unsigned xb_add(unsigned* p, unsigned v) { return __hip_atomic_fetch_add(p, v, __ATOMIC_RELAXED, __HIP_MEMORY_SCOPE_AGENT); }
__device__ __forceinline__ unsigned xb_xcc_id() { return (unsigned)__builtin_amdgcn_s_getreg((3 << 11) | 20) & 0xFu; }
#define XB_SPIN(cond, bar) do { unsigned _sp = 0; while (cond) { __builtin_amdgcn_s_sleep(1); \
    if ((++_sp & 255u) == 0u) { if (xb_ld(&(bar)[XB_TMO])) break; if (_sp > XB_SPIN_CAP) { atomicAdd(&(bar)[XB_TMO], 1u); break; } } } } while (0)
struct XcdBarrier { unsigned* bar; unsigned x; volatile LAS unsigned* st; };
__device__ __forceinline__ XcdBarrier xcd_barrier_post(unsigned* bar, volatile LAS unsigned* st) {
  XcdBarrier b; b.bar = bar; b.x = xb_xcc_id(); b.st = st;
  if (threadIdx.x == 0) (void)xb_add(&bar[XB_XCNT(b.x)], 1u);
  return b;
}
__device__ __forceinline__ void xcd_barrier_complete(unsigned* bar, unsigned x, unsigned& nloc, unsigned& nx) {
  const unsigned G = gridDim.x * gridDim.y * gridDim.z;
  unsigned sum, cnt, mine, sp = 0u;
  for (;;) {
    sum = 0u; cnt = 0u; mine = 0u;
#pragma unroll
    for (unsigned j = 0; j < 16; ++j) { const unsigned c = xb_ld(&bar[XB_XCNT(j)]); sum += c; cnt += (c > 0u) ? 1u : 0u; mine = (j == x) ? c : mine; }
    if (sum == G) break;
    __builtin_amdgcn_s_sleep(1);
    if ((++sp & 255u) == 0u) { if (xb_ld(&bar[XB_TMO])) break; if (sp > XB_SPIN_CAP) { atomicAdd(&bar[XB_TMO], 1u); break; } }
  }
  nloc = mine > 0u ? mine : 1u; nx = cnt > 0u ? cnt : 1u;
}
__device__ __forceinline__ void xcd_barrier(const XcdBarrier& b) {
  asm volatile("s_waitcnt vmcnt(0)" ::: "memory");
  __syncthreads();
  if (threadIdx.x == 0) {
    unsigned* bar = b.bar;
    __builtin_amdgcn_s_waitcnt(0);
    unsigned nloc = b.st[0], nx = b.st[1];
    if (nloc == 0u) { xcd_barrier_complete(bar, b.x, nloc, nx); b.st[0] = nloc; b.st[1] = nx; }
    const unsigned old = xb_add(&bar[XB_XSUB(b.x)], 1u);
    const unsigned gen = old / nloc;
    if (old + 1u == (gen + 1u) * nloc) {
      __builtin_amdgcn_fence(__ATOMIC_RELEASE, "agent");
      asm volatile("s_waitcnt vmcnt(0)" ::: "memory");
      const unsigned og = xb_add(&bar[XB_TOP], 1u);
      const unsigned tg = og / nx;
      if (og + 1u == (tg + 1u) * nx) xb_add(&bar[XB_TOPGEN], 1u);
      else XB_SPIN(xb_ld(&bar[XB_TOPGEN]) == tg, bar);
      __builtin_amdgcn_fence(__ATOMIC_ACQUIRE, "agent");
      xb_add(&bar[XB_XGEN(b.x)], 1u);
      asm volatile("s_waitcnt vmcnt(0)" ::: "memory");
    } else {
      XB_SPIN(xb_ld(&bar[XB_XGEN(b.x)]) == gen, bar);
      __builtin_amdgcn_fence(__ATOMIC_ACQUIRE, "agent");
      asm volatile("s_waitcnt vmcnt(0)" ::: "memory");
    }
  }
  __syncthreads();
}

__device__ __forceinline__ void gemm_acc(f32x16 (&acc)[2][2], const bfu* __restrict__ A, int lda,
                                         const bfu* __restrict__ Bt, int ldb, int K, bfu* sA, bfu*  ) {
  const int tid = threadIdx.x, lane = tid & 63, w = tid >> 6, wm = w & 1, wn = w >> 1;
  const int lr = tid >> 3;
  const int kc = ((tid & 7) ^ ((tid >> 4) & 7)) * 8;
  const bfu* Ap = A + (size_t)lr * lda + kc;
  const bfu* Bp = Bt + (size_t)lr * ldb + kc;
  const size_t a32 = (size_t)32 * lda, b32 = (size_t)32 * ldb;
  char* sbase = (char*)sA;
  char* ldst = sbase + tid * 16;
#define GISSUE(stage, k)                                                                                       \
  _Pragma("unroll") for (int i_ = 0; i_ < 4; ++i_) {                                                           \
    __builtin_amdgcn_global_load_lds((const unsigned*)(Ap + i_ * a32 + (k)),                                   \
                                     (LAS unsigned*)(ldst + (stage) * 32768 + i_ * 4096), 16, 0, 0);           \
    __builtin_amdgcn_global_load_lds((const unsigned*)(Bp + i_ * b32 + (k)),                                   \
                                     (LAS unsigned*)(ldst + (stage) * 32768 + 16384 + i_ * 4096), 16, 0, 0);   \
  }
  const int sw = (lane >> 1) & 7, hh = lane >> 5;
  const int rowA = (wm * 64 + (lane & 31)) * 128, rowB = (wn * 32 + (lane & 31)) * 128;
  __syncthreads();
  GISSUE(0, 0)
  int cur = 0;
  for (int k0 = 0; k0 < K; k0 += 64) {
    asm volatile("s_waitcnt vmcnt(0)" ::: "memory");
    __syncthreads();
    if (k0 + 64 < K) { GISSUE(cur ^ 1, k0 + 64) }
    const char* cA = sbase + cur * 32768;
    const char* cB = cA + 16384;
#pragma unroll
    for (int ks = 0; ks < 4; ++ks) {
      const int pos = ((2 * ks + hh) ^ sw) * 16;
      bf16x8 af[2], bfr[2];
#pragma unroll
      for (int mi = 0; mi < 2; ++mi) af[mi] = *(const bf16x8*)(cA + rowA + mi * 32 * 128 + pos);
#pragma unroll
      for (int ni = 0; ni < 2; ++ni) bfr[ni] = *(const bf16x8*)(cB + rowB + ni * 64 * 128 + pos);
#pragma unroll
      for (int mi = 0; mi < 2; ++mi)
#pragma unroll
        for (int ni = 0; ni < 2; ++ni)
          acc[mi][ni] = __builtin_amdgcn_mfma_f32_32x32x16_bf16(af[mi], bfr[ni], acc[mi][ni], 0, 0, 0);
    }
    cur ^= 1;
  }
}
#define gemm_acc1 gemm_acc
__device__ __forceinline__ void zero_acc(f32x16 (&acc)[2][2]) {
#pragma unroll
  for (int a = 0; a < 2; ++a)
#pragma unroll
    for (int b = 0; b < 2; ++b)
#pragma unroll
      for (int i = 0; i < 16; ++i) acc[a][b][i] = 0.f;
}
#define EPI_BEGIN                                                      \
  const int e_lane = threadIdx.x & 63, e_w = threadIdx.x >> 6;         \
  const int e_wm = e_w & 1, e_wn = e_w >> 1;                            \
  const int cl = e_wn * 32 + (e_lane & 31);                             \
  _Pragma("unroll") for (int mi = 0; mi < 2; ++mi)                      \
  _Pragma("unroll") for (int q = 0; q < 4; ++q) {                       \
    const int r0 = e_wm * 64 + mi * 32 + q * 8 + 4 * (e_lane >> 5);
#define EPI_END }

#define ST_LD 136
#define ST32_LD 132
__device__ __forceinline__ void copyout_bf16(const bfu* sT, bfu* dst, int ld) {
  const int tid = threadIdx.x;
#pragma unroll
  for (int i = 0; i < 8; ++i) {
    int id = tid + i * 256, row = id >> 4, c8 = (id & 15) * 8;
    *(uint4*)(dst + (size_t)row * ld + c8) = *(const uint4*)(sT + row * ST_LD + c8);
  }
}
__device__ __forceinline__ void stage_rm(bfu* sT, const f32x16 (&acc)[2][2], float sc) {
  EPI_BEGIN
#pragma unroll
    for (int j = 0; j < 4; ++j) {
      sT[(r0 + j) * ST_LD + cl] = f2bf(acc[mi][0][q * 4 + j] * sc);
      sT[(r0 + j) * ST_LD + cl + 64] = f2bf(acc[mi][1][q * 4 + j] * sc);
    }
  EPI_END
}

__device__ __forceinline__ void tile_map(int L, int nM, int nN, int& pm, int& pn) {
  const int nwg = nM * nN;
  const int q = nwg >> 3, r = nwg & 7, xcd = L & 7, off = L >> 3;
  int wgid = (xcd < r ? xcd * (q + 1) : r * (q + 1) + (xcd - r) * q) + off;
  const int nig = 8 * nN, gid = wgid / nig, fm = gid * 8;
  const int gsz = (nM - fm) < 8 ? (nM - fm) : 8;
  pm = fm + (wgid % nig) % gsz;
  pn = (wgid % nig) / gsz;
}
__device__ void transpose_w(const float* __restrict__ src, int K, int N, int src_ld, bfu* __restrict__ dst,
                            int remap, int gtid, int gstride) {
  int total = N * (K / 8);
  for (int i = gtid; i < total; i += gstride) {
    int n = i % N, kg = i / N;
    int col = (remap && n >= 3584) ? n + 8 : n;
    float v[8];
#pragma unroll
    for (int j = 0; j < 8; ++j) v[j] = src[(size_t)(kg * 8 + j) * src_ld + col];
    uint4 o;
    o.x = pack2(v[0], v[1]); o.y = pack2(v[2], v[3]); o.z = pack2(v[4], v[5]); o.w = pack2(v[6], v[7]);
    *(uint4*)(dst + (size_t)n * K + kg * 8) = o;
  }
}
__device__ void transpose_w_lds(const float* __restrict__ src, int K, int N, int src_ld, bfu* __restrict__ dst,
                                int remap, float* st, int boff) {
  const int tid = threadIdx.x;
  const int tilesN = N >> 6, ntile = (K >> 6) * tilesN;
  for (int t = (int)((blockIdx.x + gridDim.x - (boff % gridDim.x)) % gridDim.x); t < ntile; t += gridDim.x) {
    const int kt = t / tilesN, nt = t - kt * tilesN;
    {
      const int row = tid >> 2, c16 = (tid & 3) * 16;
      const int n0 = nt * 64 + c16;
      const int col = (remap && n0 >= 3584) ? n0 + 8 : n0;
      const float* sp = src + (size_t)(kt * 64 + row) * src_ld + col;
#pragma unroll
      for (int j = 0; j < 4; ++j) {
        float4 v = *(const float4*)(sp + j * 4);
        float* d = st + row * 65 + c16 + j * 4;
        d[0] = v.x; d[1] = v.y; d[2] = v.z; d[3] = v.w;
      }
    }
    __syncthreads();
    {
      const int n = tid >> 2, kc = (tid & 3) * 16;
#pragma unroll
      for (int hf = 0; hf < 2; ++hf) {
        float f[8];
#pragma unroll
        for (int j = 0; j < 8; ++j) f[j] = st[(kc + hf * 8 + j) * 65 + n];
        uint4 o;
        o.x = pack2(f[0], f[1]); o.y = pack2(f[2], f[3]); o.z = pack2(f[4], f[5]); o.w = pack2(f[6], f[7]);
        *(uint4*)(dst + (size_t)(nt * 64 + n) * K + kt * 64 + kc + hf * 8) = o;
      }
    }
    __syncthreads();
  }
}
__device__ void convert_bf(const float* __restrict__ src, bfu* __restrict__ dst, size_t n8, int gtid, int gstride) {
  for (size_t i = gtid; i < n8; i += gstride) {
    float4 a = *(const float4*)(src + i * 8), b = *(const float4*)(src + i * 8 + 4);
    uint4 o;
    o.x = pack2(a.x, a.y); o.y = pack2(a.z, a.w); o.z = pack2(b.x, b.y); o.w = pack2(b.z, b.w);
    *(uint4*)(dst + i * 8) = o;
  }
}

__device__ void prep_rows(const Params& P) {
  const int lane = threadIdx.x & 63, w = threadIdx.x >> 6;
  bfu* hbuf = (bfu*)(P.ws + SLOT(0));
  float* gpre = (float*)(P.ws + O_GPRE);
  for (int r = blockIdx.x * 4 + w; r < MT; r += gridDim.x * 4) {
    const float* xr = xrow(P, r);
    float4 v[4];
    float ss = 0.f;
#pragma unroll
    for (int i = 0; i < 4; ++i) {
      v[i] = *(const float4*)(xr + i * 256 + lane * 4);
      ss += v[i].x * v[i].x + v[i].y * v[i].y + v[i].z * v[i].z + v[i].w * v[i].w;
    }
    ss = wave_sum(ss);
    float rstd = rsqrtf(ss * (1.f / 1024.f) + EPS);
    float ga[8];
#pragma unroll
    for (int j = 0; j < 8; ++j) ga[j] = 0.f;
#pragma unroll
    for (int i = 0; i < 4; ++i) {
      float4 g = *(const float4*)(P.g_mix + i * 256 + lane * 4);
      float hv[4] = {v[i].x * rstd * g.x, v[i].y * rstd * g.y, v[i].z * rstd * g.z, v[i].w * rstd * g.w};
      uint2 o; o.x = pack2(hv[0], hv[1]); o.y = pack2(hv[2], hv[3]);
      *(uint2*)(hbuf + (size_t)r * 1024 + i * 256 + lane * 4) = o;
#pragma unroll
      for (int j = 0; j < 4; ++j) {
        const float* wr = P.w_in + (size_t)(i * 256 + lane * 4 + j) * 5640 + 3584;
        float4 w0 = *(const float4*)wr, w1 = *(const float4*)(wr + 4);
        ga[0] += hv[j] * w0.x; ga[1] += hv[j] * w0.y; ga[2] += hv[j] * w0.z; ga[3] += hv[j] * w0.w;
        ga[4] += hv[j] * w1.x; ga[5] += hv[j] * w1.y; ga[6] += hv[j] * w1.z; ga[7] += hv[j] * w1.w;
      }
    }
    float si = reduce4(ga[0], ga[1], ga[2], ga[3]);
    float sf = reduce4(ga[4], ga[5], ga[6], ga[7]);
    if ((lane & 15) == 0) {
      int k = lane >> 4;
      gpre[(size_t)r * 8 + k] = si + P.b_i[k];
      gpre[(size_t)r * 8 + 4 + k] = sf + P.b_f[k];
    }
  }
}
__device__ void gate_scan(const Params& P) {
  const int lane = threadIdx.x & 63, w = threadIdx.x >> 6;
  const float* gpre = (const float*)(P.ws + O_GPRE);
  for (int item = blockIdx.x * 4 + w; item < 528 * 4; item += gridDim.x * 4) {
    int tile = item >> 2, h = item & 3;
    int row0, L;
    if (tile < 512) { row0 = tile * 64; L = 64; } else { row0 = MP + (tile - 512) * 32; L = 32; }
    const int s = lane;
    bool valid = s < L;
    float ig = valid ? gpre[(size_t)(row0 + s) * 8 + h] : -INFINITY;
    float fg = valid ? gpre[(size_t)(row0 + s) * 8 + 4 + h] : 0.f;
    float lf = valid ? (fminf(fg, 0.f) - log1pf(__expf(-fabsf(fg)))) : 0.f;
    float F = lf;
#pragma unroll
    for (int o = 1; o < 64; o <<= 1) { float t = __shfl_up(F, o); if (lane >= o) F += t; }
    float u = valid ? ig - F : -INFINITY;
    float cm = u;
#pragma unroll
    for (int o = 1; o < 64; o <<= 1) { float t = __shfl_up(cm, o); if (lane >= o) cm = fmaxf(cm, t); }
    if (valid) {
      size_t gi = (size_t)(row0 + s) * 4 + h;
      ((float*)(P.ws + O_FQ))[gi] = F;
      ((float*)(P.ws + O_UQ))[gi] = u;
      ((float*)(P.ws + O_CMQ))[gi] = cm;
      if (s == L - 1) {
        ((float*)(P.ws + O_FL))[tile * 4 + h] = F;
        ((float*)(P.ws + O_UC))[tile * 4 + h] = cm;
      }
    }
  }
}

__device__ void phase_prep(const Params& P, char* smem) {
  const int gtid = blockIdx.x * NTHREADS + threadIdx.x, gstride = gridDim.x * NTHREADS;
  prep_rows(P);
  transpose_w_lds(P.w_in, 1024, 5632, 5640, (bfu*)(P.ws + O_WT_IN), 1, (float*)smem, 0);
  transpose_w_lds(P.w_up_r, 512, 1024, 1024, (bfu*)(P.ws + O_WT_UPR), 0, (float*)smem, 1408);
  transpose_w_lds(P.w_up_m, 512, 1024, 1024, (bfu*)(P.ws + O_WT_UPM), 0, (float*)smem, 1536);
  transpose_w_lds(P.w_out, 1024, 1024, 1024, (bfu*)(P.ws + O_WT_OUT), 0, (float*)smem, 1664);
  transpose_w_lds(P.w_pq, 1024, 2048, 2048, (bfu*)(P.ws + O_WT_PQ), 0, (float*)smem, 1920);
  transpose_w_lds(P.w_pg, 1024, 1024, 1024, (bfu*)(P.ws + O_WT_PG), 0, (float*)smem, 2432);
  transpose_w_lds(P.w_ple, 256, 1024, 1024, (bfu*)(P.ws + O_WT_PLE), 0, (float*)smem, 2688);
  for (int h = 0; h < 4; ++h) {
    transpose_w_lds(P.w_mq + h * 16384, 128, 128, 128, (bfu*)(P.ws + O_WT_MQ) + h * 16384, 0, (float*)smem, 2752 + h * 8);
    transpose_w_lds(P.w_mk + h * 16384, 128, 128, 128, (bfu*)(P.ws + O_WT_MK) + h * 16384, 0, (float*)smem, 2756 + h * 8);
  }
  convert_bf(P.peer_keys, (bfu*)(P.ws + O_KEYS), 16 * 128 * 128 / 8, gtid, gstride);
  float* ct = (float*)(P.ws + O_COS); float* st = (float*)(P.ws + O_SIN);
  for (int i = gtid; i < 8192 * 64; i += gstride) {
    int pos = i >> 6, j = i & 63;
    float inv = exp2f(-(float)j * (13.287712379549449f / 64.f));
    float angf = (float)pos * inv;
    double a = (double)angf;
    double k = rint(a * 0.15915494309189535);
    float r = (float)(a - k * 6.283185307179586);
    ct[i] = __cosf(r); st[i] = __sinf(r);
  }
}

__device__ void phase_gemm1(const Params& P, char* smem) {
  bfu* sA = (bfu*)smem; bfu* sB = sA + 128 * 72;
  const bfu* hbuf = (const bfu*)(P.ws + SLOT(0));
  const bfu* wt = (const bfu*)(P.ws + O_WT_IN);
  const float* ct = (const float*)(P.ws + O_COS); const float* stb = (const float*)(P.ws + O_SIN);
  for (int t = blockIdx.x; t < 260 * 44; t += gridDim.x) {
    int mt, nt; tile_map(t, 260, 44, mt, nt);
    f32x16 acc[2][2]; zero_acc(acc);
    gemm_acc(acc, hbuf + (size_t)mt * 128 * 1024, 1024, wt + (size_t)nt * 128 * 1024, 1024, 1024, sA, sB);
    const int rbase = mt * 128;
    const bool prompt = rbase < MP;
    int region = nt >> 2, hh = nt & 3;
    bfu* sT = (bfu*)smem;
    __syncthreads();
    if (region <= 1) {
      float sc = region == 1 ? 0.08838834764831845f : 1.f;
      EPI_BEGIN
#pragma unroll
        for (int j = 0; j < 4; ++j) {
          int rr = rbase + r0 + j;
          int pos = prompt ? (rr & 8191) : 2048 + ((rr - MP) & 31);
          float c = ct[pos * 64 + cl], sn = stb[pos * 64 + cl];
          float a = acc[mi][0][q * 4 + j], b = acc[mi][1][q * 4 + j];
          sT[(r0 + j) * ST_LD + cl] = f2bf((a * c - b * sn) * sc);
          sT[(r0 + j) * ST_LD + cl + 64] = f2bf((a * sn + b * c) * sc);
        }
      EPI_END
      __syncthreads();
      copyout_bf16(sT, (bfu*)(P.ws + SLOT(2 + region)) + (size_t)rbase * 512 + hh * 128, 512);
    } else if (region == 2 || region == 5) {
      EPI_BEGIN
        uint2 va, vb;
        va.x = pack2(acc[mi][0][q * 4 + 0], acc[mi][0][q * 4 + 1]); va.y = pack2(acc[mi][0][q * 4 + 2], acc[mi][0][q * 4 + 3]);
        vb.x = pack2(acc[mi][1][q * 4 + 0], acc[mi][1][q * 4 + 1]); vb.y = pack2(acc[mi][1][q * 4 + 2], acc[mi][1][q * 4 + 3]);
        *(uint2*)(sT + cl * ST_LD + r0) = va;
        *(uint2*)(sT + (cl + 64) * ST_LD + r0) = vb;
      EPI_END
      __syncthreads();
      bfu* dst = (bfu*)(P.ws + SLOT(region == 2 ? 4 : 7));
#pragma unroll
      for (int i = 0; i < 8; ++i) {
        int id = threadIdx.x + i * 256, e = id >> 4, c8 = (id & 15) * 8;
        size_t o;
        if (prompt) { int bb = rbase >> 13, tt = (rbase & 8191) + c8; o = ((size_t)((bb * 4 + hh) * 128 + e)) * 8192 + tt; }
        else { int rs = rbase - MP + c8, bb = rs >> 5, tt = rs & 31; o = SB_T + ((size_t)((bb * 4 + hh) * 128 + e)) * 32 + tt; }
        *(uint4*)(dst + o) = *(const uint4*)(sT + e * ST_LD + c8);
      }
    } else if (region == 3 || region == 4 || region == 6) {
      stage_rm(sT, acc, 1.f);
      __syncthreads();
      copyout_bf16(sT, (bfu*)(P.ws + SLOT(region == 3 ? 5 : (region == 4 ? 6 : 8))) + (size_t)rbase * 512 + hh * 128, 512);
    } else {
      int gi = nt - 28;
      stage_rm(sT, acc, 1.f);
      __syncthreads();
      copyout_bf16(sT, (bfu*)(P.ws + SLOT(gi < 8 ? 9 : 11)) + (size_t)rbase * 1024 + (gi & 7) * 128, 1024);
    }
  }
}

__device__ void phase_conv(const Params& P) {
  const int gtid = blockIdx.x * NTHREADS + threadIdx.x, gstride = gridDim.x * NTHREADS;
  const bfu* xm = (const bfu*)(P.ws + SLOT(6));
  bfu* cb = (bfu*)(P.ws + SLOT(0));
  for (int i = gtid; i < MT * 64; i += gstride) {
    int r = i >> 6, c0 = (i & 63) * 8;
    int t, T, bb; bool prompt = r < MP;
    if (prompt) { bb = r >> 13; t = r & 8191; T = 8192; } else { int rs = r - MP; bb = rs >> 5; t = rs & 31; T = 32; }
    float y[8];
#pragma unroll
    for (int j = 0; j < 8; ++j) y[j] = P.conv_b[c0 + j];
#pragma unroll
    for (int k = 0; k < 4; ++k) {
      int tt = t - 3 + k;
      float xv[8];
      if (tt >= 0) {
        uint4 v = *(const uint4*)(xm + (size_t)(r - 3 + k) * 512 + c0);
        xv[0] = bf2f(v.x & 0xffff); xv[1] = bf2f(v.x >> 16); xv[2] = bf2f(v.y & 0xffff); xv[3] = bf2f(v.y >> 16);
        xv[4] = bf2f(v.z & 0xffff); xv[5] = bf2f(v.z >> 16); xv[6] = bf2f(v.w & 0xffff); xv[7] = bf2f(v.w >> 16);
      } else if (!prompt) {
        const float* sp = P.st_conv + (size_t)(bb * 3 + (tt + 3)) * 512 + c0;
#pragma unroll
        for (int j = 0; j < 8; ++j) xv[j] = sp[j];
      } else {
#pragma unroll
        for (int j = 0; j < 8; ++j) xv[j] = 0.f;
      }
#pragma unroll
      for (int j = 0; j < 8; ++j) y[j] += xv[j] * P.conv_w[k * 512 + c0 + j];
    }
    if (t >= T - 3) {
      uint4 v = *(const uint4*)(xm + (size_t)r * 512 + c0);
      float* dst = (prompt ? P.out + OO_CONVP : P.out + OO_CONVS) + (size_t)(bb * 3 + (t - (T - 3))) * 512 + c0;
      dst[0] = bf2f(v.x & 0xffff); dst[1] = bf2f(v.x >> 16); dst[2] = bf2f(v.y & 0xffff); dst[3] = bf2f(v.y >> 16);
      dst[4] = bf2f(v.z & 0xffff); dst[5] = bf2f(v.z >> 16); dst[6] = bf2f(v.w & 0xffff); dst[7] = bf2f(v.w >> 16);
    }
    uint4 o;
#pragma unroll
    for (int j = 0; j < 8; ++j) y[j] = y[j] * sigmoidf_(y[j]);
    o.x = pack2(y[0], y[1]); o.y = pack2(y[2], y[3]); o.z = pack2(y[4], y[5]); o.w = pack2(y[6], y[7]);
    *(uint4*)(cb + (size_t)r * 512 + c0) = o;
  }
}

__device__ void m_fold(const Params& P) {
  const int gtid = blockIdx.x * NTHREADS + threadIdx.x;
  const float* FL = (const float*)(P.ws + O_FL); const float* UC = (const float*)(P.ws + O_UC);
  float* MCS = (float*)(P.ws + O_MCS);
  if (gtid < 16) {
    int b = gtid >> 2, h = gtid & 3;
    float m = 0.f;
    for (int c = 0; c < 128; c += 8) {
      float fl[8], uc[8];
#pragma unroll
      for (int k = 0; k < 8; ++k) { fl[k] = FL[(b * 128 + c + k) * 4 + h]; uc[k] = UC[(b * 128 + c + k) * 4 + h]; }
#pragma unroll
      for (int k = 0; k < 8; ++k) { MCS[gtid * 128 + c + k] = m; m = fl[k] + fmaxf(m, uc[k]); }
    }
  } else if (gtid < 16 + 64) {
    int bh = gtid - 16;
    MCS[2048 + bh] = P.st_m[bh];
  }
}
__device__ void phase_mqk(const Params& P, char* smem) {
  bfu* sA = (bfu*)smem; bfu* sB = sA + 128 * 72;
  const bfu* cb = (const bfu*)(P.ws + SLOT(0));
  for (int t = blockIdx.x; t < 260 * 8; t += gridDim.x) {
    int mt = t >> 3, which = (t >> 2) & 1, hh = t & 3;
    const bfu* wt = (const bfu*)(P.ws + (which ? O_WT_MK : O_WT_MQ)) + hh * 16384;
    f32x16 acc[2][2]; zero_acc(acc);
    gemm_acc(acc, cb + (size_t)mt * 128 * 512 + hh * 128, 512, wt, 128, 128, sA, sB);
    bfu* dst = (bfu*)(P.ws + SLOT(which ? 13 : 1));
    float sc = which ? 0.08838834764831845f : 1.f;
    bfu* sT = (bfu*)smem;
    __syncthreads();
    stage_rm(sT, acc, sc);
    __syncthreads();
    copyout_bf16(sT, dst + (size_t)mt * 128 * 512 + hh * 128, 512);
  }
}

struct Item { int b, h, c, row0, L, T, chunk, bh; bool prompt; size_t vt_off; };
__device__ __forceinline__ Item decode_item(int idx) {
  Item it;
  if (idx < 2048) {
    it.prompt = true; it.b = idx >> 9; it.h = (idx >> 7) & 3; it.c = idx & 127; it.row0 = it.b * 8192 + it.c * 64;
    it.L = 64; it.T = 8192; it.chunk = it.b * 128 + it.c; it.bh = it.b * 4 + it.h;
    it.vt_off = ((size_t)(it.bh * 128)) * 8192 + it.c * 64;
  } else {
    int si = idx - 2048; it.prompt = false; it.b = si >> 2; it.h = si & 3; it.c = 0; it.row0 = MP + it.b * 32;
    it.L = 32; it.T = 32; it.chunk = 512 + it.b; it.bh = it.b * 4 + it.h;
    it.vt_off = SB_T + ((size_t)(it.bh * 128)) * 32;
  }
  return it;
}
__device__ __forceinline__ bfu* ds_ptr(const Params& P, int mixer, int idx) {
  if (idx < 2048) return (bfu*)P.out + ((size_t)(mixer * 2048 + idx)) * 16384;
  return (bfu*)(P.ws + O_DSS) + ((size_t)(mixer * 64 + (idx - 2048))) * 16384;
}
__device__ __forceinline__ float ret_lg(int h) { return log1pf(-exp2f(-5.f - (float)h)); }

__device__ void phaseA_item(const Params& P, int mixer, int idx, char* smem) {
  const int tid = threadIdx.x, lane = tid & 63, w = tid >> 6, wm = w & 1, wn = w >> 1;
  Item it = decode_item(idx);
  bfu* sK = (bfu*)smem; bfu* sV = sK + 128 * 72;
  float* sw = (float*)(sV + 128 * 72);
  float* sm = sw + 64;
  const int L = it.L, h = it.h;
  const bfu* Ksrc = (const bfu*)(P.ws + SLOT(mixer == 0 ? 3 : 13)) + (size_t)it.row0 * 512 + h * 128;
  const bfu* Vsrc = (const bfu*)(P.ws + SLOT(mixer == 0 ? 4 : 7)) + it.vt_off;
  uint4 kreg[4], vreg[4];
#pragma unroll
  for (int i = 0; i < 4; ++i) {
    int id = tid + i * 256, s = id & 63, dc = (id >> 6) * 8;
    kreg[i] = make_uint4(0, 0, 0, 0);
    if (s < L) kreg[i] = *(const uint4*)(Ksrc + (size_t)s * 512 + dc);
    int e = id >> 3, sc = (id & 7) * 8;
    vreg[i] = make_uint4(0, 0, 0, 0);
    if (sc < L) vreg[i] = *(const uint4*)(Vsrc + (size_t)e * it.T + sc);
  }
  if (mixer == 0) {
    if (tid < 64) { float lg = ret_lg(h); sw[tid] = tid < L ? __expf(lg * (float)(L - 1 - tid)) : 0.f; }
  } else {
    const float* FL = (const float*)(P.ws + O_FL); const float* UC = (const float*)(P.ws + O_UC);
    float mc = ((const float*)(P.ws + O_MCS))[idx];
    float Ml = fmaxf(mc, UC[it.chunk * 4 + h]);
    if (tid < 64) sw[tid] = tid < L ? __expf(((const float*)(P.ws + O_UQ))[(size_t)(it.row0 + tid) * 4 + h] - Ml) : 0.f;
    if (tid == 0) {
      ((float*)(P.ws + O_AEND))[idx] = __expf(mc - Ml);
      if (!it.prompt) P.out[OO_MS + it.bh] = FL[it.chunk * 4 + h] + Ml;
      else if (it.c == 127) P.out[OO_MP + it.bh] = FL[it.chunk * 4 + h] + Ml;
    }
  }
  __syncthreads();
#pragma unroll
  for (int i = 0; i < 4; ++i) {
    int id = tid + i * 256, s = id & 63, dc = (id >> 6) * 8;
    uint4 v = kreg[i];
    float ww = sw[s];
    unsigned vv[4] = {v.x, v.y, v.z, v.w};
#pragma unroll
    for (int j = 0; j < 4; ++j) {
      sK[(dc + 2 * j) * 72 + s] = f2bf(bf2f(vv[j] & 0xffff) * ww);
      sK[(dc + 2 * j + 1) * 72 + s] = f2bf(bf2f(vv[j] >> 16) * ww);
    }
  }
#pragma unroll
  for (int i = 0; i < 4; ++i) {
    int id = tid + i * 256, e = id >> 3, sc = (id & 7) * 8;
    *(uint4*)(sV + e * 72 + sc) = vreg[i];
  }
  __syncthreads();
  f32x16 acc[2][2]; zero_acc(acc);
#pragma unroll
  for (int ks = 0; ks < 4; ++ks) {
    bf16x8 af[2], bfr[2];
#pragma unroll
    for (int mi = 0; mi < 2; ++mi)
      af[mi] = *(const bf16x8*)(sK + (wm * 64 + mi * 32 + (lane & 31)) * 72 + ks * 16 + (lane >> 5) * 8);
#pragma unroll
    for (int ni = 0; ni < 2; ++ni)
      bfr[ni] = *(const bf16x8*)(sV + (wn * 32 + ni * 64 + (lane & 31)) * 72 + ks * 16 + (lane >> 5) * 8);
#pragma unroll
    for (int mi = 0; mi < 2; ++mi)
#pragma unroll
      for (int ni = 0; ni < 2; ++ni)
        acc[mi][ni] = __builtin_amdgcn_mfma_f32_32x32x16_bf16(af[mi], bfr[ni], acc[mi][ni], 0, 0, 0);
  }
  bfu* dS = ds_ptr(P, mixer, idx);
  EPI_BEGIN
#pragma unroll
    for (int ni = 0; ni < 2; ++ni) {
      int e = cl + ni * 64;
      uint2 o; o.x = pack2(acc[mi][ni][q * 4 + 0], acc[mi][ni][q * 4 + 1]); o.y = pack2(acc[mi][ni][q * 4 + 2], acc[mi][ni][q * 4 + 3]);
      *(uint2*)(dS + e * 128 + r0) = o;
    }
  EPI_END
  if (mixer == 1 && tid < 128) {
    float s = 0.f;
#pragma unroll
    for (int j = 0; j < 8; ++j) { float f[8]; unpack8(*(const uint4*)(sK + tid * 72 + j * 8), f);
#pragma unroll
      for (int k = 0; k < 8; ++k) s += f[k]; }
    ((float*)(P.ws + O_DN))[(size_t)idx * 128 + tid] = s;
  }
  __syncthreads();
}

__device__ void phase_scan(const Params& P) {
  const int gtid = blockIdx.x * NTHREADS + threadIdx.x, gstride = gridDim.x * NTHREADS;
  const float* AE = (const float*)(P.ws + O_AEND);
  for (int i = gtid; i < 131072; i += gstride) {
    int mixer = i >> 16, bh = (i >> 12) & 15, eo = (i & 4095) * 4;
    int h = bh & 3;
    float gch = __expf(ret_lg(h) * 64.f);
    float st[4];
#pragma unroll
    for (int j = 0; j < 4; ++j) st[j] = 0.f;
    bfu* base = (bfu*)P.out + ((size_t)(mixer * 2048 + bh * 128)) * 16384 + eo;
    for (int c = 0; c < 128; c += 8) {
      uint2 v[8];
#pragma unroll
      for (int k = 0; k < 8; ++k) v[k] = *(const uint2*)(base + (size_t)(c + k) * 16384);
#pragma unroll
      for (int k = 0; k < 8; ++k) {
        float dec = mixer == 0 ? gch : AE[bh * 128 + c + k];
        float d0 = bf2f(v[k].x & 0xffff), d1 = bf2f(v[k].x >> 16), d2 = bf2f(v[k].y & 0xffff), d3 = bf2f(v[k].y >> 16);
        uint2 o; o.x = pack2(st[0], st[1]); o.y = pack2(st[2], st[3]);
        *(uint2*)(base + (size_t)(c + k) * 16384) = o;
        st[0] = dec * st[0] + d0; st[1] = dec * st[1] + d1; st[2] = dec * st[2] + d2; st[3] = dec * st[3] + d3;
      }
    }
    float* o = P.out + (mixer == 0 ? OO_RETP : OO_CP) + (size_t)bh * 16384;
    int e = eo >> 7, d0i = eo & 127;
#pragma unroll
    for (int j = 0; j < 4; ++j) o[(d0i + j) * 128 + e] = st[j];
  }
  for (int i = gtid; i < 2 * 64 * 2048; i += gstride) {
    int mixer = i >> 17, bh = (i >> 11) & 63, eo = (i & 2047) * 8;
    int h = bh & 3;
    int e = eo >> 7, d0 = eo & 127;
    const float* s0 = (mixer == 0 ? P.st_ret : P.st_C) + (size_t)bh * 16384;
    float st[8];
#pragma unroll
    for (int j = 0; j < 8; ++j) st[j] = s0[(d0 + j) * 128 + e];
    bfu* p = (bfu*)(P.ws + O_DSS) + ((size_t)(mixer * 64 + bh)) * 16384 + eo;
    float d[8]; unpack8(*(const uint4*)p, d);
    *(uint4*)p = pack8(st);
    float dec = mixer == 0 ? __expf(ret_lg(h) * 32.f) : AE[2048 + bh];
    float* o = P.out + (mixer == 0 ? OO_RETS : OO_CS) + (size_t)bh * 16384;
#pragma unroll
    for (int j = 0; j < 8; ++j) o[(d0 + j) * 128 + e] = dec * st[j] + d[j];
  }
  float* DN = (float*)(P.ws + O_DN);
  for (int i = gtid; i < 16 * 128; i += gstride) {
    int bh = i >> 7, d = i & 127;
    float n = 0.f;
    for (int c = 0; c < 128; ++c) {
      size_t o = (size_t)(bh * 128 + c) * 128 + d;
      float v = DN[o]; DN[o] = n; n = AE[bh * 128 + c] * n + v;
    }
    P.out[OO_NP + i] = n;
  }
  for (int i = gtid; i < 64 * 128; i += gstride) {
    int bh = i >> 7, d = i & 127;
    size_t o = (size_t)(2048 + bh) * 128 + d;
    float n0 = P.st_n[i]; float v = DN[o]; DN[o] = n0;
    P.out[OO_NS + i] = AE[2048 + bh] * n0 + v;
  }
}

__device__ void phaseC_item(const Params& P, int mixer, int idx, char* smem) {
  const int tid = threadIdx.x, lane = tid & 63, w = tid >> 6;
  Item it = decode_item(idx);
  const int L = it.L, h = it.h;
  bfu* sQ = (bfu*)smem;
  bfu* sKV = sQ + 64 * 136;
  bfu* sP = sKV + 128 * 72;
  bfu* sS = sP + 64 * 72;
  float* sO = (float*)sS;
  float* sRow = (float*)(sS + 128 * 136);
  const bfu* Qsrc = (const bfu*)(P.ws + SLOT(mixer == 0 ? 2 : 1)) + (size_t)it.row0 * 512 + h * 128;
  const bfu* Ksrc = (const bfu*)(P.ws + SLOT(mixer == 0 ? 3 : 13)) + (size_t)it.row0 * 512 + h * 128;
  const bfu* Vsrc = (const bfu*)(P.ws + SLOT(mixer == 0 ? 4 : 7)) + it.vt_off;
  const bfu* Ssrc = ds_ptr(P, mixer, idx);
  const float lg = ret_lg(h);
  uint4 vpre[4];
#pragma unroll
  for (int i = 0; i < 4; ++i) {
    int id = tid + i * 256, e = id >> 3, sc = (id & 7) * 8;
    vpre[i] = make_uint4(0, 0, 0, 0);
    if (sc < L) vpre[i] = *(const uint4*)(Vsrc + (size_t)e * it.T + sc);
  }
#pragma unroll
  for (int i = 0; i < 4; ++i) {
    int id = tid + i * 256, s = id >> 4, dc = (id & 15) * 8;
    uint4 vq = make_uint4(0, 0, 0, 0), vk = vq;
    if (s < L) { vq = *(const uint4*)(Qsrc + (size_t)s * 512 + dc); vk = *(const uint4*)(Ksrc + (size_t)s * 512 + dc); }
    *(uint4*)(sQ + s * 136 + dc) = vq;
    *(uint4*)(sKV + s * 136 + dc) = vk;
  }
#pragma unroll
  for (int i = 0; i < 8; ++i) {
    int id = tid + i * 256, e = id >> 4, dc = (id & 15) * 8;
    *(uint4*)(sS + e * 136 + dc) = *(const uint4*)(Ssrc + e * 128 + dc);
  }
  if (tid < 64) {
    int i = tid;
    if (mixer == 0) {
      sRow[128 + i] = __expf(lg * (float)(i + 1));
    } else {
      float mc = ((const float*)(P.ws + O_MCS))[idx];
      size_t gi = (size_t)(it.row0 + i) * 4 + h;
      bool valid = i < L;
      float u = valid ? ((const float*)(P.ws + O_UQ))[gi] : -INFINITY;
      float M = valid ? fmaxf(mc, ((const float*)(P.ws + O_CMQ))[gi]) : 0.f;
      float F = valid ? ((const float*)(P.ws + O_FQ))[gi] : 0.f;
      sRow[i] = u; sRow[64 + i] = M; sRow[128 + i] = valid ? __expf(mc - M) : 0.f;
      sRow[256 + i] = __expf(-(F + M));
    }
  }
  __syncthreads();
  {
    const int mi = w & 1, ni = w >> 1;
    f32x16 acc;
#pragma unroll
    for (int i = 0; i < 16; ++i) acc[i] = 0.f;
#pragma unroll 2
    for (int ks = 0; ks < 8; ++ks) {
      bf16x8 af = *(const bf16x8*)(sQ + (mi * 32 + (lane & 31)) * 136 + ks * 16 + (lane >> 5) * 8);
      bf16x8 bfr = *(const bf16x8*)(sKV + (ni * 32 + (lane & 31)) * 136 + ks * 16 + (lane >> 5) * 8);
      acc = __builtin_amdgcn_mfma_f32_32x32x16_bf16(af, bfr, acc, 0, 0, 0);
    }
    const int s = ni * 32 + (lane & 31);
    float us = mixer ? sRow[s] : 0.f;
#pragma unroll
    for (int reg = 0; reg < 16; ++reg) {
      int i = mi * 32 + (reg & 3) + 8 * (reg >> 2) + 4 * (lane >> 5);
      float wgt;
      if (mixer == 0) wgt = (s <= i) ? __expf(lg * (float)(i - s)) : 0.f;
      else wgt = (s <= i && i < L) ? __expf(us - sRow[64 + i]) : 0.f;
      sP[i * 72 + s] = f2bf(acc[reg] * wgt);
    }
  }
  __syncthreads();
#pragma unroll
  for (int i = 0; i < 4; ++i) {
    int id = tid + i * 256, e = id >> 3, sc = (id & 7) * 8;
    *(uint4*)(sKV + e * 72 + sc) = vpre[i];
  }
  __syncthreads();
  f32x16 acc1[2], acc2[2];
  const int mi = w & 1, nj = w >> 1;
#pragma unroll
  for (int t = 0; t < 2; ++t)
#pragma unroll
    for (int i = 0; i < 16; ++i) { acc1[t][i] = 0.f; acc2[t][i] = 0.f; }
#pragma unroll 2
  for (int ks = 0; ks < 4; ++ks) {
    bf16x8 af = *(const bf16x8*)(sP + (mi * 32 + (lane & 31)) * 72 + ks * 16 + (lane >> 5) * 8);
#pragma unroll
    for (int t = 0; t < 2; ++t) {
      bf16x8 bfr = *(const bf16x8*)(sKV + (nj * 64 + t * 32 + (lane & 31)) * 72 + ks * 16 + (lane >> 5) * 8);
      acc1[t] = __builtin_amdgcn_mfma_f32_32x32x16_bf16(af, bfr, acc1[t], 0, 0, 0);
    }
  }
#pragma unroll 2
  for (int ks = 0; ks < 8; ++ks) {
    bf16x8 af = *(const bf16x8*)(sQ + (mi * 32 + (lane & 31)) * 136 + ks * 16 + (lane >> 5) * 8);
#pragma unroll
    for (int t = 0; t < 2; ++t) {
      bf16x8 bfr = *(const bf16x8*)(sS + (nj * 64 + t * 32 + (lane & 31)) * 136 + ks * 16 + (lane >> 5) * 8);
      acc2[t] = __builtin_amdgcn_mfma_f32_32x32x16_bf16(af, bfr, acc2[t], 0, 0, 0);
    }
  }
  if (mixer == 1) {
    int i = tid >> 2, part = tid & 3;
    const float* nprev = (const float*)(P.ws + O_DN) + (size_t)idx * 128;
    float dl = 0.f, qn = 0.f;
#pragma unroll 4
    for (int s = part * 16; s < part * 16 + 16; ++s) dl += bf2f(sP[i * 72 + s]);
#pragma unroll 4
    for (int d = part * 32; d < part * 32 + 32; ++d) qn += bf2f(sQ[i * 136 + d]) * nprev[d];
    dl += __shfl_xor(dl, 1); dl += __shfl_xor(dl, 2);
    qn += __shfl_xor(qn, 1); qn += __shfl_xor(qn, 2);
    if (part == 0) {
      float den = dl + sRow[128 + i] * qn;
      sRow[192 + i] = 1.f / fmaxf(fabsf(den), sRow[256 + i]);
    }
  }
  __syncthreads();
#pragma unroll
  for (int t = 0; t < 2; ++t) {
    int e = nj * 64 + t * 32 + (lane & 31);
#pragma unroll
    for (int reg = 0; reg < 16; ++reg) {
      int i = mi * 32 + (reg & 3) + 8 * (reg >> 2) + 4 * (lane >> 5);
      float o = acc1[t][reg] + sRow[128 + i] * acc2[t][reg];
      if (mixer == 1) o *= sRow[192 + i];
      sO[i * 132 + e] = o;
    }
  }
  __syncthreads();
  {
    int i = tid >> 2, part = tid & 3;
    float ss = 0.f;
#pragma unroll 4
    for (int e = part * 32; e < part * 32 + 32; ++e) { float v = sO[i * 132 + e]; ss += v * v; }
    ss += __shfl_xor(ss, 1); ss += __shfl_xor(ss, 2);
    float rstd = rsqrtf(ss * (1.f / 128.f) + EPS);
    if (i < L) {
      size_t ro = (size_t)(it.row0 + i) * 512 + h * 128 + part * 32;
      const float* so = sO + i * 132 + part * 32;
      if (mixer == 0) {
        bfu* y = (bfu*)(P.ws + SLOT(5)) + ro;
        const float* g = P.g_ret_gn + h * 128 + part * 32;
        uint4 gv[4];
#pragma unroll
        for (int k = 0; k < 4; ++k) gv[k] = *(const uint4*)(y + k * 8);
#pragma unroll
        for (int k = 0; k < 4; ++k) {
          float gt[8], o[8];
          unpack8(gv[k], gt);
#pragma unroll
          for (int j = 0; j < 8; ++j) o[j] = gt[j] * sigmoidf_(gt[j]) * so[k * 8 + j] * rstd * g[k * 8 + j];
          *(uint4*)(y + k * 8) = pack8(o);
        }
      } else {
        bfu* y = (bfu*)(P.ws + SLOT(8)) + ro;
        const bfu* cc = (const bfu*)(P.ws + SLOT(0)) + ro;
        const float* g = P.g_ml_gn + h * 128 + part * 32;
        const float* ws = P.w_skip + h * 128 + part * 32;
        uint4 gv[4], cv[4];
#pragma unroll
        for (int k = 0; k < 4; ++k) { gv[k] = *(const uint4*)(y + k * 8); cv[k] = *(const uint4*)(cc + k * 8); }
#pragma unroll
        for (int k = 0; k < 4; ++k) {
          float gt[8], c8[8], o[8];
          unpack8(gv[k], gt); unpack8(cv[k], c8);
#pragma unroll
          for (int j = 0; j < 8; ++j) o[j] = sigmoidf_(gt[j]) * (so[k * 8 + j] * rstd * g[k * 8 + j] + ws[k * 8 + j] * c8[j]);
          *(uint4*)(y + k * 8) = pack8(o);
        }
      }
    }
  }
  __syncthreads();
}

__device__ void phase_merge(const Params& P, char* smem) {
  bfu* sA = (bfu*)smem; bfu* sB = sA + 128 * 72;
  const bfu* yr = (const bfu*)(P.ws + SLOT(5)); const bfu* ym = (const bfu*)(P.ws + SLOT(8));
  const bfu* gr = (const bfu*)(P.ws + SLOT(9)); const bfu* gm = (const bfu*)(P.ws + SLOT(11));
  bfu* mg = (bfu*)(P.ws + SLOT(6));
  for (int t = blockIdx.x; t < 260 * 8; t += gridDim.x) {
    int mt, nt; tile_map(t, 260, 8, mt, nt);
    f32x16 acc[2][2]; zero_acc(acc);
    bfu* sT = (bfu*)smem;
    const size_t tbase = (size_t)mt * 128 * 1024 + nt * 128;
    uint4 t1[8];
    gemm_acc(acc, yr + (size_t)mt * 128 * 512, 512, (const bfu*)(P.ws + O_WT_UPR) + (size_t)nt * 128 * 512, 512, 512, sA, sB);
    __syncthreads();
    stage_rm(sT, acc, 1.f);
    __syncthreads();
#pragma unroll
    for (int i = 0; i < 8; ++i) {
      int id = threadIdx.x + i * 256, row = id >> 4, c8 = (id & 15) * 8;
      float a[8], g[8];
      unpack8(*(const uint4*)(sT + row * ST_LD + c8), a);
      unpack8(*(const uint4*)(gr + tbase + (size_t)row * 1024 + c8), g);
#pragma unroll
      for (int j = 0; j < 8; ++j) a[j] *= sigmoidf_(g[j]);
      t1[i] = pack8(a);
    }
    zero_acc(acc);
    gemm_acc(acc, ym + (size_t)mt * 128 * 512, 512, (const bfu*)(P.ws + O_WT_UPM) + (size_t)nt * 128 * 512, 512, 512, sA, sB);
    __syncthreads();
    stage_rm(sT, acc, 1.f);
    __syncthreads();
#pragma unroll
    for (int i = 0; i < 8; ++i) {
      int id = threadIdx.x + i * 256, row = id >> 4, c8 = (id & 15) * 8;
      float a[8], g[8], t[8];
      unpack8(*(const uint4*)(sT + row * ST_LD + c8), a);
      unpack8(*(const uint4*)(gm + tbase + (size_t)row * 1024 + c8), g);
      unpack8(t1[i], t);
#pragma unroll
      for (int j = 0; j < 8; ++j) a[j] = t[j] + a[j] * sigmoidf_(g[j]);
      *(uint4*)(mg + tbase + (size_t)row * 1024 + c8) = pack8(a);
    }
  }
}

__device__ void phase_outproj(const Params& P, char* smem) {
  bfu* sA = (bfu*)smem; bfu* sB = sA + 128 * 72;
  const bfu* mg = (const bfu*)(P.ws + SLOT(6));
  for (int t = blockIdx.x; t < 260 * 8; t += gridDim.x) {
    int mt, nt; tile_map(t, 260, 8, mt, nt);
    f32x16 acc[2][2]; zero_acc(acc);
    gemm_acc(acc, mg + (size_t)mt * 128 * 1024, 1024, (const bfu*)(P.ws + O_WT_OUT) + (size_t)nt * 128 * 1024, 1024, 1024, sA, sB);
    float* sT32 = (float*)smem;
    __syncthreads();
    {
      EPI_BEGIN
#pragma unroll
        for (int j = 0; j < 4; ++j) {
          sT32[(r0 + j) * ST32_LD + cl] = acc[mi][0][q * 4 + j];
          sT32[(r0 + j) * ST32_LD + cl + 64] = acc[mi][1][q * 4 + j];
        }
      EPI_END
    }
    __syncthreads();
#pragma unroll
    for (int i = 0; i < 16; ++i) {
      int id = threadIdx.x + i * 256, row = id >> 5, c4 = (id & 31) * 4;
      int r = mt * 128 + row;
      float4 a = *(const float4*)(sT32 + row * ST32_LD + c4);
      float4 x = *(const float4*)(xrow(P, r) + nt * 128 + c4);
      *(float4*)(P.out + (size_t)r * 1024 + nt * 128 + c4) = make_float4(x.x + a.x, x.y + a.y, x.z + a.z, x.w + a.w);
    }
  }
}

__device__ void phase_norm_rows(const Params& P, const float* g, bfu* dst) {
  const int lane = threadIdx.x & 63, w = threadIdx.x >> 6;
  for (int r = blockIdx.x * 4 + w; r < MT; r += gridDim.x * 4) {
    const float* xr = P.out + (size_t)r * 1024;
    float4 v[4]; float ss = 0.f;
#pragma unroll
    for (int i = 0; i < 4; ++i) {
      v[i] = *(const float4*)(xr + i * 256 + lane * 4);
      ss += v[i].x * v[i].x + v[i].y * v[i].y + v[i].z * v[i].z + v[i].w * v[i].w;
    }
    ss = wave_sum(ss);
    float rstd = rsqrtf(ss * (1.f / 1024.f) + EPS);
#pragma unroll
    for (int i = 0; i < 4; ++i) {
      float4 gg = *(const float4*)(g + i * 256 + lane * 4);
      uint2 o; o.x = pack2(v[i].x * rstd * gg.x, v[i].y * rstd * gg.y); o.y = pack2(v[i].z * rstd * gg.z, v[i].w * rstd * gg.w);
      *(uint2*)(dst + (size_t)r * 1024 + i * 256 + lane * 4) = o;
    }
  }
}

__device__ void phase_pq(const Params& P, char* smem) {
  bfu* sA = (bfu*)smem; bfu* sB = sA + 128 * 72;
  const bfu* hq = (const bfu*)(P.ws + SLOT(0));
  bfu* qb = (bfu*)(P.ws + SLOT(9));
  for (int t = blockIdx.x; t < 260 * 16; t += gridDim.x) {
    int mt, nt; tile_map(t, 260, 16, mt, nt);
    f32x16 acc[2][2]; zero_acc(acc);
    gemm_acc(acc, hq + (size_t)mt * 128 * 1024, 1024, (const bfu*)(P.ws + O_WT_PQ) + (size_t)nt * 128 * 1024, 1024, 1024, sA, sB);
    bfu* sT = (bfu*)smem;
    __syncthreads();
    stage_rm(sT, acc, 1.f);
    __syncthreads();
    copyout_bf16(sT, qb + (size_t)mt * 128 * 2048 + nt * 128, 2048);
  }
}


template <bool DESC> __device__ __forceinline__ void cex(float& a, float& b) {
  float mx = fmaxf(a, b), mn = fminf(a, b);
  a = DESC ? mx : mn; b = DESC ? mn : mx;
}
template <int B, bool DESC> __device__ __forceinline__ void bmerge16(float (&v)[64]) {
#pragma unroll
  for (int j = 8; j > 0; j >>= 1)
#pragma unroll
    for (int i = 0; i < 16; ++i) { int l = i ^ j; if (l > i) cex<DESC>(v[B + i], v[B + l]); }
}
template <int B, bool DESC> __device__ __forceinline__ void bsort16(float (&v)[64]) {
#pragma unroll
  for (int k = 2; k <= 16; k <<= 1)
#pragma unroll
    for (int j = k >> 1; j > 0; j >>= 1)
#pragma unroll
      for (int i = 0; i < 16; ++i) {
        int l = i ^ j;
        if (l > i) {
          bool up = ((i & k) == 0) || (k == 16);
          if (up == true) { if (DESC) cex<true>(v[B + i], v[B + l]); else cex<false>(v[B + i], v[B + l]); }
          else { if (DESC) cex<false>(v[B + i], v[B + l]); else cex<true>(v[B + i], v[B + l]); }
        }
      }
}
__device__ __forceinline__ float pair_max(float v) {
  auto r = __builtin_amdgcn_permlane32_swap(__float_as_int(v), __float_as_int(v), false, false);
  return fmaxf(__int_as_float(r[0]), __int_as_float(r[1]));
}
__device__ void phase_topk(const Params& P, char* smem) {
  const int tid = threadIdx.x, lane = tid & 63, w = tid >> 6, r32 = lane & 31, hh = lane >> 5;
  unsigned* sL = (unsigned*)smem + w * 1664;
  unsigned* sW = sL + 32 * 33;
  const bfu* qb = (const bfu*)(P.ws + SLOT(9));
  const bfu* keys = (const bfu*)(P.ws + O_KEYS);
  int* ids = (int*)(P.ws + SLOT(4));
  float* gw = (float*)(P.ws + SLOT(13));
  for (int item = blockIdx.x * 4 + w; item < 1040 * 8; item += gridDim.x * 4) {
    const int tg = item >> 3, n = item & 7, rowb = tg * 32;
#pragma unroll 1
    for (int half = 0; half < 2; ++half) {
      f32x16 acc[4];
#pragma unroll
      for (int c = 0; c < 4; ++c)
#pragma unroll
        for (int i = 0; i < 16; ++i) acc[c][i] = 0.f;
      const bfu* kp = keys + (size_t)((n * 2 + half) * 128 + r32) * 128 + hh * 8;
      const bfu* qp = qb + (size_t)(rowb + r32) * 2048 + n * 256 + half * 128 + hh * 8;
#pragma unroll
      for (int ks = 0; ks < 8; ++ks) {
        bf16x8 bfr = *(const bf16x8*)(qp + ks * 16);
#pragma unroll
        for (int c = 0; c < 4; ++c) {
          bf16x8 af = *(const bf16x8*)(kp + (size_t)c * 32 * 128 + ks * 16);
          acc[c] = __builtin_amdgcn_mfma_f32_32x32x16_bf16(af, bfr, acc[c], 0, 0, 0);
        }
      }
      float kk[64];
#pragma unroll
      for (int c = 0; c < 4; ++c)
#pragma unroll
        for (int reg = 0; reg < 16; ++reg) {
          unsigned kidx = c * 32 + (reg & 3) + 8 * (reg >> 2) + 4 * hh;
          kk[c * 16 + reg] = __uint_as_float((__float_as_uint(acc[c][reg]) & ~127u) | kidx);
        }
      bsort16<0, true>(kk); bsort16<16, false>(kk); bsort16<32, false>(kk); bsort16<48, true>(kk);
#pragma unroll
      for (int i = 0; i < 16; ++i) { kk[i] = fmaxf(kk[i], kk[16 + i]); kk[32 + i] = fmaxf(kk[32 + i], kk[48 + i]); }
      bmerge16<0, true>(kk); bmerge16<32, false>(kk);
#pragma unroll
      for (int i = 0; i < 16; ++i) kk[i] = fmaxf(kk[i], kk[32 + i]);
      bmerge16<0, true>(kk);
      {
        float lo[16], hi[16];
#pragma unroll
        for (int i = 0; i < 16; ++i) {
          auto r = __builtin_amdgcn_permlane32_swap(__float_as_int(kk[i]), __float_as_int(kk[i]), false, false);
          lo[i] = __int_as_float(r[0]); hi[i] = __int_as_float(r[1]);
        }
#pragma unroll
        for (int i = 0; i < 16; ++i) kk[i] = fmaxf(lo[i], hi[15 - i]);
      }
      bmerge16<0, true>(kk);
      if (hh == 0) {
#pragma unroll
        for (int p = 0; p < 16; ++p) sL[r32 * 33 + half * 16 + p] = __float_as_uint(kk[p]);
      }
    }
    __builtin_amdgcn_fence(__ATOMIC_RELEASE, "workgroup");
    __builtin_amdgcn_wave_barrier();
    __builtin_amdgcn_fence(__ATOMIC_ACQUIRE, "workgroup");
    float x[4], y[16];
    {
      const unsigned* lx = sL + r32 * 33 + (hh ? 16 : 0);
      const unsigned* ly = sL + r32 * 33 + (hh ? 0 : 16);
#pragma unroll
      for (int i = 0; i < 4; ++i) x[i] = __uint_as_float(lx[i] & ~127u);
#pragma unroll
      for (int j = 0; j < 16; ++j) y[j] = __uint_as_float(ly[j] & ~127u);
    }
    float cd[25];
#define CAND(t, i, j) { float sv = x[i] + y[j]; unsigned code = hh ? ((j) << 4 | (i)) : ((i) << 4 | (j)); \
      cd[t] = __uint_as_float((__float_as_uint(sv) & ~255u) | code); }
    CAND(0, 0, 1) CAND(1, 0, 2) CAND(2, 0, 3) CAND(3, 0, 4) CAND(4, 0, 5) CAND(5, 0, 6) CAND(6, 0, 7) CAND(7, 0, 8)
    CAND(8, 0, 9) CAND(9, 0, 10) CAND(10, 0, 11) CAND(11, 0, 12) CAND(12, 0, 13) CAND(13, 0, 14) CAND(14, 0, 15)
    CAND(15, 1, 2) CAND(16, 1, 3) CAND(17, 1, 4) CAND(18, 1, 5) CAND(19, 1, 6) CAND(20, 1, 7) CAND(21, 2, 3) CAND(22, 2, 4)
    {
      float d0 = hh ? x[2] + y[2] : x[0] + y[0];
      float d1 = hh ? x[3] + y[3] : x[1] + y[1];
      unsigned c0 = hh ? 0x22u : 0x00u, c1 = hh ? 0x33u : 0x11u;
      cd[23] = __uint_as_float((__float_as_uint(d0) & ~255u) | c0);
      cd[24] = __uint_as_float((__float_as_uint(d1) & ~255u) | c1);
    }
    {
      float prev = INFINITY;
#pragma unroll 1
      for (int p = 0; p < 16; ++p) {
        float cur = -INFINITY;
#pragma unroll
        for (int t = 0; t < 25; ++t) cur = fmaxf(cur, cd[t] < prev ? cd[t] : -INFINITY);
        cur = pair_max(cur);
        if (hh == 0) sW[r32 * 17 + p] = __float_as_uint(cur);
        prev = cur;
      }
    }
    __builtin_amdgcn_fence(__ATOMIC_RELEASE, "workgroup");
    __builtin_amdgcn_wave_barrier();
    __builtin_amdgcn_fence(__ATOMIC_ACQUIRE, "workgroup");
    {
      const unsigned* la = sL + r32 * 33;
      unsigned c0 = sW[r32 * 17] & 255u;
      float scmax = __uint_as_float(la[c0 >> 4] & ~127u) + __uint_as_float(la[16 + (c0 & 15)] & ~127u);
      float ex[8]; int ee[8]; float sum = 0.f;
#pragma unroll
      for (int k = 0; k < 8; ++k) {
        unsigned code = sW[r32 * 17 + hh * 8 + k] & 255u;
        unsigned ka = la[code >> 4], kb = la[16 + (code & 15)];
        float sc = __uint_as_float(ka & ~127u) + __uint_as_float(kb & ~127u);
        ex[k] = __expf(sc - scmax);
        ee[k] = (int)((ka & 127u) * 128u + (kb & 127u));
        sum += ex[k];
      }
      sum += __shfl_xor(sum, 32);
      float inv = 1.f / sum;
      size_t o = (size_t)(rowb + r32) * 128 + n * 16 + hh * 8;
      *(int4*)(ids + o) = make_int4(ee[0], ee[1], ee[2], ee[3]);
      *(int4*)(ids + o + 4) = make_int4(ee[4], ee[5], ee[6], ee[7]);
      *(float4*)(gw + o) = make_float4(ex[0] * inv, ex[1] * inv, ex[2] * inv, ex[3] * inv);
      *(float4*)(gw + o + 4) = make_float4(ex[4] * inv, ex[5] * inv, ex[6] * inv, ex[7] * inv);
    }
    __builtin_amdgcn_wave_barrier();
  }
}

typedef float f2v __attribute__((ext_vector_type(2)));
#define U8_SCALE 512.f
#define V8_SCALE 128.f
__device__ void convert_fp8(const float* __restrict__ src, unsigned char* __restrict__ dst, size_t n16, float scale,
                            int gtid, int gstride) {
  for (size_t i = gtid; i < n16; i += gstride) {
    unsigned w[4];
#pragma unroll
    for (int k = 0; k < 4; ++k) {
      float4 a = *(const float4*)(src + i * 16 + k * 4);
      float v0 = fminf(fmaxf(a.x * scale, -448.f), 448.f), v1 = fminf(fmaxf(a.y * scale, -448.f), 448.f);
      float v2 = fminf(fmaxf(a.z * scale, -448.f), 448.f), v3 = fminf(fmaxf(a.w * scale, -448.f), 448.f);
      int t = 0;
      t = __builtin_amdgcn_cvt_pk_fp8_f32(v0, v1, t, false);
      t = __builtin_amdgcn_cvt_pk_fp8_f32(v2, v3, t, true);
      w[k] = (unsigned)t;
    }
    *(uint4*)(dst + i * 16) = make_uint4(w[0], w[1], w[2], w[3]);
  }
}
__device__ __forceinline__ float dot16_fp8(uint4 u, const f2v* x2) {
  f2v acc = __builtin_amdgcn_cvt_pk_f32_fp8((int)u.x, false) * x2[0];
  acc += __builtin_amdgcn_cvt_pk_f32_fp8((int)u.x, true) * x2[1];
  acc += __builtin_amdgcn_cvt_pk_f32_fp8((int)u.y, false) * x2[2];
  acc += __builtin_amdgcn_cvt_pk_f32_fp8((int)u.y, true) * x2[3];
  acc += __builtin_amdgcn_cvt_pk_f32_fp8((int)u.z, false) * x2[4];
  acc += __builtin_amdgcn_cvt_pk_f32_fp8((int)u.z, true) * x2[5];
  acc += __builtin_amdgcn_cvt_pk_f32_fp8((int)u.w, false) * x2[6];
  acc += __builtin_amdgcn_cvt_pk_f32_fp8((int)u.w, true) * x2[7];
  return acc.x + acc.y;
}
__device__ __forceinline__ void axpy16_fp8(f2v* o2, float cf, uint4 v) {
  f2v c = {cf, cf};
  o2[0] += c * __builtin_amdgcn_cvt_pk_f32_fp8((int)v.x, false);
  o2[1] += c * __builtin_amdgcn_cvt_pk_f32_fp8((int)v.x, true);
  o2[2] += c * __builtin_amdgcn_cvt_pk_f32_fp8((int)v.y, false);
  o2[3] += c * __builtin_amdgcn_cvt_pk_f32_fp8((int)v.y, true);
  o2[4] += c * __builtin_amdgcn_cvt_pk_f32_fp8((int)v.z, false);
  o2[5] += c * __builtin_amdgcn_cvt_pk_f32_fp8((int)v.z, true);
  o2[6] += c * __builtin_amdgcn_cvt_pk_f32_fp8((int)v.w, false);
  o2[7] += c * __builtin_amdgcn_cvt_pk_f32_fp8((int)v.w, true);
}
#define PEER_LOAD(u, v, b)                                                                   \
  _Pragma("unroll") for (int k = 0; k < 8; ++k) {                                            \
    int j = (b) * 8 + k;                                                                     \
    int e = __builtin_amdgcn_readlane((b) < 8 ? id0 : id1, j & 63);                          \
    u[k] = *(const uint4*)(U8 + (size_t)e * 1024 + lane * 16);                               \
    v[k] = *(const uint4*)(V8 + (size_t)e * 1024 + lane * 16);                               \
  }
#define PEER_COMP(u, v, b)                                                                   \
  _Pragma("unroll") for (int hf = 0; hf < 2; ++hf) {                                         \
    float s = reduce4(dot16_fp8(u[hf * 4 + 0], x2), dot16_fp8(u[hf * 4 + 1], x2),           \
                      dot16_fp8(u[hf * 4 + 2], x2), dot16_fp8(u[hf * 4 + 3], x2)) * (1.f / U8_SCALE); \
    float act = 0.5f * s * (1.f + erff(s * 0.7071067811865475f));                            \
    float gsel = __shfl((b) < 8 ? g0 : g1, ((b) * 8 + hf * 4 + (lane >> 4)) & 63);           \
    float cfv = act * gsel * (1.f / V8_SCALE);                                               \
    axpy16_fp8(o2, __int_as_float(__builtin_amdgcn_readlane(__float_as_int(cfv), 0)), v[hf * 4 + 0]);  \
    axpy16_fp8(o2, __int_as_float(__builtin_amdgcn_readlane(__float_as_int(cfv), 16)), v[hf * 4 + 1]); \
    axpy16_fp8(o2, __int_as_float(__builtin_amdgcn_readlane(__float_as_int(cfv), 32)), v[hf * 4 + 2]); \
    axpy16_fp8(o2, __int_as_float(__builtin_amdgcn_readlane(__float_as_int(cfv), 48)), v[hf * 4 + 3]); \
  }
__device__ void phase_peer(const Params& P) {
  const int lane = threadIdx.x & 63, w = threadIdx.x >> 6;
  bfu* hq = (bfu*)(P.ws + SLOT(0));
  const unsigned char* U8 = (const unsigned char*)(P.ws + SLOT(2));
  const unsigned char* V8 = (const unsigned char*)(P.ws + SLOT(3));
  const int* ids = (const int*)(P.ws + SLOT(4));
  const float* gw = (const float*)(P.ws + SLOT(13));
  bfu* pbf = (bfu*)(P.ws + SLOT(6));
  for (int r = blockIdx.x * 4 + w; r < MT; r += gridDim.x * 4) {
    f2v x2[8], o2[8];
    {
      uint4 v0 = *(const uint4*)(hq + (size_t)r * 1024 + lane * 16);
      uint4 v1 = *(const uint4*)(hq + (size_t)r * 1024 + lane * 16 + 8);
      float xf[16];
      unpack8(v0, xf); unpack8(v1, xf + 8);
#pragma unroll
      for (int j = 0; j < 8; ++j) { x2[j].x = xf[2 * j]; x2[j].y = xf[2 * j + 1]; o2[j].x = 0.f; o2[j].y = 0.f; }
    }
    int id0 = ids[(size_t)r * 128 + lane], id1 = ids[(size_t)r * 128 + 64 + lane];
    float g0 = gw[(size_t)r * 128 + lane], g1 = gw[(size_t)r * 128 + 64 + lane];
    uint4 uA[8], vA[8], uB[8], vB[8];
    PEER_LOAD(uA, vA, 0)
    for (int b = 0; b < 16; b += 2) {
      PEER_LOAD(uB, vB, b + 1)
      PEER_COMP(uA, vA, b)
      if (b + 2 < 16) { PEER_LOAD(uA, vA, b + 2) }
      PEER_COMP(uB, vB, b + 1)
    }
    float* xr = P.out + (size_t)r * 1024 + lane * 16;
    float x3[16];
    float ss = 0.f;
#pragma unroll
    for (int k = 0; k < 4; ++k) {
      float4 a = *(const float4*)(xr + k * 4);
      x3[k * 4 + 0] = a.x + o2[k * 2].x; x3[k * 4 + 1] = a.y + o2[k * 2].y;
      x3[k * 4 + 2] = a.z + o2[k * 2 + 1].x; x3[k * 4 + 3] = a.w + o2[k * 2 + 1].y;
      *(float4*)(xr + k * 4) = make_float4(x3[k * 4], x3[k * 4 + 1], x3[k * 4 + 2], x3[k * 4 + 3]);
    }
#pragma unroll
    for (int j = 0; j < 16; ++j) ss += x3[j] * x3[j];
    ss = wave_sum(ss);
    float rstd = rsqrtf(ss * (1.f / 1024.f) + EPS);
    float hv[16];
#pragma unroll
    for (int k = 0; k < 4; ++k) {
      float4 ga = *(const float4*)(P.g_ple + lane * 16 + k * 4);
      hv[k * 4] = x3[k * 4] * rstd * ga.x; hv[k * 4 + 1] = x3[k * 4 + 1] * rstd * ga.y;
      hv[k * 4 + 2] = x3[k * 4 + 2] * rstd * ga.z; hv[k * 4 + 3] = x3[k * 4 + 3] * rstd * ga.w;
    }
    *(uint4*)(hq + (size_t)r * 1024 + lane * 16) = pack8(hv);
    *(uint4*)(hq + (size_t)r * 1024 + lane * 16 + 8) = pack8(hv + 8);
    {
      const float* pr = r < MP ? P.pp + (size_t)r * 256 : P.ps + (size_t)(r - MP) * 256;
      float4 a = *(const float4*)(pr + lane * 4);
      uint2 ov; ov.x = pack2(a.x, a.y); ov.y = pack2(a.z, a.w);
      *(uint2*)(pbf + (size_t)r * 256 + lane * 4) = ov;
    }
  }
}

__device__ void phase_ple(const Params& P, char* smem) {
  bfu* sA = (bfu*)smem; bfu* sB = sA + 128 * 72;
  const bfu* hg = (const bfu*)(P.ws + SLOT(0));
  const bfu* pbf = (const bfu*)(P.ws + SLOT(6));
  for (int t = blockIdx.x; t < 260 * 8; t += gridDim.x) {
    int mt, nt; tile_map(t, 260, 8, mt, nt);
    f32x16 acc[2][2]; zero_acc(acc);
    bfu* sT = (bfu*)smem; float* sT32 = (float*)smem;
    uint2 pg[16];
    gemm_acc(acc, hg + (size_t)mt * 128 * 1024, 1024, (const bfu*)(P.ws + O_WT_PG) + (size_t)nt * 128 * 1024, 1024, 1024, sA, sB);
    __syncthreads();
    {
      EPI_BEGIN
#pragma unroll
        for (int j = 0; j < 4; ++j) {
          sT[(r0 + j) * ST_LD + cl] = f2bf(sigmoidf_(acc[mi][0][q * 4 + j]));
          sT[(r0 + j) * ST_LD + cl + 64] = f2bf(sigmoidf_(acc[mi][1][q * 4 + j]));
        }
      EPI_END
    }
    __syncthreads();
#pragma unroll
    for (int i = 0; i < 16; ++i) {
      int id = threadIdx.x + i * 256, row = id >> 5, c4 = (id & 31) * 4;
      pg[i] = *(const uint2*)(sT + row * ST_LD + c4);
    }
    zero_acc(acc);
    gemm_acc(acc, pbf + (size_t)mt * 128 * 256, 256, (const bfu*)(P.ws + O_WT_PLE) + (size_t)nt * 128 * 256, 256, 256, sA, sB);
    __syncthreads();
    {
      EPI_BEGIN
#pragma unroll
        for (int j = 0; j < 4; ++j) {
          sT32[(r0 + j) * ST32_LD + cl] = acc[mi][0][q * 4 + j];
          sT32[(r0 + j) * ST32_LD + cl + 64] = acc[mi][1][q * 4 + j];
        }
      EPI_END
    }
    __syncthreads();
#pragma unroll
    for (int i = 0; i < 16; ++i) {
      int id = threadIdx.x + i * 256, row = id >> 5, c4 = (id & 31) * 4;
      float4 a = *(const float4*)(sT32 + row * ST32_LD + c4);
      float* op = P.out + (size_t)(mt * 128 + row) * 1024 + nt * 128 + c4;
      float4 x = *(const float4*)op;
      float g0 = bf2f(pg[i].x & 0xffff), g1 = bf2f(pg[i].x >> 16), g2 = bf2f(pg[i].y & 0xffff), g3 = bf2f(pg[i].y >> 16);
      *(float4*)op = make_float4(x.x + a.x * g0, x.y + a.y * g1, x.z + a.z * g2, x.w + a.w * g3);
    }
  }
}

__device__ void phase_final(const Params& P) {
  const int lane = threadIdx.x & 63, w = threadIdx.x >> 6;
  for (int r = blockIdx.x * 4 + w; r < MT; r += gridDim.x * 4) {
    float* xr = P.out + (size_t)r * 1024;
    float4 v[4]; float ss = 0.f;
#pragma unroll
    for (int i = 0; i < 4; ++i) {
      v[i] = *(const float4*)(xr + i * 256 + lane * 4);
      ss += v[i].x * v[i].x + v[i].y * v[i].y + v[i].z * v[i].z + v[i].w * v[i].w;
    }
    ss = wave_sum(ss);
    float rstd = rsqrtf(ss * (1.f / 1024.f) + EPS);
#pragma unroll
    for (int i = 0; i < 4; ++i) {
      float4 gg = *(const float4*)(P.g_final + i * 256 + lane * 4);
      *(float4*)(xr + i * 256 + lane * 4) = make_float4(v[i].x * rstd * gg.x, v[i].y * rstd * gg.y, v[i].z * rstd * gg.z, v[i].w * rstd * gg.w);
    }
  }
}

__global__ void __launch_bounds__(NTHREADS, 2) fwd_megakernel(Params P) {
  extern __shared__ __attribute__((aligned(16))) char smem[];
  cg::grid_group grid = cg::this_grid();
  __shared__ uint4 xb_words;
  if (threadIdx.x == 0) xb_words = make_uint4(0u, 0u, 0u, 0u);
  __syncthreads();
  XcdBarrier xb = xcd_barrier_post((unsigned*)(P.ws + O_BAR), (volatile LAS unsigned*)&xb_words);
  if (P.out == nullptr) grid.sync();
  const int gtid = blockIdx.x * NTHREADS + threadIdx.x, gstride = gridDim.x * NTHREADS;
  phase_prep(P, smem);
  xcd_barrier(xb);
  phase_gemm1(P, smem);
  xcd_barrier(xb);
  phase_conv(P);
  gate_scan(P);
  xcd_barrier(xb);
  m_fold(P);
  phase_mqk(P, smem);
  xcd_barrier(xb);
  for (int t = blockIdx.x; t < 4224; t += gridDim.x) phaseA_item(P, t / 2112, t % 2112, smem);
  xcd_barrier(xb);
  phase_scan(P);
  xcd_barrier(xb);
  for (int t = blockIdx.x; t < 4224; t += gridDim.x) phaseC_item(P, t / 2112, t % 2112, smem);
  xcd_barrier(xb);
  phase_merge(P, smem);
  xcd_barrier(xb);
  phase_outproj(P, smem);
  xcd_barrier(xb);
  phase_norm_rows(P, P.g_ffn, (bfu*)(P.ws + SLOT(0)));
  convert_fp8(P.peer_u, (unsigned char*)(P.ws + SLOT(2)), 16384ull * 1024 / 16, U8_SCALE, gtid, gstride);
  convert_fp8(P.peer_v, (unsigned char*)(P.ws + SLOT(3)), 16384ull * 1024 / 16, V8_SCALE, gtid, gstride);
  xcd_barrier(xb);
  phase_pq(P, smem);
  xcd_barrier(xb);
  phase_topk(P, smem);
  xcd_barrier(xb);
  phase_peer(P);
  xcd_barrier(xb);
  phase_ple(P, smem);
  xcd_barrier(xb);
  phase_final(P);
}

extern "C" void kernel_launch(void* const* d_in, const int* in_sizes, int n_in, void* d_out, int out_size,
                              void* d_ws, size_t ws_size, hipStream_t stream) {
  static int grid_blocks = 0;
  if (!grid_blocks) {
    hipFuncSetAttribute((const void*)fwd_megakernel, hipFuncAttributeMaxDynamicSharedMemorySize, SMEM_BYTES);
    int dev = 0, cus = 0, per_cu = 0;
    hipGetDevice(&dev);
    hipDeviceGetAttribute(&cus, hipDeviceAttributeMultiprocessorCount, dev);
    hipOccupancyMaxActiveBlocksPerMultiprocessor(&per_cu, fwd_megakernel, NTHREADS, SMEM_BYTES);
    if (per_cu > 2) per_cu = 2;
    if (per_cu < 1) per_cu = 1;
    grid_blocks = cus * per_cu;
  }
  Params p{};
  const float** pf = (const float**)&p;
  for (int i = 0; i < 32; ++i) pf[i] = (const float*)d_in[i];
  p.out = (float*)d_out;
  p.ws = (char*)d_ws;
  hipMemsetAsync((char*)d_ws + O_BAR, 0, XCD_BAR_WORDS * 4, stream);
  void* args[] = {&p};
  hipError_t e = hipLaunchCooperativeKernel((void*)fwd_megakernel, dim3(grid_blocks), dim3(NTHREADS), args, SMEM_BYTES, stream);
  if (e != hipSuccess) fprintf(stderr, "cooperative launch failed: %s (grid %d)\n", hipGetErrorString(e), grid_blocks);
}
```

```cpp
#include <hip/hip_runtime.h>
#include <hip/hip_cooperative_groups.h>
#include <cstdio>
namespace cg = cooperative_groups;

typedef unsigned short bfu;
typedef __attribute__((ext_vector_type(8))) short bf16x8;
typedef __attribute__((ext_vector_type(16))) float f32x16;

#define MT 33280
#define MP 32768
#define NTHREADS 256
#define EPS 1e-6f

struct Params {
  const float *xp, *xs, *pp, *ps, *st_ret, *st_C, *st_n, *st_m, *st_conv, *g_mix, *w_in, *g_ret_gn, *w_mq,
      *w_mk, *conv_w, *conv_b, *b_i, *b_f, *g_ml_gn, *w_skip, *w_up_r, *w_up_m, *w_out, *g_ffn, *w_pq,
      *peer_keys, *peer_u, *peer_v, *g_ple, *w_pg, *w_ple, *g_final;
  float* out;
  char* ws;
};

constexpr size_t O_WT_IN = 0;
constexpr size_t O_WT_UPR = O_WT_IN + 5632ull * 1024 * 2;
constexpr size_t O_WT_UPM = O_WT_UPR + 1024ull * 512 * 2;
constexpr size_t O_WT_OUT = O_WT_UPM + 1024ull * 512 * 2;
constexpr size_t O_WT_PQ = O_WT_OUT + 1024ull * 1024 * 2;
constexpr size_t O_WT_PG = O_WT_PQ + 2048ull * 1024 * 2;
constexpr size_t O_WT_PLE = O_WT_PG + 1024ull * 1024 * 2;
constexpr size_t O_KEYS = O_WT_PLE + 1024ull * 256 * 2;
constexpr size_t O_WT_MQ = O_KEYS + 16ull * 128 * 128 * 2;
constexpr size_t O_WT_MK = O_WT_MQ + 4ull * 128 * 128 * 2;
constexpr size_t O_COS = O_WT_MK + 4ull * 128 * 128 * 2;
constexpr size_t O_SIN = O_COS + 8192ull * 64 * 4;
constexpr size_t O_FQ = O_SIN + 8192ull * 64 * 4;
constexpr size_t O_UQ = O_FQ + (size_t)MT * 16;
constexpr size_t O_CMQ = O_UQ + (size_t)MT * 16;
constexpr size_t O_FL = O_CMQ + (size_t)MT * 16;
constexpr size_t O_UC = O_FL + 16384;
constexpr size_t O_AEND = O_UC + 16384;
constexpr size_t O_MCS = O_AEND + 16384;
constexpr size_t O_DN = O_MCS + 16384;
constexpr size_t O_DSS = O_DN + 2112ull * 128 * 4;
constexpr size_t O_GPRE = O_DSS + 2ull * 64 * 16384 * 2;
constexpr size_t O_BAR = O_GPRE + (size_t)MT * 32;
constexpr size_t O_SMALL_END = O_BAR + 16384;
constexpr size_t SLOT0 = 40ull << 20;
constexpr size_t USZ = (size_t)MT * 512 * 2;
static_assert(O_SMALL_END <= SLOT0, "small region overflow");
#define SLOT(i) (SLOT0 + (size_t)(i) * USZ)
constexpr size_t SB_T = 16ull * 128 * 8192;

constexpr size_t OO_Y = 0;
constexpr size_t OO_RETP = (size_t)MT * 1024;
constexpr size_t OO_CP = OO_RETP + 262144;
constexpr size_t OO_NP = OO_CP + 262144;
constexpr size_t OO_MP = OO_NP + 2048;
constexpr size_t OO_CONVP = OO_MP + 16;
constexpr size_t OO_RETS = OO_CONVP + 6144;
constexpr size_t OO_CS = OO_RETS + 1048576;
constexpr size_t OO_NS = OO_CS + 1048576;
constexpr size_t OO_MS = OO_NS + 8192;
constexpr size_t OO_CONVS = OO_MS + 64;

constexpr int SMEM_BYTES = 81152;

__device__ __forceinline__ bfu f2bf(float f) {
  unsigned u = __float_as_uint(f);
  u += 0x7fffu + ((u >> 16) & 1u);
  return (bfu)(u >> 16);
}
__device__ __forceinline__ float bf2f(bfu b) { return __uint_as_float(((unsigned)b) << 16); }
__device__ __forceinline__ unsigned pack2(float a, float b) { return (unsigned)f2bf(a) | ((unsigned)f2bf(b) << 16); }
__device__ __forceinline__ void unpack8(uint4 v, float* f) {
  f[0] = bf2f(v.x & 0xffff); f[1] = bf2f(v.x >> 16); f[2] = bf2f(v.y & 0xffff); f[3] = bf2f(v.y >> 16);
  f[4] = bf2f(v.z & 0xffff); f[5] = bf2f(v.z >> 16); f[6] = bf2f(v.w & 0xffff); f[7] = bf2f(v.w >> 16);
}
__device__ __forceinline__ uint4 pack8(const float* f) {
  uint4 o; o.x = pack2(f[0], f[1]); o.y = pack2(f[2], f[3]); o.z = pack2(f[4], f[5]); o.w = pack2(f[6], f[7]);
  return o;
}
__device__ __forceinline__ float wave_sum(float v) {
#pragma unroll
  for (int o = 32; o > 0; o >>= 1) v += __shfl_xor(v, o);
  return v;
}
__device__ __forceinline__ float wave_max(float v) {
#pragma unroll
  for (int o = 32; o > 0; o >>= 1) v = fmaxf(v, __shfl_xor(v, o));
  return v;
}
__device__ __forceinline__ float dpp_ror_add(float s, const int ctrl_sel) {
  int v = __float_as_int(s);
  int t;
  if (ctrl_sel == 8) t = __builtin_amdgcn_update_dpp(0, v, 0x128, 0xf, 0xf, false);
  else if (ctrl_sel == 4) t = __builtin_amdgcn_update_dpp(0, v, 0x124, 0xf, 0xf, false);
  else if (ctrl_sel == 2) t = __builtin_amdgcn_update_dpp(0, v, 0x122, 0xf, 0xf, false);
  else t = __builtin_amdgcn_update_dpp(0, v, 0x121, 0xf, 0xf, false);
  return s + __int_as_float(t);
}
__device__ __forceinline__ float reduce4(float p0, float p1, float p2, float p3) {
  auto r = __builtin_amdgcn_permlane32_swap(__float_as_int(p0), __float_as_int(p2), false, false);
  float sA = __int_as_float(r[0]) + __int_as_float(r[1]);
  r = __builtin_amdgcn_permlane32_swap(__float_as_int(p1), __float_as_int(p3), false, false);
  float sB = __int_as_float(r[0]) + __int_as_float(r[1]);
  r = __builtin_amdgcn_permlane16_swap(__float_as_int(sA), __float_as_int(sB), false, false);
  float s = __int_as_float(r[0]) + __int_as_float(r[1]);
  s = dpp_ror_add(s, 8); s = dpp_ror_add(s, 4); s = dpp_ror_add(s, 2); s = dpp_ror_add(s, 1);
  return s;
}
__device__ __forceinline__ float sigmoidf_(float x) { return 1.f / (1.f + __expf(-x)); }
__device__ __forceinline__ const float* xrow(const Params& P, int r) {
  return r < MP ? P.xp + (size_t)r * 1024 : P.xs + (size_t)(r - MP) * 1024;
}


#define XB_TMO      128
#define XB_XCNT(j)  (256  + 64 * (j))
#define XB_XSUB(j)  (1280 + 64 * (j))
#define XB_XGEN(j)  (2304 + 64 * (j))
#define XB_TOP      3328
#define XB_TOPGEN   3392
#define XCD_BAR_WORDS 3456
#define XB_SPIN_CAP (1u << 22)
#define LAS __attribute__((address_space(3)))
__device__ __forceinline__ unsigned xb_ld(unsigned* p) { return __hip_atomic_load(p, __ATOMIC_RELAXED, __HIP_MEMORY_SCOPE_AGENT); }
__device__ __forceinline__ unsigned xb_add(unsigned* p, unsigned v) { return __hip_atomic_fetch_add(p, v, __ATOMIC_RELAXED, __HIP_MEMORY_SCOPE_AGENT); }
__device__ __forceinline__ unsigned xb_xcc_id() { return (unsigned)__builtin_amdgcn_s_getreg((3 << 11) | 20) & 0xFu; }
#define XB_SPIN(cond, bar) do { unsigned _sp = 0; while (cond) { __builtin_amdgcn_s_sleep(1); \
    if ((++_sp & 255u) == 0u) { if (xb_ld(&(bar)[XB_TMO])) break; if (_sp > XB_SPIN_CAP) { atomicAdd(&(bar)[XB_TMO], 1u); break; } } } } while (0)
struct XcdBarrier { unsigned* bar; unsigned x; volatile LAS unsigned* st; };
__device__ __forceinline__ XcdBarrier xcd_barrier_post(unsigned* bar, volatile LAS unsigned* st) {
  XcdBarrier b; b.bar = bar; b.x = xb_xcc_id(); b.st = st;
  if (threadIdx.x == 0) (void)xb_add(&bar[XB_XCNT(b.x)], 1u);
  return b;
}
__device__ __forceinline__ void xcd_barrier_complete(unsigned* bar, unsigned x, unsigned& nloc, unsigned& nx) {
  const unsigned G = gridDim.x * gridDim.y * gridDim.z;
  unsigned sum, cnt, mine, sp = 0u;
  for (;;) {
    sum = 0u; cnt = 0u; mine = 0u;
#pragma unroll
    for (unsigned j = 0; j < 16; ++j) { const unsigned c = xb_ld(&bar[XB_XCNT(j)]); sum += c; cnt += (c > 0u) ? 1u : 0u; mine = (j == x) ? c : mine; }
    if (sum == G) break;
    __builtin_amdgcn_s_sleep(1);
    if ((++sp & 255u) == 0u) { if (xb_ld(&bar[XB_TMO])) break; if (sp > XB_SPIN_CAP) { atomicAdd(&bar[XB_TMO], 1u); break; } }
  }
  nloc = mine > 0u ? mine : 1u; nx = cnt > 0u ? cnt : 1u;
}
__device__ __forceinline__ void xcd_barrier(const XcdBarrier& b) {
  asm volatile("s_waitcnt vmcnt(0)" ::: "memory");
  __syncthreads();
  if (threadIdx.x == 0) {
    unsigned* bar = b.bar;
    __builtin_amdgcn_s_waitcnt(0);
    unsigned nloc = b.st[0], nx = b.st[1];
    if (nloc == 0u) { xcd_barrier_complete(bar, b.x, nloc, nx); b.st[0] = nloc; b.st[1] = nx; }
    const unsigned old = xb_add(&bar[XB_XSUB(b.x)], 1u);
    const unsigned gen = old / nloc;
    if (old + 1u == (gen + 1u) * nloc) {
      __builtin_amdgcn_fence(__ATOMIC_RELEASE, "agent");
      asm volatile("s_waitcnt vmcnt(0)" ::: "memory");
      const unsigned og = xb_add(&bar[XB_TOP], 1u);
      const unsigned tg = og / nx;
      if (og + 1u == (tg + 1u) * nx) xb_add(&bar[XB_TOPGEN], 1u);
      else XB_SPIN(xb_ld(&bar[XB_TOPGEN]) == tg, bar);
      __builtin_amdgcn_fence(__ATOMIC_ACQUIRE, "agent");
      xb_add(&bar[XB_XGEN(b.x)], 1u);
      asm volatile("s_waitcnt vmcnt(0)" ::: "memory");
    } else {
      XB_SPIN(xb_ld(&bar[XB_XGEN(b.x)]) == gen, bar);
      __builtin_amdgcn_fence(__ATOMIC_ACQUIRE, "agent");
      asm volatile("s_waitcnt vmcnt(0)" ::: "memory");
    }
  }
  __syncthreads();
}

__device__ __forceinline__ void gemm_acc(f32x16 (&acc)[2][2], const bfu* __restrict__ A, int lda,
                                         const bfu* __restrict__ Bt, int ldb, int K, bfu* sA, bfu*  ) {
  const int tid = threadIdx.x, lane = tid & 63, w = tid >> 6, wm = w & 1, wn = w >> 1;
  const int lr = tid >> 3;
  const int kc = ((tid & 7) ^ ((tid >> 4) & 7)) * 8;
  const bfu* Ap = A + (size_t)lr * lda + kc;
  const bfu* Bp = Bt + (size_t)lr * ldb + kc;
  const size_t a32 = (size_t)32 * lda, b32 = (size_t)32 * ldb;
  char* sbase = (char*)sA;
  char* ldst = sbase + tid * 16;
#define GISSUE(stage, k)                                                                                       \
  _Pragma("unroll") for (int i_ = 0; i_ < 4; ++i_) {                                                           \
    __builtin_amdgcn_global_load_lds((const unsigned*)(Ap + i_ * a32 + (k)),                                   \
                                     (LAS unsigned*)(ldst + (stage) * 32768 + i_ * 4096), 16, 0, 0);           \
    __builtin_amdgcn_global_load_lds((const unsigned*)(Bp + i_ * b32 + (k)),                                   \
                                     (LAS unsigned*)(ldst + (stage) * 32768 + 16384 + i_ * 4096), 16, 0, 0);   \
  }
  const int sw = (lane >> 1) & 7, hh = lane >> 5;
  const int rowA = (wm * 64 + (lane & 31)) * 128, rowB = (wn * 32 + (lane & 31)) * 128;
  __syncthreads();
  GISSUE(0, 0)
  int cur = 0;
  for (int k0 = 0; k0 < K; k0 += 64) {
    asm volatile("s_waitcnt vmcnt(0)" ::: "memory");
    __syncthreads();
    if (k0 + 64 < K) { GISSUE(cur ^ 1, k0 + 64) }
    const char* cA = sbase + cur * 32768;
    const char* cB = cA + 16384;
    __builtin_amdgcn_s_setprio(1);
#pragma unroll
    for (int ks = 0; ks < 4; ++ks) {
      const int pos = ((2 * ks + hh) ^ sw) * 16;
      bf16x8 af[2], bfr[2];
#pragma unroll
      for (int mi = 0; mi < 2; ++mi) af[mi] = *(const bf16x8*)(cA + rowA + mi * 32 * 128 + pos);
#pragma unroll
      for (int ni = 0; ni < 2; ++ni) bfr[ni] = *(const bf16x8*)(cB + rowB + ni * 64 * 128 + pos);
#pragma unroll
      for (int mi = 0; mi < 2; ++mi)
#pragma unroll
        for (int ni = 0; ni < 2; ++ni)
          acc[mi][ni] = __builtin_amdgcn_mfma_f32_32x32x16_bf16(af[mi], bfr[ni], acc[mi][ni], 0, 0, 0);
    }
    __builtin_amdgcn_s_setprio(0);
    cur ^= 1;
  }
}
#define gemm_acc1 gemm_acc
__device__ __forceinline__ void zero_acc(f32x16 (&acc)[2][2]) {
#pragma unroll
  for (int a = 0; a < 2; ++a)
#pragma unroll
    for (int b = 0; b < 2; ++b)
#pragma unroll
      for (int i = 0; i < 16; ++i) acc[a][b][i] = 0.f;
}
#define EPI_BEGIN                                                      \
  const int e_lane = threadIdx.x & 63, e_w = threadIdx.x >> 6;         \
  const int e_wm = e_w & 1, e_wn = e_w >> 1;                            \
  const int cl = e_wn * 32 + (e_lane & 31);                             \
  _Pragma("unroll") for (int mi = 0; mi < 2; ++mi)                      \
  _Pragma("unroll") for (int q = 0; q < 4; ++q) {                       \
    const int r0 = e_wm * 64 + mi * 32 + q * 8 + 4 * (e_lane >> 5);
#define EPI_END }

#define ST_LD 136
#define ST32_LD 132
__device__ __forceinline__ void copyout_bf16(const bfu* sT, bfu* dst, int ld) {
  const int tid = threadIdx.x;
#pragma unroll
  for (int i = 0; i < 8; ++i) {
    int id = tid + i * 256, row = id >> 4, c8 = (id & 15) * 8;
    *(uint4*)(dst + (size_t)row * ld + c8) = *(const uint4*)(sT + row * ST_LD + c8);
  }
}
__device__ __forceinline__ void stage_rm(bfu* sT, const f32x16 (&acc)[2][2], float sc) {
  EPI_BEGIN
#pragma unroll
    for (int j = 0; j < 4; ++j) {
      sT[(r0 + j) * ST_LD + cl] = f2bf(acc[mi][0][q * 4 + j] * sc);
      sT[(r0 + j) * ST_LD + cl + 64] = f2bf(acc[mi][1][q * 4 + j] * sc);
    }
  EPI_END
}

__device__ __forceinline__ void tile_map(int L, int nM, int nN, int& pm, int& pn) {
  const int nwg = nM * nN;
  const int q = nwg >> 3, r = nwg & 7, xcd = L & 7, off = L >> 3;
  int wgid = (xcd < r ? xcd * (q + 1) : r * (q + 1) + (xcd - r) * q) + off;
  const int nig = 8 * nN, gid = wgid / nig, fm = gid * 8;
  const int gsz = (nM - fm) < 8 ? (nM - fm) : 8;
  pm = fm + (wgid % nig) % gsz;
  pn = (wgid % nig) / gsz;
}
__device__ void transpose_w(const float* __restrict__ src, int K, int N, int src_ld, bfu* __restrict__ dst,
                            int remap, int gtid, int gstride) {
  int total = N * (K / 8);
  for (int i = gtid; i < total; i += gstride) {
    int n = i % N, kg = i / N;
    int col = (remap && n >= 3584) ? n + 8 : n;
    float v[8];
#pragma unroll
    for (int j = 0; j < 8; ++j) v[j] = src[(size_t)(kg * 8 + j) * src_ld + col];
    uint4 o;
    o.x = pack2(v[0], v[1]); o.y = pack2(v[2], v[3]); o.z = pack2(v[4], v[5]); o.w = pack2(v[6], v[7]);
    *(uint4*)(dst + (size_t)n * K + kg * 8) = o;
  }
}
__device__ void transpose_w_lds(const float* __restrict__ src, int K, int N, int src_ld, bfu* __restrict__ dst,
                                int remap, float* st, int boff) {
  const int tid = threadIdx.x;
  const int tilesN = N >> 6, ntile = (K >> 6) * tilesN;
  for (int t = (int)((blockIdx.x + gridDim.x - (boff % gridDim.x)) % gridDim.x); t < ntile; t += gridDim.x) {
    const int kt = t / tilesN, nt = t - kt * tilesN;
    {
      const int row = tid >> 2, c16 = (tid & 3) * 16;
      const int n0 = nt * 64 + c16;
      const int col = (remap && n0 >= 3584) ? n0 + 8 : n0;
      const float* sp = src + (size_t)(kt * 64 + row) * src_ld + col;
#pragma unroll
      for (int j = 0; j < 4; ++j) {
        float4 v = *(const float4*)(sp + j * 4);
        float* d = st + row * 65 + c16 + j * 4;
        d[0] = v.x; d[1] = v.y; d[2] = v.z; d[3] = v.w;
      }
    }
    __syncthreads();
    {
      const int n = tid >> 2, kc = (tid & 3) * 16;
#pragma unroll
      for (int hf = 0; hf < 2; ++hf) {
        float f[8];
#pragma unroll
        for (int j = 0; j < 8; ++j) f[j] = st[(kc + hf * 8 + j) * 65 + n];
        uint4 o;
        o.x = pack2(f[0], f[1]); o.y = pack2(f[2], f[3]); o.z = pack2(f[4], f[5]); o.w = pack2(f[6], f[7]);
        *(uint4*)(dst + (size_t)(nt * 64 + n) * K + kt * 64 + kc + hf * 8) = o;
      }
    }
    __syncthreads();
  }
}
__device__ void convert_bf(const float* __restrict__ src, bfu* __restrict__ dst, size_t n8, int gtid, int gstride) {
  for (size_t i = gtid; i < n8; i += gstride) {
    float4 a = *(const float4*)(src + i * 8), b = *(const float4*)(src + i * 8 + 4);
    uint4 o;
    o.x = pack2(a.x, a.y); o.y = pack2(a.z, a.w); o.z = pack2(b.x, b.y); o.w = pack2(b.z, b.w);
    *(uint4*)(dst + i * 8) = o;
  }
}

__device__ void prep_rows(const Params& P) {
  const int lane = threadIdx.x & 63, w = threadIdx.x >> 6;
  bfu* hbuf = (bfu*)(P.ws + SLOT(0));
  float* gpre = (float*)(P.ws + O_GPRE);
  for (int r = blockIdx.x * 4 + w; r < MT; r += gridDim.x * 4) {
    const float* xr = xrow(P, r);
    float4 v[4];
    float ss = 0.f;
#pragma unroll
    for (int i = 0; i < 4; ++i) {
      v[i] = *(const float4*)(xr + i * 256 + lane * 4);
      ss += v[i].x * v[i].x + v[i].y * v[i].y + v[i].z * v[i].z + v[i].w * v[i].w;
    }
    ss = wave_sum(ss);
    float rstd = rsqrtf(ss * (1.f / 1024.f) + EPS);
    float ga[8];
#pragma unroll
    for (int j = 0; j < 8; ++j) ga[j] = 0.f;
#pragma unroll
    for (int i = 0; i < 4; ++i) {
      float4 g = *(const float4*)(P.g_mix + i * 256 + lane * 4);
      float hv[4] = {v[i].x * rstd * g.x, v[i].y * rstd * g.y, v[i].z * rstd * g.z, v[i].w * rstd * g.w};
      uint2 o; o.x = pack2(hv[0], hv[1]); o.y = pack2(hv[2], hv[3]);
      *(uint2*)(hbuf + (size_t)r * 1024 + i * 256 + lane * 4) = o;
#pragma unroll
      for (int j = 0; j < 4; ++j) {
        const float* wr = P.w_in + (size_t)(i * 256 + lane * 4 + j) * 5640 + 3584;
        float4 w0 = *(const float4*)wr, w1 = *(const float4*)(wr + 4);
        ga[0] += hv[j] * w0.x; ga[1] += hv[j] * w0.y; ga[2] += hv[j] * w0.z; ga[3] += hv[j] * w0.w;
        ga[4] += hv[j] * w1.x; ga[5] += hv[j] * w1.y; ga[6] += hv[j] * w1.z; ga[7] += hv[j] * w1.w;
      }
    }
    float si = reduce4(ga[0], ga[1], ga[2], ga[3]);
    float sf = reduce4(ga[4], ga[5], ga[6], ga[7]);
    if ((lane & 15) == 0) {
      int k = lane >> 4;
      gpre[(size_t)r * 8 + k] = si + P.b_i[k];
      gpre[(size_t)r * 8 + 4 + k] = sf + P.b_f[k];
    }
  }
}
__device__ void gate_scan(const Params& P) {
  const int lane = threadIdx.x & 63, w = threadIdx.x >> 6;
  const float* gpre = (const float*)(P.ws + O_GPRE);
  for (int item = blockIdx.x * 4 + w; item < 528 * 4; item += gridDim.x * 4) {
    int tile = item >> 2, h = item & 3;
    int row0, L;
    if (tile < 512) { row0 = tile * 64; L = 64; } else { row0 = MP + (tile - 512) * 32; L = 32; }
    const int s = lane;
    bool valid = s < L;
    float ig = valid ? gpre[(size_t)(row0 + s) * 8 + h] : -INFINITY;
    float fg = valid ? gpre[(size_t)(row0 + s) * 8 + 4 + h] : 0.f;
    float lf = valid ? (fminf(fg, 0.f) - log1pf(__expf(-fabsf(fg)))) : 0.f;
    float F = lf;
#pragma unroll
    for (int o = 1; o < 64; o <<= 1) { float t = __shfl_up(F, o); if (lane >= o) F += t; }
    float u = valid ? ig - F : -INFINITY;
    float cm = u;
#pragma unroll
    for (int o = 1; o < 64; o <<= 1) { float t = __shfl_up(cm, o); if (lane >= o) cm = fmaxf(cm, t); }
    if (valid) {
      size_t gi = (size_t)(row0 + s) * 4 + h;
      ((float*)(P.ws + O_FQ))[gi] = F;
      ((float*)(P.ws + O_UQ))[gi] = u;
      ((float*)(P.ws + O_CMQ))[gi] = cm;
      if (s == L - 1) {
        ((float*)(P.ws + O_FL))[tile * 4 + h] = F;
        ((float*)(P.ws + O_UC))[tile * 4 + h] = cm;
      }
    }
  }
}

__device__ void phase_prep(const Params& P, char* smem) {
  const int gtid = blockIdx.x * NTHREADS + threadIdx.x, gstride = gridDim.x * NTHREADS;
  prep_rows(P);
  transpose_w_lds(P.w_in, 1024, 5632, 5640, (bfu*)(P.ws + O_WT_IN), 1, (float*)smem, 0);
  transpose_w_lds(P.w_up_r, 512, 1024, 1024, (bfu*)(P.ws + O_WT_UPR), 0, (float*)smem, 1408);
  transpose_w_lds(P.w_up_m, 512, 1024, 1024, (bfu*)(P.ws + O_WT_UPM), 0, (float*)smem, 1536);
  transpose_w_lds(P.w_out, 1024, 1024, 1024, (bfu*)(P.ws + O_WT_OUT), 0, (float*)smem, 1664);
  transpose_w_lds(P.w_pq, 1024, 2048, 2048, (bfu*)(P.ws + O_WT_PQ), 0, (float*)smem, 1920);
  transpose_w_lds(P.w_pg, 1024, 1024, 1024, (bfu*)(P.ws + O_WT_PG), 0, (float*)smem, 2432);
  transpose_w_lds(P.w_ple, 256, 1024, 1024, (bfu*)(P.ws + O_WT_PLE), 0, (float*)smem, 2688);
  for (int h = 0; h < 4; ++h) {
    transpose_w_lds(P.w_mq + h * 16384, 128, 128, 128, (bfu*)(P.ws + O_WT_MQ) + h * 16384, 0, (float*)smem, 2752 + h * 8);
    transpose_w_lds(P.w_mk + h * 16384, 128, 128, 128, (bfu*)(P.ws + O_WT_MK) + h * 16384, 0, (float*)smem, 2756 + h * 8);
  }
  convert_bf(P.peer_keys, (bfu*)(P.ws + O_KEYS), 16 * 128 * 128 / 8, gtid, gstride);
  float* ct = (float*)(P.ws + O_COS); float* st = (float*)(P.ws + O_SIN);
  for (int i = gtid; i < 8192 * 64; i += gstride) {
    int pos = i >> 6, j = i & 63;
    float inv = exp2f(-(float)j * (13.287712379549449f / 64.f));
    float angf = (float)pos * inv;
    double a = (double)angf;
    double k = rint(a * 0.15915494309189535);
    float r = (float)(a - k * 6.283185307179586);
    ct[i] = __cosf(r); st[i] = __sinf(r);
  }
}

__device__ void phase_gemm1(const Params& P, char* smem) {
  bfu* sA = (bfu*)smem; bfu* sB = sA + 128 * 72;
  const bfu* hbuf = (const bfu*)(P.ws + SLOT(0));
  const bfu* wt = (const bfu*)(P.ws + O_WT_IN);
  const float* ct = (const float*)(P.ws + O_COS); const float* stb = (const float*)(P.ws + O_SIN);
  for (int t = blockIdx.x; t < 260 * 44; t += gridDim.x) {
    int mt, nt; tile_map(t, 260, 44, mt, nt);
    f32x16 acc[2][2]; zero_acc(acc);
    gemm_acc(acc, hbuf + (size_t)mt * 128 * 1024, 1024, wt + (size_t)nt * 128 * 1024, 1024, 1024, sA, sB);
    const int rbase = mt * 128;
    const bool prompt = rbase < MP;
    int region = nt >> 2, hh = nt & 3;
    bfu* sT = (bfu*)smem;
    __syncthreads();
    if (region <= 1) {
      float sc = region == 1 ? 0.08838834764831845f : 1.f;
      EPI_BEGIN
#pragma unroll
        for (int j = 0; j < 4; ++j) {
          int rr = rbase + r0 + j;
          int pos = prompt ? (rr & 8191) : 2048 + ((rr - MP) & 31);
          float c = ct[pos * 64 + cl], sn = stb[pos * 64 + cl];
          float a = acc[mi][0][q * 4 + j], b = acc[mi][1][q * 4 + j];
          sT[(r0 + j) * ST_LD + cl] = f2bf((a * c - b * sn) * sc);
          sT[(r0 + j) * ST_LD + cl + 64] = f2bf((a * sn + b * c) * sc);
        }
      EPI_END
      __syncthreads();
      copyout_bf16(sT, (bfu*)(P.ws + SLOT(2 + region)) + (size_t)rbase * 512 + hh * 128, 512);
    } else if (region == 2 || region == 5) {
      EPI_BEGIN
        uint2 va, vb;
        va.x = pack2(acc[mi][0][q * 4 + 0], acc[mi][0][q * 4 + 1]); va.y = pack2(acc[mi][0][q * 4 + 2], acc[mi][0][q * 4 + 3]);
        vb.x = pack2(acc[mi][1][q * 4 + 0], acc[mi][1][q * 4 + 1]); vb.y = pack2(acc[mi][1][q * 4 + 2], acc[mi][1][q * 4 + 3]);
        *(uint2*)(sT + cl * ST_LD + r0) = va;
        *(uint2*)(sT + (cl + 64) * ST_LD + r0) = vb;
      EPI_END
      __syncthreads();
      bfu* dst = (bfu*)(P.ws + SLOT(region == 2 ? 4 : 7));
#pragma unroll
      for (int i = 0; i < 8; ++i) {
        int id = threadIdx.x + i * 256, e = id >> 4, c8 = (id & 15) * 8;
        size_t o;
        if (prompt) { int bb = rbase >> 13, tt = (rbase & 8191) + c8; o = ((size_t)((bb * 4 + hh) * 128 + e)) * 8192 + tt; }
        else { int rs = rbase - MP + c8, bb = rs >> 5, tt = rs & 31; o = SB_T + ((size_t)((bb * 4 + hh) * 128 + e)) * 32 + tt; }
        *(uint4*)(dst + o) = *(const uint4*)(sT + e * ST_LD + c8);
      }
    } else if (region == 3 || region == 4 || region == 6) {
      stage_rm(sT, acc, 1.f);
      __syncthreads();
      copyout_bf16(sT, (bfu*)(P.ws + SLOT(region == 3 ? 5 : (region == 4 ? 6 : 8))) + (size_t)rbase * 512 + hh * 128, 512);
    } else {
      int gi = nt - 28;
      stage_rm(sT, acc, 1.f);
      __syncthreads();
      copyout_bf16(sT, (bfu*)(P.ws + SLOT(gi < 8 ? 9 : 11)) + (size_t)rbase * 1024 + (gi & 7) * 128, 1024);
    }
  }
}

__device__ void phase_conv(const Params& P) {
  const int gtid = blockIdx.x * NTHREADS + threadIdx.x, gstride = gridDim.x * NTHREADS;
  const bfu* xm = (const bfu*)(P.ws + SLOT(6));
  bfu* cb = (bfu*)(P.ws + SLOT(0));
  for (int i = gtid; i < MT * 64; i += gstride) {
    int r = i >> 6, c0 = (i & 63) * 8;
    int t, T, bb; bool prompt = r < MP;
    if (prompt) { bb = r >> 13; t = r & 8191; T = 8192; } else { int rs = r - MP; bb = rs >> 5; t = rs & 31; T = 32; }
    float y[8];
#pragma unroll
    for (int j = 0; j < 8; ++j) y[j] = P.conv_b[c0 + j];
#pragma unroll
    for (int k = 0; k < 4; ++k) {
      int tt = t - 3 + k;
      float xv[8];
      if (tt >= 0) {
        uint4 v = *(const uint4*)(xm + (size_t)(r - 3 + k) * 512 + c0);
        xv[0] = bf2f(v.x & 0xffff); xv[1] = bf2f(v.x >> 16); xv[2] = bf2f(v.y & 0xffff); xv[3] = bf2f(v.y >> 16);
        xv[4] = bf2f(v.z & 0xffff); xv[5] = bf2f(v.z >> 16); xv[6] = bf2f(v.w & 0xffff); xv[7] = bf2f(v.w >> 16);
      } else if (!prompt) {
        const float* sp = P.st_conv + (size_t)(bb * 3 + (tt + 3)) * 512 + c0;
#pragma unroll
        for (int j = 0; j < 8; ++j) xv[j] = sp[j];
      } else {
#pragma unroll
        for (int j = 0; j < 8; ++j) xv[j] = 0.f;
      }
#pragma unroll
      for (int j = 0; j < 8; ++j) y[j] += xv[j] * P.conv_w[k * 512 + c0 + j];
    }
    if (t >= T - 3) {
      uint4 v = *(const uint4*)(xm + (size_t)r * 512 + c0);
      float* dst = (prompt ? P.out + OO_CONVP : P.out + OO_CONVS) + (size_t)(bb * 3 + (t - (T - 3))) * 512 + c0;
      dst[0] = bf2f(v.x & 0xffff); dst[1] = bf2f(v.x >> 16); dst[2] = bf2f(v.y & 0xffff); dst[3] = bf2f(v.y >> 16);
      dst[4] = bf2f(v.z & 0xffff); dst[5] = bf2f(v.z >> 16); dst[6] = bf2f(v.w & 0xffff); dst[7] = bf2f(v.w >> 16);
    }
    uint4 o;
#pragma unroll
    for (int j = 0; j < 8; ++j) y[j] = y[j] * sigmoidf_(y[j]);
    o.x = pack2(y[0], y[1]); o.y = pack2(y[2], y[3]); o.z = pack2(y[4], y[5]); o.w = pack2(y[6], y[7]);
    *(uint4*)(cb + (size_t)r * 512 + c0) = o;
  }
}

__device__ void m_fold(const Params& P) {
  const int gtid = blockIdx.x * NTHREADS + threadIdx.x;
  const float* FL = (const float*)(P.ws + O_FL); const float* UC = (const float*)(P.ws + O_UC);
  float* MCS = (float*)(P.ws + O_MCS);
  if (gtid < 16) {
    int b = gtid >> 2, h = gtid & 3;
    float m = 0.f;
    for (int c = 0; c < 128; c += 8) {
      float fl[8], uc[8];
#pragma unroll
      for (int k = 0; k < 8; ++k) { fl[k] = FL[(b * 128 + c + k) * 4 + h]; uc[k] = UC[(b * 128 + c + k) * 4 + h]; }
#pragma unroll
      for (int k = 0; k < 8; ++k) { MCS[gtid * 128 + c + k] = m; m = fl[k] + fmaxf(m, uc[k]); }
    }
  } else if (gtid < 16 + 64) {
    int bh = gtid - 16;
    MCS[2048 + bh] = P.st_m[bh];
  }
}
__device__ void phase_mqk(const Params& P, char* smem) {
  bfu* sA = (bfu*)smem; bfu* sB = sA + 128 * 72;
  const bfu* cb = (const bfu*)(P.ws + SLOT(0));
  for (int t = blockIdx.x; t < 260 * 8; t += gridDim.x) {
    int mt = t >> 3, which = (t >> 2) & 1, hh = t & 3;
    const bfu* wt = (const bfu*)(P.ws + (which ? O_WT_MK : O_WT_MQ)) + hh * 16384;
    f32x16 acc[2][2]; zero_acc(acc);
    gemm_acc(acc, cb + (size_t)mt * 128 * 512 + hh * 128, 512, wt, 128, 128, sA, sB);
    bfu* dst = (bfu*)(P.ws + SLOT(which ? 13 : 1));
    float sc = which ? 0.08838834764831845f : 1.f;
    bfu* sT = (bfu*)smem;
    __syncthreads();
    stage_rm(sT, acc, sc);
    __syncthreads();
    copyout_bf16(sT, dst + (size_t)mt * 128 * 512 + hh * 128, 512);
  }
}

struct Item { int b, h, c, row0, L, T, chunk, bh; bool prompt; size_t vt_off; };
__device__ __forceinline__ Item decode_item(int idx) {
  Item it;
  if (idx < 2048) {
    it.prompt = true; it.b = idx >> 9; it.h = (idx >> 7) & 3; it.c = idx & 127; it.row0 = it.b * 8192 + it.c * 64;
    it.L = 64; it.T = 8192; it.chunk = it.b * 128 + it.c; it.bh = it.b * 4 + it.h;
    it.vt_off = ((size_t)(it.bh * 128)) * 8192 + it.c * 64;
  } else {
    int si = idx - 2048; it.prompt = false; it.b = si >> 2; it.h = si & 3; it.c = 0; it.row0 = MP + it.b * 32;
    it.L = 32; it.T = 32; it.chunk = 512 + it.b; it.bh = it.b * 4 + it.h;
    it.vt_off = SB_T + ((size_t)(it.bh * 128)) * 32;
  }
  return it;
}
__device__ __forceinline__ bfu* ds_ptr(const Params& P, int mixer, int idx) {
  if (idx < 2048) return (bfu*)P.out + ((size_t)(mixer * 2048 + idx)) * 16384;
  return (bfu*)(P.ws + O_DSS) + ((size_t)(mixer * 64 + (idx - 2048))) * 16384;
}
__device__ __forceinline__ float ret_lg(int h) { return log1pf(-exp2f(-5.f - (float)h)); }

__device__ void phaseA_item(const Params& P, int mixer, int idx, char* smem) {
  const int tid = threadIdx.x, lane = tid & 63, w = tid >> 6, wm = w & 1, wn = w >> 1;
  Item it = decode_item(idx);
  bfu* sK = (bfu*)smem; bfu* sV = sK + 128 * 72;
  float* sw = (float*)(sV + 128 * 72);
  float* sm = sw + 64;
  const int L = it.L, h = it.h;
  const bfu* Ksrc = (const bfu*)(P.ws + SLOT(mixer == 0 ? 3 : 13)) + (size_t)it.row0 * 512 + h * 128;
  const bfu* Vsrc = (const bfu*)(P.ws + SLOT(mixer == 0 ? 4 : 7)) + it.vt_off;
  uint4 kreg[4], vreg[4];
#pragma unroll
  for (int i = 0; i < 4; ++i) {
    int id = tid + i * 256, s = id & 63, dc = (id >> 6) * 8;
    kreg[i] = make_uint4(0, 0, 0, 0);
    if (s < L) kreg[i] = *(const uint4*)(Ksrc + (size_t)s * 512 + dc);
    int e = id >> 3, sc = (id & 7) * 8;
    vreg[i] = make_uint4(0, 0, 0, 0);
    if (sc < L) vreg[i] = *(const uint4*)(Vsrc + (size_t)e * it.T + sc);
  }
  if (mixer == 0) {
    if (tid < 64) { float lg = ret_lg(h); sw[tid] = tid < L ? __expf(lg * (float)(L - 1 - tid)) : 0.f; }
  } else {
    const float* FL = (const float*)(P.ws + O_FL); const float* UC = (const float*)(P.ws + O_UC);
    float mc = ((const float*)(P.ws + O_MCS))[idx];
    float Ml = fmaxf(mc, UC[it.chunk * 4 + h]);
    if (tid < 64) sw[tid] = tid < L ? __expf(((const float*)(P.ws + O_UQ))[(size_t)(it.row0 + tid) * 4 + h] - Ml) : 0.f;
    if (tid == 0) {
      ((float*)(P.ws + O_AEND))[idx] = __expf(mc - Ml);
      if (!it.prompt) P.out[OO_MS + it.bh] = FL[it.chunk * 4 + h] + Ml;
      else if (it.c == 127) P.out[OO_MP + it.bh] = FL[it.chunk * 4 + h] + Ml;
    }
  }
  __syncthreads();
#pragma unroll
  for (int i = 0; i < 4; ++i) {
    int id = tid + i * 256, s = id & 63, dc = (id >> 6) * 8;
    uint4 v = kreg[i];
    float ww = sw[s];
    unsigned vv[4] = {v.x, v.y, v.z, v.w};
#pragma unroll
    for (int j = 0; j < 4; ++j) {
      sK[(dc + 2 * j) * 72 + s] = f2bf(bf2f(vv[j] & 0xffff) * ww);
      sK[(dc + 2 * j + 1) * 72 + s] = f2bf(bf2f(vv[j] >> 16) * ww);
    }
  }
#pragma unroll
  for (int i = 0; i < 4; ++i) {
    int id = tid + i * 256, e = id >> 3, sc = (id & 7) * 8;
    *(uint4*)(sV + e * 72 + sc) = vreg[i];
  }
  __syncthreads();
  f32x16 acc[2][2]; zero_acc(acc);
#pragma unroll
  for (int ks = 0; ks < 4; ++ks) {
    bf16x8 af[2], bfr[2];
#pragma unroll
    for (int mi = 0; mi < 2; ++mi)
      af[mi] = *(const bf16x8*)(sK + (wm * 64 + mi * 32 + (lane & 31)) * 72 + ks * 16 + (lane >> 5) * 8);
#pragma unroll
    for (int ni = 0; ni < 2; ++ni)
      bfr[ni] = *(const bf16x8*)(sV + (wn * 32 + ni * 64 + (lane & 31)) * 72 + ks * 16 + (lane >> 5) * 8);
#pragma unroll
    for (int mi = 0; mi < 2; ++mi)
#pragma unroll
      for (int ni = 0; ni < 2; ++ni)
        acc[mi][ni] = __builtin_amdgcn_mfma_f32_32x32x16_bf16(af[mi], bfr[ni], acc[mi][ni], 0, 0, 0);
  }
  bfu* dS = ds_ptr(P, mixer, idx);
  EPI_BEGIN
#pragma unroll
    for (int ni = 0; ni < 2; ++ni) {
      int e = cl + ni * 64;
      uint2 o; o.x = pack2(acc[mi][ni][q * 4 + 0], acc[mi][ni][q * 4 + 1]); o.y = pack2(acc[mi][ni][q * 4 + 2], acc[mi][ni][q * 4 + 3]);
      *(uint2*)(dS + e * 128 + r0) = o;
    }
  EPI_END
  if (mixer == 1 && tid < 128) {
    float s = 0.f;
#pragma unroll
    for (int j = 0; j < 8; ++j) { float f[8]; unpack8(*(const uint4*)(sK + tid * 72 + j * 8), f);
#pragma unroll
      for (int k = 0; k < 8; ++k) s += f[k]; }
    ((float*)(P.ws + O_DN))[(size_t)idx * 128 + tid] = s;
  }
  __syncthreads();
}

__device__ void phase_scan(const Params& P) {
  const int gtid = blockIdx.x * NTHREADS + threadIdx.x, gstride = gridDim.x * NTHREADS;
  const float* AE = (const float*)(P.ws + O_AEND);
  for (int i = gtid; i < 131072; i += gstride) {
    int mixer = i >> 16, bh = (i >> 12) & 15, eo = (i & 4095) * 4;
    int h = bh & 3;
    float gch = __expf(ret_lg(h) * 64.f);
    float st[4];
#pragma unroll
    for (int j = 0; j < 4; ++j) st[j] = 0.f;
    bfu* base = (bfu*)P.out + ((size_t)(mixer * 2048 + bh * 128)) * 16384 + eo;
    for (int c = 0; c < 128; c += 8) {
      uint2 v[8];
#pragma unroll
      for (int k = 0; k < 8; ++k) v[k] = *(const uint2*)(base + (size_t)(c + k) * 16384);
#pragma unroll
      for (int k = 0; k < 8; ++k) {
        float dec = mixer == 0 ? gch : AE[bh * 128 + c + k];
        float d0 = bf2f(v[k].x & 0xffff), d1 = bf2f(v[k].x >> 16), d2 = bf2f(v[k].y & 0xffff), d3 = bf2f(v[k].y >> 16);
        uint2 o; o.x = pack2(st[0], st[1]); o.y = pack2(st[2], st[3]);
        *(uint2*)(base + (size_t)(c + k) * 16384) = o;
        st[0] = dec * st[0] + d0; st[1] = dec * st[1] + d1; st[2] = dec * st[2] + d2; st[3] = dec * st[3] + d3;
      }
    }
    float* o = P.out + (mixer == 0 ? OO_RETP : OO_CP) + (size_t)bh * 16384;
    int e = eo >> 7, d0i = eo & 127;
#pragma unroll
    for (int j = 0; j < 4; ++j) o[(d0i + j) * 128 + e] = st[j];
  }
  for (int i = gtid; i < 2 * 64 * 2048; i += gstride) {
    int mixer = i >> 17, bh = (i >> 11) & 63, eo = (i & 2047) * 8;
    int h = bh & 3;
    int e = eo >> 7, d0 = eo & 127;
    const float* s0 = (mixer == 0 ? P.st_ret : P.st_C) + (size_t)bh * 16384;
    float st[8];
#pragma unroll
    for (int j = 0; j < 8; ++j) st[j] = s0[(d0 + j) * 128 + e];
    bfu* p = (bfu*)(P.ws + O_DSS) + ((size_t)(mixer * 64 + bh)) * 16384 + eo;
    float d[8]; unpack8(*(const uint4*)p, d);
    *(uint4*)p = pack8(st);
    float dec = mixer == 0 ? __expf(ret_lg(h) * 32.f) : AE[2048 + bh];
    float* o = P.out + (mixer == 0 ? OO_RETS : OO_CS) + (size_t)bh * 16384;
#pragma unroll
    for (int j = 0; j < 8; ++j) o[(d0 + j) * 128 + e] = dec * st[j] + d[j];
  }
  float* DN = (float*)(P.ws + O_DN);
  for (int i = gtid; i < 16 * 128; i += gstride) {
    int bh = i >> 7, d = i & 127;
    float n = 0.f;
    for (int c = 0; c < 128; ++c) {
      size_t o = (size_t)(bh * 128 + c) * 128 + d;
      float v = DN[o]; DN[o] = n; n = AE[bh * 128 + c] * n + v;
    }
    P.out[OO_NP + i] = n;
  }
  for (int i = gtid; i < 64 * 128; i += gstride) {
    int bh = i >> 7, d = i & 127;
    size_t o = (size_t)(2048 + bh) * 128 + d;
    float n0 = P.st_n[i]; float v = DN[o]; DN[o] = n0;
    P.out[OO_NS + i] = AE[2048 + bh] * n0 + v;
  }
}

__device__ void phaseC_item(const Params& P, int mixer, int idx, char* smem) {
  const int tid = threadIdx.x, lane = tid & 63, w = tid >> 6;
  Item it = decode_item(idx);
  const int L = it.L, h = it.h;
  bfu* sQ = (bfu*)smem;
  bfu* sKV = sQ + 64 * 136;
  bfu* sP = sKV + 128 * 72;
  bfu* sS = sP + 64 * 72;
  float* sO = (float*)sS;
  float* sRow = (float*)(sS + 128 * 136);
  const bfu* Qsrc = (const bfu*)(P.ws + SLOT(mixer == 0 ? 2 : 1)) + (size_t)it.row0 * 512 + h * 128;
  const bfu* Ksrc = (const bfu*)(P.ws + SLOT(mixer == 0 ? 3 : 13)) + (size_t)it.row0 * 512 + h * 128;
  const bfu* Vsrc = (const bfu*)(P.ws + SLOT(mixer == 0 ? 4 : 7)) + it.vt_off;
  const bfu* Ssrc = ds_ptr(P, mixer, idx);
  const float lg = ret_lg(h);
  uint4 vpre[4];
#pragma unroll
  for (int i = 0; i < 4; ++i) {
    int id = tid + i * 256, e = id >> 3, sc = (id & 7) * 8;
    vpre[i] = make_uint4(0, 0, 0, 0);
    if (sc < L) vpre[i] = *(const uint4*)(Vsrc + (size_t)e * it.T + sc);
  }
#pragma unroll
  for (int i = 0; i < 4; ++i) {
    int id = tid + i * 256, s = id >> 4, dc = (id & 15) * 8;
    uint4 vq = make_uint4(0, 0, 0, 0), vk = vq;
    if (s < L) { vq = *(const uint4*)(Qsrc + (size_t)s * 512 + dc); vk = *(const uint4*)(Ksrc + (size_t)s * 512 + dc); }
    *(uint4*)(sQ + s * 136 + dc) = vq;
    *(uint4*)(sKV + s * 136 + dc) = vk;
  }
#pragma unroll
  for (int i = 0; i < 8; ++i) {
    int id = tid + i * 256, e = id >> 4, dc = (id & 15) * 8;
    *(uint4*)(sS + e * 136 + dc) = *(const uint4*)(Ssrc + e * 128 + dc);
  }
  if (tid < 64) {
    int i = tid;
    if (mixer == 0) {
      sRow[128 + i] = __expf(lg * (float)(i + 1));
    } else {
      float mc = ((const float*)(P.ws + O_MCS))[idx];
      size_t gi = (size_t)(it.row0 + i) * 4 + h;
      bool valid = i < L;
      float u = valid ? ((const float*)(P.ws + O_UQ))[gi] : -INFINITY;
      float M = valid ? fmaxf(mc, ((const float*)(P.ws + O_CMQ))[gi]) : 0.f;
      float F = valid ? ((const float*)(P.ws + O_FQ))[gi] : 0.f;
      sRow[i] = u; sRow[64 + i] = M; sRow[128 + i] = valid ? __expf(mc - M) : 0.f;
      sRow[256 + i] = __expf(-(F + M));
    }
  }
  __syncthreads();
  {
    const int mi = w & 1, ni = w >> 1;
    f32x16 acc;
#pragma unroll
    for (int i = 0; i < 16; ++i) acc[i] = 0.f;
#pragma unroll 2
    for (int ks = 0; ks < 8; ++ks) {
      bf16x8 af = *(const bf16x8*)(sQ + (mi * 32 + (lane & 31)) * 136 + ks * 16 + (lane >> 5) * 8);
      bf16x8 bfr = *(const bf16x8*)(sKV + (ni * 32 + (lane & 31)) * 136 + ks * 16 + (lane >> 5) * 8);
      acc = __builtin_amdgcn_mfma_f32_32x32x16_bf16(af, bfr, acc, 0, 0, 0);
    }
    const int s = ni * 32 + (lane & 31);
    float us = mixer ? sRow[s] : 0.f;
#pragma unroll
    for (int reg = 0; reg < 16; ++reg) {
      int i = mi * 32 + (reg & 3) + 8 * (reg >> 2) + 4 * (lane >> 5);
      float wgt;
      if (mixer == 0) wgt = (s <= i) ? __expf(lg * (float)(i - s)) : 0.f;
      else wgt = (s <= i && i < L) ? __expf(us - sRow[64 + i]) : 0.f;
      sP[i * 72 + s] = f2bf(acc[reg] * wgt);
    }
  }
  __syncthreads();
#pragma unroll
  for (int i = 0; i < 4; ++i) {
    int id = tid + i * 256, e = id >> 3, sc = (id & 7) * 8;
    *(uint4*)(sKV + e * 72 + sc) = vpre[i];
  }
  __syncthreads();
  f32x16 acc1[2], acc2[2];
  const int mi = w & 1, nj = w >> 1;
#pragma unroll
  for (int t = 0; t < 2; ++t)
#pragma unroll
    for (int i = 0; i < 16; ++i) { acc1[t][i] = 0.f; acc2[t][i] = 0.f; }
#pragma unroll 2
  for (int ks = 0; ks < 4; ++ks) {
    bf16x8 af = *(const bf16x8*)(sP + (mi * 32 + (lane & 31)) * 72 + ks * 16 + (lane >> 5) * 8);
#pragma unroll
    for (int t = 0; t < 2; ++t) {
      bf16x8 bfr = *(const bf16x8*)(sKV + (nj * 64 + t * 32 + (lane & 31)) * 72 + ks * 16 + (lane >> 5) * 8);
      acc1[t] = __builtin_amdgcn_mfma_f32_32x32x16_bf16(af, bfr, acc1[t], 0, 0, 0);
    }
  }
#pragma unroll 2
  for (int ks = 0; ks < 8; ++ks) {
    bf16x8 af = *(const bf16x8*)(sQ + (mi * 32 + (lane & 31)) * 136 + ks * 16 + (lane >> 5) * 8);
#pragma unroll
    for (int t = 0; t < 2; ++t) {
      bf16x8 bfr = *(const bf16x8*)(sS + (nj * 64 + t * 32 + (lane & 31)) * 136 + ks * 16 + (lane >> 5) * 8);
      acc2[t] = __builtin_amdgcn_mfma_f32_32x32x16_bf16(af, bfr, acc2[t], 0, 0, 0);
    }
  }
  if (mixer == 1) {
    int i = tid >> 2, part = tid & 3;
    const float* nprev = (const float*)(P.ws + O_DN) + (size_t)idx * 128;
    float dl = 0.f, qn = 0.f;
#pragma unroll 4
    for (int s = part * 16; s < part * 16 + 16; ++s) dl += bf2f(sP[i * 72 + s]);
#pragma unroll 4
    for (int d = part * 32; d < part * 32 + 32; ++d) qn += bf2f(sQ[i * 136 + d]) * nprev[d];
    dl += __shfl_xor(dl, 1); dl += __shfl_xor(dl, 2);
    qn += __shfl_xor(qn, 1); qn += __shfl_xor(qn, 2);
    if (part == 0) {
      float den = dl + sRow[128 + i] * qn;
      sRow[192 + i] = 1.f / fmaxf(fabsf(den), sRow[256 + i]);
    }
  }
  __syncthreads();
#pragma unroll
  for (int t = 0; t < 2; ++t) {
    int e = nj * 64 + t * 32 + (lane & 31);
#pragma unroll
    for (int reg = 0; reg < 16; ++reg) {
      int i = mi * 32 + (reg & 3) + 8 * (reg >> 2) + 4 * (lane >> 5);
      float o = acc1[t][reg] + sRow[128 + i] * acc2[t][reg];
      if (mixer == 1) o *= sRow[192 + i];
      sO[i * 132 + e] = o;
    }
  }
  __syncthreads();
  {
    int i = tid >> 2, part = tid & 3;
    float ss = 0.f;
#pragma unroll 4
    for (int e = part * 32; e < part * 32 + 32; ++e) { float v = sO[i * 132 + e]; ss += v * v; }
    ss += __shfl_xor(ss, 1); ss += __shfl_xor(ss, 2);
    float rstd = rsqrtf(ss * (1.f / 128.f) + EPS);
    if (i < L) {
      size_t ro = (size_t)(it.row0 + i) * 512 + h * 128 + part * 32;
      const float* so = sO + i * 132 + part * 32;
      if (mixer == 0) {
        bfu* y = (bfu*)(P.ws + SLOT(5)) + ro;
        const float* g = P.g_ret_gn + h * 128 + part * 32;
        uint4 gv[4];
#pragma unroll
        for (int k = 0; k < 4; ++k) gv[k] = *(const uint4*)(y + k * 8);
#pragma unroll
        for (int k = 0; k < 4; ++k) {
          float gt[8], o[8];
          unpack8(gv[k], gt);
#pragma unroll
          for (int j = 0; j < 8; ++j) o[j] = gt[j] * sigmoidf_(gt[j]) * so[k * 8 + j] * rstd * g[k * 8 + j];
          *(uint4*)(y + k * 8) = pack8(o);
        }
      } else {
        bfu* y = (bfu*)(P.ws + SLOT(8)) + ro;
        const bfu* cc = (const bfu*)(P.ws + SLOT(0)) + ro;
        const float* g = P.g_ml_gn + h * 128 + part * 32;
        const float* ws = P.w_skip + h * 128 + part * 32;
        uint4 gv[4], cv[4];
#pragma unroll
        for (int k = 0; k < 4; ++k) { gv[k] = *(const uint4*)(y + k * 8); cv[k] = *(const uint4*)(cc + k * 8); }
#pragma unroll
        for (int k = 0; k < 4; ++k) {
          float gt[8], c8[8], o[8];
          unpack8(gv[k], gt); unpack8(cv[k], c8);
#pragma unroll
          for (int j = 0; j < 8; ++j) o[j] = sigmoidf_(gt[j]) * (so[k * 8 + j] * rstd * g[k * 8 + j] + ws[k * 8 + j] * c8[j]);
          *(uint4*)(y + k * 8) = pack8(o);
        }
      }
    }
  }
  __syncthreads();
}

__device__ void phase_merge(const Params& P, char* smem) {
  bfu* sA = (bfu*)smem; bfu* sB = sA + 128 * 72;
  const bfu* yr = (const bfu*)(P.ws + SLOT(5)); const bfu* ym = (const bfu*)(P.ws + SLOT(8));
  const bfu* gr = (const bfu*)(P.ws + SLOT(9)); const bfu* gm = (const bfu*)(P.ws + SLOT(11));
  bfu* mg = (bfu*)(P.ws + SLOT(6));
  for (int t = blockIdx.x; t < 260 * 8; t += gridDim.x) {
    int mt, nt; tile_map(t, 260, 8, mt, nt);
    f32x16 acc[2][2]; zero_acc(acc);
    bfu* sT = (bfu*)smem;
    const size_t tbase = (size_t)mt * 128 * 1024 + nt * 128;
    uint4 t1[8];
    gemm_acc(acc, yr + (size_t)mt * 128 * 512, 512, (const bfu*)(P.ws + O_WT_UPR) + (size_t)nt * 128 * 512, 512, 512, sA, sB);
    __syncthreads();
    stage_rm(sT, acc, 1.f);
    __syncthreads();
#pragma unroll
    for (int i = 0; i < 8; ++i) {
      int id = threadIdx.x + i * 256, row = id >> 4, c8 = (id & 15) * 8;
      float a[8], g[8];
      unpack8(*(const uint4*)(sT + row * ST_LD + c8), a);
      unpack8(*(const uint4*)(gr + tbase + (size_t)row * 1024 + c8), g);
#pragma unroll
      for (int j = 0; j < 8; ++j) a[j] *= sigmoidf_(g[j]);
      t1[i] = pack8(a);
    }
    zero_acc(acc);
    gemm_acc(acc, ym + (size_t)mt * 128 * 512, 512, (const bfu*)(P.ws + O_WT_UPM) + (size_t)nt * 128 * 512, 512, 512, sA, sB);
    __syncthreads();
    stage_rm(sT, acc, 1.f);
    __syncthreads();
#pragma unroll
    for (int i = 0; i < 8; ++i) {
      int id = threadIdx.x + i * 256, row = id >> 4, c8 = (id & 15) * 8;
      float a[8], g[8], t[8];
      unpack8(*(const uint4*)(sT + row * ST_LD + c8), a);
      unpack8(*(const uint4*)(gm + tbase + (size_t)row * 1024 + c8), g);
      unpack8(t1[i], t);
#pragma unroll
      for (int j = 0; j < 8; ++j) a[j] = t[j] + a[j] * sigmoidf_(g[j]);
      *(uint4*)(mg + tbase + (size_t)row * 1024 + c8) = pack8(a);
    }
  }
}

__device__ void phase_outproj(const Params& P, char* smem) {
  bfu* sA = (bfu*)smem; bfu* sB = sA + 128 * 72;
  const bfu* mg = (const bfu*)(P.ws + SLOT(6));
  for (int t = blockIdx.x; t < 260 * 8; t += gridDim.x) {
    int mt, nt; tile_map(t, 260, 8, mt, nt);
    f32x16 acc[2][2]; zero_acc(acc);
    gemm_acc(acc, mg + (size_t)mt * 128 * 1024, 1024, (const bfu*)(P.ws + O_WT_OUT) + (size_t)nt * 128 * 1024, 1024, 1024, sA, sB);
    float* sT32 = (float*)smem;
    __syncthreads();
    {
      EPI_BEGIN
#pragma unroll
        for (int j = 0; j < 4; ++j) {
          sT32[(r0 + j) * ST32_LD + cl] = acc[mi][0][q * 4 + j];
          sT32[(r0 + j) * ST32_LD + cl + 64] = acc[mi][1][q * 4 + j];
        }
      EPI_END
    }
    __syncthreads();
#pragma unroll
    for (int i = 0; i < 16; ++i) {
      int id = threadIdx.x + i * 256, row = id >> 5, c4 = (id & 31) * 4;
      int r = mt * 128 + row;
      float4 a = *(const float4*)(sT32 + row * ST32_LD + c4);
      float4 x = *(const float4*)(xrow(P, r) + nt * 128 + c4);
      *(float4*)(P.out + (size_t)r * 1024 + nt * 128 + c4) = make_float4(x.x + a.x, x.y + a.y, x.z + a.z, x.w + a.w);
    }
  }
}

__device__ void phase_norm_rows(const Params& P, const float* g, bfu* dst) {
  const int lane = threadIdx.x & 63, w = threadIdx.x >> 6;
  for (int r = blockIdx.x * 4 + w; r < MT; r += gridDim.x * 4) {
    const float* xr = P.out + (size_t)r * 1024;
    float4 v[4]; float ss = 0.f;
#pragma unroll
    for (int i = 0; i < 4; ++i) {
      v[i] = *(const float4*)(xr + i * 256 + lane * 4);
      ss += v[i].x * v[i].x + v[i].y * v[i].y + v[i].z * v[i].z + v[i].w * v[i].w;
    }
    ss = wave_sum(ss);
    float rstd = rsqrtf(ss * (1.f / 1024.f) + EPS);
#pragma unroll
    for (int i = 0; i < 4; ++i) {
      float4 gg = *(const float4*)(g + i * 256 + lane * 4);
      uint2 o; o.x = pack2(v[i].x * rstd * gg.x, v[i].y * rstd * gg.y); o.y = pack2(v[i].z * rstd * gg.z, v[i].w * rstd * gg.w);
      *(uint2*)(dst + (size_t)r * 1024 + i * 256 + lane * 4) = o;
    }
  }
}

__device__ void phase_pq(const Params& P, char* smem) {
  bfu* sA = (bfu*)smem; bfu* sB = sA + 128 * 72;
  const bfu* hq = (const bfu*)(P.ws + SLOT(0));
  bfu* qb = (bfu*)(P.ws + SLOT(9));
  for (int t = blockIdx.x; t < 260 * 16; t += gridDim.x) {
    int mt, nt; tile_map(t, 260, 16, mt, nt);
    f32x16 acc[2][2]; zero_acc(acc);
    gemm_acc(acc, hq + (size_t)mt * 128 * 1024, 1024, (const bfu*)(P.ws + O_WT_PQ) + (size_t)nt * 128 * 1024, 1024, 1024, sA, sB);
    bfu* sT = (bfu*)smem;
    __syncthreads();
    stage_rm(sT, acc, 1.f);
    __syncthreads();
    copyout_bf16(sT, qb + (size_t)mt * 128 * 2048 + nt * 128, 2048);
  }
}


template <bool DESC> __device__ __forceinline__ void cex(float& a, float& b) {
  float mx = fmaxf(a, b), mn = fminf(a, b);
  a = DESC ? mx : mn; b = DESC ? mn : mx;
}
template <int B, bool DESC> __device__ __forceinline__ void bmerge16(float (&v)[64]) {
#pragma unroll
  for (int j = 8; j > 0; j >>= 1)
#pragma unroll
    for (int i = 0; i < 16; ++i) { int l = i ^ j; if (l > i) cex<DESC>(v[B + i], v[B + l]); }
}
template <int B, bool DESC> __device__ __forceinline__ void bsort16(float (&v)[64]) {
#pragma unroll
  for (int k = 2; k <= 16; k <<= 1)
#pragma unroll
    for (int j = k >> 1; j > 0; j >>= 1)
#pragma unroll
      for (int i = 0; i < 16; ++i) {
        int l = i ^ j;
        if (l > i) {
          bool up = ((i & k) == 0) || (k == 16);
          if (up == true) { if (DESC) cex<true>(v[B + i], v[B + l]); else cex<false>(v[B + i], v[B + l]); }
          else { if (DESC) cex<false>(v[B + i], v[B + l]); else cex<true>(v[B + i], v[B + l]); }
        }
      }
}
__device__ __forceinline__ float pair_max(float v) {
  auto r = __builtin_amdgcn_permlane32_swap(__float_as_int(v), __float_as_int(v), false, false);
  return fmaxf(__int_as_float(r[0]), __int_as_float(r[1]));
}
__device__ void phase_topk(const Params& P, char* smem) {
  const int tid = threadIdx.x, lane = tid & 63, w = tid >> 6, r32 = lane & 31, hh = lane >> 5;
  unsigned* sL = (unsigned*)smem + w * 1664;
  unsigned* sW = sL + 32 * 33;
  const bfu* qb = (const bfu*)(P.ws + SLOT(9));
  const bfu* keys = (const bfu*)(P.ws + O_KEYS);
  int* ids = (int*)(P.ws + SLOT(4));
  float* gw = (float*)(P.ws + SLOT(13));
  for (int item = blockIdx.x * 4 + w; item < 1040 * 8; item += gridDim.x * 4) {
    const int tg = item >> 3, n = item & 7, rowb = tg * 32;
#pragma unroll 1
    for (int half = 0; half < 2; ++half) {
      f32x16 acc[4];
#pragma unroll
      for (int c = 0; c < 4; ++c)
#pragma unroll
        for (int i = 0; i < 16; ++i) acc[c][i] = 0.f;
      const bfu* kp = keys + (size_t)((n * 2 + half) * 128 + r32) * 128 + hh * 8;
      const bfu* qp = qb + (size_t)(rowb + r32) * 2048 + n * 256 + half * 128 + hh * 8;
#pragma unroll
      for (int ks = 0; ks < 8; ++ks) {
        bf16x8 bfr = *(const bf16x8*)(qp + ks * 16);
#pragma unroll
        for (int c = 0; c < 4; ++c) {
          bf16x8 af = *(const bf16x8*)(kp + (size_t)c * 32 * 128 + ks * 16);
          acc[c] = __builtin_amdgcn_mfma_f32_32x32x16_bf16(af, bfr, acc[c], 0, 0, 0);
        }
      }
      float kk[64];
#pragma unroll
      for (int c = 0; c < 4; ++c)
#pragma unroll
        for (int reg = 0; reg < 16; ++reg) {
          unsigned kidx = c * 32 + (reg & 3) + 8 * (reg >> 2) + 4 * hh;
          kk[c * 16 + reg] = __uint_as_float((__float_as_uint(acc[c][reg]) & ~127u) | kidx);
        }
      bsort16<0, true>(kk); bsort16<16, false>(kk); bsort16<32, false>(kk); bsort16<48, true>(kk);
#pragma unroll
      for (int i = 0; i < 16; ++i) { kk[i] = fmaxf(kk[i], kk[16 + i]); kk[32 + i] = fmaxf(kk[32 + i], kk[48 + i]); }
      bmerge16<0, true>(kk); bmerge16<32, false>(kk);
#pragma unroll
      for (int i = 0; i < 16; ++i) kk[i] = fmaxf(kk[i], kk[32 + i]);
      bmerge16<0, true>(kk);
      {
        float lo[16], hi[16];
#pragma unroll
        for (int i = 0; i < 16; ++i) {
          auto r = __builtin_amdgcn_permlane32_swap(__float_as_int(kk[i]), __float_as_int(kk[i]), false, false);
          lo[i] = __int_as_float(r[0]); hi[i] = __int_as_float(r[1]);
        }
#pragma unroll
        for (int i = 0; i < 16; ++i) kk[i] = fmaxf(lo[i], hi[15 - i]);
      }
      bmerge16<0, true>(kk);
      if (hh == 0) {
#pragma unroll
        for (int p = 0; p < 16; ++p) sL[r32 * 33 + half * 16 + p] = __float_as_uint(kk[p]);
      }
    }
    __builtin_amdgcn_fence(__ATOMIC_RELEASE, "workgroup");
    __builtin_amdgcn_wave_barrier();
    __builtin_amdgcn_fence(__ATOMIC_ACQUIRE, "workgroup");
    float x[4], y[16];
    {
      const unsigned* lx = sL + r32 * 33 + (hh ? 16 : 0);
      const unsigned* ly = sL + r32 * 33 + (hh ? 0 : 16);
#pragma unroll
      for (int i = 0; i < 4; ++i) x[i] = __uint_as_float(lx[i] & ~127u);
#pragma unroll
      for (int j = 0; j < 16; ++j) y[j] = __uint_as_float(ly[j] & ~127u);
    }
    float cd[25];
#define CAND(t, i, j) { float sv = x[i] + y[j]; unsigned code = hh ? ((j) << 4 | (i)) : ((i) << 4 | (j)); \
      cd[t] = __uint_as_float((__float_as_uint(sv) & ~255u) | code); }
    CAND(0, 0, 1) CAND(1, 0, 2) CAND(2, 0, 3) CAND(3, 0, 4) CAND(4, 0, 5) CAND(5, 0, 6) CAND(6, 0, 7) CAND(7, 0, 8)
    CAND(8, 0, 9) CAND(9, 0, 10) CAND(10, 0, 11) CAND(11, 0, 12) CAND(12, 0, 13) CAND(13, 0, 14) CAND(14, 0, 15)
    CAND(15, 1, 2) CAND(16, 1, 3) CAND(17, 1, 4) CAND(18, 1, 5) CAND(19, 1, 6) CAND(20, 1, 7) CAND(21, 2, 3) CAND(22, 2, 4)
    {
      float d0 = hh ? x[2] + y[2] : x[0] + y[0];
      float d1 = hh ? x[3] + y[3] : x[1] + y[1];
      unsigned c0 = hh ? 0x22u : 0x00u, c1 = hh ? 0x33u : 0x11u;
      cd[23] = __uint_as_float((__float_as_uint(d0) & ~255u) | c0);
      cd[24] = __uint_as_float((__float_as_uint(d1) & ~255u) | c1);
    }
    {
      float cv[64];
#pragma unroll
      for (int t = 0; t < 25; ++t) cv[t] = cd[t];
#pragma unroll
      for (int t = 25; t < 32; ++t) cv[t] = -INFINITY;
      bsort16<0, true>(cv); bsort16<16, false>(cv);
#pragma unroll
      for (int i = 0; i < 16; ++i) cv[i] = fmaxf(cv[i], cv[16 + i]);
      bmerge16<0, true>(cv);
      {
        float lo[16], hi[16];
#pragma unroll
        for (int i = 0; i < 16; ++i) {
          auto r = __builtin_amdgcn_permlane32_swap(__float_as_int(cv[i]), __float_as_int(cv[i]), false, false);
          lo[i] = __int_as_float(r[0]); hi[i] = __int_as_float(r[1]);
        }
#pragma unroll
        for (int i = 0; i < 16; ++i) cv[i] = fmaxf(lo[i], hi[15 - i]);
      }
      bmerge16<0, true>(cv);
      if (hh == 0) {
#pragma unroll
        for (int p = 0; p < 16; ++p) sW[r32 * 17 + p] = __float_as_uint(cv[p]);
      }
    }
    __builtin_amdgcn_fence(__ATOMIC_RELEASE, "workgroup");
    __builtin_amdgcn_wave_barrier();
    __builtin_amdgcn_fence(__ATOMIC_ACQUIRE, "workgroup");
    {
      const unsigned* la = sL + r32 * 33;
      unsigned c0 = sW[r32 * 17] & 255u;
      float scmax = __uint_as_float(la[c0 >> 4] & ~127u) + __uint_as_float(la[16 + (c0 & 15)] & ~127u);
      float ex[8]; int ee[8]; float sum = 0.f;
#pragma unroll
      for (int k = 0; k < 8; ++k) {
        unsigned code = sW[r32 * 17 + hh * 8 + k] & 255u;
        unsigned ka = la[code >> 4], kb = la[16 + (code & 15)];
        float sc = __uint_as_float(ka & ~127u) + __uint_as_float(kb & ~127u);
        ex[k] = __expf(sc - scmax);
        ee[k] = (int)((ka & 127u) * 128u + (kb & 127u));
        sum += ex[k];
      }
      sum += __shfl_xor(sum, 32);
      float inv = 1.f / sum;
      size_t o = (size_t)(rowb + r32) * 128 + n * 16 + hh * 8;
      *(int4*)(ids + o) = make_int4(ee[0], ee[1], ee[2], ee[3]);
      *(int4*)(ids + o + 4) = make_int4(ee[4], ee[5], ee[6], ee[7]);
      *(float4*)(gw + o) = make_float4(ex[0] * inv, ex[1] * inv, ex[2] * inv, ex[3] * inv);
      *(float4*)(gw + o + 4) = make_float4(ex[4] * inv, ex[5] * inv, ex[6] * inv, ex[7] * inv);
    }
    __builtin_amdgcn_wave_barrier();
  }
}

typedef float f2v __attribute__((ext_vector_type(2)));
#define U8_SCALE 512.f
#define V8_SCALE 128.f
__device__ void convert_fp8(const float* __restrict__ src, unsigned char* __restrict__ dst, size_t n16, float scale,
                            int gtid, int gstride) {
  for (size_t i = gtid; i < n16; i += gstride) {
    unsigned w[4];
#pragma unroll
    for (int k = 0; k < 4; ++k) {
      float4 a = *(const float4*)(src + i * 16 + k * 4);
      float v0 = fminf(fmaxf(a.x * scale, -448.f), 448.f), v1 = fminf(fmaxf(a.y * scale, -448.f), 448.f);
      float v2 = fminf(fmaxf(a.z * scale, -448.f), 448.f), v3 = fminf(fmaxf(a.w * scale, -448.f), 448.f);
      int t = 0;
      t = __builtin_amdgcn_cvt_pk_fp8_f32(v0, v1, t, false);
      t = __builtin_amdgcn_cvt_pk_fp8_f32(v2, v3, t, true);
      w[k] = (unsigned)t;
    }
    *(uint4*)(dst + i * 16) = make_uint4(w[0], w[1], w[2], w[3]);
  }
}
__device__ __forceinline__ float dot16_fp8(uint4 u, const f2v* x2) {
  f2v acc = __builtin_amdgcn_cvt_pk_f32_fp8((int)u.x, false) * x2[0];
  acc += __builtin_amdgcn_cvt_pk_f32_fp8((int)u.x, true) * x2[1];
  acc += __builtin_amdgcn_cvt_pk_f32_fp8((int)u.y, false) * x2[2];
  acc += __builtin_amdgcn_cvt_pk_f32_fp8((int)u.y, true) * x2[3];
  acc += __builtin_amdgcn_cvt_pk_f32_fp8((int)u.z, false) * x2[4];
  acc += __builtin_amdgcn_cvt_pk_f32_fp8((int)u.z, true) * x2[5];
  acc += __builtin_amdgcn_cvt_pk_f32_fp8((int)u.w, false) * x2[6];
  acc += __builtin_amdgcn_cvt_pk_f32_fp8((int)u.w, true) * x2[7];
  return acc.x + acc.y;
}
__device__ __forceinline__ void axpy16_fp8(f2v* o2, float cf, uint4 v) {
  f2v c = {cf, cf};
  o2[0] += c * __builtin_amdgcn_cvt_pk_f32_fp8((int)v.x, false);
  o2[1] += c * __builtin_amdgcn_cvt_pk_f32_fp8((int)v.x, true);
  o2[2] += c * __builtin_amdgcn_cvt_pk_f32_fp8((int)v.y, false);
  o2[3] += c * __builtin_amdgcn_cvt_pk_f32_fp8((int)v.y, true);
  o2[4] += c * __builtin_amdgcn_cvt_pk_f32_fp8((int)v.z, false);
  o2[5] += c * __builtin_amdgcn_cvt_pk_f32_fp8((int)v.z, true);
  o2[6] += c * __builtin_amdgcn_cvt_pk_f32_fp8((int)v.w, false);
  o2[7] += c * __builtin_amdgcn_cvt_pk_f32_fp8((int)v.w, true);
}
#define PEER_LOAD(u, v, b)                                                                   \
  _Pragma("unroll") for (int k = 0; k < 8; ++k) {                                            \
    int j = (b) * 8 + k;                                                                     \
    int e = __builtin_amdgcn_readlane((b) < 8 ? id0 : id1, j & 63);                          \
    u[k] = *(const uint4*)(U8 + (size_t)e * 1024 + lane * 16);                               \
    v[k] = *(const uint4*)(V8 + (size_t)e * 1024 + lane * 16);                               \
  }
#define PEER_COMP(u, v, b)                                                                   \
  _Pragma("unroll") for (int hf = 0; hf < 2; ++hf) {                                         \
    float s = reduce4(dot16_fp8(u[hf * 4 + 0], x2), dot16_fp8(u[hf * 4 + 1], x2),           \
                      dot16_fp8(u[hf * 4 + 2], x2), dot16_fp8(u[hf * 4 + 3], x2)) * (1.f / U8_SCALE); \
    float act = 0.5f * s * (1.f + erff(s * 0.7071067811865475f));                            \
    float gsel = __shfl((b) < 8 ? g0 : g1, ((b) * 8 + hf * 4 + (lane >> 4)) & 63);           \
    float cfv = act * gsel * (1.f / V8_SCALE);                                               \
    axpy16_fp8(o2, __int_as_float(__builtin_amdgcn_readlane(__float_as_int(cfv), 0)), v[hf * 4 + 0]);  \
    axpy16_fp8(o2, __int_as_float(__builtin_amdgcn_readlane(__float_as_int(cfv), 16)), v[hf * 4 + 1]); \
    axpy16_fp8(o2, __int_as_float(__builtin_amdgcn_readlane(__float_as_int(cfv), 32)), v[hf * 4 + 2]); \
    axpy16_fp8(o2, __int_as_float(__builtin_amdgcn_readlane(__float_as_int(cfv), 48)), v[hf * 4 + 3]); \
  }
__device__ void phase_peer(const Params& P) {
  const int lane = threadIdx.x & 63, w = threadIdx.x >> 6;
  bfu* hq = (bfu*)(P.ws + SLOT(0));
  const unsigned char* U8 = (const unsigned char*)(P.ws + SLOT(2));
  const unsigned char* V8 = (const unsigned char*)(P.ws + SLOT(3));
  const int* ids = (const int*)(P.ws + SLOT(4));
  const float* gw = (const float*)(P.ws + SLOT(13));
  bfu* pbf = (bfu*)(P.ws + SLOT(6));
  for (int r = blockIdx.x * 4 + w; r < MT; r += gridDim.x * 4) {
    f2v x2[8], o2[8];
    {
      uint4 v0 = *(const uint4*)(hq + (size_t)r * 1024 + lane * 16);
      uint4 v1 = *(const uint4*)(hq + (size_t)r * 1024 + lane * 16 + 8);
      float xf[16];
      unpack8(v0, xf); unpack8(v1, xf + 8);
#pragma unroll
      for (int j = 0; j < 8; ++j) { x2[j].x = xf[2 * j]; x2[j].y = xf[2 * j + 1]; o2[j].x = 0.f; o2[j].y = 0.f; }
    }
    int id0 = ids[(size_t)r * 128 + lane], id1 = ids[(size_t)r * 128 + 64 + lane];
    float g0 = gw[(size_t)r * 128 + lane], g1 = gw[(size_t)r * 128 + 64 + lane];
    uint4 uA[8], vA[8], uB[8], vB[8];
    PEER_LOAD(uA, vA, 0)
    for (int b = 0; b < 16; b += 2) {
      PEER_LOAD(uB, vB, b + 1)
      PEER_COMP(uA, vA, b)
      if (b + 2 < 16) { PEER_LOAD(uA, vA, b + 2) }
      PEER_COMP(uB, vB, b + 1)
    }
    float* xr = P.out + (size_t)r * 1024 + lane * 16;
    float x3[16];
    float ss = 0.f;
#pragma unroll
    for (int k = 0; k < 4; ++k) {
      float4 a = *(const float4*)(xr + k * 4);
      x3[k * 4 + 0] = a.x + o2[k * 2].x; x3[k * 4 + 1] = a.y + o2[k * 2].y;
      x3[k * 4 + 2] = a.z + o2[k * 2 + 1].x; x3[k * 4 + 3] = a.w + o2[k * 2 + 1].y;
      *(float4*)(xr + k * 4) = make_float4(x3[k * 4], x3[k * 4 + 1], x3[k * 4 + 2], x3[k * 4 + 3]);
    }
#pragma unroll
    for (int j = 0; j < 16; ++j) ss += x3[j] * x3[j];
    ss = wave_sum(ss);
    float rstd = rsqrtf(ss * (1.f / 1024.f) + EPS);
    float hv[16];
#pragma unroll
    for (int k = 0; k < 4; ++k) {
      float4 ga = *(const float4*)(P.g_ple + lane * 16 + k * 4);
      hv[k * 4] = x3[k * 4] * rstd * ga.x; hv[k * 4 + 1] = x3[k * 4 + 1] * rstd * ga.y;
      hv[k * 4 + 2] = x3[k * 4 + 2] * rstd * ga.z; hv[k * 4 + 3] = x3[k * 4 + 3] * rstd * ga.w;
    }
    *(uint4*)(hq + (size_t)r * 1024 + lane * 16) = pack8(hv);
    *(uint4*)(hq + (size_t)r * 1024 + lane * 16 + 8) = pack8(hv + 8);
    {
      const float* pr = r < MP ? P.pp + (size_t)r * 256 : P.ps + (size_t)(r - MP) * 256;
      float4 a = *(const float4*)(pr + lane * 4);
      uint2 ov; ov.x = pack2(a.x, a.y); ov.y = pack2(a.z, a.w);
      *(uint2*)(pbf + (size_t)r * 256 + lane * 4) = ov;
    }
  }
}

__device__ void phase_ple(const Params& P, char* smem) {
  bfu* sA = (bfu*)smem; bfu* sB = sA + 128 * 72;
  const bfu* hg = (const bfu*)(P.ws + SLOT(0));
  const bfu* pbf = (const bfu*)(P.ws + SLOT(6));
  for (int t = blockIdx.x; t < 260 * 8; t += gridDim.x) {
    int mt, nt; tile_map(t, 260, 8, mt, nt);
    f32x16 acc[2][2]; zero_acc(acc);
    bfu* sT = (bfu*)smem; float* sT32 = (float*)smem;
    uint2 pg[16];
    gemm_acc(acc, hg + (size_t)mt * 128 * 1024, 1024, (const bfu*)(P.ws + O_WT_PG) + (size_t)nt * 128 * 1024, 1024, 1024, sA, sB);
    __syncthreads();
    {
      EPI_BEGIN
#pragma unroll
        for (int j = 0; j < 4; ++j) {
          sT[(r0 + j) * ST_LD + cl] = f2bf(sigmoidf_(acc[mi][0][q * 4 + j]));
          sT[(r0 + j) * ST_LD + cl + 64] = f2bf(sigmoidf_(acc[mi][1][q * 4 + j]));
        }
      EPI_END
    }
    __syncthreads();
#pragma unroll
    for (int i = 0; i < 16; ++i) {
      int id = threadIdx.x + i * 256, row = id >> 5, c4 = (id & 31) * 4;
      pg[i] = *(const uint2*)(sT + row * ST_LD + c4);
    }
    zero_acc(acc);
    gemm_acc(acc, pbf + (size_t)mt * 128 * 256, 256, (const bfu*)(P.ws + O_WT_PLE) + (size_t)nt * 128 * 256, 256, 256, sA, sB);
    __syncthreads();
    {
      EPI_BEGIN
#pragma unroll
        for (int j = 0; j < 4; ++j) {
          sT32[(r0 + j) * ST32_LD + cl] = acc[mi][0][q * 4 + j];
          sT32[(r0 + j) * ST32_LD + cl + 64] = acc[mi][1][q * 4 + j];
        }
      EPI_END
    }
    __syncthreads();
#pragma unroll
    for (int i = 0; i < 16; ++i) {
      int id = threadIdx.x + i * 256, row = id >> 5, c4 = (id & 31) * 4;
      float4 a = *(const float4*)(sT32 + row * ST32_LD + c4);
      float* op = P.out + (size_t)(mt * 128 + row) * 1024 + nt * 128 + c4;
      float4 x = *(const float4*)op;
      float g0 = bf2f(pg[i].x & 0xffff), g1 = bf2f(pg[i].x >> 16), g2 = bf2f(pg[i].y & 0xffff), g3 = bf2f(pg[i].y >> 16);
      *(float4*)op = make_float4(x.x + a.x * g0, x.y + a.y * g1, x.z + a.z * g2, x.w + a.w * g3);
    }
  }
}

__device__ void phase_final(const Params& P) {
  const int lane = threadIdx.x & 63, w = threadIdx.x >> 6;
  for (int r = blockIdx.x * 4 + w; r < MT; r += gridDim.x * 4) {
    float* xr = P.out + (size_t)r * 1024;
    float4 v[4]; float ss = 0.f;
#pragma unroll
    for (int i = 0; i < 4; ++i) {
      v[i] = *(const float4*)(xr + i * 256 + lane * 4);
      ss += v[i].x * v[i].x + v[i].y * v[i].y + v[i].z * v[i].z + v[i].w * v[i].w;
    }
    ss = wave_sum(ss);
    float rstd = rsqrtf(ss * (1.f / 1024.f) + EPS);
#pragma unroll
    for (int i = 0; i < 4; ++i) {
      float4 gg = *(const float4*)(P.g_final + i * 256 + lane * 4);
      *(float4*)(xr + i * 256 + lane * 4) = make_float4(v[i].x * rstd * gg.x, v[i].y * rstd * gg.y, v[i].z * rstd * gg.z, v[i].w * rstd * gg.w);
    }
  }
}

__global__ void __launch_bounds__(NTHREADS, 2) fwd_megakernel(Params P) {
  extern __shared__ __attribute__((aligned(16))) char smem[];
  cg::grid_group grid = cg::this_grid();
  __shared__ uint4 xb_words;
  if (threadIdx.x == 0) xb_words = make_uint4(0u, 0u, 0u, 0u);
  __syncthreads();
  XcdBarrier xb = xcd_barrier_post((unsigned*)(P.ws + O_BAR), (volatile LAS unsigned*)&xb_words);
  if (P.out == nullptr) grid.sync();
  const int gtid = blockIdx.x * NTHREADS + threadIdx.x, gstride = gridDim.x * NTHREADS;
  phase_prep(P, smem);
  xcd_barrier(xb);
  phase_gemm1(P, smem);
  xcd_barrier(xb);
  phase_conv(P);
  gate_scan(P);
  xcd_barrier(xb);
  m_fold(P);
  phase_mqk(P, smem);
  xcd_barrier(xb);
  for (int t = blockIdx.x; t < 4224; t += gridDim.x) phaseA_item(P, t / 2112, t % 2112, smem);
  xcd_barrier(xb);
  phase_scan(P);
  xcd_barrier(xb);
  for (int t = blockIdx.x; t < 4224; t += gridDim.x) phaseC_item(P, t / 2112, t % 2112, smem);
  xcd_barrier(xb);
  phase_merge(P, smem);
  xcd_barrier(xb);
  phase_outproj(P, smem);
  xcd_barrier(xb);
  phase_norm_rows(P, P.g_ffn, (bfu*)(P.ws + SLOT(0)));
  convert_fp8(P.peer_u, (unsigned char*)(P.ws + SLOT(2)), 16384ull * 1024 / 16, U8_SCALE, gtid, gstride);
  convert_fp8(P.peer_v, (unsigned char*)(P.ws + SLOT(3)), 16384ull * 1024 / 16, V8_SCALE, gtid, gstride);
  xcd_barrier(xb);
  phase_pq(P, smem);
  xcd_barrier(xb);
  phase_topk(P, smem);
  xcd_barrier(xb);
  phase_peer(P);
  xcd_barrier(xb);
  phase_ple(P, smem);
  xcd_barrier(xb);
  phase_final(P);
}

extern "C" void kernel_launch(void* const* d_in, const int* in_sizes, int n_in, void* d_out, int out_size,
                              void* d_ws, size_t ws_size, hipStream_t stream) {
  static int grid_blocks = 0;
  if (!grid_blocks) {
    hipFuncSetAttribute((const void*)fwd_megakernel, hipFuncAttributeMaxDynamicSharedMemorySize, SMEM_BYTES);
    int dev = 0, cus = 0, per_cu = 0;
    hipGetDevice(&dev);
    hipDeviceGetAttribute(&cus, hipDeviceAttributeMultiprocessorCount, dev);
    hipOccupancyMaxActiveBlocksPerMultiprocessor(&per_cu, fwd_megakernel, NTHREADS, SMEM_BYTES);
    if (per_cu > 2) per_cu = 2;
    if (per_cu < 1) per_cu = 1;
    grid_blocks = cus * per_cu;
  }
  Params p{};
  const float** pf = (const float**)&p;
  for (int i = 0; i < 32; ++i) pf[i] = (const float*)d_in[i];
  p.out = (float*)d_out;
  p.ws = (char*)d_ws;
  hipMemsetAsync((char*)d_ws + O_BAR, 0, XCD_BAR_WORDS * 4, stream);
  void* args[] = {&p};
  hipError_t e = hipLaunchCooperativeKernel((void*)fwd_megakernel, dim3(grid_blocks), dim3(NTHREADS), args, SMEM_BYTES, stream);
  if (e != hipSuccess) fprintf(stderr, "cooperative launch failed: %s (grid %d)\n", hipGetErrorString(e), grid_blocks);
}
```

```cpp
#include <hip/hip_runtime.h>
#include <hip/hip_cooperative_groups.h>
#include <cstdio>
namespace cg = cooperative_groups;

typedef unsigned short bfu;
typedef __attribute__((ext_vector_type(8))) short bf16x8;
typedef __attribute__((ext_vector_type(16))) float f32x16;

#define MT 33280
#define MP 32768
#define NTHREADS 256
#define EPS 1e-6f

struct Params {
  const float *xp, *xs, *pp, *ps, *st_ret, *st_C, *st_n, *st_m, *st_conv, *g_mix, *w_in, *g_ret_gn, *w_mq,
      *w_mk, *conv_w, *conv_b, *b_i, *b_f, *g_ml_gn, *w_skip, *w_up_r, *w_up_m, *w_out, *g_ffn, *w_pq,
      *peer_keys, *peer_u, *peer_v, *g_ple, *w_pg, *w_ple, *g_final;
  float* out;
  char* ws;
};

constexpr size_t O_WT_IN = 0;
constexpr size_t O_WT_UPR = O_WT_IN + 5632ull * 1024 * 2;
constexpr size_t O_WT_UPM = O_WT_UPR + 1024ull * 512 * 2;
constexpr size_t O_WT_OUT = O_WT_UPM + 1024ull * 512 * 2;
constexpr size_t O_WT_PQ = O_WT_OUT + 1024ull * 1024 * 2;
constexpr size_t O_WT_PG = O_WT_PQ + 2048ull * 1024 * 2;
constexpr size_t O_WT_PLE = O_WT_PG + 1024ull * 1024 * 2;
constexpr size_t O_KEYS = O_WT_PLE + 1024ull * 256 * 2;
constexpr size_t O_WT_MQ = O_KEYS + 16ull * 128 * 128 * 2;
constexpr size_t O_WT_MK = O_WT_MQ + 4ull * 128 * 128 * 2;
constexpr size_t O_COS = O_WT_MK + 4ull * 128 * 128 * 2;
constexpr size_t O_SIN = O_COS + 8192ull * 64 * 4;
constexpr size_t O_FQ = O_SIN + 8192ull * 64 * 4;
constexpr size_t O_UQ = O_FQ + (size_t)MT * 16;
constexpr size_t O_CMQ = O_UQ + (size_t)MT * 16;
constexpr size_t O_FL = O_CMQ + (size_t)MT * 16;
constexpr size_t O_UC = O_FL + 16384;
constexpr size_t O_AEND = O_UC + 16384;
constexpr size_t O_MCS = O_AEND + 16384;
constexpr size_t O_DN = O_MCS + 16384;
constexpr size_t O_DSS = O_DN + 2112ull * 128 * 4;
constexpr size_t O_GPRE = O_DSS + 2ull * 64 * 16384 * 2;
constexpr size_t O_BAR = O_GPRE + (size_t)MT * 32;
constexpr size_t O_SMALL_END = O_BAR + 16384;
constexpr size_t SLOT0 = 40ull << 20;
constexpr size_t USZ = (size_t)MT * 512 * 2;
static_assert(O_SMALL_END <= SLOT0, "small region overflow");
#define SLOT(i) (SLOT0 + (size_t)(i) * USZ)
constexpr size_t SB_T = 16ull * 128 * 8192;

constexpr size_t OO_Y = 0;
constexpr size_t OO_RETP = (size_t)MT * 1024;
constexpr size_t OO_CP = OO_RETP + 262144;
constexpr size_t OO_NP = OO_CP + 262144;
constexpr size_t OO_MP = OO_NP + 2048;
constexpr size_t OO_CONVP = OO_MP + 16;
constexpr size_t OO_RETS = OO_CONVP + 6144;
constexpr size_t OO_CS = OO_RETS + 1048576;
constexpr size_t OO_NS = OO_CS + 1048576;
constexpr size_t OO_MS = OO_NS + 8192;
constexpr size_t OO_CONVS = OO_MS + 64;

constexpr int SMEM_BYTES = 81152;

__device__ __forceinline__ bfu f2bf(float f) {
  unsigned u = __float_as_uint(f);
  u += 0x7fffu + ((u >> 16) & 1u);
  return (bfu)(u >> 16);
}
__device__ __forceinline__ float bf2f(bfu b) { return __uint_as_float(((unsigned)b) << 16); }
__device__ __forceinline__ unsigned pack2(float a, float b) { return (unsigned)f2bf(a) | ((unsigned)f2bf(b) << 16); }
__device__ __forceinline__ void unpack8(uint4 v, float* f) {
  f[0] = bf2f(v.x & 0xffff); f[1] = bf2f(v.x >> 16); f[2] = bf2f(v.y & 0xffff); f[3] = bf2f(v.y >> 16);
  f[4] = bf2f(v.z & 0xffff); f[5] = bf2f(v.z >> 16); f[6] = bf2f(v.w & 0xffff); f[7] = bf2f(v.w >> 16);
}
__device__ __forceinline__ uint4 pack8(const float* f) {
  uint4 o; o.x = pack2(f[0], f[1]); o.y = pack2(f[2], f[3]); o.z = pack2(f[4], f[5]); o.w = pack2(f[6], f[7]);
  return o;
}
__device__ __forceinline__ float wave_sum(float v) {
#pragma unroll
  for (int o = 32; o > 0; o >>= 1) v += __shfl_xor(v, o);
  return v;
}
__device__ __forceinline__ float wave_max(float v) {
#pragma unroll
  for (int o = 32; o > 0; o >>= 1) v = fmaxf(v, __shfl_xor(v, o));
  return v;
}
__device__ __forceinline__ float dpp_ror_add(float s, const int ctrl_sel) {
  int v = __float_as_int(s);
  int t;
  if (ctrl_sel == 8) t = __builtin_amdgcn_update_dpp(0, v, 0x128, 0xf, 0xf, false);
  else if (ctrl_sel == 4) t = __builtin_amdgcn_update_dpp(0, v, 0x124, 0xf, 0xf, false);
  else if (ctrl_sel == 2) t = __builtin_amdgcn_update_dpp(0, v, 0x122, 0xf, 0xf, false);
  else t = __builtin_amdgcn_update_dpp(0, v, 0x121, 0xf, 0xf, false);
  return s + __int_as_float(t);
}
__device__ __forceinline__ float reduce4(float p0, float p1, float p2, float p3) {
  auto r = __builtin_amdgcn_permlane32_swap(__float_as_int(p0), __float_as_int(p2), false, false);
  float sA = __int_as_float(r[0]) + __int_as_float(r[1]);
  r = __builtin_amdgcn_permlane32_swap(__float_as_int(p1), __float_as_int(p3), false, false);
  float sB = __int_as_float(r[0]) + __int_as_float(r[1]);
  r = __builtin_amdgcn_permlane16_swap(__float_as_int(sA), __float_as_int(sB), false, false);
  float s = __int_as_float(r[0]) + __int_as_float(r[1]);
  s = dpp_ror_add(s, 8); s = dpp_ror_add(s, 4); s = dpp_ror_add(s, 2); s = dpp_ror_add(s, 1);
  return s;
}
__device__ __forceinline__ float sigmoidf_(float x) { return 1.f / (1.f + __expf(-x)); }
__device__ __forceinline__ const float* xrow(const Params& P, int r) {
  return r < MP ? P.xp + (size_t)r * 1024 : P.xs + (size_t)(r - MP) * 1024;
}


#define XB_TMO      128
#define XB_XCNT(j)  (256  + 64 * (j))
#define XB_XSUB(j)  (1280 + 64 * (j))
#define XB_XGEN(j)  (2304 + 64 * (j))
#define XB_TOP      3328
#define XB_TOPGEN   3392
#define XCD_BAR_WORDS 3456
#define XB_SPIN_CAP (1u << 22)
#define LAS __attribute__((address_space(3)))
__device__ __forceinline__ unsigned xb_ld(unsigned* p) { return __hip_atomic_load(p, __ATOMIC_RELAXED, __HIP_MEMORY_SCOPE_AGENT); }
__device__ __forceinline__ unsigned xb_add(unsigned* p, unsigned v) { return __hip_atomic_fetch_add(p, v, __ATOMIC_RELAXED, __HIP_MEMORY_SCOPE_AGENT); }
__device__ __forceinline__ unsigned xb_xcc_id() { return (unsigned)__builtin_amdgcn_s_getreg((3 << 11) | 20) & 0xFu; }
#define XB_SPIN(cond, bar) do { unsigned _sp = 0; while (cond) { __builtin_amdgcn_s_sleep(1); \
    if ((++_sp & 255u) == 0u) { if (xb_ld(&(bar)[XB_TMO])) break; if (_sp > XB_SPIN_CAP) { atomicAdd(&(bar)[XB_TMO], 1u); break; } } } } while (0)
struct XcdBarrier { unsigned* bar; unsigned x; volatile LAS unsigned* st; };
__device__ __forceinline__ XcdBarrier xcd_barrier_post(unsigned* bar, volatile LAS unsigned* st) {
  XcdBarrier b; b.bar = bar; b.x = xb_xcc_id(); b.st = st;
  if (threadIdx.x == 0) (void)xb_add(&bar[XB_XCNT(b.x)], 1u);
  return b;
}
__device__ __forceinline__ void xcd_barrier_complete(unsigned* bar, unsigned x, unsigned& nloc, unsigned& nx) {
  const unsigned G = gridDim.x * gridDim.y * gridDim.z;
  unsigned sum, cnt, mine, sp = 0u;
  for (;;) {
    sum = 0u; cnt = 0u; mine = 0u;
#pragma unroll
    for (unsigned j = 0; j < 16; ++j) { const unsigned c = xb_ld(&bar[XB_XCNT(j)]); sum += c; cnt += (c > 0u) ? 1u : 0u; mine = (j == x) ? c : mine; }
    if (sum == G) break;
    __builtin_amdgcn_s_sleep(1);
    if ((++sp & 255u) == 0u) { if (xb_ld(&bar[XB_TMO])) break; if (sp > XB_SPIN_CAP) { atomicAdd(&bar[XB_TMO], 1u); break; } }
  }
  nloc = mine > 0u ? mine : 1u; nx = cnt > 0u ? cnt : 1u;
}
__device__ __forceinline__ void xcd_barrier(const XcdBarrier& b) {
  asm volatile("s_waitcnt vmcnt(0)" ::: "memory");
  __syncthreads();
  if (threadIdx.x == 0) {
    unsigned* bar = b.bar;
    __builtin_amdgcn_s_waitcnt(0);
    unsigned nloc = b.st[0], nx = b.st[1];
    if (nloc == 0u) { xcd_barrier_complete(bar, b.x, nloc, nx); b.st[0] = nloc; b.st[1] = nx; }
    const unsigned old = xb_add(&bar[XB_XSUB(b.x)], 1u);
    const unsigned gen = old / nloc;
    if (old + 1u == (gen + 1u) * nloc) {
      __builtin_amdgcn_fence(__ATOMIC_RELEASE, "agent");
      asm volatile("s_waitcnt vmcnt(0)" ::: "memory");
      const unsigned og = xb_add(&bar[XB_TOP], 1u);
      const unsigned tg = og / nx;
      if (og + 1u == (tg + 1u) * nx) xb_add(&bar[XB_TOPGEN], 1u);
      else XB_SPIN(xb_ld(&bar[XB_TOPGEN]) == tg, bar);
      __builtin_amdgcn_fence(__ATOMIC_ACQUIRE, "agent");
      xb_add(&bar[XB_XGEN(b.x)], 1u);
      asm volatile("s_waitcnt vmcnt(0)" ::: "memory");
    } else {
      XB_SPIN(xb_ld(&bar[XB_XGEN(b.x)]) == gen, bar);
      __builtin_amdgcn_fence(__ATOMIC_ACQUIRE, "agent");
      asm volatile("s_waitcnt vmcnt(0)" ::: "memory");
    }
  }
  __syncthreads();
}

__device__ __forceinline__ void gemm_acc(f32x16 (&acc)[2][2], const bfu* __restrict__ A, int lda,
                                         const bfu* __restrict__ Bt, int ldb, int K, bfu* sA, bfu*  ) {
  const int tid = threadIdx.x, lane = tid & 63, w = tid >> 6, wm = w & 1, wn = w >> 1;
  const int lr = tid >> 3;
  const int kc = ((tid & 7) ^ ((tid >> 4) & 7)) * 8;
  const bfu* Ap = A + (size_t)lr * lda + kc;
  const bfu* Bp = Bt + (size_t)lr * ldb + kc;
  const size_t a32 = (size_t)32 * lda, b32 = (size_t)32 * ldb;
  char* sbase = (char*)sA;
  char* ldst = sbase + tid * 16;
#define GISSUE(stage, k)                                                                                       \
  _Pragma("unroll") for (int i_ = 0; i_ < 4; ++i_) {                                                           \
    __builtin_amdgcn_global_load_lds((const unsigned*)(Ap + i_ * a32 + (k)),                                   \
                                     (LAS unsigned*)(ldst + (stage) * 32768 + i_ * 4096), 16, 0, 0);           \
    __builtin_amdgcn_global_load_lds((const unsigned*)(Bp + i_ * b32 + (k)),                                   \
                                     (LAS unsigned*)(ldst + (stage) * 32768 + 16384 + i_ * 4096), 16, 0, 0);   \
  }
  const int sw = (lane >> 1) & 7, hh = lane >> 5;
  const int rowA = (wm * 64 + (lane & 31)) * 128, rowB = (wn * 32 + (lane & 31)) * 128;
  __syncthreads();
  GISSUE(0, 0)
  int cur = 0;
  for (int k0 = 0; k0 < K; k0 += 64) {
    asm volatile("s_waitcnt vmcnt(0)" ::: "memory");
    __syncthreads();
    if (k0 + 64 < K) { GISSUE(cur ^ 1, k0 + 64) }
    const char* cA = sbase + cur * 32768;
    const char* cB = cA + 16384;
    __builtin_amdgcn_s_setprio(1);
#pragma unroll
    for (int ks = 0; ks < 4; ++ks) {
      const int pos = ((2 * ks + hh) ^ sw) * 16;
      bf16x8 af[2], bfr[2];
#pragma unroll
      for (int mi = 0; mi < 2; ++mi) af[mi] = *(const bf16x8*)(cA + rowA + mi * 32 * 128 + pos);
#pragma unroll
      for (int ni = 0; ni < 2; ++ni) bfr[ni] = *(const bf16x8*)(cB + rowB + ni * 64 * 128 + pos);
#pragma unroll
      for (int mi = 0; mi < 2; ++mi)
#pragma unroll
        for (int ni = 0; ni < 2; ++ni)
          acc[mi][ni] = __builtin_amdgcn_mfma_f32_32x32x16_bf16(af[mi], bfr[ni], acc[mi][ni], 0, 0, 0);
    }
    __builtin_amdgcn_s_setprio(0);
    cur ^= 1;
  }
}
#define gemm_acc1 gemm_acc
__device__ __forceinline__ void zero_acc(f32x16 (&acc)[2][2]) {
#pragma unroll
  for (int a = 0; a < 2; ++a)
#pragma unroll
    for (int b = 0; b < 2; ++b)
#pragma unroll
      for (int i = 0; i < 16; ++i) acc[a][b][i] = 0.f;
}
#define EPI_BEGIN                                                      \
  const int e_lane = threadIdx.x & 63, e_w = threadIdx.x >> 6;         \
  const int e_wm = e_w & 1, e_wn = e_w >> 1;                            \
  const int cl = e_wn * 32 + (e_lane & 31);                             \
  _Pragma("unroll") for (int mi = 0; mi < 2; ++mi)                      \
  _Pragma("unroll") for (int q = 0; q < 4; ++q) {                       \
    const int r0 = e_wm * 64 + mi * 32 + q * 8 + 4 * (e_lane >> 5);
#define EPI_END }

#define ST_LD 136
#define ST32_LD 132
__device__ __forceinline__ void copyout_bf16(const bfu* sT, bfu* dst, int ld) {
  const int tid = threadIdx.x;
#pragma unroll
  for (int i = 0; i < 8; ++i) {
    int id = tid + i * 256, row = id >> 4, c8 = (id & 15) * 8;
    *(uint4*)(dst + (size_t)row * ld + c8) = *(const uint4*)(sT + row * ST_LD + c8);
  }
}
__device__ __forceinline__ void stage_rm(bfu* sT, const f32x16 (&acc)[2][2], float sc) {
  EPI_BEGIN
#pragma unroll
    for (int j = 0; j < 4; ++j) {
      sT[(r0 + j) * ST_LD + cl] = f2bf(acc[mi][0][q * 4 + j] * sc);
      sT[(r0 + j) * ST_LD + cl + 64] = f2bf(acc[mi][1][q * 4 + j] * sc);
    }
  EPI_END
}

__device__ __forceinline__ void tile_map(int L, int nM, int nN, int& pm, int& pn) {
  const int nwg = nM * nN;
  const int q = nwg >> 3, r = nwg & 7, xcd = L & 7, off = L >> 3;
  int wgid = (xcd < r ? xcd * (q + 1) : r * (q + 1) + (xcd - r) * q) + off;
  const int nig = 8 * nN, gid = wgid / nig, fm = gid * 8;
  const int gsz = (nM - fm) < 8 ? (nM - fm) : 8;
  pm = fm + (wgid % nig) % gsz;
  pn = (wgid % nig) / gsz;
}
__device__ void transpose_w(const float* __restrict__ src, int K, int N, int src_ld, bfu* __restrict__ dst,
                            int remap, int gtid, int gstride) {
  int total = N * (K / 8);
  for (int i = gtid; i < total; i += gstride) {
    int n = i % N, kg = i / N;
    int col = (remap && n >= 3584) ? n + 8 : n;
    float v[8];
#pragma unroll
    for (int j = 0; j < 8; ++j) v[j] = src[(size_t)(kg * 8 + j) * src_ld + col];
    uint4 o;
    o.x = pack2(v[0], v[1]); o.y = pack2(v[2], v[3]); o.z = pack2(v[4], v[5]); o.w = pack2(v[6], v[7]);
    *(uint4*)(dst + (size_t)n * K + kg * 8) = o;
  }
}
__device__ void transpose_w_lds(const float* __restrict__ src, int K, int N, int src_ld, bfu* __restrict__ dst,
                                int remap, float* st, int boff) {
  const int tid = threadIdx.x;
  const int tilesN = N >> 6, ntile = (K >> 6) * tilesN;
  for (int t = (int)((blockIdx.x + gridDim.x - (boff % gridDim.x)) % gridDim.x); t < ntile; t += gridDim.x) {
    const int kt = t / tilesN, nt = t - kt * tilesN;
    {
      const int row = tid >> 2, c16 = (tid & 3) * 16;
      const int n0 = nt * 64 + c16;
      const int col = (remap && n0 >= 3584) ? n0 + 8 : n0;
      const float* sp = src + (size_t)(kt * 64 + row) * src_ld + col;
#pragma unroll
      for (int j = 0; j < 4; ++j) {
        float4 v = *(const float4*)(sp + j * 4);
        float* d = st + row * 65 + c16 + j * 4;
        d[0] = v.x; d[1] = v.y; d[2] = v.z; d[3] = v.w;
      }
    }
    __syncthreads();
    {
      const int n = tid >> 2, kc = (tid & 3) * 16;
#pragma unroll
      for (int hf = 0; hf < 2; ++hf) {
        float f[8];
#pragma unroll
        for (int j = 0; j < 8; ++j) f[j] = st[(kc + hf * 8 + j) * 65 + n];
        uint4 o;
        o.x = pack2(f[0], f[1]); o.y = pack2(f[2], f[3]); o.z = pack2(f[4], f[5]); o.w = pack2(f[6], f[7]);
        *(uint4*)(dst + (size_t)(nt * 64 + n) * K + kt * 64 + kc + hf * 8) = o;
      }
    }
    __syncthreads();
  }
}
__device__ void convert_bf(const float* __restrict__ src, bfu* __restrict__ dst, size_t n8, int gtid, int gstride) {
  for (size_t i = gtid; i < n8; i += gstride) {
    float4 a = *(const float4*)(src + i * 8), b = *(const float4*)(src + i * 8 + 4);
    uint4 o;
    o.x = pack2(a.x, a.y); o.y = pack2(a.z, a.w); o.z = pack2(b.x, b.y); o.w = pack2(b.z, b.w);
    *(uint4*)(dst + i * 8) = o;
  }
}

__device__ void prep_rows(const Params& P) {
  const int lane = threadIdx.x & 63, w = threadIdx.x >> 6;
  bfu* hbuf = (bfu*)(P.ws + SLOT(0));
  float* gpre = (float*)(P.ws + O_GPRE);
  for (int r = blockIdx.x * 4 + w; r < MT; r += gridDim.x * 4) {
    const float* xr = xrow(P, r);
    float4 v[4];
    float ss = 0.f;
#pragma unroll
    for (int i = 0; i < 4; ++i) {
      v[i] = *(const float4*)(xr + i * 256 + lane * 4);
      ss += v[i].x * v[i].x + v[i].y * v[i].y + v[i].z * v[i].z + v[i].w * v[i].w;
    }
    ss = wave_sum(ss);
    float rstd = rsqrtf(ss * (1.f / 1024.f) + EPS);
    float ga[8];
#pragma unroll
    for (int j = 0; j < 8; ++j) ga[j] = 0.f;
#pragma unroll
    for (int i = 0; i < 4; ++i) {
      float4 g = *(const float4*)(P.g_mix + i * 256 + lane * 4);
      float hv[4] = {v[i].x * rstd * g.x, v[i].y * rstd * g.y, v[i].z * rstd * g.z, v[i].w * rstd * g.w};
      uint2 o; o.x = pack2(hv[0], hv[1]); o.y = pack2(hv[2], hv[3]);
      *(uint2*)(hbuf + (size_t)r * 1024 + i * 256 + lane * 4) = o;
#pragma unroll
      for (int j = 0; j < 4; ++j) {
        const float* wr = P.w_in + (size_t)(i * 256 + lane * 4 + j) * 5640 + 3584;
        float4 w0 = *(const float4*)wr, w1 = *(const float4*)(wr + 4);
        ga[0] += hv[j] * w0.x; ga[1] += hv[j] * w0.y; ga[2] += hv[j] * w0.z; ga[3] += hv[j] * w0.w;
        ga[4] += hv[j] * w1.x; ga[5] += hv[j] * w1.y; ga[6] += hv[j] * w1.z; ga[7] += hv[j] * w1.w;
      }
    }
    float si = reduce4(ga[0], ga[1], ga[2], ga[3]);
    float sf = reduce4(ga[4], ga[5], ga[6], ga[7]);
    if ((lane & 15) == 0) {
      int k = lane >> 4;
      gpre[(size_t)r * 8 + k] = si + P.b_i[k];
      gpre[(size_t)r * 8 + 4 + k] = sf + P.b_f[k];
    }
  }
}
__device__ void gate_scan(const Params& P) {
  const int lane = threadIdx.x & 63, w = threadIdx.x >> 6;
  const float* gpre = (const float*)(P.ws + O_GPRE);
  for (int item = blockIdx.x * 4 + w; item < 528 * 4; item += gridDim.x * 4) {
    int tile = item >> 2, h = item & 3;
    int row0, L;
    if (tile < 512) { row0 = tile * 64; L = 64; } else { row0 = MP + (tile - 512) * 32; L = 32; }
    const int s = lane;
    bool valid = s < L;
    float ig = valid ? gpre[(size_t)(row0 + s) * 8 + h] : -INFINITY;
    float fg = valid ? gpre[(size_t)(row0 + s) * 8 + 4 + h] : 0.f;
    float lf = valid ? (fminf(fg, 0.f) - log1pf(__expf(-fabsf(fg)))) : 0.f;
    float F = lf;
#pragma unroll
    for (int o = 1; o < 64; o <<= 1) { float t = __shfl_up(F, o); if (lane >= o) F += t; }
    float u = valid ? ig - F : -INFINITY;
    float cm = u;
#pragma unroll
    for (int o = 1; o < 64; o <<= 1) { float t = __shfl_up(cm, o); if (lane >= o) cm = fmaxf(cm, t); }
    if (valid) {
      size_t gi = (size_t)(row0 + s) * 4 + h;
      ((float*)(P.ws + O_FQ))[gi] = F;
      ((float*)(P.ws + O_UQ))[gi] = u;
      ((float*)(P.ws + O_CMQ))[gi] = cm;
      if (s == L - 1) {
        ((float*)(P.ws + O_FL))[tile * 4 + h] = F;
        ((float*)(P.ws + O_UC))[tile * 4 + h] = cm;
      }
    }
  }
}

__device__ void phase_prep(const Params& P, char* smem) {
  const int gtid = blockIdx.x * NTHREADS + threadIdx.x, gstride = gridDim.x * NTHREADS;
  prep_rows(P);
  transpose_w_lds(P.w_in, 1024, 5632, 5640, (bfu*)(P.ws + O_WT_IN), 1, (float*)smem, 0);
  transpose_w_lds(P.w_up_r, 512, 1024, 1024, (bfu*)(P.ws + O_WT_UPR), 0, (float*)smem, 1408);
  transpose_w_lds(P.w_up_m, 512, 1024, 1024, (bfu*)(P.ws + O_WT_UPM), 0, (float*)smem, 1536);
  transpose_w_lds(P.w_out, 1024, 1024, 1024, (bfu*)(P.ws + O_WT_OUT), 0, (float*)smem, 1664);
  transpose_w_lds(P.w_pq, 1024, 2048, 2048, (bfu*)(P.ws + O_WT_PQ), 0, (float*)smem, 1920);
  transpose_w_lds(P.w_pg, 1024, 1024, 1024, (bfu*)(P.ws + O_WT_PG), 0, (float*)smem, 2432);
  transpose_w_lds(P.w_ple, 256, 1024, 1024, (bfu*)(P.ws + O_WT_PLE), 0, (float*)smem, 2688);
  for (int h = 0; h < 4; ++h) {
    transpose_w_lds(P.w_mq + h * 16384, 128, 128, 128, (bfu*)(P.ws + O_WT_MQ) + h * 16384, 0, (float*)smem, 2752 + h * 8);
    transpose_w_lds(P.w_mk + h * 16384, 128, 128, 128, (bfu*)(P.ws + O_WT_MK) + h * 16384, 0, (float*)smem, 2756 + h * 8);
  }
  convert_bf(P.peer_keys, (bfu*)(P.ws + O_KEYS), 16 * 128 * 128 / 8, gtid, gstride);
  float* ct = (float*)(P.ws + O_COS); float* st = (float*)(P.ws + O_SIN);
  for (int i = gtid; i < 8192 * 64; i += gstride) {
    int pos = i >> 6, j = i & 63;
    float inv = exp2f(-(float)j * (13.287712379549449f / 64.f));
    float angf = (float)pos * inv;
    double a = (double)angf;
    double k = rint(a * 0.15915494309189535);
    float r = (float)(a - k * 6.283185307179586);
    ct[i] = __cosf(r); st[i] = __sinf(r);
  }
}

__device__ __forceinline__ void gemm_acc256(f32x16 (&acc)[4][2], const bfu* __restrict__ A, int lda,
                                            const bfu* __restrict__ Bt, int ldb, int K, char* sbase) {
  const int tid = threadIdx.x, lane = tid & 63, w = tid >> 6, wm = w & 1, wn = w >> 1;
  const int kc = ((tid & 3) ^ ((tid >> 4) & 3)) * 8;
  const bfu* Ap = A + (size_t)(tid >> 2) * lda + kc;
  const bfu* Bp = Bt + (size_t)(tid >> 2) * ldb + kc;
  const size_t a64 = (size_t)64 * lda, b64 = (size_t)64 * ldb;
  char* ldst = sbase + tid * 16;
#define GISSUE256(stage, k)                                                                                      \
  {                                                                                                              \
    char* d_ = ldst + (stage) * 24576;                                                                           \
    __builtin_amdgcn_global_load_lds((const unsigned*)(Ap + (k)), (LAS unsigned*)(d_), 16, 0, 0);                \
    __builtin_amdgcn_global_load_lds((const unsigned*)(Ap + a64 + (k)), (LAS unsigned*)(d_ + 4096), 16, 0, 0);   \
    __builtin_amdgcn_global_load_lds((const unsigned*)(Ap + 2 * a64 + (k)), (LAS unsigned*)(d_ + 8192), 16, 0, 0);  \
    __builtin_amdgcn_global_load_lds((const unsigned*)(Ap + 3 * a64 + (k)), (LAS unsigned*)(d_ + 12288), 16, 0, 0); \
    __builtin_amdgcn_global_load_lds((const unsigned*)(Bp + (k)), (LAS unsigned*)(d_ + 16384), 16, 0, 0);        \
    __builtin_amdgcn_global_load_lds((const unsigned*)(Bp + b64 + (k)), (LAS unsigned*)(d_ + 20480), 16, 0, 0);  \
  }
  const int sw = (lane >> 2) & 3, hh = lane >> 5;
  const int rowA = (wm * 64 + (lane & 31)) * 64, rowB = (wn * 32 + (lane & 31)) * 64;
  const int nk = K >> 5;
  __syncthreads();
  asm volatile("s_waitcnt vmcnt(0)" ::: "memory");
  GISSUE256(0, 0)
  if (nk > 1) GISSUE256(1, 32)
  int st = 0;
  for (int kt = 0; kt < nk; ++kt) {
    if (kt + 1 < nk) asm volatile("s_waitcnt vmcnt(6)" ::: "memory");
    else asm volatile("s_waitcnt vmcnt(0)" ::: "memory");
    asm volatile("s_waitcnt lgkmcnt(0)" ::: "memory");
    __builtin_amdgcn_s_barrier();
    asm volatile("" ::: "memory");
    if (kt + 2 < nk) { const int s2 = st >= 1 ? st - 1 : 2; GISSUE256(s2, (kt + 2) * 32) }
    const char* cA = sbase + st * 24576;
    const char* cB = cA + 16384;
    __builtin_amdgcn_s_setprio(1);
#pragma unroll
    for (int ks = 0; ks < 2; ++ks) {
      const int pos = ((2 * ks + hh) ^ sw) * 16;
      bf16x8 af[4], bfr[2];
#pragma unroll
      for (int mi = 0; mi < 4; ++mi) af[mi] = *(const bf16x8*)(cA + rowA + ((mi >> 1) * 128 + (mi & 1) * 32) * 64 + pos);
#pragma unroll
      for (int ni = 0; ni < 2; ++ni) bfr[ni] = *(const bf16x8*)(cB + rowB + ni * 64 * 64 + pos);
#pragma unroll
      for (int mi = 0; mi < 4; ++mi)
#pragma unroll
        for (int ni = 0; ni < 2; ++ni)
          acc[mi][ni] = __builtin_amdgcn_mfma_f32_32x32x16_bf16(af[mi], bfr[ni], acc[mi][ni], 0, 0, 0);
    }
    __builtin_amdgcn_s_setprio(0);
    st = st == 2 ? 0 : st + 1;
  }
}

__device__ __forceinline__ void gemm1_epilogue(const Params& P, char* smem, f32x16 (&acc)[2][2], const int rbase, const int nt,
                                               const float* ct, const float* stb) {
    const bool prompt = rbase < MP;
  int region = nt >> 2, hh = nt & 3;
  bfu* sT = (bfu*)smem;
  __syncthreads();
  if (region <= 1) {
    float sc = region == 1 ? 0.08838834764831845f : 1.f;
    EPI_BEGIN
#pragma unroll
      for (int j = 0; j < 4; ++j) {
        int rr = rbase + r0 + j;
        int pos = prompt ? (rr & 8191) : 2048 + ((rr - MP) & 31);
        float c = ct[pos * 64 + cl], sn = stb[pos * 64 + cl];
        float a = acc[mi][0][q * 4 + j], b = acc[mi][1][q * 4 + j];
        sT[(r0 + j) * ST_LD + cl] = f2bf((a * c - b * sn) * sc);
        sT[(r0 + j) * ST_LD + cl + 64] = f2bf((a * sn + b * c) * sc);
      }
    EPI_END
    __syncthreads();
    copyout_bf16(sT, (bfu*)(P.ws + SLOT(2 + region)) + (size_t)rbase * 512 + hh * 128, 512);
  } else if (region == 2 || region == 5) {
    EPI_BEGIN
      uint2 va, vb;
      va.x = pack2(acc[mi][0][q * 4 + 0], acc[mi][0][q * 4 + 1]); va.y = pack2(acc[mi][0][q * 4 + 2], acc[mi][0][q * 4 + 3]);
      vb.x = pack2(acc[mi][1][q * 4 + 0], acc[mi][1][q * 4 + 1]); vb.y = pack2(acc[mi][1][q * 4 + 2], acc[mi][1][q * 4 + 3]);
      *(uint2*)(sT + cl * ST_LD + r0) = va;
      *(uint2*)(sT + (cl + 64) * ST_LD + r0) = vb;
    EPI_END
    __syncthreads();
    bfu* dst = (bfu*)(P.ws + SLOT(region == 2 ? 4 : 7));
#pragma unroll
    for (int i = 0; i < 8; ++i) {
      int id = threadIdx.x + i * 256, e = id >> 4, c8 = (id & 15) * 8;
      size_t o;
      if (prompt) { int bb = rbase >> 13, tt = (rbase & 8191) + c8; o = ((size_t)((bb * 4 + hh) * 128 + e)) * 8192 + tt; }
      else { int rs = rbase - MP + c8, bb = rs >> 5, tt = rs & 31; o = SB_T + ((size_t)((bb * 4 + hh) * 128 + e)) * 32 + tt; }
      *(uint4*)(dst + o) = *(const uint4*)(sT + e * ST_LD + c8);
    }
  } else if (region == 3 || region == 4 || region == 6) {
    stage_rm(sT, acc, 1.f);
    __syncthreads();
    copyout_bf16(sT, (bfu*)(P.ws + SLOT(region == 3 ? 5 : (region == 4 ? 6 : 8))) + (size_t)rbase * 512 + hh * 128, 512);
  } else {
    int gi = nt - 28;
    stage_rm(sT, acc, 1.f);
    __syncthreads();
    copyout_bf16(sT, (bfu*)(P.ws + SLOT(gi < 8 ? 9 : 11)) + (size_t)rbase * 1024 + (gi & 7) * 128, 1024);
  }

}

__device__ void phase_gemm1(const Params& P, char* smem) {
  const bfu* hbuf = (const bfu*)(P.ws + SLOT(0));
  const bfu* wt = (const bfu*)(P.ws + O_WT_IN);
  const float* ct = (const float*)(P.ws + O_COS); const float* stb = (const float*)(P.ws + O_SIN);
  for (int t = blockIdx.x; t < 130 * 44; t += gridDim.x) {
    int mt, nt; tile_map(t, 130, 44, mt, nt);
    f32x16 acc[4][2];
#pragma unroll
    for (int a = 0; a < 4; ++a)
#pragma unroll
      for (int b = 0; b < 2; ++b)
#pragma unroll
        for (int i = 0; i < 16; ++i) acc[a][b][i] = 0.f;
    gemm_acc256(acc, hbuf + (size_t)mt * 256 * 1024, 1024, wt + (size_t)nt * 128 * 1024, 1024, 1024, smem);
    gemm1_epilogue(P, smem, reinterpret_cast<f32x16(&)[2][2]>(acc[0]), mt * 256, nt, ct, stb);
    gemm1_epilogue(P, smem, reinterpret_cast<f32x16(&)[2][2]>(acc[2]), mt * 256 + 128, nt, ct, stb);
  }
}

__device__ void phase_conv(const Params& P) {
  const int gtid = blockIdx.x * NTHREADS + threadIdx.x, gstride = gridDim.x * NTHREADS;
  const bfu* xm = (const bfu*)(P.ws + SLOT(6));
  bfu* cb = (bfu*)(P.ws + SLOT(0));
  for (int i = gtid; i < MT * 64; i += gstride) {
    int r = i >> 6, c0 = (i & 63) * 8;
    int t, T, bb; bool prompt = r < MP;
    if (prompt) { bb = r >> 13; t = r & 8191; T = 8192; } else { int rs = r - MP; bb = rs >> 5; t = rs & 31; T = 32; }
    float y[8];
#pragma unroll
    for (int j = 0; j < 8; ++j) y[j] = P.conv_b[c0 + j];
#pragma unroll
    for (int k = 0; k < 4; ++k) {
      int tt = t - 3 + k;
      float xv[8];
      if (tt >= 0) {
        uint4 v = *(const uint4*)(xm + (size_t)(r - 3 + k) * 512 + c0);
        xv[0] = bf2f(v.x & 0xffff); xv[1] = bf2f(v.x >> 16); xv[2] = bf2f(v.y & 0xffff); xv[3] = bf2f(v.y >> 16);
        xv[4] = bf2f(v.z & 0xffff); xv[5] = bf2f(v.z >> 16); xv[6] = bf2f(v.w & 0xffff); xv[7] = bf2f(v.w >> 16);
      } else if (!prompt) {
        const float* sp = P.st_conv + (size_t)(bb * 3 + (tt + 3)) * 512 + c0;
#pragma unroll
        for (int j = 0; j < 8; ++j) xv[j] = sp[j];
      } else {
#pragma unroll
        for (int j = 0; j < 8; ++j) xv[j] = 0.f;
      }
#pragma unroll
      for (int j = 0; j < 8; ++j) y[j] += xv[j] * P.conv_w[k * 512 + c0 + j];
    }
    if (t >= T - 3) {
      uint4 v = *(const uint4*)(xm + (size_t)r * 512 + c0);
      float* dst = (prompt ? P.out + OO_CONVP : P.out + OO_CONVS) + (size_t)(bb * 3 + (t - (T - 3))) * 512 + c0;
      dst[0] = bf2f(v.x & 0xffff); dst[1] = bf2f(v.x >> 16); dst[2] = bf2f(v.y & 0xffff); dst[3] = bf2f(v.y >> 16);
      dst[4] = bf2f(v.z & 0xffff); dst[5] = bf2f(v.z >> 16); dst[6] = bf2f(v.w & 0xffff); dst[7] = bf2f(v.w >> 16);
    }
    uint4 o;
#pragma unroll
    for (int j = 0; j < 8; ++j) y[j] = y[j] * sigmoidf_(y[j]);
    o.x = pack2(y[0], y[1]); o.y = pack2(y[2], y[3]); o.z = pack2(y[4], y[5]); o.w = pack2(y[6], y[7]);
    *(uint4*)(cb + (size_t)r * 512 + c0) = o;
  }
}

__device__ void m_fold(const Params& P) {
  const int gtid = blockIdx.x * NTHREADS + threadIdx.x;
  const float* FL = (const float*)(P.ws + O_FL); const float* UC = (const float*)(P.ws + O_UC);
  float* MCS = (float*)(P.ws + O_MCS);
  if (gtid < 16) {
    int b = gtid >> 2, h = gtid & 3;
    float m = 0.f;
    for (int c = 0; c < 128; c += 8) {
      float fl[8], uc[8];
#pragma unroll
      for (int k = 0; k < 8; ++k) { fl[k] = FL[(b * 128 + c + k) * 4 + h]; uc[k] = UC[(b * 128 + c + k) * 4 + h]; }
#pragma unroll
      for (int k = 0; k < 8; ++k) { MCS[gtid * 128 + c + k] = m; m = fl[k] + fmaxf(m, uc[k]); }
    }
  } else if (gtid < 16 + 64) {
    int bh = gtid - 16;
    MCS[2048 + bh] = P.st_m[bh];
  }
}
__device__ void phase_mqk(const Params& P, char* smem) {
  bfu* sA = (bfu*)smem; bfu* sB = sA + 128 * 72;
  const bfu* cb = (const bfu*)(P.ws + SLOT(0));
  for (int t = blockIdx.x; t < 260 * 8; t += gridDim.x) {
    int mt = t >> 3, which = (t >> 2) & 1, hh = t & 3;
    const bfu* wt = (const bfu*)(P.ws + (which ? O_WT_MK : O_WT_MQ)) + hh * 16384;
    f32x16 acc[2][2]; zero_acc(acc);
    gemm_acc(acc, cb + (size_t)mt * 128 * 512 + hh * 128, 512, wt, 128, 128, sA, sB);
    bfu* dst = (bfu*)(P.ws + SLOT(which ? 13 : 1));
    float sc = which ? 0.08838834764831845f : 1.f;
    bfu* sT = (bfu*)smem;
    __syncthreads();
    stage_rm(sT, acc, sc);
    __syncthreads();
    copyout_bf16(sT, dst + (size_t)mt * 128 * 512 + hh * 128, 512);
  }
}

struct Item { int b, h, c, row0, L, T, chunk, bh; bool prompt; size_t vt_off; };
__device__ __forceinline__ Item decode_item(int idx) {
  Item it;
  if (idx < 2048) {
    it.prompt = true; it.b = idx >> 9; it.h = (idx >> 7) & 3; it.c = idx & 127; it.row0 = it.b * 8192 + it.c * 64;
    it.L = 64; it.T = 8192; it.chunk = it.b * 128 + it.c; it.bh = it.b * 4 + it.h;
    it.vt_off = ((size_t)(it.bh * 128)) * 8192 + it.c * 64;
  } else {
    int si = idx - 2048; it.prompt = false; it.b = si >> 2; it.h = si & 3; it.c = 0; it.row0 = MP + it.b * 32;
    it.L = 32; it.T = 32; it.chunk = 512 + it.b; it.bh = it.b * 4 + it.h;
    it.vt_off = SB_T + ((size_t)(it.bh * 128)) * 32;
  }
  return it;
}
__device__ __forceinline__ bfu* ds_ptr(const Params& P, int mixer, int idx) {
  if (idx < 2048) return (bfu*)P.out + ((size_t)(mixer * 2048 + idx)) * 16384;
  return (bfu*)(P.ws + O_DSS) + ((size_t)(mixer * 64 + (idx - 2048))) * 16384;
}
__device__ __forceinline__ float ret_lg(int h) { return log1pf(-exp2f(-5.f - (float)h)); }

__device__ void phaseA_item(const Params& P, int mixer, int idx, char* smem) {
  const int tid = threadIdx.x, lane = tid & 63, w = tid >> 6, wm = w & 1, wn = w >> 1;
  Item it = decode_item(idx);
  bfu* sK = (bfu*)smem; bfu* sV = sK + 128 * 72;
  float* sw = (float*)(sV + 128 * 72);
  float* sm = sw + 64;
  const int L = it.L, h = it.h;
  const bfu* Ksrc = (const bfu*)(P.ws + SLOT(mixer == 0 ? 3 : 13)) + (size_t)it.row0 * 512 + h * 128;
  const bfu* Vsrc = (const bfu*)(P.ws + SLOT(mixer == 0 ? 4 : 7)) + it.vt_off;
  uint4 kreg[4], vreg[4];
#pragma unroll
  for (int i = 0; i < 4; ++i) {
    int id = tid + i * 256, s = id & 63, dc = (id >> 6) * 8;
    kreg[i] = make_uint4(0, 0, 0, 0);
    if (s < L) kreg[i] = *(const uint4*)(Ksrc + (size_t)s * 512 + dc);
    int e = id >> 3, sc = (id & 7) * 8;
    vreg[i] = make_uint4(0, 0, 0, 0);
    if (sc < L) vreg[i] = *(const uint4*)(Vsrc + (size_t)e * it.T + sc);
  }
  if (mixer == 0) {
    if (tid < 64) { float lg = ret_lg(h); sw[tid] = tid < L ? __expf(lg * (float)(L - 1 - tid)) : 0.f; }
  } else {
    const float* FL = (const float*)(P.ws + O_FL); const float* UC = (const float*)(P.ws + O_UC);
    float mc = ((const float*)(P.ws + O_MCS))[idx];
    float Ml = fmaxf(mc, UC[it.chunk * 4 + h]);
    if (tid < 64) sw[tid] = tid < L ? __expf(((const float*)(P.ws + O_UQ))[(size_t)(it.row0 + tid) * 4 + h] - Ml) : 0.f;
    if (tid == 0) {
      ((float*)(P.ws + O_AEND))[idx] = __expf(mc - Ml);
      if (!it.prompt) P.out[OO_MS + it.bh] = FL[it.chunk * 4 + h] + Ml;
      else if (it.c == 127) P.out[OO_MP + it.bh] = FL[it.chunk * 4 + h] + Ml;
    }
  }
  __syncthreads();
#pragma unroll
  for (int i = 0; i < 4; ++i) {
    int id = tid + i * 256, s = id & 63, dc = (id >> 6) * 8;
    uint4 v = kreg[i];
    float ww = sw[s];
    unsigned vv[4] = {v.x, v.y, v.z, v.w};
#pragma unroll
    for (int j = 0; j < 4; ++j) {
      sK[(dc + 2 * j) * 72 + s] = f2bf(bf2f(vv[j] & 0xffff) * ww);
      sK[(dc + 2 * j + 1) * 72 + s] = f2bf(bf2f(vv[j] >> 16) * ww);
    }
  }
#pragma unroll
  for (int i = 0; i < 4; ++i) {
    int id = tid + i * 256, e = id >> 3, sc = (id & 7) * 8;
    *(uint4*)(sV + e * 72 + sc) = vreg[i];
  }
  __syncthreads();
  f32x16 acc[2][2]; zero_acc(acc);
#pragma unroll
  for (int ks = 0; ks < 4; ++ks) {
    bf16x8 af[2], bfr[2];
#pragma unroll
    for (int mi = 0; mi < 2; ++mi)
      af[mi] = *(const bf16x8*)(sK + (wm * 64 + mi * 32 + (lane & 31)) * 72 + ks * 16 + (lane >> 5) * 8);
#pragma unroll
    for (int ni = 0; ni < 2; ++ni)
      bfr[ni] = *(const bf16x8*)(sV + (wn * 32 + ni * 64 + (lane & 31)) * 72 + ks * 16 + (lane >> 5) * 8);
#pragma unroll
    for (int mi = 0; mi < 2; ++mi)
#pragma unroll
      for (int ni = 0; ni < 2; ++ni)
        acc[mi][ni] = __builtin_amdgcn_mfma_f32_32x32x16_bf16(af[mi], bfr[ni], acc[mi][ni], 0, 0, 0);
  }
  bfu* dS = ds_ptr(P, mixer, idx);
  EPI_BEGIN
#pragma unroll
    for (int ni = 0; ni < 2; ++ni) {
      int e = cl + ni * 64;
      uint2 o; o.x = pack2(acc[mi][ni][q * 4 + 0], acc[mi][ni][q * 4 + 1]); o.y = pack2(acc[mi][ni][q * 4 + 2], acc[mi][ni][q * 4 + 3]);
      *(uint2*)(dS + e * 128 + r0) = o;
    }
  EPI_END
  if (mixer == 1 && tid < 128) {
    float s = 0.f;
#pragma unroll
    for (int j = 0; j < 8; ++j) { float f[8]; unpack8(*(const uint4*)(sK + tid * 72 + j * 8), f);
#pragma unroll
      for (int k = 0; k < 8; ++k) s += f[k]; }
    ((float*)(P.ws + O_DN))[(size_t)idx * 128 + tid] = s;
  }
  __syncthreads();
}

__device__ void phase_scan(const Params& P) {
  const int gtid = blockIdx.x * NTHREADS + threadIdx.x, gstride = gridDim.x * NTHREADS;
  const float* AE = (const float*)(P.ws + O_AEND);
  for (int i = gtid; i < 131072; i += gstride) {
    int mixer = i >> 16, bh = (i >> 12) & 15, eo = (i & 4095) * 4;
    int h = bh & 3;
    float gch = __expf(ret_lg(h) * 64.f);
    float st[4];
#pragma unroll
    for (int j = 0; j < 4; ++j) st[j] = 0.f;
    bfu* base = (bfu*)P.out + ((size_t)(mixer * 2048 + bh * 128)) * 16384 + eo;
    for (int c = 0; c < 128; c += 8) {
      uint2 v[8];
#pragma unroll
      for (int k = 0; k < 8; ++k) v[k] = *(const uint2*)(base + (size_t)(c + k) * 16384);
#pragma unroll
      for (int k = 0; k < 8; ++k) {
        float dec = mixer == 0 ? gch : AE[bh * 128 + c + k];
        float d0 = bf2f(v[k].x & 0xffff), d1 = bf2f(v[k].x >> 16), d2 = bf2f(v[k].y & 0xffff), d3 = bf2f(v[k].y >> 16);
        uint2 o; o.x = pack2(st[0], st[1]); o.y = pack2(st[2], st[3]);
        *(uint2*)(base + (size_t)(c + k) * 16384) = o;
        st[0] = dec * st[0] + d0; st[1] = dec * st[1] + d1; st[2] = dec * st[2] + d2; st[3] = dec * st[3] + d3;
      }
    }
    float* o = P.out + (mixer == 0 ? OO_RETP : OO_CP) + (size_t)bh * 16384;
    int e = eo >> 7, d0i = eo & 127;
#pragma unroll
    for (int j = 0; j < 4; ++j) o[(d0i + j) * 128 + e] = st[j];
  }
  for (int i = gtid; i < 2 * 64 * 2048; i += gstride) {
    int mixer = i >> 17, bh = (i >> 11) & 63, eo = (i & 2047) * 8;
    int h = bh & 3;
    int e = eo >> 7, d0 = eo & 127;
    const float* s0 = (mixer == 0 ? P.st_ret : P.st_C) + (size_t)bh * 16384;
    float st[8];
#pragma unroll
    for (int j = 0; j < 8; ++j) st[j] = s0[(d0 + j) * 128 + e];
    bfu* p = (bfu*)(P.ws + O_DSS) + ((size_t)(mixer * 64 + bh)) * 16384 + eo;
    float d[8]; unpack8(*(const uint4*)p, d);
    *(uint4*)p = pack8(st);
    float dec = mixer == 0 ? __expf(ret_lg(h) * 32.f) : AE[2048 + bh];
    float* o = P.out + (mixer == 0 ? OO_RETS : OO_CS) + (size_t)bh * 16384;
#pragma unroll
    for (int j = 0; j < 8; ++j) o[(d0 + j) * 128 + e] = dec * st[j] + d[j];
  }
  float* DN = (float*)(P.ws + O_DN);
  for (int i = gtid; i < 16 * 128; i += gstride) {
    int bh = i >> 7, d = i & 127;
    float n = 0.f;
    for (int c = 0; c < 128; ++c) {
      size_t o = (size_t)(bh * 128 + c) * 128 + d;
      float v = DN[o]; DN[o] = n; n = AE[bh * 128 + c] * n + v;
    }
    P.out[OO_NP + i] = n;
  }
  for (int i = gtid; i < 64 * 128; i += gstride) {
    int bh = i >> 7, d = i & 127;
    size_t o = (size_t)(2048 + bh) * 128 + d;
    float n0 = P.st_n[i]; float v = DN[o]; DN[o] = n0;
    P.out[OO_NS + i] = AE[2048 + bh] * n0 + v;
  }
}

__device__ void phaseC_item(const Params& P, int mixer, int idx, char* smem) {
  const int tid = threadIdx.x, lane = tid & 63, w = tid >> 6;
  Item it = decode_item(idx);
  const int L = it.L, h = it.h;
  bfu* sQ = (bfu*)smem;
  bfu* sKV = sQ + 64 * 136;
  bfu* sP = sKV + 128 * 72;
  bfu* sS = sP + 64 * 72;
  float* sO = (float*)sS;
  float* sRow = (float*)(sS + 128 * 136);
  const bfu* Qsrc = (const bfu*)(P.ws + SLOT(mixer == 0 ? 2 : 1)) + (size_t)it.row0 * 512 + h * 128;
  const bfu* Ksrc = (const bfu*)(P.ws + SLOT(mixer == 0 ? 3 : 13)) + (size_t)it.row0 * 512 + h * 128;
  const bfu* Vsrc = (const bfu*)(P.ws + SLOT(mixer == 0 ? 4 : 7)) + it.vt_off;
  const bfu* Ssrc = ds_ptr(P, mixer, idx);
  const float lg = ret_lg(h);
  uint4 vpre[4];
#pragma unroll
  for (int i = 0; i < 4; ++i) {
    int id = tid + i * 256, e = id >> 3, sc = (id & 7) * 8;
    vpre[i] = make_uint4(0, 0, 0, 0);
    if (sc < L) vpre[i] = *(const uint4*)(Vsrc + (size_t)e * it.T + sc);
  }
#pragma unroll
  for (int i = 0; i < 4; ++i) {
    int id = tid + i * 256, s = id >> 4, dc = (id & 15) * 8;
    uint4 vq = make_uint4(0, 0, 0, 0), vk = vq;
    if (s < L) { vq = *(const uint4*)(Qsrc + (size_t)s * 512 + dc); vk = *(const uint4*)(Ksrc + (size_t)s * 512 + dc); }
    *(uint4*)(sQ + s * 136 + dc) = vq;
    *(uint4*)(sKV + s * 136 + dc) = vk;
  }
#pragma unroll
  for (int i = 0; i < 8; ++i) {
    int id = tid + i * 256, e = id >> 4, dc = (id & 15) * 8;
    *(uint4*)(sS + e * 136 + dc) = *(const uint4*)(Ssrc + e * 128 + dc);
  }
  if (tid < 64) {
    int i = tid;
    if (mixer == 0) {
      sRow[128 + i] = __expf(lg * (float)(i + 1));
    } else {
      float mc = ((const float*)(P.ws + O_MCS))[idx];
      size_t gi = (size_t)(it.row0 + i) * 4 + h;
      bool valid = i < L;
      float u = valid ? ((const float*)(P.ws + O_UQ))[gi] : -INFINITY;
      float M = valid ? fmaxf(mc, ((const float*)(P.ws + O_CMQ))[gi]) : 0.f;
      float F = valid ? ((const float*)(P.ws + O_FQ))[gi] : 0.f;
      sRow[i] = u; sRow[64 + i] = M; sRow[128 + i] = valid ? __expf(mc - M) : 0.f;
      sRow[256 + i] = __expf(-(F + M));
    }
  }
  __syncthreads();
  {
    const int mi = w & 1, ni = w >> 1;
    f32x16 acc;
#pragma unroll
    for (int i = 0; i < 16; ++i) acc[i] = 0.f;
#pragma unroll 2
    for (int ks = 0; ks < 8; ++ks) {
      bf16x8 af = *(const bf16x8*)(sQ + (mi * 32 + (lane & 31)) * 136 + ks * 16 + (lane >> 5) * 8);
      bf16x8 bfr = *(const bf16x8*)(sKV + (ni * 32 + (lane & 31)) * 136 + ks * 16 + (lane >> 5) * 8);
      acc = __builtin_amdgcn_mfma_f32_32x32x16_bf16(af, bfr, acc, 0, 0, 0);
    }
    const int s = ni * 32 + (lane & 31);
    float us = mixer ? sRow[s] : 0.f;
#pragma unroll
    for (int reg = 0; reg < 16; ++reg) {
      int i = mi * 32 + (reg & 3) + 8 * (reg >> 2) + 4 * (lane >> 5);
      float wgt;
      if (mixer == 0) wgt = (s <= i) ? __expf(lg * (float)(i - s)) : 0.f;
      else wgt = (s <= i && i < L) ? __expf(us - sRow[64 + i]) : 0.f;
      sP[i * 72 + s] = f2bf(acc[reg] * wgt);
    }
  }
  __syncthreads();
#pragma unroll
  for (int i = 0; i < 4; ++i) {
    int id = tid + i * 256, e = id >> 3, sc = (id & 7) * 8;
    *(uint4*)(sKV + e * 72 + sc) = vpre[i];
  }
  __syncthreads();
  f32x16 acc1[2], acc2[2];
  const int mi = w & 1, nj = w >> 1;
#pragma unroll
  for (int t = 0; t < 2; ++t)
#pragma unroll
    for (int i = 0; i < 16; ++i) { acc1[t][i] = 0.f; acc2[t][i] = 0.f; }
#pragma unroll 2
  for (int ks = 0; ks < 4; ++ks) {
    bf16x8 af = *(const bf16x8*)(sP + (mi * 32 + (lane & 31)) * 72 + ks * 16 + (lane >> 5) * 8);
#pragma unroll
    for (int t = 0; t < 2; ++t) {
      bf16x8 bfr = *(const bf16x8*)(sKV + (nj * 64 + t * 32 + (lane & 31)) * 72 + ks * 16 + (lane >> 5) * 8);
      acc1[t] = __builtin_amdgcn_mfma_f32_32x32x16_bf16(af, bfr, acc1[t], 0, 0, 0);
    }
  }
#pragma unroll 2
  for (int ks = 0; ks < 8; ++ks) {
    bf16x8 af = *(const bf16x8*)(sQ + (mi * 32 + (lane & 31)) * 136 + ks * 16 + (lane >> 5) * 8);
#pragma unroll
    for (int t = 0; t < 2; ++t) {
      bf16x8 bfr = *(const bf16x8*)(sS + (nj * 64 + t * 32 + (lane & 31)) * 136 + ks * 16 + (lane >> 5) * 8);
      acc2[t] = __builtin_amdgcn_mfma_f32_32x32x16_bf16(af, bfr, acc2[t], 0, 0, 0);
    }
  }
  if (mixer == 1) {
    int i = tid >> 2, part = tid & 3;
    const float* nprev = (const float*)(P.ws + O_DN) + (size_t)idx * 128;
    float dl = 0.f, qn = 0.f;
#pragma unroll 4
    for (int s = part * 16; s < part * 16 + 16; ++s) dl += bf2f(sP[i * 72 + s]);
#pragma unroll 4
    for (int d = part * 32; d < part * 32 + 32; ++d) qn += bf2f(sQ[i * 136 + d]) * nprev[d];
    dl += __shfl_xor(dl, 1); dl += __shfl_xor(dl, 2);
    qn += __shfl_xor(qn, 1); qn += __shfl_xor(qn, 2);
    if (part == 0) {
      float den = dl + sRow[128 + i] * qn;
      sRow[192 + i] = 1.f / fmaxf(fabsf(den), sRow[256 + i]);
    }
  }
  __syncthreads();
#pragma unroll
  for (int t = 0; t < 2; ++t) {
    int e = nj * 64 + t * 32 + (lane & 31);
#pragma unroll
    for (int reg = 0; reg < 16; ++reg) {
      int i = mi * 32 + (reg & 3) + 8 * (reg >> 2) + 4 * (lane >> 5);
      float o = acc1[t][reg] + sRow[128 + i] * acc2[t][reg];
      if (mixer == 1) o *= sRow[192 + i];
      sO[i * 132 + e] = o;
    }
  }
  __syncthreads();
  {
    int i = tid >> 2, part = tid & 3;
    float ss = 0.f;
#pragma unroll 4
    for (int e = part * 32; e < part * 32 + 32; ++e) { float v = sO[i * 132 + e]; ss += v * v; }
    ss += __shfl_xor(ss, 1); ss += __shfl_xor(ss, 2);
    float rstd = rsqrtf(ss * (1.f / 128.f) + EPS);
    if (i < L) {
      size_t ro = (size_t)(it.row0 + i) * 512 + h * 128 + part * 32;
      const float* so = sO + i * 132 + part * 32;
      if (mixer == 0) {
        bfu* y = (bfu*)(P.ws + SLOT(5)) + ro;
        const float* g = P.g_ret_gn + h * 128 + part * 32;
        uint4 gv[4];
#pragma unroll
        for (int k = 0; k < 4; ++k) gv[k] = *(const uint4*)(y + k * 8);
#pragma unroll
        for (int k = 0; k < 4; ++k) {
          float gt[8], o[8];
          unpack8(gv[k], gt);
#pragma unroll
          for (int j = 0; j < 8; ++j) o[j] = gt[j] * sigmoidf_(gt[j]) * so[k * 8 + j] * rstd * g[k * 8 + j];
          *(uint4*)(y + k * 8) = pack8(o);
        }
      } else {
        bfu* y = (bfu*)(P.ws + SLOT(8)) + ro;
        const bfu* cc = (const bfu*)(P.ws + SLOT(0)) + ro;
        const float* g = P.g_ml_gn + h * 128 + part * 32;
        const float* ws = P.w_skip + h * 128 + part * 32;
        uint4 gv[4], cv[4];
#pragma unroll
        for (int k = 0; k < 4; ++k) { gv[k] = *(const uint4*)(y + k * 8); cv[k] = *(const uint4*)(cc + k * 8); }
#pragma unroll
        for (int k = 0; k < 4; ++k) {
          float gt[8], c8[8], o[8];
          unpack8(gv[k], gt); unpack8(cv[k], c8);
#pragma unroll
          for (int j = 0; j < 8; ++j) o[j] = sigmoidf_(gt[j]) * (so[k * 8 + j] * rstd * g[k * 8 + j] + ws[k * 8 + j] * c8[j]);
          *(uint4*)(y + k * 8) = pack8(o);
        }
      }
    }
  }
  __syncthreads();
}

__device__ void phase_merge(const Params& P, char* smem) {
  bfu* sA = (bfu*)smem; bfu* sB = sA + 128 * 72;
  const bfu* yr = (const bfu*)(P.ws + SLOT(5)); const bfu* ym = (const bfu*)(P.ws + SLOT(8));
  const bfu* gr = (const bfu*)(P.ws + SLOT(9)); const bfu* gm = (const bfu*)(P.ws + SLOT(11));
  bfu* mg = (bfu*)(P.ws + SLOT(6));
  for (int t = blockIdx.x; t < 260 * 8; t += gridDim.x) {
    int mt, nt; tile_map(t, 260, 8, mt, nt);
    f32x16 acc[2][2]; zero_acc(acc);
    bfu* sT = (bfu*)smem;
    const size_t tbase = (size_t)mt * 128 * 1024 + nt * 128;
    uint4 t1[8];
    gemm_acc(acc, yr + (size_t)mt * 128 * 512, 512, (const bfu*)(P.ws + O_WT_UPR) + (size_t)nt * 128 * 512, 512, 512, sA, sB);
    __syncthreads();
    stage_rm(sT, acc, 1.f);
    __syncthreads();
#pragma unroll
    for (int i = 0; i < 8; ++i) {
      int id = threadIdx.x + i * 256, row = id >> 4, c8 = (id & 15) * 8;
      float a[8], g[8];
      unpack8(*(const uint4*)(sT + row * ST_LD + c8), a);
      unpack8(*(const uint4*)(gr + tbase + (size_t)row * 1024 + c8), g);
#pragma unroll
      for (int j = 0; j < 8; ++j) a[j] *= sigmoidf_(g[j]);
      t1[i] = pack8(a);
    }
    zero_acc(acc);
    gemm_acc(acc, ym + (size_t)mt * 128 * 512, 512, (const bfu*)(P.ws + O_WT_UPM) + (size_t)nt * 128 * 512, 512, 512, sA, sB);
    __syncthreads();
    stage_rm(sT, acc, 1.f);
    __syncthreads();
#pragma unroll
    for (int i = 0; i < 8; ++i) {
      int id = threadIdx.x + i * 256, row = id >> 4, c8 = (id & 15) * 8;
      float a[8], g[8], t[8];
      unpack8(*(const uint4*)(sT + row * ST_LD + c8), a);
      unpack8(*(const uint4*)(gm + tbase + (size_t)row * 1024 + c8), g);
      unpack8(t1[i], t);
#pragma unroll
      for (int j = 0; j < 8; ++j) a[j] = t[j] + a[j] * sigmoidf_(g[j]);
      *(uint4*)(mg + tbase + (size_t)row * 1024 + c8) = pack8(a);
    }
  }
}

__device__ void phase_outproj(const Params& P, char* smem) {
  bfu* sA = (bfu*)smem; bfu* sB = sA + 128 * 72;
  const bfu* mg = (const bfu*)(P.ws + SLOT(6));
  for (int t = blockIdx.x; t < 260 * 8; t += gridDim.x) {
    int mt, nt; tile_map(t, 260, 8, mt, nt);
    f32x16 acc[2][2]; zero_acc(acc);
    gemm_acc(acc, mg + (size_t)mt * 128 * 1024, 1024, (const bfu*)(P.ws + O_WT_OUT) + (size_t)nt * 128 * 1024, 1024, 1024, sA, sB);
    float* sT32 = (float*)smem;
    __syncthreads();
    {
      EPI_BEGIN
#pragma unroll
        for (int j = 0; j < 4; ++j) {
          sT32[(r0 + j) * ST32_LD + cl] = acc[mi][0][q * 4 + j];
          sT32[(r0 + j) * ST32_LD + cl + 64] = acc[mi][1][q * 4 + j];
        }
      EPI_END
    }
    __syncthreads();
#pragma unroll
    for (int i = 0; i < 16; ++i) {
      int id = threadIdx.x + i * 256, row = id >> 5, c4 = (id & 31) * 4;
      int r = mt * 128 + row;
      float4 a = *(const float4*)(sT32 + row * ST32_LD + c4);
      float4 x = *(const float4*)(xrow(P, r) + nt * 128 + c4);
      *(float4*)(P.out + (size_t)r * 1024 + nt * 128 + c4) = make_float4(x.x + a.x, x.y + a.y, x.z + a.z, x.w + a.w);
    }
  }
}

__device__ void phase_norm_rows(const Params& P, const float* g, bfu* dst) {
  const int lane = threadIdx.x & 63, w = threadIdx.x >> 6;
  for (int r = blockIdx.x * 4 + w; r < MT; r += gridDim.x * 4) {
    const float* xr = P.out + (size_t)r * 1024;
    float4 v[4]; float ss = 0.f;
#pragma unroll
    for (int i = 0; i < 4; ++i) {
      v[i] = *(const float4*)(xr + i * 256 + lane * 4);
      ss += v[i].x * v[i].x + v[i].y * v[i].y + v[i].z * v[i].z + v[i].w * v[i].w;
    }
    ss = wave_sum(ss);
    float rstd = rsqrtf(ss * (1.f / 1024.f) + EPS);
#pragma unroll
    for (int i = 0; i < 4; ++i) {
      float4 gg = *(const float4*)(g + i * 256 + lane * 4);
      uint2 o; o.x = pack2(v[i].x * rstd * gg.x, v[i].y * rstd * gg.y); o.y = pack2(v[i].z * rstd * gg.z, v[i].w * rstd * gg.w);
      *(uint2*)(dst + (size_t)r * 1024 + i * 256 + lane * 4) = o;
    }
  }
}

__device__ void phase_pq(const Params& P, char* smem) {
  bfu* sA = (bfu*)smem; bfu* sB = sA + 128 * 72;
  const bfu* hq = (const bfu*)(P.ws + SLOT(0));
  bfu* qb = (bfu*)(P.ws + SLOT(9));
  for (int t = blockIdx.x; t < 260 * 16; t += gridDim.x) {
    int mt, nt; tile_map(t, 260, 16, mt, nt);
    f32x16 acc[2][2]; zero_acc(acc);
    gemm_acc(acc, hq + (size_t)mt * 128 * 1024, 1024, (const bfu*)(P.ws + O_WT_PQ) + (size_t)nt * 128 * 1024, 1024, 1024, sA, sB);
    bfu* sT = (bfu*)smem;
    __syncthreads();
    stage_rm(sT, acc, 1.f);
    __syncthreads();
    copyout_bf16(sT, qb + (size_t)mt * 128 * 2048 + nt * 128, 2048);
  }
}


template <bool DESC> __device__ __forceinline__ void cex(float& a, float& b) {
  float mx = fmaxf(a, b), mn = fminf(a, b);
  a = DESC ? mx : mn; b = DESC ? mn : mx;
}
template <int B, bool DESC> __device__ __forceinline__ void bmerge16(float (&v)[64]) {
#pragma unroll
  for (int j = 8; j > 0; j >>= 1)
#pragma unroll
    for (int i = 0; i < 16; ++i) { int l = i ^ j; if (l > i) cex<DESC>(v[B + i], v[B + l]); }
}
template <int B, bool DESC> __device__ __forceinline__ void bsort16(float (&v)[64]) {
#pragma unroll
  for (int k = 2; k <= 16; k <<= 1)
#pragma unroll
    for (int j = k >> 1; j > 0; j >>= 1)
#pragma unroll
      for (int i = 0; i < 16; ++i) {
        int l = i ^ j;
        if (l > i) {
          bool up = ((i & k) == 0) || (k == 16);
          if (up == true) { if (DESC) cex<true>(v[B + i], v[B + l]); else cex<false>(v[B + i], v[B + l]); }
          else { if (DESC) cex<false>(v[B + i], v[B + l]); else cex<true>(v[B + i], v[B + l]); }
        }
      }
}
__device__ __forceinline__ float pair_max(float v) {
  auto r = __builtin_amdgcn_permlane32_swap(__float_as_int(v), __float_as_int(v), false, false);
  return fmaxf(__int_as_float(r[0]), __int_as_float(r[1]));
}
__device__ void phase_topk(const Params& P, char* smem) {
  const int tid = threadIdx.x, lane = tid & 63, w = tid >> 6, r32 = lane & 31, hh = lane >> 5;
  unsigned* sL = (unsigned*)smem + w * 1664;
  unsigned* sW = sL + 32 * 33;
  const bfu* qb = (const bfu*)(P.ws + SLOT(9));
  const bfu* keys = (const bfu*)(P.ws + O_KEYS);
  int* ids = (int*)(P.ws + SLOT(4));
  float* gw = (float*)(P.ws + SLOT(13));
  for (int item = blockIdx.x * 4 + w; item < 1040 * 8; item += gridDim.x * 4) {
    const int tg = item >> 3, n = item & 7, rowb = tg * 32;
#pragma unroll 1
    for (int half = 0; half < 2; ++half) {
      f32x16 acc[4];
#pragma unroll
      for (int c = 0; c < 4; ++c)
#pragma unroll
        for (int i = 0; i < 16; ++i) acc[c][i] = 0.f;
      const bfu* kp = keys + (size_t)((n * 2 + half) * 128 + r32) * 128 + hh * 8;
      const bfu* qp = qb + (size_t)(rowb + r32) * 2048 + n * 256 + half * 128 + hh * 8;
#pragma unroll
      for (int ks = 0; ks < 8; ++ks) {
        bf16x8 bfr = *(const bf16x8*)(qp + ks * 16);
#pragma unroll
        for (int c = 0; c < 4; ++c) {
          bf16x8 af = *(const bf16x8*)(kp + (size_t)c * 32 * 128 + ks * 16);
          acc[c] = __builtin_amdgcn_mfma_f32_32x32x16_bf16(af, bfr, acc[c], 0, 0, 0);
        }
      }
      float kk[64];
#pragma unroll
      for (int c = 0; c < 4; ++c)
#pragma unroll
        for (int reg = 0; reg < 16; ++reg) {
          unsigned kidx = c * 32 + (reg & 3) + 8 * (reg >> 2) + 4 * hh;
          kk[c * 16 + reg] = __uint_as_float((__float_as_uint(acc[c][reg]) & ~127u) | kidx);
        }
      bsort16<0, true>(kk); bsort16<16, false>(kk); bsort16<32, false>(kk); bsort16<48, true>(kk);
#pragma unroll
      for (int i = 0; i < 16; ++i) { kk[i] = fmaxf(kk[i], kk[16 + i]); kk[32 + i] = fmaxf(kk[32 + i], kk[48 + i]); }
      bmerge16<0, true>(kk); bmerge16<32, false>(kk);
#pragma unroll
      for (int i = 0; i < 16; ++i) kk[i] = fmaxf(kk[i], kk[32 + i]);
      bmerge16<0, true>(kk);
      {
        float lo[16], hi[16];
#pragma unroll
        for (int i = 0; i < 16; ++i) {
          auto r = __builtin_amdgcn_permlane32_swap(__float_as_int(kk[i]), __float_as_int(kk[i]), false, false);
          lo[i] = __int_as_float(r[0]); hi[i] = __int_as_float(r[1]);
        }
#pragma unroll
        for (int i = 0; i < 16; ++i) kk[i] = fmaxf(lo[i], hi[15 - i]);
      }
      bmerge16<0, true>(kk);
      if (hh == 0) {
#pragma unroll
        for (int p = 0; p < 16; ++p) sL[r32 * 33 + half * 16 + p] = __float_as_uint(kk[p]);
      }
    }
    __builtin_amdgcn_fence(__ATOMIC_RELEASE, "workgroup");
    __builtin_amdgcn_wave_barrier();
    __builtin_amdgcn_fence(__ATOMIC_ACQUIRE, "workgroup");
    float x[4], y[16];
    {
      const unsigned* lx = sL + r32 * 33 + (hh ? 16 : 0);
      const unsigned* ly = sL + r32 * 33 + (hh ? 0 : 16);
#pragma unroll
      for (int i = 0; i < 4; ++i) x[i] = __uint_as_float(lx[i] & ~127u);
#pragma unroll
      for (int j = 0; j < 16; ++j) y[j] = __uint_as_float(ly[j] & ~127u);
    }
    float cd[25];
#define CAND(t, i, j) { float sv = x[i] + y[j]; unsigned code = hh ? ((j) << 4 | (i)) : ((i) << 4 | (j)); \
      cd[t] = __uint_as_float((__float_as_uint(sv) & ~255u) | code); }
    CAND(0, 0, 1) CAND(1, 0, 2) CAND(2, 0, 3) CAND(3, 0, 4) CAND(4, 0, 5) CAND(5, 0, 6) CAND(6, 0, 7) CAND(7, 0, 8)
    CAND(8, 0, 9) CAND(9, 0, 10) CAND(10, 0, 11) CAND(11, 0, 12) CAND(12, 0, 13) CAND(13, 0, 14) CAND(14, 0, 15)
    CAND(15, 1, 2) CAND(16, 1, 3) CAND(17, 1, 4) CAND(18, 1, 5) CAND(19, 1, 6) CAND(20, 1, 7) CAND(21, 2, 3) CAND(22, 2, 4)
    {
      float d0 = hh ? x[2] + y[2] : x[0] + y[0];
      float d1 = hh ? x[3] + y[3] : x[1] + y[1];
      unsigned c0 = hh ? 0x22u : 0x00u, c1 = hh ? 0x33u : 0x11u;
      cd[23] = __uint_as_float((__float_as_uint(d0) & ~255u) | c0);
      cd[24] = __uint_as_float((__float_as_uint(d1) & ~255u) | c1);
    }
    {
      float cv[64];
#pragma unroll
      for (int t = 0; t < 25; ++t) cv[t] = cd[t];
#pragma unroll
      for (int t = 25; t < 32; ++t) cv[t] = -INFINITY;
      bsort16<0, true>(cv); bsort16<16, false>(cv);
#pragma unroll
      for (int i = 0; i < 16; ++i) cv[i] = fmaxf(cv[i], cv[16 + i]);
      bmerge16<0, true>(cv);
      {
        float lo[16], hi[16];
#pragma unroll
        for (int i = 0; i < 16; ++i) {
          auto r = __builtin_amdgcn_permlane32_swap(__float_as_int(cv[i]), __float_as_int(cv[i]), false, false);
          lo[i] = __int_as_float(r[0]); hi[i] = __int_as_float(r[1]);
        }
#pragma unroll
        for (int i = 0; i < 16; ++i) cv[i] = fmaxf(lo[i], hi[15 - i]);
      }
      bmerge16<0, true>(cv);
      if (hh == 0) {
#pragma unroll
        for (int p = 0; p < 16; ++p) sW[r32 * 17 + p] = __float_as_uint(cv[p]);
      }
    }
    __builtin_amdgcn_fence(__ATOMIC_RELEASE, "workgroup");
    __builtin_amdgcn_wave_barrier();
    __builtin_amdgcn_fence(__ATOMIC_ACQUIRE, "workgroup");
    {
      const unsigned* la = sL + r32 * 33;
      unsigned c0 = sW[r32 * 17] & 255u;
      float scmax = __uint_as_float(la[c0 >> 4] & ~127u) + __uint_as_float(la[16 + (c0 & 15)] & ~127u);
      float ex[8]; int ee[8]; float sum = 0.f;
#pragma unroll
      for (int k = 0; k < 8; ++k) {
        unsigned code = sW[r32 * 17 + hh * 8 + k] & 255u;
        unsigned ka = la[code >> 4], kb = la[16 + (code & 15)];
        float sc = __uint_as_float(ka & ~127u) + __uint_as_float(kb & ~127u);
        ex[k] = __expf(sc - scmax);
        ee[k] = (int)((ka & 127u) * 128u + (kb & 127u));
        sum += ex[k];
      }
      sum += __shfl_xor(sum, 32);
      float inv = 1.f / sum;
      size_t o = (size_t)(rowb + r32) * 128 + n * 16 + hh * 8;
      *(int4*)(ids + o) = make_int4(ee[0], ee[1], ee[2], ee[3]);
      *(int4*)(ids + o + 4) = make_int4(ee[4], ee[5], ee[6], ee[7]);
      *(float4*)(gw + o) = make_float4(ex[0] * inv, ex[1] * inv, ex[2] * inv, ex[3] * inv);
      *(float4*)(gw + o + 4) = make_float4(ex[4] * inv, ex[5] * inv, ex[6] * inv, ex[7] * inv);
    }
    __builtin_amdgcn_wave_barrier();
  }
}

typedef float f2v __attribute__((ext_vector_type(2)));
#define U8_SCALE 512.f
#define V8_SCALE 128.f
__device__ void convert_fp8(const float* __restrict__ src, unsigned char* __restrict__ dst, size_t n16, float scale,
                            int gtid, int gstride) {
  for (size_t i = gtid; i < n16; i += gstride) {
    unsigned w[4];
#pragma unroll
    for (int k = 0; k < 4; ++k) {
      float4 a = *(const float4*)(src + i * 16 + k * 4);
      float v0 = fminf(fmaxf(a.x * scale, -448.f), 448.f), v1 = fminf(fmaxf(a.y * scale, -448.f), 448.f);
      float v2 = fminf(fmaxf(a.z * scale, -448.f), 448.f), v3 = fminf(fmaxf(a.w * scale, -448.f), 448.f);
      int t = 0;
      t = __builtin_amdgcn_cvt_pk_fp8_f32(v0, v1, t, false);
      t = __builtin_amdgcn_cvt_pk_fp8_f32(v2, v3, t, true);
      w[k] = (unsigned)t;
    }
    *(uint4*)(dst + i * 16) = make_uint4(w[0], w[1], w[2], w[3]);
  }
}
__device__ __forceinline__ float dot16_fp8(uint4 u, const f2v* x2) {
  f2v acc = __builtin_amdgcn_cvt_pk_f32_fp8((int)u.x, false) * x2[0];
  acc += __builtin_amdgcn_cvt_pk_f32_fp8((int)u.x, true) * x2[1];
  acc += __builtin_amdgcn_cvt_pk_f32_fp8((int)u.y, false) * x2[2];
  acc += __builtin_amdgcn_cvt_pk_f32_fp8((int)u.y, true) * x2[3];
  acc += __builtin_amdgcn_cvt_pk_f32_fp8((int)u.z, false) * x2[4];
  acc += __builtin_amdgcn_cvt_pk_f32_fp8((int)u.z, true) * x2[5];
  acc += __builtin_amdgcn_cvt_pk_f32_fp8((int)u.w, false) * x2[6];
  acc += __builtin_amdgcn_cvt_pk_f32_fp8((int)u.w, true) * x2[7];
  return acc.x + acc.y;
}
__device__ __forceinline__ void axpy16_fp8(f2v* o2, float cf, uint4 v) {
  f2v c = {cf, cf};
  o2[0] += c * __builtin_amdgcn_cvt_pk_f32_fp8((int)v.x, false);
  o2[1] += c * __builtin_amdgcn_cvt_pk_f32_fp8((int)v.x, true);
  o2[2] += c * __builtin_amdgcn_cvt_pk_f32_fp8((int)v.y, false);
  o2[3] += c * __builtin_amdgcn_cvt_pk_f32_fp8((int)v.y, true);
  o2[4] += c * __builtin_amdgcn_cvt_pk_f32_fp8((int)v.z, false);
  o2[5] += c * __builtin_amdgcn_cvt_pk_f32_fp8((int)v.z, true);
  o2[6] += c * __builtin_amdgcn_cvt_pk_f32_fp8((int)v.w, false);
  o2[7] += c * __builtin_amdgcn_cvt_pk_f32_fp8((int)v.w, true);
}
#define PEER_LOAD(u, v, b)                                                                   \
  _Pragma("unroll") for (int k = 0; k < 8; ++k) {                                            \
    int j = (b) * 8 + k;                                                                     \
    int e = __builtin_amdgcn_readlane((b) < 8 ? id0 : id1, j & 63);                          \
    u[k] = *(const uint4*)(U8 + (size_t)e * 1024 + lane * 16);                               \
    v[k] = *(const uint4*)(V8 + (size_t)e * 1024 + lane * 16);                               \
  }
#define PEER_COMP(u, v, b)                                                                   \
  _Pragma("unroll") for (int hf = 0; hf < 2; ++hf) {                                         \
    float s = reduce4(dot16_fp8(u[hf * 4 + 0], x2), dot16_fp8(u[hf * 4 + 1], x2),           \
                      dot16_fp8(u[hf * 4 + 2], x2), dot16_fp8(u[hf * 4 + 3], x2)) * (1.f / U8_SCALE); \
    float act = 0.5f * s * (1.f + erff(s * 0.7071067811865475f));                            \
    float gsel = __shfl((b) < 8 ? g0 : g1, ((b) * 8 + hf * 4 + (lane >> 4)) & 63);           \
    float cfv = act * gsel * (1.f / V8_SCALE);                                               \
    axpy16_fp8(o2, __int_as_float(__builtin_amdgcn_readlane(__float_as_int(cfv), 0)), v[hf * 4 + 0]);  \
    axpy16_fp8(o2, __int_as_float(__builtin_amdgcn_readlane(__float_as_int(cfv), 16)), v[hf * 4 + 1]); \
    axpy16_fp8(o2, __int_as_float(__builtin_amdgcn_readlane(__float_as_int(cfv), 32)), v[hf * 4 + 2]); \
    axpy16_fp8(o2, __int_as_float(__builtin_amdgcn_readlane(__float_as_int(cfv), 48)), v[hf * 4 + 3]); \
  }
__device__ void phase_peer(const Params& P) {
  const int lane = threadIdx.x & 63, w = threadIdx.x >> 6;
  bfu* hq = (bfu*)(P.ws + SLOT(0));
  const unsigned char* U8 = (const unsigned char*)(P.ws + SLOT(2));
  const unsigned char* V8 = (const unsigned char*)(P.ws + SLOT(3));
  const int* ids = (const int*)(P.ws + SLOT(4));
  const float* gw = (const float*)(P.ws + SLOT(13));
  bfu* pbf = (bfu*)(P.ws + SLOT(6));
  for (int r = blockIdx.x * 4 + w; r < MT; r += gridDim.x * 4) {
    f2v x2[8], o2[8];
    {
      uint4 v0 = *(const uint4*)(hq + (size_t)r * 1024 + lane * 16);
      uint4 v1 = *(const uint4*)(hq + (size_t)r * 1024 + lane * 16 + 8);
      float xf[16];
      unpack8(v0, xf); unpack8(v1, xf + 8);
#pragma unroll
      for (int j = 0; j < 8; ++j) { x2[j].x = xf[2 * j]; x2[j].y = xf[2 * j + 1]; o2[j].x = 0.f; o2[j].y = 0.f; }
    }
    int id0 = ids[(size_t)r * 128 + lane], id1 = ids[(size_t)r * 128 + 64 + lane];
    float g0 = gw[(size_t)r * 128 + lane], g1 = gw[(size_t)r * 128 + 64 + lane];
    uint4 uA[8], vA[8], uB[8], vB[8];
    PEER_LOAD(uA, vA, 0)
    for (int b = 0; b < 16; b += 2) {
      PEER_LOAD(uB, vB, b + 1)
      PEER_COMP(uA, vA, b)
      if (b + 2 < 16) { PEER_LOAD(uA, vA, b + 2) }
      PEER_COMP(uB, vB, b + 1)
    }
    float* xr = P.out + (size_t)r * 1024 + lane * 16;
    float x3[16];
    float ss = 0.f;
#pragma unroll
    for (int k = 0; k < 4; ++k) {
      float4 a = *(const float4*)(xr + k * 4);
      x3[k * 4 + 0] = a.x + o2[k * 2].x; x3[k * 4 + 1] = a.y + o2[k * 2].y;
      x3[k * 4 + 2] = a.z + o2[k * 2 + 1].x; x3[k * 4 + 3] = a.w + o2[k * 2 + 1].y;
      *(float4*)(xr + k * 4) = make_float4(x3[k * 4], x3[k * 4 + 1], x3[k * 4 + 2], x3[k * 4 + 3]);
    }
#pragma unroll
    for (int j = 0; j < 16; ++j) ss += x3[j] * x3[j];
    ss = wave_sum(ss);
    float rstd = rsqrtf(ss * (1.f / 1024.f) + EPS);
    float hv[16];
#pragma unroll
    for (int k = 0; k < 4; ++k) {
      float4 ga = *(const float4*)(P.g_ple + lane * 16 + k * 4);
      hv[k * 4] = x3[k * 4] * rstd * ga.x; hv[k * 4 + 1] = x3[k * 4 + 1] * rstd * ga.y;
      hv[k * 4 + 2] = x3[k * 4 + 2] * rstd * ga.z; hv[k * 4 + 3] = x3[k * 4 + 3] * rstd * ga.w;
    }
    *(uint4*)(hq + (size_t)r * 1024 + lane * 16) = pack8(hv);
    *(uint4*)(hq + (size_t)r * 1024 + lane * 16 + 8) = pack8(hv + 8);
    {
      const float* pr = r < MP ? P.pp + (size_t)r * 256 : P.ps + (size_t)(r - MP) * 256;
      float4 a = *(const float4*)(pr + lane * 4);
      uint2 ov; ov.x = pack2(a.x, a.y); ov.y = pack2(a.z, a.w);
      *(uint2*)(pbf + (size_t)r * 256 + lane * 4) = ov;
    }
  }
}

__device__ void phase_ple(const Params& P, char* smem) {
  bfu* sA = (bfu*)smem; bfu* sB = sA + 128 * 72;
  const bfu* hg = (const bfu*)(P.ws + SLOT(0));
  const bfu* pbf = (const bfu*)(P.ws + SLOT(6));
  for (int t = blockIdx.x; t < 260 * 8; t += gridDim.x) {
    int mt, nt; tile_map(t, 260, 8, mt, nt);
    f32x16 acc[2][2]; zero_acc(acc);
    bfu* sT = (bfu*)smem; float* sT32 = (float*)smem;
    uint2 pg[16];
    gemm_acc(acc, hg + (size_t)mt * 128 * 1024, 1024, (const bfu*)(P.ws + O_WT_PG) + (size_t)nt * 128 * 1024, 1024, 1024, sA, sB);
    __syncthreads();
    {
      EPI_BEGIN
#pragma unroll
        for (int j = 0; j < 4; ++j) {
          sT[(r0 + j) * ST_LD + cl] = f2bf(sigmoidf_(acc[mi][0][q * 4 + j]));
          sT[(r0 + j) * ST_LD + cl + 64] = f2bf(sigmoidf_(acc[mi][1][q * 4 + j]));
        }
      EPI_END
    }
    __syncthreads();
#pragma unroll
    for (int i = 0; i < 16; ++i) {
      int id = threadIdx.x + i * 256, row = id >> 5, c4 = (id & 31) * 4;
      pg[i] = *(const uint2*)(sT + row * ST_LD + c4);
    }
    zero_acc(acc);
    gemm_acc(acc, pbf + (size_t)mt * 128 * 256, 256, (const bfu*)(P.ws + O_WT_PLE) + (size_t)nt * 128 * 256, 256, 256, sA, sB);
    __syncthreads();
    {
      EPI_BEGIN
#pragma unroll
        for (int j = 0; j < 4; ++j) {
          sT32[(r0 + j) * ST32_LD + cl] = acc[mi][0][q * 4 + j];
          sT32[(r0 + j) * ST32_LD + cl + 64] = acc[mi][1][q * 4 + j];
        }
      EPI_END
    }
    __syncthreads();
#pragma unroll
    for (int i = 0; i < 16; ++i) {
      int id = threadIdx.x + i * 256, row = id >> 5, c4 = (id & 31) * 4;
      float4 a = *(const float4*)(sT32 + row * ST32_LD + c4);
      float* op = P.out + (size_t)(mt * 128 + row) * 1024 + nt * 128 + c4;
      float4 x = *(const float4*)op;
      float g0 = bf2f(pg[i].x & 0xffff), g1 = bf2f(pg[i].x >> 16), g2 = bf2f(pg[i].y & 0xffff), g3 = bf2f(pg[i].y >> 16);
      *(float4*)op = make_float4(x.x + a.x * g0, x.y + a.y * g1, x.z + a.z * g2, x.w + a.w * g3);
    }
  }
}

__device__ void phase_final(const Params& P) {
  const int lane = threadIdx.x & 63, w = threadIdx.x >> 6;
  for (int r = blockIdx.x * 4 + w; r < MT; r += gridDim.x * 4) {
    float* xr = P.out + (size_t)r * 1024;
    float4 v[4]; float ss = 0.f;
#pragma unroll
    for (int i = 0; i < 4; ++i) {
      v[i] = *(const float4*)(xr + i * 256 + lane * 4);
      ss += v[i].x * v[i].x + v[i].y * v[i].y + v[i].z * v[i].z + v[i].w * v[i].w;
    }
    ss = wave_sum(ss);
    float rstd = rsqrtf(ss * (1.f / 1024.f) + EPS);
#pragma unroll
    for (int i = 0; i < 4; ++i) {
      float4 gg = *(const float4*)(P.g_final + i * 256 + lane * 4);
      *(float4*)(xr + i * 256 + lane * 4) = make_float4(v[i].x * rstd * gg.x, v[i].y * rstd * gg.y, v[i].z * rstd * gg.z, v[i].w * rstd * gg.w);
    }
  }
}

__global__ void __launch_bounds__(NTHREADS, 2) fwd_megakernel(Params P) {
  extern __shared__ __attribute__((aligned(16))) char smem[];
  cg::grid_group grid = cg::this_grid();
  __shared__ uint4 xb_words;
  if (threadIdx.x == 0) xb_words = make_uint4(0u, 0u, 0u, 0u);
  __syncthreads();
  XcdBarrier xb = xcd_barrier_post((unsigned*)(P.ws + O_BAR), (volatile LAS unsigned*)&xb_words);
  if (P.out == nullptr) grid.sync();
  const int gtid = blockIdx.x * NTHREADS + threadIdx.x, gstride = gridDim.x * NTHREADS;
  phase_prep(P, smem);
  xcd_barrier(xb);
  phase_gemm1(P, smem);
  xcd_barrier(xb);
  phase_conv(P);
  gate_scan(P);
  xcd_barrier(xb);
  m_fold(P);
  phase_mqk(P, smem);
  xcd_barrier(xb);
  for (int t = blockIdx.x; t < 4224; t += gridDim.x) phaseA_item(P, t / 2112, t % 2112, smem);
  xcd_barrier(xb);
  phase_scan(P);
  xcd_barrier(xb);
  for (int t = blockIdx.x; t < 4224; t += gridDim.x) phaseC_item(P, t / 2112, t % 2112, smem);
  xcd_barrier(xb);
  phase_merge(P, smem);
  xcd_barrier(xb);
  phase_outproj(P, smem);
  xcd_barrier(xb);
  phase_norm_rows(P, P.g_ffn, (bfu*)(P.ws + SLOT(0)));
  convert_fp8(P.peer_u, (unsigned char*)(P.ws + SLOT(2)), 16384ull * 1024 / 16, U8_SCALE, gtid, gstride);
  convert_fp8(P.peer_v, (unsigned char*)(P.ws + SLOT(3)), 16384ull * 1024 / 16, V8_SCALE, gtid, gstride);
  xcd_barrier(xb);
  phase_pq(P, smem);
  xcd_barrier(xb);
  phase_topk(P, smem);
  xcd_barrier(xb);
  phase_peer(P);
  xcd_barrier(xb);
  phase_ple(P, smem);
  xcd_barrier(xb);
  phase_final(P);
}

extern "C" void kernel_launch(void* const* d_in, const int* in_sizes, int n_in, void* d_out, int out_size,
                              void* d_ws, size_t ws_size, hipStream_t stream) {
  static int grid_blocks = 0;
  if (!grid_blocks) {
    hipFuncSetAttribute((const void*)fwd_megakernel, hipFuncAttributeMaxDynamicSharedMemorySize, SMEM_BYTES);
    int dev = 0, cus = 0, per_cu = 0;
    hipGetDevice(&dev);
    hipDeviceGetAttribute(&cus, hipDeviceAttributeMultiprocessorCount, dev);
    hipOccupancyMaxActiveBlocksPerMultiprocessor(&per_cu, fwd_megakernel, NTHREADS, SMEM_BYTES);
    if (per_cu > 2) per_cu = 2;
    if (per_cu < 1) per_cu = 1;
    grid_blocks = cus * per_cu;
  }
  Params p{};
  const float** pf = (const float**)&p;
  for (int i = 0; i < 32; ++i) pf[i] = (const float*)d_in[i];
  p.out = (float*)d_out;
  p.ws = (char*)d_ws;
  hipMemsetAsync((char*)d_ws + O_BAR, 0, XCD_BAR_WORDS * 4, stream);
  void* args[] = {&p};
  hipError_t e = hipLaunchCooperativeKernel((void*)fwd_megakernel, dim3(grid_blocks), dim3(NTHREADS), args, SMEM_BYTES, stream);
  if (e != hipSuccess) fprintf(stderr, "cooperative launch failed: %s (grid %d)\n", hipGetErrorString(e), grid_blocks);
}
```

```cpp
#include <hip/hip_runtime.h>
#include <hip/hip_cooperative_groups.h>
#include <cstdio>
namespace cg = cooperative_groups;

typedef unsigned short bfu;
typedef __attribute__((ext_vector_type(8))) short bf16x8;
typedef __attribute__((ext_vector_type(16))) float f32x16;

#define MT 33280
#define MP 32768
#define NTHREADS 256
#define EPS 1e-6f

struct Params {
  const float *xp, *xs, *pp, *ps, *st_ret, *st_C, *st_n, *st_m, *st_conv, *g_mix, *w_in, *g_ret_gn, *w_mq,
      *w_mk, *conv_w, *conv_b, *b_i, *b_f, *g_ml_gn, *w_skip, *w_up_r, *w_up_m, *w_out, *g_ffn, *w_pq,
      *peer_keys, *peer_u, *peer_v, *g_ple, *w_pg, *w_ple, *g_final;
  float* out;
  char* ws;
};

constexpr size_t O_WT_IN = 0;
constexpr size_t O_WT_UPR = O_WT_IN + 5632ull * 1024 * 2;
constexpr size_t O_WT_UPM = O_WT_UPR + 1024ull * 512 * 2;
constexpr size_t O_WT_OUT = O_WT_UPM + 1024ull * 512 * 2;
constexpr size_t O_WT_PQ = O_WT_OUT + 1024ull * 1024 * 2;
constexpr size_t O_WT_PG = O_WT_PQ + 2048ull * 1024 * 2;
constexpr size_t O_WT_PLE = O_WT_PG + 1024ull * 1024 * 2;
constexpr size_t O_KEYS = O_WT_PLE + 1024ull * 256 * 2;
constexpr size_t O_WT_MQ = O_KEYS + 16ull * 128 * 128 * 2;
constexpr size_t O_WT_MK = O_WT_MQ + 4ull * 128 * 128 * 2;
constexpr size_t O_COS = O_WT_MK + 4ull * 128 * 128 * 2;
constexpr size_t O_SIN = O_COS + 8192ull * 64 * 4;
constexpr size_t O_FQ = O_SIN + 8192ull * 64 * 4;
constexpr size_t O_UQ = O_FQ + (size_t)MT * 16;
constexpr size_t O_CMQ = O_UQ + (size_t)MT * 16;
constexpr size_t O_FL = O_CMQ + (size_t)MT * 16;
constexpr size_t O_UC = O_FL + 16384;
constexpr size_t O_AEND = O_UC + 16384;
constexpr size_t O_MCS = O_AEND + 16384;
constexpr size_t O_DN = O_MCS + 16384;
constexpr size_t O_DSS = O_DN + 2112ull * 128 * 4;
constexpr size_t O_GPRE = O_DSS + 2ull * 64 * 16384 * 2;
constexpr size_t O_BAR = O_GPRE + (size_t)MT * 32;
constexpr size_t O_SMALL_END = O_BAR + 16384;
constexpr size_t SLOT0 = 40ull << 20;
constexpr size_t USZ = (size_t)MT * 512 * 2;
static_assert(O_SMALL_END <= SLOT0, "small region overflow");
#define SLOT(i) (SLOT0 + (size_t)(i) * USZ)
constexpr size_t SB_T = 16ull * 128 * 8192;

constexpr size_t OO_Y = 0;
constexpr size_t OO_RETP = (size_t)MT * 1024;
constexpr size_t OO_CP = OO_RETP + 262144;
constexpr size_t OO_NP = OO_CP + 262144;
constexpr size_t OO_MP = OO_NP + 2048;
constexpr size_t OO_CONVP = OO_MP + 16;
constexpr size_t OO_RETS = OO_CONVP + 6144;
constexpr size_t OO_CS = OO_RETS + 1048576;
constexpr size_t OO_NS = OO_CS + 1048576;
constexpr size_t OO_MS = OO_NS + 8192;
constexpr size_t OO_CONVS = OO_MS + 64;

constexpr int SMEM_BYTES = 81152;

__device__ __forceinline__ bfu f2bf(float f) {
  unsigned u = __float_as_uint(f);
  u += 0x7fffu + ((u >> 16) & 1u);
  return (bfu)(u >> 16);
}
__device__ __forceinline__ float bf2f(bfu b) { return __uint_as_float(((unsigned)b) << 16); }
__device__ __forceinline__ unsigned pack2(float a, float b) { return (unsigned)f2bf(a) | ((unsigned)f2bf(b) << 16); }
__device__ __forceinline__ void unpack8(uint4 v, float* f) {
  f[0] = bf2f(v.x & 0xffff); f[1] = bf2f(v.x >> 16); f[2] = bf2f(v.y & 0xffff); f[3] = bf2f(v.y >> 16);
  f[4] = bf2f(v.z & 0xffff); f[5] = bf2f(v.z >> 16); f[6] = bf2f(v.w & 0xffff); f[7] = bf2f(v.w >> 16);
}
__device__ __forceinline__ uint4 pack8(const float* f) {
  uint4 o; o.x = pack2(f[0], f[1]); o.y = pack2(f[2], f[3]); o.z = pack2(f[4], f[5]); o.w = pack2(f[6], f[7]);
  return o;
}
__device__ __forceinline__ float wave_sum(float v) {
#pragma unroll
  for (int o = 32; o > 0; o >>= 1) v += __shfl_xor(v, o);
  return v;
}
__device__ __forceinline__ float wave_max(float v) {
#pragma unroll
  for (int o = 32; o > 0; o >>= 1) v = fmaxf(v, __shfl_xor(v, o));
  return v;
}
__device__ __forceinline__ float dpp_ror_add(float s, const int ctrl_sel) {
  int v = __float_as_int(s);
  int t;
  if (ctrl_sel == 8) t = __builtin_amdgcn_update_dpp(0, v, 0x128, 0xf, 0xf, false);
  else if (ctrl_sel == 4) t = __builtin_amdgcn_update_dpp(0, v, 0x124, 0xf, 0xf, false);
  else if (ctrl_sel == 2) t = __builtin_amdgcn_update_dpp(0, v, 0x122, 0xf, 0xf, false);
  else t = __builtin_amdgcn_update_dpp(0, v, 0x121, 0xf, 0xf, false);
  return s + __int_as_float(t);
}
__device__ __forceinline__ float reduce4(float p0, float p1, float p2, float p3) {
  auto r = __builtin_amdgcn_permlane32_swap(__float_as_int(p0), __float_as_int(p2), false, false);
  float sA = __int_as_float(r[0]) + __int_as_float(r[1]);
  r = __builtin_amdgcn_permlane32_swap(__float_as_int(p1), __float_as_int(p3), false, false);
  float sB = __int_as_float(r[0]) + __int_as_float(r[1]);
  r = __builtin_amdgcn_permlane16_swap(__float_as_int(sA), __float_as_int(sB), false, false);
  float s = __int_as_float(r[0]) + __int_as_float(r[1]);
  s = dpp_ror_add(s, 8); s = dpp_ror_add(s, 4); s = dpp_ror_add(s, 2); s = dpp_ror_add(s, 1);
  return s;
}
__device__ __forceinline__ float sigmoidf_(float x) { return 1.f / (1.f + __expf(-x)); }
__device__ __forceinline__ const float* xrow(const Params& P, int r) {
  return r < MP ? P.xp + (size_t)r * 1024 : P.xs + (size_t)(r - MP) * 1024;
}


#define XB_TMO      128
#define XB_XCNT(j)  (256  + 64 * (j))
#define XB_XSUB(j)  (1280 + 64 * (j))
#define XB_XGEN(j)  (2304 + 64 * (j))
#define XB_TOP      3328
#define XB_TOPGEN   3392
#define XCD_BAR_WORDS 3456
#define XB_SPIN_CAP (1u << 22)
#define LAS __attribute__((address_space(3)))
__device__ __forceinline__ unsigned xb_ld(unsigned* p) { return __hip_atomic_load(p, __ATOMIC_RELAXED, __HIP_MEMORY_SCOPE_AGENT); }
__device__ __forceinline__ unsigned xb_add(unsigned* p, unsigned v) { return __hip_atomic_fetch_add(p, v, __ATOMIC_RELAXED, __HIP_MEMORY_SCOPE_AGENT); }
__device__ __forceinline__ unsigned xb_xcc_id() { return (unsigned)__builtin_amdgcn_s_getreg((3 << 11) | 20) & 0xFu; }
#define XB_SPIN(cond, bar) do { unsigned _sp = 0; while (cond) { __builtin_amdgcn_s_sleep(1); \
    if ((++_sp & 255u) == 0u) { if (xb_ld(&(bar)[XB_TMO])) break; if (_sp > XB_SPIN_CAP) { atomicAdd(&(bar)[XB_TMO], 1u); break; } } } } while (0)
struct XcdBarrier { unsigned* bar; unsigned x; volatile LAS unsigned* st; };
__device__ __forceinline__ XcdBarrier xcd_barrier_post(unsigned* bar, volatile LAS unsigned* st) {
  XcdBarrier b; b.bar = bar; b.x = xb_xcc_id(); b.st = st;
  if (threadIdx.x == 0) (void)xb_add(&bar[XB_XCNT(b.x)], 1u);
  return b;
}
__device__ __forceinline__ void xcd_barrier_complete(unsigned* bar, unsigned x, unsigned& nloc, unsigned& nx) {
  const unsigned G = gridDim.x * gridDim.y * gridDim.z;
  unsigned sum, cnt, mine, sp = 0u;
  for (;;) {
    sum = 0u; cnt = 0u; mine = 0u;
#pragma unroll
    for (unsigned j = 0; j < 16; ++j) { const unsigned c = xb_ld(&bar[XB_XCNT(j)]); sum += c; cnt += (c > 0u) ? 1u : 0u; mine = (j == x) ? c : mine; }
    if (sum == G) break;
    __builtin_amdgcn_s_sleep(1);
    if ((++sp & 255u) == 0u) { if (xb_ld(&bar[XB_TMO])) break; if (sp > XB_SPIN_CAP) { atomicAdd(&bar[XB_TMO], 1u); break; } }
  }
  nloc = mine > 0u ? mine : 1u; nx = cnt > 0u ? cnt : 1u;
}
__device__ __forceinline__ void xcd_barrier(const XcdBarrier& b) {
  asm volatile("s_waitcnt vmcnt(0)" ::: "memory");
  __syncthreads();
  if (threadIdx.x == 0) {
    unsigned* bar = b.bar;
    __builtin_amdgcn_s_waitcnt(0);
    unsigned nloc = b.st[0], nx = b.st[1];
    if (nloc == 0u) { xcd_barrier_complete(bar, b.x, nloc, nx); b.st[0] = nloc; b.st[1] = nx; }
    const unsigned old = xb_add(&bar[XB_XSUB(b.x)], 1u);
    const unsigned gen = old / nloc;
    if (old + 1u == (gen + 1u) * nloc) {
      __builtin_amdgcn_fence(__ATOMIC_RELEASE, "agent");
      asm volatile("s_waitcnt vmcnt(0)" ::: "memory");
      const unsigned og = xb_add(&bar[XB_TOP], 1u);
      const unsigned tg = og / nx;
      if (og + 1u == (tg + 1u) * nx) xb_add(&bar[XB_TOPGEN], 1u);
      else XB_SPIN(xb_ld(&bar[XB_TOPGEN]) == tg, bar);
      __builtin_amdgcn_fence(__ATOMIC_ACQUIRE, "agent");
      xb_add(&bar[XB_XGEN(b.x)], 1u);
      asm volatile("s_waitcnt vmcnt(0)" ::: "memory");
    } else {
      XB_SPIN(xb_ld(&bar[XB_XGEN(b.x)]) == gen, bar);
      __builtin_amdgcn_fence(__ATOMIC_ACQUIRE, "agent");
      asm volatile("s_waitcnt vmcnt(0)" ::: "memory");
    }
  }
  __syncthreads();
}

__device__ __forceinline__ void gemm_acc(f32x16 (&acc)[2][2], const bfu* __restrict__ A, int lda,
                                         const bfu* __restrict__ Bt, int ldb, int K, bfu* sA, bfu*  ) {
  const int tid = threadIdx.x, lane = tid & 63, w = tid >> 6, wm = w & 1, wn = w >> 1;
  const int lr = tid >> 3;
  const int kc = ((tid & 7) ^ ((tid >> 4) & 7)) * 8;
  const bfu* Ap = A + (size_t)lr * lda + kc;
  const bfu* Bp = Bt + (size_t)lr * ldb + kc;
  const size_t a32 = (size_t)32 * lda, b32 = (size_t)32 * ldb;
  char* sbase = (char*)sA;
  char* ldst = sbase + tid * 16;
#define GISSUE(stage, k)                                                                                       \
  _Pragma("unroll") for (int i_ = 0; i_ < 4; ++i_) {                                                           \
    __builtin_amdgcn_global_load_lds((const unsigned*)(Ap + i_ * a32 + (k)),                                   \
                                     (LAS unsigned*)(ldst + (stage) * 32768 + i_ * 4096), 16, 0, 0);           \
    __builtin_amdgcn_global_load_lds((const unsigned*)(Bp + i_ * b32 + (k)),                                   \
                                     (LAS unsigned*)(ldst + (stage) * 32768 + 16384 + i_ * 4096), 16, 0, 0);   \
  }
  const int sw = (lane >> 1) & 7, hh = lane >> 5;
  const int rowA = (wm * 64 + (lane & 31)) * 128, rowB = (wn * 32 + (lane & 31)) * 128;
  __syncthreads();
  GISSUE(0, 0)
  int cur = 0;
  for (int k0 = 0; k0 < K; k0 += 64) {
    asm volatile("s_waitcnt vmcnt(0)" ::: "memory");
    __syncthreads();
    if (k0 + 64 < K) { GISSUE(cur ^ 1, k0 + 64) }
    const char* cA = sbase + cur * 32768;
    const char* cB = cA + 16384;
    __builtin_amdgcn_s_setprio(1);
#pragma unroll
    for (int ks = 0; ks < 4; ++ks) {
      const int pos = ((2 * ks + hh) ^ sw) * 16;
      bf16x8 af[2], bfr[2];
#pragma unroll
      for (int mi = 0; mi < 2; ++mi) af[mi] = *(const bf16x8*)(cA + rowA + mi * 32 * 128 + pos);
#pragma unroll
      for (int ni = 0; ni < 2; ++ni) bfr[ni] = *(const bf16x8*)(cB + rowB + ni * 64 * 128 + pos);
#pragma unroll
      for (int mi = 0; mi < 2; ++mi)
#pragma unroll
        for (int ni = 0; ni < 2; ++ni)
          acc[mi][ni] = __builtin_amdgcn_mfma_f32_32x32x16_bf16(af[mi], bfr[ni], acc[mi][ni], 0, 0, 0);
    }
    __builtin_amdgcn_s_setprio(0);
    cur ^= 1;
  }
}
#define gemm_acc1 gemm_acc
__device__ __forceinline__ void zero_acc(f32x16 (&acc)[2][2]) {
#pragma unroll
  for (int a = 0; a < 2; ++a)
#pragma unroll
    for (int b = 0; b < 2; ++b)
#pragma unroll
      for (int i = 0; i < 16; ++i) acc[a][b][i] = 0.f;
}
#define EPI_BEGIN                                                      \
  const int e_lane = threadIdx.x & 63, e_w = threadIdx.x >> 6;         \
  const int e_wm = e_w & 1, e_wn = e_w >> 1;                            \
  const int cl = e_wn * 32 + (e_lane & 31);                             \
  _Pragma("unroll") for (int mi = 0; mi < 2; ++mi)                      \
  _Pragma("unroll") for (int q = 0; q < 4; ++q) {                       \
    const int r0 = e_wm * 64 + mi * 32 + q * 8 + 4 * (e_lane >> 5);
#define EPI_END }

#define ST_LD 136
#define ST32_LD 132
__device__ __forceinline__ void copyout_bf16(const bfu* sT, bfu* dst, int ld) {
  const int tid = threadIdx.x;
#pragma unroll
  for (int i = 0; i < 8; ++i) {
    int id = tid + i * 256, row = id >> 4, c8 = (id & 15) * 8;
    *(uint4*)(dst + (size_t)row * ld + c8) = *(const uint4*)(sT + row * ST_LD + c8);
  }
}
__device__ __forceinline__ void stage_rm(bfu* sT, const f32x16 (&acc)[2][2], float sc) {
  EPI_BEGIN
#pragma unroll
    for (int j = 0; j < 4; ++j) {
      sT[(r0 + j) * ST_LD + cl] = f2bf(acc[mi][0][q * 4 + j] * sc);
      sT[(r0 + j) * ST_LD + cl + 64] = f2bf(acc[mi][1][q * 4 + j] * sc);
    }
  EPI_END
}

__device__ __forceinline__ void tile_map(int L, int nM, int nN, int& pm, int& pn) {
  const int nwg = nM * nN;
  const int q = nwg >> 3, r = nwg & 7, xcd = L & 7, off = L >> 3;
  int wgid = (xcd < r ? xcd * (q + 1) : r * (q + 1) + (xcd - r) * q) + off;
  const int nig = 8 * nN, gid = wgid / nig, fm = gid * 8;
  const int gsz = (nM - fm) < 8 ? (nM - fm) : 8;
  pm = fm + (wgid % nig) % gsz;
  pn = (wgid % nig) / gsz;
}
__device__ void transpose_w(const float* __restrict__ src, int K, int N, int src_ld, bfu* __restrict__ dst,
                            int remap, int gtid, int gstride) {
  int total = N * (K / 8);
  for (int i = gtid; i < total; i += gstride) {
    int n = i % N, kg = i / N;
    int col = (remap && n >= 3584) ? n + 8 : n;
    float v[8];
#pragma unroll
    for (int j = 0; j < 8; ++j) v[j] = src[(size_t)(kg * 8 + j) * src_ld + col];
    uint4 o;
    o.x = pack2(v[0], v[1]); o.y = pack2(v[2], v[3]); o.z = pack2(v[4], v[5]); o.w = pack2(v[6], v[7]);
    *(uint4*)(dst + (size_t)n * K + kg * 8) = o;
  }
}
__device__ void transpose_w_lds(const float* __restrict__ src, int K, int N, int src_ld, bfu* __restrict__ dst,
                                int remap, float* st, int boff) {
  const int tid = threadIdx.x;
  const int tilesN = N >> 6, ntile = (K >> 6) * tilesN;
  for (int t = (int)((blockIdx.x + gridDim.x - (boff % gridDim.x)) % gridDim.x); t < ntile; t += gridDim.x) {
    const int kt = t / tilesN, nt = t - kt * tilesN;
    {
      const int row = tid >> 2, c16 = (tid & 3) * 16;
      const int n0 = nt * 64 + c16;
      const int col = (remap && n0 >= 3584) ? n0 + 8 : n0;
      const float* sp = src + (size_t)(kt * 64 + row) * src_ld + col;
#pragma unroll
      for (int j = 0; j < 4; ++j) {
        float4 v = *(const float4*)(sp + j * 4);
        float* d = st + row * 65 + c16 + j * 4;
        d[0] = v.x; d[1] = v.y; d[2] = v.z; d[3] = v.w;
      }
    }
    __syncthreads();
    {
      const int n = tid >> 2, kc = (tid & 3) * 16;
#pragma unroll
      for (int hf = 0; hf < 2; ++hf) {
        float f[8];
#pragma unroll
        for (int j = 0; j < 8; ++j) f[j] = st[(kc + hf * 8 + j) * 65 + n];
        uint4 o;
        o.x = pack2(f[0], f[1]); o.y = pack2(f[2], f[3]); o.z = pack2(f[4], f[5]); o.w = pack2(f[6], f[7]);
        *(uint4*)(dst + (size_t)(nt * 64 + n) * K + kt * 64 + kc + hf * 8) = o;
      }
    }
    __syncthreads();
  }
}
__device__ void convert_bf(const float* __restrict__ src, bfu* __restrict__ dst, size_t n8, int gtid, int gstride) {
  for (size_t i = gtid; i < n8; i += gstride) {
    float4 a = *(const float4*)(src + i * 8), b = *(const float4*)(src + i * 8 + 4);
    uint4 o;
    o.x = pack2(a.x, a.y); o.y = pack2(a.z, a.w); o.z = pack2(b.x, b.y); o.w = pack2(b.z, b.w);
    *(uint4*)(dst + i * 8) = o;
  }
}

__device__ void prep_rows(const Params& P) {
  const int lane = threadIdx.x & 63, w = threadIdx.x >> 6;
  bfu* hbuf = (bfu*)(P.ws + SLOT(0));
  float* gpre = (float*)(P.ws + O_GPRE);
  float4 wg0[16], wg1[16];
#pragma unroll
  for (int i = 0; i < 4; ++i)
#pragma unroll
    for (int j = 0; j < 4; ++j) {
      const float* wr = P.w_in + (size_t)(i * 256 + lane * 4 + j) * 5640 + 3584;
      wg0[i * 4 + j] = *(const float4*)wr; wg1[i * 4 + j] = *(const float4*)(wr + 4);
    }
  float4 gm[4];
#pragma unroll
  for (int i = 0; i < 4; ++i) gm[i] = *(const float4*)(P.g_mix + i * 256 + lane * 4);
  for (int r = blockIdx.x * 4 + w; r < MT; r += gridDim.x * 4) {
    const float* xr = xrow(P, r);
    float4 v[4];
    float ss = 0.f;
#pragma unroll
    for (int i = 0; i < 4; ++i) {
      v[i] = *(const float4*)(xr + i * 256 + lane * 4);
      ss += v[i].x * v[i].x + v[i].y * v[i].y + v[i].z * v[i].z + v[i].w * v[i].w;
    }
    ss = wave_sum(ss);
    float rstd = rsqrtf(ss * (1.f / 1024.f) + EPS);
    float ga[8];
#pragma unroll
    for (int j = 0; j < 8; ++j) ga[j] = 0.f;
#pragma unroll
    for (int i = 0; i < 4; ++i) {
      float hv[4] = {v[i].x * rstd * gm[i].x, v[i].y * rstd * gm[i].y, v[i].z * rstd * gm[i].z, v[i].w * rstd * gm[i].w};
      uint2 o; o.x = pack2(hv[0], hv[1]); o.y = pack2(hv[2], hv[3]);
      *(uint2*)(hbuf + (size_t)r * 1024 + i * 256 + lane * 4) = o;
#pragma unroll
      for (int j = 0; j < 4; ++j) {
        const float4 w0 = wg0[i * 4 + j], w1 = wg1[i * 4 + j];
        ga[0] += hv[j] * w0.x; ga[1] += hv[j] * w0.y; ga[2] += hv[j] * w0.z; ga[3] += hv[j] * w0.w;
        ga[4] += hv[j] * w1.x; ga[5] += hv[j] * w1.y; ga[6] += hv[j] * w1.z; ga[7] += hv[j] * w1.w;
      }
    }
    float si = reduce4(ga[0], ga[1], ga[2], ga[3]);
    float sf = reduce4(ga[4], ga[5], ga[6], ga[7]);
    if ((lane & 15) == 0) {
      int k = lane >> 4;
      gpre[(size_t)r * 8 + k] = si + P.b_i[k];
      gpre[(size_t)r * 8 + 4 + k] = sf + P.b_f[k];
    }
  }
}
__device__ void gate_scan(const Params& P) {
  const int lane = threadIdx.x & 63, w = threadIdx.x >> 6;
  const float* gpre = (const float*)(P.ws + O_GPRE);
  for (int item = blockIdx.x * 4 + w; item < 528 * 4; item += gridDim.x * 4) {
    int tile = item >> 2, h = item & 3;
    int row0, L;
    if (tile < 512) { row0 = tile * 64; L = 64; } else { row0 = MP + (tile - 512) * 32; L = 32; }
    const int s = lane;
    bool valid = s < L;
    float ig = valid ? gpre[(size_t)(row0 + s) * 8 + h] : -INFINITY;
    float fg = valid ? gpre[(size_t)(row0 + s) * 8 + 4 + h] : 0.f;
    float lf = valid ? (fminf(fg, 0.f) - log1pf(__expf(-fabsf(fg)))) : 0.f;
    float F = lf;
#pragma unroll
    for (int o = 1; o < 64; o <<= 1) { float t = __shfl_up(F, o); if (lane >= o) F += t; }
    float u = valid ? ig - F : -INFINITY;
    float cm = u;
#pragma unroll
    for (int o = 1; o < 64; o <<= 1) { float t = __shfl_up(cm, o); if (lane >= o) cm = fmaxf(cm, t); }
    if (valid) {
      size_t gi = (size_t)(row0 + s) * 4 + h;
      ((float*)(P.ws + O_FQ))[gi] = F;
      ((float*)(P.ws + O_UQ))[gi] = u;
      ((float*)(P.ws + O_CMQ))[gi] = cm;
      if (s == L - 1) {
        ((float*)(P.ws + O_FL))[tile * 4 + h] = F;
        ((float*)(P.ws + O_UC))[tile * 4 + h] = cm;
      }
    }
  }
}

__device__ void phase_prep(const Params& P, char* smem) {
  const int gtid = blockIdx.x * NTHREADS + threadIdx.x, gstride = gridDim.x * NTHREADS;
  prep_rows(P);
  transpose_w_lds(P.w_in, 1024, 5632, 5640, (bfu*)(P.ws + O_WT_IN), 1, (float*)smem, 0);
  transpose_w_lds(P.w_up_r, 512, 1024, 1024, (bfu*)(P.ws + O_WT_UPR), 0, (float*)smem, 1408);
  transpose_w_lds(P.w_up_m, 512, 1024, 1024, (bfu*)(P.ws + O_WT_UPM), 0, (float*)smem, 1536);
  transpose_w_lds(P.w_out, 1024, 1024, 1024, (bfu*)(P.ws + O_WT_OUT), 0, (float*)smem, 1664);
  transpose_w_lds(P.w_pq, 1024, 2048, 2048, (bfu*)(P.ws + O_WT_PQ), 0, (float*)smem, 1920);
  transpose_w_lds(P.w_pg, 1024, 1024, 1024, (bfu*)(P.ws + O_WT_PG), 0, (float*)smem, 2432);
  transpose_w_lds(P.w_ple, 256, 1024, 1024, (bfu*)(P.ws + O_WT_PLE), 0, (float*)smem, 2688);
  for (int h = 0; h < 4; ++h) {
    transpose_w_lds(P.w_mq + h * 16384, 128, 128, 128, (bfu*)(P.ws + O_WT_MQ) + h * 16384, 0, (float*)smem, 2752 + h * 8);
    transpose_w_lds(P.w_mk + h * 16384, 128, 128, 128, (bfu*)(P.ws + O_WT_MK) + h * 16384, 0, (float*)smem, 2756 + h * 8);
  }
  convert_bf(P.peer_keys, (bfu*)(P.ws + O_KEYS), 16 * 128 * 128 / 8, gtid, gstride);
  float* ct = (float*)(P.ws + O_COS); float* st = (float*)(P.ws + O_SIN);
  for (int i = gtid; i < 8192 * 64; i += gstride) {
    int pos = i >> 6, j = i & 63;
    float inv = exp2f(-(float)j * (13.287712379549449f / 64.f));
    float angf = (float)pos * inv;
    double a = (double)angf;
    double k = rint(a * 0.15915494309189535);
    float r = (float)(a - k * 6.283185307179586);
    ct[i] = __cosf(r); st[i] = __sinf(r);
  }
}

__device__ __forceinline__ void gemm_acc256(f32x16 (&acc)[4][2], const bfu* __restrict__ A, int lda,
                                            const bfu* __restrict__ Bt, int ldb, int K, char* sbase) {
  const int tid = threadIdx.x, lane = tid & 63, w = tid >> 6, wm = w & 1, wn = w >> 1;
  const int kc = ((tid & 3) ^ ((tid >> 4) & 3)) * 8;
  const bfu* Ap = A + (size_t)(tid >> 2) * lda + kc;
  const bfu* Bp = Bt + (size_t)(tid >> 2) * ldb + kc;
  const size_t a64 = (size_t)64 * lda, b64 = (size_t)64 * ldb;
  char* ldst = sbase + tid * 16;
#define GISSUE256(stage, k)                                                                                      \
  {                                                                                                              \
    char* d_ = ldst + (stage) * 24576;                                                                           \
    __builtin_amdgcn_global_load_lds((const unsigned*)(Ap + (k)), (LAS unsigned*)(d_), 16, 0, 0);                \
    __builtin_amdgcn_global_load_lds((const unsigned*)(Ap + a64 + (k)), (LAS unsigned*)(d_ + 4096), 16, 0, 0);   \
    __builtin_amdgcn_global_load_lds((const unsigned*)(Ap + 2 * a64 + (k)), (LAS unsigned*)(d_ + 8192), 16, 0, 0);  \
    __builtin_amdgcn_global_load_lds((const unsigned*)(Ap + 3 * a64 + (k)), (LAS unsigned*)(d_ + 12288), 16, 0, 0); \
    __builtin_amdgcn_global_load_lds((const unsigned*)(Bp + (k)), (LAS unsigned*)(d_ + 16384), 16, 0, 0);        \
    __builtin_amdgcn_global_load_lds((const unsigned*)(Bp + b64 + (k)), (LAS unsigned*)(d_ + 20480), 16, 0, 0);  \
  }
  const int sw = (lane >> 2) & 3, hh = lane >> 5;
  const int rowA = (wm * 64 + (lane & 31)) * 64, rowB = (wn * 32 + (lane & 31)) * 64;
  const int nk = K >> 5;
  __syncthreads();
  asm volatile("s_waitcnt vmcnt(0)" ::: "memory");
  GISSUE256(0, 0)
  if (nk > 1) GISSUE256(1, 32)
  int st = 0;
  for (int kt = 0; kt < nk; ++kt) {
    if (kt + 1 < nk) asm volatile("s_waitcnt vmcnt(6)" ::: "memory");
    else asm volatile("s_waitcnt vmcnt(0)" ::: "memory");
    asm volatile("s_waitcnt lgkmcnt(0)" ::: "memory");
    __builtin_amdgcn_s_barrier();
    asm volatile("" ::: "memory");
    if (kt + 2 < nk) { const int s2 = st >= 1 ? st - 1 : 2; GISSUE256(s2, (kt + 2) * 32) }
    const char* cA = sbase + st * 24576;
    const char* cB = cA + 16384;
    __builtin_amdgcn_s_setprio(1);
#pragma unroll
    for (int ks = 0; ks < 2; ++ks) {
      const int pos = ((2 * ks + hh) ^ sw) * 16;
      bf16x8 af[4], bfr[2];
#pragma unroll
      for (int mi = 0; mi < 4; ++mi) af[mi] = *(const bf16x8*)(cA + rowA + ((mi >> 1) * 128 + (mi & 1) * 32) * 64 + pos);
#pragma unroll
      for (int ni = 0; ni < 2; ++ni) bfr[ni] = *(const bf16x8*)(cB + rowB + ni * 64 * 64 + pos);
#pragma unroll
      for (int mi = 0; mi < 4; ++mi)
#pragma unroll
        for (int ni = 0; ni < 2; ++ni)
          acc[mi][ni] = __builtin_amdgcn_mfma_f32_32x32x16_bf16(af[mi], bfr[ni], acc[mi][ni], 0, 0, 0);
    }
    __builtin_amdgcn_s_setprio(0);
    st = st == 2 ? 0 : st + 1;
  }
}

__device__ __forceinline__ void gemm1_epilogue(const Params& P, char* smem, f32x16 (&acc)[2][2], const int rbase, const int nt,
                                               const float* ct, const float* stb) {
    const bool prompt = rbase < MP;
  int region = nt >> 2, hh = nt & 3;
  bfu* sT = (bfu*)smem;
  __syncthreads();
  if (region <= 1) {
    float sc = region == 1 ? 0.08838834764831845f : 1.f;
    EPI_BEGIN
#pragma unroll
      for (int j = 0; j < 4; ++j) {
        int rr = rbase + r0 + j;
        int pos = prompt ? (rr & 8191) : 2048 + ((rr - MP) & 31);
        float c = ct[pos * 64 + cl], sn = stb[pos * 64 + cl];
        float a = acc[mi][0][q * 4 + j], b = acc[mi][1][q * 4 + j];
        sT[(r0 + j) * ST_LD + cl] = f2bf((a * c - b * sn) * sc);
        sT[(r0 + j) * ST_LD + cl + 64] = f2bf((a * sn + b * c) * sc);
      }
    EPI_END
    __syncthreads();
    copyout_bf16(sT, (bfu*)(P.ws + SLOT(2 + region)) + (size_t)rbase * 512 + hh * 128, 512);
  } else if (region == 2 || region == 5) {
    EPI_BEGIN
      uint2 va, vb;
      va.x = pack2(acc[mi][0][q * 4 + 0], acc[mi][0][q * 4 + 1]); va.y = pack2(acc[mi][0][q * 4 + 2], acc[mi][0][q * 4 + 3]);
      vb.x = pack2(acc[mi][1][q * 4 + 0], acc[mi][1][q * 4 + 1]); vb.y = pack2(acc[mi][1][q * 4 + 2], acc[mi][1][q * 4 + 3]);
      *(uint2*)(sT + cl * ST_LD + r0) = va;
      *(uint2*)(sT + (cl + 64) * ST_LD + r0) = vb;
    EPI_END
    __syncthreads();
    bfu* dst = (bfu*)(P.ws + SLOT(region == 2 ? 4 : 7));
#pragma unroll
    for (int i = 0; i < 8; ++i) {
      int id = threadIdx.x + i * 256, e = id >> 4, c8 = (id & 15) * 8;
      size_t o;
      if (prompt) { int bb = rbase >> 13, tt = (rbase & 8191) + c8; o = ((size_t)((bb * 4 + hh) * 128 + e)) * 8192 + tt; }
      else { int rs = rbase - MP + c8, bb = rs >> 5, tt = rs & 31; o = SB_T + ((size_t)((bb * 4 + hh) * 128 + e)) * 32 + tt; }
      *(uint4*)(dst + o) = *(const uint4*)(sT + e * ST_LD + c8);
    }
  } else if (region == 3 || region == 4 || region == 6) {
    stage_rm(sT, acc, 1.f);
    __syncthreads();
    copyout_bf16(sT, (bfu*)(P.ws + SLOT(region == 3 ? 5 : (region == 4 ? 6 : 8))) + (size_t)rbase * 512 + hh * 128, 512);
  } else {
    int gi = nt - 28;
    stage_rm(sT, acc, 1.f);
    __syncthreads();
    copyout_bf16(sT, (bfu*)(P.ws + SLOT(gi < 8 ? 9 : 11)) + (size_t)rbase * 1024 + (gi & 7) * 128, 1024);
  }

}

__device__ void phase_gemm1(const Params& P, char* smem) {
  const bfu* hbuf = (const bfu*)(P.ws + SLOT(0));
  const bfu* wt = (const bfu*)(P.ws + O_WT_IN);
  const float* ct = (const float*)(P.ws + O_COS); const float* stb = (const float*)(P.ws + O_SIN);
  for (int t = blockIdx.x; t < 130 * 44; t += gridDim.x) {
    int mt, nt; tile_map(t, 130, 44, mt, nt);
    f32x16 acc[4][2];
#pragma unroll
    for (int a = 0; a < 4; ++a)
#pragma unroll
      for (int b = 0; b < 2; ++b)
#pragma unroll
        for (int i = 0; i < 16; ++i) acc[a][b][i] = 0.f;
    gemm_acc256(acc, hbuf + (size_t)mt * 256 * 1024, 1024, wt + (size_t)nt * 128 * 1024, 1024, 1024, smem);
    gemm1_epilogue(P, smem, reinterpret_cast<f32x16(&)[2][2]>(acc[0]), mt * 256, nt, ct, stb);
    gemm1_epilogue(P, smem, reinterpret_cast<f32x16(&)[2][2]>(acc[2]), mt * 256 + 128, nt, ct, stb);
  }
}

__device__ void phase_conv(const Params& P) {
  const int gtid = blockIdx.x * NTHREADS + threadIdx.x, gstride = gridDim.x * NTHREADS;
  const bfu* xm = (const bfu*)(P.ws + SLOT(6));
  bfu* cb = (bfu*)(P.ws + SLOT(0));
  for (int i = gtid; i < MT * 64; i += gstride) {
    int r = i >> 6, c0 = (i & 63) * 8;
    int t, T, bb; bool prompt = r < MP;
    if (prompt) { bb = r >> 13; t = r & 8191; T = 8192; } else { int rs = r - MP; bb = rs >> 5; t = rs & 31; T = 32; }
    float y[8];
#pragma unroll
    for (int j = 0; j < 8; ++j) y[j] = P.conv_b[c0 + j];
#pragma unroll
    for (int k = 0; k < 4; ++k) {
      int tt = t - 3 + k;
      float xv[8];
      if (tt >= 0) {
        uint4 v = *(const uint4*)(xm + (size_t)(r - 3 + k) * 512 + c0);
        xv[0] = bf2f(v.x & 0xffff); xv[1] = bf2f(v.x >> 16); xv[2] = bf2f(v.y & 0xffff); xv[3] = bf2f(v.y >> 16);
        xv[4] = bf2f(v.z & 0xffff); xv[5] = bf2f(v.z >> 16); xv[6] = bf2f(v.w & 0xffff); xv[7] = bf2f(v.w >> 16);
      } else if (!prompt) {
        const float* sp = P.st_conv + (size_t)(bb * 3 + (tt + 3)) * 512 + c0;
#pragma unroll
        for (int j = 0; j < 8; ++j) xv[j] = sp[j];
      } else {
#pragma unroll
        for (int j = 0; j < 8; ++j) xv[j] = 0.f;
      }
#pragma unroll
      for (int j = 0; j < 8; ++j) y[j] += xv[j] * P.conv_w[k * 512 + c0 + j];
    }
    if (t >= T - 3) {
      uint4 v = *(const uint4*)(xm + (size_t)r * 512 + c0);
      float* dst = (prompt ? P.out + OO_CONVP : P.out + OO_CONVS) + (size_t)(bb * 3 + (t - (T - 3))) * 512 + c0;
      dst[0] = bf2f(v.x & 0xffff); dst[1] = bf2f(v.x >> 16); dst[2] = bf2f(v.y & 0xffff); dst[3] = bf2f(v.y >> 16);
      dst[4] = bf2f(v.z & 0xffff); dst[5] = bf2f(v.z >> 16); dst[6] = bf2f(v.w & 0xffff); dst[7] = bf2f(v.w >> 16);
    }
    uint4 o;
#pragma unroll
    for (int j = 0; j < 8; ++j) y[j] = y[j] * sigmoidf_(y[j]);
    o.x = pack2(y[0], y[1]); o.y = pack2(y[2], y[3]); o.z = pack2(y[4], y[5]); o.w = pack2(y[6], y[7]);
    *(uint4*)(cb + (size_t)r * 512 + c0) = o;
  }
}

__device__ void m_fold(const Params& P) {
  const int gtid = blockIdx.x * NTHREADS + threadIdx.x;
  const float* FL = (const float*)(P.ws + O_FL); const float* UC = (const float*)(P.ws + O_UC);
  float* MCS = (float*)(P.ws + O_MCS);
  if (gtid < 16) {
    int b = gtid >> 2, h = gtid & 3;
    float m = 0.f;
    for (int c = 0; c < 128; c += 8) {
      float fl[8], uc[8];
#pragma unroll
      for (int k = 0; k < 8; ++k) { fl[k] = FL[(b * 128 + c + k) * 4 + h]; uc[k] = UC[(b * 128 + c + k) * 4 + h]; }
#pragma unroll
      for (int k = 0; k < 8; ++k) { MCS[gtid * 128 + c + k] = m; m = fl[k] + fmaxf(m, uc[k]); }
    }
  } else if (gtid < 16 + 64) {
    int bh = gtid - 16;
    MCS[2048 + bh] = P.st_m[bh];
  }
}
__device__ void phase_mqk(const Params& P, char* smem) {
  bfu* sA = (bfu*)smem; bfu* sB = sA + 128 * 72;
  const bfu* cb = (const bfu*)(P.ws + SLOT(0));
  for (int t = blockIdx.x; t < 260 * 8; t += gridDim.x) {
    int mt = t >> 3, which = (t >> 2) & 1, hh = t & 3;
    const bfu* wt = (const bfu*)(P.ws + (which ? O_WT_MK : O_WT_MQ)) + hh * 16384;
    f32x16 acc[2][2]; zero_acc(acc);
    gemm_acc(acc, cb + (size_t)mt * 128 * 512 + hh * 128, 512, wt, 128, 128, sA, sB);
    bfu* dst = (bfu*)(P.ws + SLOT(which ? 13 : 1));
    float sc = which ? 0.08838834764831845f : 1.f;
    bfu* sT = (bfu*)smem;
    __syncthreads();
    stage_rm(sT, acc, sc);
    __syncthreads();
    copyout_bf16(sT, dst + (size_t)mt * 128 * 512 + hh * 128, 512);
  }
}

struct Item { int b, h, c, row0, L, T, chunk, bh; bool prompt; size_t vt_off; };
__device__ __forceinline__ Item decode_item(int idx) {
  Item it;
  if (idx < 2048) {
    it.prompt = true; it.b = idx >> 9; it.h = (idx >> 7) & 3; it.c = idx & 127; it.row0 = it.b * 8192 + it.c * 64;
    it.L = 64; it.T = 8192; it.chunk = it.b * 128 + it.c; it.bh = it.b * 4 + it.h;
    it.vt_off = ((size_t)(it.bh * 128)) * 8192 + it.c * 64;
  } else {
    int si = idx - 2048; it.prompt = false; it.b = si >> 2; it.h = si & 3; it.c = 0; it.row0 = MP + it.b * 32;
    it.L = 32; it.T = 32; it.chunk = 512 + it.b; it.bh = it.b * 4 + it.h;
    it.vt_off = SB_T + ((size_t)(it.bh * 128)) * 32;
  }
  return it;
}
__device__ __forceinline__ bfu* ds_ptr(const Params& P, int mixer, int idx) {
  if (idx < 2048) return (bfu*)P.out + ((size_t)(mixer * 2048 + idx)) * 16384;
  return (bfu*)(P.ws + O_DSS) + ((size_t)(mixer * 64 + (idx - 2048))) * 16384;
}
__device__ __forceinline__ float ret_lg(int h) { return log1pf(-exp2f(-5.f - (float)h)); }

__device__ void phaseA_item(const Params& P, int mixer, int idx, char* smem) {
  const int tid = threadIdx.x, lane = tid & 63, w = tid >> 6, wm = w & 1, wn = w >> 1;
  Item it = decode_item(idx);
  bfu* sK = (bfu*)smem; bfu* sV = sK + 128 * 72;
  float* sw = (float*)(sV + 128 * 72);
  float* sm = sw + 64;
  const int L = it.L, h = it.h;
  const bfu* Ksrc = (const bfu*)(P.ws + SLOT(mixer == 0 ? 3 : 13)) + (size_t)it.row0 * 512 + h * 128;
  const bfu* Vsrc = (const bfu*)(P.ws + SLOT(mixer == 0 ? 4 : 7)) + it.vt_off;
  uint4 kreg[4], vreg[4];
#pragma unroll
  for (int i = 0; i < 4; ++i) {
    int id = tid + i * 256, s = id & 63, dc = (id >> 6) * 8;
    kreg[i] = make_uint4(0, 0, 0, 0);
    if (s < L) kreg[i] = *(const uint4*)(Ksrc + (size_t)s * 512 + dc);
    int e = id >> 3, sc = (id & 7) * 8;
    vreg[i] = make_uint4(0, 0, 0, 0);
    if (sc < L) vreg[i] = *(const uint4*)(Vsrc + (size_t)e * it.T + sc);
  }
  if (mixer == 0) {
    if (tid < 64) { float lg = ret_lg(h); sw[tid] = tid < L ? __expf(lg * (float)(L - 1 - tid)) : 0.f; }
  } else {
    const float* FL = (const float*)(P.ws + O_FL); const float* UC = (const float*)(P.ws + O_UC);
    float mc = ((const float*)(P.ws + O_MCS))[idx];
    float Ml = fmaxf(mc, UC[it.chunk * 4 + h]);
    if (tid < 64) sw[tid] = tid < L ? __expf(((const float*)(P.ws + O_UQ))[(size_t)(it.row0 + tid) * 4 + h] - Ml) : 0.f;
    if (tid == 0) {
      ((float*)(P.ws + O_AEND))[idx] = __expf(mc - Ml);
      if (!it.prompt) P.out[OO_MS + it.bh] = FL[it.chunk * 4 + h] + Ml;
      else if (it.c == 127) P.out[OO_MP + it.bh] = FL[it.chunk * 4 + h] + Ml;
    }
  }
  __syncthreads();
#pragma unroll
  for (int i = 0; i < 4; ++i) {
    int id = tid + i * 256, s = id & 63, dc = (id >> 6) * 8;
    uint4 v = kreg[i];
    float ww = sw[s];
    unsigned vv[4] = {v.x, v.y, v.z, v.w};
#pragma unroll
    for (int j = 0; j < 4; ++j) {
      sK[(dc + 2 * j) * 72 + s] = f2bf(bf2f(vv[j] & 0xffff) * ww);
      sK[(dc + 2 * j + 1) * 72 + s] = f2bf(bf2f(vv[j] >> 16) * ww);
    }
  }
#pragma unroll
  for (int i = 0; i < 4; ++i) {
    int id = tid + i * 256, e = id >> 3, sc = (id & 7) * 8;
    *(uint4*)(sV + e * 72 + sc) = vreg[i];
  }
  __syncthreads();
  f32x16 acc[2][2]; zero_acc(acc);
#pragma unroll
  for (int ks = 0; ks < 4; ++ks) {
    bf16x8 af[2], bfr[2];
#pragma unroll
    for (int mi = 0; mi < 2; ++mi)
      af[mi] = *(const bf16x8*)(sK + (wm * 64 + mi * 32 + (lane & 31)) * 72 + ks * 16 + (lane >> 5) * 8);
#pragma unroll
    for (int ni = 0; ni < 2; ++ni)
      bfr[ni] = *(const bf16x8*)(sV + (wn * 32 + ni * 64 + (lane & 31)) * 72 + ks * 16 + (lane >> 5) * 8);
#pragma unroll
    for (int mi = 0; mi < 2; ++mi)
#pragma unroll
      for (int ni = 0; ni < 2; ++ni)
        acc[mi][ni] = __builtin_amdgcn_mfma_f32_32x32x16_bf16(af[mi], bfr[ni], acc[mi][ni], 0, 0, 0);
  }
  bfu* dS = ds_ptr(P, mixer, idx);
  EPI_BEGIN
#pragma unroll
    for (int ni = 0; ni < 2; ++ni) {
      int e = cl + ni * 64;
      uint2 o; o.x = pack2(acc[mi][ni][q * 4 + 0], acc[mi][ni][q * 4 + 1]); o.y = pack2(acc[mi][ni][q * 4 + 2], acc[mi][ni][q * 4 + 3]);
      *(uint2*)(dS + e * 128 + r0) = o;
    }
  EPI_END
  if (mixer == 1 && tid < 128) {
    float s = 0.f;
#pragma unroll
    for (int j = 0; j < 8; ++j) { float f[8]; unpack8(*(const uint4*)(sK + tid * 72 + j * 8), f);
#pragma unroll
      for (int k = 0; k < 8; ++k) s += f[k]; }
    ((float*)(P.ws + O_DN))[(size_t)idx * 128 + tid] = s;
  }
  __syncthreads();
}

__device__ void phase_scan(const Params& P) {
  const int gtid = blockIdx.x * NTHREADS + threadIdx.x, gstride = gridDim.x * NTHREADS;
  const float* AE = (const float*)(P.ws + O_AEND);
  for (int i = gtid; i < 131072; i += gstride) {
    int mixer = i >> 16, bh = (i >> 12) & 15, eo = (i & 4095) * 4;
    int h = bh & 3;
    float gch = __expf(ret_lg(h) * 64.f);
    float st[4];
#pragma unroll
    for (int j = 0; j < 4; ++j) st[j] = 0.f;
    bfu* base = (bfu*)P.out + ((size_t)(mixer * 2048 + bh * 128)) * 16384 + eo;
    for (int c = 0; c < 128; c += 8) {
      uint2 v[8];
#pragma unroll
      for (int k = 0; k < 8; ++k) v[k] = *(const uint2*)(base + (size_t)(c + k) * 16384);
#pragma unroll
      for (int k = 0; k < 8; ++k) {
        float dec = mixer == 0 ? gch : AE[bh * 128 + c + k];
        float d0 = bf2f(v[k].x & 0xffff), d1 = bf2f(v[k].x >> 16), d2 = bf2f(v[k].y & 0xffff), d3 = bf2f(v[k].y >> 16);
        uint2 o; o.x = pack2(st[0], st[1]); o.y = pack2(st[2], st[3]);
        *(uint2*)(base + (size_t)(c + k) * 16384) = o;
        st[0] = dec * st[0] + d0; st[1] = dec * st[1] + d1; st[2] = dec * st[2] + d2; st[3] = dec * st[3] + d3;
      }
    }
    float* o = P.out + (mixer == 0 ? OO_RETP : OO_CP) + (size_t)bh * 16384;
    int e = eo >> 7, d0i = eo & 127;
#pragma unroll
    for (int j = 0; j < 4; ++j) o[(d0i + j) * 128 + e] = st[j];
  }
  for (int i = gtid; i < 2 * 64 * 2048; i += gstride) {
    int mixer = i >> 17, bh = (i >> 11) & 63, eo = (i & 2047) * 8;
    int h = bh & 3;
    int e = eo >> 7, d0 = eo & 127;
    const float* s0 = (mixer == 0 ? P.st_ret : P.st_C) + (size_t)bh * 16384;
    float st[8];
#pragma unroll
    for (int j = 0; j < 8; ++j) st[j] = s0[(d0 + j) * 128 + e];
    bfu* p = (bfu*)(P.ws + O_DSS) + ((size_t)(mixer * 64 + bh)) * 16384 + eo;
    float d[8]; unpack8(*(const uint4*)p, d);
    *(uint4*)p = pack8(st);
    float dec = mixer == 0 ? __expf(ret_lg(h) * 32.f) : AE[2048 + bh];
    float* o = P.out + (mixer == 0 ? OO_RETS : OO_CS) + (size_t)bh * 16384;
#pragma unroll
    for (int j = 0; j < 8; ++j) o[(d0 + j) * 128 + e] = dec * st[j] + d[j];
  }
  float* DN = (float*)(P.ws + O_DN);
  for (int i = gtid; i < 16 * 128; i += gstride) {
    int bh = i >> 7, d = i & 127;
    float n = 0.f;
    for (int c = 0; c < 128; ++c) {
      size_t o = (size_t)(bh * 128 + c) * 128 + d;
      float v = DN[o]; DN[o] = n; n = AE[bh * 128 + c] * n + v;
    }
    P.out[OO_NP + i] = n;
  }
  for (int i = gtid; i < 64 * 128; i += gstride) {
    int bh = i >> 7, d = i & 127;
    size_t o = (size_t)(2048 + bh) * 128 + d;
    float n0 = P.st_n[i]; float v = DN[o]; DN[o] = n0;
    P.out[OO_NS + i] = AE[2048 + bh] * n0 + v;
  }
}

__device__ void phaseC_item(const Params& P, int mixer, int idx, char* smem) {
  const int tid = threadIdx.x, lane = tid & 63, w = tid >> 6;
  Item it = decode_item(idx);
  const int L = it.L, h = it.h;
  bfu* sQ = (bfu*)smem;
  bfu* sKV = sQ + 64 * 136;
  bfu* sP = sKV + 128 * 72;
  bfu* sS = sP + 64 * 72;
  float* sO = (float*)sS;
  float* sRow = (float*)(sS + 128 * 136);
  const bfu* Qsrc = (const bfu*)(P.ws + SLOT(mixer == 0 ? 2 : 1)) + (size_t)it.row0 * 512 + h * 128;
  const bfu* Ksrc = (const bfu*)(P.ws + SLOT(mixer == 0 ? 3 : 13)) + (size_t)it.row0 * 512 + h * 128;
  const bfu* Vsrc = (const bfu*)(P.ws + SLOT(mixer == 0 ? 4 : 7)) + it.vt_off;
  const bfu* Ssrc = ds_ptr(P, mixer, idx);
  const float lg = ret_lg(h);
  uint4 vpre[4];
#pragma unroll
  for (int i = 0; i < 4; ++i) {
    int id = tid + i * 256, e = id >> 3, sc = (id & 7) * 8;
    vpre[i] = make_uint4(0, 0, 0, 0);
    if (sc < L) vpre[i] = *(const uint4*)(Vsrc + (size_t)e * it.T + sc);
  }
#pragma unroll
  for (int i = 0; i < 4; ++i) {
    int id = tid + i * 256, s = id >> 4, dc = (id & 15) * 8;
    uint4 vq = make_uint4(0, 0, 0, 0), vk = vq;
    if (s < L) { vq = *(const uint4*)(Qsrc + (size_t)s * 512 + dc); vk = *(const uint4*)(Ksrc + (size_t)s * 512 + dc); }
    *(uint4*)(sQ + s * 136 + dc) = vq;
    *(uint4*)(sKV + s * 136 + dc) = vk;
  }
#pragma unroll
  for (int i = 0; i < 8; ++i) {
    int id = tid + i * 256, e = id >> 4, dc = (id & 15) * 8;
    *(uint4*)(sS + e * 136 + dc) = *(const uint4*)(Ssrc + e * 128 + dc);
  }
  if (tid < 64) {
    int i = tid;
    if (mixer == 0) {
      sRow[128 + i] = __expf(lg * (float)(i + 1));
    } else {
      float mc = ((const float*)(P.ws + O_MCS))[idx];
      size_t gi = (size_t)(it.row0 + i) * 4 + h;
      bool valid = i < L;
      float u = valid ? ((const float*)(P.ws + O_UQ))[gi] : -INFINITY;
      float M = valid ? fmaxf(mc, ((const float*)(P.ws + O_CMQ))[gi]) : 0.f;
      float F = valid ? ((const float*)(P.ws + O_FQ))[gi] : 0.f;
      sRow[i] = u; sRow[64 + i] = M; sRow[128 + i] = valid ? __expf(mc - M) : 0.f;
      sRow[256 + i] = __expf(-(F + M));
    }
  }
  __syncthreads();
  {
    const int mi = w & 1, ni = w >> 1;
    f32x16 acc;
#pragma unroll
    for (int i = 0; i < 16; ++i) acc[i] = 0.f;
#pragma unroll 2
    for (int ks = 0; ks < 8; ++ks) {
      bf16x8 af = *(const bf16x8*)(sQ + (mi * 32 + (lane & 31)) * 136 + ks * 16 + (lane >> 5) * 8);
      bf16x8 bfr = *(const bf16x8*)(sKV + (ni * 32 + (lane & 31)) * 136 + ks * 16 + (lane >> 5) * 8);
      acc = __builtin_amdgcn_mfma_f32_32x32x16_bf16(af, bfr, acc, 0, 0, 0);
    }
    const int s = ni * 32 + (lane & 31);
    float us = mixer ? sRow[s] : 0.f;
#pragma unroll
    for (int reg = 0; reg < 16; ++reg) {
      int i = mi * 32 + (reg & 3) + 8 * (reg >> 2) + 4 * (lane >> 5);
      float wgt;
      if (mixer == 0) wgt = (s <= i) ? __expf(lg * (float)(i - s)) : 0.f;
      else wgt = (s <= i && i < L) ? __expf(us - sRow[64 + i]) : 0.f;
      sP[i * 72 + s] = f2bf(acc[reg] * wgt);
    }
  }
  __syncthreads();
#pragma unroll
  for (int i = 0; i < 4; ++i) {
    int id = tid + i * 256, e = id >> 3, sc = (id & 7) * 8;
    *(uint4*)(sKV + e * 72 + sc) = vpre[i];
  }
  __syncthreads();
  f32x16 acc1[2], acc2[2];
  const int mi = w & 1, nj = w >> 1;
#pragma unroll
  for (int t = 0; t < 2; ++t)
#pragma unroll
    for (int i = 0; i < 16; ++i) { acc1[t][i] = 0.f; acc2[t][i] = 0.f; }
#pragma unroll 2
  for (int ks = 0; ks < 4; ++ks) {
    bf16x8 af = *(const bf16x8*)(sP + (mi * 32 + (lane & 31)) * 72 + ks * 16 + (lane >> 5) * 8);
#pragma unroll
    for (int t = 0; t < 2; ++t) {
      bf16x8 bfr = *(const bf16x8*)(sKV + (nj * 64 + t * 32 + (lane & 31)) * 72 + ks * 16 + (lane >> 5) * 8);
      acc1[t] = __builtin_amdgcn_mfma_f32_32x32x16_bf16(af, bfr, acc1[t], 0, 0, 0);
    }
  }
#pragma unroll 2
  for (int ks = 0; ks < 8; ++ks) {
    bf16x8 af = *(const bf16x8*)(sQ + (mi * 32 + (lane & 31)) * 136 + ks * 16 + (lane >> 5) * 8);
#pragma unroll
    for (int t = 0; t < 2; ++t) {
      bf16x8 bfr = *(const bf16x8*)(sS + (nj * 64 + t * 32 + (lane & 31)) * 136 + ks * 16 + (lane >> 5) * 8);
      acc2[t] = __builtin_amdgcn_mfma_f32_32x32x16_bf16(af, bfr, acc2[t], 0, 0, 0);
    }
  }
  if (mixer == 1) {
    int i = tid >> 2, part = tid & 3;
    const float* nprev = (const float*)(P.ws + O_DN) + (size_t)idx * 128;
    float dl = 0.f, qn = 0.f;
#pragma unroll 4
    for (int s = part * 16; s < part * 16 + 16; ++s) dl += bf2f(sP[i * 72 + s]);
#pragma unroll 4
    for (int d = part * 32; d < part * 32 + 32; ++d) qn += bf2f(sQ[i * 136 + d]) * nprev[d];
    dl += __shfl_xor(dl, 1); dl += __shfl_xor(dl, 2);
    qn += __shfl_xor(qn, 1); qn += __shfl_xor(qn, 2);
    if (part == 0) {
      float den = dl + sRow[128 + i] * qn;
      sRow[192 + i] = 1.f / fmaxf(fabsf(den), sRow[256 + i]);
    }
  }
  __syncthreads();
#pragma unroll
  for (int t = 0; t < 2; ++t) {
    int e = nj * 64 + t * 32 + (lane & 31);
#pragma unroll
    for (int reg = 0; reg < 16; ++reg) {
      int i = mi * 32 + (reg & 3) + 8 * (reg >> 2) + 4 * (lane >> 5);
      float o = acc1[t][reg] + sRow[128 + i] * acc2[t][reg];
      if (mixer == 1) o *= sRow[192 + i];
      sO[i * 132 + e] = o;
    }
  }
  __syncthreads();
  {
    int i = tid >> 2, part = tid & 3;
    float ss = 0.f;
#pragma unroll 4
    for (int e = part * 32; e < part * 32 + 32; ++e) { float v = sO[i * 132 + e]; ss += v * v; }
    ss += __shfl_xor(ss, 1); ss += __shfl_xor(ss, 2);
    float rstd = rsqrtf(ss * (1.f / 128.f) + EPS);
    if (i < L) {
      size_t ro = (size_t)(it.row0 + i) * 512 + h * 128 + part * 32;
      const float* so = sO + i * 132 + part * 32;
      if (mixer == 0) {
        bfu* y = (bfu*)(P.ws + SLOT(5)) + ro;
        const float* g = P.g_ret_gn + h * 128 + part * 32;
        uint4 gv[4];
#pragma unroll
        for (int k = 0; k < 4; ++k) gv[k] = *(const uint4*)(y + k * 8);
#pragma unroll
        for (int k = 0; k < 4; ++k) {
          float gt[8], o[8];
          unpack8(gv[k], gt);
#pragma unroll
          for (int j = 0; j < 8; ++j) o[j] = gt[j] * sigmoidf_(gt[j]) * so[k * 8 + j] * rstd * g[k * 8 + j];
          *(uint4*)(y + k * 8) = pack8(o);
        }
      } else {
        bfu* y = (bfu*)(P.ws + SLOT(8)) + ro;
        const bfu* cc = (const bfu*)(P.ws + SLOT(0)) + ro;
        const float* g = P.g_ml_gn + h * 128 + part * 32;
        const float* ws = P.w_skip + h * 128 + part * 32;
        uint4 gv[4], cv[4];
#pragma unroll
        for (int k = 0; k < 4; ++k) { gv[k] = *(const uint4*)(y + k * 8); cv[k] = *(const uint4*)(cc + k * 8); }
#pragma unroll
        for (int k = 0; k < 4; ++k) {
          float gt[8], c8[8], o[8];
          unpack8(gv[k], gt); unpack8(cv[k], c8);
#pragma unroll
          for (int j = 0; j < 8; ++j) o[j] = sigmoidf_(gt[j]) * (so[k * 8 + j] * rstd * g[k * 8 + j] + ws[k * 8 + j] * c8[j]);
          *(uint4*)(y + k * 8) = pack8(o);
        }
      }
    }
  }
  __syncthreads();
}

__device__ void phase_merge(const Params& P, char* smem) {
  bfu* sA = (bfu*)smem; bfu* sB = sA + 128 * 72;
  const bfu* yr = (const bfu*)(P.ws + SLOT(5)); const bfu* ym = (const bfu*)(P.ws + SLOT(8));
  const bfu* gr = (const bfu*)(P.ws + SLOT(9)); const bfu* gm = (const bfu*)(P.ws + SLOT(11));
  bfu* mg = (bfu*)(P.ws + SLOT(6));
  for (int t = blockIdx.x; t < 260 * 8; t += gridDim.x) {
    int mt, nt; tile_map(t, 260, 8, mt, nt);
    f32x16 acc[2][2]; zero_acc(acc);
    bfu* sT = (bfu*)smem;
    const size_t tbase = (size_t)mt * 128 * 1024 + nt * 128;
    uint4 t1[8];
    gemm_acc(acc, yr + (size_t)mt * 128 * 512, 512, (const bfu*)(P.ws + O_WT_UPR) + (size_t)nt * 128 * 512, 512, 512, sA, sB);
    __syncthreads();
    stage_rm(sT, acc, 1.f);
    __syncthreads();
#pragma unroll
    for (int i = 0; i < 8; ++i) {
      int id = threadIdx.x + i * 256, row = id >> 4, c8 = (id & 15) * 8;
      float a[8], g[8];
      unpack8(*(const uint4*)(sT + row * ST_LD + c8), a);
      unpack8(*(const uint4*)(gr + tbase + (size_t)row * 1024 + c8), g);
#pragma unroll
      for (int j = 0; j < 8; ++j) a[j] *= sigmoidf_(g[j]);
      t1[i] = pack8(a);
    }
    zero_acc(acc);
    gemm_acc(acc, ym + (size_t)mt * 128 * 512, 512, (const bfu*)(P.ws + O_WT_UPM) + (size_t)nt * 128 * 512, 512, 512, sA, sB);
    __syncthreads();
    stage_rm(sT, acc, 1.f);
    __syncthreads();
#pragma unroll
    for (int i = 0; i < 8; ++i) {
      int id = threadIdx.x + i * 256, row = id >> 4, c8 = (id & 15) * 8;
      float a[8], g[8], t[8];
      unpack8(*(const uint4*)(sT + row * ST_LD + c8), a);
      unpack8(*(const uint4*)(gm + tbase + (size_t)row * 1024 + c8), g);
      unpack8(t1[i], t);
#pragma unroll
      for (int j = 0; j < 8; ++j) a[j] = t[j] + a[j] * sigmoidf_(g[j]);
      *(uint4*)(mg + tbase + (size_t)row * 1024 + c8) = pack8(a);
    }
  }
}

__device__ void phase_outproj(const Params& P, char* smem) {
  bfu* sA = (bfu*)smem; bfu* sB = sA + 128 * 72;
  const bfu* mg = (const bfu*)(P.ws + SLOT(6));
  for (int t = blockIdx.x; t < 260 * 8; t += gridDim.x) {
    int mt, nt; tile_map(t, 260, 8, mt, nt);
    f32x16 acc[2][2]; zero_acc(acc);
    gemm_acc(acc, mg + (size_t)mt * 128 * 1024, 1024, (const bfu*)(P.ws + O_WT_OUT) + (size_t)nt * 128 * 1024, 1024, 1024, sA, sB);
    float* sT32 = (float*)smem;
    __syncthreads();
    {
      EPI_BEGIN
#pragma unroll
        for (int j = 0; j < 4; ++j) {
          sT32[(r0 + j) * ST32_LD + cl] = acc[mi][0][q * 4 + j];
          sT32[(r0 + j) * ST32_LD + cl + 64] = acc[mi][1][q * 4 + j];
        }
      EPI_END
    }
    __syncthreads();
#pragma unroll
    for (int i = 0; i < 16; ++i) {
      int id = threadIdx.x + i * 256, row = id >> 5, c4 = (id & 31) * 4;
      int r = mt * 128 + row;
      float4 a = *(const float4*)(sT32 + row * ST32_LD + c4);
      float4 x = *(const float4*)(xrow(P, r) + nt * 128 + c4);
      *(float4*)(P.out + (size_t)r * 1024 + nt * 128 + c4) = make_float4(x.x + a.x, x.y + a.y, x.z + a.z, x.w + a.w);
    }
  }
}

__device__ void phase_norm_rows(const Params& P, const float* g, bfu* dst) {
  const int lane = threadIdx.x & 63, w = threadIdx.x >> 6;
  for (int r = blockIdx.x * 4 + w; r < MT; r += gridDim.x * 4) {
    const float* xr = P.out + (size_t)r * 1024;
    float4 v[4]; float ss = 0.f;
#pragma unroll
    for (int i = 0; i < 4; ++i) {
      v[i] = *(const float4*)(xr + i * 256 + lane * 4);
      ss += v[i].x * v[i].x + v[i].y * v[i].y + v[i].z * v[i].z + v[i].w * v[i].w;
    }
    ss = wave_sum(ss);
    float rstd = rsqrtf(ss * (1.f / 1024.f) + EPS);
#pragma unroll
    for (int i = 0; i < 4; ++i) {
      float4 gg = *(const float4*)(g + i * 256 + lane * 4);
      uint2 o; o.x = pack2(v[i].x * rstd * gg.x, v[i].y * rstd * gg.y); o.y = pack2(v[i].z * rstd * gg.z, v[i].w * rstd * gg.w);
      *(uint2*)(dst + (size_t)r * 1024 + i * 256 + lane * 4) = o;
    }
  }
}

__device__ void phase_pq(const Params& P, char* smem) {
  bfu* sA = (bfu*)smem; bfu* sB = sA + 128 * 72;
  const bfu* hq = (const bfu*)(P.ws + SLOT(0));
  bfu* qb = (bfu*)(P.ws + SLOT(9));
  for (int t = blockIdx.x; t < 260 * 16; t += gridDim.x) {
    int mt, nt; tile_map(t, 260, 16, mt, nt);
    f32x16 acc[2][2]; zero_acc(acc);
    gemm_acc(acc, hq + (size_t)mt * 128 * 1024, 1024, (const bfu*)(P.ws + O_WT_PQ) + (size_t)nt * 128 * 1024, 1024, 1024, sA, sB);
    bfu* sT = (bfu*)smem;
    __syncthreads();
    stage_rm(sT, acc, 1.f);
    __syncthreads();
    copyout_bf16(sT, qb + (size_t)mt * 128 * 2048 + nt * 128, 2048);
  }
}


template <bool DESC> __device__ __forceinline__ void cex(float& a, float& b) {
  float mx = fmaxf(a, b), mn = fminf(a, b);
  a = DESC ? mx : mn; b = DESC ? mn : mx;
}
template <int B, bool DESC> __device__ __forceinline__ void bmerge16(float (&v)[64]) {
#pragma unroll
  for (int j = 8; j > 0; j >>= 1)
#pragma unroll
    for (int i = 0; i < 16; ++i) { int l = i ^ j; if (l > i) cex<DESC>(v[B + i], v[B + l]); }
}
template <int B, bool DESC> __device__ __forceinline__ void bsort16(float (&v)[64]) {
#pragma unroll
  for (int k = 2; k <= 16; k <<= 1)
#pragma unroll
    for (int j = k >> 1; j > 0; j >>= 1)
#pragma unroll
      for (int i = 0; i < 16; ++i) {
        int l = i ^ j;
        if (l > i) {
          bool up = ((i & k) == 0) || (k == 16);
          if (up == true) { if (DESC) cex<true>(v[B + i], v[B + l]); else cex<false>(v[B + i], v[B + l]); }
          else { if (DESC) cex<false>(v[B + i], v[B + l]); else cex<true>(v[B + i], v[B + l]); }
        }
      }
}
__device__ __forceinline__ float pair_max(float v) {
  auto r = __builtin_amdgcn_permlane32_swap(__float_as_int(v), __float_as_int(v), false, false);
  return fmaxf(__int_as_float(r[0]), __int_as_float(r[1]));
}
__device__ void phase_topk(const Params& P, char* smem) {
  const int tid = threadIdx.x, lane = tid & 63, w = tid >> 6, r32 = lane & 31, hh = lane >> 5;
  unsigned* sL = (unsigned*)smem + w * 1664;
  unsigned* sW = sL + 32 * 33;
  const bfu* qb = (const bfu*)(P.ws + SLOT(9));
  const bfu* keys = (const bfu*)(P.ws + O_KEYS);
  int* ids = (int*)(P.ws + SLOT(4));
  float* gw = (float*)(P.ws + SLOT(13));
  for (int item = blockIdx.x * 4 + w; item < 1040 * 8; item += gridDim.x * 4) {
    const int tg = item >> 3, n = item & 7, rowb = tg * 32;
#pragma unroll 1
    for (int half = 0; half < 2; ++half) {
      f32x16 acc[4];
#pragma unroll
      for (int c = 0; c < 4; ++c)
#pragma unroll
        for (int i = 0; i < 16; ++i) acc[c][i] = 0.f;
      const bfu* kp = keys + (size_t)((n * 2 + half) * 128 + r32) * 128 + hh * 8;
      const bfu* qp = qb + (size_t)(rowb + r32) * 2048 + n * 256 + half * 128 + hh * 8;
#pragma unroll
      for (int ks = 0; ks < 8; ++ks) {
        bf16x8 bfr = *(const bf16x8*)(qp + ks * 16);
#pragma unroll
        for (int c = 0; c < 4; ++c) {
          bf16x8 af = *(const bf16x8*)(kp + (size_t)c * 32 * 128 + ks * 16);
          acc[c] = __builtin_amdgcn_mfma_f32_32x32x16_bf16(af, bfr, acc[c], 0, 0, 0);
        }
      }
      float kk[64];
#pragma unroll
      for (int c = 0; c < 4; ++c)
#pragma unroll
        for (int reg = 0; reg < 16; ++reg) {
          unsigned kidx = c * 32 + (reg & 3) + 8 * (reg >> 2) + 4 * hh;
          kk[c * 16 + reg] = __uint_as_float((__float_as_uint(acc[c][reg]) & ~127u) | kidx);
        }
      bsort16<0, true>(kk); bsort16<16, false>(kk); bsort16<32, false>(kk); bsort16<48, true>(kk);
#pragma unroll
      for (int i = 0; i < 16; ++i) { kk[i] = fmaxf(kk[i], kk[16 + i]); kk[32 + i] = fmaxf(kk[32 + i], kk[48 + i]); }
      bmerge16<0, true>(kk); bmerge16<32, false>(kk);
#pragma unroll
      for (int i = 0; i < 16; ++i) kk[i] = fmaxf(kk[i], kk[32 + i]);
      bmerge16<0, true>(kk);
      {
        float lo[16], hi[16];
#pragma unroll
        for (int i = 0; i < 16; ++i) {
          auto r = __builtin_amdgcn_permlane32_swap(__float_as_int(kk[i]), __float_as_int(kk[i]), false, false);
          lo[i] = __int_as_float(r[0]); hi[i] = __int_as_float(r[1]);
        }
#pragma unroll
        for (int i = 0; i < 16; ++i) kk[i] = fmaxf(lo[i], hi[15 - i]);
      }
      bmerge16<0, true>(kk);
      if (hh == 0) {
#pragma unroll
        for (int p = 0; p < 16; ++p) sL[r32 * 33 + half * 16 + p] = __float_as_uint(kk[p]);
      }
    }
    __builtin_amdgcn_fence(__ATOMIC_RELEASE, "workgroup");
    __builtin_amdgcn_wave_barrier();
    __builtin_amdgcn_fence(__ATOMIC_ACQUIRE, "workgroup");
    float x[4], y[16];
    {
      const unsigned* lx = sL + r32 * 33 + (hh ? 16 : 0);
      const unsigned* ly = sL + r32 * 33 + (hh ? 0 : 16);
#pragma unroll
      for (int i = 0; i < 4; ++i) x[i] = __uint_as_float(lx[i] & ~127u);
#pragma unroll
      for (int j = 0; j < 16; ++j) y[j] = __uint_as_float(ly[j] & ~127u);
    }
    float cd[25];
#define CAND(t, i, j) { float sv = x[i] + y[j]; unsigned code = hh ? ((j) << 4 | (i)) : ((i) << 4 | (j)); \
      cd[t] = __uint_as_float((__float_as_uint(sv) & ~255u) | code); }
    CAND(0, 0, 1) CAND(1, 0, 2) CAND(2, 0, 3) CAND(3, 0, 4) CAND(4, 0, 5) CAND(5, 0, 6) CAND(6, 0, 7) CAND(7, 0, 8)
    CAND(8, 0, 9) CAND(9, 0, 10) CAND(10, 0, 11) CAND(11, 0, 12) CAND(12, 0, 13) CAND(13, 0, 14) CAND(14, 0, 15)
    CAND(15, 1, 2) CAND(16, 1, 3) CAND(17, 1, 4) CAND(18, 1, 5) CAND(19, 1, 6) CAND(20, 1, 7) CAND(21, 2, 3) CAND(22, 2, 4)
    {
      float d0 = hh ? x[2] + y[2] : x[0] + y[0];
      float d1 = hh ? x[3] + y[3] : x[1] + y[1];
      unsigned c0 = hh ? 0x22u : 0x00u, c1 = hh ? 0x33u : 0x11u;
      cd[23] = __uint_as_float((__float_as_uint(d0) & ~255u) | c0);
      cd[24] = __uint_as_float((__float_as_uint(d1) & ~255u) | c1);
    }
    {
      float cv[64];
#pragma unroll
      for (int t = 0; t < 25; ++t) cv[t] = cd[t];
#pragma unroll
      for (int t = 25; t < 32; ++t) cv[t] = -INFINITY;
      bsort16<0, true>(cv); bsort16<16, false>(cv);
#pragma unroll
      for (int i = 0; i < 16; ++i) cv[i] = fmaxf(cv[i], cv[16 + i]);
      bmerge16<0, true>(cv);
      {
        float lo[16], hi[16];
#pragma unroll
        for (int i = 0; i < 16; ++i) {
          auto r = __builtin_amdgcn_permlane32_swap(__float_as_int(cv[i]), __float_as_int(cv[i]), false, false);
          lo[i] = __int_as_float(r[0]); hi[i] = __int_as_float(r[1]);
        }
#pragma unroll
        for (int i = 0; i < 16; ++i) cv[i] = fmaxf(lo[i], hi[15 - i]);
      }
      bmerge16<0, true>(cv);
      if (hh == 0) {
#pragma unroll
        for (int p = 0; p < 16; ++p) sW[r32 * 17 + p] = __float_as_uint(cv[p]);
      }
    }
    __builtin_amdgcn_fence(__ATOMIC_RELEASE, "workgroup");
    __builtin_amdgcn_wave_barrier();
    __builtin_amdgcn_fence(__ATOMIC_ACQUIRE, "workgroup");
    {
      const unsigned* la = sL + r32 * 33;
      unsigned c0 = sW[r32 * 17] & 255u;
      float scmax = __uint_as_float(la[c0 >> 4] & ~127u) + __uint_as_float(la[16 + (c0 & 15)] & ~127u);
      float ex[8]; int ee[8]; float sum = 0.f;
#pragma unroll
      for (int k = 0; k < 8; ++k) {
        unsigned code = sW[r32 * 17 + hh * 8 + k] & 255u;
        unsigned ka = la[code >> 4], kb = la[16 + (code & 15)];
        float sc = __uint_as_float(ka & ~127u) + __uint_as_float(kb & ~127u);
        ex[k] = __expf(sc - scmax);
        ee[k] = (int)((ka & 127u) * 128u + (kb & 127u));
        sum += ex[k];
      }
      sum += __shfl_xor(sum, 32);
      float inv = 1.f / sum;
      size_t o = (size_t)(rowb + r32) * 128 + n * 16 + hh * 8;
      *(int4*)(ids + o) = make_int4(ee[0], ee[1], ee[2], ee[3]);
      *(int4*)(ids + o + 4) = make_int4(ee[4], ee[5], ee[6], ee[7]);
      *(float4*)(gw + o) = make_float4(ex[0] * inv, ex[1] * inv, ex[2] * inv, ex[3] * inv);
      *(float4*)(gw + o + 4) = make_float4(ex[4] * inv, ex[5] * inv, ex[6] * inv, ex[7] * inv);
    }
    __builtin_amdgcn_wave_barrier();
  }
}

typedef float f2v __attribute__((ext_vector_type(2)));
#define U8_SCALE 512.f
#define V8_SCALE 128.f
__device__ void convert_fp8(const float* __restrict__ src, unsigned char* __restrict__ dst, size_t n16, float scale,
                            int gtid, int gstride) {
  for (size_t i = gtid; i < n16; i += gstride) {
    unsigned w[4];
#pragma unroll
    for (int k = 0; k < 4; ++k) {
      float4 a = *(const float4*)(src + i * 16 + k * 4);
      float v0 = fminf(fmaxf(a.x * scale, -448.f), 448.f), v1 = fminf(fmaxf(a.y * scale, -448.f), 448.f);
      float v2 = fminf(fmaxf(a.z * scale, -448.f), 448.f), v3 = fminf(fmaxf(a.w * scale, -448.f), 448.f);
      int t = 0;
      t = __builtin_amdgcn_cvt_pk_fp8_f32(v0, v1, t, false);
      t = __builtin_amdgcn_cvt_pk_fp8_f32(v2, v3, t, true);
      w[k] = (unsigned)t;
    }
    *(uint4*)(dst + i * 16) = make_uint4(w[0], w[1], w[2], w[3]);
  }
}
__device__ __forceinline__ float dot16_fp8(uint4 u, const f2v* x2) {
  f2v acc = __builtin_amdgcn_cvt_pk_f32_fp8((int)u.x, false) * x2[0];
  acc += __builtin_amdgcn_cvt_pk_f32_fp8((int)u.x, true) * x2[1];
  acc += __builtin_amdgcn_cvt_pk_f32_fp8((int)u.y, false) * x2[2];
  acc += __builtin_amdgcn_cvt_pk_f32_fp8((int)u.y, true) * x2[3];
  acc += __builtin_amdgcn_cvt_pk_f32_fp8((int)u.z, false) * x2[4];
  acc += __builtin_amdgcn_cvt_pk_f32_fp8((int)u.z, true) * x2[5];
  acc += __builtin_amdgcn_cvt_pk_f32_fp8((int)u.w, false) * x2[6];
  acc += __builtin_amdgcn_cvt_pk_f32_fp8((int)u.w, true) * x2[7];
  return acc.x + acc.y;
}
__device__ __forceinline__ void axpy16_fp8(f2v* o2, float cf, uint4 v) {
  f2v c = {cf, cf};
  o2[0] += c * __builtin_amdgcn_cvt_pk_f32_fp8((int)v.x, false);
  o2[1] += c * __builtin_amdgcn_cvt_pk_f32_fp8((int)v.x, true);
  o2[2] += c * __builtin_amdgcn_cvt_pk_f32_fp8((int)v.y, false);
  o2[3] += c * __builtin_amdgcn_cvt_pk_f32_fp8((int)v.y, true);
  o2[4] += c * __builtin_amdgcn_cvt_pk_f32_fp8((int)v.z, false);
  o2[5] += c * __builtin_amdgcn_cvt_pk_f32_fp8((int)v.z, true);
  o2[6] += c * __builtin_amdgcn_cvt_pk_f32_fp8((int)v.w, false);
  o2[7] += c * __builtin_amdgcn_cvt_pk_f32_fp8((int)v.w, true);
}
#define PEER_LOAD(u, v, b)                                                                   \
  _Pragma("unroll") for (int k = 0; k < 8; ++k) {                                            \
    int j = (b) * 8 + k;                                                                     \
    int e = __builtin_amdgcn_readlane((b) < 8 ? id0 : id1, j & 63);                          \
    u[k] = *(const uint4*)(U8 + (size_t)e * 1024 + lane * 16);                               \
    v[k] = *(const uint4*)(V8 + (size_t)e * 1024 + lane * 16);                               \
  }
#define PEER_COMP(u, v, b)                                                                   \
  _Pragma("unroll") for (int hf = 0; hf < 2; ++hf) {                                         \
    float s = reduce4(dot16_fp8(u[hf * 4 + 0], x2), dot16_fp8(u[hf * 4 + 1], x2),           \
                      dot16_fp8(u[hf * 4 + 2], x2), dot16_fp8(u[hf * 4 + 3], x2)) * (1.f / U8_SCALE); \
    float act = 0.5f * s * (1.f + erff(s * 0.7071067811865475f));                            \
    float gsel = __shfl((b) < 8 ? g0 : g1, ((b) * 8 + hf * 4 + (lane >> 4)) & 63);           \
    float cfv = act * gsel * (1.f / V8_SCALE);                                               \
    axpy16_fp8(o2, __int_as_float(__builtin_amdgcn_readlane(__float_as_int(cfv), 0)), v[hf * 4 + 0]);  \
    axpy16_fp8(o2, __int_as_float(__builtin_amdgcn_readlane(__float_as_int(cfv), 16)), v[hf * 4 + 1]); \
    axpy16_fp8(o2, __int_as_float(__builtin_amdgcn_readlane(__float_as_int(cfv), 32)), v[hf * 4 + 2]); \
    axpy16_fp8(o2, __int_as_float(__builtin_amdgcn_readlane(__float_as_int(cfv), 48)), v[hf * 4 + 3]); \
  }
__device__ void phase_peer(const Params& P) {
  const int lane = threadIdx.x & 63, w = threadIdx.x >> 6;
  bfu* hq = (bfu*)(P.ws + SLOT(0));
  const unsigned char* U8 = (const unsigned char*)(P.ws + SLOT(2));
  const unsigned char* V8 = (const unsigned char*)(P.ws + SLOT(3));
  const int* ids = (const int*)(P.ws + SLOT(4));
  const float* gw = (const float*)(P.ws + SLOT(13));
  bfu* pbf = (bfu*)(P.ws + SLOT(6));
  for (int r = blockIdx.x * 4 + w; r < MT; r += gridDim.x * 4) {
    f2v x2[8], o2[8];
    {
      uint4 v0 = *(const uint4*)(hq + (size_t)r * 1024 + lane * 16);
      uint4 v1 = *(const uint4*)(hq + (size_t)r * 1024 + lane * 16 + 8);
      float xf[16];
      unpack8(v0, xf); unpack8(v1, xf + 8);
#pragma unroll
      for (int j = 0; j < 8; ++j) { x2[j].x = xf[2 * j]; x2[j].y = xf[2 * j + 1]; o2[j].x = 0.f; o2[j].y = 0.f; }
    }
    int id0 = ids[(size_t)r * 128 + lane], id1 = ids[(size_t)r * 128 + 64 + lane];
    float g0 = gw[(size_t)r * 128 + lane], g1 = gw[(size_t)r * 128 + 64 + lane];
    uint4 uA[8], vA[8], uB[8], vB[8];
    PEER_LOAD(uA, vA, 0)
    for (int b = 0; b < 16; b += 2) {
      PEER_LOAD(uB, vB, b + 1)
      PEER_COMP(uA, vA, b)
      if (b + 2 < 16) { PEER_LOAD(uA, vA, b + 2) }
      PEER_COMP(uB, vB, b + 1)
    }
    float* xr = P.out + (size_t)r * 1024 + lane * 16;
    float x3[16];
    float ss = 0.f;
#pragma unroll
    for (int k = 0; k < 4; ++k) {
      float4 a = *(const float4*)(xr + k * 4);
      x3[k * 4 + 0] = a.x + o2[k * 2].x; x3[k * 4 + 1] = a.y + o2[k * 2].y;
      x3[k * 4 + 2] = a.z + o2[k * 2 + 1].x; x3[k * 4 + 3] = a.w + o2[k * 2 + 1].y;
      *(float4*)(xr + k * 4) = make_float4(x3[k * 4], x3[k * 4 + 1], x3[k * 4 + 2], x3[k * 4 + 3]);
    }
#pragma unroll
    for (int j = 0; j < 16; ++j) ss += x3[j] * x3[j];
    ss = wave_sum(ss);
    float rstd = rsqrtf(ss * (1.f / 1024.f) + EPS);
    float hv[16];
#pragma unroll
    for (int k = 0; k < 4; ++k) {
      float4 ga = *(const float4*)(P.g_ple + lane * 16 + k * 4);
      hv[k * 4] = x3[k * 4] * rstd * ga.x; hv[k * 4 + 1] = x3[k * 4 + 1] * rstd * ga.y;
      hv[k * 4 + 2] = x3[k * 4 + 2] * rstd * ga.z; hv[k * 4 + 3] = x3[k * 4 + 3] * rstd * ga.w;
    }
    *(uint4*)(hq + (size_t)r * 1024 + lane * 16) = pack8(hv);
    *(uint4*)(hq + (size_t)r * 1024 + lane * 16 + 8) = pack8(hv + 8);
    {
      const float* pr = r < MP ? P.pp + (size_t)r * 256 : P.ps + (size_t)(r - MP) * 256;
      float4 a = *(const float4*)(pr + lane * 4);
      uint2 ov; ov.x = pack2(a.x, a.y); ov.y = pack2(a.z, a.w);
      *(uint2*)(pbf + (size_t)r * 256 + lane * 4) = ov;
    }
  }
}

__device__ void phase_ple(const Params& P, char* smem) {
  bfu* sA = (bfu*)smem; bfu* sB = sA + 128 * 72;
  const bfu* hg = (const bfu*)(P.ws + SLOT(0));
  const bfu* pbf = (const bfu*)(P.ws + SLOT(6));
  for (int t = blockIdx.x; t < 260 * 8; t += gridDim.x) {
    int mt, nt; tile_map(t, 260, 8, mt, nt);
    f32x16 acc[2][2]; zero_acc(acc);
    bfu* sT = (bfu*)smem; float* sT32 = (float*)smem;
    uint2 pg[16];
    gemm_acc(acc, hg + (size_t)mt * 128 * 1024, 1024, (const bfu*)(P.ws + O_WT_PG) + (size_t)nt * 128 * 1024, 1024, 1024, sA, sB);
    __syncthreads();
    {
      EPI_BEGIN
#pragma unroll
        for (int j = 0; j < 4; ++j) {
          sT[(r0 + j) * ST_LD + cl] = f2bf(sigmoidf_(acc[mi][0][q * 4 + j]));
          sT[(r0 + j) * ST_LD + cl + 64] = f2bf(sigmoidf_(acc[mi][1][q * 4 + j]));
        }
      EPI_END
    }
    __syncthreads();
#pragma unroll
    for (int i = 0; i < 16; ++i) {
      int id = threadIdx.x + i * 256, row = id >> 5, c4 = (id & 31) * 4;
      pg[i] = *(const uint2*)(sT + row * ST_LD + c4);
    }
    zero_acc(acc);
    gemm_acc(acc, pbf + (size_t)mt * 128 * 256, 256, (const bfu*)(P.ws + O_WT_PLE) + (size_t)nt * 128 * 256, 256, 256, sA, sB);
    __syncthreads();
    {
      EPI_BEGIN
#pragma unroll
        for (int j = 0; j < 4; ++j) {
          sT32[(r0 + j) * ST32_LD + cl] = acc[mi][0][q * 4 + j];
          sT32[(r0 + j) * ST32_LD + cl + 64] = acc[mi][1][q * 4 + j];
        }
      EPI_END
    }
    __syncthreads();
#pragma unroll
    for (int i = 0; i < 16; ++i) {
      int id = threadIdx.x + i * 256, row = id >> 5, c4 = (id & 31) * 4;
      float4 a = *(const float4*)(sT32 + row * ST32_LD + c4);
      float* op = P.out + (size_t)(mt * 128 + row) * 1024 + nt * 128 + c4;
      float4 x = *(const float4*)op;
      float g0 = bf2f(pg[i].x & 0xffff), g1 = bf2f(pg[i].x >> 16), g2 = bf2f(pg[i].y & 0xffff), g3 = bf2f(pg[i].y >> 16);
      *(float4*)op = make_float4(x.x + a.x * g0, x.y + a.y * g1, x.z + a.z * g2, x.w + a.w * g3);
    }
  }
}

__device__ void phase_final(const Params& P) {
  const int lane = threadIdx.x & 63, w = threadIdx.x >> 6;
  for (int r = blockIdx.x * 4 + w; r < MT; r += gridDim.x * 4) {
    float* xr = P.out + (size_t)r * 1024;
    float4 v[4]; float ss = 0.f;
#pragma unroll
    for (int i = 0; i < 4; ++i) {
      v[i] = *(const float4*)(xr + i * 256 + lane * 4);
      ss += v[i].x * v[i].x + v[i].y * v[i].y + v[i].z * v[i].z + v[i].w * v[i].w;
    }
    ss = wave_sum(ss);
    float rstd = rsqrtf(ss * (1.f / 1024.f) + EPS);
#pragma unroll
    for (int i = 0; i < 4; ++i) {
      float4 gg = *(const float4*)(P.g_final + i * 256 + lane * 4);
      *(float4*)(xr + i * 256 + lane * 4) = make_float4(v[i].x * rstd * gg.x, v[i].y * rstd * gg.y, v[i].z * rstd * gg.z, v[i].w * rstd * gg.w);
    }
  }
}

__global__ void __launch_bounds__(NTHREADS, 2) fwd_megakernel(Params P) {
  extern __shared__ __attribute__((aligned(16))) char smem[];
  cg::grid_group grid = cg::this_grid();
  __shared__ uint4 xb_words;
  if (threadIdx.x == 0) xb_words = make_uint4(0u, 0u, 0u, 0u);
  __syncthreads();
  XcdBarrier xb = xcd_barrier_post((unsigned*)(P.ws + O_BAR), (volatile LAS unsigned*)&xb_words);
  if (P.out == nullptr) grid.sync();
  const int gtid = blockIdx.x * NTHREADS + threadIdx.x, gstride = gridDim.x * NTHREADS;
  phase_prep(P, smem);
  xcd_barrier(xb);
  phase_gemm1(P, smem);
  xcd_barrier(xb);
  phase_conv(P);
  gate_scan(P);
  xcd_barrier(xb);
  m_fold(P);
  phase_mqk(P, smem);
  xcd_barrier(xb);
  for (int t = blockIdx.x; t < 4224; t += gridDim.x) phaseA_item(P, t / 2112, t % 2112, smem);
  xcd_barrier(xb);
  phase_scan(P);
  xcd_barrier(xb);
  for (int t = blockIdx.x; t < 4224; t += gridDim.x) phaseC_item(P, t / 2112, t % 2112, smem);
  xcd_barrier(xb);
  phase_merge(P, smem);
  xcd_barrier(xb);
  phase_outproj(P, smem);
  xcd_barrier(xb);
  phase_norm_rows(P, P.g_ffn, (bfu*)(P.ws + SLOT(0)));
  convert_fp8(P.peer_u, (unsigned char*)(P.ws + SLOT(2)), 16384ull * 1024 / 16, U8_SCALE, gtid, gstride);
  convert_fp8(P.peer_v, (unsigned char*)(P.ws + SLOT(3)), 16384ull * 1024 / 16, V8_SCALE, gtid, gstride);
  xcd_barrier(xb);
  phase_pq(P, smem);
  xcd_barrier(xb);
  phase_topk(P, smem);
  xcd_barrier(xb);
  phase_peer(P);
  xcd_barrier(xb);
  phase_ple(P, smem);
  xcd_barrier(xb);
  phase_final(P);
}

extern "C" void kernel_launch(void* const* d_in, const int* in_sizes, int n_in, void* d_out, int out_size,
                              void* d_ws, size_t ws_size, hipStream_t stream) {
  static int grid_blocks = 0;
  if (!grid_blocks) {
    hipFuncSetAttribute((const void*)fwd_megakernel, hipFuncAttributeMaxDynamicSharedMemorySize, SMEM_BYTES);
    int dev = 0, cus = 0, per_cu = 0;
    hipGetDevice(&dev);
    hipDeviceGetAttribute(&cus, hipDeviceAttributeMultiprocessorCount, dev);
    hipOccupancyMaxActiveBlocksPerMultiprocessor(&per_cu, fwd_megakernel, NTHREADS, SMEM_BYTES);
    if (per_cu > 2) per_cu = 2;
    if (per_cu < 1) per_cu = 1;
    grid_blocks = cus * per_cu;
  }
  Params p{};
  const float** pf = (const float**)&p;
  for (int i = 0; i < 32; ++i) pf[i] = (const float*)d_in[i];
  p.out = (float*)d_out;
  p.ws = (char*)d_ws;
  hipMemsetAsync((char*)d_ws + O_BAR, 0, XCD_BAR_WORDS * 4, stream);
  void* args[] = {&p};
  hipError_t e = hipLaunchCooperativeKernel((void*)fwd_megakernel, dim3(grid_blocks), dim3(NTHREADS), args, SMEM_BYTES, stream);
  if (e != hipSuccess) fprintf(stderr, "cooperative launch failed: %s (grid %d)\n", hipGetErrorString(e), grid_blocks);
}
```

```cpp
#include <hip/hip_runtime.h>
#include <hip/hip_cooperative_groups.h>
#include <cstdio>
namespace cg = cooperative_groups;

typedef unsigned short bfu;
typedef __attribute__((ext_vector_type(8))) short bf16x8;
typedef __attribute__((ext_vector_type(16))) float f32x16;

#define MT 33280
#define MP 32768
#define NTHREADS 256
#define EPS 1e-6f

struct Params {
  const float *xp, *xs, *pp, *ps, *st_ret, *st_C, *st_n, *st_m, *st_conv, *g_mix, *w_in, *g_ret_gn, *w_mq,
      *w_mk, *conv_w, *conv_b, *b_i, *b_f, *g_ml_gn, *w_skip, *w_up_r, *w_up_m, *w_out, *g_ffn, *w_pq,
      *peer_keys, *peer_u, *peer_v, *g_ple, *w_pg, *w_ple, *g_final;
  float* out;
  char* ws;
};

constexpr size_t O_WT_IN = 0;
constexpr size_t O_WT_UPR = O_WT_IN + 5632ull * 1024 * 2;
constexpr size_t O_WT_UPM = O_WT_UPR + 1024ull * 512 * 2;
constexpr size_t O_WT_OUT = O_WT_UPM + 1024ull * 512 * 2;
constexpr size_t O_WT_PQ = O_WT_OUT + 1024ull * 1024 * 2;
constexpr size_t O_WT_PG = O_WT_PQ + 2048ull * 1024 * 2;
constexpr size_t O_WT_PLE = O_WT_PG + 1024ull * 1024 * 2;
constexpr size_t O_KEYS = O_WT_PLE + 1024ull * 256 * 2;
constexpr size_t O_WT_MQ = O_KEYS + 16ull * 128 * 128 * 2;
constexpr size_t O_WT_MK = O_WT_MQ + 4ull * 128 * 128 * 2;
constexpr size_t O_COS = O_WT_MK + 4ull * 128 * 128 * 2;
constexpr size_t O_SIN = O_COS + 8192ull * 64 * 4;
constexpr size_t O_FQ = O_SIN + 8192ull * 64 * 4;
constexpr size_t O_UQ = O_FQ + (size_t)MT * 16;
constexpr size_t O_CMQ = O_UQ + (size_t)MT * 16;
constexpr size_t O_FL = O_CMQ + (size_t)MT * 16;
constexpr size_t O_UC = O_FL + 16384;
constexpr size_t O_AEND = O_UC + 16384;
constexpr size_t O_MCS = O_AEND + 16384;
constexpr size_t O_DN = O_MCS + 16384;
constexpr size_t O_DSS = O_DN + 2112ull * 128 * 4;
constexpr size_t O_GPRE = O_DSS + 2ull * 64 * 16384 * 2;
constexpr size_t O_BAR = O_GPRE + (size_t)MT * 32;
constexpr size_t O_SMALL_END = O_BAR + 16384;
constexpr size_t SLOT0 = 40ull << 20;
constexpr size_t USZ = (size_t)MT * 512 * 2;
static_assert(O_SMALL_END <= SLOT0, "small region overflow");
#define SLOT(i) (SLOT0 + (size_t)(i) * USZ)
constexpr size_t SB_T = 16ull * 128 * 8192;

constexpr size_t OO_Y = 0;
constexpr size_t OO_RETP = (size_t)MT * 1024;
constexpr size_t OO_CP = OO_RETP + 262144;
constexpr size_t OO_NP = OO_CP + 262144;
constexpr size_t OO_MP = OO_NP + 2048;
constexpr size_t OO_CONVP = OO_MP + 16;
constexpr size_t OO_RETS = OO_CONVP + 6144;
constexpr size_t OO_CS = OO_RETS + 1048576;
constexpr size_t OO_NS = OO_CS + 1048576;
constexpr size_t OO_MS = OO_NS + 8192;
constexpr size_t OO_CONVS = OO_MS + 64;

constexpr int SMEM_BYTES = 81152;

__device__ __forceinline__ bfu f2bf(float f) {
  unsigned u = __float_as_uint(f);
  u += 0x7fffu + ((u >> 16) & 1u);
  return (bfu)(u >> 16);
}
__device__ __forceinline__ float bf2f(bfu b) { return __uint_as_float(((unsigned)b) << 16); }
__device__ __forceinline__ unsigned pack2(float a, float b) { return (unsigned)f2bf(a) | ((unsigned)f2bf(b) << 16); }
__device__ __forceinline__ void unpack8(uint4 v, float* f) {
  f[0] = bf2f(v.x & 0xffff); f[1] = bf2f(v.x >> 16); f[2] = bf2f(v.y & 0xffff); f[3] = bf2f(v.y >> 16);
  f[4] = bf2f(v.z & 0xffff); f[5] = bf2f(v.z >> 16); f[6] = bf2f(v.w & 0xffff); f[7] = bf2f(v.w >> 16);
}
__device__ __forceinline__ uint4 pack8(const float* f) {
  uint4 o; o.x = pack2(f[0], f[1]); o.y = pack2(f[2], f[3]); o.z = pack2(f[4], f[5]); o.w = pack2(f[6], f[7]);
  return o;
}
__device__ __forceinline__ float wave_sum(float v) {
#pragma unroll
  for (int o = 32; o > 0; o >>= 1) v += __shfl_xor(v, o);
  return v;
}
__device__ __forceinline__ float wave_max(float v) {
#pragma unroll
  for (int o = 32; o > 0; o >>= 1) v = fmaxf(v, __shfl_xor(v, o));
  return v;
}
__device__ __forceinline__ float dpp_ror_add(float s, const int ctrl_sel) {
  int v = __float_as_int(s);
  int t;
  if (ctrl_sel == 8) t = __builtin_amdgcn_update_dpp(0, v, 0x128, 0xf, 0xf, false);
  else if (ctrl_sel == 4) t = __builtin_amdgcn_update_dpp(0, v, 0x124, 0xf, 0xf, false);
  else if (ctrl_sel == 2) t = __builtin_amdgcn_update_dpp(0, v, 0x122, 0xf, 0xf, false);
  else t = __builtin_amdgcn_update_dpp(0, v, 0x121, 0xf, 0xf, false);
  return s + __int_as_float(t);
}
__device__ __forceinline__ float reduce4(float p0, float p1, float p2, float p3) {
  auto r = __builtin_amdgcn_permlane32_swap(__float_as_int(p0), __float_as_int(p2), false, false);
  float sA = __int_as_float(r[0]) + __int_as_float(r[1]);
  r = __builtin_amdgcn_permlane32_swap(__float_as_int(p1), __float_as_int(p3), false, false);
  float sB = __int_as_float(r[0]) + __int_as_float(r[1]);
  r = __builtin_amdgcn_permlane16_swap(__float_as_int(sA), __float_as_int(sB), false, false);
  float s = __int_as_float(r[0]) + __int_as_float(r[1]);
  s = dpp_ror_add(s, 8); s = dpp_ror_add(s, 4); s = dpp_ror_add(s, 2); s = dpp_ror_add(s, 1);
  return s;
}
__device__ __forceinline__ float sigmoidf_(float x) { return 1.f / (1.f + __expf(-x)); }
__device__ __forceinline__ const float* xrow(const Params& P, int r) {
  return r < MP ? P.xp + (size_t)r * 1024 : P.xs + (size_t)(r - MP) * 1024;
}


#define XB_TMO      128
#define XB_XCNT(j)  (256  + 64 * (j))
#define XB_XSUB(j)  (1280 + 64 * (j))
#define XB_XGEN(j)  (2304 + 64 * (j))
#define XB_TOP      3328
#define XB_TOPGEN   3392
#define XCD_BAR_WORDS 3456
#define XB_SPIN_CAP (1u << 22)
#define LAS __attribute__((address_space(3)))
__device__ __forceinline__ unsigned xb_ld(unsigned* p) { return __hip_atomic_load(p, __ATOMIC_RELAXED, __HIP_MEMORY_SCOPE_AGENT); }
__device__ __forceinline__ unsigned xb_add(unsigned* p, unsigned v) { return __hip_atomic_fetch_add(p, v, __ATOMIC_RELAXED, __HIP_MEMORY_SCOPE_AGENT); }
__device__ __forceinline__ unsigned xb_xcc_id() { return (unsigned)__builtin_amdgcn_s_getreg((3 << 11) | 20) & 0xFu; }
#define XB_SPIN(cond, bar) do { unsigned _sp = 0; while (cond) { __builtin_amdgcn_s_sleep(1); \
    if ((++_sp & 255u) == 0u) { if (xb_ld(&(bar)[XB_TMO])) break; if (_sp > XB_SPIN_CAP) { atomicAdd(&(bar)[XB_TMO], 1u); break; } } } } while (0)
struct XcdBarrier { unsigned* bar; unsigned x; volatile LAS unsigned* st; };
__device__ __forceinline__ XcdBarrier xcd_barrier_post(unsigned* bar, volatile LAS unsigned* st) {
  XcdBarrier b; b.bar = bar; b.x = xb_xcc_id(); b.st = st;
  if (threadIdx.x == 0) (void)xb_add(&bar[XB_XCNT(b.x)], 1u);
  return b;
}
__device__ __forceinline__ void xcd_barrier_complete(unsigned* bar, unsigned x, unsigned& nloc, unsigned& nx) {
  const unsigned G = gridDim.x * gridDim.y * gridDim.z;
  unsigned sum, cnt, mine, sp = 0u;
  for (;;) {
    sum = 0u; cnt = 0u; mine = 0u;
#pragma unroll
    for (unsigned j = 0; j < 16; ++j) { const unsigned c = xb_ld(&bar[XB_XCNT(j)]); sum += c; cnt += (c > 0u) ? 1u : 0u; mine = (j == x) ? c : mine; }
    if (sum == G) break;
    __builtin_amdgcn_s_sleep(1);
    if ((++sp & 255u) == 0u) { if (xb_ld(&bar[XB_TMO])) break; if (sp > XB_SPIN_CAP) { atomicAdd(&bar[XB_TMO], 1u); break; } }
  }
  nloc = mine > 0u ? mine : 1u; nx = cnt > 0u ? cnt : 1u;
}
__device__ __forceinline__ void xcd_barrier(const XcdBarrier& b) {
  asm volatile("s_waitcnt vmcnt(0)" ::: "memory");
  __syncthreads();
  if (threadIdx.x == 0) {
    unsigned* bar = b.bar;
    __builtin_amdgcn_s_waitcnt(0);
    unsigned nloc = b.st[0], nx = b.st[1];
    if (nloc == 0u) { xcd_barrier_complete(bar, b.x, nloc, nx); b.st[0] = nloc; b.st[1] = nx; }
    const unsigned old = xb_add(&bar[XB_XSUB(b.x)], 1u);
    const unsigned gen = old / nloc;
    if (old + 1u == (gen + 1u) * nloc) {
      __builtin_amdgcn_fence(__ATOMIC_RELEASE, "agent");
      asm volatile("s_waitcnt vmcnt(0)" ::: "memory");
      const unsigned og = xb_add(&bar[XB_TOP], 1u);
      const unsigned tg = og / nx;
      if (og + 1u == (tg + 1u) * nx) xb_add(&bar[XB_TOPGEN], 1u);
      else XB_SPIN(xb_ld(&bar[XB_TOPGEN]) == tg, bar);
      __builtin_amdgcn_fence(__ATOMIC_ACQUIRE, "agent");
      xb_add(&bar[XB_XGEN(b.x)], 1u);
      asm volatile("s_waitcnt vmcnt(0)" ::: "memory");
    } else {
      XB_SPIN(xb_ld(&bar[XB_XGEN(b.x)]) == gen, bar);
      __builtin_amdgcn_fence(__ATOMIC_ACQUIRE, "agent");
      asm volatile("s_waitcnt vmcnt(0)" ::: "memory");
    }
  }
  __syncthreads();
}

__device__ __forceinline__ void gemm_acc(f32x16 (&acc)[2][2], const bfu* __restrict__ A, int lda,
                                         const bfu* __restrict__ Bt, int ldb, int K, bfu* sA, bfu*  ) {
  const int tid = threadIdx.x, lane = tid & 63, w = tid >> 6, wm = w & 1, wn = w >> 1;
  const int lr = tid >> 3;
  const int kc = ((tid & 7) ^ ((tid >> 4) & 7)) * 8;
  const bfu* Ap = A + (size_t)lr * lda + kc;
  const bfu* Bp = Bt + (size_t)lr * ldb + kc;
  const size_t a32 = (size_t)32 * lda, b32 = (size_t)32 * ldb;
  char* sbase = (char*)sA;
  char* ldst = sbase + tid * 16;
#define GISSUE(stage, k)                                                                                       \
  _Pragma("unroll") for (int i_ = 0; i_ < 4; ++i_) {                                                           \
    __builtin_amdgcn_global_load_lds((const unsigned*)(Ap + i_ * a32 + (k)),                                   \
                                     (LAS unsigned*)(ldst + (stage) * 32768 + i_ * 4096), 16, 0, 0);           \
    __builtin_amdgcn_global_load_lds((const unsigned*)(Bp + i_ * b32 + (k)),                                   \
                                     (LAS unsigned*)(ldst + (stage) * 32768 + 16384 + i_ * 4096), 16, 0, 0);   \
  }
  const int sw = (lane >> 1) & 7, hh = lane >> 5;
  const int rowA = (wm * 64 + (lane & 31)) * 128, rowB = (wn * 32 + (lane & 31)) * 128;
  __syncthreads();
  GISSUE(0, 0)
  int cur = 0;
  for (int k0 = 0; k0 < K; k0 += 64) {
    asm volatile("s_waitcnt vmcnt(0)" ::: "memory");
    __syncthreads();
    if (k0 + 64 < K) { GISSUE(cur ^ 1, k0 + 64) }
    const char* cA = sbase + cur * 32768;
    const char* cB = cA + 16384;
    __builtin_amdgcn_s_setprio(1);
#pragma unroll
    for (int ks = 0; ks < 4; ++ks) {
      const int pos = ((2 * ks + hh) ^ sw) * 16;
      bf16x8 af[2], bfr[2];
#pragma unroll
      for (int mi = 0; mi < 2; ++mi) af[mi] = *(const bf16x8*)(cA + rowA + mi * 32 * 128 + pos);
#pragma unroll
      for (int ni = 0; ni < 2; ++ni) bfr[ni] = *(const bf16x8*)(cB + rowB + ni * 64 * 128 + pos);
#pragma unroll
      for (int mi = 0; mi < 2; ++mi)
#pragma unroll
        for (int ni = 0; ni < 2; ++ni)
          acc[mi][ni] = __builtin_amdgcn_mfma_f32_32x32x16_bf16(af[mi], bfr[ni], acc[mi][ni], 0, 0, 0);
    }
    __builtin_amdgcn_s_setprio(0);
    cur ^= 1;
  }
}
#define gemm_acc1 gemm_acc
__device__ __forceinline__ void zero_acc(f32x16 (&acc)[2][2]) {
#pragma unroll
  for (int a = 0; a < 2; ++a)
#pragma unroll
    for (int b = 0; b < 2; ++b)
#pragma unroll
      for (int i = 0; i < 16; ++i) acc[a][b][i] = 0.f;
}
#define EPI_BEGIN                                                      \
  const int e_lane = threadIdx.x & 63, e_w = threadIdx.x >> 6;         \
  const int e_wm = e_w & 1, e_wn = e_w >> 1;                            \
  const int cl = e_wn * 32 + (e_lane & 31);                             \
  _Pragma("unroll") for (int mi = 0; mi < 2; ++mi)                      \
  _Pragma("unroll") for (int q = 0; q < 4; ++q) {                       \
    const int r0 = e_wm * 64 + mi * 32 + q * 8 + 4 * (e_lane >> 5);
#define EPI_END }

#define ST_LD 136
#define ST32_LD 132
__device__ __forceinline__ void copyout_bf16(const bfu* sT, bfu* dst, int ld) {
  const int tid = threadIdx.x;
#pragma unroll
  for (int i = 0; i < 8; ++i) {
    int id = tid + i * 256, row = id >> 4, c8 = (id & 15) * 8;
    *(uint4*)(dst + (size_t)row * ld + c8) = *(const uint4*)(sT + row * ST_LD + c8);
  }
}
__device__ __forceinline__ void stage_rm(bfu* sT, const f32x16 (&acc)[2][2], float sc) {
  EPI_BEGIN
#pragma unroll
    for (int j = 0; j < 4; ++j) {
      sT[(r0 + j) * ST_LD + cl] = f2bf(acc[mi][0][q * 4 + j] * sc);
      sT[(r0 + j) * ST_LD + cl + 64] = f2bf(acc[mi][1][q * 4 + j] * sc);
    }
  EPI_END
}

__device__ __forceinline__ void tile_map(int L, int nM, int nN, int& pm, int& pn) {
  const int nwg = nM * nN;
  const int q = nwg >> 3, r = nwg & 7, xcd = L & 7, off = L >> 3;
  int wgid = (xcd < r ? xcd * (q + 1) : r * (q + 1) + (xcd - r) * q) + off;
  const int nig = 8 * nN, gid = wgid / nig, fm = gid * 8;
  const int gsz = (nM - fm) < 8 ? (nM - fm) : 8;
  pm = fm + (wgid % nig) % gsz;
  pn = (wgid % nig) / gsz;
}
__device__ void transpose_w(const float* __restrict__ src, int K, int N, int src_ld, bfu* __restrict__ dst,
                            int remap, int gtid, int gstride) {
  int total = N * (K / 8);
  for (int i = gtid; i < total; i += gstride) {
    int n = i % N, kg = i / N;
    int col = (remap && n >= 3584) ? n + 8 : n;
    float v[8];
#pragma unroll
    for (int j = 0; j < 8; ++j) v[j] = src[(size_t)(kg * 8 + j) * src_ld + col];
    uint4 o;
    o.x = pack2(v[0], v[1]); o.y = pack2(v[2], v[3]); o.z = pack2(v[4], v[5]); o.w = pack2(v[6], v[7]);
    *(uint4*)(dst + (size_t)n * K + kg * 8) = o;
  }
}
__device__ void transpose_w_lds(const float* __restrict__ src, int K, int N, int src_ld, bfu* __restrict__ dst,
                                int remap, float* st, int boff) {
  const int tid = threadIdx.x;
  const int tilesN = N >> 6, ntile = (K >> 6) * tilesN;
  for (int t = (int)((blockIdx.x + gridDim.x - (boff % gridDim.x)) % gridDim.x); t < ntile; t += gridDim.x) {
    const int kt = t / tilesN, nt = t - kt * tilesN;
    {
      const int row = tid >> 2, c16 = (tid & 3) * 16;
      const int n0 = nt * 64 + c16;
      const int col = (remap && n0 >= 3584) ? n0 + 8 : n0;
      const float* sp = src + (size_t)(kt * 64 + row) * src_ld + col;
#pragma unroll
      for (int j = 0; j < 4; ++j) {
        float4 v = *(const float4*)(sp + j * 4);
        float* d = st + row * 65 + c16 + j * 4;
        d[0] = v.x; d[1] = v.y; d[2] = v.z; d[3] = v.w;
      }
    }
    __syncthreads();
    {
      const int n = tid >> 2, kc = (tid & 3) * 16;
#pragma unroll
      for (int hf = 0; hf < 2; ++hf) {
        float f[8];
#pragma unroll
        for (int j = 0; j < 8; ++j) f[j] = st[(kc + hf * 8 + j) * 65 + n];
        uint4 o;
        o.x = pack2(f[0], f[1]); o.y = pack2(f[2], f[3]); o.z = pack2(f[4], f[5]); o.w = pack2(f[6], f[7]);
        *(uint4*)(dst + (size_t)(nt * 64 + n) * K + kt * 64 + kc + hf * 8) = o;
      }
    }
    __syncthreads();
  }
}
__device__ void convert_bf(const float* __restrict__ src, bfu* __restrict__ dst, size_t n8, int gtid, int gstride) {
  for (size_t i = gtid; i < n8; i += gstride) {
    float4 a = *(const float4*)(src + i * 8), b = *(const float4*)(src + i * 8 + 4);
    uint4 o;
    o.x = pack2(a.x, a.y); o.y = pack2(a.z, a.w); o.z = pack2(b.x, b.y); o.w = pack2(b.z, b.w);
    *(uint4*)(dst + i * 8) = o;
  }
}

__device__ void prep_rows(const Params& P) {
  const int lane = threadIdx.x & 63, w = threadIdx.x >> 6;
  bfu* hbuf = (bfu*)(P.ws + SLOT(0));
  float* gpre = (float*)(P.ws + O_GPRE);
  float4 wg0[16], wg1[16];
#pragma unroll
  for (int i = 0; i < 4; ++i)
#pragma unroll
    for (int j = 0; j < 4; ++j) {
      const float* wr = P.w_in + (size_t)(i * 256 + lane * 4 + j) * 5640 + 3584;
      wg0[i * 4 + j] = *(const float4*)wr; wg1[i * 4 + j] = *(const float4*)(wr + 4);
    }
  float4 gm[4];
#pragma unroll
  for (int i = 0; i < 4; ++i) gm[i] = *(const float4*)(P.g_mix + i * 256 + lane * 4);
  for (int r = blockIdx.x * 4 + w; r < MT; r += gridDim.x * 4) {
    const float* xr = xrow(P, r);
    float4 v[4];
    float ss = 0.f;
#pragma unroll
    for (int i = 0; i < 4; ++i) {
      v[i] = *(const float4*)(xr + i * 256 + lane * 4);
      ss += v[i].x * v[i].x + v[i].y * v[i].y + v[i].z * v[i].z + v[i].w * v[i].w;
    }
    ss = wave_sum(ss);
    float rstd = rsqrtf(ss * (1.f / 1024.f) + EPS);
    float ga[8];
#pragma unroll
    for (int j = 0; j < 8; ++j) ga[j] = 0.f;
#pragma unroll
    for (int i = 0; i < 4; ++i) {
      float hv[4] = {v[i].x * rstd * gm[i].x, v[i].y * rstd * gm[i].y, v[i].z * rstd * gm[i].z, v[i].w * rstd * gm[i].w};
      uint2 o; o.x = pack2(hv[0], hv[1]); o.y = pack2(hv[2], hv[3]);
      *(uint2*)(hbuf + (size_t)r * 1024 + i * 256 + lane * 4) = o;
#pragma unroll
      for (int j = 0; j < 4; ++j) {
        const float4 w0 = wg0[i * 4 + j], w1 = wg1[i * 4 + j];
        ga[0] += hv[j] * w0.x; ga[1] += hv[j] * w0.y; ga[2] += hv[j] * w0.z; ga[3] += hv[j] * w0.w;
        ga[4] += hv[j] * w1.x; ga[5] += hv[j] * w1.y; ga[6] += hv[j] * w1.z; ga[7] += hv[j] * w1.w;
      }
    }
    float si = reduce4(ga[0], ga[1], ga[2], ga[3]);
    float sf = reduce4(ga[4], ga[5], ga[6], ga[7]);
    if ((lane & 15) == 0) {
      int k = lane >> 4;
      gpre[(size_t)r * 8 + k] = si + P.b_i[k];
      gpre[(size_t)r * 8 + 4 + k] = sf + P.b_f[k];
    }
  }
}
__device__ void gate_scan(const Params& P) {
  const int lane = threadIdx.x & 63, w = threadIdx.x >> 6;
  const float* gpre = (const float*)(P.ws + O_GPRE);
  for (int item = blockIdx.x * 4 + w; item < 528 * 4; item += gridDim.x * 4) {
    int tile = item >> 2, h = item & 3;
    int row0, L;
    if (tile < 512) { row0 = tile * 64; L = 64; } else { row0 = MP + (tile - 512) * 32; L = 32; }
    const int s = lane;
    bool valid = s < L;
    float ig = valid ? gpre[(size_t)(row0 + s) * 8 + h] : -INFINITY;
    float fg = valid ? gpre[(size_t)(row0 + s) * 8 + 4 + h] : 0.f;
    float lf = valid ? (fminf(fg, 0.f) - log1pf(__expf(-fabsf(fg)))) : 0.f;
    float F = lf;
#pragma unroll
    for (int o = 1; o < 64; o <<= 1) { float t = __shfl_up(F, o); if (lane >= o) F += t; }
    float u = valid ? ig - F : -INFINITY;
    float cm = u;
#pragma unroll
    for (int o = 1; o < 64; o <<= 1) { float t = __shfl_up(cm, o); if (lane >= o) cm = fmaxf(cm, t); }
    if (valid) {
      size_t gi = (size_t)(row0 + s) * 4 + h;
      ((float*)(P.ws + O_FQ))[gi] = F;
      ((float*)(P.ws + O_UQ))[gi] = u;
      ((float*)(P.ws + O_CMQ))[gi] = cm;
      if (s == L - 1) {
        ((float*)(P.ws + O_FL))[tile * 4 + h] = F;
        ((float*)(P.ws + O_UC))[tile * 4 + h] = cm;
      }
    }
  }
}

__device__ void phase_prep(const Params& P, char* smem) {
  const int gtid = blockIdx.x * NTHREADS + threadIdx.x, gstride = gridDim.x * NTHREADS;
  prep_rows(P);
  transpose_w_lds(P.w_in, 1024, 5632, 5640, (bfu*)(P.ws + O_WT_IN), 1, (float*)smem, 0);
  transpose_w_lds(P.w_up_r, 512, 1024, 1024, (bfu*)(P.ws + O_WT_UPR), 0, (float*)smem, 1408);
  transpose_w_lds(P.w_up_m, 512, 1024, 1024, (bfu*)(P.ws + O_WT_UPM), 0, (float*)smem, 1536);
  transpose_w_lds(P.w_out, 1024, 1024, 1024, (bfu*)(P.ws + O_WT_OUT), 0, (float*)smem, 1664);
  transpose_w_lds(P.w_pq, 1024, 2048, 2048, (bfu*)(P.ws + O_WT_PQ), 0, (float*)smem, 1920);
  transpose_w_lds(P.w_pg, 1024, 1024, 1024, (bfu*)(P.ws + O_WT_PG), 0, (float*)smem, 2432);
  transpose_w_lds(P.w_ple, 256, 1024, 1024, (bfu*)(P.ws + O_WT_PLE), 0, (float*)smem, 2688);
  for (int h = 0; h < 4; ++h) {
    transpose_w_lds(P.w_mq + h * 16384, 128, 128, 128, (bfu*)(P.ws + O_WT_MQ) + h * 16384, 0, (float*)smem, 2752 + h * 8);
    transpose_w_lds(P.w_mk + h * 16384, 128, 128, 128, (bfu*)(P.ws + O_WT_MK) + h * 16384, 0, (float*)smem, 2756 + h * 8);
  }
  convert_bf(P.peer_keys, (bfu*)(P.ws + O_KEYS), 16 * 128 * 128 / 8, gtid, gstride);
  float* ct = (float*)(P.ws + O_COS); float* st = (float*)(P.ws + O_SIN);
  for (int i = gtid; i < 8192 * 64; i += gstride) {
    int pos = i >> 6, j = i & 63;
    float inv = exp2f(-(float)j * (13.287712379549449f / 64.f));
    float angf = (float)pos * inv;
    double a = (double)angf;
    double k = rint(a * 0.15915494309189535);
    float r = (float)(a - k * 6.283185307179586);
    ct[i] = __cosf(r); st[i] = __sinf(r);
  }
}

__device__ __forceinline__ void gemm_acc256(f32x16 (&acc)[4][2], const bfu* __restrict__ A, int lda,
                                            const bfu* __restrict__ Bt, int ldb, int K, char* sbase) {
  const int tid = threadIdx.x, lane = tid & 63, w = tid >> 6, wm = w & 1, wn = w >> 1;
  const int kc = ((tid & 3) ^ ((tid >> 4) & 3)) * 8;
  const bfu* Ap = A + (size_t)(tid >> 2) * lda + kc;
  const bfu* Bp = Bt + (size_t)(tid >> 2) * ldb + kc;
  const size_t a64 = (size_t)64 * lda, b64 = (size_t)64 * ldb;
  char* ldst = sbase + tid * 16;
#define GISSUE256(stage, k)                                                                                      \
  {                                                                                                              \
    char* d_ = ldst + (stage) * 24576;                                                                           \
    __builtin_amdgcn_global_load_lds((const unsigned*)(Ap + (k)), (LAS unsigned*)(d_), 16, 0, 0);                \
    __builtin_amdgcn_global_load_lds((const unsigned*)(Ap + a64 + (k)), (LAS unsigned*)(d_ + 4096), 16, 0, 0);   \
    __builtin_amdgcn_global_load_lds((const unsigned*)(Ap + 2 * a64 + (k)), (LAS unsigned*)(d_ + 8192), 16, 0, 0);  \
    __builtin_amdgcn_global_load_lds((const unsigned*)(Ap + 3 * a64 + (k)), (LAS unsigned*)(d_ + 12288), 16, 0, 0); \
    __builtin_amdgcn_global_load_lds((const unsigned*)(Bp + (k)), (LAS unsigned*)(d_ + 16384), 16, 0, 0);        \
    __builtin_amdgcn_global_load_lds((const unsigned*)(Bp + b64 + (k)), (LAS unsigned*)(d_ + 20480), 16, 0, 0);  \
  }
  const int sw = (lane >> 2) & 3, hh = lane >> 5;
  const int rowA = (wm * 64 + (lane & 31)) * 64, rowB = (wn * 32 + (lane & 31)) * 64;
  const int nk = K >> 5;
  __syncthreads();
  asm volatile("s_waitcnt vmcnt(0)" ::: "memory");
  GISSUE256(0, 0)
  if (nk > 1) GISSUE256(1, 32)
  int st = 0;
  for (int kt = 0; kt < nk; ++kt) {
    if (kt + 1 < nk) asm volatile("s_waitcnt vmcnt(6)" ::: "memory");
    else asm volatile("s_waitcnt vmcnt(0)" ::: "memory");
    asm volatile("s_waitcnt lgkmcnt(0)" ::: "memory");
    __builtin_amdgcn_s_barrier();
    asm volatile("" ::: "memory");
    if (kt + 2 < nk) { const int s2 = st >= 1 ? st - 1 : 2; GISSUE256(s2, (kt + 2) * 32) }
    const char* cA = sbase + st * 24576;
    const char* cB = cA + 16384;
    __builtin_amdgcn_s_setprio(1);
#pragma unroll
    for (int ks = 0; ks < 2; ++ks) {
      const int pos = ((2 * ks + hh) ^ sw) * 16;
      bf16x8 af[4], bfr[2];
#pragma unroll
      for (int mi = 0; mi < 4; ++mi) af[mi] = *(const bf16x8*)(cA + rowA + ((mi >> 1) * 128 + (mi & 1) * 32) * 64 + pos);
#pragma unroll
      for (int ni = 0; ni < 2; ++ni) bfr[ni] = *(const bf16x8*)(cB + rowB + ni * 64 * 64 + pos);
#pragma unroll
      for (int mi = 0; mi < 4; ++mi)
#pragma unroll
        for (int ni = 0; ni < 2; ++ni)
          acc[mi][ni] = __builtin_amdgcn_mfma_f32_32x32x16_bf16(af[mi], bfr[ni], acc[mi][ni], 0, 0, 0);
    }
    __builtin_amdgcn_s_setprio(0);
    st = st == 2 ? 0 : st + 1;
  }
}

__device__ __forceinline__ void gemm1_epilogue(const Params& P, char* smem, f32x16 (&acc)[2][2], const int rbase, const int nt,
                                               const float* ct, const float* stb) {
    const bool prompt = rbase < MP;
  int region = nt >> 2, hh = nt & 3;
  bfu* sT = (bfu*)smem;
  __syncthreads();
  if (region <= 1) {
    float sc = region == 1 ? 0.08838834764831845f : 1.f;
    EPI_BEGIN
#pragma unroll
      for (int j = 0; j < 4; ++j) {
        int rr = rbase + r0 + j;
        int pos = prompt ? (rr & 8191) : 2048 + ((rr - MP) & 31);
        float c = ct[pos * 64 + cl], sn = stb[pos * 64 + cl];
        float a = acc[mi][0][q * 4 + j], b = acc[mi][1][q * 4 + j];
        sT[(r0 + j) * ST_LD + cl] = f2bf((a * c - b * sn) * sc);
        sT[(r0 + j) * ST_LD + cl + 64] = f2bf((a * sn + b * c) * sc);
      }
    EPI_END
    __syncthreads();
    copyout_bf16(sT, (bfu*)(P.ws + SLOT(2 + region)) + (size_t)rbase * 512 + hh * 128, 512);
  } else if (region == 2 || region == 5) {
    EPI_BEGIN
      uint2 va, vb;
      va.x = pack2(acc[mi][0][q * 4 + 0], acc[mi][0][q * 4 + 1]); va.y = pack2(acc[mi][0][q * 4 + 2], acc[mi][0][q * 4 + 3]);
      vb.x = pack2(acc[mi][1][q * 4 + 0], acc[mi][1][q * 4 + 1]); vb.y = pack2(acc[mi][1][q * 4 + 2], acc[mi][1][q * 4 + 3]);
      *(uint2*)(sT + cl * ST_LD + r0) = va;
      *(uint2*)(sT + (cl + 64) * ST_LD + r0) = vb;
    EPI_END
    __syncthreads();
    bfu* dst = (bfu*)(P.ws + SLOT(region == 2 ? 4 : 7));
#pragma unroll
    for (int i = 0; i < 8; ++i) {
      int id = threadIdx.x + i * 256, e = id >> 4, c8 = (id & 15) * 8;
      size_t o;
      if (prompt) { int bb = rbase >> 13, tt = (rbase & 8191) + c8; o = ((size_t)((bb * 4 + hh) * 128 + e)) * 8192 + tt; }
      else { int rs = rbase - MP + c8, bb = rs >> 5, tt = rs & 31; o = SB_T + ((size_t)((bb * 4 + hh) * 128 + e)) * 32 + tt; }
      *(uint4*)(dst + o) = *(const uint4*)(sT + e * ST_LD + c8);
    }
  } else if (region == 3 || region == 4 || region == 6) {
    stage_rm(sT, acc, 1.f);
    __syncthreads();
    copyout_bf16(sT, (bfu*)(P.ws + SLOT(region == 3 ? 5 : (region == 4 ? 6 : 8))) + (size_t)rbase * 512 + hh * 128, 512);
  } else {
    int gi = nt - 28;
    stage_rm(sT, acc, 1.f);
    __syncthreads();
    copyout_bf16(sT, (bfu*)(P.ws + SLOT(gi < 8 ? 9 : 11)) + (size_t)rbase * 1024 + (gi & 7) * 128, 1024);
  }

}

__device__ void phase_gemm1(const Params& P, char* smem) {
  const bfu* hbuf = (const bfu*)(P.ws + SLOT(0));
  const bfu* wt = (const bfu*)(P.ws + O_WT_IN);
  const float* ct = (const float*)(P.ws + O_COS); const float* stb = (const float*)(P.ws + O_SIN);
  for (int t = blockIdx.x; t < 130 * 44; t += gridDim.x) {
    int mt, nt; tile_map(t, 130, 44, mt, nt);
    f32x16 acc[4][2];
#pragma unroll
    for (int a = 0; a < 4; ++a)
#pragma unroll
      for (int b = 0; b < 2; ++b)
#pragma unroll
        for (int i = 0; i < 16; ++i) acc[a][b][i] = 0.f;
    gemm_acc256(acc, hbuf + (size_t)mt * 256 * 1024, 1024, wt + (size_t)nt * 128 * 1024, 1024, 1024, smem);
    gemm1_epilogue(P, smem, reinterpret_cast<f32x16(&)[2][2]>(acc[0]), mt * 256, nt, ct, stb);
    gemm1_epilogue(P, smem, reinterpret_cast<f32x16(&)[2][2]>(acc[2]), mt * 256 + 128, nt, ct, stb);
  }
}

__device__ void phase_conv(const Params& P) {
  const int gtid = blockIdx.x * NTHREADS + threadIdx.x, gstride = gridDim.x * NTHREADS;
  const bfu* xm = (const bfu*)(P.ws + SLOT(6));
  bfu* cb = (bfu*)(P.ws + SLOT(0));
  for (int i = gtid; i < MT * 64; i += gstride) {
    int r = i >> 6, c0 = (i & 63) * 8;
    int t, T, bb; bool prompt = r < MP;
    if (prompt) { bb = r >> 13; t = r & 8191; T = 8192; } else { int rs = r - MP; bb = rs >> 5; t = rs & 31; T = 32; }
    float y[8];
#pragma unroll
    for (int j = 0; j < 8; ++j) y[j] = P.conv_b[c0 + j];
#pragma unroll
    for (int k = 0; k < 4; ++k) {
      int tt = t - 3 + k;
      float xv[8];
      if (tt >= 0) {
        uint4 v = *(const uint4*)(xm + (size_t)(r - 3 + k) * 512 + c0);
        xv[0] = bf2f(v.x & 0xffff); xv[1] = bf2f(v.x >> 16); xv[2] = bf2f(v.y & 0xffff); xv[3] = bf2f(v.y >> 16);
        xv[4] = bf2f(v.z & 0xffff); xv[5] = bf2f(v.z >> 16); xv[6] = bf2f(v.w & 0xffff); xv[7] = bf2f(v.w >> 16);
      } else if (!prompt) {
        const float* sp = P.st_conv + (size_t)(bb * 3 + (tt + 3)) * 512 + c0;
#pragma unroll
        for (int j = 0; j < 8; ++j) xv[j] = sp[j];
      } else {
#pragma unroll
        for (int j = 0; j < 8; ++j) xv[j] = 0.f;
      }
#pragma unroll
      for (int j = 0; j < 8; ++j) y[j] += xv[j] * P.conv_w[k * 512 + c0 + j];
    }
    if (t >= T - 3) {
      uint4 v = *(const uint4*)(xm + (size_t)r * 512 + c0);
      float* dst = (prompt ? P.out + OO_CONVP : P.out + OO_CONVS) + (size_t)(bb * 3 + (t - (T - 3))) * 512 + c0;
      dst[0] = bf2f(v.x & 0xffff); dst[1] = bf2f(v.x >> 16); dst[2] = bf2f(v.y & 0xffff); dst[3] = bf2f(v.y >> 16);
      dst[4] = bf2f(v.z & 0xffff); dst[5] = bf2f(v.z >> 16); dst[6] = bf2f(v.w & 0xffff); dst[7] = bf2f(v.w >> 16);
    }
    uint4 o;
#pragma unroll
    for (int j = 0; j < 8; ++j) y[j] = y[j] * sigmoidf_(y[j]);
    o.x = pack2(y[0], y[1]); o.y = pack2(y[2], y[3]); o.z = pack2(y[4], y[5]); o.w = pack2(y[6], y[7]);
    *(uint4*)(cb + (size_t)r * 512 + c0) = o;
  }
}

__device__ void m_fold(const Params& P) {
  const int gtid = blockIdx.x * NTHREADS + threadIdx.x;
  const float* FL = (const float*)(P.ws + O_FL); const float* UC = (const float*)(P.ws + O_UC);
  float* MCS = (float*)(P.ws + O_MCS);
  if (gtid < 16) {
    int b = gtid >> 2, h = gtid & 3;
    float m = 0.f;
    for (int c = 0; c < 128; c += 8) {
      float fl[8], uc[8];
#pragma unroll
      for (int k = 0; k < 8; ++k) { fl[k] = FL[(b * 128 + c + k) * 4 + h]; uc[k] = UC[(b * 128 + c + k) * 4 + h]; }
#pragma unroll
      for (int k = 0; k < 8; ++k) { MCS[gtid * 128 + c + k] = m; m = fl[k] + fmaxf(m, uc[k]); }
    }
  } else if (gtid < 16 + 64) {
    int bh = gtid - 16;
    MCS[2048 + bh] = P.st_m[bh];
  }
}
__device__ void phase_mqk(const Params& P, char* smem) {
  bfu* sA = (bfu*)smem; bfu* sB = sA + 128 * 72;
  const bfu* cb = (const bfu*)(P.ws + SLOT(0));
  for (int t = blockIdx.x; t < 260 * 8; t += gridDim.x) {
    int mt = t >> 3, which = (t >> 2) & 1, hh = t & 3;
    const bfu* wt = (const bfu*)(P.ws + (which ? O_WT_MK : O_WT_MQ)) + hh * 16384;
    f32x16 acc[2][2]; zero_acc(acc);
    gemm_acc(acc, cb + (size_t)mt * 128 * 512 + hh * 128, 512, wt, 128, 128, sA, sB);
    bfu* dst = (bfu*)(P.ws + SLOT(which ? 13 : 1));
    float sc = which ? 0.08838834764831845f : 1.f;
    bfu* sT = (bfu*)smem;
    __syncthreads();
    stage_rm(sT, acc, sc);
    __syncthreads();
    copyout_bf16(sT, dst + (size_t)mt * 128 * 512 + hh * 128, 512);
  }
}

struct Item { int b, h, c, row0, L, T, chunk, bh; bool prompt; size_t vt_off; };
__device__ __forceinline__ Item decode_item(int idx) {
  Item it;
  if (idx < 2048) {
    it.prompt = true; it.b = idx >> 9; it.h = (idx >> 7) & 3; it.c = idx & 127; it.row0 = it.b * 8192 + it.c * 64;
    it.L = 64; it.T = 8192; it.chunk = it.b * 128 + it.c; it.bh = it.b * 4 + it.h;
    it.vt_off = ((size_t)(it.bh * 128)) * 8192 + it.c * 64;
  } else {
    int si = idx - 2048; it.prompt = false; it.b = si >> 2; it.h = si & 3; it.c = 0; it.row0 = MP + it.b * 32;
    it.L = 32; it.T = 32; it.chunk = 512 + it.b; it.bh = it.b * 4 + it.h;
    it.vt_off = SB_T + ((size_t)(it.bh * 128)) * 32;
  }
  return it;
}
__device__ __forceinline__ bfu* ds_ptr(const Params& P, int mixer, int idx) {
  if (idx < 2048) return (bfu*)P.out + ((size_t)(mixer * 2048 + idx)) * 16384;
  return (bfu*)(P.ws + O_DSS) + ((size_t)(mixer * 64 + (idx - 2048))) * 16384;
}
__device__ __forceinline__ float ret_lg(int h) { return log1pf(-exp2f(-5.f - (float)h)); }

__device__ void phaseA_item(const Params& P, int mixer, int idx, char* smem) {
  const int tid = threadIdx.x, lane = tid & 63, w = tid >> 6, wm = w & 1, wn = w >> 1;
  Item it = decode_item(idx);
  bfu* sK = (bfu*)smem; bfu* sV = sK + 128 * 72;
  float* sw = (float*)(sV + 128 * 72);
  float* sm = sw + 64;
  const int L = it.L, h = it.h;
  const bfu* Ksrc = (const bfu*)(P.ws + SLOT(mixer == 0 ? 3 : 13)) + (size_t)it.row0 * 512 + h * 128;
  const bfu* Vsrc = (const bfu*)(P.ws + SLOT(mixer == 0 ? 4 : 7)) + it.vt_off;
  uint4 kreg[4], vreg[4];
#pragma unroll
  for (int i = 0; i < 4; ++i) {
    int id = tid + i * 256, s = id & 63, dc = (id >> 6) * 8;
    kreg[i] = make_uint4(0, 0, 0, 0);
    if (s < L) kreg[i] = *(const uint4*)(Ksrc + (size_t)s * 512 + dc);
    int e = id >> 3, sc = (id & 7) * 8;
    vreg[i] = make_uint4(0, 0, 0, 0);
    if (sc < L) vreg[i] = *(const uint4*)(Vsrc + (size_t)e * it.T + sc);
  }
  if (mixer == 0) {
    if (tid < 64) { float lg = ret_lg(h); sw[tid] = tid < L ? __expf(lg * (float)(L - 1 - tid)) : 0.f; }
  } else {
    const float* FL = (const float*)(P.ws + O_FL); const float* UC = (const float*)(P.ws + O_UC);
    float mc = ((const float*)(P.ws + O_MCS))[idx];
    float Ml = fmaxf(mc, UC[it.chunk * 4 + h]);
    if (tid < 64) sw[tid] = tid < L ? __expf(((const float*)(P.ws + O_UQ))[(size_t)(it.row0 + tid) * 4 + h] - Ml) : 0.f;
    if (tid == 0) {
      ((float*)(P.ws + O_AEND))[idx] = __expf(mc - Ml);
      if (!it.prompt) P.out[OO_MS + it.bh] = FL[it.chunk * 4 + h] + Ml;
      else if (it.c == 127) P.out[OO_MP + it.bh] = FL[it.chunk * 4 + h] + Ml;
    }
  }
  __syncthreads();
#pragma unroll
  for (int i = 0; i < 4; ++i) {
    int id = tid + i * 256, s = id & 63, dc = (id >> 6) * 8;
    uint4 v = kreg[i];
    float ww = sw[s];
    unsigned vv[4] = {v.x, v.y, v.z, v.w};
#pragma unroll
    for (int j = 0; j < 4; ++j) {
      sK[(dc + 2 * j) * 72 + s] = f2bf(bf2f(vv[j] & 0xffff) * ww);
      sK[(dc + 2 * j + 1) * 72 + s] = f2bf(bf2f(vv[j] >> 16) * ww);
    }
  }
#pragma unroll
  for (int i = 0; i < 4; ++i) {
    int id = tid + i * 256, e = id >> 3, sc = (id & 7) * 8;
    *(uint4*)(sV + e * 72 + sc) = vreg[i];
  }
  __syncthreads();
  f32x16 acc[2][2]; zero_acc(acc);
#pragma unroll
  for (int ks = 0; ks < 4; ++ks) {
    bf16x8 af[2], bfr[2];
#pragma unroll
    for (int mi = 0; mi < 2; ++mi)
      af[mi] = *(const bf16x8*)(sK + (wm * 64 + mi * 32 + (lane & 31)) * 72 + ks * 16 + (lane >> 5) * 8);
#pragma unroll
    for (int ni = 0; ni < 2; ++ni)
      bfr[ni] = *(const bf16x8*)(sV + (wn * 32 + ni * 64 + (lane & 31)) * 72 + ks * 16 + (lane >> 5) * 8);
#pragma unroll
    for (int mi = 0; mi < 2; ++mi)
#pragma unroll
      for (int ni = 0; ni < 2; ++ni)
        acc[mi][ni] = __builtin_amdgcn_mfma_f32_32x32x16_bf16(af[mi], bfr[ni], acc[mi][ni], 0, 0, 0);
  }
  bfu* dS = ds_ptr(P, mixer, idx);
  EPI_BEGIN
#pragma unroll
    for (int ni = 0; ni < 2; ++ni) {
      int e = cl + ni * 64;
      uint2 o; o.x = pack2(acc[mi][ni][q * 4 + 0], acc[mi][ni][q * 4 + 1]); o.y = pack2(acc[mi][ni][q * 4 + 2], acc[mi][ni][q * 4 + 3]);
      *(uint2*)(dS + e * 128 + r0) = o;
    }
  EPI_END
  if (mixer == 1 && tid < 128) {
    float s = 0.f;
#pragma unroll
    for (int j = 0; j < 8; ++j) { float f[8]; unpack8(*(const uint4*)(sK + tid * 72 + j * 8), f);
#pragma unroll
      for (int k = 0; k < 8; ++k) s += f[k]; }
    ((float*)(P.ws + O_DN))[(size_t)idx * 128 + tid] = s;
  }
  __syncthreads();
}

__device__ void phase_scan(const Params& P) {
  const int gtid = blockIdx.x * NTHREADS + threadIdx.x, gstride = gridDim.x * NTHREADS;
  const float* AE = (const float*)(P.ws + O_AEND);
  for (int i = gtid; i < 131072; i += gstride) {
    int mixer = i >> 16, bh = (i >> 12) & 15, eo = (i & 4095) * 4;
    int h = bh & 3;
    float gch = __expf(ret_lg(h) * 64.f);
    float st[4];
#pragma unroll
    for (int j = 0; j < 4; ++j) st[j] = 0.f;
    bfu* base = (bfu*)P.out + ((size_t)(mixer * 2048 + bh * 128)) * 16384 + eo;
    for (int c = 0; c < 128; c += 8) {
      uint2 v[8];
#pragma unroll
      for (int k = 0; k < 8; ++k) v[k] = *(const uint2*)(base + (size_t)(c + k) * 16384);
#pragma unroll
      for (int k = 0; k < 8; ++k) {
        float dec = mixer == 0 ? gch : AE[bh * 128 + c + k];
        float d0 = bf2f(v[k].x & 0xffff), d1 = bf2f(v[k].x >> 16), d2 = bf2f(v[k].y & 0xffff), d3 = bf2f(v[k].y >> 16);
        uint2 o; o.x = pack2(st[0], st[1]); o.y = pack2(st[2], st[3]);
        *(uint2*)(base + (size_t)(c + k) * 16384) = o;
        st[0] = dec * st[0] + d0; st[1] = dec * st[1] + d1; st[2] = dec * st[2] + d2; st[3] = dec * st[3] + d3;
      }
    }
    float* o = P.out + (mixer == 0 ? OO_RETP : OO_CP) + (size_t)bh * 16384;
    int e = eo >> 7, d0i = eo & 127;
#pragma unroll
    for (int j = 0; j < 4; ++j) o[(d0i + j) * 128 + e] = st[j];
  }
  for (int i = gtid; i < 2 * 64 * 2048; i += gstride) {
    int mixer = i >> 17, bh = (i >> 11) & 63, eo = (i & 2047) * 8;
    int h = bh & 3;
    int e = eo >> 7, d0 = eo & 127;
    const float* s0 = (mixer == 0 ? P.st_ret : P.st_C) + (size_t)bh * 16384;
    float st[8];
#pragma unroll
    for (int j = 0; j < 8; ++j) st[j] = s0[(d0 + j) * 128 + e];
    bfu* p = (bfu*)(P.ws + O_DSS) + ((size_t)(mixer * 64 + bh)) * 16384 + eo;
    float d[8]; unpack8(*(const uint4*)p, d);
    *(uint4*)p = pack8(st);
    float dec = mixer == 0 ? __expf(ret_lg(h) * 32.f) : AE[2048 + bh];
    float* o = P.out + (mixer == 0 ? OO_RETS : OO_CS) + (size_t)bh * 16384;
#pragma unroll
    for (int j = 0; j < 8; ++j) o[(d0 + j) * 128 + e] = dec * st[j] + d[j];
  }
  float* DN = (float*)(P.ws + O_DN);
  for (int i = gtid; i < 16 * 128; i += gstride) {
    int bh = i >> 7, d = i & 127;
    float n = 0.f;
    for (int c0 = 0; c0 < 128; c0 += 16) {
      float v[16], ae[16];
#pragma unroll
      for (int k = 0; k < 16; ++k) { v[k] = DN[(size_t)(bh * 128 + c0 + k) * 128 + d]; ae[k] = AE[bh * 128 + c0 + k]; }
#pragma unroll
      for (int k = 0; k < 16; ++k) { DN[(size_t)(bh * 128 + c0 + k) * 128 + d] = n; n = ae[k] * n + v[k]; }
    }
    P.out[OO_NP + i] = n;
  }
  for (int i = gtid; i < 64 * 128; i += gstride) {
    int bh = i >> 7, d = i & 127;
    size_t o = (size_t)(2048 + bh) * 128 + d;
    float n0 = P.st_n[i]; float v = DN[o]; DN[o] = n0;
    P.out[OO_NS + i] = AE[2048 + bh] * n0 + v;
  }
}

__device__ void phaseC_item(const Params& P, int mixer, int idx, char* smem) {
  const int tid = threadIdx.x, lane = tid & 63, w = tid >> 6;
  Item it = decode_item(idx);
  const int L = it.L, h = it.h;
  bfu* sQ = (bfu*)smem;
  bfu* sKV = sQ + 64 * 136;
  bfu* sP = sKV + 128 * 72;
  bfu* sS = sP + 64 * 72;
  float* sO = (float*)sS;
  float* sRow = (float*)(sS + 128 * 136);
  const bfu* Qsrc = (const bfu*)(P.ws + SLOT(mixer == 0 ? 2 : 1)) + (size_t)it.row0 * 512 + h * 128;
  const bfu* Ksrc = (const bfu*)(P.ws + SLOT(mixer == 0 ? 3 : 13)) + (size_t)it.row0 * 512 + h * 128;
  const bfu* Vsrc = (const bfu*)(P.ws + SLOT(mixer == 0 ? 4 : 7)) + it.vt_off;
  const bfu* Ssrc = ds_ptr(P, mixer, idx);
  const float lg = ret_lg(h);
  uint4 vpre[4];
#pragma unroll
  for (int i = 0; i < 4; ++i) {
    int id = tid + i * 256, e = id >> 3, sc = (id & 7) * 8;
    vpre[i] = make_uint4(0, 0, 0, 0);
    if (sc < L) vpre[i] = *(const uint4*)(Vsrc + (size_t)e * it.T + sc);
  }
#pragma unroll
  for (int i = 0; i < 4; ++i) {
    int id = tid + i * 256, s = id >> 4, dc = (id & 15) * 8;
    uint4 vq = make_uint4(0, 0, 0, 0), vk = vq;
    if (s < L) { vq = *(const uint4*)(Qsrc + (size_t)s * 512 + dc); vk = *(const uint4*)(Ksrc + (size_t)s * 512 + dc); }
    *(uint4*)(sQ + s * 136 + dc) = vq;
    *(uint4*)(sKV + s * 136 + dc) = vk;
  }
#pragma unroll
  for (int i = 0; i < 8; ++i) {
    int id = tid + i * 256, e = id >> 4, dc = (id & 15) * 8;
    *(uint4*)(sS + e * 136 + dc) = *(const uint4*)(Ssrc + e * 128 + dc);
  }
  if (tid < 64) {
    int i = tid;
    if (mixer == 0) {
      sRow[128 + i] = __expf(lg * (float)(i + 1));
    } else {
      float mc = ((const float*)(P.ws + O_MCS))[idx];
      size_t gi = (size_t)(it.row0 + i) * 4 + h;
      bool valid = i < L;
      float u = valid ? ((const float*)(P.ws + O_UQ))[gi] : -INFINITY;
      float M = valid ? fmaxf(mc, ((const float*)(P.ws + O_CMQ))[gi]) : 0.f;
      float F = valid ? ((const float*)(P.ws + O_FQ))[gi] : 0.f;
      sRow[i] = u; sRow[64 + i] = M; sRow[128 + i] = valid ? __expf(mc - M) : 0.f;
      sRow[256 + i] = __expf(-(F + M));
    }
  }
  __syncthreads();
  {
    const int mi = w & 1, ni = w >> 1;
    f32x16 acc;
#pragma unroll
    for (int i = 0; i < 16; ++i) acc[i] = 0.f;
#pragma unroll 2
    for (int ks = 0; ks < 8; ++ks) {
      bf16x8 af = *(const bf16x8*)(sQ + (mi * 32 + (lane & 31)) * 136 + ks * 16 + (lane >> 5) * 8);
      bf16x8 bfr = *(const bf16x8*)(sKV + (ni * 32 + (lane & 31)) * 136 + ks * 16 + (lane >> 5) * 8);
      acc = __builtin_amdgcn_mfma_f32_32x32x16_bf16(af, bfr, acc, 0, 0, 0);
    }
    const int s = ni * 32 + (lane & 31);
    float us = mixer ? sRow[s] : 0.f;
#pragma unroll
    for (int reg = 0; reg < 16; ++reg) {
      int i = mi * 32 + (reg & 3) + 8 * (reg >> 2) + 4 * (lane >> 5);
      float wgt;
      if (mixer == 0) wgt = (s <= i) ? __expf(lg * (float)(i - s)) : 0.f;
      else wgt = (s <= i && i < L) ? __expf(us - sRow[64 + i]) : 0.f;
      sP[i * 72 + s] = f2bf(acc[reg] * wgt);
    }
  }
  __syncthreads();
#pragma unroll
  for (int i = 0; i < 4; ++i) {
    int id = tid + i * 256, e = id >> 3, sc = (id & 7) * 8;
    *(uint4*)(sKV + e * 72 + sc) = vpre[i];
  }
  __syncthreads();
  f32x16 acc1[2], acc2[2];
  const int mi = w & 1, nj = w >> 1;
#pragma unroll
  for (int t = 0; t < 2; ++t)
#pragma unroll
    for (int i = 0; i < 16; ++i) { acc1[t][i] = 0.f; acc2[t][i] = 0.f; }
#pragma unroll 2
  for (int ks = 0; ks < 4; ++ks) {
    bf16x8 af = *(const bf16x8*)(sP + (mi * 32 + (lane & 31)) * 72 + ks * 16 + (lane >> 5) * 8);
#pragma unroll
    for (int t = 0; t < 2; ++t) {
      bf16x8 bfr = *(const bf16x8*)(sKV + (nj * 64 + t * 32 + (lane & 31)) * 72 + ks * 16 + (lane >> 5) * 8);
      acc1[t] = __builtin_amdgcn_mfma_f32_32x32x16_bf16(af, bfr, acc1[t], 0, 0, 0);
    }
  }
#pragma unroll 2
  for (int ks = 0; ks < 8; ++ks) {
    bf16x8 af = *(const bf16x8*)(sQ + (mi * 32 + (lane & 31)) * 136 + ks * 16 + (lane >> 5) * 8);
#pragma unroll
    for (int t = 0; t < 2; ++t) {
      bf16x8 bfr = *(const bf16x8*)(sS + (nj * 64 + t * 32 + (lane & 31)) * 136 + ks * 16 + (lane >> 5) * 8);
      acc2[t] = __builtin_amdgcn_mfma_f32_32x32x16_bf16(af, bfr, acc2[t], 0, 0, 0);
    }
  }
  if (mixer == 1) {
    int i = tid >> 2, part = tid & 3;
    const float* nprev = (const float*)(P.ws + O_DN) + (size_t)idx * 128;
    float dl = 0.f, qn = 0.f;
#pragma unroll 4
    for (int s = part * 16; s < part * 16 + 16; ++s) dl += bf2f(sP[i * 72 + s]);
#pragma unroll 4
    for (int d = part * 32; d < part * 32 + 32; ++d) qn += bf2f(sQ[i * 136 + d]) * nprev[d];
    dl += __shfl_xor(dl, 1); dl += __shfl_xor(dl, 2);
    qn += __shfl_xor(qn, 1); qn += __shfl_xor(qn, 2);
    if (part == 0) {
      float den = dl + sRow[128 + i] * qn;
      sRow[192 + i] = 1.f / fmaxf(fabsf(den), sRow[256 + i]);
    }
  }
  __syncthreads();
#pragma unroll
  for (int t = 0; t < 2; ++t) {
    int e = nj * 64 + t * 32 + (lane & 31);
#pragma unroll
    for (int reg = 0; reg < 16; ++reg) {
      int i = mi * 32 + (reg & 3) + 8 * (reg >> 2) + 4 * (lane >> 5);
      float o = acc1[t][reg] + sRow[128 + i] * acc2[t][reg];
      if (mixer == 1) o *= sRow[192 + i];
      sO[i * 132 + e] = o;
    }
  }
  __syncthreads();
  {
    int i = tid >> 2, part = tid & 3;
    float ss = 0.f;
#pragma unroll 4
    for (int e = part * 32; e < part * 32 + 32; ++e) { float v = sO[i * 132 + e]; ss += v * v; }
    ss += __shfl_xor(ss, 1); ss += __shfl_xor(ss, 2);
    float rstd = rsqrtf(ss * (1.f / 128.f) + EPS);
    if (i < L) {
      size_t ro = (size_t)(it.row0 + i) * 512 + h * 128 + part * 32;
      const float* so = sO + i * 132 + part * 32;
      if (mixer == 0) {
        bfu* y = (bfu*)(P.ws + SLOT(5)) + ro;
        const float* g = P.g_ret_gn + h * 128 + part * 32;
        uint4 gv[4];
#pragma unroll
        for (int k = 0; k < 4; ++k) gv[k] = *(const uint4*)(y + k * 8);
#pragma unroll
        for (int k = 0; k < 4; ++k) {
          float gt[8], o[8];
          unpack8(gv[k], gt);
#pragma unroll
          for (int j = 0; j < 8; ++j) o[j] = gt[j] * sigmoidf_(gt[j]) * so[k * 8 + j] * rstd * g[k * 8 + j];
          *(uint4*)(y + k * 8) = pack8(o);
        }
      } else {
        bfu* y = (bfu*)(P.ws + SLOT(8)) + ro;
        const bfu* cc = (const bfu*)(P.ws + SLOT(0)) + ro;
        const float* g = P.g_ml_gn + h * 128 + part * 32;
        const float* ws = P.w_skip + h * 128 + part * 32;
        uint4 gv[4], cv[4];
#pragma unroll
        for (int k = 0; k < 4; ++k) { gv[k] = *(const uint4*)(y + k * 8); cv[k] = *(const uint4*)(cc + k * 8); }
#pragma unroll
        for (int k = 0; k < 4; ++k) {
          float gt[8], c8[8], o[8];
          unpack8(gv[k], gt); unpack8(cv[k], c8);
#pragma unroll
          for (int j = 0; j < 8; ++j) o[j] = sigmoidf_(gt[j]) * (so[k * 8 + j] * rstd * g[k * 8 + j] + ws[k * 8 + j] * c8[j]);
          *(uint4*)(y + k * 8) = pack8(o);
        }
      }
    }
  }
  __syncthreads();
}

__device__ void phase_merge(const Params& P, char* smem) {
  bfu* sA = (bfu*)smem; bfu* sB = sA + 128 * 72;
  const bfu* yr = (const bfu*)(P.ws + SLOT(5)); const bfu* ym = (const bfu*)(P.ws + SLOT(8));
  const bfu* gr = (const bfu*)(P.ws + SLOT(9)); const bfu* gm = (const bfu*)(P.ws + SLOT(11));
  bfu* mg = (bfu*)(P.ws + SLOT(6));
  for (int t = blockIdx.x; t < 260 * 8; t += gridDim.x) {
    int mt, nt; tile_map(t, 260, 8, mt, nt);
    f32x16 acc[2][2]; zero_acc(acc);
    bfu* sT = (bfu*)smem;
    const size_t tbase = (size_t)mt * 128 * 1024 + nt * 128;
    uint4 t1[8];
    gemm_acc(acc, yr + (size_t)mt * 128 * 512, 512, (const bfu*)(P.ws + O_WT_UPR) + (size_t)nt * 128 * 512, 512, 512, sA, sB);
    __syncthreads();
    stage_rm(sT, acc, 1.f);
    __syncthreads();
#pragma unroll
    for (int i = 0; i < 8; ++i) {
      int id = threadIdx.x + i * 256, row = id >> 4, c8 = (id & 15) * 8;
      float a[8], g[8];
      unpack8(*(const uint4*)(sT + row * ST_LD + c8), a);
      unpack8(*(const uint4*)(gr + tbase + (size_t)row * 1024 + c8), g);
#pragma unroll
      for (int j = 0; j < 8; ++j) a[j] *= sigmoidf_(g[j]);
      t1[i] = pack8(a);
    }
    zero_acc(acc);
    gemm_acc(acc, ym + (size_t)mt * 128 * 512, 512, (const bfu*)(P.ws + O_WT_UPM) + (size_t)nt * 128 * 512, 512, 512, sA, sB);
    __syncthreads();
    stage_rm(sT, acc, 1.f);
    __syncthreads();
#pragma unroll
    for (int i = 0; i < 8; ++i) {
      int id = threadIdx.x + i * 256, row = id >> 4, c8 = (id & 15) * 8;
      float a[8], g[8], t[8];
      unpack8(*(const uint4*)(sT + row * ST_LD + c8), a);
      unpack8(*(const uint4*)(gm + tbase + (size_t)row * 1024 + c8), g);
      unpack8(t1[i], t);
#pragma unroll
      for (int j = 0; j < 8; ++j) a[j] = t[j] + a[j] * sigmoidf_(g[j]);
      *(uint4*)(mg + tbase + (size_t)row * 1024 + c8) = pack8(a);
    }
  }
}

__device__ void phase_outproj(const Params& P, char* smem) {
  bfu* sA = (bfu*)smem; bfu* sB = sA + 128 * 72;
  const bfu* mg = (const bfu*)(P.ws + SLOT(6));
  for (int t = blockIdx.x; t < 260 * 8; t += gridDim.x) {
    int mt, nt; tile_map(t, 260, 8, mt, nt);
    f32x16 acc[2][2]; zero_acc(acc);
    gemm_acc(acc, mg + (size_t)mt * 128 * 1024, 1024, (const bfu*)(P.ws + O_WT_OUT) + (size_t)nt * 128 * 1024, 1024, 1024, sA, sB);
    float* sT32 = (float*)smem;
    __syncthreads();
    {
      EPI_BEGIN
#pragma unroll
        for (int j = 0; j < 4; ++j) {
          sT32[(r0 + j) * ST32_LD + cl] = acc[mi][0][q * 4 + j];
          sT32[(r0 + j) * ST32_LD + cl + 64] = acc[mi][1][q * 4 + j];
        }
      EPI_END
    }
    __syncthreads();
#pragma unroll
    for (int i = 0; i < 16; ++i) {
      int id = threadIdx.x + i * 256, row = id >> 5, c4 = (id & 31) * 4;
      int r = mt * 128 + row;
      float4 a = *(const float4*)(sT32 + row * ST32_LD + c4);
      float4 x = *(const float4*)(xrow(P, r) + nt * 128 + c4);
      float4 o = make_float4(x.x + a.x, x.y + a.y, x.z + a.z, x.w + a.w);
      *(float4*)(P.out + (size_t)r * 1024 + nt * 128 + c4) = o;
      float4 g = *(const float4*)(P.g_ffn + nt * 128 + c4);
      uint2 hv; hv.x = pack2(o.x * g.x, o.y * g.y); hv.y = pack2(o.z * g.z, o.w * g.w);
      *(uint2*)((bfu*)(P.ws + SLOT(0)) + (size_t)r * 1024 + nt * 128 + c4) = hv;
      float ss = o.x * o.x + o.y * o.y + o.z * o.z + o.w * o.w;
      ss = dpp_ror_add(ss, 8); ss = dpp_ror_add(ss, 4); ss = dpp_ror_add(ss, 2); ss = dpp_ror_add(ss, 1);
      ss += __shfl_xor(ss, 16);
      if ((threadIdx.x & 31) == 0) ((float*)(P.ws + O_GPRE))[(size_t)r * 8 + nt] = ss;
    }
  }
}

__device__ void phase_norm_rows(const Params& P, const float* g, bfu* dst) {
  const int lane = threadIdx.x & 63, w = threadIdx.x >> 6;
  for (int r = blockIdx.x * 4 + w; r < MT; r += gridDim.x * 4) {
    const float* xr = P.out + (size_t)r * 1024;
    float4 v[4]; float ss = 0.f;
#pragma unroll
    for (int i = 0; i < 4; ++i) {
      v[i] = *(const float4*)(xr + i * 256 + lane * 4);
      ss += v[i].x * v[i].x + v[i].y * v[i].y + v[i].z * v[i].z + v[i].w * v[i].w;
    }
    ss = wave_sum(ss);
    float rstd = rsqrtf(ss * (1.f / 1024.f) + EPS);
#pragma unroll
    for (int i = 0; i < 4; ++i) {
      float4 gg = *(const float4*)(g + i * 256 + lane * 4);
      uint2 o; o.x = pack2(v[i].x * rstd * gg.x, v[i].y * rstd * gg.y); o.y = pack2(v[i].z * rstd * gg.z, v[i].w * rstd * gg.w);
      *(uint2*)(dst + (size_t)r * 1024 + i * 256 + lane * 4) = o;
    }
  }
}

__device__ void phase_pq(const Params& P, char* smem) {
  bfu* sA = (bfu*)smem; bfu* sB = sA + 128 * 72;
  const bfu* hq = (const bfu*)(P.ws + SLOT(0));
  bfu* qb = (bfu*)(P.ws + SLOT(9));
  for (int t = blockIdx.x; t < 260 * 16; t += gridDim.x) {
    int mt, nt; tile_map(t, 260, 16, mt, nt);
    f32x16 acc[2][2]; zero_acc(acc);
    float* sRstd = (float*)(smem + 66048);
    if (threadIdx.x < 128) {
      const float* pp = (const float*)(P.ws + O_GPRE) + (size_t)(mt * 128 + threadIdx.x) * 8;
      float4 p0 = *(const float4*)pp, p1 = *(const float4*)(pp + 4);
      sRstd[threadIdx.x] = rsqrtf((p0.x + p0.y + p0.z + p0.w + p1.x + p1.y + p1.z + p1.w) * (1.f / 1024.f) + EPS);
    }
    gemm_acc(acc, hq + (size_t)mt * 128 * 1024, 1024, (const bfu*)(P.ws + O_WT_PQ) + (size_t)nt * 128 * 1024, 1024, 1024, sA, sB);
    bfu* sT = (bfu*)smem;
    __syncthreads();
    {
      EPI_BEGIN
#pragma unroll
        for (int j = 0; j < 4; ++j) {
          const float rs = sRstd[r0 + j];
          sT[(r0 + j) * ST_LD + cl] = f2bf(acc[mi][0][q * 4 + j] * rs);
          sT[(r0 + j) * ST_LD + cl + 64] = f2bf(acc[mi][1][q * 4 + j] * rs);
        }
      EPI_END
    }
    __syncthreads();
    copyout_bf16(sT, qb + (size_t)mt * 128 * 2048 + nt * 128, 2048);
  }
}


template <bool DESC> __device__ __forceinline__ void cex(float& a, float& b) {
  float mx = fmaxf(a, b), mn = fminf(a, b);
  a = DESC ? mx : mn; b = DESC ? mn : mx;
}
template <int B, bool DESC> __device__ __forceinline__ void bmerge16(float (&v)[64]) {
#pragma unroll
  for (int j = 8; j > 0; j >>= 1)
#pragma unroll
    for (int i = 0; i < 16; ++i) { int l = i ^ j; if (l > i) cex<DESC>(v[B + i], v[B + l]); }
}
template <int B, bool DESC> __device__ __forceinline__ void bsort16(float (&v)[64]) {
#pragma unroll
  for (int k = 2; k <= 16; k <<= 1)
#pragma unroll
    for (int j = k >> 1; j > 0; j >>= 1)
#pragma unroll
      for (int i = 0; i < 16; ++i) {
        int l = i ^ j;
        if (l > i) {
          bool up = ((i & k) == 0) || (k == 16);
          if (up == true) { if (DESC) cex<true>(v[B + i], v[B + l]); else cex<false>(v[B + i], v[B + l]); }
          else { if (DESC) cex<false>(v[B + i], v[B + l]); else cex<true>(v[B + i], v[B + l]); }
        }
      }
}
__device__ __forceinline__ float pair_max(float v) {
  auto r = __builtin_amdgcn_permlane32_swap(__float_as_int(v), __float_as_int(v), false, false);
  return fmaxf(__int_as_float(r[0]), __int_as_float(r[1]));
}
__device__ void phase_topk(const Params& P, char* smem) {
  const int tid = threadIdx.x, lane = tid & 63, w = tid >> 6, r32 = lane & 31, hh = lane >> 5;
  unsigned* sL = (unsigned*)smem + w * 1664;
  unsigned* sW = sL + 32 * 33;
  const bfu* qb = (const bfu*)(P.ws + SLOT(9));
  const bfu* keys = (const bfu*)(P.ws + O_KEYS);
  int* ids = (int*)(P.ws + SLOT(4));
  float* gw = (float*)(P.ws + SLOT(13));
  for (int item = blockIdx.x * 4 + w; item < 1040 * 8; item += gridDim.x * 4) {
    const int tg = item >> 3, n = item & 7, rowb = tg * 32;
#pragma unroll 1
    for (int half = 0; half < 2; ++half) {
      f32x16 acc[4];
#pragma unroll
      for (int c = 0; c < 4; ++c)
#pragma unroll
        for (int i = 0; i < 16; ++i) acc[c][i] = 0.f;
      const bfu* kp = keys + (size_t)((n * 2 + half) * 128 + r32) * 128 + hh * 8;
      const bfu* qp = qb + (size_t)(rowb + r32) * 2048 + n * 256 + half * 128 + hh * 8;
#pragma unroll
      for (int ks = 0; ks < 8; ++ks) {
        bf16x8 bfr = *(const bf16x8*)(qp + ks * 16);
#pragma unroll
        for (int c = 0; c < 4; ++c) {
          bf16x8 af = *(const bf16x8*)(kp + (size_t)c * 32 * 128 + ks * 16);
          acc[c] = __builtin_amdgcn_mfma_f32_32x32x16_bf16(af, bfr, acc[c], 0, 0, 0);
        }
      }
      float kk[64];
#pragma unroll
      for (int c = 0; c < 4; ++c)
#pragma unroll
        for (int reg = 0; reg < 16; ++reg) {
          unsigned kidx = c * 32 + (reg & 3) + 8 * (reg >> 2) + 4 * hh;
          kk[c * 16 + reg] = __uint_as_float((__float_as_uint(acc[c][reg]) & ~127u) | kidx);
        }
      bsort16<0, true>(kk); bsort16<16, false>(kk); bsort16<32, false>(kk); bsort16<48, true>(kk);
#pragma unroll
      for (int i = 0; i < 16; ++i) { kk[i] = fmaxf(kk[i], kk[16 + i]); kk[32 + i] = fmaxf(kk[32 + i], kk[48 + i]); }
      bmerge16<0, true>(kk); bmerge16<32, false>(kk);
#pragma unroll
      for (int i = 0; i < 16; ++i) kk[i] = fmaxf(kk[i], kk[32 + i]);
      bmerge16<0, true>(kk);
      {
        float lo[16], hi[16];
#pragma unroll
        for (int i = 0; i < 16; ++i) {
          auto r = __builtin_amdgcn_permlane32_swap(__float_as_int(kk[i]), __float_as_int(kk[i]), false, false);
          lo[i] = __int_as_float(r[0]); hi[i] = __int_as_float(r[1]);
        }
#pragma unroll
        for (int i = 0; i < 16; ++i) kk[i] = fmaxf(lo[i], hi[15 - i]);
      }
      bmerge16<0, true>(kk);
      if (hh == 0) {
#pragma unroll
        for (int p = 0; p < 16; ++p) sL[r32 * 33 + half * 16 + p] = __float_as_uint(kk[p]);
      }
    }
    __builtin_amdgcn_fence(__ATOMIC_RELEASE, "workgroup");
    __builtin_amdgcn_wave_barrier();
    __builtin_amdgcn_fence(__ATOMIC_ACQUIRE, "workgroup");
    float x[4], y[16];
    {
      const unsigned* lx = sL + r32 * 33 + (hh ? 16 : 0);
      const unsigned* ly = sL + r32 * 33 + (hh ? 0 : 16);
#pragma unroll
      for (int i = 0; i < 4; ++i) x[i] = __uint_as_float(lx[i] & ~127u);
#pragma unroll
      for (int j = 0; j < 16; ++j) y[j] = __uint_as_float(ly[j] & ~127u);
    }
    float cd[25];
#define CAND(t, i, j) { float sv = x[i] + y[j]; unsigned code = hh ? ((j) << 4 | (i)) : ((i) << 4 | (j)); \
      cd[t] = __uint_as_float((__float_as_uint(sv) & ~255u) | code); }
    CAND(0, 0, 1) CAND(1, 0, 2) CAND(2, 0, 3) CAND(3, 0, 4) CAND(4, 0, 5) CAND(5, 0, 6) CAND(6, 0, 7) CAND(7, 0, 8)
    CAND(8, 0, 9) CAND(9, 0, 10) CAND(10, 0, 11) CAND(11, 0, 12) CAND(12, 0, 13) CAND(13, 0, 14) CAND(14, 0, 15)
    CAND(15, 1, 2) CAND(16, 1, 3) CAND(17, 1, 4) CAND(18, 1, 5) CAND(19, 1, 6) CAND(20, 1, 7) CAND(21, 2, 3) CAND(22, 2, 4)
    {
      float d0 = hh ? x[2] + y[2] : x[0] + y[0];
      float d1 = hh ? x[3] + y[3] : x[1] + y[1];
      unsigned c0 = hh ? 0x22u : 0x00u, c1 = hh ? 0x33u : 0x11u;
      cd[23] = __uint_as_float((__float_as_uint(d0) & ~255u) | c0);
      cd[24] = __uint_as_float((__float_as_uint(d1) & ~255u) | c1);
    }
    {
      float cv[64];
#pragma unroll
      for (int t = 0; t < 25; ++t) cv[t] = cd[t];
#pragma unroll
      for (int t = 25; t < 32; ++t) cv[t] = -INFINITY;
      bsort16<0, true>(cv); bsort16<16, false>(cv);
#pragma unroll
      for (int i = 0; i < 16; ++i) cv[i] = fmaxf(cv[i], cv[16 + i]);
      bmerge16<0, true>(cv);
      {
        float lo[16], hi[16];
#pragma unroll
        for (int i = 0; i < 16; ++i) {
          auto r = __builtin_amdgcn_permlane32_swap(__float_as_int(cv[i]), __float_as_int(cv[i]), false, false);
          lo[i] = __int_as_float(r[0]); hi[i] = __int_as_float(r[1]);
        }
#pragma unroll
        for (int i = 0; i < 16; ++i) cv[i] = fmaxf(lo[i], hi[15 - i]);
      }
      bmerge16<0, true>(cv);
      if (hh == 0) {
#pragma unroll
        for (int p = 0; p < 16; ++p) sW[r32 * 17 + p] = __float_as_uint(cv[p]);
      }
    }
    __builtin_amdgcn_fence(__ATOMIC_RELEASE, "workgroup");
    __builtin_amdgcn_wave_barrier();
    __builtin_amdgcn_fence(__ATOMIC_ACQUIRE, "workgroup");
    {
      const unsigned* la = sL + r32 * 33;
      unsigned c0 = sW[r32 * 17] & 255u;
      float scmax = __uint_as_float(la[c0 >> 4] & ~127u) + __uint_as_float(la[16 + (c0 & 15)] & ~127u);
      float ex[8]; int ee[8]; float sum = 0.f;
#pragma unroll
      for (int k = 0; k < 8; ++k) {
        unsigned code = sW[r32 * 17 + hh * 8 + k] & 255u;
        unsigned ka = la[code >> 4], kb = la[16 + (code & 15)];
        float sc = __uint_as_float(ka & ~127u) + __uint_as_float(kb & ~127u);
        ex[k] = __expf(sc - scmax);
        ee[k] = (int)((ka & 127u) * 128u + (kb & 127u));
        sum += ex[k];
      }
      sum += __shfl_xor(sum, 32);
      float inv = 1.f / sum;
      size_t o = (size_t)(rowb + r32) * 128 + n * 16 + hh * 8;
      *(int4*)(ids + o) = make_int4(ee[0], ee[1], ee[2], ee[3]);
      *(int4*)(ids + o + 4) = make_int4(ee[4], ee[5], ee[6], ee[7]);
      *(float4*)(gw + o) = make_float4(ex[0] * inv, ex[1] * inv, ex[2] * inv, ex[3] * inv);
      *(float4*)(gw + o + 4) = make_float4(ex[4] * inv, ex[5] * inv, ex[6] * inv, ex[7] * inv);
    }
    __builtin_amdgcn_wave_barrier();
  }
}

typedef float f2v __attribute__((ext_vector_type(2)));
#define U8_SCALE 512.f
#define V8_SCALE 128.f
__device__ void convert_fp8(const float* __restrict__ src, unsigned char* __restrict__ dst, size_t n16, float scale,
                            int gtid, int gstride) {
  for (size_t i = gtid; i < n16; i += gstride) {
    unsigned w[4];
#pragma unroll
    for (int k = 0; k < 4; ++k) {
      float4 a = *(const float4*)(src + i * 16 + k * 4);
      float v0 = fminf(fmaxf(a.x * scale, -448.f), 448.f), v1 = fminf(fmaxf(a.y * scale, -448.f), 448.f);
      float v2 = fminf(fmaxf(a.z * scale, -448.f), 448.f), v3 = fminf(fmaxf(a.w * scale, -448.f), 448.f);
      int t = 0;
      t = __builtin_amdgcn_cvt_pk_fp8_f32(v0, v1, t, false);
      t = __builtin_amdgcn_cvt_pk_fp8_f32(v2, v3, t, true);
      w[k] = (unsigned)t;
    }
    *(uint4*)(dst + i * 16) = make_uint4(w[0], w[1], w[2], w[3]);
  }
}
__device__ __forceinline__ float dot16_fp8(uint4 u, const f2v* x2) {
  f2v acc = __builtin_amdgcn_cvt_pk_f32_fp8((int)u.x, false) * x2[0];
  acc += __builtin_amdgcn_cvt_pk_f32_fp8((int)u.x, true) * x2[1];
  acc += __builtin_amdgcn_cvt_pk_f32_fp8((int)u.y, false) * x2[2];
  acc += __builtin_amdgcn_cvt_pk_f32_fp8((int)u.y, true) * x2[3];
  acc += __builtin_amdgcn_cvt_pk_f32_fp8((int)u.z, false) * x2[4];
  acc += __builtin_amdgcn_cvt_pk_f32_fp8((int)u.z, true) * x2[5];
  acc += __builtin_amdgcn_cvt_pk_f32_fp8((int)u.w, false) * x2[6];
  acc += __builtin_amdgcn_cvt_pk_f32_fp8((int)u.w, true) * x2[7];
  return acc.x + acc.y;
}
__device__ __forceinline__ void axpy16_fp8(f2v* o2, float cf, uint4 v) {
  f2v c = {cf, cf};
  o2[0] += c * __builtin_amdgcn_cvt_pk_f32_fp8((int)v.x, false);
  o2[1] += c * __builtin_amdgcn_cvt_pk_f32_fp8((int)v.x, true);
  o2[2] += c * __builtin_amdgcn_cvt_pk_f32_fp8((int)v.y, false);
  o2[3] += c * __builtin_amdgcn_cvt_pk_f32_fp8((int)v.y, true);
  o2[4] += c * __builtin_amdgcn_cvt_pk_f32_fp8((int)v.z, false);
  o2[5] += c * __builtin_amdgcn_cvt_pk_f32_fp8((int)v.z, true);
  o2[6] += c * __builtin_amdgcn_cvt_pk_f32_fp8((int)v.w, false);
  o2[7] += c * __builtin_amdgcn_cvt_pk_f32_fp8((int)v.w, true);
}
#define PEER_LOAD(u, v, b)                                                                   \
  _Pragma("unroll") for (int k = 0; k < 8; ++k) {                                            \
    int j = (b) * 8 + k;                                                                     \
    int e = __builtin_amdgcn_readlane((b) < 8 ? id0 : id1, j & 63);                          \
    u[k] = *(const uint4*)(U8 + (size_t)e * 1024 + lane * 16);                               \
    v[k] = *(const uint4*)(V8 + (size_t)e * 1024 + lane * 16);                               \
  }
#define PEER_COMP(u, v, b)                                                                   \
  _Pragma("unroll") for (int hf = 0; hf < 2; ++hf) {                                         \
    float s = reduce4(dot16_fp8(u[hf * 4 + 0], x2), dot16_fp8(u[hf * 4 + 1], x2),           \
                      dot16_fp8(u[hf * 4 + 2], x2), dot16_fp8(u[hf * 4 + 3], x2)) * xr_rstd; \
    float act = 0.5f * s * (1.f + erff(s * 0.7071067811865475f));                            \
    float gsel = __shfl((b) < 8 ? g0 : g1, ((b) * 8 + hf * 4 + (lane >> 4)) & 63);           \
    float cfv = act * gsel * (1.f / V8_SCALE);                                               \
    axpy16_fp8(o2, __int_as_float(__builtin_amdgcn_readlane(__float_as_int(cfv), 0)), v[hf * 4 + 0]);  \
    axpy16_fp8(o2, __int_as_float(__builtin_amdgcn_readlane(__float_as_int(cfv), 16)), v[hf * 4 + 1]); \
    axpy16_fp8(o2, __int_as_float(__builtin_amdgcn_readlane(__float_as_int(cfv), 32)), v[hf * 4 + 2]); \
    axpy16_fp8(o2, __int_as_float(__builtin_amdgcn_readlane(__float_as_int(cfv), 48)), v[hf * 4 + 3]); \
  }
__device__ void phase_peer(const Params& P) {
  const int lane = threadIdx.x & 63, w = threadIdx.x >> 6;
  bfu* hq = (bfu*)(P.ws + SLOT(0));
  const unsigned char* U8 = (const unsigned char*)(P.ws + SLOT(2));
  const unsigned char* V8 = (const unsigned char*)(P.ws + SLOT(3));
  const int* ids = (const int*)(P.ws + SLOT(4));
  const float* gw = (const float*)(P.ws + SLOT(13));
  bfu* pbf = (bfu*)(P.ws + SLOT(6));
  for (int r = blockIdx.x * 4 + w; r < MT; r += gridDim.x * 4) {
    f2v x2[8], o2[8];
    {
      uint4 v0 = *(const uint4*)(hq + (size_t)r * 1024 + lane * 16);
      uint4 v1 = *(const uint4*)(hq + (size_t)r * 1024 + lane * 16 + 8);
      float xf[16];
      unpack8(v0, xf); unpack8(v1, xf + 8);
#pragma unroll
      for (int j = 0; j < 8; ++j) { x2[j].x = xf[2 * j]; x2[j].y = xf[2 * j + 1]; o2[j].x = 0.f; o2[j].y = 0.f; }
    }
    int id0 = ids[(size_t)r * 128 + lane], id1 = ids[(size_t)r * 128 + 64 + lane];
    float g0 = gw[(size_t)r * 128 + lane], g1 = gw[(size_t)r * 128 + 64 + lane];
    float xr_rstd;
    {
      const float* pp = (const float*)(P.ws + O_GPRE) + (size_t)r * 8;
      float4 p0 = *(const float4*)pp, p1 = *(const float4*)(pp + 4);
      xr_rstd = rsqrtf((p0.x + p0.y + p0.z + p0.w + p1.x + p1.y + p1.z + p1.w) * (1.f / 1024.f) + EPS) * (1.f / U8_SCALE);
    }
    uint4 uA[8], vA[8], uB[8], vB[8];
    PEER_LOAD(uA, vA, 0)
    for (int b = 0; b < 16; b += 2) {
      PEER_LOAD(uB, vB, b + 1)
      PEER_COMP(uA, vA, b)
      if (b + 2 < 16) { PEER_LOAD(uA, vA, b + 2) }
      PEER_COMP(uB, vB, b + 1)
    }
    float* xr = P.out + (size_t)r * 1024 + lane * 16;
    float x3[16];
    float ss = 0.f;
#pragma unroll
    for (int k = 0; k < 4; ++k) {
      float4 a = *(const float4*)(xr + k * 4);
      x3[k * 4 + 0] = a.x + o2[k * 2].x; x3[k * 4 + 1] = a.y + o2[k * 2].y;
      x3[k * 4 + 2] = a.z + o2[k * 2 + 1].x; x3[k * 4 + 3] = a.w + o2[k * 2 + 1].y;
      *(float4*)(xr + k * 4) = make_float4(x3[k * 4], x3[k * 4 + 1], x3[k * 4 + 2], x3[k * 4 + 3]);
    }
#pragma unroll
    for (int j = 0; j < 16; ++j) ss += x3[j] * x3[j];
    ss = wave_sum(ss);
    float rstd = rsqrtf(ss * (1.f / 1024.f) + EPS);
    float hv[16];
#pragma unroll
    for (int k = 0; k < 4; ++k) {
      float4 ga = *(const float4*)(P.g_ple + lane * 16 + k * 4);
      hv[k * 4] = x3[k * 4] * rstd * ga.x; hv[k * 4 + 1] = x3[k * 4 + 1] * rstd * ga.y;
      hv[k * 4 + 2] = x3[k * 4 + 2] * rstd * ga.z; hv[k * 4 + 3] = x3[k * 4 + 3] * rstd * ga.w;
    }
    *(uint4*)(hq + (size_t)r * 1024 + lane * 16) = pack8(hv);
    *(uint4*)(hq + (size_t)r * 1024 + lane * 16 + 8) = pack8(hv + 8);
    {
      const float* pr = r < MP ? P.pp + (size_t)r * 256 : P.ps + (size_t)(r - MP) * 256;
      float4 a = *(const float4*)(pr + lane * 4);
      uint2 ov; ov.x = pack2(a.x, a.y); ov.y = pack2(a.z, a.w);
      *(uint2*)(pbf + (size_t)r * 256 + lane * 4) = ov;
    }
  }
}

__device__ void phase_ple(const Params& P, char* smem) {
  bfu* sA = (bfu*)smem; bfu* sB = sA + 128 * 72;
  const bfu* hg = (const bfu*)(P.ws + SLOT(0));
  const bfu* pbf = (const bfu*)(P.ws + SLOT(6));
  for (int t = blockIdx.x; t < 260 * 8; t += gridDim.x) {
    int mt, nt; tile_map(t, 260, 8, mt, nt);
    f32x16 acc[2][2]; zero_acc(acc);
    bfu* sT = (bfu*)smem; float* sT32 = (float*)smem;
    uint2 pg[16];
    gemm_acc(acc, hg + (size_t)mt * 128 * 1024, 1024, (const bfu*)(P.ws + O_WT_PG) + (size_t)nt * 128 * 1024, 1024, 1024, sA, sB);
    __syncthreads();
    {
      EPI_BEGIN
#pragma unroll
        for (int j = 0; j < 4; ++j) {
          sT[(r0 + j) * ST_LD + cl] = f2bf(sigmoidf_(acc[mi][0][q * 4 + j]));
          sT[(r0 + j) * ST_LD + cl + 64] = f2bf(sigmoidf_(acc[mi][1][q * 4 + j]));
        }
      EPI_END
    }
    __syncthreads();
#pragma unroll
    for (int i = 0; i < 16; ++i) {
      int id = threadIdx.x + i * 256, row = id >> 5, c4 = (id & 31) * 4;
      pg[i] = *(const uint2*)(sT + row * ST_LD + c4);
    }
    zero_acc(acc);
    gemm_acc(acc, pbf + (size_t)mt * 128 * 256, 256, (const bfu*)(P.ws + O_WT_PLE) + (size_t)nt * 128 * 256, 256, 256, sA, sB);
    __syncthreads();
    {
      EPI_BEGIN
#pragma unroll
        for (int j = 0; j < 4; ++j) {
          sT32[(r0 + j) * ST32_LD + cl] = acc[mi][0][q * 4 + j];
          sT32[(r0 + j) * ST32_LD + cl + 64] = acc[mi][1][q * 4 + j];
        }
      EPI_END
    }
    __syncthreads();
#pragma unroll
    for (int i = 0; i < 16; ++i) {
      int id = threadIdx.x + i * 256, row = id >> 5, c4 = (id & 31) * 4;
      float4 a = *(const float4*)(sT32 + row * ST32_LD + c4);
      float* op = P.out + (size_t)(mt * 128 + row) * 1024 + nt * 128 + c4;
      float4 x = *(const float4*)op;
      float g0 = bf2f(pg[i].x & 0xffff), g1 = bf2f(pg[i].x >> 16), g2 = bf2f(pg[i].y & 0xffff), g3 = bf2f(pg[i].y >> 16);
      *(float4*)op = make_float4(x.x + a.x * g0, x.y + a.y * g1, x.z + a.z * g2, x.w + a.w * g3);
    }
  }
}

__device__ void phase_final(const Params& P) {
  const int lane = threadIdx.x & 63, w = threadIdx.x >> 6;
  for (int r = blockIdx.x * 4 + w; r < MT; r += gridDim.x * 4) {
    float* xr = P.out + (size_t)r * 1024;
    float4 v[4]; float ss = 0.f;
#pragma unroll
    for (int i = 0; i < 4; ++i) {
      v[i] = *(const float4*)(xr + i * 256 + lane * 4);
      ss += v[i].x * v[i].x + v[i].y * v[i].y + v[i].z * v[i].z + v[i].w * v[i].w;
    }
    ss = wave_sum(ss);
    float rstd = rsqrtf(ss * (1.f / 1024.f) + EPS);
#pragma unroll
    for (int i = 0; i < 4; ++i) {
      float4 gg = *(const float4*)(P.g_final + i * 256 + lane * 4);
      *(float4*)(xr + i * 256 + lane * 4) = make_float4(v[i].x * rstd * gg.x, v[i].y * rstd * gg.y, v[i].z * rstd * gg.z, v[i].w * rstd * gg.w);
    }
  }
}

__global__ void __launch_bounds__(NTHREADS, 2) fwd_megakernel(Params P) {
  extern __shared__ __attribute__((aligned(16))) char smem[];
  cg::grid_group grid = cg::this_grid();
  __shared__ uint4 xb_words;
  if (threadIdx.x == 0) xb_words = make_uint4(0u, 0u, 0u, 0u);
  __syncthreads();
  XcdBarrier xb = xcd_barrier_post((unsigned*)(P.ws + O_BAR), (volatile LAS unsigned*)&xb_words);
  if (P.out == nullptr) grid.sync();
  const int gtid = blockIdx.x * NTHREADS + threadIdx.x, gstride = gridDim.x * NTHREADS;
  phase_prep(P, smem);
  xcd_barrier(xb);
  phase_gemm1(P, smem);
  xcd_barrier(xb);
  phase_conv(P);
  gate_scan(P);
  xcd_barrier(xb);
  m_fold(P);
  phase_mqk(P, smem);
  xcd_barrier(xb);
  for (int t = blockIdx.x; t < 4224; t += gridDim.x) phaseA_item(P, t / 2112, t % 2112, smem);
  xcd_barrier(xb);
  phase_scan(P);
  xcd_barrier(xb);
  for (int t = blockIdx.x; t < 4224; t += gridDim.x) phaseC_item(P, t / 2112, t % 2112, smem);
  xcd_barrier(xb);
  phase_merge(P, smem);
  {
    const int extra = 2080 % (int)gridDim.x;
    if ((int)blockIdx.x >= extra) {
      const int cg_tid = ((int)blockIdx.x - extra) * NTHREADS + threadIdx.x, cg_str = ((int)gridDim.x - extra) * NTHREADS;
      convert_fp8(P.peer_u, (unsigned char*)(P.ws + SLOT(2)), 16384ull * 1024 / 16, U8_SCALE, cg_tid, cg_str);
      convert_fp8(P.peer_v, (unsigned char*)(P.ws + SLOT(3)), 16384ull * 1024 / 16, V8_SCALE, cg_tid, cg_str);
    }
  }
  xcd_barrier(xb);
  phase_outproj(P, smem);
  xcd_barrier(xb);
  phase_pq(P, smem);
  xcd_barrier(xb);
  phase_topk(P, smem);
  xcd_barrier(xb);
  phase_peer(P);
  xcd_barrier(xb);
  phase_ple(P, smem);
  xcd_barrier(xb);
  phase_final(P);
}

extern "C" void kernel_launch(void* const* d_in, const int* in_sizes, int n_in, void* d_out, int out_size,
                              void* d_ws, size_t ws_size, hipStream_t stream) {
  static int grid_blocks = 0;
  if (!grid_blocks) {
    hipFuncSetAttribute((const void*)fwd_megakernel, hipFuncAttributeMaxDynamicSharedMemorySize, SMEM_BYTES);
    int dev = 0, cus = 0, per_cu = 0;
    hipGetDevice(&dev);
    hipDeviceGetAttribute(&cus, hipDeviceAttributeMultiprocessorCount, dev);
    hipOccupancyMaxActiveBlocksPerMultiprocessor(&per_cu, fwd_megakernel, NTHREADS, SMEM_BYTES);
    if (per_cu > 2) per_cu = 2;
    if (per_cu < 1) per_cu = 1;
    grid_blocks = cus * per_cu;
  }
  Params p{};
  const float** pf = (const float**)&p;
  for (int i = 0; i < 32; ++i) pf[i] = (const float*)d_in[i];
  p.out = (float*)d_out;
  p.ws = (char*)d_ws;
  hipMemsetAsync((char*)d_ws + O_BAR, 0, XCD_BAR_WORDS * 4, stream);
  void* args[] = {&p};
  hipError_t e = hipLaunchCooperativeKernel((void*)fwd_megakernel, dim3(grid_blocks), dim3(NTHREADS), args, SMEM_BYTES, stream);
  if (e != hipSuccess) fprintf(stderr, "cooperative launch failed: %s (grid %d)\n", hipGetErrorString(e), grid_blocks);
}
```

```cpp
#include <hip/hip_runtime.h>
#include <hip/hip_cooperative_groups.h>
#include <cstdio>
namespace cg = cooperative_groups;

typedef unsigned short bfu;
typedef __attribute__((ext_vector_type(8))) short bf16x8;
typedef __attribute__((ext_vector_type(16))) float f32x16;

#define MT 33280
#define MP 32768
#define NTHREADS 256
#define EPS 1e-6f

struct Params {
  const float *xp, *xs, *pp, *ps, *st_ret, *st_C, *st_n, *st_m, *st_conv, *g_mix, *w_in, *g_ret_gn, *w_mq,
      *w_mk, *conv_w, *conv_b, *b_i, *b_f, *g_ml_gn, *w_skip, *w_up_r, *w_up_m, *w_out, *g_ffn, *w_pq,
      *peer_keys, *peer_u, *peer_v, *g_ple, *w_pg, *w_ple, *g_final;
  float* out;
  char* ws;
};

constexpr size_t O_WT_IN = 0;
constexpr size_t O_WT_UPR = O_WT_IN + 5632ull * 1024 * 2;
constexpr size_t O_WT_UPM = O_WT_UPR + 1024ull * 512 * 2;
constexpr size_t O_WT_OUT = O_WT_UPM + 1024ull * 512 * 2;
constexpr size_t O_WT_PQ = O_WT_OUT + 1024ull * 1024 * 2;
constexpr size_t O_WT_PG = O_WT_PQ + 2048ull * 1024 * 2;
constexpr size_t O_WT_PLE = O_WT_PG + 1024ull * 1024 * 2;
constexpr size_t O_KEYS = O_WT_PLE + 1024ull * 256 * 2;
constexpr size_t O_WT_MQ = O_KEYS + 16ull * 128 * 128 * 2;
constexpr size_t O_WT_MK = O_WT_MQ + 4ull * 128 * 128 * 2;
constexpr size_t O_COS = O_WT_MK + 4ull * 128 * 128 * 2;
constexpr size_t O_SIN = O_COS + 8192ull * 64 * 4;
constexpr size_t O_FQ = O_SIN + 8192ull * 64 * 4;
constexpr size_t O_UQ = O_FQ + (size_t)MT * 16;
constexpr size_t O_CMQ = O_UQ + (size_t)MT * 16;
constexpr size_t O_FL = O_CMQ + (size_t)MT * 16;
constexpr size_t O_UC = O_FL + 16384;
constexpr size_t O_AEND = O_UC + 16384;
constexpr size_t O_MCS = O_AEND + 16384;
constexpr size_t O_DN = O_MCS + 16384;
constexpr size_t O_DSS = O_DN + 2112ull * 128 * 4;
constexpr size_t O_GPRE = O_DSS + 2ull * 64 * 16384 * 2;
constexpr size_t O_BAR = O_GPRE + (size_t)MT * 32;
constexpr size_t O_SMALL_END = O_BAR + 16384;
constexpr size_t SLOT0 = 40ull << 20;
constexpr size_t USZ = (size_t)MT * 512 * 2;
static_assert(O_SMALL_END <= SLOT0, "small region overflow");
#define SLOT(i) (SLOT0 + (size_t)(i) * USZ)
constexpr size_t SB_T = 16ull * 128 * 8192;

constexpr size_t OO_Y = 0;
constexpr size_t OO_RETP = (size_t)MT * 1024;
constexpr size_t OO_CP = OO_RETP + 262144;
constexpr size_t OO_NP = OO_CP + 262144;
constexpr size_t OO_MP = OO_NP + 2048;
constexpr size_t OO_CONVP = OO_MP + 16;
constexpr size_t OO_RETS = OO_CONVP + 6144;
constexpr size_t OO_CS = OO_RETS + 1048576;
constexpr size_t OO_NS = OO_CS + 1048576;
constexpr size_t OO_MS = OO_NS + 8192;
constexpr size_t OO_CONVS = OO_MS + 64;

constexpr int SMEM_BYTES = 81152;

__device__ __forceinline__ bfu f2bf(float f) {
  unsigned u = __float_as_uint(f);
  u += 0x7fffu + ((u >> 16) & 1u);
  return (bfu)(u >> 16);
}
__device__ __forceinline__ float bf2f(bfu b) { return __uint_as_float(((unsigned)b) << 16); }
__device__ __forceinline__ unsigned pack2(float a, float b) { return (unsigned)f2bf(a) | ((unsigned)f2bf(b) << 16); }
__device__ __forceinline__ void unpack8(uint4 v, float* f) {
  f[0] = bf2f(v.x & 0xffff); f[1] = bf2f(v.x >> 16); f[2] = bf2f(v.y & 0xffff); f[3] = bf2f(v.y >> 16);
  f[4] = bf2f(v.z & 0xffff); f[5] = bf2f(v.z >> 16); f[6] = bf2f(v.w & 0xffff); f[7] = bf2f(v.w >> 16);
}
__device__ __forceinline__ uint4 pack8(const float* f) {
  uint4 o; o.x = pack2(f[0], f[1]); o.y = pack2(f[2], f[3]); o.z = pack2(f[4], f[5]); o.w = pack2(f[6], f[7]);
  return o;
}
__device__ __forceinline__ float wave_sum(float v) {
#pragma unroll
  for (int o = 32; o > 0; o >>= 1) v += __shfl_xor(v, o);
  return v;
}
__device__ __forceinline__ float wave_max(float v) {
#pragma unroll
  for (int o = 32; o > 0; o >>= 1) v = fmaxf(v, __shfl_xor(v, o));
  return v;
}
__device__ __forceinline__ float dpp_ror_add(float s, const int ctrl_sel) {
  int v = __float_as_int(s);
  int t;
  if (ctrl_sel == 8) t = __builtin_amdgcn_update_dpp(0, v, 0x128, 0xf, 0xf, false);
  else if (ctrl_sel == 4) t = __builtin_amdgcn_update_dpp(0, v, 0x124, 0xf, 0xf, false);
  else if (ctrl_sel == 2) t = __builtin_amdgcn_update_dpp(0, v, 0x122, 0xf, 0xf, false);
  else t = __builtin_amdgcn_update_dpp(0, v, 0x121, 0xf, 0xf, false);
  return s + __int_as_float(t);
}
__device__ __forceinline__ float reduce4(float p0, float p1, float p2, float p3) {
  auto r = __builtin_amdgcn_permlane32_swap(__float_as_int(p0), __float_as_int(p2), false, false);
  float sA = __int_as_float(r[0]) + __int_as_float(r[1]);
  r = __builtin_amdgcn_permlane32_swap(__float_as_int(p1), __float_as_int(p3), false, false);
  float sB = __int_as_float(r[0]) + __int_as_float(r[1]);
  r = __builtin_amdgcn_permlane16_swap(__float_as_int(sA), __float_as_int(sB), false, false);
  float s = __int_as_float(r[0]) + __int_as_float(r[1]);
  s = dpp_ror_add(s, 8); s = dpp_ror_add(s, 4); s = dpp_ror_add(s, 2); s = dpp_ror_add(s, 1);
  return s;
}
__device__ __forceinline__ float sigmoidf_(float x) { return 1.f / (1.f + __expf(-x)); }
__device__ __forceinline__ const float* xrow(const Params& P, int r) {
  return r < MP ? P.xp + (size_t)r * 1024 : P.xs + (size_t)(r - MP) * 1024;
}


#define XB_TMO      128
#define XB_XCNT(j)  (256  + 64 * (j))
#define XB_XSUB(j)  (1280 + 64 * (j))
#define XB_XGEN(j)  (2304 + 64 * (j))
#define XB_TOP      3328
#define XB_TOPGEN   3392
#define XCD_BAR_WORDS 3456
#define XB_SPIN_CAP (1u << 22)
#define LAS __attribute__((address_space(3)))
__device__ __forceinline__ unsigned xb_ld(unsigned* p) { return __hip_atomic_load(p, __ATOMIC_RELAXED, __HIP_MEMORY_SCOPE_AGENT); }
__device__ __forceinline__ unsigned xb_add(unsigned* p, unsigned v) { return __hip_atomic_fetch_add(p, v, __ATOMIC_RELAXED, __HIP_MEMORY_SCOPE_AGENT); }
__device__ __forceinline__ unsigned xb_xcc_id() { return (unsigned)__builtin_amdgcn_s_getreg((3 << 11) | 20) & 0xFu; }
#define XB_SPIN(cond, bar) do { unsigned _sp = 0; while (cond) { __builtin_amdgcn_s_sleep(1); \
    if ((++_sp & 255u) == 0u) { if (xb_ld(&(bar)[XB_TMO])) break; if (_sp > XB_SPIN_CAP) { atomicAdd(&(bar)[XB_TMO], 1u); break; } } } } while (0)
struct XcdBarrier { unsigned* bar; unsigned x; volatile LAS unsigned* st; };
__device__ __forceinline__ XcdBarrier xcd_barrier_post(unsigned* bar, volatile LAS unsigned* st) {
  XcdBarrier b; b.bar = bar; b.x = xb_xcc_id(); b.st = st;
  if (threadIdx.x == 0) (void)xb_add(&bar[XB_XCNT(b.x)], 1u);
  return b;
}
__device__ __forceinline__ void xcd_barrier_complete(unsigned* bar, unsigned x, unsigned& nloc, unsigned& nx) {
  const unsigned G = gridDim.x * gridDim.y * gridDim.z;
  unsigned sum, cnt, mine, sp = 0u;
  for (;;) {
    sum = 0u; cnt = 0u; mine = 0u;
#pragma unroll
    for (unsigned j = 0; j < 16; ++j) { const unsigned c = xb_ld(&bar[XB_XCNT(j)]); sum += c; cnt += (c > 0u) ? 1u : 0u; mine = (j == x) ? c : mine; }
    if (sum == G) break;
    __builtin_amdgcn_s_sleep(1);
    if ((++sp & 255u) == 0u) { if (xb_ld(&bar[XB_TMO])) break; if (sp > XB_SPIN_CAP) { atomicAdd(&bar[XB_TMO], 1u); break; } }
  }
  nloc = mine > 0u ? mine : 1u; nx = cnt > 0u ? cnt : 1u;
}
__device__ __forceinline__ void xcd_barrier(const XcdBarrier& b) {
  asm volatile("s_waitcnt vmcnt(0)" ::: "memory");
  __syncthreads();
  if (threadIdx.x == 0) {
    unsigned* bar = b.bar;
    __builtin_amdgcn_s_waitcnt(0);
    unsigned nloc = b.st[0], nx = b.st[1];
    if (nloc == 0u) { xcd_barrier_complete(bar, b.x, nloc, nx); b.st[0] = nloc; b.st[1] = nx; }
    const unsigned old = xb_add(&bar[XB_XSUB(b.x)], 1u);
    const unsigned gen = old / nloc;
    if (old + 1u == (gen + 1u) * nloc) {
      __builtin_amdgcn_fence(__ATOMIC_RELEASE, "agent");
      asm volatile("s_waitcnt vmcnt(0)" ::: "memory");
      const unsigned og = xb_add(&bar[XB_TOP], 1u);
      const unsigned tg = og / nx;
      if (og + 1u == (tg + 1u) * nx) xb_add(&bar[XB_TOPGEN], 1u);
      else XB_SPIN(xb_ld(&bar[XB_TOPGEN]) == tg, bar);
      __builtin_amdgcn_fence(__ATOMIC_ACQUIRE, "agent");
      xb_add(&bar[XB_XGEN(b.x)], 1u);
      asm volatile("s_waitcnt vmcnt(0)" ::: "memory");
    } else {
      XB_SPIN(xb_ld(&bar[XB_XGEN(b.x)]) == gen, bar);
      __builtin_amdgcn_fence(__ATOMIC_ACQUIRE, "agent");
      asm volatile("s_waitcnt vmcnt(0)" ::: "memory");
    }
  }
  __syncthreads();
}

__device__ __forceinline__ void gemm_acc(f32x16 (&acc)[2][2], const bfu* __restrict__ A, int lda,
                                         const bfu* __restrict__ Bt, int ldb, int K, bfu* sA, bfu*  ) {
  const int tid = threadIdx.x, lane = tid & 63, w = tid >> 6, wm = w & 1, wn = w >> 1;
  const int lr = tid >> 3;
  const int kc = ((tid & 7) ^ ((tid >> 4) & 7)) * 8;
  const bfu* Ap = A + (size_t)lr * lda + kc;
  const bfu* Bp = Bt + (size_t)lr * ldb + kc;
  const size_t a32 = (size_t)32 * lda, b32 = (size_t)32 * ldb;
  char* sbase = (char*)sA;
  char* ldst = sbase + tid * 16;
#define GISSUE(stage, k)                                                                                       \
  _Pragma("unroll") for (int i_ = 0; i_ < 4; ++i_) {                                                           \
    __builtin_amdgcn_global_load_lds((const unsigned*)(Ap + i_ * a32 + (k)),                                   \
                                     (LAS unsigned*)(ldst + (stage) * 32768 + i_ * 4096), 16, 0, 0);           \
    __builtin_amdgcn_global_load_lds((const unsigned*)(Bp + i_ * b32 + (k)),                                   \
                                     (LAS unsigned*)(ldst + (stage) * 32768 + 16384 + i_ * 4096), 16, 0, 0);   \
  }
  const int sw = (lane >> 1) & 7, hh = lane >> 5;
  const int rowA = (wm * 64 + (lane & 31)) * 128, rowB = (wn * 32 + (lane & 31)) * 128;
  __syncthreads();
  GISSUE(0, 0)
  int cur = 0;
  for (int k0 = 0; k0 < K; k0 += 64) {
    asm volatile("s_waitcnt vmcnt(0)" ::: "memory");
    __syncthreads();
    if (k0 + 64 < K) { GISSUE(cur ^ 1, k0 + 64) }
    const char* cA = sbase + cur * 32768;
    const char* cB = cA + 16384;
    __builtin_amdgcn_s_setprio(1);
#pragma unroll
    for (int ks = 0; ks < 4; ++ks) {
      const int pos = ((2 * ks + hh) ^ sw) * 16;
      bf16x8 af[2], bfr[2];
#pragma unroll
      for (int mi = 0; mi < 2; ++mi) af[mi] = *(const bf16x8*)(cA + rowA + mi * 32 * 128 + pos);
#pragma unroll
      for (int ni = 0; ni < 2; ++ni) bfr[ni] = *(const bf16x8*)(cB + rowB + ni * 64 * 128 + pos);
#pragma unroll
      for (int mi = 0; mi < 2; ++mi)
#pragma unroll
        for (int ni = 0; ni < 2; ++ni)
          acc[mi][ni] = __builtin_amdgcn_mfma_f32_32x32x16_bf16(af[mi], bfr[ni], acc[mi][ni], 0, 0, 0);
    }
    __builtin_amdgcn_s_setprio(0);
    cur ^= 1;
  }
}
#define gemm_acc1 gemm_acc
__device__ __forceinline__ void zero_acc(f32x16 (&acc)[2][2]) {
#pragma unroll
  for (int a = 0; a < 2; ++a)
#pragma unroll
    for (int b = 0; b < 2; ++b)
#pragma unroll
      for (int i = 0; i < 16; ++i) acc[a][b][i] = 0.f;
}
#define EPI_BEGIN                                                      \
  const int e_lane = threadIdx.x & 63, e_w = threadIdx.x >> 6;         \
  const int e_wm = e_w & 1, e_wn = e_w >> 1;                            \
  const int cl = e_wn * 32 + (e_lane & 31);                             \
  _Pragma("unroll") for (int mi = 0; mi < 2; ++mi)                      \
  _Pragma("unroll") for (int q = 0; q < 4; ++q) {                       \
    const int r0 = e_wm * 64 + mi * 32 + q * 8 + 4 * (e_lane >> 5);
#define EPI_END }

#define ST_LD 136
#define ST32_LD 132
typedef unsigned u32x4nt __attribute__((ext_vector_type(4)));
__device__ __forceinline__ void nt_store_u4(void* p, uint4 v) { u32x4nt t = {v.x, v.y, v.z, v.w}; __builtin_nontemporal_store(t, (u32x4nt*)p); }
__device__ __forceinline__ void copyout_bf16(const bfu* sT, bfu* dst, int ld) {
  const int tid = threadIdx.x;
#pragma unroll
  for (int i = 0; i < 8; ++i) {
    int id = tid + i * 256, row = id >> 4, c8 = (id & 15) * 8;
    *(uint4*)(dst + (size_t)row * ld + c8) = *(const uint4*)(sT + row * ST_LD + c8);
  }
}
__device__ __forceinline__ void copyout_bf16_nt(const bfu* sT, bfu* dst, int ld) {
  const int tid = threadIdx.x;
#pragma unroll
  for (int i = 0; i < 8; ++i) {
    int id = tid + i * 256, row = id >> 4, c8 = (id & 15) * 8;
    nt_store_u4(dst + (size_t)row * ld + c8, *(const uint4*)(sT + row * ST_LD + c8));
  }
}
__device__ __forceinline__ void stage_rm(bfu* sT, const f32x16 (&acc)[2][2], float sc) {
  EPI_BEGIN
#pragma unroll
    for (int j = 0; j < 4; ++j) {
      sT[(r0 + j) * ST_LD + cl] = f2bf(acc[mi][0][q * 4 + j] * sc);
      sT[(r0 + j) * ST_LD + cl + 64] = f2bf(acc[mi][1][q * 4 + j] * sc);
    }
  EPI_END
}

__device__ __forceinline__ void tile_map(int L, int nM, int nN, int& pm, int& pn) {
  const int nwg = nM * nN;
  const int q = nwg >> 3, r = nwg & 7, xcd = L & 7, off = L >> 3;
  int wgid = (xcd < r ? xcd * (q + 1) : r * (q + 1) + (xcd - r) * q) + off;
  const int nig = 8 * nN, gid = wgid / nig, fm = gid * 8;
  const int gsz = (nM - fm) < 8 ? (nM - fm) : 8;
  pm = fm + (wgid % nig) % gsz;
  pn = (wgid % nig) / gsz;
}
__device__ void transpose_w(const float* __restrict__ src, int K, int N, int src_ld, bfu* __restrict__ dst,
                            int remap, int gtid, int gstride) {
  int total = N * (K / 8);
  for (int i = gtid; i < total; i += gstride) {
    int n = i % N, kg = i / N;
    int col = (remap && n >= 3584) ? n + 8 : n;
    float v[8];
#pragma unroll
    for (int j = 0; j < 8; ++j) v[j] = src[(size_t)(kg * 8 + j) * src_ld + col];
    uint4 o;
    o.x = pack2(v[0], v[1]); o.y = pack2(v[2], v[3]); o.z = pack2(v[4], v[5]); o.w = pack2(v[6], v[7]);
    *(uint4*)(dst + (size_t)n * K + kg * 8) = o;
  }
}
__device__ void transpose_w_lds(const float* __restrict__ src, int K, int N, int src_ld, bfu* __restrict__ dst,
                                int remap, float* st, int boff) {
  const int tid = threadIdx.x;
  const int tilesN = N >> 6, ntile = (K >> 6) * tilesN;
  for (int t = (int)((blockIdx.x + gridDim.x - (boff % gridDim.x)) % gridDim.x); t < ntile; t += gridDim.x) {
    const int kt = t / tilesN, nt = t - kt * tilesN;
    {
      const int row = tid >> 2, c16 = (tid & 3) * 16;
      const int n0 = nt * 64 + c16;
      const int col = (remap && n0 >= 3584) ? n0 + 8 : n0;
      const float* sp = src + (size_t)(kt * 64 + row) * src_ld + col;
#pragma unroll
      for (int j = 0; j < 4; ++j) {
        float4 v = *(const float4*)(sp + j * 4);
        float* d = st + row * 65 + c16 + j * 4;
        d[0] = v.x; d[1] = v.y; d[2] = v.z; d[3] = v.w;
      }
    }
    __syncthreads();
    {
      const int n = tid >> 2, kc = (tid & 3) * 16;
#pragma unroll
      for (int hf = 0; hf < 2; ++hf) {
        float f[8];
#pragma unroll
        for (int j = 0; j < 8; ++j) f[j] = st[(kc + hf * 8 + j) * 65 + n];
        uint4 o;
        o.x = pack2(f[0], f[1]); o.y = pack2(f[2], f[3]); o.z = pack2(f[4], f[5]); o.w = pack2(f[6], f[7]);
        *(uint4*)(dst + (size_t)(nt * 64 + n) * K + kt * 64 + kc + hf * 8) = o;
      }
    }
    __syncthreads();
  }
}
__device__ void convert_bf(const float* __restrict__ src, bfu* __restrict__ dst, size_t n8, int gtid, int gstride) {
  for (size_t i = gtid; i < n8; i += gstride) {
    float4 a = *(const float4*)(src + i * 8), b = *(const float4*)(src + i * 8 + 4);
    uint4 o;
    o.x = pack2(a.x, a.y); o.y = pack2(a.z, a.w); o.z = pack2(b.x, b.y); o.w = pack2(b.z, b.w);
    *(uint4*)(dst + i * 8) = o;
  }
}

__device__ void prep_rows(const Params& P) {
  const int lane = threadIdx.x & 63, w = threadIdx.x >> 6;
  bfu* hbuf = (bfu*)(P.ws + SLOT(0));
  float* gpre = (float*)(P.ws + O_GPRE);
  float4 wg0[16], wg1[16];
#pragma unroll
  for (int i = 0; i < 4; ++i)
#pragma unroll
    for (int j = 0; j < 4; ++j) {
      const float* wr = P.w_in + (size_t)(i * 256 + lane * 4 + j) * 5640 + 3584;
      wg0[i * 4 + j] = *(const float4*)wr; wg1[i * 4 + j] = *(const float4*)(wr + 4);
    }
  float4 gm[4];
#pragma unroll
  for (int i = 0; i < 4; ++i) gm[i] = *(const float4*)(P.g_mix + i * 256 + lane * 4);
  for (int r = blockIdx.x * 4 + w; r < MT; r += gridDim.x * 4) {
    const float* xr = xrow(P, r);
    float4 v[4];
    float ss = 0.f;
#pragma unroll
    for (int i = 0; i < 4; ++i) {
      v[i] = *(const float4*)(xr + i * 256 + lane * 4);
      ss += v[i].x * v[i].x + v[i].y * v[i].y + v[i].z * v[i].z + v[i].w * v[i].w;
    }
    ss = wave_sum(ss);
    float rstd = rsqrtf(ss * (1.f / 1024.f) + EPS);
    float ga[8];
#pragma unroll
    for (int j = 0; j < 8; ++j) ga[j] = 0.f;
#pragma unroll
    for (int i = 0; i < 4; ++i) {
      float hv[4] = {v[i].x * rstd * gm[i].x, v[i].y * rstd * gm[i].y, v[i].z * rstd * gm[i].z, v[i].w * rstd * gm[i].w};
      uint2 o; o.x = pack2(hv[0], hv[1]); o.y = pack2(hv[2], hv[3]);
      *(uint2*)(hbuf + (size_t)r * 1024 + i * 256 + lane * 4) = o;
#pragma unroll
      for (int j = 0; j < 4; ++j) {
        const float4 w0 = wg0[i * 4 + j], w1 = wg1[i * 4 + j];
        ga[0] += hv[j] * w0.x; ga[1] += hv[j] * w0.y; ga[2] += hv[j] * w0.z; ga[3] += hv[j] * w0.w;
        ga[4] += hv[j] * w1.x; ga[5] += hv[j] * w1.y; ga[6] += hv[j] * w1.z; ga[7] += hv[j] * w1.w;
      }
    }
    float si = reduce4(ga[0], ga[1], ga[2], ga[3]);
    float sf = reduce4(ga[4], ga[5], ga[6], ga[7]);
    if ((lane & 15) == 0) {
      int k = lane >> 4;
      gpre[(size_t)r * 8 + k] = si + P.b_i[k];
      gpre[(size_t)r * 8 + 4 + k] = sf + P.b_f[k];
    }
  }
}
__device__ void gate_scan(const Params& P) {
  const int lane = threadIdx.x & 63, w = threadIdx.x >> 6;
  const float* gpre = (const float*)(P.ws + O_GPRE);
  for (int item = blockIdx.x * 4 + w; item < 528 * 4; item += gridDim.x * 4) {
    int tile = item >> 2, h = item & 3;
    int row0, L;
    if (tile < 512) { row0 = tile * 64; L = 64; } else { row0 = MP + (tile - 512) * 32; L = 32; }
    const int s = lane;
    bool valid = s < L;
    float ig = valid ? gpre[(size_t)(row0 + s) * 8 + h] : -INFINITY;
    float fg = valid ? gpre[(size_t)(row0 + s) * 8 + 4 + h] : 0.f;
    float lf = valid ? (fminf(fg, 0.f) - log1pf(__expf(-fabsf(fg)))) : 0.f;
    float F = lf;
#pragma unroll
    for (int o = 1; o < 64; o <<= 1) { float t = __shfl_up(F, o); if (lane >= o) F += t; }
    float u = valid ? ig - F : -INFINITY;
    float cm = u;
#pragma unroll
    for (int o = 1; o < 64; o <<= 1) { float t = __shfl_up(cm, o); if (lane >= o) cm = fmaxf(cm, t); }
    if (valid) {
      size_t gi = (size_t)(row0 + s) * 4 + h;
      ((float*)(P.ws + O_FQ))[gi] = F;
      ((float*)(P.ws + O_UQ))[gi] = u;
      ((float*)(P.ws + O_CMQ))[gi] = cm;
      if (s == L - 1) {
        ((float*)(P.ws + O_FL))[tile * 4 + h] = F;
        ((float*)(P.ws + O_UC))[tile * 4 + h] = cm;
      }
    }
  }
}

__device__ void phase_prep(const Params& P, char* smem) {
  const int gtid = blockIdx.x * NTHREADS + threadIdx.x, gstride = gridDim.x * NTHREADS;
  prep_rows(P);
  transpose_w_lds(P.w_in, 1024, 5632, 5640, (bfu*)(P.ws + O_WT_IN), 1, (float*)smem, 0);
  transpose_w_lds(P.w_up_r, 512, 1024, 1024, (bfu*)(P.ws + O_WT_UPR), 0, (float*)smem, 1408);
  transpose_w_lds(P.w_up_m, 512, 1024, 1024, (bfu*)(P.ws + O_WT_UPM), 0, (float*)smem, 1536);
  transpose_w_lds(P.w_out, 1024, 1024, 1024, (bfu*)(P.ws + O_WT_OUT), 0, (float*)smem, 1664);
  transpose_w_lds(P.w_pq, 1024, 2048, 2048, (bfu*)(P.ws + O_WT_PQ), 0, (float*)smem, 1920);
  transpose_w_lds(P.w_pg, 1024, 1024, 1024, (bfu*)(P.ws + O_WT_PG), 0, (float*)smem, 2432);
  transpose_w_lds(P.w_ple, 256, 1024, 1024, (bfu*)(P.ws + O_WT_PLE), 0, (float*)smem, 2688);
  for (int h = 0; h < 4; ++h) {
    transpose_w_lds(P.w_mq + h * 16384, 128, 128, 128, (bfu*)(P.ws + O_WT_MQ) + h * 16384, 0, (float*)smem, 2752 + h * 8);
    transpose_w_lds(P.w_mk + h * 16384, 128, 128, 128, (bfu*)(P.ws + O_WT_MK) + h * 16384, 0, (float*)smem, 2756 + h * 8);
  }
  convert_bf(P.peer_keys, (bfu*)(P.ws + O_KEYS), 16 * 128 * 128 / 8, gtid, gstride);
  float* ct = (float*)(P.ws + O_COS); float* st = (float*)(P.ws + O_SIN);
  for (int i = gtid; i < 8192 * 64; i += gstride) {
    int pos = i >> 6, j = i & 63;
    float inv = exp2f(-(float)j * (13.287712379549449f / 64.f));
    float angf = (float)pos * inv;
    double a = (double)angf;
    double k = rint(a * 0.15915494309189535);
    float r = (float)(a - k * 6.283185307179586);
    ct[i] = __cosf(r); st[i] = __sinf(r);
  }
}

__device__ __forceinline__ void gemm_acc256(f32x16 (&acc)[4][2], const bfu* __restrict__ A, int lda,
                                            const bfu* __restrict__ Bt, int ldb, int K, char* sbase) {
  const int tid = threadIdx.x, lane = tid & 63, w = tid >> 6, wm = w & 1, wn = w >> 1;
  const int kc = ((tid & 3) ^ ((tid >> 4) & 3)) * 8;
  const bfu* Ap = A + (size_t)(tid >> 2) * lda + kc;
  const bfu* Bp = Bt + (size_t)(tid >> 2) * ldb + kc;
  const size_t a64 = (size_t)64 * lda, b64 = (size_t)64 * ldb;
  char* ldst = sbase + tid * 16;
#define GISSUE256(stage, k)                                                                                      \
  {                                                                                                              \
    char* d_ = ldst + (stage) * 24576;                                                                           \
    __builtin_amdgcn_global_load_lds((const unsigned*)(Ap + (k)), (LAS unsigned*)(d_), 16, 0, 0);                \
    __builtin_amdgcn_global_load_lds((const unsigned*)(Ap + a64 + (k)), (LAS unsigned*)(d_ + 4096), 16, 0, 0);   \
    __builtin_amdgcn_global_load_lds((const unsigned*)(Ap + 2 * a64 + (k)), (LAS unsigned*)(d_ + 8192), 16, 0, 0);  \
    __builtin_amdgcn_global_load_lds((const unsigned*)(Ap + 3 * a64 + (k)), (LAS unsigned*)(d_ + 12288), 16, 0, 0); \
    __builtin_amdgcn_global_load_lds((const unsigned*)(Bp + (k)), (LAS unsigned*)(d_ + 16384), 16, 0, 0);        \
    __builtin_amdgcn_global_load_lds((const unsigned*)(Bp + b64 + (k)), (LAS unsigned*)(d_ + 20480), 16, 0, 0);  \
  }
  const int sw = (lane >> 2) & 3, hh = lane >> 5;
  const int rowA = (wm * 64 + (lane & 31)) * 64, rowB = (wn * 32 + (lane & 31)) * 64;
  const int nk = K >> 5;
  __syncthreads();
  asm volatile("s_waitcnt vmcnt(0)" ::: "memory");
  GISSUE256(0, 0)
  if (nk > 1) GISSUE256(1, 32)
  int st = 0;
  for (int kt = 0; kt < nk; ++kt) {
    if (kt + 1 < nk) asm volatile("s_waitcnt vmcnt(6)" ::: "memory");
    else asm volatile("s_waitcnt vmcnt(0)" ::: "memory");
    asm volatile("s_waitcnt lgkmcnt(0)" ::: "memory");
    __builtin_amdgcn_s_barrier();
    asm volatile("" ::: "memory");
    if (kt + 2 < nk) { const int s2 = st >= 1 ? st - 1 : 2; GISSUE256(s2, (kt + 2) * 32) }
    const char* cA = sbase + st * 24576;
    const char* cB = cA + 16384;
    __builtin_amdgcn_s_setprio(1);
#pragma unroll
    for (int ks = 0; ks < 2; ++ks) {
      const int pos = ((2 * ks + hh) ^ sw) * 16;
      bf16x8 af[4], bfr[2];
#pragma unroll
      for (int mi = 0; mi < 4; ++mi) af[mi] = *(const bf16x8*)(cA + rowA + ((mi >> 1) * 128 + (mi & 1) * 32) * 64 + pos);
#pragma unroll
      for (int ni = 0; ni < 2; ++ni) bfr[ni] = *(const bf16x8*)(cB + rowB + ni * 64 * 64 + pos);
#pragma unroll
      for (int mi = 0; mi < 4; ++mi)
#pragma unroll
        for (int ni = 0; ni < 2; ++ni)
          acc[mi][ni] = __builtin_amdgcn_mfma_f32_32x32x16_bf16(af[mi], bfr[ni], acc[mi][ni], 0, 0, 0);
    }
    __builtin_amdgcn_s_setprio(0);
    st = st == 2 ? 0 : st + 1;
  }
}

__device__ __forceinline__ void gemm1_epilogue(const Params& P, char* smem, f32x16 (&acc)[2][2], const int rbase, const int nt,
                                               const float* ct, const float* stb) {
    const bool prompt = rbase < MP;
  int region = nt >> 2, hh = nt & 3;
  bfu* sT = (bfu*)smem;
  __syncthreads();
  if (region <= 1) {
    float sc = region == 1 ? 0.08838834764831845f : 1.f;
    EPI_BEGIN
#pragma unroll
      for (int j = 0; j < 4; ++j) {
        int rr = rbase + r0 + j;
        int pos = prompt ? (rr & 8191) : 2048 + ((rr - MP) & 31);
        float c = ct[pos * 64 + cl], sn = stb[pos * 64 + cl];
        float a = acc[mi][0][q * 4 + j], b = acc[mi][1][q * 4 + j];
        sT[(r0 + j) * ST_LD + cl] = f2bf((a * c - b * sn) * sc);
        sT[(r0 + j) * ST_LD + cl + 64] = f2bf((a * sn + b * c) * sc);
      }
    EPI_END
    __syncthreads();
    copyout_bf16_nt(sT, (bfu*)(P.ws + SLOT(2 + region)) + (size_t)rbase * 512 + hh * 128, 512);
  } else if (region == 2 || region == 5) {
    EPI_BEGIN
      uint2 va, vb;
      va.x = pack2(acc[mi][0][q * 4 + 0], acc[mi][0][q * 4 + 1]); va.y = pack2(acc[mi][0][q * 4 + 2], acc[mi][0][q * 4 + 3]);
      vb.x = pack2(acc[mi][1][q * 4 + 0], acc[mi][1][q * 4 + 1]); vb.y = pack2(acc[mi][1][q * 4 + 2], acc[mi][1][q * 4 + 3]);
      *(uint2*)(sT + cl * ST_LD + r0) = va;
      *(uint2*)(sT + (cl + 64) * ST_LD + r0) = vb;
    EPI_END
    __syncthreads();
    bfu* dst = (bfu*)(P.ws + SLOT(region == 2 ? 4 : 7));
#pragma unroll
    for (int i = 0; i < 8; ++i) {
      int id = threadIdx.x + i * 256, e = id >> 4, c8 = (id & 15) * 8;
      size_t o;
      if (prompt) { int bb = rbase >> 13, tt = (rbase & 8191) + c8; o = ((size_t)((bb * 4 + hh) * 128 + e)) * 8192 + tt; }
      else { int rs = rbase - MP + c8, bb = rs >> 5, tt = rs & 31; o = SB_T + ((size_t)((bb * 4 + hh) * 128 + e)) * 32 + tt; }
      nt_store_u4(dst + o, *(const uint4*)(sT + e * ST_LD + c8));
    }
  } else if (region == 3 || region == 4 || region == 6) {
    stage_rm(sT, acc, 1.f);
    __syncthreads();
    copyout_bf16_nt(sT, (bfu*)(P.ws + SLOT(region == 3 ? 5 : (region == 4 ? 6 : 8))) + (size_t)rbase * 512 + hh * 128, 512);
  } else {
    int gi = nt - 28;
    stage_rm(sT, acc, 1.f);
    __syncthreads();
    copyout_bf16_nt(sT, (bfu*)(P.ws + SLOT(gi < 8 ? 9 : 11)) + (size_t)rbase * 1024 + (gi & 7) * 128, 1024);
  }

}

__device__ void phase_gemm1(const Params& P, char* smem) {
  const bfu* hbuf = (const bfu*)(P.ws + SLOT(0));
  const bfu* wt = (const bfu*)(P.ws + O_WT_IN);
  const float* ct = (const float*)(P.ws + O_COS); const float* stb = (const float*)(P.ws + O_SIN);
  for (int t = blockIdx.x; t < 130 * 44; t += gridDim.x) {
    int mt, nt; tile_map(t, 130, 44, mt, nt);
    f32x16 acc[4][2];
#pragma unroll
    for (int a = 0; a < 4; ++a)
#pragma unroll
      for (int b = 0; b < 2; ++b)
#pragma unroll
        for (int i = 0; i < 16; ++i) acc[a][b][i] = 0.f;
    gemm_acc256(acc, hbuf + (size_t)mt * 256 * 1024, 1024, wt + (size_t)nt * 128 * 1024, 1024, 1024, smem);
    gemm1_epilogue(P, smem, reinterpret_cast<f32x16(&)[2][2]>(acc[0]), mt * 256, nt, ct, stb);
    gemm1_epilogue(P, smem, reinterpret_cast<f32x16(&)[2][2]>(acc[2]), mt * 256 + 128, nt, ct, stb);
  }
}

__device__ void phase_conv(const Params& P) {
  const int gtid = blockIdx.x * NTHREADS + threadIdx.x, gstride = gridDim.x * NTHREADS;
  const bfu* xm = (const bfu*)(P.ws + SLOT(6));
  bfu* cb = (bfu*)(P.ws + SLOT(0));
  for (int i = gtid; i < MT * 64; i += gstride) {
    int r = i >> 6, c0 = (i & 63) * 8;
    int t, T, bb; bool prompt = r < MP;
    if (prompt) { bb = r >> 13; t = r & 8191; T = 8192; } else { int rs = r - MP; bb = rs >> 5; t = rs & 31; T = 32; }
    float y[8];
#pragma unroll
    for (int j = 0; j < 8; ++j) y[j] = P.conv_b[c0 + j];
#pragma unroll
    for (int k = 0; k < 4; ++k) {
      int tt = t - 3 + k;
      float xv[8];
      if (tt >= 0) {
        uint4 v = *(const uint4*)(xm + (size_t)(r - 3 + k) * 512 + c0);
        xv[0] = bf2f(v.x & 0xffff); xv[1] = bf2f(v.x >> 16); xv[2] = bf2f(v.y & 0xffff); xv[3] = bf2f(v.y >> 16);
        xv[4] = bf2f(v.z & 0xffff); xv[5] = bf2f(v.z >> 16); xv[6] = bf2f(v.w & 0xffff); xv[7] = bf2f(v.w >> 16);
      } else if (!prompt) {
        const float* sp = P.st_conv + (size_t)(bb * 3 + (tt + 3)) * 512 + c0;
#pragma unroll
        for (int j = 0; j < 8; ++j) xv[j] = sp[j];
      } else {
#pragma unroll
        for (int j = 0; j < 8; ++j) xv[j] = 0.f;
      }
#pragma unroll
      for (int j = 0; j < 8; ++j) y[j] += xv[j] * P.conv_w[k * 512 + c0 + j];
    }
    if (t >= T - 3) {
      uint4 v = *(const uint4*)(xm + (size_t)r * 512 + c0);
      float* dst = (prompt ? P.out + OO_CONVP : P.out + OO_CONVS) + (size_t)(bb * 3 + (t - (T - 3))) * 512 + c0;
      dst[0] = bf2f(v.x & 0xffff); dst[1] = bf2f(v.x >> 16); dst[2] = bf2f(v.y & 0xffff); dst[3] = bf2f(v.y >> 16);
      dst[4] = bf2f(v.z & 0xffff); dst[5] = bf2f(v.z >> 16); dst[6] = bf2f(v.w & 0xffff); dst[7] = bf2f(v.w >> 16);
    }
    uint4 o;
#pragma unroll
    for (int j = 0; j < 8; ++j) y[j] = y[j] * sigmoidf_(y[j]);
    o.x = pack2(y[0], y[1]); o.y = pack2(y[2], y[3]); o.z = pack2(y[4], y[5]); o.w = pack2(y[6], y[7]);
    *(uint4*)(cb + (size_t)r * 512 + c0) = o;
  }
}

__device__ void m_fold(const Params& P) {
  const int lane = threadIdx.x & 63, w = threadIdx.x >> 6;
  const float* FL = (const float*)(P.ws + O_FL); const float* UC = (const float*)(P.ws + O_UC);
  float* MCS = (float*)(P.ws + O_MCS);
  const int slot = (int)gridDim.x - 1 - (int)blockIdx.x;
  if (w == 3 && slot < 16) {
    const int bh = slot, b = bh >> 2, h = bh & 3;
    const int c0 = 2 * lane;
    const float fl0 = FL[(b * 128 + c0) * 4 + h], uc0 = UC[(b * 128 + c0) * 4 + h];
    const float fl1 = FL[(b * 128 + c0 + 1) * 4 + h], uc1 = UC[(b * 128 + c0 + 1) * 4 + h];
    float a = fl0 + fl1, bb = fmaxf(fl0 + uc0 + fl1, fl1 + uc1);
#pragma unroll
    for (int o = 1; o < 64; o <<= 1) {
      float ap = __shfl_up(a, o), bp = __shfl_up(bb, o);
      if (lane >= o) { bb = fmaxf(bp + a, bb); a = ap + a; }
    }
    float ae = __shfl_up(a, 1), be = __shfl_up(bb, 1);
    float m0 = lane == 0 ? 0.f : fmaxf(ae, be);
    float m1 = fl0 + fmaxf(m0, uc0);
    MCS[bh * 128 + c0] = m0;
    MCS[bh * 128 + c0 + 1] = m1;
  }
  const int gtid = blockIdx.x * NTHREADS + threadIdx.x;
  if (gtid < 64) MCS[2048 + gtid] = P.st_m[gtid];
}
__device__ void phase_mqk(const Params& P, char* smem) {
  bfu* sA = (bfu*)smem; bfu* sB = sA + 128 * 72;
  const bfu* cb = (const bfu*)(P.ws + SLOT(0));
  for (int t = blockIdx.x; t < 260 * 8; t += gridDim.x) {
    int mt = t >> 3, which = (t >> 2) & 1, hh = t & 3;
    const bfu* wt = (const bfu*)(P.ws + (which ? O_WT_MK : O_WT_MQ)) + hh * 16384;
    f32x16 acc[2][2]; zero_acc(acc);
    gemm_acc(acc, cb + (size_t)mt * 128 * 512 + hh * 128, 512, wt, 128, 128, sA, sB);
    bfu* dst = (bfu*)(P.ws + SLOT(which ? 13 : 1));
    float sc = which ? 0.08838834764831845f : 1.f;
    bfu* sT = (bfu*)smem;
    __syncthreads();
    stage_rm(sT, acc, sc);
    __syncthreads();
    copyout_bf16(sT, dst + (size_t)mt * 128 * 512 + hh * 128, 512);
  }
}

struct Item { int b, h, c, row0, L, T, chunk, bh; bool prompt; size_t vt_off; };
__device__ __forceinline__ Item decode_item(int idx) {
  Item it;
  if (idx < 2048) {
    it.prompt = true; it.b = idx >> 9; it.h = (idx >> 7) & 3; it.c = idx & 127; it.row0 = it.b * 8192 + it.c * 64;
    it.L = 64; it.T = 8192; it.chunk = it.b * 128 + it.c; it.bh = it.b * 4 + it.h;
    it.vt_off = ((size_t)(it.bh * 128)) * 8192 + it.c * 64;
  } else {
    int si = idx - 2048; it.prompt = false; it.b = si >> 2; it.h = si & 3; it.c = 0; it.row0 = MP + it.b * 32;
    it.L = 32; it.T = 32; it.chunk = 512 + it.b; it.bh = it.b * 4 + it.h;
    it.vt_off = SB_T + ((size_t)(it.bh * 128)) * 32;
  }
  return it;
}
__device__ __forceinline__ bfu* ds_ptr(const Params& P, int mixer, int idx) {
  if (idx < 2048) return (bfu*)P.out + ((size_t)(mixer * 2048 + idx)) * 16384;
  return (bfu*)(P.ws + O_DSS) + ((size_t)(mixer * 64 + (idx - 2048))) * 16384;
}
__device__ __forceinline__ float ret_lg(int h) { return log1pf(-exp2f(-5.f - (float)h)); }

__device__ void phaseA_item(const Params& P, int mixer, int idx, char* smem) {
  const int tid = threadIdx.x, lane = tid & 63, w = tid >> 6, wm = w & 1, wn = w >> 1;
  Item it = decode_item(idx);
  bfu* sK = (bfu*)smem; bfu* sV = sK + 128 * 72;
  float* sw = (float*)(sV + 128 * 72);
  float* sm = sw + 64;
  const int L = it.L, h = it.h;
  const bfu* Ksrc = (const bfu*)(P.ws + SLOT(mixer == 0 ? 3 : 13)) + (size_t)it.row0 * 512 + h * 128;
  const bfu* Vsrc = (const bfu*)(P.ws + SLOT(mixer == 0 ? 4 : 7)) + it.vt_off;
  uint4 kreg[4], vreg[4];
#pragma unroll
  for (int i = 0; i < 4; ++i) {
    int id = tid + i * 256, s = id & 63, dc = (id >> 6) * 8;
    kreg[i] = make_uint4(0, 0, 0, 0);
    if (s < L) kreg[i] = *(const uint4*)(Ksrc + (size_t)s * 512 + dc);
    int e = id >> 3, sc = (id & 7) * 8;
    vreg[i] = make_uint4(0, 0, 0, 0);
    if (sc < L) vreg[i] = *(const uint4*)(Vsrc + (size_t)e * it.T + sc);
  }
  if (mixer == 0) {
    if (tid < 64) { float lg = ret_lg(h); sw[tid] = tid < L ? __expf(lg * (float)(L - 1 - tid)) : 0.f; }
  } else {
    const float* FL = (const float*)(P.ws + O_FL); const float* UC = (const float*)(P.ws + O_UC);
    float mc = ((const float*)(P.ws + O_MCS))[idx];
    float Ml = fmaxf(mc, UC[it.chunk * 4 + h]);
    if (tid < 64) sw[tid] = tid < L ? __expf(((const float*)(P.ws + O_UQ))[(size_t)(it.row0 + tid) * 4 + h] - Ml) : 0.f;
    if (tid == 0) {
      ((float*)(P.ws + O_AEND))[idx] = __expf(mc - Ml);
      if (!it.prompt) P.out[OO_MS + it.bh] = FL[it.chunk * 4 + h] + Ml;
      else if (it.c == 127) P.out[OO_MP + it.bh] = FL[it.chunk * 4 + h] + Ml;
    }
  }
  __syncthreads();
#pragma unroll
  for (int i = 0; i < 4; ++i) {
    int id = tid + i * 256, s = id & 63, dc = (id >> 6) * 8;
    uint4 v = kreg[i];
    float ww = sw[s];
    unsigned vv[4] = {v.x, v.y, v.z, v.w};
#pragma unroll
    for (int j = 0; j < 4; ++j) {
      sK[(dc + 2 * j) * 72 + s] = f2bf(bf2f(vv[j] & 0xffff) * ww);
      sK[(dc + 2 * j + 1) * 72 + s] = f2bf(bf2f(vv[j] >> 16) * ww);
    }
  }
#pragma unroll
  for (int i = 0; i < 4; ++i) {
    int id = tid + i * 256, e = id >> 3, sc = (id & 7) * 8;
    *(uint4*)(sV + e * 72 + sc) = vreg[i];
  }
  __syncthreads();
  f32x16 acc[2][2]; zero_acc(acc);
#pragma unroll
  for (int ks = 0; ks < 4; ++ks) {
    bf16x8 af[2], bfr[2];
#pragma unroll
    for (int mi = 0; mi < 2; ++mi)
      af[mi] = *(const bf16x8*)(sK + (wm * 64 + mi * 32 + (lane & 31)) * 72 + ks * 16 + (lane >> 5) * 8);
#pragma unroll
    for (int ni = 0; ni < 2; ++ni)
      bfr[ni] = *(const bf16x8*)(sV + (wn * 32 + ni * 64 + (lane & 31)) * 72 + ks * 16 + (lane >> 5) * 8);
#pragma unroll
    for (int mi = 0; mi < 2; ++mi)
#pragma unroll
      for (int ni = 0; ni < 2; ++ni)
        acc[mi][ni] = __builtin_amdgcn_mfma_f32_32x32x16_bf16(af[mi], bfr[ni], acc[mi][ni], 0, 0, 0);
  }
  bfu* dS = ds_ptr(P, mixer, idx);
  EPI_BEGIN
#pragma unroll
    for (int ni = 0; ni < 2; ++ni) {
      int e = cl + ni * 64;
      uint2 o; o.x = pack2(acc[mi][ni][q * 4 + 0], acc[mi][ni][q * 4 + 1]); o.y = pack2(acc[mi][ni][q * 4 + 2], acc[mi][ni][q * 4 + 3]);
      *(uint2*)(dS + e * 128 + r0) = o;
    }
  EPI_END
  if (mixer == 1 && tid < 128) {
    float s = 0.f;
#pragma unroll
    for (int j = 0; j < 8; ++j) { float f[8]; unpack8(*(const uint4*)(sK + tid * 72 + j * 8), f);
#pragma unroll
      for (int k = 0; k < 8; ++k) s += f[k]; }
    ((float*)(P.ws + O_DN))[(size_t)idx * 128 + tid] = s;
  }
  __syncthreads();
}

__device__ void phase_scan(const Params& P) {
  const int gtid = blockIdx.x * NTHREADS + threadIdx.x, gstride = gridDim.x * NTHREADS;
  const float* AE = (const float*)(P.ws + O_AEND);
  for (int i = gtid; i < 131072; i += gstride) {
    int mixer = i >> 16, bh = (i >> 12) & 15, eo = (i & 4095) * 4;
    int h = bh & 3;
    float gch = __expf(ret_lg(h) * 64.f);
    float st[4];
#pragma unroll
    for (int j = 0; j < 4; ++j) st[j] = 0.f;
    bfu* base = (bfu*)P.out + ((size_t)(mixer * 2048 + bh * 128)) * 16384 + eo;
    for (int c = 0; c < 128; c += 8) {
      uint2 v[8];
#pragma unroll
      for (int k = 0; k < 8; ++k) v[k] = *(const uint2*)(base + (size_t)(c + k) * 16384);
#pragma unroll
      for (int k = 0; k < 8; ++k) {
        float dec = mixer == 0 ? gch : AE[bh * 128 + c + k];
        float d0 = bf2f(v[k].x & 0xffff), d1 = bf2f(v[k].x >> 16), d2 = bf2f(v[k].y & 0xffff), d3 = bf2f(v[k].y >> 16);
        uint2 o; o.x = pack2(st[0], st[1]); o.y = pack2(st[2], st[3]);
        *(uint2*)(base + (size_t)(c + k) * 16384) = o;
        st[0] = dec * st[0] + d0; st[1] = dec * st[1] + d1; st[2] = dec * st[2] + d2; st[3] = dec * st[3] + d3;
      }
    }
    float* o = P.out + (mixer == 0 ? OO_RETP : OO_CP) + (size_t)bh * 16384;
    int e = eo >> 7, d0i = eo & 127;
#pragma unroll
    for (int j = 0; j < 4; ++j) o[(d0i + j) * 128 + e] = st[j];
  }
  for (int i = gtid; i < 2 * 64 * 2048; i += gstride) {
    int mixer = i >> 17, bh = (i >> 11) & 63, eo = (i & 2047) * 8;
    int h = bh & 3;
    int e = eo >> 7, d0 = eo & 127;
    const float* s0 = (mixer == 0 ? P.st_ret : P.st_C) + (size_t)bh * 16384;
    float st[8];
#pragma unroll
    for (int j = 0; j < 8; ++j) st[j] = s0[(d0 + j) * 128 + e];
    bfu* p = (bfu*)(P.ws + O_DSS) + ((size_t)(mixer * 64 + bh)) * 16384 + eo;
    float d[8]; unpack8(*(const uint4*)p, d);
    *(uint4*)p = pack8(st);
    float dec = mixer == 0 ? __expf(ret_lg(h) * 32.f) : AE[2048 + bh];
    float* o = P.out + (mixer == 0 ? OO_RETS : OO_CS) + (size_t)bh * 16384;
#pragma unroll
    for (int j = 0; j < 8; ++j) o[(d0 + j) * 128 + e] = dec * st[j] + d[j];
  }
  float* DN = (float*)(P.ws + O_DN);
  for (int i = gtid; i < 16 * 128; i += gstride) {
    int bh = i >> 7, d = i & 127;
    float n = 0.f;
    for (int c0 = 0; c0 < 128; c0 += 16) {
      float v[16], ae[16];
#pragma unroll
      for (int k = 0; k < 16; ++k) { v[k] = DN[(size_t)(bh * 128 + c0 + k) * 128 + d]; ae[k] = AE[bh * 128 + c0 + k]; }
#pragma unroll
      for (int k = 0; k < 16; ++k) { DN[(size_t)(bh * 128 + c0 + k) * 128 + d] = n; n = ae[k] * n + v[k]; }
    }
    P.out[OO_NP + i] = n;
  }
  for (int i = gtid; i < 64 * 128; i += gstride) {
    int bh = i >> 7, d = i & 127;
    size_t o = (size_t)(2048 + bh) * 128 + d;
    float n0 = P.st_n[i]; float v = DN[o]; DN[o] = n0;
    P.out[OO_NS + i] = AE[2048 + bh] * n0 + v;
  }
}

__device__ void phaseC_item(const Params& P, int mixer, int idx, char* smem) {
  const int tid = threadIdx.x, lane = tid & 63, w = tid >> 6;
  Item it = decode_item(idx);
  const int L = it.L, h = it.h;
  bfu* sQ = (bfu*)smem;
  bfu* sKV = sQ + 64 * 136;
  bfu* sP = sKV + 128 * 72;
  bfu* sS = sP + 64 * 72;
  float* sO = (float*)sS;
  float* sRow = (float*)(sS + 128 * 136);
  const bfu* Qsrc = (const bfu*)(P.ws + SLOT(mixer == 0 ? 2 : 1)) + (size_t)it.row0 * 512 + h * 128;
  const bfu* Ksrc = (const bfu*)(P.ws + SLOT(mixer == 0 ? 3 : 13)) + (size_t)it.row0 * 512 + h * 128;
  const bfu* Vsrc = (const bfu*)(P.ws + SLOT(mixer == 0 ? 4 : 7)) + it.vt_off;
  const bfu* Ssrc = ds_ptr(P, mixer, idx);
  const float lg = ret_lg(h);
  uint4 vpre[4];
#pragma unroll
  for (int i = 0; i < 4; ++i) {
    int id = tid + i * 256, e = id >> 3, sc = (id & 7) * 8;
    vpre[i] = make_uint4(0, 0, 0, 0);
    if (sc < L) vpre[i] = *(const uint4*)(Vsrc + (size_t)e * it.T + sc);
  }
#pragma unroll
  for (int i = 0; i < 4; ++i) {
    int id = tid + i * 256, s = id >> 4, dc = (id & 15) * 8;
    uint4 vq = make_uint4(0, 0, 0, 0), vk = vq;
    if (s < L) { vq = *(const uint4*)(Qsrc + (size_t)s * 512 + dc); vk = *(const uint4*)(Ksrc + (size_t)s * 512 + dc); }
    *(uint4*)(sQ + s * 136 + dc) = vq;
    *(uint4*)(sKV + s * 136 + dc) = vk;
  }
#pragma unroll
  for (int i = 0; i < 8; ++i) {
    int id = tid + i * 256, e = id >> 4, dc = (id & 15) * 8;
    *(uint4*)(sS + e * 136 + dc) = *(const uint4*)(Ssrc + e * 128 + dc);
  }
  if (tid < 64) {
    int i = tid;
    if (mixer == 0) {
      sRow[128 + i] = __expf(lg * (float)(i + 1));
    } else {
      float mc = ((const float*)(P.ws + O_MCS))[idx];
      size_t gi = (size_t)(it.row0 + i) * 4 + h;
      bool valid = i < L;
      float u = valid ? ((const float*)(P.ws + O_UQ))[gi] : -INFINITY;
      float M = valid ? fmaxf(mc, ((const float*)(P.ws + O_CMQ))[gi]) : 0.f;
      float F = valid ? ((const float*)(P.ws + O_FQ))[gi] : 0.f;
      sRow[i] = u; sRow[64 + i] = M; sRow[128 + i] = valid ? __expf(mc - M) : 0.f;
      sRow[256 + i] = __expf(-(F + M));
    }
  }
  __syncthreads();
  {
    const int mi = w & 1, ni = w >> 1;
    f32x16 acc;
#pragma unroll
    for (int i = 0; i < 16; ++i) acc[i] = 0.f;
#pragma unroll 2
    for (int ks = 0; ks < 8; ++ks) {
      bf16x8 af = *(const bf16x8*)(sQ + (mi * 32 + (lane & 31)) * 136 + ks * 16 + (lane >> 5) * 8);
      bf16x8 bfr = *(const bf16x8*)(sKV + (ni * 32 + (lane & 31)) * 136 + ks * 16 + (lane >> 5) * 8);
      acc = __builtin_amdgcn_mfma_f32_32x32x16_bf16(af, bfr, acc, 0, 0, 0);
    }
    const int s = ni * 32 + (lane & 31);
    float us = mixer ? sRow[s] : 0.f;
#pragma unroll
    for (int reg = 0; reg < 16; ++reg) {
      int i = mi * 32 + (reg & 3) + 8 * (reg >> 2) + 4 * (lane >> 5);
      float wgt;
      if (mixer == 0) wgt = (s <= i) ? __expf(lg * (float)(i - s)) : 0.f;
      else wgt = (s <= i && i < L) ? __expf(us - sRow[64 + i]) : 0.f;
      sP[i * 72 + s] = f2bf(acc[reg] * wgt);
    }
  }
  __syncthreads();
#pragma unroll
  for (int i = 0; i < 4; ++i) {
    int id = tid + i * 256, e = id >> 3, sc = (id & 7) * 8;
    *(uint4*)(sKV + e * 72 + sc) = vpre[i];
  }
  __syncthreads();
  f32x16 acc1[2], acc2[2];
  const int mi = w & 1, nj = w >> 1;
#pragma unroll
  for (int t = 0; t < 2; ++t)
#pragma unroll
    for (int i = 0; i < 16; ++i) { acc1[t][i] = 0.f; acc2[t][i] = 0.f; }
#pragma unroll 2
  for (int ks = 0; ks < 4; ++ks) {
    bf16x8 af = *(const bf16x8*)(sP + (mi * 32 + (lane & 31)) * 72 + ks * 16 + (lane >> 5) * 8);
#pragma unroll
    for (int t = 0; t < 2; ++t) {
      bf16x8 bfr = *(const bf16x8*)(sKV + (nj * 64 + t * 32 + (lane & 31)) * 72 + ks * 16 + (lane >> 5) * 8);
      acc1[t] = __builtin_amdgcn_mfma_f32_32x32x16_bf16(af, bfr, acc1[t], 0, 0, 0);
    }
  }
#pragma unroll 2
  for (int ks = 0; ks < 8; ++ks) {
    bf16x8 af = *(const bf16x8*)(sQ + (mi * 32 + (lane & 31)) * 136 + ks * 16 + (lane >> 5) * 8);
#pragma unroll
    for (int t = 0; t < 2; ++t) {
      bf16x8 bfr = *(const bf16x8*)(sS + (nj * 64 + t * 32 + (lane & 31)) * 136 + ks * 16 + (lane >> 5) * 8);
      acc2[t] = __builtin_amdgcn_mfma_f32_32x32x16_bf16(af, bfr, acc2[t], 0, 0, 0);
    }
  }
  if (mixer == 1) {
    int i = tid >> 2, part = tid & 3;
    const float* nprev = (const float*)(P.ws + O_DN) + (size_t)idx * 128;
    float dl = 0.f, qn = 0.f;
#pragma unroll 4
    for (int s = part * 16; s < part * 16 + 16; ++s) dl += bf2f(sP[i * 72 + s]);
#pragma unroll 4
    for (int d = part * 32; d < part * 32 + 32; ++d) qn += bf2f(sQ[i * 136 + d]) * nprev[d];
    dl += __shfl_xor(dl, 1); dl += __shfl_xor(dl, 2);
    qn += __shfl_xor(qn, 1); qn += __shfl_xor(qn, 2);
    if (part == 0) {
      float den = dl + sRow[128 + i] * qn;
      sRow[192 + i] = 1.f / fmaxf(fabsf(den), sRow[256 + i]);
    }
  }
  __syncthreads();
#pragma unroll
  for (int t = 0; t < 2; ++t) {
    int e = nj * 64 + t * 32 + (lane & 31);
#pragma unroll
    for (int reg = 0; reg < 16; ++reg) {
      int i = mi * 32 + (reg & 3) + 8 * (reg >> 2) + 4 * (lane >> 5);
      float o = acc1[t][reg] + sRow[128 + i] * acc2[t][reg];
      if (mixer == 1) o *= sRow[192 + i];
      sO[i * 132 + e] = o;
    }
  }
  __syncthreads();
  {
    int i = tid >> 2, part = tid & 3;
    float ss = 0.f;
#pragma unroll 4
    for (int e = part * 32; e < part * 32 + 32; ++e) { float v = sO[i * 132 + e]; ss += v * v; }
    ss += __shfl_xor(ss, 1); ss += __shfl_xor(ss, 2);
    float rstd = rsqrtf(ss * (1.f / 128.f) + EPS);
    if (i < L) {
      size_t ro = (size_t)(it.row0 + i) * 512 + h * 128 + part * 32;
      const float* so = sO + i * 132 + part * 32;
      if (mixer == 0) {
        bfu* y = (bfu*)(P.ws + SLOT(5)) + ro;
        const float* g = P.g_ret_gn + h * 128 + part * 32;
        uint4 gv[4];
#pragma unroll
        for (int k = 0; k < 4; ++k) gv[k] = *(const uint4*)(y + k * 8);
#pragma unroll
        for (int k = 0; k < 4; ++k) {
          float gt[8], o[8];
          unpack8(gv[k], gt);
#pragma unroll
          for (int j = 0; j < 8; ++j) o[j] = gt[j] * sigmoidf_(gt[j]) * so[k * 8 + j] * rstd * g[k * 8 + j];
          *(uint4*)(y + k * 8) = pack8(o);
        }
      } else {
        bfu* y = (bfu*)(P.ws + SLOT(8)) + ro;
        const bfu* cc = (const bfu*)(P.ws + SLOT(0)) + ro;
        const float* g = P.g_ml_gn + h * 128 + part * 32;
        const float* ws = P.w_skip + h * 128 + part * 32;
        uint4 gv[4], cv[4];
#pragma unroll
        for (int k = 0; k < 4; ++k) { gv[k] = *(const uint4*)(y + k * 8); cv[k] = *(const uint4*)(cc + k * 8); }
#pragma unroll
        for (int k = 0; k < 4; ++k) {
          float gt[8], c8[8], o[8];
          unpack8(gv[k], gt); unpack8(cv[k], c8);
#pragma unroll
          for (int j = 0; j < 8; ++j) o[j] = sigmoidf_(gt[j]) * (so[k * 8 + j] * rstd * g[k * 8 + j] + ws[k * 8 + j] * c8[j]);
          *(uint4*)(y + k * 8) = pack8(o);
        }
      }
    }
  }
  __syncthreads();
}

__device__ void phase_merge(const Params& P, char* smem) {
  bfu* sA = (bfu*)smem; bfu* sB = sA + 128 * 72;
  const bfu* yr = (const bfu*)(P.ws + SLOT(5)); const bfu* ym = (const bfu*)(P.ws + SLOT(8));
  const bfu* gr = (const bfu*)(P.ws + SLOT(9)); const bfu* gm = (const bfu*)(P.ws + SLOT(11));
  bfu* mg = (bfu*)(P.ws + SLOT(6));
  for (int t = blockIdx.x; t < 260 * 8; t += gridDim.x) {
    int mt, nt; tile_map(t, 260, 8, mt, nt);
    f32x16 acc[2][2]; zero_acc(acc);
    bfu* sT = (bfu*)smem;
    const size_t tbase = (size_t)mt * 128 * 1024 + nt * 128;
    uint4 t1[8];
    gemm_acc(acc, yr + (size_t)mt * 128 * 512, 512, (const bfu*)(P.ws + O_WT_UPR) + (size_t)nt * 128 * 512, 512, 512, sA, sB);
    __syncthreads();
    stage_rm(sT, acc, 1.f);
    __syncthreads();
#pragma unroll
    for (int i = 0; i < 8; ++i) {
      int id = threadIdx.x + i * 256, row = id >> 4, c8 = (id & 15) * 8;
      float a[8], g[8];
      unpack8(*(const uint4*)(sT + row * ST_LD + c8), a);
      unpack8(*(const uint4*)(gr + tbase + (size_t)row * 1024 + c8), g);
#pragma unroll
      for (int j = 0; j < 8; ++j) a[j] *= sigmoidf_(g[j]);
      t1[i] = pack8(a);
    }
    zero_acc(acc);
    gemm_acc(acc, ym + (size_t)mt * 128 * 512, 512, (const bfu*)(P.ws + O_WT_UPM) + (size_t)nt * 128 * 512, 512, 512, sA, sB);
    __syncthreads();
    stage_rm(sT, acc, 1.f);
    __syncthreads();
#pragma unroll
    for (int i = 0; i < 8; ++i) {
      int id = threadIdx.x + i * 256, row = id >> 4, c8 = (id & 15) * 8;
      float a[8], g[8], t[8];
      unpack8(*(const uint4*)(sT + row * ST_LD + c8), a);
      unpack8(*(const uint4*)(gm + tbase + (size_t)row * 1024 + c8), g);
      unpack8(t1[i], t);
#pragma unroll
      for (int j = 0; j < 8; ++j) a[j] = t[j] + a[j] * sigmoidf_(g[j]);
      *(uint4*)(mg + tbase + (size_t)row * 1024 + c8) = pack8(a);
    }
  }
}

__device__ void phase_outproj(const Params& P, char* smem) {
  bfu* sA = (bfu*)smem; bfu* sB = sA + 128 * 72;
  const bfu* mg = (const bfu*)(P.ws + SLOT(6));
  for (int t = blockIdx.x; t < 260 * 8; t += gridDim.x) {
    int mt, nt; tile_map(t, 260, 8, mt, nt);
    f32x16 acc[2][2]; zero_acc(acc);
    gemm_acc(acc, mg + (size_t)mt * 128 * 1024, 1024, (const bfu*)(P.ws + O_WT_OUT) + (size_t)nt * 128 * 1024, 1024, 1024, sA, sB);
    float* sT32 = (float*)smem;
    __syncthreads();
    {
      EPI_BEGIN
#pragma unroll
        for (int j = 0; j < 4; ++j) {
          sT32[(r0 + j) * ST32_LD + cl] = acc[mi][0][q * 4 + j];
          sT32[(r0 + j) * ST32_LD + cl + 64] = acc[mi][1][q * 4 + j];
        }
      EPI_END
    }
    __syncthreads();
#pragma unroll
    for (int i = 0; i < 16; ++i) {
      int id = threadIdx.x + i * 256, row = id >> 5, c4 = (id & 31) * 4;
      int r = mt * 128 + row;
      float4 a = *(const float4*)(sT32 + row * ST32_LD + c4);
      float4 x = *(const float4*)(xrow(P, r) + nt * 128 + c4);
      float4 o = make_float4(x.x + a.x, x.y + a.y, x.z + a.z, x.w + a.w);
      *(float4*)(P.out + (size_t)r * 1024 + nt * 128 + c4) = o;
      float4 g = *(const float4*)(P.g_ffn + nt * 128 + c4);
      uint2 hv; hv.x = pack2(o.x * g.x, o.y * g.y); hv.y = pack2(o.z * g.z, o.w * g.w);
      *(uint2*)((bfu*)(P.ws + SLOT(0)) + (size_t)r * 1024 + nt * 128 + c4) = hv;
      float ss = o.x * o.x + o.y * o.y + o.z * o.z + o.w * o.w;
      ss = dpp_ror_add(ss, 8); ss = dpp_ror_add(ss, 4); ss = dpp_ror_add(ss, 2); ss = dpp_ror_add(ss, 1);
      ss += __shfl_xor(ss, 16);
      if ((threadIdx.x & 31) == 0) ((float*)(P.ws + O_GPRE))[(size_t)r * 8 + nt] = ss;
    }
  }
}

__device__ void phase_norm_rows(const Params& P, const float* g, bfu* dst) {
  const int lane = threadIdx.x & 63, w = threadIdx.x >> 6;
  for (int r = blockIdx.x * 4 + w; r < MT; r += gridDim.x * 4) {
    const float* xr = P.out + (size_t)r * 1024;
    float4 v[4]; float ss = 0.f;
#pragma unroll
    for (int i = 0; i < 4; ++i) {
      v[i] = *(const float4*)(xr + i * 256 + lane * 4);
      ss += v[i].x * v[i].x + v[i].y * v[i].y + v[i].z * v[i].z + v[i].w * v[i].w;
    }
    ss = wave_sum(ss);
    float rstd = rsqrtf(ss * (1.f / 1024.f) + EPS);
#pragma unroll
    for (int i = 0; i < 4; ++i) {
      float4 gg = *(const float4*)(g + i * 256 + lane * 4);
      uint2 o; o.x = pack2(v[i].x * rstd * gg.x, v[i].y * rstd * gg.y); o.y = pack2(v[i].z * rstd * gg.z, v[i].w * rstd * gg.w);
      *(uint2*)(dst + (size_t)r * 1024 + i * 256 + lane * 4) = o;
    }
  }
}

__device__ void phase_pq(const Params& P, char* smem) {
  bfu* sA = (bfu*)smem; bfu* sB = sA + 128 * 72;
  const bfu* hq = (const bfu*)(P.ws + SLOT(0));
  bfu* qb = (bfu*)(P.ws + SLOT(9));
  for (int t = blockIdx.x; t < 260 * 16; t += gridDim.x) {
    int mt, nt; tile_map(t, 260, 16, mt, nt);
    f32x16 acc[2][2]; zero_acc(acc);
    float* sRstd = (float*)(smem + 66048);
    if (threadIdx.x < 128) {
      const float* pp = (const float*)(P.ws + O_GPRE) + (size_t)(mt * 128 + threadIdx.x) * 8;
      float4 p0 = *(const float4*)pp, p1 = *(const float4*)(pp + 4);
      sRstd[threadIdx.x] = rsqrtf((p0.x + p0.y + p0.z + p0.w + p1.x + p1.y + p1.z + p1.w) * (1.f / 1024.f) + EPS);
    }
    gemm_acc(acc, hq + (size_t)mt * 128 * 1024, 1024, (const bfu*)(P.ws + O_WT_PQ) + (size_t)nt * 128 * 1024, 1024, 1024, sA, sB);
    bfu* sT = (bfu*)smem;
    __syncthreads();
    {
      EPI_BEGIN
#pragma unroll
        for (int j = 0; j < 4; ++j) {
          const float rs = sRstd[r0 + j];
          sT[(r0 + j) * ST_LD + cl] = f2bf(acc[mi][0][q * 4 + j] * rs);
          sT[(r0 + j) * ST_LD + cl + 64] = f2bf(acc[mi][1][q * 4 + j] * rs);
        }
      EPI_END
    }
    __syncthreads();
    copyout_bf16(sT, qb + (size_t)mt * 128 * 2048 + nt * 128, 2048);
  }
}


template <bool DESC> __device__ __forceinline__ void cex(float& a, float& b) {
  float mx = fmaxf(a, b), mn = fminf(a, b);
  a = DESC ? mx : mn; b = DESC ? mn : mx;
}
template <int B, bool DESC> __device__ __forceinline__ void bmerge16(float (&v)[64]) {
#pragma unroll
  for (int j = 8; j > 0; j >>= 1)
#pragma unroll
    for (int i = 0; i < 16; ++i) { int l = i ^ j; if (l > i) cex<DESC>(v[B + i], v[B + l]); }
}
template <int B, bool DESC> __device__ __forceinline__ void bsort16(float (&v)[64]) {
#pragma unroll
  for (int k = 2; k <= 16; k <<= 1)
#pragma unroll
    for (int j = k >> 1; j > 0; j >>= 1)
#pragma unroll
      for (int i = 0; i < 16; ++i) {
        int l = i ^ j;
        if (l > i) {
          bool up = ((i & k) == 0) || (k == 16);
          if (up == true) { if (DESC) cex<true>(v[B + i], v[B + l]); else cex<false>(v[B + i], v[B + l]); }
          else { if (DESC) cex<false>(v[B + i], v[B + l]); else cex<true>(v[B + i], v[B + l]); }
        }
      }
}
__device__ __forceinline__ float pair_max(float v) {
  auto r = __builtin_amdgcn_permlane32_swap(__float_as_int(v), __float_as_int(v), false, false);
  return fmaxf(__int_as_float(r[0]), __int_as_float(r[1]));
}
__device__ void phase_topk(const Params& P, char* smem) {
  const int tid = threadIdx.x, lane = tid & 63, w = tid >> 6, r32 = lane & 31, hh = lane >> 5;
  unsigned* sL = (unsigned*)smem + w * 1664;
  unsigned* sW = sL + 32 * 33;
  const bfu* qb = (const bfu*)(P.ws + SLOT(9));
  const bfu* keys = (const bfu*)(P.ws + O_KEYS);
  int* ids = (int*)(P.ws + SLOT(4));
  float* gw = (float*)(P.ws + SLOT(13));
  for (int item = blockIdx.x * 4 + w; item < 1040 * 8; item += gridDim.x * 4) {
    const int tg = item >> 3, n = item & 7, rowb = tg * 32;
#pragma unroll 1
    for (int half = 0; half < 2; ++half) {
      f32x16 acc[4];
#pragma unroll
      for (int c = 0; c < 4; ++c)
#pragma unroll
        for (int i = 0; i < 16; ++i) acc[c][i] = 0.f;
      const bfu* kp = keys + (size_t)((n * 2 + half) * 128 + r32) * 128 + hh * 8;
      const bfu* qp = qb + (size_t)(rowb + r32) * 2048 + n * 256 + half * 128 + hh * 8;
#pragma unroll
      for (int ks = 0; ks < 8; ++ks) {
        bf16x8 bfr = *(const bf16x8*)(qp + ks * 16);
#pragma unroll
        for (int c = 0; c < 4; ++c) {
          bf16x8 af = *(const bf16x8*)(kp + (size_t)c * 32 * 128 + ks * 16);
          acc[c] = __builtin_amdgcn_mfma_f32_32x32x16_bf16(af, bfr, acc[c], 0, 0, 0);
        }
      }
      float kk[64];
#pragma unroll
      for (int c = 0; c < 4; ++c)
#pragma unroll
        for (int reg = 0; reg < 16; ++reg) {
          unsigned kidx = c * 32 + (reg & 3) + 8 * (reg >> 2) + 4 * hh;
          kk[c * 16 + reg] = __uint_as_float((__float_as_uint(acc[c][reg]) & ~127u) | kidx);
        }
      bsort16<0, true>(kk); bsort16<16, false>(kk); bsort16<32, false>(kk); bsort16<48, true>(kk);
#pragma unroll
      for (int i = 0; i < 16; ++i) { kk[i] = fmaxf(kk[i], kk[16 + i]); kk[32 + i] = fmaxf(kk[32 + i], kk[48 + i]); }
      bmerge16<0, true>(kk); bmerge16<32, false>(kk);
#pragma unroll
      for (int i = 0; i < 16; ++i) kk[i] = fmaxf(kk[i], kk[32 + i]);
      bmerge16<0, true>(kk);
      {
        float lo[16], hi[16];
#pragma unroll
        for (int i = 0; i < 16; ++i) {
          auto r = __builtin_amdgcn_permlane32_swap(__float_as_int(kk[i]), __float_as_int(kk[i]), false, false);
          lo[i] = __int_as_float(r[0]); hi[i] = __int_as_float(r[1]);
        }
#pragma unroll
        for (int i = 0; i < 16; ++i) kk[i] = fmaxf(lo[i], hi[15 - i]);
      }
      bmerge16<0, true>(kk);
      if (hh == 0) {
#pragma unroll
        for (int p = 0; p < 16; ++p) sL[r32 * 33 + half * 16 + p] = __float_as_uint(kk[p]);
      }
    }
    __builtin_amdgcn_fence(__ATOMIC_RELEASE, "workgroup");
    __builtin_amdgcn_wave_barrier();
    __builtin_amdgcn_fence(__ATOMIC_ACQUIRE, "workgroup");
    float x[4], y[16];
    {
      const unsigned* lx = sL + r32 * 33 + (hh ? 16 : 0);
      const unsigned* ly = sL + r32 * 33 + (hh ? 0 : 16);
#pragma unroll
      for (int i = 0; i < 4; ++i) x[i] = __uint_as_float(lx[i] & ~127u);
#pragma unroll
      for (int j = 0; j < 16; ++j) y[j] = __uint_as_float(ly[j] & ~127u);
    }
    float cd[25];
#define CAND(t, i, j) { float sv = x[i] + y[j]; unsigned code = hh ? ((j) << 4 | (i)) : ((i) << 4 | (j)); \
      cd[t] = __uint_as_float((__float_as_uint(sv) & ~255u) | code); }
    CAND(0, 0, 1) CAND(1, 0, 2) CAND(2, 0, 3) CAND(3, 0, 4) CAND(4, 0, 5) CAND(5, 0, 6) CAND(6, 0, 7) CAND(7, 0, 8)
    CAND(8, 0, 9) CAND(9, 0, 10) CAND(10, 0, 11) CAND(11, 0, 12) CAND(12, 0, 13) CAND(13, 0, 14) CAND(14, 0, 15)
    CAND(15, 1, 2) CAND(16, 1, 3) CAND(17, 1, 4) CAND(18, 1, 5) CAND(19, 1, 6) CAND(20, 1, 7) CAND(21, 2, 3) CAND(22, 2, 4)
    {
      float d0 = hh ? x[2] + y[2] : x[0] + y[0];
      float d1 = hh ? x[3] + y[3] : x[1] + y[1];
      unsigned c0 = hh ? 0x22u : 0x00u, c1 = hh ? 0x33u : 0x11u;
      cd[23] = __uint_as_float((__float_as_uint(d0) & ~255u) | c0);
      cd[24] = __uint_as_float((__float_as_uint(d1) & ~255u) | c1);
    }
    {
      float cv[64];
#pragma unroll
      for (int t = 0; t < 25; ++t) cv[t] = cd[t];
#pragma unroll
      for (int t = 25; t < 32; ++t) cv[t] = -INFINITY;
      bsort16<0, true>(cv); bsort16<16, false>(cv);
#pragma unroll
      for (int i = 0; i < 16; ++i) cv[i] = fmaxf(cv[i], cv[16 + i]);
      bmerge16<0, true>(cv);
      {
        float lo[16], hi[16];
#pragma unroll
        for (int i = 0; i < 16; ++i) {
          auto r = __builtin_amdgcn_permlane32_swap(__float_as_int(cv[i]), __float_as_int(cv[i]), false, false);
          lo[i] = __int_as_float(r[0]); hi[i] = __int_as_float(r[1]);
        }
#pragma unroll
        for (int i = 0; i < 16; ++i) cv[i] = fmaxf(lo[i], hi[15 - i]);
      }
      bmerge16<0, true>(cv);
      if (hh == 0) {
#pragma unroll
        for (int p = 0; p < 16; ++p) sW[r32 * 17 + p] = __float_as_uint(cv[p]);
      }
    }
    __builtin_amdgcn_fence(__ATOMIC_RELEASE, "workgroup");
    __builtin_amdgcn_wave_barrier();
    __builtin_amdgcn_fence(__ATOMIC_ACQUIRE, "workgroup");
    {
      const unsigned* la = sL + r32 * 33;
      unsigned c0 = sW[r32 * 17] & 255u;
      float scmax = __uint_as_float(la[c0 >> 4] & ~127u) + __uint_as_float(la[16 + (c0 & 15)] & ~127u);
      float ex[8]; int ee[8]; float sum = 0.f;
#pragma unroll
      for (int k = 0; k < 8; ++k) {
        unsigned code = sW[r32 * 17 + hh * 8 + k] & 255u;
        unsigned ka = la[code >> 4], kb = la[16 + (code & 15)];
        float sc = __uint_as_float(ka & ~127u) + __uint_as_float(kb & ~127u);
        ex[k] = __expf(sc - scmax);
        ee[k] = (int)((ka & 127u) * 128u + (kb & 127u));
        sum += ex[k];
      }
      sum += __shfl_xor(sum, 32);
      float inv = 1.f / sum;
      size_t o = (size_t)(rowb + r32) * 128 + n * 16 + hh * 8;
      *(int4*)(ids + o) = make_int4(ee[0], ee[1], ee[2], ee[3]);
      *(int4*)(ids + o + 4) = make_int4(ee[4], ee[5], ee[6], ee[7]);
      *(float4*)(gw + o) = make_float4(ex[0] * inv, ex[1] * inv, ex[2] * inv, ex[3] * inv);
      *(float4*)(gw + o + 4) = make_float4(ex[4] * inv, ex[5] * inv, ex[6] * inv, ex[7] * inv);
    }
    __builtin_amdgcn_wave_barrier();
  }
}

typedef float f2v __attribute__((ext_vector_type(2)));
#define U8_SCALE 512.f
#define V8_SCALE 128.f
__device__ void convert_fp8(const float* __restrict__ src, unsigned char* __restrict__ dst, size_t n16, float scale,
                            int gtid, int gstride) {
  for (size_t i = gtid; i < n16; i += gstride) {
    unsigned w[4];
#pragma unroll
    for (int k = 0; k < 4; ++k) {
      float4 a = *(const float4*)(src + i * 16 + k * 4);
      float v0 = fminf(fmaxf(a.x * scale, -448.f), 448.f), v1 = fminf(fmaxf(a.y * scale, -448.f), 448.f);
      float v2 = fminf(fmaxf(a.z * scale, -448.f), 448.f), v3 = fminf(fmaxf(a.w * scale, -448.f), 448.f);
      int t = 0;
      t = __builtin_amdgcn_cvt_pk_fp8_f32(v0, v1, t, false);
      t = __builtin_amdgcn_cvt_pk_fp8_f32(v2, v3, t, true);
      w[k] = (unsigned)t;
    }
    *(uint4*)(dst + i * 16) = make_uint4(w[0], w[1], w[2], w[3]);
  }
}
__device__ __forceinline__ float dot16_fp8(uint4 u, const f2v* x2) {
  f2v acc = __builtin_amdgcn_cvt_pk_f32_fp8((int)u.x, false) * x2[0];
  acc += __builtin_amdgcn_cvt_pk_f32_fp8((int)u.x, true) * x2[1];
  acc += __builtin_amdgcn_cvt_pk_f32_fp8((int)u.y, false) * x2[2];
  acc += __builtin_amdgcn_cvt_pk_f32_fp8((int)u.y, true) * x2[3];
  acc += __builtin_amdgcn_cvt_pk_f32_fp8((int)u.z, false) * x2[4];
  acc += __builtin_amdgcn_cvt_pk_f32_fp8((int)u.z, true) * x2[5];
  acc += __builtin_amdgcn_cvt_pk_f32_fp8((int)u.w, false) * x2[6];
  acc += __builtin_amdgcn_cvt_pk_f32_fp8((int)u.w, true) * x2[7];
  return acc.x + acc.y;
}
__device__ __forceinline__ void axpy16_fp8(f2v* o2, float cf, uint4 v) {
  f2v c = {cf, cf};
  o2[0] += c * __builtin_amdgcn_cvt_pk_f32_fp8((int)v.x, false);
  o2[1] += c * __builtin_amdgcn_cvt_pk_f32_fp8((int)v.x, true);
  o2[2] += c * __builtin_amdgcn_cvt_pk_f32_fp8((int)v.y, false);
  o2[3] += c * __builtin_amdgcn_cvt_pk_f32_fp8((int)v.y, true);
  o2[4] += c * __builtin_amdgcn_cvt_pk_f32_fp8((int)v.z, false);
  o2[5] += c * __builtin_amdgcn_cvt_pk_f32_fp8((int)v.z, true);
  o2[6] += c * __builtin_amdgcn_cvt_pk_f32_fp8((int)v.w, false);
  o2[7] += c * __builtin_amdgcn_cvt_pk_f32_fp8((int)v.w, true);
}
#define PEER_LOAD(u, v, b)                                                                   \
  _Pragma("unroll") for (int k = 0; k < 8; ++k) {                                            \
    int j = (b) * 8 + k;                                                                     \
    int e = __builtin_amdgcn_readlane((b) < 8 ? id0 : id1, j & 63);                          \
    u[k] = *(const uint4*)(U8 + (size_t)e * 1024 + lane * 16);                               \
    v[k] = *(const uint4*)(V8 + (size_t)e * 1024 + lane * 16);                               \
  }
#define PEER_COMP(u, v, b)                                                                   \
  _Pragma("unroll") for (int hf = 0; hf < 2; ++hf) {                                         \
    float s = reduce4(dot16_fp8(u[hf * 4 + 0], x2), dot16_fp8(u[hf * 4 + 1], x2),           \
                      dot16_fp8(u[hf * 4 + 2], x2), dot16_fp8(u[hf * 4 + 3], x2)) * xr_rstd; \
    float act = 0.5f * s * (1.f + erff(s * 0.7071067811865475f));                            \
    float gsel = __shfl((b) < 8 ? g0 : g1, ((b) * 8 + hf * 4 + (lane >> 4)) & 63);           \
    float cfv = act * gsel * (1.f / V8_SCALE);                                               \
    axpy16_fp8(o2, __int_as_float(__builtin_amdgcn_readlane(__float_as_int(cfv), 0)), v[hf * 4 + 0]);  \
    axpy16_fp8(o2, __int_as_float(__builtin_amdgcn_readlane(__float_as_int(cfv), 16)), v[hf * 4 + 1]); \
    axpy16_fp8(o2, __int_as_float(__builtin_amdgcn_readlane(__float_as_int(cfv), 32)), v[hf * 4 + 2]); \
    axpy16_fp8(o2, __int_as_float(__builtin_amdgcn_readlane(__float_as_int(cfv), 48)), v[hf * 4 + 3]); \
  }
__device__ void phase_peer(const Params& P) {
  const int lane = threadIdx.x & 63, w = threadIdx.x >> 6;
  bfu* hq = (bfu*)(P.ws + SLOT(0));
  const unsigned char* U8 = (const unsigned char*)(P.ws + SLOT(2));
  const unsigned char* V8 = (const unsigned char*)(P.ws + SLOT(3));
  const int* ids = (const int*)(P.ws + SLOT(4));
  const float* gw = (const float*)(P.ws + SLOT(13));
  bfu* pbf = (bfu*)(P.ws + SLOT(6));
  for (int r = blockIdx.x * 4 + w; r < MT; r += gridDim.x * 4) {
    f2v x2[8], o2[8];
    {
      uint4 v0 = *(const uint4*)(hq + (size_t)r * 1024 + lane * 16);
      uint4 v1 = *(const uint4*)(hq + (size_t)r * 1024 + lane * 16 + 8);
      float xf[16];
      unpack8(v0, xf); unpack8(v1, xf + 8);
#pragma unroll
      for (int j = 0; j < 8; ++j) { x2[j].x = xf[2 * j]; x2[j].y = xf[2 * j + 1]; o2[j].x = 0.f; o2[j].y = 0.f; }
    }
    int id0 = ids[(size_t)r * 128 + lane], id1 = ids[(size_t)r * 128 + 64 + lane];
    float g0 = gw[(size_t)r * 128 + lane], g1 = gw[(size_t)r * 128 + 64 + lane];
    float xr_rstd;
    {
      const float* pp = (const float*)(P.ws + O_GPRE) + (size_t)r * 8;
      float4 p0 = *(const float4*)pp, p1 = *(const float4*)(pp + 4);
      xr_rstd = rsqrtf((p0.x + p0.y + p0.z + p0.w + p1.x + p1.y + p1.z + p1.w) * (1.f / 1024.f) + EPS) * (1.f / U8_SCALE);
    }
    uint4 uA[8], vA[8], uB[8], vB[8];
    PEER_LOAD(uA, vA, 0)
    for (int b = 0; b < 16; b += 2) {
      PEER_LOAD(uB, vB, b + 1)
      PEER_COMP(uA, vA, b)
      if (b + 2 < 16) { PEER_LOAD(uA, vA, b + 2) }
      PEER_COMP(uB, vB, b + 1)
    }
    float* xr = P.out + (size_t)r * 1024 + lane * 16;
    float x3[16];
    float ss = 0.f;
#pragma unroll
    for (int k = 0; k < 4; ++k) {
      float4 a = *(const float4*)(xr + k * 4);
      x3[k * 4 + 0] = a.x + o2[k * 2].x; x3[k * 4 + 1] = a.y + o2[k * 2].y;
      x3[k * 4 + 2] = a.z + o2[k * 2 + 1].x; x3[k * 4 + 3] = a.w + o2[k * 2 + 1].y;
      *(float4*)(xr + k * 4) = make_float4(x3[k * 4], x3[k * 4 + 1], x3[k * 4 + 2], x3[k * 4 + 3]);
    }
#pragma unroll
    for (int j = 0; j < 16; ++j) ss += x3[j] * x3[j];
    ss = wave_sum(ss);
    float rstd = rsqrtf(ss * (1.f / 1024.f) + EPS);
    float hv[16];
#pragma unroll
    for (int k = 0; k < 4; ++k) {
      float4 ga = *(const float4*)(P.g_ple + lane * 16 + k * 4);
      hv[k * 4] = x3[k * 4] * rstd * ga.x; hv[k * 4 + 1] = x3[k * 4 + 1] * rstd * ga.y;
      hv[k * 4 + 2] = x3[k * 4 + 2] * rstd * ga.z; hv[k * 4 + 3] = x3[k * 4 + 3] * rstd * ga.w;
    }
    *(uint4*)(hq + (size_t)r * 1024 + lane * 16) = pack8(hv);
    *(uint4*)(hq + (size_t)r * 1024 + lane * 16 + 8) = pack8(hv + 8);
    {
      const float* pr = r < MP ? P.pp + (size_t)r * 256 : P.ps + (size_t)(r - MP) * 256;
      float4 a = *(const float4*)(pr + lane * 4);
      uint2 ov; ov.x = pack2(a.x, a.y); ov.y = pack2(a.z, a.w);
      *(uint2*)(pbf + (size_t)r * 256 + lane * 4) = ov;
    }
  }
}

__device__ void phase_ple(const Params& P, char* smem) {
  bfu* sA = (bfu*)smem; bfu* sB = sA + 128 * 72;
  const bfu* hg = (const bfu*)(P.ws + SLOT(0));
  const bfu* pbf = (const bfu*)(P.ws + SLOT(6));
  for (int t = blockIdx.x; t < 260 * 8; t += gridDim.x) {
    int mt, nt; tile_map(t, 260, 8, mt, nt);
    f32x16 acc[2][2]; zero_acc(acc);
    bfu* sT = (bfu*)smem; float* sT32 = (float*)smem;
    uint2 pg[16];
    gemm_acc(acc, hg + (size_t)mt * 128 * 1024, 1024, (const bfu*)(P.ws + O_WT_PG) + (size_t)nt * 128 * 1024, 1024, 1024, sA, sB);
    __syncthreads();
    {
      EPI_BEGIN
#pragma unroll
        for (int j = 0; j < 4; ++j) {
          sT[(r0 + j) * ST_LD + cl] = f2bf(sigmoidf_(acc[mi][0][q * 4 + j]));
          sT[(r0 + j) * ST_LD + cl + 64] = f2bf(sigmoidf_(acc[mi][1][q * 4 + j]));
        }
      EPI_END
    }
    __syncthreads();
#pragma unroll
    for (int i = 0; i < 16; ++i) {
      int id = threadIdx.x + i * 256, row = id >> 5, c4 = (id & 31) * 4;
      pg[i] = *(const uint2*)(sT + row * ST_LD + c4);
    }
    zero_acc(acc);
    gemm_acc(acc, pbf + (size_t)mt * 128 * 256, 256, (const bfu*)(P.ws + O_WT_PLE) + (size_t)nt * 128 * 256, 256, 256, sA, sB);
    __syncthreads();
    {
      EPI_BEGIN
#pragma unroll
        for (int j = 0; j < 4; ++j) {
          sT32[(r0 + j) * ST32_LD + cl] = acc[mi][0][q * 4 + j];
          sT32[(r0 + j) * ST32_LD + cl + 64] = acc[mi][1][q * 4 + j];
        }
      EPI_END
    }
    __syncthreads();
#pragma unroll
    for (int i = 0; i < 16; ++i) {
      int id = threadIdx.x + i * 256, row = id >> 5, c4 = (id & 31) * 4;
      float4 a = *(const float4*)(sT32 + row * ST32_LD + c4);
      float* op = P.out + (size_t)(mt * 128 + row) * 1024 + nt * 128 + c4;
      float4 x = *(const float4*)op;
      float g0 = bf2f(pg[i].x & 0xffff), g1 = bf2f(pg[i].x >> 16), g2 = bf2f(pg[i].y & 0xffff), g3 = bf2f(pg[i].y >> 16);
      *(float4*)op = make_float4(x.x + a.x * g0, x.y + a.y * g1, x.z + a.z * g2, x.w + a.w * g3);
    }
  }
}

__device__ void phase_final(const Params& P) {
  const int lane = threadIdx.x & 63, w = threadIdx.x >> 6;
  for (int r = blockIdx.x * 4 + w; r < MT; r += gridDim.x * 4) {
    float* xr = P.out + (size_t)r * 1024;
    float4 v[4]; float ss = 0.f;
#pragma unroll
    for (int i = 0; i < 4; ++i) {
      v[i] = *(const float4*)(xr + i * 256 + lane * 4);
      ss += v[i].x * v[i].x + v[i].y * v[i].y + v[i].z * v[i].z + v[i].w * v[i].w;
    }
    ss = wave_sum(ss);
    float rstd = rsqrtf(ss * (1.f / 1024.f) + EPS);
#pragma unroll
    for (int i = 0; i < 4; ++i) {
      float4 gg = *(const float4*)(P.g_final + i * 256 + lane * 4);
      *(float4*)(xr + i * 256 + lane * 4) = make_float4(v[i].x * rstd * gg.x, v[i].y * rstd * gg.y, v[i].z * rstd * gg.z, v[i].w * rstd * gg.w);
    }
  }
}

__global__ void __launch_bounds__(NTHREADS, 2) fwd_megakernel(Params P) {
  extern __shared__ __attribute__((aligned(16))) char smem[];
  cg::grid_group grid = cg::this_grid();
  __shared__ uint4 xb_words;
  if (threadIdx.x == 0) xb_words = make_uint4(0u, 0u, 0u, 0u);
  __syncthreads();
  XcdBarrier xb = xcd_barrier_post((unsigned*)(P.ws + O_BAR), (volatile LAS unsigned*)&xb_words);
  if (P.out == nullptr) grid.sync();
  const int gtid = blockIdx.x * NTHREADS + threadIdx.x, gstride = gridDim.x * NTHREADS;
  phase_prep(P, smem);
  xcd_barrier(xb);
  phase_gemm1(P, smem);
  xcd_barrier(xb);
  phase_conv(P);
  gate_scan(P);
  xcd_barrier(xb);
  m_fold(P);
  phase_mqk(P, smem);
  xcd_barrier(xb);
  for (int t = blockIdx.x; t < 4224; t += gridDim.x) phaseA_item(P, t / 2112, t % 2112, smem);
  xcd_barrier(xb);
  phase_scan(P);
  xcd_barrier(xb);
  for (int t = blockIdx.x; t < 4224; t += gridDim.x) phaseC_item(P, t / 2112, t % 2112, smem);
  xcd_barrier(xb);
  phase_merge(P, smem);
  {
    const int extra = 2080 % (int)gridDim.x;
    if ((int)blockIdx.x >= extra) {
      const int cg_tid = ((int)blockIdx.x - extra) * NTHREADS + threadIdx.x, cg_str = ((int)gridDim.x - extra) * NTHREADS;
      convert_fp8(P.peer_u, (unsigned char*)(P.ws + SLOT(2)), 16384ull * 1024 / 16, U8_SCALE, cg_tid, cg_str);
      convert_fp8(P.peer_v, (unsigned char*)(P.ws + SLOT(3)), 16384ull * 1024 / 16, V8_SCALE, cg_tid, cg_str);
    }
  }
  xcd_barrier(xb);
  phase_outproj(P, smem);
  xcd_barrier(xb);
  phase_pq(P, smem);
  xcd_barrier(xb);
  phase_topk(P, smem);
  xcd_barrier(xb);
  phase_peer(P);
  xcd_barrier(xb);
  phase_ple(P, smem);
  xcd_barrier(xb);
  phase_final(P);
}

extern "C" void kernel_launch(void* const* d_in, const int* in_sizes, int n_in, void* d_out, int out_size,
                              void* d_ws, size_t ws_size, hipStream_t stream) {
  static int grid_blocks = 0;
  if (!grid_blocks) {
    hipFuncSetAttribute((const void*)fwd_megakernel, hipFuncAttributeMaxDynamicSharedMemorySize, SMEM_BYTES);
    int dev = 0, cus = 0, per_cu = 0;
    hipGetDevice(&dev);
    hipDeviceGetAttribute(&cus, hipDeviceAttributeMultiprocessorCount, dev);
    hipOccupancyMaxActiveBlocksPerMultiprocessor(&per_cu, fwd_megakernel, NTHREADS, SMEM_BYTES);
    if (per_cu > 2) per_cu = 2;
    if (per_cu < 1) per_cu = 1;
    grid_blocks = cus * per_cu;
  }
  Params p{};
  const float** pf = (const float**)&p;
  for (int i = 0; i < 32; ++i) pf[i] = (const float*)d_in[i];
  p.out = (float*)d_out;
  p.ws = (char*)d_ws;
  hipMemsetAsync((char*)d_ws + O_BAR, 0, XCD_BAR_WORDS * 4, stream);
  void* args[] = {&p};
  hipError_t e = hipLaunchCooperativeKernel((void*)fwd_megakernel, dim3(grid_blocks), dim3(NTHREADS), args, SMEM_BYTES, stream);
  if (e != hipSuccess) fprintf(stderr, "cooperative launch failed: %s (grid %d)\n", hipGetErrorString(e), grid_blocks);
}
```

```cpp
#include <hip/hip_runtime.h>
#include <hip/hip_cooperative_groups.h>
#include <cstdio>
namespace cg = cooperative_groups;

typedef unsigned short bfu;
typedef __attribute__((ext_vector_type(8))) short bf16x8;
typedef __attribute__((ext_vector_type(16))) float f32x16;

#define MT 33280
#define MP 32768
#define NTHREADS 256
#define EPS 1e-6f

struct Params {
  const float *xp, *xs, *pp, *ps, *st_ret, *st_C, *st_n, *st_m, *st_conv, *g_mix, *w_in, *g_ret_gn, *w_mq,
      *w_mk, *conv_w, *conv_b, *b_i, *b_f, *g_ml_gn, *w_skip, *w_up_r, *w_up_m, *w_out, *g_ffn, *w_pq,
      *peer_keys, *peer_u, *peer_v, *g_ple, *w_pg, *w_ple, *g_final;
  float* out;
  char* ws;
};

constexpr size_t O_WT_IN = 0;
constexpr size_t O_WT_UPR = O_WT_IN + 5632ull * 1024 * 2;
constexpr size_t O_WT_UPM = O_WT_UPR + 1024ull * 512 * 2;
constexpr size_t O_WT_OUT = O_WT_UPM + 1024ull * 512 * 2;
constexpr size_t O_WT_PQ = O_WT_OUT + 1024ull * 1024 * 2;
constexpr size_t O_WT_PG = O_WT_PQ + 2048ull * 1024 * 2;
constexpr size_t O_WT_PLE = O_WT_PG + 1024ull * 1024 * 2;
constexpr size_t O_KEYS = O_WT_PLE + 1024ull * 256 * 2;
constexpr size_t O_WT_MQ = O_KEYS + 16ull * 128 * 128 * 2;
constexpr size_t O_WT_MK = O_WT_MQ + 4ull * 128 * 128 * 2;
constexpr size_t O_COS = O_WT_MK + 4ull * 128 * 128 * 2;
constexpr size_t O_SIN = O_COS + 8192ull * 64 * 4;
constexpr size_t O_FQ = O_SIN + 8192ull * 64 * 4;
constexpr size_t O_UQ = O_FQ + (size_t)MT * 16;
constexpr size_t O_CMQ = O_UQ + (size_t)MT * 16;
constexpr size_t O_FL = O_CMQ + (size_t)MT * 16;
constexpr size_t O_UC = O_FL + 16384;
constexpr size_t O_AEND = O_UC + 16384;
constexpr size_t O_MCS = O_AEND + 16384;
constexpr size_t O_DN = O_MCS + 16384;
constexpr size_t O_DSS = O_DN + 2112ull * 128 * 4;
constexpr size_t O_GPRE = O_DSS + 2ull * 64 * 16384 * 2;
constexpr size_t O_BAR = O_GPRE + (size_t)MT * 32;
constexpr size_t O_SMALL_END = O_BAR + 16384;
constexpr size_t SLOT0 = 40ull << 20;
constexpr size_t USZ = (size_t)MT * 512 * 2;
static_assert(O_SMALL_END <= SLOT0, "small region overflow");
#define SLOT(i) (SLOT0 + (size_t)(i) * USZ)
constexpr size_t SB_T = 16ull * 128 * 8192;

constexpr size_t OO_Y = 0;
constexpr size_t OO_RETP = (size_t)MT * 1024;
constexpr size_t OO_CP = OO_RETP + 262144;
constexpr size_t OO_NP = OO_CP + 262144;
constexpr size_t OO_MP = OO_NP + 2048;
constexpr size_t OO_CONVP = OO_MP + 16;
constexpr size_t OO_RETS = OO_CONVP + 6144;
constexpr size_t OO_CS = OO_RETS + 1048576;
constexpr size_t OO_NS = OO_CS + 1048576;
constexpr size_t OO_MS = OO_NS + 8192;
constexpr size_t OO_CONVS = OO_MS + 64;

constexpr int SMEM_BYTES = 81152;

__device__ __forceinline__ bfu f2bf(float f) {
  unsigned u = __float_as_uint(f);
  u += 0x7fffu + ((u >> 16) & 1u);
  return (bfu)(u >> 16);
}
__device__ __forceinline__ float bf2f(bfu b) { return __uint_as_float(((unsigned)b) << 16); }
__device__ __forceinline__ unsigned pack2(float a, float b) { return (unsigned)f2bf(a) | ((unsigned)f2bf(b) << 16); }
__device__ __forceinline__ void unpack8(uint4 v, float* f) {
  f[0] = bf2f(v.x & 0xffff); f[1] = bf2f(v.x >> 16); f[2] = bf2f(v.y & 0xffff); f[3] = bf2f(v.y >> 16);
  f[4] = bf2f(v.z & 0xffff); f[5] = bf2f(v.z >> 16); f[6] = bf2f(v.w & 0xffff); f[7] = bf2f(v.w >> 16);
}
__device__ __forceinline__ uint4 pack8(const float* f) {
  uint4 o; o.x = pack2(f[0], f[1]); o.y = pack2(f[2], f[3]); o.z = pack2(f[4], f[5]); o.w = pack2(f[6], f[7]);
  return o;
}
__device__ __forceinline__ float wave_sum(float v) {
#pragma unroll
  for (int o = 32; o > 0; o >>= 1) v += __shfl_xor(v, o);
  return v;
}
__device__ __forceinline__ float wave_max(float v) {
#pragma unroll
  for (int o = 32; o > 0; o >>= 1) v = fmaxf(v, __shfl_xor(v, o));
  return v;
}
__device__ __forceinline__ float dpp_ror_add(float s, const int ctrl_sel) {
  int v = __float_as_int(s);
  int t;
  if (ctrl_sel == 8) t = __builtin_amdgcn_update_dpp(0, v, 0x128, 0xf, 0xf, false);
  else if (ctrl_sel == 4) t = __builtin_amdgcn_update_dpp(0, v, 0x124, 0xf, 0xf, false);
  else if (ctrl_sel == 2) t = __builtin_amdgcn_update_dpp(0, v, 0x122, 0xf, 0xf, false);
  else t = __builtin_amdgcn_update_dpp(0, v, 0x121, 0xf, 0xf, false);
  return s + __int_as_float(t);
}
__device__ __forceinline__ float reduce4(float p0, float p1, float p2, float p3) {
  auto r = __builtin_amdgcn_permlane32_swap(__float_as_int(p0), __float_as_int(p2), false, false);
  float sA = __int_as_float(r[0]) + __int_as_float(r[1]);
  r = __builtin_amdgcn_permlane32_swap(__float_as_int(p1), __float_as_int(p3), false, false);
  float sB = __int_as_float(r[0]) + __int_as_float(r[1]);
  r = __builtin_amdgcn_permlane16_swap(__float_as_int(sA), __float_as_int(sB), false, false);
  float s = __int_as_float(r[0]) + __int_as_float(r[1]);
  s = dpp_ror_add(s, 8); s = dpp_ror_add(s, 4); s = dpp_ror_add(s, 2); s = dpp_ror_add(s, 1);
  return s;
}
__device__ __forceinline__ float sigmoidf_(float x) { return 1.f / (1.f + __expf(-x)); }
__device__ __forceinline__ const float* xrow(const Params& P, int r) {
  return r < MP ? P.xp + (size_t)r * 1024 : P.xs + (size_t)(r - MP) * 1024;
}


#define XB_TMO      128
#define XB_XCNT(j)  (256  + 64 * (j))
#define XB_XSUB(j)  (1280 + 64 * (j))
#define XB_XGEN(j)  (2304 + 64 * (j))
#define XB_TOP      3328
#define XB_TOPGEN   3392
#define XCD_BAR_WORDS 3456
#define XB_SPIN_CAP (1u << 22)
#define LAS __attribute__((address_space(3)))
__device__ __forceinline__ unsigned xb_ld(unsigned* p) { return __hip_atomic_load(p, __ATOMIC_RELAXED, __HIP_MEMORY_SCOPE_AGENT); }
__device__ __forceinline__ unsigned xb_add(unsigned* p, unsigned v) { return __hip_atomic_fetch_add(p, v, __ATOMIC_RELAXED, __HIP_MEMORY_SCOPE_AGENT); }
__device__ __forceinline__ unsigned xb_xcc_id() { return (unsigned)__builtin_amdgcn_s_getreg((3 << 11) | 20) & 0xFu; }
#define XB_SPIN(cond, bar) do { unsigned _sp = 0; while (cond) { __builtin_amdgcn_s_sleep(1); \
    if ((++_sp & 255u) == 0u) { if (xb_ld(&(bar)[XB_TMO])) break; if (_sp > XB_SPIN_CAP) { atomicAdd(&(bar)[XB_TMO], 1u); break; } } } } while (0)
struct XcdBarrier { unsigned* bar; unsigned x; volatile LAS unsigned* st; };
__device__ __forceinline__ XcdBarrier xcd_barrier_post(unsigned* bar, volatile LAS unsigned* st) {
  XcdBarrier b; b.bar = bar; b.x = xb_xcc_id(); b.st = st;
  if (threadIdx.x == 0) (void)xb_add(&bar[XB_XCNT(b.x)], 1u);
  return b;
}
__device__ __forceinline__ void xcd_barrier_complete(unsigned* bar, unsigned x, unsigned& nloc, unsigned& nx) {
  const unsigned G = gridDim.x * gridDim.y * gridDim.z;
  unsigned sum, cnt, mine, sp = 0u;
  for (;;) {
    sum = 0u; cnt = 0u; mine = 0u;
#pragma unroll
    for (unsigned j = 0; j < 16; ++j) { const unsigned c = xb_ld(&bar[XB_XCNT(j)]); sum += c; cnt += (c > 0u) ? 1u : 0u; mine = (j == x) ? c : mine; }
    if (sum == G) break;
    __builtin_amdgcn_s_sleep(1);
    if ((++sp & 255u) == 0u) { if (xb_ld(&bar[XB_TMO])) break; if (sp > XB_SPIN_CAP) { atomicAdd(&bar[XB_TMO], 1u); break; } }
  }
  nloc = mine > 0u ? mine : 1u; nx = cnt > 0u ? cnt : 1u;
}
__device__ __forceinline__ void xcd_barrier(const XcdBarrier& b) {
  asm volatile("s_waitcnt vmcnt(0)" ::: "memory");
  __syncthreads();
  if (threadIdx.x == 0) {
    unsigned* bar = b.bar;
    __builtin_amdgcn_s_waitcnt(0);
    unsigned nloc = b.st[0], nx = b.st[1];
    if (nloc == 0u) { xcd_barrier_complete(bar, b.x, nloc, nx); b.st[0] = nloc; b.st[1] = nx; }
    const unsigned old = xb_add(&bar[XB_XSUB(b.x)], 1u);
    const unsigned gen = old / nloc;
    if (old + 1u == (gen + 1u) * nloc) {
      __builtin_amdgcn_fence(__ATOMIC_RELEASE, "agent");
      asm volatile("s_waitcnt vmcnt(0)" ::: "memory");
      const unsigned og = xb_add(&bar[XB_TOP], 1u);
      const unsigned tg = og / nx;
      if (og + 1u == (tg + 1u) * nx) xb_add(&bar[XB_TOPGEN], 1u);
      else XB_SPIN(xb_ld(&bar[XB_TOPGEN]) == tg, bar);
      __builtin_amdgcn_fence(__ATOMIC_ACQUIRE, "agent");
      xb_add(&bar[XB_XGEN(b.x)], 1u);
      asm volatile("s_waitcnt vmcnt(0)" ::: "memory");
    } else {
      XB_SPIN(xb_ld(&bar[XB_XGEN(b.x)]) == gen, bar);
      __builtin_amdgcn_fence(__ATOMIC_ACQUIRE, "agent");
      asm volatile("s_waitcnt vmcnt(0)" ::: "memory");
    }
  }
  __syncthreads();
}

__device__ __forceinline__ void gemm_acc(f32x16 (&acc)[2][2], const bfu* __restrict__ A, int lda,
                                         const bfu* __restrict__ Bt, int ldb, int K, bfu* sA, bfu*  ) {
  const int tid = threadIdx.x, lane = tid & 63, w = tid >> 6, wm = w & 1, wn = w >> 1;
  const int lr = tid >> 3;
  const int kc = ((tid & 7) ^ ((tid >> 4) & 7)) * 8;
  const bfu* Ap = A + (size_t)lr * lda + kc;
  const bfu* Bp = Bt + (size_t)lr * ldb + kc;
  const size_t a32 = (size_t)32 * lda, b32 = (size_t)32 * ldb;
  char* sbase = (char*)sA;
  char* ldst = sbase + tid * 16;
#define GISSUE(stage, k)                                                                                       \
  _Pragma("unroll") for (int i_ = 0; i_ < 4; ++i_) {                                                           \
    __builtin_amdgcn_global_load_lds((const unsigned*)(Ap + i_ * a32 + (k)),                                   \
                                     (LAS unsigned*)(ldst + (stage) * 32768 + i_ * 4096), 16, 0, 0);           \
    __builtin_amdgcn_global_load_lds((const unsigned*)(Bp + i_ * b32 + (k)),                                   \
                                     (LAS unsigned*)(ldst + (stage) * 32768 + 16384 + i_ * 4096), 16, 0, 0);   \
  }
  const int sw = (lane >> 1) & 7, hh = lane >> 5;
  const int rowA = (wm * 64 + (lane & 31)) * 128, rowB = (wn * 32 + (lane & 31)) * 128;
  __syncthreads();
  GISSUE(0, 0)
  int cur = 0;
  for (int k0 = 0; k0 < K; k0 += 64) {
    asm volatile("s_waitcnt vmcnt(0)" ::: "memory");
    __syncthreads();
    if (k0 + 64 < K) { GISSUE(cur ^ 1, k0 + 64) }
    const char* cA = sbase + cur * 32768;
    const char* cB = cA + 16384;
    __builtin_amdgcn_s_setprio(1);
#pragma unroll
    for (int ks = 0; ks < 4; ++ks) {
      const int pos = ((2 * ks + hh) ^ sw) * 16;
      bf16x8 af[2], bfr[2];
#pragma unroll
      for (int mi = 0; mi < 2; ++mi) af[mi] = *(const bf16x8*)(cA + rowA + mi * 32 * 128 + pos);
#pragma unroll
      for (int ni = 0; ni < 2; ++ni) bfr[ni] = *(const bf16x8*)(cB + rowB + ni * 64 * 128 + pos);
#pragma unroll
      for (int mi = 0; mi < 2; ++mi)
#pragma unroll
        for (int ni = 0; ni < 2; ++ni)
          acc[mi][ni] = __builtin_amdgcn_mfma_f32_32x32x16_bf16(af[mi], bfr[ni], acc[mi][ni], 0, 0, 0);
    }
    __builtin_amdgcn_s_setprio(0);
    cur ^= 1;
  }
}
#define gemm_acc1 gemm_acc
__device__ __forceinline__ void zero_acc(f32x16 (&acc)[2][2]) {
#pragma unroll
  for (int a = 0; a < 2; ++a)
#pragma unroll
    for (int b = 0; b < 2; ++b)
#pragma unroll
      for (int i = 0; i < 16; ++i) acc[a][b][i] = 0.f;
}
#define EPI_BEGIN                                                      \
  const int e_lane = threadIdx.x & 63, e_w = threadIdx.x >> 6;         \
  const int e_wm = e_w & 1, e_wn = e_w >> 1;                            \
  const int cl = e_wn * 32 + (e_lane & 31);                             \
  _Pragma("unroll") for (int mi = 0; mi < 2; ++mi)                      \
  _Pragma("unroll") for (int q = 0; q < 4; ++q) {                       \
    const int r0 = e_wm * 64 + mi * 32 + q * 8 + 4 * (e_lane >> 5);
#define EPI_END }

#define ST_LD 136
#define ST32_LD 132
typedef unsigned u32x4nt __attribute__((ext_vector_type(4)));
__device__ __forceinline__ void nt_store_u4(void* p, uint4 v) { u32x4nt t = {v.x, v.y, v.z, v.w}; __builtin_nontemporal_store(t, (u32x4nt*)p); }
__device__ __forceinline__ void copyout_bf16(const bfu* sT, bfu* dst, int ld) {
  const int tid = threadIdx.x;
#pragma unroll
  for (int i = 0; i < 8; ++i) {
    int id = tid + i * 256, row = id >> 4, c8 = (id & 15) * 8;
    *(uint4*)(dst + (size_t)row * ld + c8) = *(const uint4*)(sT + row * ST_LD + c8);
  }
}
__device__ __forceinline__ void copyout_bf16_nt(const bfu* sT, bfu* dst, int ld) {
  const int tid = threadIdx.x;
#pragma unroll
  for (int i = 0; i < 8; ++i) {
    int id = tid + i * 256, row = id >> 4, c8 = (id & 15) * 8;
    nt_store_u4(dst + (size_t)row * ld + c8, *(const uint4*)(sT + row * ST_LD + c8));
  }
}
__device__ __forceinline__ void stage_rm(bfu* sT, const f32x16 (&acc)[2][2], float sc) {
  EPI_BEGIN
#pragma unroll
    for (int j = 0; j < 4; ++j) {
      sT[(r0 + j) * ST_LD + cl] = f2bf(acc[mi][0][q * 4 + j] * sc);
      sT[(r0 + j) * ST_LD + cl + 64] = f2bf(acc[mi][1][q * 4 + j] * sc);
    }
  EPI_END
}

__device__ __forceinline__ void tile_map(int L, int nM, int nN, int& pm, int& pn) {
  const int nwg = nM * nN;
  const int q = nwg >> 3, r = nwg & 7, xcd = L & 7, off = L >> 3;
  int wgid = (xcd < r ? xcd * (q + 1) : r * (q + 1) + (xcd - r) * q) + off;
  const int nig = 8 * nN, gid = wgid / nig, fm = gid * 8;
  const int gsz = (nM - fm) < 8 ? (nM - fm) : 8;
  pm = fm + (wgid % nig) % gsz;
  pn = (wgid % nig) / gsz;
}
__device__ void transpose_w(const float* __restrict__ src, int K, int N, int src_ld, bfu* __restrict__ dst,
                            int remap, int gtid, int gstride) {
  int total = N * (K / 8);
  for (int i = gtid; i < total; i += gstride) {
    int n = i % N, kg = i / N;
    int col = (remap && n >= 3584) ? n + 8 : n;
    float v[8];
#pragma unroll
    for (int j = 0; j < 8; ++j) v[j] = src[(size_t)(kg * 8 + j) * src_ld + col];
    uint4 o;
    o.x = pack2(v[0], v[1]); o.y = pack2(v[2], v[3]); o.z = pack2(v[4], v[5]); o.w = pack2(v[6], v[7]);
    *(uint4*)(dst + (size_t)n * K + kg * 8) = o;
  }
}
__device__ void transpose_w_lds(const float* __restrict__ src, int K, int N, int src_ld, bfu* __restrict__ dst,
                                int remap, float* st, int boff) {
  const int tid = threadIdx.x;
  const int tilesN = N >> 6, ntile = (K >> 6) * tilesN;
  for (int t = (int)((blockIdx.x + gridDim.x - (boff % gridDim.x)) % gridDim.x); t < ntile; t += gridDim.x) {
    const int kt = t / tilesN, nt = t - kt * tilesN;
    {
      const int row = tid >> 2, c16 = (tid & 3) * 16;
      const int n0 = nt * 64 + c16;
      const int col = (remap && n0 >= 3584) ? n0 + 8 : n0;
      const float* sp = src + (size_t)(kt * 64 + row) * src_ld + col;
#pragma unroll
      for (int j = 0; j < 4; ++j) {
        float4 v = *(const float4*)(sp + j * 4);
        float* d = st + row * 65 + c16 + j * 4;
        d[0] = v.x; d[1] = v.y; d[2] = v.z; d[3] = v.w;
      }
    }
    __syncthreads();
    {
      const int n = tid >> 2, kc = (tid & 3) * 16;
#pragma unroll
      for (int hf = 0; hf < 2; ++hf) {
        float f[8];
#pragma unroll
        for (int j = 0; j < 8; ++j) f[j] = st[(kc + hf * 8 + j) * 65 + n];
        uint4 o;
        o.x = pack2(f[0], f[1]); o.y = pack2(f[2], f[3]); o.z = pack2(f[4], f[5]); o.w = pack2(f[6], f[7]);
        *(uint4*)(dst + (size_t)(nt * 64 + n) * K + kt * 64 + kc + hf * 8) = o;
      }
    }
    __syncthreads();
  }
}
__device__ void convert_bf(const float* __restrict__ src, bfu* __restrict__ dst, size_t n8, int gtid, int gstride) {
  for (size_t i = gtid; i < n8; i += gstride) {
    float4 a = *(const float4*)(src + i * 8), b = *(const float4*)(src + i * 8 + 4);
    uint4 o;
    o.x = pack2(a.x, a.y); o.y = pack2(a.z, a.w); o.z = pack2(b.x, b.y); o.w = pack2(b.z, b.w);
    *(uint4*)(dst + i * 8) = o;
  }
}

__device__ void prep_rows(const Params& P) {
  const int lane = threadIdx.x & 63, w = threadIdx.x >> 6;
  bfu* hbuf = (bfu*)(P.ws + SLOT(0));
  float* gpre = (float*)(P.ws + O_GPRE);
  float4 wg0[16], wg1[16];
#pragma unroll
  for (int i = 0; i < 4; ++i)
#pragma unroll
    for (int j = 0; j < 4; ++j) {
      const float* wr = P.w_in + (size_t)(i * 256 + lane * 4 + j) * 5640 + 3584;
      wg0[i * 4 + j] = *(const float4*)wr; wg1[i * 4 + j] = *(const float4*)(wr + 4);
    }
  float4 gm[4];
#pragma unroll
  for (int i = 0; i < 4; ++i) gm[i] = *(const float4*)(P.g_mix + i * 256 + lane * 4);
  for (int r = blockIdx.x * 4 + w; r < MT; r += gridDim.x * 4) {
    const float* xr = xrow(P, r);
    float4 v[4];
    float ss = 0.f;
#pragma unroll
    for (int i = 0; i < 4; ++i) {
      v[i] = *(const float4*)(xr + i * 256 + lane * 4);
      ss += v[i].x * v[i].x + v[i].y * v[i].y + v[i].z * v[i].z + v[i].w * v[i].w;
    }
    ss = wave_sum(ss);
    float rstd = rsqrtf(ss * (1.f / 1024.f) + EPS);
    float ga[8];
#pragma unroll
    for (int j = 0; j < 8; ++j) ga[j] = 0.f;
#pragma unroll
    for (int i = 0; i < 4; ++i) {
      float hv[4] = {v[i].x * rstd * gm[i].x, v[i].y * rstd * gm[i].y, v[i].z * rstd * gm[i].z, v[i].w * rstd * gm[i].w};
      uint2 o; o.x = pack2(hv[0], hv[1]); o.y = pack2(hv[2], hv[3]);
      *(uint2*)(hbuf + (size_t)r * 1024 + i * 256 + lane * 4) = o;
#pragma unroll
      for (int j = 0; j < 4; ++j) {
        const float4 w0 = wg0[i * 4 + j], w1 = wg1[i * 4 + j];
        ga[0] += hv[j] * w0.x; ga[1] += hv[j] * w0.y; ga[2] += hv[j] * w0.z; ga[3] += hv[j] * w0.w;
        ga[4] += hv[j] * w1.x; ga[5] += hv[j] * w1.y; ga[6] += hv[j] * w1.z; ga[7] += hv[j] * w1.w;
      }
    }
    float si = reduce4(ga[0], ga[1], ga[2], ga[3]);
    float sf = reduce4(ga[4], ga[5], ga[6], ga[7]);
    if ((lane & 15) == 0) {
      int k = lane >> 4;
      gpre[(size_t)r * 8 + k] = si + P.b_i[k];
      gpre[(size_t)r * 8 + 4 + k] = sf + P.b_f[k];
    }
  }
}
__device__ void gate_scan(const Params& P) {
  const int lane = threadIdx.x & 63, w = threadIdx.x >> 6;
  const float* gpre = (const float*)(P.ws + O_GPRE);
  for (int item = blockIdx.x * 4 + w; item < 528 * 4; item += gridDim.x * 4) {
    int tile = item >> 2, h = item & 3;
    int row0, L;
    if (tile < 512) { row0 = tile * 64; L = 64; } else { row0 = MP + (tile - 512) * 32; L = 32; }
    const int s = lane;
    bool valid = s < L;
    float ig = valid ? gpre[(size_t)(row0 + s) * 8 + h] : -INFINITY;
    float fg = valid ? gpre[(size_t)(row0 + s) * 8 + 4 + h] : 0.f;
    float lf = valid ? (fminf(fg, 0.f) - log1pf(__expf(-fabsf(fg)))) : 0.f;
    float F = lf;
#pragma unroll
    for (int o = 1; o < 64; o <<= 1) { float t = __shfl_up(F, o); if (lane >= o) F += t; }
    float u = valid ? ig - F : -INFINITY;
    float cm = u;
#pragma unroll
    for (int o = 1; o < 64; o <<= 1) { float t = __shfl_up(cm, o); if (lane >= o) cm = fmaxf(cm, t); }
    if (valid) {
      size_t gi = (size_t)(row0 + s) * 4 + h;
      ((float*)(P.ws + O_FQ))[gi] = F;
      ((float*)(P.ws + O_UQ))[gi] = u;
      ((float*)(P.ws + O_CMQ))[gi] = cm;
      if (s == L - 1) {
        ((float*)(P.ws + O_FL))[tile * 4 + h] = F;
        ((float*)(P.ws + O_UC))[tile * 4 + h] = cm;
      }
    }
  }
}

__device__ void phase_prep(const Params& P, char* smem) {
  const int gtid = blockIdx.x * NTHREADS + threadIdx.x, gstride = gridDim.x * NTHREADS;
  prep_rows(P);
  transpose_w_lds(P.w_in, 1024, 5632, 5640, (bfu*)(P.ws + O_WT_IN), 1, (float*)smem, 0);
  transpose_w_lds(P.w_up_r, 512, 1024, 1024, (bfu*)(P.ws + O_WT_UPR), 0, (float*)smem, 1408);
  transpose_w_lds(P.w_up_m, 512, 1024, 1024, (bfu*)(P.ws + O_WT_UPM), 0, (float*)smem, 1536);
  transpose_w_lds(P.w_out, 1024, 1024, 1024, (bfu*)(P.ws + O_WT_OUT), 0, (float*)smem, 1664);
  transpose_w_lds(P.w_pq, 1024, 2048, 2048, (bfu*)(P.ws + O_WT_PQ), 0, (float*)smem, 1920);
  transpose_w_lds(P.w_pg, 1024, 1024, 1024, (bfu*)(P.ws + O_WT_PG), 0, (float*)smem, 2432);
  transpose_w_lds(P.w_ple, 256, 1024, 1024, (bfu*)(P.ws + O_WT_PLE), 0, (float*)smem, 2688);
  for (int h = 0; h < 4; ++h) {
    transpose_w_lds(P.w_mq + h * 16384, 128, 128, 128, (bfu*)(P.ws + O_WT_MQ) + h * 16384, 0, (float*)smem, 2752 + h * 8);
    transpose_w_lds(P.w_mk + h * 16384, 128, 128, 128, (bfu*)(P.ws + O_WT_MK) + h * 16384, 0, (float*)smem, 2756 + h * 8);
  }
  convert_bf(P.peer_keys, (bfu*)(P.ws + O_KEYS), 16 * 128 * 128 / 8, gtid, gstride);
  float* ct = (float*)(P.ws + O_COS); float* st = (float*)(P.ws + O_SIN);
  for (int i = gtid; i < 8192 * 64; i += gstride) {
    int pos = i >> 6, j = i & 63;
    float inv = exp2f(-(float)j * (13.287712379549449f / 64.f));
    float angf = (float)pos * inv;
    double a = (double)angf;
    double k = rint(a * 0.15915494309189535);
    float r = (float)(a - k * 6.283185307179586);
    ct[i] = __cosf(r); st[i] = __sinf(r);
  }
}

__device__ __forceinline__ void gemm_acc256(f32x16 (&acc)[4][2], const bfu* __restrict__ A, int lda,
                                            const bfu* __restrict__ Bt, int ldb, int K, char* sbase) {
  const int tid = threadIdx.x, lane = tid & 63, w = tid >> 6, wm = w & 1, wn = w >> 1;
  const int kc = ((tid & 3) ^ ((tid >> 4) & 3)) * 8;
  const bfu* Ap = A + (size_t)(tid >> 2) * lda + kc;
  const bfu* Bp = Bt + (size_t)(tid >> 2) * ldb + kc;
  const size_t a64 = (size_t)64 * lda, b64 = (size_t)64 * ldb;
  char* ldst = sbase + tid * 16;
#define GISSUE256(stage, k)                                                                                      \
  {                                                                                                              \
    char* d_ = ldst + (stage) * 24576;                                                                           \
    __builtin_amdgcn_global_load_lds((const unsigned*)(Ap + (k)), (LAS unsigned*)(d_), 16, 0, 0);                \
    __builtin_amdgcn_global_load_lds((const unsigned*)(Ap + a64 + (k)), (LAS unsigned*)(d_ + 4096), 16, 0, 0);   \
    __builtin_amdgcn_global_load_lds((const unsigned*)(Ap + 2 * a64 + (k)), (LAS unsigned*)(d_ + 8192), 16, 0, 0);  \
    __builtin_amdgcn_global_load_lds((const unsigned*)(Ap + 3 * a64 + (k)), (LAS unsigned*)(d_ + 12288), 16, 0, 0); \
    __builtin_amdgcn_global_load_lds((const unsigned*)(Bp + (k)), (LAS unsigned*)(d_ + 16384), 16, 0, 0);        \
    __builtin_amdgcn_global_load_lds((const unsigned*)(Bp + b64 + (k)), (LAS unsigned*)(d_ + 20480), 16, 0, 0);  \
  }
  const int sw = (lane >> 2) & 3, hh = lane >> 5;
  const int rowA = (wm * 64 + (lane & 31)) * 64, rowB = (wn * 32 + (lane & 31)) * 64;
  const int nk = K >> 5;
  __syncthreads();
  asm volatile("s_waitcnt vmcnt(0)" ::: "memory");
  GISSUE256(0, 0)
  if (nk > 1) GISSUE256(1, 32)
  int st = 0;
  for (int kt = 0; kt < nk; ++kt) {
    if (kt + 1 < nk) asm volatile("s_waitcnt vmcnt(6)" ::: "memory");
    else asm volatile("s_waitcnt vmcnt(0)" ::: "memory");
    asm volatile("s_waitcnt lgkmcnt(0)" ::: "memory");
    __builtin_amdgcn_s_barrier();
    asm volatile("" ::: "memory");
    if (kt + 2 < nk) { const int s2 = st >= 1 ? st - 1 : 2; GISSUE256(s2, (kt + 2) * 32) }
    const char* cA = sbase + st * 24576;
    const char* cB = cA + 16384;
    __builtin_amdgcn_s_setprio(1);
#pragma unroll
    for (int ks = 0; ks < 2; ++ks) {
      const int pos = ((2 * ks + hh) ^ sw) * 16;
      bf16x8 af[4], bfr[2];
#pragma unroll
      for (int mi = 0; mi < 4; ++mi) af[mi] = *(const bf16x8*)(cA + rowA + ((mi >> 1) * 128 + (mi & 1) * 32) * 64 + pos);
#pragma unroll
      for (int ni = 0; ni < 2; ++ni) bfr[ni] = *(const bf16x8*)(cB + rowB + ni * 64 * 64 + pos);
#pragma unroll
      for (int mi = 0; mi < 4; ++mi)
#pragma unroll
        for (int ni = 0; ni < 2; ++ni)
          acc[mi][ni] = __builtin_amdgcn_mfma_f32_32x32x16_bf16(af[mi], bfr[ni], acc[mi][ni], 0, 0, 0);
    }
    __builtin_amdgcn_s_setprio(0);
    st = st == 2 ? 0 : st + 1;
  }
}

__device__ __forceinline__ void gemm1_epilogue(const Params& P, char* smem, f32x16 (&acc)[2][2], const int rbase, const int nt,
                                               const float* ct, const float* stb) {
    const bool prompt = rbase < MP;
  int region = nt >> 2, hh = nt & 3;
  bfu* sT = (bfu*)smem;
  __syncthreads();
  if (region <= 1) {
    float sc = region == 1 ? 0.08838834764831845f : 1.f;
    EPI_BEGIN
#pragma unroll
      for (int j = 0; j < 4; ++j) {
        int rr = rbase + r0 + j;
        int pos = prompt ? (rr & 8191) : 2048 + ((rr - MP) & 31);
        float c = ct[pos * 64 + cl], sn = stb[pos * 64 + cl];
        float a = acc[mi][0][q * 4 + j], b = acc[mi][1][q * 4 + j];
        sT[(r0 + j) * ST_LD + cl] = f2bf((a * c - b * sn) * sc);
        sT[(r0 + j) * ST_LD + cl + 64] = f2bf((a * sn + b * c) * sc);
      }
    EPI_END
    __syncthreads();
    copyout_bf16_nt(sT, (bfu*)(P.ws + SLOT(2 + region)) + (size_t)rbase * 512 + hh * 128, 512);
  } else if (region == 2 || region == 5) {
    EPI_BEGIN
      uint2 va, vb;
      va.x = pack2(acc[mi][0][q * 4 + 0], acc[mi][0][q * 4 + 1]); va.y = pack2(acc[mi][0][q * 4 + 2], acc[mi][0][q * 4 + 3]);
      vb.x = pack2(acc[mi][1][q * 4 + 0], acc[mi][1][q * 4 + 1]); vb.y = pack2(acc[mi][1][q * 4 + 2], acc[mi][1][q * 4 + 3]);
      *(uint2*)(sT + cl * ST_LD + r0) = va;
      *(uint2*)(sT + (cl + 64) * ST_LD + r0) = vb;
    EPI_END
    __syncthreads();
    bfu* dst = (bfu*)(P.ws + SLOT(region == 2 ? 4 : 7));
#pragma unroll
    for (int i = 0; i < 8; ++i) {
      int id = threadIdx.x + i * 256, e = id >> 4, c8 = (id & 15) * 8;
      size_t o;
      if (prompt) { int bb = rbase >> 13, tt = (rbase & 8191) + c8; o = ((size_t)((bb * 4 + hh) * 128 + e)) * 8192 + tt; }
      else { int rs = rbase - MP + c8, bb = rs >> 5, tt = rs & 31; o = SB_T + ((size_t)((bb * 4 + hh) * 128 + e)) * 32 + tt; }
      nt_store_u4(dst + o, *(const uint4*)(sT + e * ST_LD + c8));
    }
  } else if (region == 3 || region == 4 || region == 6) {
    stage_rm(sT, acc, 1.f);
    __syncthreads();
    copyout_bf16_nt(sT, (bfu*)(P.ws + SLOT(region == 3 ? 5 : (region == 4 ? 6 : 8))) + (size_t)rbase * 512 + hh * 128, 512);
  } else {
    int gi = nt - 28;
    stage_rm(sT, acc, 1.f);
    __syncthreads();
    copyout_bf16_nt(sT, (bfu*)(P.ws + SLOT(gi < 8 ? 9 : 11)) + (size_t)rbase * 1024 + (gi & 7) * 128, 1024);
  }

}

__device__ void phase_gemm1(const Params& P, char* smem) {
  const bfu* hbuf = (const bfu*)(P.ws + SLOT(0));
  const bfu* wt = (const bfu*)(P.ws + O_WT_IN);
  const float* ct = (const float*)(P.ws + O_COS); const float* stb = (const float*)(P.ws + O_SIN);
  for (int t = blockIdx.x; t < 130 * 44; t += gridDim.x) {
    int mt, nt; tile_map(t, 130, 44, mt, nt);
    f32x16 acc[4][2];
#pragma unroll
    for (int a = 0; a < 4; ++a)
#pragma unroll
      for (int b = 0; b < 2; ++b)
#pragma unroll
        for (int i = 0; i < 16; ++i) acc[a][b][i] = 0.f;
    gemm_acc256(acc, hbuf + (size_t)mt * 256 * 1024, 1024, wt + (size_t)nt * 128 * 1024, 1024, 1024, smem);
    gemm1_epilogue(P, smem, reinterpret_cast<f32x16(&)[2][2]>(acc[0]), mt * 256, nt, ct, stb);
    gemm1_epilogue(P, smem, reinterpret_cast<f32x16(&)[2][2]>(acc[2]), mt * 256 + 128, nt, ct, stb);
  }
}

__device__ void phase_conv(const Params& P) {
  const int gtid = blockIdx.x * NTHREADS + threadIdx.x, gstride = gridDim.x * NTHREADS;
  const bfu* xm = (const bfu*)(P.ws + SLOT(6));
  bfu* cb = (bfu*)(P.ws + SLOT(0));
  for (int i = gtid; i < MT * 64; i += gstride) {
    int r = i >> 6, c0 = (i & 63) * 8;
    int t, T, bb; bool prompt = r < MP;
    if (prompt) { bb = r >> 13; t = r & 8191; T = 8192; } else { int rs = r - MP; bb = rs >> 5; t = rs & 31; T = 32; }
    float y[8];
#pragma unroll
    for (int j = 0; j < 8; ++j) y[j] = P.conv_b[c0 + j];
#pragma unroll
    for (int k = 0; k < 4; ++k) {
      int tt = t - 3 + k;
      float xv[8];
      if (tt >= 0) {
        uint4 v = *(const uint4*)(xm + (size_t)(r - 3 + k) * 512 + c0);
        xv[0] = bf2f(v.x & 0xffff); xv[1] = bf2f(v.x >> 16); xv[2] = bf2f(v.y & 0xffff); xv[3] = bf2f(v.y >> 16);
        xv[4] = bf2f(v.z & 0xffff); xv[5] = bf2f(v.z >> 16); xv[6] = bf2f(v.w & 0xffff); xv[7] = bf2f(v.w >> 16);
      } else if (!prompt) {
        const float* sp = P.st_conv + (size_t)(bb * 3 + (tt + 3)) * 512 + c0;
#pragma unroll
        for (int j = 0; j < 8; ++j) xv[j] = sp[j];
      } else {
#pragma unroll
        for (int j = 0; j < 8; ++j) xv[j] = 0.f;
      }
#pragma unroll
      for (int j = 0; j < 8; ++j) y[j] += xv[j] * P.conv_w[k * 512 + c0 + j];
    }
    if (t >= T - 3) {
      uint4 v = *(const uint4*)(xm + (size_t)r * 512 + c0);
      float* dst = (prompt ? P.out + OO_CONVP : P.out + OO_CONVS) + (size_t)(bb * 3 + (t - (T - 3))) * 512 + c0;
      dst[0] = bf2f(v.x & 0xffff); dst[1] = bf2f(v.x >> 16); dst[2] = bf2f(v.y & 0xffff); dst[3] = bf2f(v.y >> 16);
      dst[4] = bf2f(v.z & 0xffff); dst[5] = bf2f(v.z >> 16); dst[6] = bf2f(v.w & 0xffff); dst[7] = bf2f(v.w >> 16);
    }
    uint4 o;
#pragma unroll
    for (int j = 0; j < 8; ++j) y[j] = y[j] * sigmoidf_(y[j]);
    o.x = pack2(y[0], y[1]); o.y = pack2(y[2], y[3]); o.z = pack2(y[4], y[5]); o.w = pack2(y[6], y[7]);
    *(uint4*)(cb + (size_t)r * 512 + c0) = o;
  }
}

__device__ void m_fold(const Params& P) {
  const int lane = threadIdx.x & 63, w = threadIdx.x >> 6;
  const float* FL = (const float*)(P.ws + O_FL); const float* UC = (const float*)(P.ws + O_UC);
  float* MCS = (float*)(P.ws + O_MCS);
  const int slot = (int)gridDim.x - 1 - (int)blockIdx.x;
  if (w == 3 && slot < 16) {
    const int bh = slot, b = bh >> 2, h = bh & 3;
    const int c0 = 2 * lane;
    const float fl0 = FL[(b * 128 + c0) * 4 + h], uc0 = UC[(b * 128 + c0) * 4 + h];
    const float fl1 = FL[(b * 128 + c0 + 1) * 4 + h], uc1 = UC[(b * 128 + c0 + 1) * 4 + h];
    float a = fl0 + fl1, bb = fmaxf(fl0 + uc0 + fl1, fl1 + uc1);
#pragma unroll
    for (int o = 1; o < 64; o <<= 1) {
      float ap = __shfl_up(a, o), bp = __shfl_up(bb, o);
      if (lane >= o) { bb = fmaxf(bp + a, bb); a = ap + a; }
    }
    float ae = __shfl_up(a, 1), be = __shfl_up(bb, 1);
    float m0 = lane == 0 ? 0.f : fmaxf(ae, be);
    float m1 = fl0 + fmaxf(m0, uc0);
    MCS[bh * 128 + c0] = m0;
    MCS[bh * 128 + c0 + 1] = m1;
  }
  const int gtid = blockIdx.x * NTHREADS + threadIdx.x;
  if (gtid < 64) MCS[2048 + gtid] = P.st_m[gtid];
}
__device__ void phase_mqk(const Params& P, char* smem) {
  bfu* sA = (bfu*)smem; bfu* sB = sA + 128 * 72;
  const bfu* cb = (const bfu*)(P.ws + SLOT(0));
  for (int t = blockIdx.x; t < 260 * 8; t += gridDim.x) {
    int mt = t >> 3, which = (t >> 2) & 1, hh = t & 3;
    const bfu* wt = (const bfu*)(P.ws + (which ? O_WT_MK : O_WT_MQ)) + hh * 16384;
    f32x16 acc[2][2]; zero_acc(acc);
    gemm_acc(acc, cb + (size_t)mt * 128 * 512 + hh * 128, 512, wt, 128, 128, sA, sB);
    bfu* dst = (bfu*)(P.ws + SLOT(which ? 13 : 1));
    float sc = which ? 0.08838834764831845f : 1.f;
    bfu* sT = (bfu*)smem;
    __syncthreads();
    stage_rm(sT, acc, sc);
    __syncthreads();
    copyout_bf16(sT, dst + (size_t)mt * 128 * 512 + hh * 128, 512);
  }
}

struct Item { int b, h, c, row0, L, T, chunk, bh; bool prompt; size_t vt_off; };
__device__ __forceinline__ Item decode_item(int idx) {
  Item it;
  if (idx < 2048) {
    it.prompt = true; it.b = idx >> 9; it.h = (idx >> 7) & 3; it.c = idx & 127; it.row0 = it.b * 8192 + it.c * 64;
    it.L = 64; it.T = 8192; it.chunk = it.b * 128 + it.c; it.bh = it.b * 4 + it.h;
    it.vt_off = ((size_t)(it.bh * 128)) * 8192 + it.c * 64;
  } else {
    int si = idx - 2048; it.prompt = false; it.b = si >> 2; it.h = si & 3; it.c = 0; it.row0 = MP + it.b * 32;
    it.L = 32; it.T = 32; it.chunk = 512 + it.b; it.bh = it.b * 4 + it.h;
    it.vt_off = SB_T + ((size_t)(it.bh * 128)) * 32;
  }
  return it;
}
__device__ __forceinline__ bfu* ds_ptr(const Params& P, int mixer, int idx) {
  if (idx < 2048) return (bfu*)P.out + ((size_t)(mixer * 2048 + idx)) * 16384;
  return (bfu*)(P.ws + O_DSS) + ((size_t)(mixer * 64 + (idx - 2048))) * 16384;
}
__device__ __forceinline__ float ret_lg(int h) { return log1pf(-exp2f(-5.f - (float)h)); }

__device__ void phaseA_item(const Params& P, int mixer, int idx, char* smem) {
  const int tid = threadIdx.x, lane = tid & 63, w = tid >> 6, wm = w & 1, wn = w >> 1;
  Item it = decode_item(idx);
  bfu* sK = (bfu*)smem; bfu* sV = sK + 128 * 72;
  float* sw = (float*)(sV + 128 * 72);
  float* sm = sw + 64;
  const int L = it.L, h = it.h;
  const bfu* Ksrc = (const bfu*)(P.ws + SLOT(mixer == 0 ? 3 : 13)) + (size_t)it.row0 * 512 + h * 128;
  const bfu* Vsrc = (const bfu*)(P.ws + SLOT(mixer == 0 ? 4 : 7)) + it.vt_off;
  uint4 kreg[4], vreg[4];
#pragma unroll
  for (int i = 0; i < 4; ++i) {
    int id = tid + i * 256, s = id & 63, dc = (id >> 6) * 8;
    kreg[i] = make_uint4(0, 0, 0, 0);
    if (s < L) kreg[i] = *(const uint4*)(Ksrc + (size_t)s * 512 + dc);
    int e = id >> 3, sc = (id & 7) * 8;
    vreg[i] = make_uint4(0, 0, 0, 0);
    if (sc < L) vreg[i] = *(const uint4*)(Vsrc + (size_t)e * it.T + sc);
  }
  if (mixer == 0) {
    if (tid < 64) { float lg = ret_lg(h); sw[tid] = tid < L ? __expf(lg * (float)(L - 1 - tid)) : 0.f; }
  } else {
    const float* FL = (const float*)(P.ws + O_FL); const float* UC = (const float*)(P.ws + O_UC);
    float mc = ((const float*)(P.ws + O_MCS))[idx];
    float Ml = fmaxf(mc, UC[it.chunk * 4 + h]);
    if (tid < 64) sw[tid] = tid < L ? __expf(((const float*)(P.ws + O_UQ))[(size_t)(it.row0 + tid) * 4 + h] - Ml) : 0.f;
    if (tid == 0) {
      ((float*)(P.ws + O_AEND))[idx] = __expf(mc - Ml);
      if (!it.prompt) P.out[OO_MS + it.bh] = FL[it.chunk * 4 + h] + Ml;
      else if (it.c == 127) P.out[OO_MP + it.bh] = FL[it.chunk * 4 + h] + Ml;
    }
  }
  __syncthreads();
#pragma unroll
  for (int i = 0; i < 4; ++i) {
    int id = tid + i * 256, s = id & 63, dc = (id >> 6) * 8;
    uint4 v = kreg[i];
    float ww = sw[s];
    unsigned vv[4] = {v.x, v.y, v.z, v.w};
#pragma unroll
    for (int j = 0; j < 4; ++j) {
      sK[(dc + 2 * j) * 72 + s] = f2bf(bf2f(vv[j] & 0xffff) * ww);
      sK[(dc + 2 * j + 1) * 72 + s] = f2bf(bf2f(vv[j] >> 16) * ww);
    }
  }
#pragma unroll
  for (int i = 0; i < 4; ++i) {
    int id = tid + i * 256, e = id >> 3, sc = (id & 7) * 8;
    *(uint4*)(sV + e * 72 + sc) = vreg[i];
  }
  __syncthreads();
  f32x16 acc[2][2]; zero_acc(acc);
#pragma unroll
  for (int ks = 0; ks < 4; ++ks) {
    bf16x8 af[2], bfr[2];
#pragma unroll
    for (int mi = 0; mi < 2; ++mi)
      af[mi] = *(const bf16x8*)(sK + (wm * 64 + mi * 32 + (lane & 31)) * 72 + ks * 16 + (lane >> 5) * 8);
#pragma unroll
    for (int ni = 0; ni < 2; ++ni)
      bfr[ni] = *(const bf16x8*)(sV + (wn * 32 + ni * 64 + (lane & 31)) * 72 + ks * 16 + (lane >> 5) * 8);
#pragma unroll
    for (int mi = 0; mi < 2; ++mi)
#pragma unroll
      for (int ni = 0; ni < 2; ++ni)
        acc[mi][ni] = __builtin_amdgcn_mfma_f32_32x32x16_bf16(af[mi], bfr[ni], acc[mi][ni], 0, 0, 0);
  }
  bfu* dS = ds_ptr(P, mixer, idx);
  bfu* sD = (bfu*)(smem + 40960);
  {
    EPI_BEGIN
#pragma unroll
      for (int ni = 0; ni < 2; ++ni) {
        int e = cl + ni * 64;
        uint2 o; o.x = pack2(acc[mi][ni][q * 4 + 0], acc[mi][ni][q * 4 + 1]); o.y = pack2(acc[mi][ni][q * 4 + 2], acc[mi][ni][q * 4 + 3]);
        *(uint2*)(sD + e * 136 + r0) = o;
      }
    EPI_END
  }
  __syncthreads();
#pragma unroll
  for (int i = 0; i < 8; ++i) {
    int id = tid + i * 256, e = id >> 4, c8 = (id & 15) * 8;
    *(uint4*)(dS + e * 128 + c8) = *(const uint4*)(sD + e * 136 + c8);
  }
  if (mixer == 1 && tid < 128) {
    float s = 0.f;
#pragma unroll
    for (int j = 0; j < 8; ++j) { float f[8]; unpack8(*(const uint4*)(sK + tid * 72 + j * 8), f);
#pragma unroll
      for (int k = 0; k < 8; ++k) s += f[k]; }
    ((float*)(P.ws + O_DN))[(size_t)idx * 128 + tid] = s;
  }
  __syncthreads();
}

__device__ void phase_scan(const Params& P) {
  const int gtid = blockIdx.x * NTHREADS + threadIdx.x, gstride = gridDim.x * NTHREADS;
  const float* AE = (const float*)(P.ws + O_AEND);
  for (int i = gtid; i < 131072; i += gstride) {
    int mixer = i >> 16, bh = (i >> 12) & 15, eo = (i & 4095) * 4;
    int h = bh & 3;
    float gch = __expf(ret_lg(h) * 64.f);
    float st[4];
#pragma unroll
    for (int j = 0; j < 4; ++j) st[j] = 0.f;
    bfu* base = (bfu*)P.out + ((size_t)(mixer * 2048 + bh * 128)) * 16384 + eo;
    for (int c = 0; c < 128; c += 8) {
      uint2 v[8];
#pragma unroll
      for (int k = 0; k < 8; ++k) v[k] = *(const uint2*)(base + (size_t)(c + k) * 16384);
#pragma unroll
      for (int k = 0; k < 8; ++k) {
        float dec = mixer == 0 ? gch : AE[bh * 128 + c + k];
        float d0 = bf2f(v[k].x & 0xffff), d1 = bf2f(v[k].x >> 16), d2 = bf2f(v[k].y & 0xffff), d3 = bf2f(v[k].y >> 16);
        uint2 o; o.x = pack2(st[0], st[1]); o.y = pack2(st[2], st[3]);
        *(uint2*)(base + (size_t)(c + k) * 16384) = o;
        st[0] = dec * st[0] + d0; st[1] = dec * st[1] + d1; st[2] = dec * st[2] + d2; st[3] = dec * st[3] + d3;
      }
    }
    float* o = P.out + (mixer == 0 ? OO_RETP : OO_CP) + (size_t)bh * 16384;
    int e = eo >> 7, d0i = eo & 127;
#pragma unroll
    for (int j = 0; j < 4; ++j) o[(d0i + j) * 128 + e] = st[j];
  }
  for (int i = gtid; i < 2 * 64 * 2048; i += gstride) {
    int mixer = i >> 17, bh = (i >> 11) & 63, eo = (i & 2047) * 8;
    int h = bh & 3;
    int e = eo >> 7, d0 = eo & 127;
    const float* s0 = (mixer == 0 ? P.st_ret : P.st_C) + (size_t)bh * 16384;
    float st[8];
#pragma unroll
    for (int j = 0; j < 8; ++j) st[j] = s0[(d0 + j) * 128 + e];
    bfu* p = (bfu*)(P.ws + O_DSS) + ((size_t)(mixer * 64 + bh)) * 16384 + eo;
    float d[8]; unpack8(*(const uint4*)p, d);
    *(uint4*)p = pack8(st);
    float dec = mixer == 0 ? __expf(ret_lg(h) * 32.f) : AE[2048 + bh];
    float* o = P.out + (mixer == 0 ? OO_RETS : OO_CS) + (size_t)bh * 16384;
#pragma unroll
    for (int j = 0; j < 8; ++j) o[(d0 + j) * 128 + e] = dec * st[j] + d[j];
  }
  float* DN = (float*)(P.ws + O_DN);
  for (int i = gtid; i < 16 * 128; i += gstride) {
    int bh = i >> 7, d = i & 127;
    float n = 0.f;
    for (int c0 = 0; c0 < 128; c0 += 16) {
      float v[16], ae[16];
#pragma unroll
      for (int k = 0; k < 16; ++k) { v[k] = DN[(size_t)(bh * 128 + c0 + k) * 128 + d]; ae[k] = AE[bh * 128 + c0 + k]; }
#pragma unroll
      for (int k = 0; k < 16; ++k) { DN[(size_t)(bh * 128 + c0 + k) * 128 + d] = n; n = ae[k] * n + v[k]; }
    }
    P.out[OO_NP + i] = n;
  }
  for (int i = gtid; i < 64 * 128; i += gstride) {
    int bh = i >> 7, d = i & 127;
    size_t o = (size_t)(2048 + bh) * 128 + d;
    float n0 = P.st_n[i]; float v = DN[o]; DN[o] = n0;
    P.out[OO_NS + i] = AE[2048 + bh] * n0 + v;
  }
}

__device__ void phaseC_item(const Params& P, int mixer, int idx, char* smem) {
  const int tid = threadIdx.x, lane = tid & 63, w = tid >> 6;
  Item it = decode_item(idx);
  const int L = it.L, h = it.h;
  bfu* sQ = (bfu*)smem;
  bfu* sKV = sQ + 64 * 136;
  bfu* sP = sKV + 128 * 72;
  bfu* sS = sP + 64 * 72;
  float* sO = (float*)sS;
  float* sRow = (float*)(sS + 128 * 136);
  const bfu* Qsrc = (const bfu*)(P.ws + SLOT(mixer == 0 ? 2 : 1)) + (size_t)it.row0 * 512 + h * 128;
  const bfu* Ksrc = (const bfu*)(P.ws + SLOT(mixer == 0 ? 3 : 13)) + (size_t)it.row0 * 512 + h * 128;
  const bfu* Vsrc = (const bfu*)(P.ws + SLOT(mixer == 0 ? 4 : 7)) + it.vt_off;
  const bfu* Ssrc = ds_ptr(P, mixer, idx);
  const float lg = ret_lg(h);
  uint4 vpre[4];
#pragma unroll
  for (int i = 0; i < 4; ++i) {
    int id = tid + i * 256, e = id >> 3, sc = (id & 7) * 8;
    vpre[i] = make_uint4(0, 0, 0, 0);
    if (sc < L) vpre[i] = *(const uint4*)(Vsrc + (size_t)e * it.T + sc);
  }
#pragma unroll
  for (int i = 0; i < 4; ++i) {
    int id = tid + i * 256, s = id >> 4, dc = (id & 15) * 8;
    uint4 vq = make_uint4(0, 0, 0, 0), vk = vq;
    if (s < L) { vq = *(const uint4*)(Qsrc + (size_t)s * 512 + dc); vk = *(const uint4*)(Ksrc + (size_t)s * 512 + dc); }
    *(uint4*)(sQ + s * 136 + dc) = vq;
    *(uint4*)(sKV + s * 136 + dc) = vk;
  }
#pragma unroll
  for (int i = 0; i < 8; ++i) {
    int id = tid + i * 256, e = id >> 4, dc = (id & 15) * 8;
    *(uint4*)(sS + e * 136 + dc) = *(const uint4*)(Ssrc + e * 128 + dc);
  }
  if (tid < 64) {
    int i = tid;
    if (mixer == 0) {
      sRow[128 + i] = __expf(lg * (float)(i + 1));
    } else {
      float mc = ((const float*)(P.ws + O_MCS))[idx];
      size_t gi = (size_t)(it.row0 + i) * 4 + h;
      bool valid = i < L;
      float u = valid ? ((const float*)(P.ws + O_UQ))[gi] : -INFINITY;
      float M = valid ? fmaxf(mc, ((const float*)(P.ws + O_CMQ))[gi]) : 0.f;
      float F = valid ? ((const float*)(P.ws + O_FQ))[gi] : 0.f;
      sRow[i] = u; sRow[64 + i] = M; sRow[128 + i] = valid ? __expf(mc - M) : 0.f;
      sRow[256 + i] = __expf(-(F + M));
    }
  }
  __syncthreads();
  {
    const int mi = w & 1, ni = w >> 1;
    f32x16 acc;
#pragma unroll
    for (int i = 0; i < 16; ++i) acc[i] = 0.f;
#pragma unroll 2
    for (int ks = 0; ks < 8; ++ks) {
      bf16x8 af = *(const bf16x8*)(sQ + (mi * 32 + (lane & 31)) * 136 + ks * 16 + (lane >> 5) * 8);
      bf16x8 bfr = *(const bf16x8*)(sKV + (ni * 32 + (lane & 31)) * 136 + ks * 16 + (lane >> 5) * 8);
      acc = __builtin_amdgcn_mfma_f32_32x32x16_bf16(af, bfr, acc, 0, 0, 0);
    }
    const int s = ni * 32 + (lane & 31);
    float us = mixer ? sRow[s] : 0.f;
#pragma unroll
    for (int reg = 0; reg < 16; ++reg) {
      int i = mi * 32 + (reg & 3) + 8 * (reg >> 2) + 4 * (lane >> 5);
      float wgt;
      if (mixer == 0) wgt = (s <= i) ? __expf(lg * (float)(i - s)) : 0.f;
      else wgt = (s <= i && i < L) ? __expf(us - sRow[64 + i]) : 0.f;
      sP[i * 72 + s] = f2bf(acc[reg] * wgt);
    }
  }
  __syncthreads();
#pragma unroll
  for (int i = 0; i < 4; ++i) {
    int id = tid + i * 256, e = id >> 3, sc = (id & 7) * 8;
    *(uint4*)(sKV + e * 72 + sc) = vpre[i];
  }
  __syncthreads();
  f32x16 acc1[2], acc2[2];
  const int mi = w & 1, nj = w >> 1;
#pragma unroll
  for (int t = 0; t < 2; ++t)
#pragma unroll
    for (int i = 0; i < 16; ++i) { acc1[t][i] = 0.f; acc2[t][i] = 0.f; }
#pragma unroll 2
  for (int ks = 0; ks < 4; ++ks) {
    bf16x8 af = *(const bf16x8*)(sP + (mi * 32 + (lane & 31)) * 72 + ks * 16 + (lane >> 5) * 8);
#pragma unroll
    for (int t = 0; t < 2; ++t) {
      bf16x8 bfr = *(const bf16x8*)(sKV + (nj * 64 + t * 32 + (lane & 31)) * 72 + ks * 16 + (lane >> 5) * 8);
      acc1[t] = __builtin_amdgcn_mfma_f32_32x32x16_bf16(af, bfr, acc1[t], 0, 0, 0);
    }
  }
#pragma unroll 2
  for (int ks = 0; ks < 8; ++ks) {
    bf16x8 af = *(const bf16x8*)(sQ + (mi * 32 + (lane & 31)) * 136 + ks * 16 + (lane >> 5) * 8);
#pragma unroll
    for (int t = 0; t < 2; ++t) {
      bf16x8 bfr = *(const bf16x8*)(sS + (nj * 64 + t * 32 + (lane & 31)) * 136 + ks * 16 + (lane >> 5) * 8);
      acc2[t] = __builtin_amdgcn_mfma_f32_32x32x16_bf16(af, bfr, acc2[t], 0, 0, 0);
    }
  }
  if (mixer == 1) {
    int i = tid >> 2, part = tid & 3;
    const float* nprev = (const float*)(P.ws + O_DN) + (size_t)idx * 128;
    float dl = 0.f, qn = 0.f;
#pragma unroll 4
    for (int s = part * 16; s < part * 16 + 16; ++s) dl += bf2f(sP[i * 72 + s]);
#pragma unroll 4
    for (int d = part * 32; d < part * 32 + 32; ++d) qn += bf2f(sQ[i * 136 + d]) * nprev[d];
    dl += __shfl_xor(dl, 1); dl += __shfl_xor(dl, 2);
    qn += __shfl_xor(qn, 1); qn += __shfl_xor(qn, 2);
    if (part == 0) {
      float den = dl + sRow[128 + i] * qn;
      sRow[192 + i] = 1.f / fmaxf(fabsf(den), sRow[256 + i]);
    }
  }
  __syncthreads();
#pragma unroll
  for (int t = 0; t < 2; ++t) {
    int e = nj * 64 + t * 32 + (lane & 31);
#pragma unroll
    for (int reg = 0; reg < 16; ++reg) {
      int i = mi * 32 + (reg & 3) + 8 * (reg >> 2) + 4 * (lane >> 5);
      float o = acc1[t][reg] + sRow[128 + i] * acc2[t][reg];
      if (mixer == 1) o *= sRow[192 + i];
      sO[i * 132 + e] = o;
    }
  }
  __syncthreads();
  {
    int i = tid >> 2, part = tid & 3;
    float ss = 0.f;
#pragma unroll 4
    for (int e = part * 32; e < part * 32 + 32; ++e) { float v = sO[i * 132 + e]; ss += v * v; }
    ss += __shfl_xor(ss, 1); ss += __shfl_xor(ss, 2);
    float rstd = rsqrtf(ss * (1.f / 128.f) + EPS);
    if (i < L) {
      size_t ro = (size_t)(it.row0 + i) * 512 + h * 128 + part * 32;
      const float* so = sO + i * 132 + part * 32;
      if (mixer == 0) {
        bfu* y = (bfu*)(P.ws + SLOT(5)) + ro;
        const float* g = P.g_ret_gn + h * 128 + part * 32;
        uint4 gv[4];
#pragma unroll
        for (int k = 0; k < 4; ++k) gv[k] = *(const uint4*)(y + k * 8);
#pragma unroll
        for (int k = 0; k < 4; ++k) {
          float gt[8], o[8];
          unpack8(gv[k], gt);
#pragma unroll
          for (int j = 0; j < 8; ++j) o[j] = gt[j] * sigmoidf_(gt[j]) * so[k * 8 + j] * rstd * g[k * 8 + j];
          *(uint4*)(y + k * 8) = pack8(o);
        }
      } else {
        bfu* y = (bfu*)(P.ws + SLOT(8)) + ro;
        const bfu* cc = (const bfu*)(P.ws + SLOT(0)) + ro;
        const float* g = P.g_ml_gn + h * 128 + part * 32;
        const float* ws = P.w_skip + h * 128 + part * 32;
        uint4 gv[4], cv[4];
#pragma unroll
        for (int k = 0; k < 4; ++k) { gv[k] = *(const uint4*)(y + k * 8); cv[k] = *(const uint4*)(cc + k * 8); }
#pragma unroll
        for (int k = 0; k < 4; ++k) {
          float gt[8], c8[8], o[8];
          unpack8(gv[k], gt); unpack8(cv[k], c8);
#pragma unroll
          for (int j = 0; j < 8; ++j) o[j] = sigmoidf_(gt[j]) * (so[k * 8 + j] * rstd * g[k * 8 + j] + ws[k * 8 + j] * c8[j]);
          *(uint4*)(y + k * 8) = pack8(o);
        }
      }
    }
  }
  __syncthreads();
}

__device__ void phase_merge(const Params& P, char* smem) {
  bfu* sA = (bfu*)smem; bfu* sB = sA + 128 * 72;
  const bfu* yr = (const bfu*)(P.ws + SLOT(5)); const bfu* ym = (const bfu*)(P.ws + SLOT(8));
  const bfu* gr = (const bfu*)(P.ws + SLOT(9)); const bfu* gm = (const bfu*)(P.ws + SLOT(11));
  bfu* mg = (bfu*)(P.ws + SLOT(6));
  for (int t = blockIdx.x; t < 260 * 8; t += gridDim.x) {
    int mt, nt; tile_map(t, 260, 8, mt, nt);
    f32x16 acc[2][2]; zero_acc(acc);
    bfu* sT = (bfu*)smem;
    const size_t tbase = (size_t)mt * 128 * 1024 + nt * 128;
    uint4 t1[8];
    gemm_acc(acc, yr + (size_t)mt * 128 * 512, 512, (const bfu*)(P.ws + O_WT_UPR) + (size_t)nt * 128 * 512, 512, 512, sA, sB);
    __syncthreads();
    stage_rm(sT, acc, 1.f);
    __syncthreads();
#pragma unroll
    for (int i = 0; i < 8; ++i) {
      int id = threadIdx.x + i * 256, row = id >> 4, c8 = (id & 15) * 8;
      float a[8], g[8];
      unpack8(*(const uint4*)(sT + row * ST_LD + c8), a);
      unpack8(*(const uint4*)(gr + tbase + (size_t)row * 1024 + c8), g);
#pragma unroll
      for (int j = 0; j < 8; ++j) a[j] *= sigmoidf_(g[j]);
      t1[i] = pack8(a);
    }
    zero_acc(acc);
    gemm_acc(acc, ym + (size_t)mt * 128 * 512, 512, (const bfu*)(P.ws + O_WT_UPM) + (size_t)nt * 128 * 512, 512, 512, sA, sB);
    __syncthreads();
    stage_rm(sT, acc, 1.f);
    __syncthreads();
#pragma unroll
    for (int i = 0; i < 8; ++i) {
      int id = threadIdx.x + i * 256, row = id >> 4, c8 = (id & 15) * 8;
      float a[8], g[8], t[8];
      unpack8(*(const uint4*)(sT + row * ST_LD + c8), a);
      unpack8(*(const uint4*)(gm + tbase + (size_t)row * 1024 + c8), g);
      unpack8(t1[i], t);
#pragma unroll
      for (int j = 0; j < 8; ++j) a[j] = t[j] + a[j] * sigmoidf_(g[j]);
      *(uint4*)(mg + tbase + (size_t)row * 1024 + c8) = pack8(a);
    }
  }
}

__device__ void phase_outproj(const Params& P, char* smem) {
  bfu* sA = (bfu*)smem; bfu* sB = sA + 128 * 72;
  const bfu* mg = (const bfu*)(P.ws + SLOT(6));
  for (int t = blockIdx.x; t < 260 * 8; t += gridDim.x) {
    int mt, nt; tile_map(t, 260, 8, mt, nt);
    f32x16 acc[2][2]; zero_acc(acc);
    gemm_acc(acc, mg + (size_t)mt * 128 * 1024, 1024, (const bfu*)(P.ws + O_WT_OUT) + (size_t)nt * 128 * 1024, 1024, 1024, sA, sB);
    float* sT32 = (float*)smem;
    __syncthreads();
    {
      EPI_BEGIN
#pragma unroll
        for (int j = 0; j < 4; ++j) {
          sT32[(r0 + j) * ST32_LD + cl] = acc[mi][0][q * 4 + j];
          sT32[(r0 + j) * ST32_LD + cl + 64] = acc[mi][1][q * 4 + j];
        }
      EPI_END
    }
    __syncthreads();
#pragma unroll
    for (int i = 0; i < 16; ++i) {
      int id = threadIdx.x + i * 256, row = id >> 5, c4 = (id & 31) * 4;
      int r = mt * 128 + row;
      float4 a = *(const float4*)(sT32 + row * ST32_LD + c4);
      float4 x = *(const float4*)(xrow(P, r) + nt * 128 + c4);
      float4 o = make_float4(x.x + a.x, x.y + a.y, x.z + a.z, x.w + a.w);
      *(float4*)(P.out + (size_t)r * 1024 + nt * 128 + c4) = o;
      float4 g = *(const float4*)(P.g_ffn + nt * 128 + c4);
      uint2 hv; hv.x = pack2(o.x * g.x, o.y * g.y); hv.y = pack2(o.z * g.z, o.w * g.w);
      *(uint2*)((bfu*)(P.ws + SLOT(0)) + (size_t)r * 1024 + nt * 128 + c4) = hv;
      float ss = o.x * o.x + o.y * o.y + o.z * o.z + o.w * o.w;
      ss = dpp_ror_add(ss, 8); ss = dpp_ror_add(ss, 4); ss = dpp_ror_add(ss, 2); ss = dpp_ror_add(ss, 1);
      ss += __shfl_xor(ss, 16);
      if ((threadIdx.x & 31) == 0) ((float*)(P.ws + O_GPRE))[(size_t)r * 8 + nt] = ss;
    }
  }
}

__device__ void phase_norm_rows(const Params& P, const float* g, bfu* dst) {
  const int lane = threadIdx.x & 63, w = threadIdx.x >> 6;
  for (int r = blockIdx.x * 4 + w; r < MT; r += gridDim.x * 4) {
    const float* xr = P.out + (size_t)r * 1024;
    float4 v[4]; float ss = 0.f;
#pragma unroll
    for (int i = 0; i < 4; ++i) {
      v[i] = *(const float4*)(xr + i * 256 + lane * 4);
      ss += v[i].x * v[i].x + v[i].y * v[i].y + v[i].z * v[i].z + v[i].w * v[i].w;
    }
    ss = wave_sum(ss);
    float rstd = rsqrtf(ss * (1.f / 1024.f) + EPS);
#pragma unroll
    for (int i = 0; i < 4; ++i) {
      float4 gg = *(const float4*)(g + i * 256 + lane * 4);
      uint2 o; o.x = pack2(v[i].x * rstd * gg.x, v[i].y * rstd * gg.y); o.y = pack2(v[i].z * rstd * gg.z, v[i].w * rstd * gg.w);
      *(uint2*)(dst + (size_t)r * 1024 + i * 256 + lane * 4) = o;
    }
  }
}

__device__ void phase_pq(const Params& P, char* smem) {
  bfu* sA = (bfu*)smem; bfu* sB = sA + 128 * 72;
  const bfu* hq = (const bfu*)(P.ws + SLOT(0));
  bfu* qb = (bfu*)(P.ws + SLOT(9));
  for (int t = blockIdx.x; t < 260 * 16; t += gridDim.x) {
    int mt, nt; tile_map(t, 260, 16, mt, nt);
    f32x16 acc[2][2]; zero_acc(acc);
    float* sRstd = (float*)(smem + 66048);
    if (threadIdx.x < 128) {
      const float* pp = (const float*)(P.ws + O_GPRE) + (size_t)(mt * 128 + threadIdx.x) * 8;
      float4 p0 = *(const float4*)pp, p1 = *(const float4*)(pp + 4);
      sRstd[threadIdx.x] = rsqrtf((p0.x + p0.y + p0.z + p0.w + p1.x + p1.y + p1.z + p1.w) * (1.f / 1024.f) + EPS);
    }
    gemm_acc(acc, hq + (size_t)mt * 128 * 1024, 1024, (const bfu*)(P.ws + O_WT_PQ) + (size_t)nt * 128 * 1024, 1024, 1024, sA, sB);
    bfu* sT = (bfu*)smem;
    __syncthreads();
    {
      EPI_BEGIN
#pragma unroll
        for (int j = 0; j < 4; ++j) {
          const float rs = sRstd[r0 + j];
          sT[(r0 + j) * ST_LD + cl] = f2bf(acc[mi][0][q * 4 + j] * rs);
          sT[(r0 + j) * ST_LD + cl + 64] = f2bf(acc[mi][1][q * 4 + j] * rs);
        }
      EPI_END
    }
    __syncthreads();
    copyout_bf16(sT, qb + (size_t)mt * 128 * 2048 + nt * 128, 2048);
  }
}


template <bool DESC> __device__ __forceinline__ void cex(float& a, float& b) {
  float mx = fmaxf(a, b), mn = fminf(a, b);
  a = DESC ? mx : mn; b = DESC ? mn : mx;
}
template <int B, bool DESC> __device__ __forceinline__ void bmerge16(float (&v)[64]) {
#pragma unroll
  for (int j = 8; j > 0; j >>= 1)
#pragma unroll
    for (int i = 0; i < 16; ++i) { int l = i ^ j; if (l > i) cex<DESC>(v[B + i], v[B + l]); }
}
template <int B, bool DESC> __device__ __forceinline__ void bsort16(float (&v)[64]) {
#pragma unroll
  for (int k = 2; k <= 16; k <<= 1)
#pragma unroll
    for (int j = k >> 1; j > 0; j >>= 1)
#pragma unroll
      for (int i = 0; i < 16; ++i) {
        int l = i ^ j;
        if (l > i) {
          bool up = ((i & k) == 0) || (k == 16);
          if (up == true) { if (DESC) cex<true>(v[B + i], v[B + l]); else cex<false>(v[B + i], v[B + l]); }
          else { if (DESC) cex<false>(v[B + i], v[B + l]); else cex<true>(v[B + i], v[B + l]); }
        }
      }
}
__device__ __forceinline__ float pair_max(float v) {
  auto r = __builtin_amdgcn_permlane32_swap(__float_as_int(v), __float_as_int(v), false, false);
  return fmaxf(__int_as_float(r[0]), __int_as_float(r[1]));
}
__device__ void phase_topk(const Params& P, char* smem) {
  const int tid = threadIdx.x, lane = tid & 63, w = tid >> 6, r32 = lane & 31, hh = lane >> 5;
  unsigned* sL = (unsigned*)smem + w * 1664;
  unsigned* sW = sL + 32 * 33;
  const bfu* qb = (const bfu*)(P.ws + SLOT(9));
  const bfu* keys = (const bfu*)(P.ws + O_KEYS);
  int* ids = (int*)(P.ws + SLOT(4));
  float* gw = (float*)(P.ws + SLOT(13));
  for (int item = blockIdx.x * 4 + w; item < 1040 * 8; item += gridDim.x * 4) {
    const int tg = item >> 3, n = item & 7, rowb = tg * 32;
#pragma unroll 1
    for (int half = 0; half < 2; ++half) {
      f32x16 acc[4];
#pragma unroll
      for (int c = 0; c < 4; ++c)
#pragma unroll
        for (int i = 0; i < 16; ++i) acc[c][i] = 0.f;
      const bfu* kp = keys + (size_t)((n * 2 + half) * 128 + r32) * 128 + hh * 8;
      const bfu* qp = qb + (size_t)(rowb + r32) * 2048 + n * 256 + half * 128 + hh * 8;
#pragma unroll
      for (int ks = 0; ks < 8; ++ks) {
        bf16x8 bfr = *(const bf16x8*)(qp + ks * 16);
#pragma unroll
        for (int c = 0; c < 4; ++c) {
          bf16x8 af = *(const bf16x8*)(kp + (size_t)c * 32 * 128 + ks * 16);
          acc[c] = __builtin_amdgcn_mfma_f32_32x32x16_bf16(af, bfr, acc[c], 0, 0, 0);
        }
      }
      float kk[64];
#pragma unroll
      for (int c = 0; c < 4; ++c)
#pragma unroll
        for (int reg = 0; reg < 16; ++reg) {
          unsigned kidx = c * 32 + (reg & 3) + 8 * (reg >> 2) + 4 * hh;
          kk[c * 16 + reg] = __uint_as_float((__float_as_uint(acc[c][reg]) & ~127u) | kidx);
        }
      bsort16<0, true>(kk); bsort16<16, false>(kk); bsort16<32, false>(kk); bsort16<48, true>(kk);
#pragma unroll
      for (int i = 0; i < 16; ++i) { kk[i] = fmaxf(kk[i], kk[16 + i]); kk[32 + i] = fmaxf(kk[32 + i], kk[48 + i]); }
      bmerge16<0, true>(kk); bmerge16<32, false>(kk);
#pragma unroll
      for (int i = 0; i < 16; ++i) kk[i] = fmaxf(kk[i], kk[32 + i]);
      bmerge16<0, true>(kk);
      {
        float lo[16], hi[16];
#pragma unroll
        for (int i = 0; i < 16; ++i) {
          auto r = __builtin_amdgcn_permlane32_swap(__float_as_int(kk[i]), __float_as_int(kk[i]), false, false);
          lo[i] = __int_as_float(r[0]); hi[i] = __int_as_float(r[1]);
        }
#pragma unroll
        for (int i = 0; i < 16; ++i) kk[i] = fmaxf(lo[i], hi[15 - i]);
      }
      bmerge16<0, true>(kk);
      if (hh == 0) {
#pragma unroll
        for (int p = 0; p < 16; ++p) sL[r32 * 33 + half * 16 + p] = __float_as_uint(kk[p]);
      }
    }
    __builtin_amdgcn_fence(__ATOMIC_RELEASE, "workgroup");
    __builtin_amdgcn_wave_barrier();
    __builtin_amdgcn_fence(__ATOMIC_ACQUIRE, "workgroup");
    float x[4], y[16];
    {
      const unsigned* lx = sL + r32 * 33 + (hh ? 16 : 0);
      const unsigned* ly = sL + r32 * 33 + (hh ? 0 : 16);
#pragma unroll
      for (int i = 0; i < 4; ++i) x[i] = __uint_as_float(lx[i] & ~127u);
#pragma unroll
      for (int j = 0; j < 16; ++j) y[j] = __uint_as_float(ly[j] & ~127u);
    }
    float cd[25];
#define CAND(t, i, j) { float sv = x[i] + y[j]; unsigned code = hh ? ((j) << 4 | (i)) : ((i) << 4 | (j)); \
      cd[t] = __uint_as_float((__float_as_uint(sv) & ~255u) | code); }
    CAND(0, 0, 1) CAND(1, 0, 2) CAND(2, 0, 3) CAND(3, 0, 4) CAND(4, 0, 5) CAND(5, 0, 6) CAND(6, 0, 7) CAND(7, 0, 8)
    CAND(8, 0, 9) CAND(9, 0, 10) CAND(10, 0, 11) CAND(11, 0, 12) CAND(12, 0, 13) CAND(13, 0, 14) CAND(14, 0, 15)
    CAND(15, 1, 2) CAND(16, 1, 3) CAND(17, 1, 4) CAND(18, 1, 5) CAND(19, 1, 6) CAND(20, 1, 7) CAND(21, 2, 3) CAND(22, 2, 4)
    {
      float d0 = hh ? x[2] + y[2] : x[0] + y[0];
      float d1 = hh ? x[3] + y[3] : x[1] + y[1];
      unsigned c0 = hh ? 0x22u : 0x00u, c1 = hh ? 0x33u : 0x11u;
      cd[23] = __uint_as_float((__float_as_uint(d0) & ~255u) | c0);
      cd[24] = __uint_as_float((__float_as_uint(d1) & ~255u) | c1);
    }
    {
      float cv[64];
#pragma unroll
      for (int t = 0; t < 25; ++t) cv[t] = cd[t];
#pragma unroll
      for (int t = 25; t < 32; ++t) cv[t] = -INFINITY;
      bsort16<0, true>(cv); bsort16<16, false>(cv);
#pragma unroll
      for (int i = 0; i < 16; ++i) cv[i] = fmaxf(cv[i], cv[16 + i]);
      bmerge16<0, true>(cv);
      {
        float lo[16], hi[16];
#pragma unroll
        for (int i = 0; i < 16; ++i) {
          auto r = __builtin_amdgcn_permlane32_swap(__float_as_int(cv[i]), __float_as_int(cv[i]), false, false);
          lo[i] = __int_as_float(r[0]); hi[i] = __int_as_float(r[1]);
        }
#pragma unroll
        for (int i = 0; i < 16; ++i) cv[i] = fmaxf(lo[i], hi[15 - i]);
      }
      bmerge16<0, true>(cv);
      if (hh == 0) {
#pragma unroll
        for (int p = 0; p < 16; ++p) sW[r32 * 17 + p] = __float_as_uint(cv[p]);
      }
    }
    __builtin_amdgcn_fence(__ATOMIC_RELEASE, "workgroup");
    __builtin_amdgcn_wave_barrier();
    __builtin_amdgcn_fence(__ATOMIC_ACQUIRE, "workgroup");
    {
      const unsigned* la = sL + r32 * 33;
      unsigned c0 = sW[r32 * 17] & 255u;
      float scmax = __uint_as_float(la[c0 >> 4] & ~127u) + __uint_as_float(la[16 + (c0 & 15)] & ~127u);
      float ex[8]; int ee[8]; float sum = 0.f;
#pragma unroll
      for (int k = 0; k < 8; ++k) {
        unsigned code = sW[r32 * 17 + hh * 8 + k] & 255u;
        unsigned ka = la[code >> 4], kb = la[16 + (code & 15)];
        float sc = __uint_as_float(ka & ~127u) + __uint_as_float(kb & ~127u);
        ex[k] = __expf(sc - scmax);
        ee[k] = (int)((ka & 127u) * 128u + (kb & 127u));
        sum += ex[k];
      }
      sum += __shfl_xor(sum, 32);
      float inv = 1.f / sum;
      size_t o = (size_t)(rowb + r32) * 128 + n * 16 + hh * 8;
      *(int4*)(ids + o) = make_int4(ee[0], ee[1], ee[2], ee[3]);
      *(int4*)(ids + o + 4) = make_int4(ee[4], ee[5], ee[6], ee[7]);
      *(float4*)(gw + o) = make_float4(ex[0] * inv, ex[1] * inv, ex[2] * inv, ex[3] * inv);
      *(float4*)(gw + o + 4) = make_float4(ex[4] * inv, ex[5] * inv, ex[6] * inv, ex[7] * inv);
    }
    __builtin_amdgcn_wave_barrier();
  }
}

typedef float f2v __attribute__((ext_vector_type(2)));
#define U8_SCALE 512.f
#define V8_SCALE 128.f
__device__ void convert_fp8(const float* __restrict__ src, unsigned char* __restrict__ dst, size_t n16, float scale,
                            int gtid, int gstride) {
  for (size_t i = gtid; i < n16; i += gstride) {
    unsigned w[4];
#pragma unroll
    for (int k = 0; k < 4; ++k) {
      float4 a = *(const float4*)(src + i * 16 + k * 4);
      float v0 = fminf(fmaxf(a.x * scale, -448.f), 448.f), v1 = fminf(fmaxf(a.y * scale, -448.f), 448.f);
      float v2 = fminf(fmaxf(a.z * scale, -448.f), 448.f), v3 = fminf(fmaxf(a.w * scale, -448.f), 448.f);
      int t = 0;
      t = __builtin_amdgcn_cvt_pk_fp8_f32(v0, v1, t, false);
      t = __builtin_amdgcn_cvt_pk_fp8_f32(v2, v3, t, true);
      w[k] = (unsigned)t;
    }
    *(uint4*)(dst + i * 16) = make_uint4(w[0], w[1], w[2], w[3]);
  }
}
__device__ __forceinline__ float dot16_fp8(uint4 u, const f2v* x2) {
  f2v acc = __builtin_amdgcn_cvt_pk_f32_fp8((int)u.x, false) * x2[0];
  acc += __builtin_amdgcn_cvt_pk_f32_fp8((int)u.x, true) * x2[1];
  acc += __builtin_amdgcn_cvt_pk_f32_fp8((int)u.y, false) * x2[2];
  acc += __builtin_amdgcn_cvt_pk_f32_fp8((int)u.y, true) * x2[3];
  acc += __builtin_amdgcn_cvt_pk_f32_fp8((int)u.z, false) * x2[4];
  acc += __builtin_amdgcn_cvt_pk_f32_fp8((int)u.z, true) * x2[5];
  acc += __builtin_amdgcn_cvt_pk_f32_fp8((int)u.w, false) * x2[6];
  acc += __builtin_amdgcn_cvt_pk_f32_fp8((int)u.w, true) * x2[7];
  return acc.x + acc.y;
}
__device__ __forceinline__ void axpy16_fp8(f2v* o2, float cf, uint4 v) {
  f2v c = {cf, cf};
  o2[0] += c * __builtin_amdgcn_cvt_pk_f32_fp8((int)v.x, false);
  o2[1] += c * __builtin_amdgcn_cvt_pk_f32_fp8((int)v.x, true);
  o2[2] += c * __builtin_amdgcn_cvt_pk_f32_fp8((int)v.y, false);
  o2[3] += c * __builtin_amdgcn_cvt_pk_f32_fp8((int)v.y, true);
  o2[4] += c * __builtin_amdgcn_cvt_pk_f32_fp8((int)v.z, false);
  o2[5] += c * __builtin_amdgcn_cvt_pk_f32_fp8((int)v.z, true);
  o2[6] += c * __builtin_amdgcn_cvt_pk_f32_fp8((int)v.w, false);
  o2[7] += c * __builtin_amdgcn_cvt_pk_f32_fp8((int)v.w, true);
}
#define PEER_LOAD(u, v, b)                                                                   \
  _Pragma("unroll") for (int k = 0; k < 8; ++k) {                                            \
    int j = (b) * 8 + k;                                                                     \
    int e = __builtin_amdgcn_readlane((b) < 8 ? id0 : id1, j & 63);                          \
    u[k] = *(const uint4*)(U8 + (size_t)e * 1024 + lane * 16);                               \
    v[k] = *(const uint4*)(V8 + (size_t)e * 1024 + lane * 16);                               \
  }
#define PEER_COMP(u, v, b)                                                                   \
  _Pragma("unroll") for (int hf = 0; hf < 2; ++hf) {                                         \
    float s = reduce4(dot16_fp8(u[hf * 4 + 0], x2), dot16_fp8(u[hf * 4 + 1], x2),           \
                      dot16_fp8(u[hf * 4 + 2], x2), dot16_fp8(u[hf * 4 + 3], x2)) * xr_rstd; \
    float act = 0.5f * s * (1.f + erff(s * 0.7071067811865475f));                            \
    float gsel = __shfl((b) < 8 ? g0 : g1, ((b) * 8 + hf * 4 + (lane >> 4)) & 63);           \
    float cfv = act * gsel * (1.f / V8_SCALE);                                               \
    axpy16_fp8(o2, __int_as_float(__builtin_amdgcn_readlane(__float_as_int(cfv), 0)), v[hf * 4 + 0]);  \
    axpy16_fp8(o2, __int_as_float(__builtin_amdgcn_readlane(__float_as_int(cfv), 16)), v[hf * 4 + 1]); \
    axpy16_fp8(o2, __int_as_float(__builtin_amdgcn_readlane(__float_as_int(cfv), 32)), v[hf * 4 + 2]); \
    axpy16_fp8(o2, __int_as_float(__builtin_amdgcn_readlane(__float_as_int(cfv), 48)), v[hf * 4 + 3]); \
  }
__device__ void phase_peer(const Params& P) {
  const int lane = threadIdx.x & 63, w = threadIdx.x >> 6;
  bfu* hq = (bfu*)(P.ws + SLOT(0));
  const unsigned char* U8 = (const unsigned char*)(P.ws + SLOT(2));
  const unsigned char* V8 = (const unsigned char*)(P.ws + SLOT(3));
  const int* ids = (const int*)(P.ws + SLOT(4));
  const float* gw = (const float*)(P.ws + SLOT(13));
  bfu* pbf = (bfu*)(P.ws + SLOT(6));
  for (int r = blockIdx.x * 4 + w; r < MT; r += gridDim.x * 4) {
    f2v x2[8], o2[8];
    {
      uint4 v0 = *(const uint4*)(hq + (size_t)r * 1024 + lane * 16);
      uint4 v1 = *(const uint4*)(hq + (size_t)r * 1024 + lane * 16 + 8);
      float xf[16];
      unpack8(v0, xf); unpack8(v1, xf + 8);
#pragma unroll
      for (int j = 0; j < 8; ++j) { x2[j].x = xf[2 * j]; x2[j].y = xf[2 * j + 1]; o2[j].x = 0.f; o2[j].y = 0.f; }
    }
    int id0 = ids[(size_t)r * 128 + lane], id1 = ids[(size_t)r * 128 + 64 + lane];
    float g0 = gw[(size_t)r * 128 + lane], g1 = gw[(size_t)r * 128 + 64 + lane];
    float xr_rstd;
    {
      const float* pp = (const float*)(P.ws + O_GPRE) + (size_t)r * 8;
      float4 p0 = *(const float4*)pp, p1 = *(const float4*)(pp + 4);
      xr_rstd = rsqrtf((p0.x + p0.y + p0.z + p0.w + p1.x + p1.y + p1.z + p1.w) * (1.f / 1024.f) + EPS) * (1.f / U8_SCALE);
    }
    uint4 uA[8], vA[8], uB[8], vB[8];
    PEER_LOAD(uA, vA, 0)
    for (int b = 0; b < 16; b += 2) {
      PEER_LOAD(uB, vB, b + 1)
      PEER_COMP(uA, vA, b)
      if (b + 2 < 16) { PEER_LOAD(uA, vA, b + 2) }
      PEER_COMP(uB, vB, b + 1)
    }
    float* xr = P.out + (size_t)r * 1024 + lane * 16;
    float x3[16];
    float ss = 0.f;
#pragma unroll
    for (int k = 0; k < 4; ++k) {
      float4 a = *(const float4*)(xr + k * 4);
      x3[k * 4 + 0] = a.x + o2[k * 2].x; x3[k * 4 + 1] = a.y + o2[k * 2].y;
      x3[k * 4 + 2] = a.z + o2[k * 2 + 1].x; x3[k * 4 + 3] = a.w + o2[k * 2 + 1].y;
      *(float4*)(xr + k * 4) = make_float4(x3[k * 4], x3[k * 4 + 1], x3[k * 4 + 2], x3[k * 4 + 3]);
    }
#pragma unroll
    for (int j = 0; j < 16; ++j) ss += x3[j] * x3[j];
    ss = wave_sum(ss);
    float rstd = rsqrtf(ss * (1.f / 1024.f) + EPS);
    float hv[16];
#pragma unroll
    for (int k = 0; k < 4; ++k) {
      float4 ga = *(const float4*)(P.g_ple + lane * 16 + k * 4);
      hv[k * 4] = x3[k * 4] * rstd * ga.x; hv[k * 4 + 1] = x3[k * 4 + 1] * rstd * ga.y;
      hv[k * 4 + 2] = x3[k * 4 + 2] * rstd * ga.z; hv[k * 4 + 3] = x3[k * 4 + 3] * rstd * ga.w;
    }
    *(uint4*)(hq + (size_t)r * 1024 + lane * 16) = pack8(hv);
    *(uint4*)(hq + (size_t)r * 1024 + lane * 16 + 8) = pack8(hv + 8);
    {
      const float* pr = r < MP ? P.pp + (size_t)r * 256 : P.ps + (size_t)(r - MP) * 256;
      float4 a = *(const float4*)(pr + lane * 4);
      uint2 ov; ov.x = pack2(a.x, a.y); ov.y = pack2(a.z, a.w);
      *(uint2*)(pbf + (size_t)r * 256 + lane * 4) = ov;
    }
  }
}

__device__ void phase_ple(const Params& P, char* smem) {
  bfu* sA = (bfu*)smem; bfu* sB = sA + 128 * 72;
  const bfu* hg = (const bfu*)(P.ws + SLOT(0));
  const bfu* pbf = (const bfu*)(P.ws + SLOT(6));
  for (int t = blockIdx.x; t < 260 * 8; t += gridDim.x) {
    int mt, nt; tile_map(t, 260, 8, mt, nt);
    f32x16 acc[2][2]; zero_acc(acc);
    bfu* sT = (bfu*)smem; float* sT32 = (float*)smem;
    uint2 pg[16];
    gemm_acc(acc, hg + (size_t)mt * 128 * 1024, 1024, (const bfu*)(P.ws + O_WT_PG) + (size_t)nt * 128 * 1024, 1024, 1024, sA, sB);
    __syncthreads();
    {
      EPI_BEGIN
#pragma unroll
        for (int j = 0; j < 4; ++j) {
          sT[(r0 + j) * ST_LD + cl] = f2bf(sigmoidf_(acc[mi][0][q * 4 + j]));
          sT[(r0 + j) * ST_LD + cl + 64] = f2bf(sigmoidf_(acc[mi][1][q * 4 + j]));
        }
      EPI_END
    }
    __syncthreads();
#pragma unroll
    for (int i = 0; i < 16; ++i) {
      int id = threadIdx.x + i * 256, row = id >> 5, c4 = (id & 31) * 4;
      pg[i] = *(const uint2*)(sT + row * ST_LD + c4);
    }
    zero_acc(acc);
    gemm_acc(acc, pbf + (size_t)mt * 128 * 256, 256, (const bfu*)(P.ws + O_WT_PLE) + (size_t)nt * 128 * 256, 256, 256, sA, sB);
    __syncthreads();
    {
      EPI_BEGIN
#pragma unroll
        for (int j = 0; j < 4; ++j) {
          sT32[(r0 + j) * ST32_LD + cl] = acc[mi][0][q * 4 + j];
          sT32[(r0 + j) * ST32_LD + cl + 64] = acc[mi][1][q * 4 + j];
        }
      EPI_END
    }
    __syncthreads();
#pragma unroll
    for (int i = 0; i < 16; ++i) {
      int id = threadIdx.x + i * 256, row = id >> 5, c4 = (id & 31) * 4;
      float4 a = *(const float4*)(sT32 + row * ST32_LD + c4);
      float* op = P.out + (size_t)(mt * 128 + row) * 1024 + nt * 128 + c4;
      float4 x = *(const float4*)op;
      float g0 = bf2f(pg[i].x & 0xffff), g1 = bf2f(pg[i].x >> 16), g2 = bf2f(pg[i].y & 0xffff), g3 = bf2f(pg[i].y >> 16);
      *(float4*)op = make_float4(x.x + a.x * g0, x.y + a.y * g1, x.z + a.z * g2, x.w + a.w * g3);
    }
  }
}

__device__ void phase_final(const Params& P) {
  const int lane = threadIdx.x & 63, w = threadIdx.x >> 6;
  for (int r = blockIdx.x * 4 + w; r < MT; r += gridDim.x * 4) {
    float* xr = P.out + (size_t)r * 1024;
    float4 v[4]; float ss = 0.f;
#pragma unroll
    for (int i = 0; i < 4; ++i) {
      v[i] = *(const float4*)(xr + i * 256 + lane * 4);
      ss += v[i].x * v[i].x + v[i].y * v[i].y + v[i].z * v[i].z + v[i].w * v[i].w;
    }
    ss = wave_sum(ss);
    float rstd = rsqrtf(ss * (1.f / 1024.f) + EPS);
#pragma unroll
    for (int i = 0; i < 4; ++i) {
      float4 gg = *(const float4*)(P.g_final + i * 256 + lane * 4);
      *(float4*)(xr + i * 256 + lane * 4) = make_float4(v[i].x * rstd * gg.x, v[i].y * rstd * gg.y, v[i].z * rstd * gg.z, v[i].w * rstd * gg.w);
    }
  }
}

__global__ void __launch_bounds__(NTHREADS, 2) fwd_megakernel(Params P) {
  extern __shared__ __attribute__((aligned(16))) char smem[];
  cg::grid_group grid = cg::this_grid();
  __shared__ uint4 xb_words;
  if (threadIdx.x == 0) xb_words = make_uint4(0u, 0u, 0u, 0u);
  __syncthreads();
  XcdBarrier xb = xcd_barrier_post((unsigned*)(P.ws + O_BAR), (volatile LAS unsigned*)&xb_words);
  if (P.out == nullptr) grid.sync();
  const int gtid = blockIdx.x * NTHREADS + threadIdx.x, gstride = gridDim.x * NTHREADS;
  phase_prep(P, smem);
  xcd_barrier(xb);
  phase_gemm1(P, smem);
  xcd_barrier(xb);
  phase_conv(P);
  gate_scan(P);
  xcd_barrier(xb);
  m_fold(P);
  phase_mqk(P, smem);
  xcd_barrier(xb);
  for (int t = blockIdx.x; t < 4224; t += gridDim.x) phaseA_item(P, t / 2112, t % 2112, smem);
  xcd_barrier(xb);
  phase_scan(P);
  xcd_barrier(xb);
  for (int t = blockIdx.x; t < 4224; t += gridDim.x) phaseC_item(P, t / 2112, t % 2112, smem);
  xcd_barrier(xb);
  phase_merge(P, smem);
  {
    const int extra = 2080 % (int)gridDim.x;
    if ((int)blockIdx.x >= extra) {
      const int cg_tid = ((int)blockIdx.x - extra) * NTHREADS + threadIdx.x, cg_str = ((int)gridDim.x - extra) * NTHREADS;
      convert_fp8(P.peer_u, (unsigned char*)(P.ws + SLOT(2)), 16384ull * 1024 / 16, U8_SCALE, cg_tid, cg_str);
      convert_fp8(P.peer_v, (unsigned char*)(P.ws + SLOT(3)), 16384ull * 1024 / 16, V8_SCALE, cg_tid, cg_str);
    }
  }
  xcd_barrier(xb);
  phase_outproj(P, smem);
  xcd_barrier(xb);
  phase_pq(P, smem);
  xcd_barrier(xb);
  phase_topk(P, smem);
  xcd_barrier(xb);
  phase_peer(P);
  xcd_barrier(xb);
  phase_ple(P, smem);
  xcd_barrier(xb);
  phase_final(P);
}

extern "C" void kernel_launch(void* const* d_in, const int* in_sizes, int n_in, void* d_out, int out_size,
                              void* d_ws, size_t ws_size, hipStream_t stream) {
  static int grid_blocks = 0;
  if (!grid_blocks) {
    hipFuncSetAttribute((const void*)fwd_megakernel, hipFuncAttributeMaxDynamicSharedMemorySize, SMEM_BYTES);
    int dev = 0, cus = 0, per_cu = 0;
    hipGetDevice(&dev);
    hipDeviceGetAttribute(&cus, hipDeviceAttributeMultiprocessorCount, dev);
    hipOccupancyMaxActiveBlocksPerMultiprocessor(&per_cu, fwd_megakernel, NTHREADS, SMEM_BYTES);
    if (per_cu > 2) per_cu = 2;
    if (per_cu < 1) per_cu = 1;
    grid_blocks = cus * per_cu;
  }
  Params p{};
  const float** pf = (const float**)&p;
  for (int i = 0; i < 32; ++i) pf[i] = (const float*)d_in[i];
  p.out = (float*)d_out;
  p.ws = (char*)d_ws;
  hipMemsetAsync((char*)d_ws + O_BAR, 0, XCD_BAR_WORDS * 4, stream);
  void* args[] = {&p};
  hipError_t e = hipLaunchCooperativeKernel((void*)fwd_megakernel, dim3(grid_blocks), dim3(NTHREADS), args, SMEM_BYTES, stream);
  if (e != hipSuccess) fprintf(stderr, "cooperative launch failed: %s (grid %d)\n", hipGetErrorString(e), grid_blocks);
}
```

```cpp
#include <hip/hip_runtime.h>
#include <hip/hip_cooperative_groups.h>
#include <cstdio>
namespace cg = cooperative_groups;

typedef unsigned short bfu;
typedef __attribute__((ext_vector_type(8))) short bf16x8;
typedef __attribute__((ext_vector_type(16))) float f32x16;

#define MT 33280
#define MP 32768
#define NTHREADS 256
#define EPS 1e-6f

struct Params {
  const float *xp, *xs, *pp, *ps, *st_ret, *st_C, *st_n, *st_m, *st_conv, *g_mix, *w_in, *g_ret_gn, *w_mq,
      *w_mk, *conv_w, *conv_b, *b_i, *b_f, *g_ml_gn, *w_skip, *w_up_r, *w_up_m, *w_out, *g_ffn, *w_pq,
      *peer_keys, *peer_u, *peer_v, *g_ple, *w_pg, *w_ple, *g_final;
  float* out;
  char* ws;
};

constexpr size_t O_WT_IN = 0;
constexpr size_t O_WT_UPR = O_WT_IN + 5632ull * 1024 * 2;
constexpr size_t O_WT_UPM = O_WT_UPR + 1024ull * 512 * 2;
constexpr size_t O_WT_OUT = O_WT_UPM + 1024ull * 512 * 2;
constexpr size_t O_WT_PQ = O_WT_OUT + 1024ull * 1024 * 2;
constexpr size_t O_WT_PG = O_WT_PQ + 2048ull * 1024 * 2;
constexpr size_t O_WT_PLE = O_WT_PG + 1024ull * 1024 * 2;
constexpr size_t O_KEYS = O_WT_PLE + 1024ull * 256 * 2;
constexpr size_t O_WT_MQ = O_KEYS + 16ull * 128 * 128 * 2;
constexpr size_t O_WT_MK = O_WT_MQ + 4ull * 128 * 128 * 2;
constexpr size_t O_COS = O_WT_MK + 4ull * 128 * 128 * 2;
constexpr size_t O_SIN = O_COS + 8192ull * 64 * 4;
constexpr size_t O_FQ = O_SIN + 8192ull * 64 * 4;
constexpr size_t O_UQ = O_FQ + (size_t)MT * 16;
constexpr size_t O_CMQ = O_UQ + (size_t)MT * 16;
constexpr size_t O_FL = O_CMQ + (size_t)MT * 16;
constexpr size_t O_UC = O_FL + 16384;
constexpr size_t O_AEND = O_UC + 16384;
constexpr size_t O_MCS = O_AEND + 16384;
constexpr size_t O_DN = O_MCS + 16384;
constexpr size_t O_DSS = O_DN + 2112ull * 128 * 4;
constexpr size_t O_GPRE = O_DSS + 2ull * 64 * 16384 * 2;
constexpr size_t O_BAR = O_GPRE + (size_t)MT * 32;
constexpr size_t O_SMALL_END = O_BAR + 16384;
constexpr size_t SLOT0 = 40ull << 20;
constexpr size_t USZ = (size_t)MT * 512 * 2;
static_assert(O_SMALL_END <= SLOT0, "small region overflow");
#define SLOT(i) (SLOT0 + (size_t)(i) * USZ)
constexpr size_t SB_T = 16ull * 128 * 8192;

constexpr size_t OO_Y = 0;
constexpr size_t OO_RETP = (size_t)MT * 1024;
constexpr size_t OO_CP = OO_RETP + 262144;
constexpr size_t OO_NP = OO_CP + 262144;
constexpr size_t OO_MP = OO_NP + 2048;
constexpr size_t OO_CONVP = OO_MP + 16;
constexpr size_t OO_RETS = OO_CONVP + 6144;
constexpr size_t OO_CS = OO_RETS + 1048576;
constexpr size_t OO_NS = OO_CS + 1048576;
constexpr size_t OO_MS = OO_NS + 8192;
constexpr size_t OO_CONVS = OO_MS + 64;

constexpr int SMEM_BYTES = 81152;

__device__ __forceinline__ bfu f2bf(float f) {
  unsigned u = __float_as_uint(f);
  u += 0x7fffu + ((u >> 16) & 1u);
  return (bfu)(u >> 16);
}
__device__ __forceinline__ float bf2f(bfu b) { return __uint_as_float(((unsigned)b) << 16); }
__device__ __forceinline__ unsigned pack2(float a, float b) { return (unsigned)f2bf(a) | ((unsigned)f2bf(b) << 16); }
__device__ __forceinline__ void unpack8(uint4 v, float* f) {
  f[0] = bf2f(v.x & 0xffff); f[1] = bf2f(v.x >> 16); f[2] = bf2f(v.y & 0xffff); f[3] = bf2f(v.y >> 16);
  f[4] = bf2f(v.z & 0xffff); f[5] = bf2f(v.z >> 16); f[6] = bf2f(v.w & 0xffff); f[7] = bf2f(v.w >> 16);
}
__device__ __forceinline__ uint4 pack8(const float* f) {
  uint4 o; o.x = pack2(f[0], f[1]); o.y = pack2(f[2], f[3]); o.z = pack2(f[4], f[5]); o.w = pack2(f[6], f[7]);
  return o;
}
__device__ __forceinline__ float wave_sum(float v) {
#pragma unroll
  for (int o = 32; o > 0; o >>= 1) v += __shfl_xor(v, o);
  return v;
}
__device__ __forceinline__ float wave_max(float v) {
#pragma unroll
  for (int o = 32; o > 0; o >>= 1) v = fmaxf(v, __shfl_xor(v, o));
  return v;
}
__device__ __forceinline__ float dpp_ror_add(float s, const int ctrl_sel) {
  int v = __float_as_int(s);
  int t;
  if (ctrl_sel == 8) t = __builtin_amdgcn_update_dpp(0, v, 0x128, 0xf, 0xf, false);
  else if (ctrl_sel == 4) t = __builtin_amdgcn_update_dpp(0, v, 0x124, 0xf, 0xf, false);
  else if (ctrl_sel == 2) t = __builtin_amdgcn_update_dpp(0, v, 0x122, 0xf, 0xf, false);
  else t = __builtin_amdgcn_update_dpp(0, v, 0x121, 0xf, 0xf, false);
  return s + __int_as_float(t);
}
__device__ __forceinline__ float reduce4(float p0, float p1, float p2, float p3) {
  auto r = __builtin_amdgcn_permlane32_swap(__float_as_int(p0), __float_as_int(p2), false, false);
  float sA = __int_as_float(r[0]) + __int_as_float(r[1]);
  r = __builtin_amdgcn_permlane32_swap(__float_as_int(p1), __float_as_int(p3), false, false);
  float sB = __int_as_float(r[0]) + __int_as_float(r[1]);
  r = __builtin_amdgcn_permlane16_swap(__float_as_int(sA), __float_as_int(sB), false, false);
  float s = __int_as_float(r[0]) + __int_as_float(r[1]);
  s = dpp_ror_add(s, 8); s = dpp_ror_add(s, 4); s = dpp_ror_add(s, 2); s = dpp_ror_add(s, 1);
  return s;
}
__device__ __forceinline__ float sigmoidf_(float x) { return 1.f / (1.f + __expf(-x)); }
__device__ __forceinline__ const float* xrow(const Params& P, int r) {
  return r < MP ? P.xp + (size_t)r * 1024 : P.xs + (size_t)(r - MP) * 1024;
}


#define XB_TMO      128
#define XB_XCNT(j)  (256  + 64 * (j))
#define XB_XSUB(j)  (1280 + 64 * (j))
#define XB_XGEN(j)  (2304 + 64 * (j))
#define XB_TOP      3328
#define XB_TOPGEN   3392
#define XCD_BAR_WORDS 3456
#define XB_SPIN_CAP (1u << 22)
#define LAS __attribute__((address_space(3)))
__device__ __forceinline__ unsigned xb_ld(unsigned* p) { return __hip_atomic_load(p, __ATOMIC_RELAXED, __HIP_MEMORY_SCOPE_AGENT); }
__device__ __forceinline__ unsigned xb_add(unsigned* p, unsigned v) { return __hip_atomic_fetch_add(p, v, __ATOMIC_RELAXED, __HIP_MEMORY_SCOPE_AGENT); }
__device__ __forceinline__ unsigned xb_xcc_id() { return (unsigned)__builtin_amdgcn_s_getreg((3 << 11) | 20) & 0xFu; }
#define XB_SPIN(cond, bar) do { unsigned _sp = 0; while (cond) { __builtin_amdgcn_s_sleep(1); \
    if ((++_sp & 255u) == 0u) { if (xb_ld(&(bar)[XB_TMO])) break; if (_sp > XB_SPIN_CAP) { atomicAdd(&(bar)[XB_TMO], 1u); break; } } } } while (0)
struct XcdBarrier { unsigned* bar; unsigned x; volatile LAS unsigned* st; };
__device__ __forceinline__ XcdBarrier xcd_barrier_post(unsigned* bar, volatile LAS unsigned* st) {
  XcdBarrier b; b.bar = bar; b.x = xb_xcc_id(); b.st = st;
  if (threadIdx.x == 0) (void)xb_add(&bar[XB_XCNT(b.x)], 1u);
  return b;
}
__device__ __forceinline__ void xcd_barrier_complete(unsigned* bar, unsigned x, unsigned& nloc, unsigned& nx) {
  const unsigned G = gridDim.x * gridDim.y * gridDim.z;
  unsigned sum, cnt, mine, sp = 0u;
  for (;;) {
    sum = 0u; cnt = 0u; mine = 0u;
#pragma unroll
    for (unsigned j = 0; j < 16; ++j) { const unsigned c = xb_ld(&bar[XB_XCNT(j)]); sum += c; cnt += (c > 0u) ? 1u : 0u; mine = (j == x) ? c : mine; }
    if (sum == G) break;
    __builtin_amdgcn_s_sleep(1);
    if ((++sp & 255u) == 0u) { if (xb_ld(&bar[XB_TMO])) break; if (sp > XB_SPIN_CAP) { atomicAdd(&bar[XB_TMO], 1u); break; } }
  }
  nloc = mine > 0u ? mine : 1u; nx = cnt > 0u ? cnt : 1u;
}
__device__ __forceinline__ void xcd_barrier(const XcdBarrier& b) {
  asm volatile("s_waitcnt vmcnt(0)" ::: "memory");
  __syncthreads();
  if (threadIdx.x == 0) {
    unsigned* bar = b.bar;
    __builtin_amdgcn_s_waitcnt(0);
    unsigned nloc = b.st[0], nx = b.st[1];
    if (nloc == 0u) { xcd_barrier_complete(bar, b.x, nloc, nx); b.st[0] = nloc; b.st[1] = nx; }
    const unsigned old = xb_add(&bar[XB_XSUB(b.x)], 1u);
    const unsigned gen = old / nloc;
    if (old + 1u == (gen + 1u) * nloc) {
      __builtin_amdgcn_fence(__ATOMIC_RELEASE, "agent");
      asm volatile("s_waitcnt vmcnt(0)" ::: "memory");
      const unsigned og = xb_add(&bar[XB_TOP], 1u);
      const unsigned tg = og / nx;
      if (og + 1u == (tg + 1u) * nx) xb_add(&bar[XB_TOPGEN], 1u);
      else XB_SPIN(xb_ld(&bar[XB_TOPGEN]) == tg, bar);
      __builtin_amdgcn_fence(__ATOMIC_ACQUIRE, "agent");
      xb_add(&bar[XB_XGEN(b.x)], 1u);
      asm volatile("s_waitcnt vmcnt(0)" ::: "memory");
    } else {
      XB_SPIN(xb_ld(&bar[XB_XGEN(b.x)]) == gen, bar);
      __builtin_amdgcn_fence(__ATOMIC_ACQUIRE, "agent");
      asm volatile("s_waitcnt vmcnt(0)" ::: "memory");
    }
  }
  __syncthreads();
}

__device__ __forceinline__ void gemm_acc(f32x16 (&acc)[2][2], const bfu* __restrict__ A, int lda,
                                         const bfu* __restrict__ Bt, int ldb, int K, bfu* sA, bfu*  ) {
  const int tid = threadIdx.x, lane = tid & 63, w = tid >> 6, wm = w & 1, wn = w >> 1;
  const int lr = tid >> 3;
  const int kc = ((tid & 7) ^ ((tid >> 4) & 7)) * 8;
  const bfu* Ap = A + (size_t)lr * lda + kc;
  const bfu* Bp = Bt + (size_t)lr * ldb + kc;
  const size_t a32 = (size_t)32 * lda, b32 = (size_t)32 * ldb;
  char* sbase = (char*)sA;
  char* ldst = sbase + tid * 16;
#define GISSUE(stage, k)                                                                                       \
  _Pragma("unroll") for (int i_ = 0; i_ < 4; ++i_) {                                                           \
    __builtin_amdgcn_global_load_lds((const unsigned*)(Ap + i_ * a32 + (k)),                                   \
                                     (LAS unsigned*)(ldst + (stage) * 32768 + i_ * 4096), 16, 0, 0);           \
    __builtin_amdgcn_global_load_lds((const unsigned*)(Bp + i_ * b32 + (k)),                                   \
                                     (LAS unsigned*)(ldst + (stage) * 32768 + 16384 + i_ * 4096), 16, 0, 0);   \
  }
  const int sw = (lane >> 1) & 7, hh = lane >> 5;
  const int rowA = (wm * 64 + (lane & 31)) * 128, rowB = (wn * 32 + (lane & 31)) * 128;
  __syncthreads();
  GISSUE(0, 0)
  int cur = 0;
  for (int k0 = 0; k0 < K; k0 += 64) {
    asm volatile("s_waitcnt vmcnt(0)" ::: "memory");
    __syncthreads();
    if (k0 + 64 < K) { GISSUE(cur ^ 1, k0 + 64) }
    const char* cA = sbase + cur * 32768;
    const char* cB = cA + 16384;
    __builtin_amdgcn_s_setprio(1);
#pragma unroll
    for (int ks = 0; ks < 4; ++ks) {
      const int pos = ((2 * ks + hh) ^ sw) * 16;
      bf16x8 af[2], bfr[2];
#pragma unroll
      for (int mi = 0; mi < 2; ++mi) af[mi] = *(const bf16x8*)(cA + rowA + mi * 32 * 128 + pos);
#pragma unroll
      for (int ni = 0; ni < 2; ++ni) bfr[ni] = *(const bf16x8*)(cB + rowB + ni * 64 * 128 + pos);
#pragma unroll
      for (int mi = 0; mi < 2; ++mi)
#pragma unroll
        for (int ni = 0; ni < 2; ++ni)
          acc[mi][ni] = __builtin_amdgcn_mfma_f32_32x32x16_bf16(af[mi], bfr[ni], acc[mi][ni], 0, 0, 0);
    }
    __builtin_amdgcn_s_setprio(0);
    cur ^= 1;
  }
}
#define gemm_acc1 gemm_acc
__device__ __forceinline__ void zero_acc(f32x16 (&acc)[2][2]) {
#pragma unroll
  for (int a = 0; a < 2; ++a)
#pragma unroll
    for (int b = 0; b < 2; ++b)
#pragma unroll
      for (int i = 0; i < 16; ++i) acc[a][b][i] = 0.f;
}
#define EPI_BEGIN                                                      \
  const int e_lane = threadIdx.x & 63, e_w = threadIdx.x >> 6;         \
  const int e_wm = e_w & 1, e_wn = e_w >> 1;                            \
  const int cl = e_wn * 32 + (e_lane & 31);                             \
  _Pragma("unroll") for (int mi = 0; mi < 2; ++mi)                      \
  _Pragma("unroll") for (int q = 0; q < 4; ++q) {                       \
    const int r0 = e_wm * 64 + mi * 32 + q * 8 + 4 * (e_lane >> 5);
#define EPI_END }

#define ST_LD 136
#define ST32_LD 132
typedef unsigned u32x4nt __attribute__((ext_vector_type(4)));
__device__ __forceinline__ void nt_store_u4(void* p, uint4 v) { u32x4nt t = {v.x, v.y, v.z, v.w}; __builtin_nontemporal_store(t, (u32x4nt*)p); }
__device__ __forceinline__ void copyout_bf16(const bfu* sT, bfu* dst, int ld) {
  const int tid = threadIdx.x;
#pragma unroll
  for (int i = 0; i < 8; ++i) {
    int id = tid + i * 256, row = id >> 4, c8 = (id & 15) * 8;
    *(uint4*)(dst + (size_t)row * ld + c8) = *(const uint4*)(sT + row * ST_LD + c8);
  }
}
__device__ __forceinline__ void copyout_bf16_nt(const bfu* sT, bfu* dst, int ld) {
  const int tid = threadIdx.x;
#pragma unroll
  for (int i = 0; i < 8; ++i) {
    int id = tid + i * 256, row = id >> 4, c8 = (id & 15) * 8;
    nt_store_u4(dst + (size_t)row * ld + c8, *(const uint4*)(sT + row * ST_LD + c8));
  }
}
__device__ __forceinline__ void stage_rm(bfu* sT, const f32x16 (&acc)[2][2], float sc) {
  EPI_BEGIN
#pragma unroll
    for (int j = 0; j < 4; ++j) {
      sT[(r0 + j) * ST_LD + cl] = f2bf(acc[mi][0][q * 4 + j] * sc);
      sT[(r0 + j) * ST_LD + cl + 64] = f2bf(acc[mi][1][q * 4 + j] * sc);
    }
  EPI_END
}

__device__ __forceinline__ void tile_map(int L, int nM, int nN, int& pm, int& pn) {
  const int nwg = nM * nN;
  const int q = nwg >> 3, r = nwg & 7, xcd = L & 7, off = L >> 3;
  int wgid = (xcd < r ? xcd * (q + 1) : r * (q + 1) + (xcd - r) * q) + off;
  const int nig = 8 * nN, gid = wgid / nig, fm = gid * 8;
  const int gsz = (nM - fm) < 8 ? (nM - fm) : 8;
  pm = fm + (wgid % nig) % gsz;
  pn = (wgid % nig) / gsz;
}
__device__ void transpose_w(const float* __restrict__ src, int K, int N, int src_ld, bfu* __restrict__ dst,
                            int remap, int gtid, int gstride) {
  int total = N * (K / 8);
  for (int i = gtid; i < total; i += gstride) {
    int n = i % N, kg = i / N;
    int col = (remap && n >= 3584) ? n + 8 : n;
    float v[8];
#pragma unroll
    for (int j = 0; j < 8; ++j) v[j] = src[(size_t)(kg * 8 + j) * src_ld + col];
    uint4 o;
    o.x = pack2(v[0], v[1]); o.y = pack2(v[2], v[3]); o.z = pack2(v[4], v[5]); o.w = pack2(v[6], v[7]);
    *(uint4*)(dst + (size_t)n * K + kg * 8) = o;
  }
}
__device__ void transpose_w_lds(const float* __restrict__ src, int K, int N, int src_ld, bfu* __restrict__ dst,
                                int remap, float* st, int boff) {
  const int tid = threadIdx.x;
  const int tilesN = N >> 6, ntile = (K >> 6) * tilesN;
  for (int t = (int)((blockIdx.x + gridDim.x - (boff % gridDim.x)) % gridDim.x); t < ntile; t += gridDim.x) {
    const int kt = t / tilesN, nt = t - kt * tilesN;
    {
      const int row = tid >> 2, c16 = (tid & 3) * 16;
      const int n0 = nt * 64 + c16;
      const int col = (remap && n0 >= 3584) ? n0 + 8 : n0;
      const float* sp = src + (size_t)(kt * 64 + row) * src_ld + col;
#pragma unroll
      for (int j = 0; j < 4; ++j) {
        float4 v = *(const float4*)(sp + j * 4);
        float* d = st + row * 65 + c16 + j * 4;
        d[0] = v.x; d[1] = v.y; d[2] = v.z; d[3] = v.w;
      }
    }
    __syncthreads();
    {
      const int n = tid >> 2, kc = (tid & 3) * 16;
#pragma unroll
      for (int hf = 0; hf < 2; ++hf) {
        float f[8];
#pragma unroll
        for (int j = 0; j < 8; ++j) f[j] = st[(kc + hf * 8 + j) * 65 + n];
        uint4 o;
        o.x = pack2(f[0], f[1]); o.y = pack2(f[2], f[3]); o.z = pack2(f[4], f[5]); o.w = pack2(f[6], f[7]);
        *(uint4*)(dst + (size_t)(nt * 64 + n) * K + kt * 64 + kc + hf * 8) = o;
      }
    }
    __syncthreads();
  }
}
__device__ void convert_bf(const float* __restrict__ src, bfu* __restrict__ dst, size_t n8, int gtid, int gstride) {
  for (size_t i = gtid; i < n8; i += gstride) {
    float4 a = *(const float4*)(src + i * 8), b = *(const float4*)(src + i * 8 + 4);
    uint4 o;
    o.x = pack2(a.x, a.y); o.y = pack2(a.z, a.w); o.z = pack2(b.x, b.y); o.w = pack2(b.z, b.w);
    *(uint4*)(dst + i * 8) = o;
  }
}

__device__ void prep_rows(const Params& P) {
  const int lane = threadIdx.x & 63, w = threadIdx.x >> 6;
  bfu* hbuf = (bfu*)(P.ws + SLOT(0));
  float* gpre = (float*)(P.ws + O_GPRE);
  float4 wg0[16], wg1[16];
#pragma unroll
  for (int i = 0; i < 4; ++i)
#pragma unroll
    for (int j = 0; j < 4; ++j) {
      const float* wr = P.w_in + (size_t)(i * 256 + lane * 4 + j) * 5640 + 3584;
      wg0[i * 4 + j] = *(const float4*)wr; wg1[i * 4 + j] = *(const float4*)(wr + 4);
    }
  float4 gm[4];
#pragma unroll
  for (int i = 0; i < 4; ++i) gm[i] = *(const float4*)(P.g_mix + i * 256 + lane * 4);
  for (int r = blockIdx.x * 4 + w; r < MT; r += gridDim.x * 4) {
    const float* xr = xrow(P, r);
    float4 v[4];
    float ss = 0.f;
#pragma unroll
    for (int i = 0; i < 4; ++i) {
      v[i] = *(const float4*)(xr + i * 256 + lane * 4);
      ss += v[i].x * v[i].x + v[i].y * v[i].y + v[i].z * v[i].z + v[i].w * v[i].w;
    }
    ss = wave_sum(ss);
    float rstd = rsqrtf(ss * (1.f / 1024.f) + EPS);
    float ga[8];
#pragma unroll
    for (int j = 0; j < 8; ++j) ga[j] = 0.f;
#pragma unroll
    for (int i = 0; i < 4; ++i) {
      float hv[4] = {v[i].x * rstd * gm[i].x, v[i].y * rstd * gm[i].y, v[i].z * rstd * gm[i].z, v[i].w * rstd * gm[i].w};
      uint2 o; o.x = pack2(hv[0], hv[1]); o.y = pack2(hv[2], hv[3]);
      *(uint2*)(hbuf + (size_t)r * 1024 + i * 256 + lane * 4) = o;
#pragma unroll
      for (int j = 0; j < 4; ++j) {
        const float4 w0 = wg0[i * 4 + j], w1 = wg1[i * 4 + j];
        ga[0] += hv[j] * w0.x; ga[1] += hv[j] * w0.y; ga[2] += hv[j] * w0.z; ga[3] += hv[j] * w0.w;
        ga[4] += hv[j] * w1.x; ga[5] += hv[j] * w1.y; ga[6] += hv[j] * w1.z; ga[7] += hv[j] * w1.w;
      }
    }
    float si = reduce4(ga[0], ga[1], ga[2], ga[3]);
    float sf = reduce4(ga[4], ga[5], ga[6], ga[7]);
    if ((lane & 15) == 0) {
      int k = lane >> 4;
      gpre[(size_t)r * 8 + k] = si + P.b_i[k];
      gpre[(size_t)r * 8 + 4 + k] = sf + P.b_f[k];
    }
  }
}
__device__ void gate_scan(const Params& P) {
  const int lane = threadIdx.x & 63, w = threadIdx.x >> 6;
  const float* gpre = (const float*)(P.ws + O_GPRE);
  for (int item = blockIdx.x * 4 + w; item < 528 * 4; item += gridDim.x * 4) {
    int tile = item >> 2, h = item & 3;
    int row0, L;
    if (tile < 512) { row0 = tile * 64; L = 64; } else { row0 = MP + (tile - 512) * 32; L = 32; }
    const int s = lane;
    bool valid = s < L;
    float ig = valid ? gpre[(size_t)(row0 + s) * 8 + h] : -INFINITY;
    float fg = valid ? gpre[(size_t)(row0 + s) * 8 + 4 + h] : 0.f;
    float lf = valid ? (fminf(fg, 0.f) - log1pf(__expf(-fabsf(fg)))) : 0.f;
    float F = lf;
#pragma unroll
    for (int o = 1; o < 64; o <<= 1) { float t = __shfl_up(F, o); if (lane >= o) F += t; }
    float u = valid ? ig - F : -INFINITY;
    float cm = u;
#pragma unroll
    for (int o = 1; o < 64; o <<= 1) { float t = __shfl_up(cm, o); if (lane >= o) cm = fmaxf(cm, t); }
    if (valid) {
      size_t gi = (size_t)(row0 + s) * 4 + h;
      ((float*)(P.ws + O_FQ))[gi] = F;
      ((float*)(P.ws + O_UQ))[gi] = u;
      ((float*)(P.ws + O_CMQ))[gi] = cm;
      if (s == L - 1) {
        ((float*)(P.ws + O_FL))[tile * 4 + h] = F;
        ((float*)(P.ws + O_UC))[tile * 4 + h] = cm;
      }
    }
  }
}

__device__ void phase_prep(const Params& P, char* smem) {
  const int gtid = blockIdx.x * NTHREADS + threadIdx.x, gstride = gridDim.x * NTHREADS;
  prep_rows(P);
  transpose_w_lds(P.w_in, 1024, 5632, 5640, (bfu*)(P.ws + O_WT_IN), 1, (float*)smem, 0);
  transpose_w_lds(P.w_up_r, 512, 1024, 1024, (bfu*)(P.ws + O_WT_UPR), 0, (float*)smem, 1408);
  transpose_w_lds(P.w_up_m, 512, 1024, 1024, (bfu*)(P.ws + O_WT_UPM), 0, (float*)smem, 1536);
  transpose_w_lds(P.w_out, 1024, 1024, 1024, (bfu*)(P.ws + O_WT_OUT), 0, (float*)smem, 1664);
  transpose_w_lds(P.w_pq, 1024, 2048, 2048, (bfu*)(P.ws + O_WT_PQ), 0, (float*)smem, 1920);
  transpose_w_lds(P.w_pg, 1024, 1024, 1024, (bfu*)(P.ws + O_WT_PG), 0, (float*)smem, 2432);
  transpose_w_lds(P.w_ple, 256, 1024, 1024, (bfu*)(P.ws + O_WT_PLE), 0, (float*)smem, 2688);
  for (int h = 0; h < 4; ++h) {
    transpose_w_lds(P.w_mq + h * 16384, 128, 128, 128, (bfu*)(P.ws + O_WT_MQ) + h * 16384, 0, (float*)smem, 2752 + h * 8);
    transpose_w_lds(P.w_mk + h * 16384, 128, 128, 128, (bfu*)(P.ws + O_WT_MK) + h * 16384, 0, (float*)smem, 2756 + h * 8);
  }
  convert_bf(P.peer_keys, (bfu*)(P.ws + O_KEYS), 16 * 128 * 128 / 8, gtid, gstride);
  float* ct = (float*)(P.ws + O_COS); float* st = (float*)(P.ws + O_SIN);
  for (int i = gtid; i < 8192 * 64; i += gstride) {
    int pos = i >> 6, j = i & 63;
    float inv = exp2f(-(float)j * (13.287712379549449f / 64.f));
    float angf = (float)pos * inv;
    double a = (double)angf;
    double k = rint(a * 0.15915494309189535);
    float r = (float)(a - k * 6.283185307179586);
    ct[i] = __cosf(r); st[i] = __sinf(r);
  }
}

__device__ __forceinline__ void gemm_acc256(f32x16 (&acc)[4][2], const bfu* __restrict__ A, int lda,
                                            const bfu* __restrict__ Bt, int ldb, int K, char* sbase) {
  const int tid = threadIdx.x, lane = tid & 63, w = tid >> 6, wm = w & 1, wn = w >> 1;
  const int kc = ((tid & 3) ^ ((tid >> 4) & 3)) * 8;
  const bfu* Ap = A + (size_t)(tid >> 2) * lda + kc;
  const bfu* Bp = Bt + (size_t)(tid >> 2) * ldb + kc;
  const size_t a64 = (size_t)64 * lda, b64 = (size_t)64 * ldb;
  char* ldst = sbase + tid * 16;
#define GISSUE256(stage, k)                                                                                      \
  {                                                                                                              \
    char* d_ = ldst + (stage) * 24576;                                                                           \
    __builtin_amdgcn_global_load_lds((const unsigned*)(Ap + (k)), (LAS unsigned*)(d_), 16, 0, 0);                \
    __builtin_amdgcn_global_load_lds((const unsigned*)(Ap + a64 + (k)), (LAS unsigned*)(d_ + 4096), 16, 0, 0);   \
    __builtin_amdgcn_global_load_lds((const unsigned*)(Ap + 2 * a64 + (k)), (LAS unsigned*)(d_ + 8192), 16, 0, 0);  \
    __builtin_amdgcn_global_load_lds((const unsigned*)(Ap + 3 * a64 + (k)), (LAS unsigned*)(d_ + 12288), 16, 0, 0); \
    __builtin_amdgcn_global_load_lds((const unsigned*)(Bp + (k)), (LAS unsigned*)(d_ + 16384), 16, 0, 0);        \
    __builtin_amdgcn_global_load_lds((const unsigned*)(Bp + b64 + (k)), (LAS unsigned*)(d_ + 20480), 16, 0, 0);  \
  }
  const int sw = (lane >> 2) & 3, hh = lane >> 5;
  const int rowA = (wm * 64 + (lane & 31)) * 64, rowB = (wn * 32 + (lane & 31)) * 64;
  const int nk = K >> 5;
  __syncthreads();
  asm volatile("s_waitcnt vmcnt(0)" ::: "memory");
  GISSUE256(0, 0)
  if (nk > 1) GISSUE256(1, 32)
  int st = 0;
  for (int kt = 0; kt < nk; ++kt) {
    if (kt + 1 < nk) asm volatile("s_waitcnt vmcnt(6)" ::: "memory");
    else asm volatile("s_waitcnt vmcnt(0)" ::: "memory");
    asm volatile("s_waitcnt lgkmcnt(0)" ::: "memory");
    __builtin_amdgcn_s_barrier();
    asm volatile("" ::: "memory");
    if (kt + 2 < nk) { const int s2 = st >= 1 ? st - 1 : 2; GISSUE256(s2, (kt + 2) * 32) }
    const char* cA = sbase + st * 24576;
    const char* cB = cA + 16384;
    __builtin_amdgcn_s_setprio(1);
#pragma unroll
    for (int ks = 0; ks < 2; ++ks) {
      const int pos = ((2 * ks + hh) ^ sw) * 16;
      bf16x8 af[4], bfr[2];
#pragma unroll
      for (int mi = 0; mi < 4; ++mi) af[mi] = *(const bf16x8*)(cA + rowA + ((mi >> 1) * 128 + (mi & 1) * 32) * 64 + pos);
#pragma unroll
      for (int ni = 0; ni < 2; ++ni) bfr[ni] = *(const bf16x8*)(cB + rowB + ni * 64 * 64 + pos);
#pragma unroll
      for (int mi = 0; mi < 4; ++mi)
#pragma unroll
        for (int ni = 0; ni < 2; ++ni)
          acc[mi][ni] = __builtin_amdgcn_mfma_f32_32x32x16_bf16(af[mi], bfr[ni], acc[mi][ni], 0, 0, 0);
    }
    __builtin_amdgcn_s_setprio(0);
    st = st == 2 ? 0 : st + 1;
  }
}

__device__ __forceinline__ void gemm1_epilogue(const Params& P, char* smem, f32x16 (&acc)[2][2], const int rbase, const int nt,
                                               const float* ct, const float* stb) {
    const bool prompt = rbase < MP;
  int region = nt >> 2, hh = nt & 3;
  bfu* sT = (bfu*)smem;
  __syncthreads();
  if (region <= 1) {
    float sc = region == 1 ? 0.08838834764831845f : 1.f;
    EPI_BEGIN
#pragma unroll
      for (int j = 0; j < 4; ++j) {
        int rr = rbase + r0 + j;
        int pos = prompt ? (rr & 8191) : 2048 + ((rr - MP) & 31);
        float c = ct[pos * 64 + cl], sn = stb[pos * 64 + cl];
        float a = acc[mi][0][q * 4 + j], b = acc[mi][1][q * 4 + j];
        sT[(r0 + j) * ST_LD + cl] = f2bf((a * c - b * sn) * sc);
        sT[(r0 + j) * ST_LD + cl + 64] = f2bf((a * sn + b * c) * sc);
      }
    EPI_END
    __syncthreads();
    copyout_bf16_nt(sT, (bfu*)(P.ws + SLOT(2 + region)) + (size_t)rbase * 512 + hh * 128, 512);
  } else if (region == 2 || region == 5) {
    EPI_BEGIN
      uint2 va, vb;
      va.x = pack2(acc[mi][0][q * 4 + 0], acc[mi][0][q * 4 + 1]); va.y = pack2(acc[mi][0][q * 4 + 2], acc[mi][0][q * 4 + 3]);
      vb.x = pack2(acc[mi][1][q * 4 + 0], acc[mi][1][q * 4 + 1]); vb.y = pack2(acc[mi][1][q * 4 + 2], acc[mi][1][q * 4 + 3]);
      *(uint2*)(sT + cl * ST_LD + r0) = va;
      *(uint2*)(sT + (cl + 64) * ST_LD + r0) = vb;
    EPI_END
    __syncthreads();
    bfu* dst = (bfu*)(P.ws + SLOT(region == 2 ? 4 : 7));
#pragma unroll
    for (int i = 0; i < 8; ++i) {
      int id = threadIdx.x + i * 256, e = id >> 4, c8 = (id & 15) * 8;
      size_t o;
      if (prompt) { int bb = rbase >> 13, tt = (rbase & 8191) + c8; o = ((size_t)((bb * 4 + hh) * 128 + e)) * 8192 + tt; }
      else { int rs = rbase - MP + c8, bb = rs >> 5, tt = rs & 31; o = SB_T + ((size_t)((bb * 4 + hh) * 128 + e)) * 32 + tt; }
      nt_store_u4(dst + o, *(const uint4*)(sT + e * ST_LD + c8));
    }
  } else if (region == 3 || region == 4 || region == 6) {
    stage_rm(sT, acc, 1.f);
    __syncthreads();
    copyout_bf16_nt(sT, (bfu*)(P.ws + SLOT(region == 3 ? 5 : (region == 4 ? 6 : 8))) + (size_t)rbase * 512 + hh * 128, 512);
  } else {
    int gi = nt - 28;
    stage_rm(sT, acc, 1.f);
    __syncthreads();
    copyout_bf16_nt(sT, (bfu*)(P.ws + SLOT(gi < 8 ? 9 : 11)) + (size_t)rbase * 1024 + (gi & 7) * 128, 1024);
  }

}

__device__ void phase_gemm1(const Params& P, char* smem) {
  const bfu* hbuf = (const bfu*)(P.ws + SLOT(0));
  const bfu* wt = (const bfu*)(P.ws + O_WT_IN);
  const float* ct = (const float*)(P.ws + O_COS); const float* stb = (const float*)(P.ws + O_SIN);
  for (int t = blockIdx.x; t < 130 * 44; t += gridDim.x) {
    int mt, nt; tile_map(t, 130, 44, mt, nt);
    f32x16 acc[4][2];
#pragma unroll
    for (int a = 0; a < 4; ++a)
#pragma unroll
      for (int b = 0; b < 2; ++b)
#pragma unroll
        for (int i = 0; i < 16; ++i) acc[a][b][i] = 0.f;
    gemm_acc256(acc, hbuf + (size_t)mt * 256 * 1024, 1024, wt + (size_t)nt * 128 * 1024, 1024, 1024, smem);
    gemm1_epilogue(P, smem, reinterpret_cast<f32x16(&)[2][2]>(acc[0]), mt * 256, nt, ct, stb);
    gemm1_epilogue(P, smem, reinterpret_cast<f32x16(&)[2][2]>(acc[2]), mt * 256 + 128, nt, ct, stb);
  }
}

__device__ void phase_conv(const Params& P) {
  const int gtid = blockIdx.x * NTHREADS + threadIdx.x, gstride = gridDim.x * NTHREADS;
  const bfu* xm = (const bfu*)(P.ws + SLOT(6));
  bfu* cb = (bfu*)(P.ws + SLOT(0));
  for (int i = gtid; i < MT * 64; i += gstride) {
    int r = i >> 6, c0 = (i & 63) * 8;
    int t, T, bb; bool prompt = r < MP;
    if (prompt) { bb = r >> 13; t = r & 8191; T = 8192; } else { int rs = r - MP; bb = rs >> 5; t = rs & 31; T = 32; }
    float y[8];
#pragma unroll
    for (int j = 0; j < 8; ++j) y[j] = P.conv_b[c0 + j];
#pragma unroll
    for (int k = 0; k < 4; ++k) {
      int tt = t - 3 + k;
      float xv[8];
      if (tt >= 0) {
        uint4 v = *(const uint4*)(xm + (size_t)(r - 3 + k) * 512 + c0);
        xv[0] = bf2f(v.x & 0xffff); xv[1] = bf2f(v.x >> 16); xv[2] = bf2f(v.y & 0xffff); xv[3] = bf2f(v.y >> 16);
        xv[4] = bf2f(v.z & 0xffff); xv[5] = bf2f(v.z >> 16); xv[6] = bf2f(v.w & 0xffff); xv[7] = bf2f(v.w >> 16);
      } else if (!prompt) {
        const float* sp = P.st_conv + (size_t)(bb * 3 + (tt + 3)) * 512 + c0;
#pragma unroll
        for (int j = 0; j < 8; ++j) xv[j] = sp[j];
      } else {
#pragma unroll
        for (int j = 0; j < 8; ++j) xv[j] = 0.f;
      }
#pragma unroll
      for (int j = 0; j < 8; ++j) y[j] += xv[j] * P.conv_w[k * 512 + c0 + j];
    }
    if (t >= T - 3) {
      uint4 v = *(const uint4*)(xm + (size_t)r * 512 + c0);
      float* dst = (prompt ? P.out + OO_CONVP : P.out + OO_CONVS) + (size_t)(bb * 3 + (t - (T - 3))) * 512 + c0;
      dst[0] = bf2f(v.x & 0xffff); dst[1] = bf2f(v.x >> 16); dst[2] = bf2f(v.y & 0xffff); dst[3] = bf2f(v.y >> 16);
      dst[4] = bf2f(v.z & 0xffff); dst[5] = bf2f(v.z >> 16); dst[6] = bf2f(v.w & 0xffff); dst[7] = bf2f(v.w >> 16);
    }
    uint4 o;
#pragma unroll
    for (int j = 0; j < 8; ++j) y[j] = y[j] * sigmoidf_(y[j]);
    o.x = pack2(y[0], y[1]); o.y = pack2(y[2], y[3]); o.z = pack2(y[4], y[5]); o.w = pack2(y[6], y[7]);
    *(uint4*)(cb + (size_t)r * 512 + c0) = o;
  }
}

__device__ void m_fold(const Params& P) {
  const int lane = threadIdx.x & 63, w = threadIdx.x >> 6;
  const float* FL = (const float*)(P.ws + O_FL); const float* UC = (const float*)(P.ws + O_UC);
  float* MCS = (float*)(P.ws + O_MCS);
  const int slot = (int)gridDim.x - 1 - (int)blockIdx.x;
  if (w == 3 && slot < 16) {
    const int bh = slot, b = bh >> 2, h = bh & 3;
    const int c0 = 2 * lane;
    const float fl0 = FL[(b * 128 + c0) * 4 + h], uc0 = UC[(b * 128 + c0) * 4 + h];
    const float fl1 = FL[(b * 128 + c0 + 1) * 4 + h], uc1 = UC[(b * 128 + c0 + 1) * 4 + h];
    float a = fl0 + fl1, bb = fmaxf(fl0 + uc0 + fl1, fl1 + uc1);
#pragma unroll
    for (int o = 1; o < 64; o <<= 1) {
      float ap = __shfl_up(a, o), bp = __shfl_up(bb, o);
      if (lane >= o) { bb = fmaxf(bp + a, bb); a = ap + a; }
    }
    float ae = __shfl_up(a, 1), be = __shfl_up(bb, 1);
    float m0 = lane == 0 ? 0.f : fmaxf(ae, be);
    float m1 = fl0 + fmaxf(m0, uc0);
    MCS[bh * 128 + c0] = m0;
    MCS[bh * 128 + c0 + 1] = m1;
  }
  const int gtid = blockIdx.x * NTHREADS + threadIdx.x;
  if (gtid < 64) MCS[2048 + gtid] = P.st_m[gtid];
}
__device__ void phase_mqk(const Params& P, char* smem) {
  bfu* sA = (bfu*)smem; bfu* sB = sA + 128 * 72;
  const bfu* cb = (const bfu*)(P.ws + SLOT(0));
  for (int t = blockIdx.x; t < 260 * 8; t += gridDim.x) {
    int mt = t >> 3, which = (t >> 2) & 1, hh = t & 3;
    const bfu* wt = (const bfu*)(P.ws + (which ? O_WT_MK : O_WT_MQ)) + hh * 16384;
    f32x16 acc[2][2]; zero_acc(acc);
    gemm_acc(acc, cb + (size_t)mt * 128 * 512 + hh * 128, 512, wt, 128, 128, sA, sB);
    bfu* dst = (bfu*)(P.ws + SLOT(which ? 13 : 1));
    float sc = which ? 0.08838834764831845f : 1.f;
    bfu* sT = (bfu*)smem;
    __syncthreads();
    stage_rm(sT, acc, sc);
    __syncthreads();
    copyout_bf16(sT, dst + (size_t)mt * 128 * 512 + hh * 128, 512);
  }
}

struct Item { int b, h, c, row0, L, T, chunk, bh; bool prompt; size_t vt_off; };
__device__ __forceinline__ Item decode_item(int idx) {
  Item it;
  if (idx < 2048) {
    it.prompt = true; it.b = idx >> 9; it.h = (idx >> 7) & 3; it.c = idx & 127; it.row0 = it.b * 8192 + it.c * 64;
    it.L = 64; it.T = 8192; it.chunk = it.b * 128 + it.c; it.bh = it.b * 4 + it.h;
    it.vt_off = ((size_t)(it.bh * 128)) * 8192 + it.c * 64;
  } else {
    int si = idx - 2048; it.prompt = false; it.b = si >> 2; it.h = si & 3; it.c = 0; it.row0 = MP + it.b * 32;
    it.L = 32; it.T = 32; it.chunk = 512 + it.b; it.bh = it.b * 4 + it.h;
    it.vt_off = SB_T + ((size_t)(it.bh * 128)) * 32;
  }
  return it;
}
__device__ __forceinline__ bfu* ds_ptr(const Params& P, int mixer, int idx) {
  if (idx < 2048) return (bfu*)P.out + ((size_t)(mixer * 2048 + idx)) * 16384;
  return (bfu*)(P.ws + O_DSS) + ((size_t)(mixer * 64 + (idx - 2048))) * 16384;
}
__device__ __forceinline__ float ret_lg(int h) { return log1pf(-exp2f(-5.f - (float)h)); }

__device__ void phaseA_item(const Params& P, int mixer, int idx, char* smem) {
  const int tid = threadIdx.x, lane = tid & 63, w = tid >> 6, wm = w & 1, wn = w >> 1;
  Item it = decode_item(idx);
  bfu* sK = (bfu*)smem; bfu* sV = sK + 128 * 72;
  float* sw = (float*)(sV + 128 * 72);
  float* sm = sw + 64;
  const int L = it.L, h = it.h;
  const bfu* Ksrc = (const bfu*)(P.ws + SLOT(mixer == 0 ? 3 : 13)) + (size_t)it.row0 * 512 + h * 128;
  const bfu* Vsrc = (const bfu*)(P.ws + SLOT(mixer == 0 ? 4 : 7)) + it.vt_off;
  uint4 kreg[4], vreg[4];
#pragma unroll
  for (int i = 0; i < 4; ++i) {
    int id = tid + i * 256, s = id & 63, dc = (id >> 6) * 8;
    kreg[i] = make_uint4(0, 0, 0, 0);
    if (s < L) kreg[i] = *(const uint4*)(Ksrc + (size_t)s * 512 + dc);
    int e = id >> 3, sc = (id & 7) * 8;
    vreg[i] = make_uint4(0, 0, 0, 0);
    if (sc < L) vreg[i] = *(const uint4*)(Vsrc + (size_t)e * it.T + sc);
  }
  if (mixer == 0) {
    if (tid < 64) { float lg = ret_lg(h); sw[tid] = tid < L ? __expf(lg * (float)(L - 1 - tid)) : 0.f; }
  } else {
    const float* FL = (const float*)(P.ws + O_FL); const float* UC = (const float*)(P.ws + O_UC);
    float mc = ((const float*)(P.ws + O_MCS))[idx];
    float Ml = fmaxf(mc, UC[it.chunk * 4 + h]);
    if (tid < 64) sw[tid] = tid < L ? __expf(((const float*)(P.ws + O_UQ))[(size_t)(it.row0 + tid) * 4 + h] - Ml) : 0.f;
    if (tid == 0) {
      ((float*)(P.ws + O_AEND))[idx] = __expf(mc - Ml);
      if (!it.prompt) P.out[OO_MS + it.bh] = FL[it.chunk * 4 + h] + Ml;
      else if (it.c == 127) P.out[OO_MP + it.bh] = FL[it.chunk * 4 + h] + Ml;
    }
  }
  __syncthreads();
#pragma unroll
  for (int i = 0; i < 4; ++i) {
    int id = tid + i * 256, s = id & 63, dc = (id >> 6) * 8;
    uint4 v = kreg[i];
    float ww = sw[s];
    unsigned vv[4] = {v.x, v.y, v.z, v.w};
#pragma unroll
    for (int j = 0; j < 4; ++j) {
      sK[(dc + 2 * j) * 72 + s] = f2bf(bf2f(vv[j] & 0xffff) * ww);
      sK[(dc + 2 * j + 1) * 72 + s] = f2bf(bf2f(vv[j] >> 16) * ww);
    }
  }
#pragma unroll
  for (int i = 0; i < 4; ++i) {
    int id = tid + i * 256, e = id >> 3, sc = (id & 7) * 8;
    *(uint4*)(sV + e * 72 + sc) = vreg[i];
  }
  __syncthreads();
  f32x16 acc[2][2]; zero_acc(acc);
#pragma unroll
  for (int ks = 0; ks < 4; ++ks) {
    bf16x8 af[2], bfr[2];
#pragma unroll
    for (int mi = 0; mi < 2; ++mi)
      af[mi] = *(const bf16x8*)(sK + (wm * 64 + mi * 32 + (lane & 31)) * 72 + ks * 16 + (lane >> 5) * 8);
#pragma unroll
    for (int ni = 0; ni < 2; ++ni)
      bfr[ni] = *(const bf16x8*)(sV + (wn * 32 + ni * 64 + (lane & 31)) * 72 + ks * 16 + (lane >> 5) * 8);
#pragma unroll
    for (int mi = 0; mi < 2; ++mi)
#pragma unroll
      for (int ni = 0; ni < 2; ++ni)
        acc[mi][ni] = __builtin_amdgcn_mfma_f32_32x32x16_bf16(af[mi], bfr[ni], acc[mi][ni], 0, 0, 0);
  }
  bfu* dS = ds_ptr(P, mixer, idx);
  bfu* sD = (bfu*)(smem + 40960);
  {
    EPI_BEGIN
#pragma unroll
      for (int ni = 0; ni < 2; ++ni) {
        int e = cl + ni * 64;
        uint2 o; o.x = pack2(acc[mi][ni][q * 4 + 0], acc[mi][ni][q * 4 + 1]); o.y = pack2(acc[mi][ni][q * 4 + 2], acc[mi][ni][q * 4 + 3]);
        *(uint2*)(sD + e * 136 + r0) = o;
      }
    EPI_END
  }
  __syncthreads();
#pragma unroll
  for (int i = 0; i < 8; ++i) {
    int id = tid + i * 256, e = id >> 4, c8 = (id & 15) * 8;
    *(uint4*)(dS + e * 128 + c8) = *(const uint4*)(sD + e * 136 + c8);
  }
  if (mixer == 1 && tid < 128) {
    float s = 0.f;
#pragma unroll
    for (int j = 0; j < 8; ++j) { float f[8]; unpack8(*(const uint4*)(sK + tid * 72 + j * 8), f);
#pragma unroll
      for (int k = 0; k < 8; ++k) s += f[k]; }
    ((float*)(P.ws + O_DN))[(size_t)idx * 128 + tid] = s;
  }
  __syncthreads();
}

__device__ void phase_scan(const Params& P) {
  const int gtid = blockIdx.x * NTHREADS + threadIdx.x, gstride = gridDim.x * NTHREADS;
  const float* AE = (const float*)(P.ws + O_AEND);
  for (int i = gtid; i < 131072; i += gstride) {
    int mixer = i >> 16, bh = (i >> 12) & 15, eo = (i & 4095) * 4;
    int h = bh & 3;
    float gch = __expf(ret_lg(h) * 64.f);
    float st[4];
#pragma unroll
    for (int j = 0; j < 4; ++j) st[j] = 0.f;
    bfu* base = (bfu*)P.out + ((size_t)(mixer * 2048 + bh * 128)) * 16384 + eo;
    for (int c = 0; c < 128; c += 8) {
      uint2 v[8];
#pragma unroll
      for (int k = 0; k < 8; ++k) v[k] = *(const uint2*)(base + (size_t)(c + k) * 16384);
#pragma unroll
      for (int k = 0; k < 8; ++k) {
        float dec = mixer == 0 ? gch : AE[bh * 128 + c + k];
        float d0 = bf2f(v[k].x & 0xffff), d1 = bf2f(v[k].x >> 16), d2 = bf2f(v[k].y & 0xffff), d3 = bf2f(v[k].y >> 16);
        uint2 o; o.x = pack2(st[0], st[1]); o.y = pack2(st[2], st[3]);
        *(uint2*)(base + (size_t)(c + k) * 16384) = o;
        st[0] = dec * st[0] + d0; st[1] = dec * st[1] + d1; st[2] = dec * st[2] + d2; st[3] = dec * st[3] + d3;
      }
    }
    float* o = P.out + (mixer == 0 ? OO_RETP : OO_CP) + (size_t)bh * 16384;
    int e = eo >> 7, d0i = eo & 127;
#pragma unroll
    for (int j = 0; j < 4; ++j) o[(d0i + j) * 128 + e] = st[j];
  }
  for (int i = gtid; i < 2 * 64 * 2048; i += gstride) {
    int mixer = i >> 17, bh = (i >> 11) & 63, eo = (i & 2047) * 8;
    int h = bh & 3;
    int e = eo >> 7, d0 = eo & 127;
    const float* s0 = (mixer == 0 ? P.st_ret : P.st_C) + (size_t)bh * 16384;
    float st[8];
#pragma unroll
    for (int j = 0; j < 8; ++j) st[j] = s0[(d0 + j) * 128 + e];
    bfu* p = (bfu*)(P.ws + O_DSS) + ((size_t)(mixer * 64 + bh)) * 16384 + eo;
    float d[8]; unpack8(*(const uint4*)p, d);
    *(uint4*)p = pack8(st);
    float dec = mixer == 0 ? __expf(ret_lg(h) * 32.f) : AE[2048 + bh];
    float* o = P.out + (mixer == 0 ? OO_RETS : OO_CS) + (size_t)bh * 16384;
#pragma unroll
    for (int j = 0; j < 8; ++j) o[(d0 + j) * 128 + e] = dec * st[j] + d[j];
  }
  float* DN = (float*)(P.ws + O_DN);
  for (int i = gtid; i < 16 * 128; i += gstride) {
    int bh = i >> 7, d = i & 127;
    float n = 0.f;
    for (int c0 = 0; c0 < 128; c0 += 16) {
      float v[16], ae[16];
#pragma unroll
      for (int k = 0; k < 16; ++k) { v[k] = DN[(size_t)(bh * 128 + c0 + k) * 128 + d]; ae[k] = AE[bh * 128 + c0 + k]; }
#pragma unroll
      for (int k = 0; k < 16; ++k) { DN[(size_t)(bh * 128 + c0 + k) * 128 + d] = n; n = ae[k] * n + v[k]; }
    }
    P.out[OO_NP + i] = n;
  }
  for (int i = gtid; i < 64 * 128; i += gstride) {
    int bh = i >> 7, d = i & 127;
    size_t o = (size_t)(2048 + bh) * 128 + d;
    float n0 = P.st_n[i]; float v = DN[o]; DN[o] = n0;
    P.out[OO_NS + i] = AE[2048 + bh] * n0 + v;
  }
}

__device__ void phaseC_item(const Params& P, int mixer, int idx, char* smem) {
  const int tid = threadIdx.x, lane = tid & 63, w = tid >> 6;
  Item it = decode_item(idx);
  const int L = it.L, h = it.h;
  bfu* sQ = (bfu*)smem;
  bfu* sKV = sQ + 64 * 136;
  bfu* sP = sKV + 128 * 72;
  bfu* sS = sP + 64 * 72;
  float* sO = (float*)sS;
  float* sRow = (float*)(sS + 128 * 136);
  const bfu* Qsrc = (const bfu*)(P.ws + SLOT(mixer == 0 ? 2 : 1)) + (size_t)it.row0 * 512 + h * 128;
  const bfu* Ksrc = (const bfu*)(P.ws + SLOT(mixer == 0 ? 3 : 13)) + (size_t)it.row0 * 512 + h * 128;
  const bfu* Vsrc = (const bfu*)(P.ws + SLOT(mixer == 0 ? 4 : 7)) + it.vt_off;
  const bfu* Ssrc = ds_ptr(P, mixer, idx);
  const float lg = ret_lg(h);
  uint4 vpre[4];
#pragma unroll
  for (int i = 0; i < 4; ++i) {
    int id = tid + i * 256, e = id >> 3, sc = (id & 7) * 8;
    vpre[i] = make_uint4(0, 0, 0, 0);
    if (sc < L) vpre[i] = *(const uint4*)(Vsrc + (size_t)e * it.T + sc);
  }
#pragma unroll
  for (int i = 0; i < 4; ++i) {
    int id = tid + i * 256, s = id >> 4, dc = (id & 15) * 8;
    uint4 vq = make_uint4(0, 0, 0, 0), vk = vq;
    if (s < L) { vq = *(const uint4*)(Qsrc + (size_t)s * 512 + dc); vk = *(const uint4*)(Ksrc + (size_t)s * 512 + dc); }
    *(uint4*)(sQ + s * 136 + dc) = vq;
    *(uint4*)(sKV + s * 136 + dc) = vk;
  }
#pragma unroll
  for (int i = 0; i < 8; ++i) {
    int id = tid + i * 256, e = id >> 4, dc = (id & 15) * 8;
    *(uint4*)(sS + e * 136 + dc) = *(const uint4*)(Ssrc + e * 128 + dc);
  }
  if (tid < 64) {
    int i = tid;
    if (mixer == 0) {
      sRow[128 + i] = __expf(lg * (float)(i + 1));
    } else {
      float mc = ((const float*)(P.ws + O_MCS))[idx];
      size_t gi = (size_t)(it.row0 + i) * 4 + h;
      bool valid = i < L;
      float u = valid ? ((const float*)(P.ws + O_UQ))[gi] : -INFINITY;
      float M = valid ? fmaxf(mc, ((const float*)(P.ws + O_CMQ))[gi]) : 0.f;
      float F = valid ? ((const float*)(P.ws + O_FQ))[gi] : 0.f;
      sRow[i] = u; sRow[64 + i] = M; sRow[128 + i] = valid ? __expf(mc - M) : 0.f;
      sRow[256 + i] = __expf(-(F + M));
    }
  }
  __syncthreads();
  {
    const int mi = w & 1, ni = w >> 1;
    f32x16 acc;
#pragma unroll
    for (int i = 0; i < 16; ++i) acc[i] = 0.f;
#pragma unroll 2
    for (int ks = 0; ks < 8; ++ks) {
      bf16x8 af = *(const bf16x8*)(sQ + (mi * 32 + (lane & 31)) * 136 + ks * 16 + (lane >> 5) * 8);
      bf16x8 bfr = *(const bf16x8*)(sKV + (ni * 32 + (lane & 31)) * 136 + ks * 16 + (lane >> 5) * 8);
      acc = __builtin_amdgcn_mfma_f32_32x32x16_bf16(af, bfr, acc, 0, 0, 0);
    }
    const int s = ni * 32 + (lane & 31);
    float us = mixer ? sRow[s] : 0.f;
#pragma unroll
    for (int reg = 0; reg < 16; ++reg) {
      int i = mi * 32 + (reg & 3) + 8 * (reg >> 2) + 4 * (lane >> 5);
      float wgt;
      if (mixer == 0) wgt = (s <= i) ? __expf(lg * (float)(i - s)) : 0.f;
      else wgt = (s <= i && i < L) ? __expf(us - sRow[64 + i]) : 0.f;
      sP[i * 72 + s] = f2bf(acc[reg] * wgt);
    }
  }
  __syncthreads();
#pragma unroll
  for (int i = 0; i < 4; ++i) {
    int id = tid + i * 256, e = id >> 3, sc = (id & 7) * 8;
    *(uint4*)(sKV + e * 72 + sc) = vpre[i];
  }
  __syncthreads();
  f32x16 acc1[2], acc2[2];
  const int mi = w & 1, nj = w >> 1;
#pragma unroll
  for (int t = 0; t < 2; ++t)
#pragma unroll
    for (int i = 0; i < 16; ++i) { acc1[t][i] = 0.f; acc2[t][i] = 0.f; }
#pragma unroll 2
  for (int ks = 0; ks < 4; ++ks) {
    bf16x8 af = *(const bf16x8*)(sP + (mi * 32 + (lane & 31)) * 72 + ks * 16 + (lane >> 5) * 8);
#pragma unroll
    for (int t = 0; t < 2; ++t) {
      bf16x8 bfr = *(const bf16x8*)(sKV + (nj * 64 + t * 32 + (lane & 31)) * 72 + ks * 16 + (lane >> 5) * 8);
      acc1[t] = __builtin_amdgcn_mfma_f32_32x32x16_bf16(af, bfr, acc1[t], 0, 0, 0);
    }
  }
#pragma unroll 2
  for (int ks = 0; ks < 8; ++ks) {
    bf16x8 af = *(const bf16x8*)(sQ + (mi * 32 + (lane & 31)) * 136 + ks * 16 + (lane >> 5) * 8);
#pragma unroll
    for (int t = 0; t < 2; ++t) {
      bf16x8 bfr = *(const bf16x8*)(sS + (nj * 64 + t * 32 + (lane & 31)) * 136 + ks * 16 + (lane >> 5) * 8);
      acc2[t] = __builtin_amdgcn_mfma_f32_32x32x16_bf16(af, bfr, acc2[t], 0, 0, 0);
    }
  }
  if (mixer == 1) {
    int i = tid >> 2, part = tid & 3;
    const float* nprev = (const float*)(P.ws + O_DN) + (size_t)idx * 128;
    float dl = 0.f, qn = 0.f;
#pragma unroll 4
    for (int s = part * 16; s < part * 16 + 16; ++s) dl += bf2f(sP[i * 72 + s]);
#pragma unroll 4
    for (int d = part * 32; d < part * 32 + 32; ++d) qn += bf2f(sQ[i * 136 + d]) * nprev[d];
    dl += __shfl_xor(dl, 1); dl += __shfl_xor(dl, 2);
    qn += __shfl_xor(qn, 1); qn += __shfl_xor(qn, 2);
    if (part == 0) {
      float den = dl + sRow[128 + i] * qn;
      sRow[192 + i] = 1.f / fmaxf(fabsf(den), sRow[256 + i]);
    }
  }
  __syncthreads();
#pragma unroll
  for (int t = 0; t < 2; ++t) {
    int e = nj * 64 + t * 32 + (lane & 31);
#pragma unroll
    for (int reg = 0; reg < 16; ++reg) {
      int i = mi * 32 + (reg & 3) + 8 * (reg >> 2) + 4 * (lane >> 5);
      float o = acc1[t][reg] + sRow[128 + i] * acc2[t][reg];
      if (mixer == 1) o *= sRow[192 + i];
      sO[i * 132 + e] = o;
    }
  }
  __syncthreads();
  {
    int i = tid >> 2, part = tid & 3;
    float ss = 0.f;
#pragma unroll 4
    for (int e = part * 32; e < part * 32 + 32; ++e) { float v = sO[i * 132 + e]; ss += v * v; }
    ss += __shfl_xor(ss, 1); ss += __shfl_xor(ss, 2);
    float rstd = rsqrtf(ss * (1.f / 128.f) + EPS);
    if (i < L) {
      size_t ro = (size_t)(it.row0 + i) * 512 + h * 128 + part * 32;
      const float* so = sO + i * 132 + part * 32;
      if (mixer == 0) {
        bfu* y = (bfu*)(P.ws + SLOT(5)) + ro;
        const float* g = P.g_ret_gn + h * 128 + part * 32;
        uint4 gv[4];
#pragma unroll
        for (int k = 0; k < 4; ++k) gv[k] = *(const uint4*)(y + k * 8);
#pragma unroll
        for (int k = 0; k < 4; ++k) {
          float gt[8], o[8];
          unpack8(gv[k], gt);
#pragma unroll
          for (int j = 0; j < 8; ++j) o[j] = gt[j] * sigmoidf_(gt[j]) * so[k * 8 + j] * rstd * g[k * 8 + j];
          *(uint4*)(y + k * 8) = pack8(o);
        }
      } else {
        bfu* y = (bfu*)(P.ws + SLOT(8)) + ro;
        const bfu* cc = (const bfu*)(P.ws + SLOT(0)) + ro;
        const float* g = P.g_ml_gn + h * 128 + part * 32;
        const float* ws = P.w_skip + h * 128 + part * 32;
        uint4 gv[4], cv[4];
#pragma unroll
        for (int k = 0; k < 4; ++k) { gv[k] = *(const uint4*)(y + k * 8); cv[k] = *(const uint4*)(cc + k * 8); }
#pragma unroll
        for (int k = 0; k < 4; ++k) {
          float gt[8], c8[8], o[8];
          unpack8(gv[k], gt); unpack8(cv[k], c8);
#pragma unroll
          for (int j = 0; j < 8; ++j) o[j] = sigmoidf_(gt[j]) * (so[k * 8 + j] * rstd * g[k * 8 + j] + ws[k * 8 + j] * c8[j]);
          *(uint4*)(y + k * 8) = pack8(o);
        }
      }
    }
  }
  __syncthreads();
}

__device__ void phase_merge(const Params& P, char* smem) {
  bfu* sA = (bfu*)smem; bfu* sB = sA + 128 * 72;
  const bfu* yr = (const bfu*)(P.ws + SLOT(5)); const bfu* ym = (const bfu*)(P.ws + SLOT(8));
  const bfu* gr = (const bfu*)(P.ws + SLOT(9)); const bfu* gm = (const bfu*)(P.ws + SLOT(11));
  bfu* mg = (bfu*)(P.ws + SLOT(6));
  for (int t = blockIdx.x; t < 260 * 8; t += gridDim.x) {
    int mt, nt; tile_map(t, 260, 8, mt, nt);
    f32x16 acc[2][2]; zero_acc(acc);
    bfu* sT = (bfu*)smem;
    const size_t tbase = (size_t)mt * 128 * 1024 + nt * 128;
    uint4 t1[8];
    gemm_acc(acc, yr + (size_t)mt * 128 * 512, 512, (const bfu*)(P.ws + O_WT_UPR) + (size_t)nt * 128 * 512, 512, 512, sA, sB);
    __syncthreads();
    stage_rm(sT, acc, 1.f);
    __syncthreads();
#pragma unroll
    for (int i = 0; i < 8; ++i) {
      int id = threadIdx.x + i * 256, row = id >> 4, c8 = (id & 15) * 8;
      float a[8], g[8];
      unpack8(*(const uint4*)(sT + row * ST_LD + c8), a);
      unpack8(*(const uint4*)(gr + tbase + (size_t)row * 1024 + c8), g);
#pragma unroll
      for (int j = 0; j < 8; ++j) a[j] *= sigmoidf_(g[j]);
      t1[i] = pack8(a);
    }
    zero_acc(acc);
    gemm_acc(acc, ym + (size_t)mt * 128 * 512, 512, (const bfu*)(P.ws + O_WT_UPM) + (size_t)nt * 128 * 512, 512, 512, sA, sB);
    __syncthreads();
    stage_rm(sT, acc, 1.f);
    __syncthreads();
#pragma unroll
    for (int i = 0; i < 8; ++i) {
      int id = threadIdx.x + i * 256, row = id >> 4, c8 = (id & 15) * 8;
      float a[8], g[8], t[8];
      unpack8(*(const uint4*)(sT + row * ST_LD + c8), a);
      unpack8(*(const uint4*)(gm + tbase + (size_t)row * 1024 + c8), g);
      unpack8(t1[i], t);
#pragma unroll
      for (int j = 0; j < 8; ++j) a[j] = t[j] + a[j] * sigmoidf_(g[j]);
      *(uint4*)(mg + tbase + (size_t)row * 1024 + c8) = pack8(a);
    }
  }
}

__device__ void phase_outproj(const Params& P, char* smem) {
  bfu* sA = (bfu*)smem; bfu* sB = sA + 128 * 72;
  const bfu* mg = (const bfu*)(P.ws + SLOT(6));
  for (int t = blockIdx.x; t < 260 * 8; t += gridDim.x) {
    int mt, nt; tile_map(t, 260, 8, mt, nt);
    f32x16 acc[2][2]; zero_acc(acc);
    gemm_acc(acc, mg + (size_t)mt * 128 * 1024, 1024, (const bfu*)(P.ws + O_WT_OUT) + (size_t)nt * 128 * 1024, 1024, 1024, sA, sB);
    float* sT32 = (float*)smem;
    __syncthreads();
    {
      EPI_BEGIN
#pragma unroll
        for (int j = 0; j < 4; ++j) {
          sT32[(r0 + j) * ST32_LD + cl] = acc[mi][0][q * 4 + j];
          sT32[(r0 + j) * ST32_LD + cl + 64] = acc[mi][1][q * 4 + j];
        }
      EPI_END
    }
    __syncthreads();
#pragma unroll
    for (int i = 0; i < 16; ++i) {
      int id = threadIdx.x + i * 256, row = id >> 5, c4 = (id & 31) * 4;
      int r = mt * 128 + row;
      float4 a = *(const float4*)(sT32 + row * ST32_LD + c4);
      float4 x = *(const float4*)(xrow(P, r) + nt * 128 + c4);
      float4 o = make_float4(x.x + a.x, x.y + a.y, x.z + a.z, x.w + a.w);
      *(float4*)(P.out + (size_t)r * 1024 + nt * 128 + c4) = o;
      float4 g = *(const float4*)(P.g_ffn + nt * 128 + c4);
      uint2 hv; hv.x = pack2(o.x * g.x, o.y * g.y); hv.y = pack2(o.z * g.z, o.w * g.w);
      *(uint2*)((bfu*)(P.ws + SLOT(0)) + (size_t)r * 1024 + nt * 128 + c4) = hv;
      float ss = o.x * o.x + o.y * o.y + o.z * o.z + o.w * o.w;
      ss = dpp_ror_add(ss, 8); ss = dpp_ror_add(ss, 4); ss = dpp_ror_add(ss, 2); ss = dpp_ror_add(ss, 1);
      ss += __shfl_xor(ss, 16);
      if ((threadIdx.x & 31) == 0) ((float*)(P.ws + O_GPRE))[(size_t)r * 8 + nt] = ss;
    }
  }
}

__device__ void phase_norm_rows(const Params& P, const float* g, bfu* dst) {
  const int lane = threadIdx.x & 63, w = threadIdx.x >> 6;
  for (int r = blockIdx.x * 4 + w; r < MT; r += gridDim.x * 4) {
    const float* xr = P.out + (size_t)r * 1024;
    float4 v[4]; float ss = 0.f;
#pragma unroll
    for (int i = 0; i < 4; ++i) {
      v[i] = *(const float4*)(xr + i * 256 + lane * 4);
      ss += v[i].x * v[i].x + v[i].y * v[i].y + v[i].z * v[i].z + v[i].w * v[i].w;
    }
    ss = wave_sum(ss);
    float rstd = rsqrtf(ss * (1.f / 1024.f) + EPS);
#pragma unroll
    for (int i = 0; i < 4; ++i) {
      float4 gg = *(const float4*)(g + i * 256 + lane * 4);
      uint2 o; o.x = pack2(v[i].x * rstd * gg.x, v[i].y * rstd * gg.y); o.y = pack2(v[i].z * rstd * gg.z, v[i].w * rstd * gg.w);
      *(uint2*)(dst + (size_t)r * 1024 + i * 256 + lane * 4) = o;
    }
  }
}

__device__ void phase_pq(const Params& P, char* smem) {
  bfu* sA = (bfu*)smem; bfu* sB = sA + 128 * 72;
  const bfu* hq = (const bfu*)(P.ws + SLOT(0));
  bfu* qb = (bfu*)(P.ws + SLOT(9));
  for (int t = blockIdx.x; t < 260 * 16; t += gridDim.x) {
    int mt, nt; tile_map(t, 260, 16, mt, nt);
    f32x16 acc[2][2]; zero_acc(acc);
    float* sRstd = (float*)(smem + 66048);
    if (threadIdx.x < 128) {
      const float* pp = (const float*)(P.ws + O_GPRE) + (size_t)(mt * 128 + threadIdx.x) * 8;
      float4 p0 = *(const float4*)pp, p1 = *(const float4*)(pp + 4);
      sRstd[threadIdx.x] = rsqrtf((p0.x + p0.y + p0.z + p0.w + p1.x + p1.y + p1.z + p1.w) * (1.f / 1024.f) + EPS);
    }
    gemm_acc(acc, hq + (size_t)mt * 128 * 1024, 1024, (const bfu*)(P.ws + O_WT_PQ) + (size_t)nt * 128 * 1024, 1024, 1024, sA, sB);
    bfu* sT = (bfu*)smem;
    __syncthreads();
    {
      EPI_BEGIN
#pragma unroll
        for (int j = 0; j < 4; ++j) {
          const float rs = sRstd[r0 + j];
          sT[(r0 + j) * ST_LD + cl] = f2bf(acc[mi][0][q * 4 + j] * rs);
          sT[(r0 + j) * ST_LD + cl + 64] = f2bf(acc[mi][1][q * 4 + j] * rs);
        }
      EPI_END
    }
    __syncthreads();
    copyout_bf16(sT, qb + (size_t)mt * 128 * 2048 + nt * 128, 2048);
  }
}


template <bool DESC> __device__ __forceinline__ void cex(float& a, float& b) {
  float mx = fmaxf(a, b), mn = fminf(a, b);
  a = DESC ? mx : mn; b = DESC ? mn : mx;
}
template <int B, bool DESC> __device__ __forceinline__ void bmerge16(float (&v)[64]) {
#pragma unroll
  for (int j = 8; j > 0; j >>= 1)
#pragma unroll
    for (int i = 0; i < 16; ++i) { int l = i ^ j; if (l > i) cex<DESC>(v[B + i], v[B + l]); }
}
template <int B, bool DESC> __device__ __forceinline__ void bsort16(float (&v)[64]) {
#pragma unroll
  for (int k = 2; k <= 16; k <<= 1)
#pragma unroll
    for (int j = k >> 1; j > 0; j >>= 1)
#pragma unroll
      for (int i = 0; i < 16; ++i) {
        int l = i ^ j;
        if (l > i) {
          bool up = ((i & k) == 0) || (k == 16);
          if (up == true) { if (DESC) cex<true>(v[B + i], v[B + l]); else cex<false>(v[B + i], v[B + l]); }
          else { if (DESC) cex<false>(v[B + i], v[B + l]); else cex<true>(v[B + i], v[B + l]); }
        }
      }
}
__device__ __forceinline__ float pair_max(float v) {
  auto r = __builtin_amdgcn_permlane32_swap(__float_as_int(v), __float_as_int(v), false, false);
  return fmaxf(__int_as_float(r[0]), __int_as_float(r[1]));
}
__device__ void phase_topk(const Params& P, char* smem) {
  const int tid = threadIdx.x, lane = tid & 63, w = tid >> 6, r32 = lane & 31, hh = lane >> 5;
  unsigned* sL = (unsigned*)smem + w * 1664;
  unsigned* sW = sL + 32 * 33;
  const bfu* qb = (const bfu*)(P.ws + SLOT(9));
  const bfu* keys = (const bfu*)(P.ws + O_KEYS);
  int* ids = (int*)(P.ws + SLOT(4));
  float* gw = (float*)(P.ws + SLOT(13));
  for (int item = blockIdx.x * 4 + w; item < 1040 * 8; item += gridDim.x * 4) {
    const int tg = item >> 3, n = item & 7, rowb = tg * 32;
#pragma unroll 1
    for (int half = 0; half < 2; ++half) {
      f32x16 acc[4];
#pragma unroll
      for (int c = 0; c < 4; ++c)
#pragma unroll
        for (int i = 0; i < 16; ++i) acc[c][i] = 0.f;
      const bfu* kp = keys + (size_t)((n * 2 + half) * 128 + r32) * 128 + hh * 8;
      const bfu* qp = qb + (size_t)(rowb + r32) * 2048 + n * 256 + half * 128 + hh * 8;
#pragma unroll
      for (int ks = 0; ks < 8; ++ks) {
        bf16x8 bfr = *(const bf16x8*)(qp + ks * 16);
#pragma unroll
        for (int c = 0; c < 4; ++c) {
          bf16x8 af = *(const bf16x8*)(kp + (size_t)c * 32 * 128 + ks * 16);
          acc[c] = __builtin_amdgcn_mfma_f32_32x32x16_bf16(af, bfr, acc[c], 0, 0, 0);
        }
      }
      float kk[64];
#pragma unroll
      for (int c = 0; c < 4; ++c)
#pragma unroll
        for (int reg = 0; reg < 16; ++reg) {
          unsigned kidx = c * 32 + (reg & 3) + 8 * (reg >> 2) + 4 * hh;
          kk[c * 16 + reg] = __uint_as_float((__float_as_uint(acc[c][reg]) & ~127u) | kidx);
        }
      bsort16<0, true>(kk); bsort16<16, false>(kk); bsort16<32, false>(kk); bsort16<48, true>(kk);
#pragma unroll
      for (int i = 0; i < 16; ++i) { kk[i] = fmaxf(kk[i], kk[16 + i]); kk[32 + i] = fmaxf(kk[32 + i], kk[48 + i]); }
      bmerge16<0, true>(kk); bmerge16<32, false>(kk);
#pragma unroll
      for (int i = 0; i < 16; ++i) kk[i] = fmaxf(kk[i], kk[32 + i]);
      bmerge16<0, true>(kk);
      {
        float lo[16], hi[16];
#pragma unroll
        for (int i = 0; i < 16; ++i) {
          auto r = __builtin_amdgcn_permlane32_swap(__float_as_int(kk[i]), __float_as_int(kk[i]), false, false);
          lo[i] = __int_as_float(r[0]); hi[i] = __int_as_float(r[1]);
        }
#pragma unroll
        for (int i = 0; i < 16; ++i) kk[i] = fmaxf(lo[i], hi[15 - i]);
      }
      bmerge16<0, true>(kk);
      if (hh == 0) {
#pragma unroll
        for (int p = 0; p < 16; ++p) sL[r32 * 33 + half * 16 + p] = __float_as_uint(kk[p]);
      }
    }
    __builtin_amdgcn_fence(__ATOMIC_RELEASE, "workgroup");
    __builtin_amdgcn_wave_barrier();
    __builtin_amdgcn_fence(__ATOMIC_ACQUIRE, "workgroup");
    float x[4], y[16];
    {
      const unsigned* lx = sL + r32 * 33 + (hh ? 16 : 0);
      const unsigned* ly = sL + r32 * 33 + (hh ? 0 : 16);
#pragma unroll
      for (int i = 0; i < 4; ++i) x[i] = __uint_as_float(lx[i] & ~127u);
#pragma unroll
      for (int j = 0; j < 16; ++j) y[j] = __uint_as_float(ly[j] & ~127u);
    }
    float cd[25];
#define CAND(t, i, j) { float sv = x[i] + y[j]; unsigned code = hh ? ((j) << 4 | (i)) : ((i) << 4 | (j)); \
      cd[t] = __uint_as_float((__float_as_uint(sv) & ~255u) | code); }
    CAND(0, 0, 1) CAND(1, 0, 2) CAND(2, 0, 3) CAND(3, 0, 4) CAND(4, 0, 5) CAND(5, 0, 6) CAND(6, 0, 7) CAND(7, 0, 8)
    CAND(8, 0, 9) CAND(9, 0, 10) CAND(10, 0, 11) CAND(11, 0, 12) CAND(12, 0, 13) CAND(13, 0, 14) CAND(14, 0, 15)
    CAND(15, 1, 2) CAND(16, 1, 3) CAND(17, 1, 4) CAND(18, 1, 5) CAND(19, 1, 6) CAND(20, 1, 7) CAND(21, 2, 3) CAND(22, 2, 4)
    {
      float d0 = hh ? x[2] + y[2] : x[0] + y[0];
      float d1 = hh ? x[3] + y[3] : x[1] + y[1];
      unsigned c0 = hh ? 0x22u : 0x00u, c1 = hh ? 0x33u : 0x11u;
      cd[23] = __uint_as_float((__float_as_uint(d0) & ~255u) | c0);
      cd[24] = __uint_as_float((__float_as_uint(d1) & ~255u) | c1);
    }
    {
      float cv[64];
#pragma unroll
      for (int t = 0; t < 25; ++t) cv[t] = cd[t];
#pragma unroll
      for (int t = 25; t < 32; ++t) cv[t] = -INFINITY;
      bsort16<0, true>(cv); bsort16<16, false>(cv);
#pragma unroll
      for (int i = 0; i < 16; ++i) cv[i] = fmaxf(cv[i], cv[16 + i]);
      bmerge16<0, true>(cv);
      {
        float lo[16], hi[16];
#pragma unroll
        for (int i = 0; i < 16; ++i) {
          auto r = __builtin_amdgcn_permlane32_swap(__float_as_int(cv[i]), __float_as_int(cv[i]), false, false);
          lo[i] = __int_as_float(r[0]); hi[i] = __int_as_float(r[1]);
        }
#pragma unroll
        for (int i = 0; i < 16; ++i) cv[i] = fmaxf(lo[i], hi[15 - i]);
      }
      bmerge16<0, true>(cv);
      if (hh == 0) {
#pragma unroll
        for (int p = 0; p < 16; ++p) sW[r32 * 17 + p] = __float_as_uint(cv[p]);
      }
    }
    __builtin_amdgcn_fence(__ATOMIC_RELEASE, "workgroup");
    __builtin_amdgcn_wave_barrier();
    __builtin_amdgcn_fence(__ATOMIC_ACQUIRE, "workgroup");
    {
      const unsigned* la = sL + r32 * 33;
      unsigned c0 = sW[r32 * 17] & 255u;
      float scmax = __uint_as_float(la[c0 >> 4] & ~127u) + __uint_as_float(la[16 + (c0 & 15)] & ~127u);
      float ex[8]; int ee[8]; float sum = 0.f;
#pragma unroll
      for (int k = 0; k < 8; ++k) {
        unsigned code = sW[r32 * 17 + hh * 8 + k] & 255u;
        unsigned ka = la[code >> 4], kb = la[16 + (code & 15)];
        float sc = __uint_as_float(ka & ~127u) + __uint_as_float(kb & ~127u);
        ex[k] = __expf(sc - scmax);
        ee[k] = (int)((ka & 127u) * 128u + (kb & 127u));
        sum += ex[k];
      }
      sum += __shfl_xor(sum, 32);
      float inv = 1.f / sum;
      size_t o = (size_t)(rowb + r32) * 128 + n * 16 + hh * 8;
      *(int4*)(ids + o) = make_int4(ee[0], ee[1], ee[2], ee[3]);
      *(int4*)(ids + o + 4) = make_int4(ee[4], ee[5], ee[6], ee[7]);
      *(float4*)(gw + o) = make_float4(ex[0] * inv, ex[1] * inv, ex[2] * inv, ex[3] * inv);
      *(float4*)(gw + o + 4) = make_float4(ex[4] * inv, ex[5] * inv, ex[6] * inv, ex[7] * inv);
    }
    __builtin_amdgcn_wave_barrier();
  }
}

typedef float f2v __attribute__((ext_vector_type(2)));
#define U8_SCALE 512.f
#define V8_SCALE 128.f
__device__ void convert_fp8(const float* __restrict__ src, unsigned char* __restrict__ dst, size_t n16, float scale,
                            int gtid, int gstride) {
  for (size_t i = gtid; i < n16; i += gstride) {
    unsigned w[4];
#pragma unroll
    for (int k = 0; k < 4; ++k) {
      float4 a = *(const float4*)(src + i * 16 + k * 4);
      float v0 = fminf(fmaxf(a.x * scale, -448.f), 448.f), v1 = fminf(fmaxf(a.y * scale, -448.f), 448.f);
      float v2 = fminf(fmaxf(a.z * scale, -448.f), 448.f), v3 = fminf(fmaxf(a.w * scale, -448.f), 448.f);
      int t = 0;
      t = __builtin_amdgcn_cvt_pk_fp8_f32(v0, v1, t, false);
      t = __builtin_amdgcn_cvt_pk_fp8_f32(v2, v3, t, true);
      w[k] = (unsigned)t;
    }
    *(uint4*)(dst + i * 16) = make_uint4(w[0], w[1], w[2], w[3]);
  }
}
__device__ __forceinline__ float dot16_fp8(uint4 u, const f2v* x2) {
  f2v acc = __builtin_amdgcn_cvt_pk_f32_fp8((int)u.x, false) * x2[0];
  acc += __builtin_amdgcn_cvt_pk_f32_fp8((int)u.x, true) * x2[1];
  acc += __builtin_amdgcn_cvt_pk_f32_fp8((int)u.y, false) * x2[2];
  acc += __builtin_amdgcn_cvt_pk_f32_fp8((int)u.y, true) * x2[3];
  acc += __builtin_amdgcn_cvt_pk_f32_fp8((int)u.z, false) * x2[4];
  acc += __builtin_amdgcn_cvt_pk_f32_fp8((int)u.z, true) * x2[5];
  acc += __builtin_amdgcn_cvt_pk_f32_fp8((int)u.w, false) * x2[6];
  acc += __builtin_amdgcn_cvt_pk_f32_fp8((int)u.w, true) * x2[7];
  return acc.x + acc.y;
}
__device__ __forceinline__ void axpy16_fp8(f2v* o2, float cf, uint4 v) {
  f2v c = {cf, cf};
  o2[0] += c * __builtin_amdgcn_cvt_pk_f32_fp8((int)v.x, false);
  o2[1] += c * __builtin_amdgcn_cvt_pk_f32_fp8((int)v.x, true);
  o2[2] += c * __builtin_amdgcn_cvt_pk_f32_fp8((int)v.y, false);
  o2[3] += c * __builtin_amdgcn_cvt_pk_f32_fp8((int)v.y, true);
  o2[4] += c * __builtin_amdgcn_cvt_pk_f32_fp8((int)v.z, false);
  o2[5] += c * __builtin_amdgcn_cvt_pk_f32_fp8((int)v.z, true);
  o2[6] += c * __builtin_amdgcn_cvt_pk_f32_fp8((int)v.w, false);
  o2[7] += c * __builtin_amdgcn_cvt_pk_f32_fp8((int)v.w, true);
}
#define PEER_LOAD(u, v, b)                                                                   \
  _Pragma("unroll") for (int k = 0; k < 8; ++k) {                                            \
    int j = (b) * 8 + k;                                                                     \
    int e = __builtin_amdgcn_readlane((b) < 8 ? id0 : id1, j & 63);                          \
    u[k] = *(const uint4*)(U8 + (size_t)e * 1024 + lane * 16);                               \
    v[k] = *(const uint4*)(V8 + (size_t)e * 1024 + lane * 16);                               \
  }
#define PEER_COMP(u, v, b)                                                                   \
  _Pragma("unroll") for (int hf = 0; hf < 2; ++hf) {                                         \
    float s = reduce4(dot16_fp8(u[hf * 4 + 0], x2), dot16_fp8(u[hf * 4 + 1], x2),           \
                      dot16_fp8(u[hf * 4 + 2], x2), dot16_fp8(u[hf * 4 + 3], x2)) * xr_rstd; \
    float act = 0.5f * s * (1.f + erff(s * 0.7071067811865475f));                            \
    float gsel = __shfl((b) < 8 ? g0 : g1, ((b) * 8 + hf * 4 + (lane >> 4)) & 63);           \
    float cfv = act * gsel * (1.f / V8_SCALE);                                               \
    axpy16_fp8(o2, __int_as_float(__builtin_amdgcn_readlane(__float_as_int(cfv), 0)), v[hf * 4 + 0]);  \
    axpy16_fp8(o2, __int_as_float(__builtin_amdgcn_readlane(__float_as_int(cfv), 16)), v[hf * 4 + 1]); \
    axpy16_fp8(o2, __int_as_float(__builtin_amdgcn_readlane(__float_as_int(cfv), 32)), v[hf * 4 + 2]); \
    axpy16_fp8(o2, __int_as_float(__builtin_amdgcn_readlane(__float_as_int(cfv), 48)), v[hf * 4 + 3]); \
  }
__device__ void phase_peer(const Params& P) {
  const int lane = threadIdx.x & 63, w = threadIdx.x >> 6;
  bfu* hq = (bfu*)(P.ws + SLOT(0));
  const unsigned char* U8 = (const unsigned char*)(P.ws + SLOT(2));
  const unsigned char* V8 = (const unsigned char*)(P.ws + SLOT(3));
  const int* ids = (const int*)(P.ws + SLOT(4));
  const float* gw = (const float*)(P.ws + SLOT(13));
  bfu* pbf = (bfu*)(P.ws + SLOT(6));
  int nid0 = 0, nid1 = 0;
  if (blockIdx.x * 4 + w < MT) { nid0 = ids[(size_t)(blockIdx.x * 4 + w) * 128 + lane]; nid1 = ids[(size_t)(blockIdx.x * 4 + w) * 128 + 64 + lane]; }
  for (int r = blockIdx.x * 4 + w; r < MT; r += gridDim.x * 4) {
    f2v x2[8], o2[8];
    {
      uint4 v0 = *(const uint4*)(hq + (size_t)r * 1024 + lane * 16);
      uint4 v1 = *(const uint4*)(hq + (size_t)r * 1024 + lane * 16 + 8);
      float xf[16];
      unpack8(v0, xf); unpack8(v1, xf + 8);
#pragma unroll
      for (int j = 0; j < 8; ++j) { x2[j].x = xf[2 * j]; x2[j].y = xf[2 * j + 1]; o2[j].x = 0.f; o2[j].y = 0.f; }
    }
    const int id0 = nid0, id1 = nid1;
    float g0 = gw[(size_t)r * 128 + lane], g1 = gw[(size_t)r * 128 + 64 + lane];
    float xr_rstd;
    {
      const float* pp = (const float*)(P.ws + O_GPRE) + (size_t)r * 8;
      float4 p0 = *(const float4*)pp, p1 = *(const float4*)(pp + 4);
      xr_rstd = rsqrtf((p0.x + p0.y + p0.z + p0.w + p1.x + p1.y + p1.z + p1.w) * (1.f / 1024.f) + EPS) * (1.f / U8_SCALE);
    }
    uint4 uA[8], vA[8], uB[8], vB[8];
    PEER_LOAD(uA, vA, 0)
    for (int b = 0; b < 16; b += 2) {
      PEER_LOAD(uB, vB, b + 1)
      PEER_COMP(uA, vA, b)
      if (b + 2 < 16) { PEER_LOAD(uA, vA, b + 2) }
      PEER_COMP(uB, vB, b + 1)
    }
    asm volatile("" ::: "memory");
    {
      const int rn = r + (int)gridDim.x * 4;
      if (rn < MT) { nid0 = ids[(size_t)rn * 128 + lane]; nid1 = ids[(size_t)rn * 128 + 64 + lane]; }
    }
    float* xr = P.out + (size_t)r * 1024 + lane * 16;
    float x3[16];
    float ss = 0.f;
#pragma unroll
    for (int k = 0; k < 4; ++k) {
      float4 a = *(const float4*)(xr + k * 4);
      x3[k * 4 + 0] = a.x + o2[k * 2].x; x3[k * 4 + 1] = a.y + o2[k * 2].y;
      x3[k * 4 + 2] = a.z + o2[k * 2 + 1].x; x3[k * 4 + 3] = a.w + o2[k * 2 + 1].y;
      *(float4*)(xr + k * 4) = make_float4(x3[k * 4], x3[k * 4 + 1], x3[k * 4 + 2], x3[k * 4 + 3]);
    }
#pragma unroll
    for (int j = 0; j < 16; ++j) ss += x3[j] * x3[j];
    ss = wave_sum(ss);
    float rstd = rsqrtf(ss * (1.f / 1024.f) + EPS);
    float hv[16];
#pragma unroll
    for (int k = 0; k < 4; ++k) {
      float4 ga = *(const float4*)(P.g_ple + lane * 16 + k * 4);
      hv[k * 4] = x3[k * 4] * rstd * ga.x; hv[k * 4 + 1] = x3[k * 4 + 1] * rstd * ga.y;
      hv[k * 4 + 2] = x3[k * 4 + 2] * rstd * ga.z; hv[k * 4 + 3] = x3[k * 4 + 3] * rstd * ga.w;
    }
    *(uint4*)(hq + (size_t)r * 1024 + lane * 16) = pack8(hv);
    *(uint4*)(hq + (size_t)r * 1024 + lane * 16 + 8) = pack8(hv + 8);
    {
      const float* pr = r < MP ? P.pp + (size_t)r * 256 : P.ps + (size_t)(r - MP) * 256;
      float4 a = *(const float4*)(pr + lane * 4);
      uint2 ov; ov.x = pack2(a.x, a.y); ov.y = pack2(a.z, a.w);
      *(uint2*)(pbf + (size_t)r * 256 + lane * 4) = ov;
    }
  }
}

__device__ void phase_ple(const Params& P, char* smem) {
  bfu* sA = (bfu*)smem; bfu* sB = sA + 128 * 72;
  const bfu* hg = (const bfu*)(P.ws + SLOT(0));
  const bfu* pbf = (const bfu*)(P.ws + SLOT(6));
  for (int t = blockIdx.x; t < 260 * 8; t += gridDim.x) {
    int mt, nt; tile_map(t, 260, 8, mt, nt);
    f32x16 acc[2][2]; zero_acc(acc);
    bfu* sT = (bfu*)smem; float* sT32 = (float*)smem;
    uint2 pg[16];
    gemm_acc(acc, hg + (size_t)mt * 128 * 1024, 1024, (const bfu*)(P.ws + O_WT_PG) + (size_t)nt * 128 * 1024, 1024, 1024, sA, sB);
    __syncthreads();
    {
      EPI_BEGIN
#pragma unroll
        for (int j = 0; j < 4; ++j) {
          sT[(r0 + j) * ST_LD + cl] = f2bf(sigmoidf_(acc[mi][0][q * 4 + j]));
          sT[(r0 + j) * ST_LD + cl + 64] = f2bf(sigmoidf_(acc[mi][1][q * 4 + j]));
        }
      EPI_END
    }
    __syncthreads();
#pragma unroll
    for (int i = 0; i < 16; ++i) {
      int id = threadIdx.x + i * 256, row = id >> 5, c4 = (id & 31) * 4;
      pg[i] = *(const uint2*)(sT + row * ST_LD + c4);
    }
    zero_acc(acc);
    gemm_acc(acc, pbf + (size_t)mt * 128 * 256, 256, (const bfu*)(P.ws + O_WT_PLE) + (size_t)nt * 128 * 256, 256, 256, sA, sB);
    __syncthreads();
    {
      EPI_BEGIN
#pragma unroll
        for (int j = 0; j < 4; ++j) {
          sT32[(r0 + j) * ST32_LD + cl] = acc[mi][0][q * 4 + j];
          sT32[(r0 + j) * ST32_LD + cl + 64] = acc[mi][1][q * 4 + j];
        }
      EPI_END
    }
    __syncthreads();
#pragma unroll
    for (int i = 0; i < 16; ++i) {
      int id = threadIdx.x + i * 256, row = id >> 5, c4 = (id & 31) * 4;
      float4 a = *(const float4*)(sT32 + row * ST32_LD + c4);
      float* op = P.out + (size_t)(mt * 128 + row) * 1024 + nt * 128 + c4;
      float4 x = *(const float4*)op;
      float g0 = bf2f(pg[i].x & 0xffff), g1 = bf2f(pg[i].x >> 16), g2 = bf2f(pg[i].y & 0xffff), g3 = bf2f(pg[i].y >> 16);
      *(float4*)op = make_float4(x.x + a.x * g0, x.y + a.y * g1, x.z + a.z * g2, x.w + a.w * g3);
    }
  }
}

__device__ void phase_final(const Params& P) {
  const int lane = threadIdx.x & 63, w = threadIdx.x >> 6;
  for (int r = blockIdx.x * 4 + w; r < MT; r += gridDim.x * 4) {
    float* xr = P.out + (size_t)r * 1024;
    float4 v[4]; float ss = 0.f;
#pragma unroll
    for (int i = 0; i < 4; ++i) {
      v[i] = *(const float4*)(xr + i * 256 + lane * 4);
      ss += v[i].x * v[i].x + v[i].y * v[i].y + v[i].z * v[i].z + v[i].w * v[i].w;
    }
    ss = wave_sum(ss);
    float rstd = rsqrtf(ss * (1.f / 1024.f) + EPS);
#pragma unroll
    for (int i = 0; i < 4; ++i) {
      float4 gg = *(const float4*)(P.g_final + i * 256 + lane * 4);
      *(float4*)(xr + i * 256 + lane * 4) = make_float4(v[i].x * rstd * gg.x, v[i].y * rstd * gg.y, v[i].z * rstd * gg.z, v[i].w * rstd * gg.w);
    }
  }
}

__global__ void __launch_bounds__(NTHREADS, 2) fwd_megakernel(Params P) {
  extern __shared__ __attribute__((aligned(16))) char smem[];
  cg::grid_group grid = cg::this_grid();
  __shared__ uint4 xb_words;
  if (threadIdx.x == 0) xb_words = make_uint4(0u, 0u, 0u, 0u);
  __syncthreads();
  XcdBarrier xb = xcd_barrier_post((unsigned*)(P.ws + O_BAR), (volatile LAS unsigned*)&xb_words);
  if (P.out == nullptr) grid.sync();
  const int gtid = blockIdx.x * NTHREADS + threadIdx.x, gstride = gridDim.x * NTHREADS;
  phase_prep(P, smem);
  xcd_barrier(xb);
  phase_gemm1(P, smem);
  xcd_barrier(xb);
  phase_conv(P);
  gate_scan(P);
  xcd_barrier(xb);
  m_fold(P);
  phase_mqk(P, smem);
  xcd_barrier(xb);
  for (int t = blockIdx.x; t < 4224; t += gridDim.x) phaseA_item(P, t / 2112, t % 2112, smem);
  xcd_barrier(xb);
  phase_scan(P);
  xcd_barrier(xb);
  for (int t = blockIdx.x; t < 4224; t += gridDim.x) phaseC_item(P, t / 2112, t % 2112, smem);
  xcd_barrier(xb);
  phase_merge(P, smem);
  {
    const int extra = 2080 % (int)gridDim.x;
    if ((int)blockIdx.x >= extra) {
      const int cg_tid = ((int)blockIdx.x - extra) * NTHREADS + threadIdx.x, cg_str = ((int)gridDim.x - extra) * NTHREADS;
      convert_fp8(P.peer_u, (unsigned char*)(P.ws + SLOT(2)), 16384ull * 1024 / 16, U8_SCALE, cg_tid, cg_str);
      convert_fp8(P.peer_v, (unsigned char*)(P.ws + SLOT(3)), 16384ull * 1024 / 16, V8_SCALE, cg_tid, cg_str);
    }
  }
  xcd_barrier(xb);
  phase_outproj(P, smem);
  xcd_barrier(xb);
  phase_pq(P, smem);
  xcd_barrier(xb);
  phase_topk(P, smem);
  xcd_barrier(xb);
  phase_peer(P);
  xcd_barrier(xb);
  phase_ple(P, smem);
  xcd_barrier(xb);
  phase_final(P);
}

extern "C" void kernel_launch(void* const* d_in, const int* in_sizes, int n_in, void* d_out, int out_size,
                              void* d_ws, size_t ws_size, hipStream_t stream) {
  static int grid_blocks = 0;
  if (!grid_blocks) {
    hipFuncSetAttribute((const void*)fwd_megakernel, hipFuncAttributeMaxDynamicSharedMemorySize, SMEM_BYTES);
    int dev = 0, cus = 0, per_cu = 0;
    hipGetDevice(&dev);
    hipDeviceGetAttribute(&cus, hipDeviceAttributeMultiprocessorCount, dev);
    hipOccupancyMaxActiveBlocksPerMultiprocessor(&per_cu, fwd_megakernel, NTHREADS, SMEM_BYTES);
    if (per_cu > 2) per_cu = 2;
    if (per_cu < 1) per_cu = 1;
    grid_blocks = cus * per_cu;
  }
  Params p{};
  const float** pf = (const float**)&p;
  for (int i = 0; i < 32; ++i) pf[i] = (const float*)d_in[i];
  p.out = (float*)d_out;
  p.ws = (char*)d_ws;
  hipMemsetAsync((char*)d_ws + O_BAR, 0, XCD_BAR_WORDS * 4, stream);
  void* args[] = {&p};
  hipError_t e = hipLaunchCooperativeKernel((void*)fwd_megakernel, dim3(grid_blocks), dim3(NTHREADS), args, SMEM_BYTES, stream);
  if (e != hipSuccess) fprintf(stderr, "cooperative launch failed: %s (grid %d)\n", hipGetErrorString(e), grid_blocks);
}
```

```cpp
#include <hip/hip_runtime.h>
#include <hip/hip_cooperative_groups.h>
#include <cstdio>
namespace cg = cooperative_groups;

typedef unsigned short bfu;
typedef __attribute__((ext_vector_type(8))) short bf16x8;
typedef __attribute__((ext_vector_type(16))) float f32x16;

#define MT 33280
#define MP 32768
#define NTHREADS 256
#define EPS 1e-6f

struct Params {
  const float *xp, *xs, *pp, *ps, *st_ret, *st_C, *st_n, *st_m, *st_conv, *g_mix, *w_in, *g_ret_gn, *w_mq,
      *w_mk, *conv_w, *conv_b, *b_i, *b_f, *g_ml_gn, *w_skip, *w_up_r, *w_up_m, *w_out, *g_ffn, *w_pq,
      *peer_keys, *peer_u, *peer_v, *g_ple, *w_pg, *w_ple, *g_final;
  float* out;
  char* ws;
};

constexpr size_t O_WT_IN = 0;
constexpr size_t O_WT_UPR = O_WT_IN + 5632ull * 1024 * 2;
constexpr size_t O_WT_UPM = O_WT_UPR + 1024ull * 512 * 2;
constexpr size_t O_WT_OUT = O_WT_UPM + 1024ull * 512 * 2;
constexpr size_t O_WT_PQ = O_WT_OUT + 1024ull * 1024 * 2;
constexpr size_t O_WT_PG = O_WT_PQ + 2048ull * 1024 * 2;
constexpr size_t O_WT_PLE = O_WT_PG + 1024ull * 1024 * 2;
constexpr size_t O_KEYS = O_WT_PLE + 1024ull * 256 * 2;
constexpr size_t O_WT_MQ = O_KEYS + 16ull * 128 * 128 * 2;
constexpr size_t O_WT_MK = O_WT_MQ + 4ull * 128 * 128 * 2;
constexpr size_t O_COS = O_WT_MK + 4ull * 128 * 128 * 2;
constexpr size_t O_SIN = O_COS + 8192ull * 64 * 4;
constexpr size_t O_FQ = O_SIN + 8192ull * 64 * 4;
constexpr size_t O_UQ = O_FQ + (size_t)MT * 16;
constexpr size_t O_CMQ = O_UQ + (size_t)MT * 16;
constexpr size_t O_FL = O_CMQ + (size_t)MT * 16;
constexpr size_t O_UC = O_FL + 16384;
constexpr size_t O_AEND = O_UC + 16384;
constexpr size_t O_MCS = O_AEND + 16384;
constexpr size_t O_DN = O_MCS + 16384;
constexpr size_t O_DSS = O_DN + 2112ull * 128 * 4;
constexpr size_t O_GPRE = O_DSS + 2ull * 64 * 16384 * 2;
constexpr size_t O_BAR = O_GPRE + (size_t)MT * 32;
constexpr size_t O_SMALL_END = O_BAR + 16384;
constexpr size_t SLOT0 = 40ull << 20;
constexpr size_t USZ = (size_t)MT * 512 * 2;
static_assert(O_SMALL_END <= SLOT0, "small region overflow");
#define SLOT(i) (SLOT0 + (size_t)(i) * USZ)
constexpr size_t SB_T = 16ull * 128 * 8192;

constexpr size_t OO_Y = 0;
constexpr size_t OO_RETP = (size_t)MT * 1024;
constexpr size_t OO_CP = OO_RETP + 262144;
constexpr size_t OO_NP = OO_CP + 262144;
constexpr size_t OO_MP = OO_NP + 2048;
constexpr size_t OO_CONVP = OO_MP + 16;
constexpr size_t OO_RETS = OO_CONVP + 6144;
constexpr size_t OO_CS = OO_RETS + 1048576;
constexpr size_t OO_NS = OO_CS + 1048576;
constexpr size_t OO_MS = OO_NS + 8192;
constexpr size_t OO_CONVS = OO_MS + 64;

constexpr int SMEM_BYTES = 81152;

__device__ __forceinline__ bfu f2bf(float f) {
  unsigned u = __float_as_uint(f);
  u += 0x7fffu + ((u >> 16) & 1u);
  return (bfu)(u >> 16);
}
__device__ __forceinline__ float bf2f(bfu b) { return __uint_as_float(((unsigned)b) << 16); }
__device__ __forceinline__ unsigned pack2(float a, float b) { return (unsigned)f2bf(a) | ((unsigned)f2bf(b) << 16); }
__device__ __forceinline__ void unpack8(uint4 v, float* f) {
  f[0] = bf2f(v.x & 0xffff); f[1] = bf2f(v.x >> 16); f[2] = bf2f(v.y & 0xffff); f[3] = bf2f(v.y >> 16);
  f[4] = bf2f(v.z & 0xffff); f[5] = bf2f(v.z >> 16); f[6] = bf2f(v.w & 0xffff); f[7] = bf2f(v.w >> 16);
}
__device__ __forceinline__ uint4 pack8(const float* f) {
  uint4 o; o.x = pack2(f[0], f[1]); o.y = pack2(f[2], f[3]); o.z = pack2(f[4], f[5]); o.w = pack2(f[6], f[7]);
  return o;
}
__device__ __forceinline__ float wave_sum(float v) {
#pragma unroll
  for (int o = 32; o > 0; o >>= 1) v += __shfl_xor(v, o);
  return v;
}
__device__ __forceinline__ float wave_max(float v) {
#pragma unroll
  for (int o = 32; o > 0; o >>= 1) v = fmaxf(v, __shfl_xor(v, o));
  return v;
}
__device__ __forceinline__ float dpp_ror_add(float s, const int ctrl_sel) {
  int v = __float_as_int(s);
  int t;
  if (ctrl_sel == 8) t = __builtin_amdgcn_update_dpp(0, v, 0x128, 0xf, 0xf, false);
  else if (ctrl_sel == 4) t = __builtin_amdgcn_update_dpp(0, v, 0x124, 0xf, 0xf, false);
  else if (ctrl_sel == 2) t = __builtin_amdgcn_update_dpp(0, v, 0x122, 0xf, 0xf, false);
  else t = __builtin_amdgcn_update_dpp(0, v, 0x121, 0xf, 0xf, false);
  return s + __int_as_float(t);
}
__device__ __forceinline__ float reduce4(float p0, float p1, float p2, float p3) {
  auto r = __builtin_amdgcn_permlane32_swap(__float_as_int(p0), __float_as_int(p2), false, false);
  float sA = __int_as_float(r[0]) + __int_as_float(r[1]);
  r = __builtin_amdgcn_permlane32_swap(__float_as_int(p1), __float_as_int(p3), false, false);
  float sB = __int_as_float(r[0]) + __int_as_float(r[1]);
  r = __builtin_amdgcn_permlane16_swap(__float_as_int(sA), __float_as_int(sB), false, false);
  float s = __int_as_float(r[0]) + __int_as_float(r[1]);
  s = dpp_ror_add(s, 8); s = dpp_ror_add(s, 4); s = dpp_ror_add(s, 2); s = dpp_ror_add(s, 1);
  return s;
}
__device__ __forceinline__ float sigmoidf_(float x) { return 1.f / (1.f + __expf(-x)); }
__device__ __forceinline__ const float* xrow(const Params& P, int r) {
  return r < MP ? P.xp + (size_t)r * 1024 : P.xs + (size_t)(r - MP) * 1024;
}


#define XB_TMO      128
#define XB_XCNT(j)  (256  + 64 * (j))
#define XB_XSUB(j)  (1280 + 64 * (j))
#define XB_XGEN(j)  (2304 + 64 * (j))
#define XB_TOP      3328
#define XB_TOPGEN   3392
#define XCD_BAR_WORDS 3456
#define XB_SPIN_CAP (1u << 22)
#define LAS __attribute__((address_space(3)))
__device__ __forceinline__ unsigned xb_ld(unsigned* p) { return __hip_atomic_load(p, __ATOMIC_RELAXED, __HIP_MEMORY_SCOPE_AGENT); }
__device__ __forceinline__ unsigned xb_add(unsigned* p, unsigned v) { return __hip_atomic_fetch_add(p, v, __ATOMIC_RELAXED, __HIP_MEMORY_SCOPE_AGENT); }
__device__ __forceinline__ unsigned xb_xcc_id() { return (unsigned)__builtin_amdgcn_s_getreg((3 << 11) | 20) & 0xFu; }
#define XB_SPIN(cond, bar) do { unsigned _sp = 0; while (cond) { __builtin_amdgcn_s_sleep(1); \
    if ((++_sp & 255u) == 0u) { if (xb_ld(&(bar)[XB_TMO])) break; if (_sp > XB_SPIN_CAP) { atomicAdd(&(bar)[XB_TMO], 1u); break; } } } } while (0)
struct XcdBarrier { unsigned* bar; unsigned x; volatile LAS unsigned* st; };
__device__ __forceinline__ XcdBarrier xcd_barrier_post(unsigned* bar, volatile LAS unsigned* st) {
  XcdBarrier b; b.bar = bar; b.x = xb_xcc_id(); b.st = st;
  if (threadIdx.x == 0) (void)xb_add(&bar[XB_XCNT(b.x)], 1u);
  return b;
}
__device__ __forceinline__ void xcd_barrier_complete(unsigned* bar, unsigned x, unsigned& nloc, unsigned& nx) {
  const unsigned G = gridDim.x * gridDim.y * gridDim.z;
  unsigned sum, cnt, mine, sp = 0u;
  for (;;) {
    sum = 0u; cnt = 0u; mine = 0u;
#pragma unroll
    for (unsigned j = 0; j < 16; ++j) { const unsigned c = xb_ld(&bar[XB_XCNT(j)]); sum += c; cnt += (c > 0u) ? 1u : 0u; mine = (j == x) ? c : mine; }
    if (sum == G) break;
    __builtin_amdgcn_s_sleep(1);
    if ((++sp & 255u) == 0u) { if (xb_ld(&bar[XB_TMO])) break; if (sp > XB_SPIN_CAP) { atomicAdd(&bar[XB_TMO], 1u); break; } }
  }
  nloc = mine > 0u ? mine : 1u; nx = cnt > 0u ? cnt : 1u;
}
__device__ __forceinline__ void xcd_barrier(const XcdBarrier& b) {
  asm volatile("s_waitcnt vmcnt(0)" ::: "memory");
  __syncthreads();
  if (threadIdx.x == 0) {
    unsigned* bar = b.bar;
    __builtin_amdgcn_s_waitcnt(0);
    unsigned nloc = b.st[0], nx = b.st[1];
    if (nloc == 0u) { xcd_barrier_complete(bar, b.x, nloc, nx); b.st[0] = nloc; b.st[1] = nx; }
    const unsigned old = xb_add(&bar[XB_XSUB(b.x)], 1u);
    const unsigned gen = old / nloc;
    if (old + 1u == (gen + 1u) * nloc) {
      __builtin_amdgcn_fence(__ATOMIC_RELEASE, "agent");
      asm volatile("s_waitcnt vmcnt(0)" ::: "memory");
      const unsigned og = xb_add(&bar[XB_TOP], 1u);
      const unsigned tg = og / nx;
      if (og + 1u == (tg + 1u) * nx) xb_add(&bar[XB_TOPGEN], 1u);
      else XB_SPIN(xb_ld(&bar[XB_TOPGEN]) == tg, bar);
      __builtin_amdgcn_fence(__ATOMIC_ACQUIRE, "agent");
      xb_add(&bar[XB_XGEN(b.x)], 1u);
      asm volatile("s_waitcnt vmcnt(0)" ::: "memory");
    } else {
      XB_SPIN(xb_ld(&bar[XB_XGEN(b.x)]) == gen, bar);
      __builtin_amdgcn_fence(__ATOMIC_ACQUIRE, "agent");
      asm volatile("s_waitcnt vmcnt(0)" ::: "memory");
    }
  }
  __syncthreads();
}

__device__ __forceinline__ void gemm_acc(f32x16 (&acc)[2][2], const bfu* __restrict__ A, int lda,
                                         const bfu* __restrict__ Bt, int ldb, int K, bfu* sA, bfu*  ) {
  const int tid = threadIdx.x, lane = tid & 63, w = tid >> 6, wm = w & 1, wn = w >> 1;
  const int lr = tid >> 3;
  const int kc = ((tid & 7) ^ ((tid >> 4) & 7)) * 8;
  const bfu* Ap = A + (size_t)lr * lda + kc;
  const bfu* Bp = Bt + (size_t)lr * ldb + kc;
  const size_t a32 = (size_t)32 * lda, b32 = (size_t)32 * ldb;
  char* sbase = (char*)sA;
  char* ldst = sbase + tid * 16;
#define GISSUE(stage, k)                                                                                       \
  _Pragma("unroll") for (int i_ = 0; i_ < 4; ++i_) {                                                           \
    __builtin_amdgcn_global_load_lds((const unsigned*)(Ap + i_ * a32 + (k)),                                   \
                                     (LAS unsigned*)(ldst + (stage) * 32768 + i_ * 4096), 16, 0, 0);           \
    __builtin_amdgcn_global_load_lds((const unsigned*)(Bp + i_ * b32 + (k)),                                   \
                                     (LAS unsigned*)(ldst + (stage) * 32768 + 16384 + i_ * 4096), 16, 0, 0);   \
  }
  const int sw = (lane >> 1) & 7, hh = lane >> 5;
  const int rowA = (wm * 64 + (lane & 31)) * 128, rowB = (wn * 32 + (lane & 31)) * 128;
  __syncthreads();
  GISSUE(0, 0)
  int cur = 0;
  for (int k0 = 0; k0 < K; k0 += 64) {
    asm volatile("s_waitcnt vmcnt(0)" ::: "memory");
    __syncthreads();
    if (k0 + 64 < K) { GISSUE(cur ^ 1, k0 + 64) }
    const char* cA = sbase + cur * 32768;
    const char* cB = cA + 16384;
    __builtin_amdgcn_s_setprio(1);
#pragma unroll
    for (int ks = 0; ks < 4; ++ks) {
      const int pos = ((2 * ks + hh) ^ sw) * 16;
      bf16x8 af[2], bfr[2];
#pragma unroll
      for (int mi = 0; mi < 2; ++mi) af[mi] = *(const bf16x8*)(cA + rowA + mi * 32 * 128 + pos);
#pragma unroll
      for (int ni = 0; ni < 2; ++ni) bfr[ni] = *(const bf16x8*)(cB + rowB + ni * 64 * 128 + pos);
#pragma unroll
      for (int mi = 0; mi < 2; ++mi)
#pragma unroll
        for (int ni = 0; ni < 2; ++ni)
          acc[mi][ni] = __builtin_amdgcn_mfma_f32_32x32x16_bf16(af[mi], bfr[ni], acc[mi][ni], 0, 0, 0);
    }
    __builtin_amdgcn_s_setprio(0);
    cur ^= 1;
  }
}
#define gemm_acc1 gemm_acc
__device__ __forceinline__ void zero_acc(f32x16 (&acc)[2][2]) {
#pragma unroll
  for (int a = 0; a < 2; ++a)
#pragma unroll
    for (int b = 0; b < 2; ++b)
#pragma unroll
      for (int i = 0; i < 16; ++i) acc[a][b][i] = 0.f;
}
#define EPI_BEGIN                                                      \
  const int e_lane = threadIdx.x & 63, e_w = threadIdx.x >> 6;         \
  const int e_wm = e_w & 1, e_wn = e_w >> 1;                            \
  const int cl = e_wn * 32 + (e_lane & 31);                             \
  _Pragma("unroll") for (int mi = 0; mi < 2; ++mi)                      \
  _Pragma("unroll") for (int q = 0; q < 4; ++q) {                       \
    const int r0 = e_wm * 64 + mi * 32 + q * 8 + 4 * (e_lane >> 5);
#define EPI_END }

#define ST_LD 136
#define ST32_LD 132
typedef unsigned u32x4nt __attribute__((ext_vector_type(4)));
__device__ __forceinline__ void nt_store_u4(void* p, uint4 v) { u32x4nt t = {v.x, v.y, v.z, v.w}; __builtin_nontemporal_store(t, (u32x4nt*)p); }
__device__ __forceinline__ void copyout_bf16(const bfu* sT, bfu* dst, int ld) {
  const int tid = threadIdx.x;
#pragma unroll
  for (int i = 0; i < 8; ++i) {
    int id = tid + i * 256, row = id >> 4, c8 = (id & 15) * 8;
    *(uint4*)(dst + (size_t)row * ld + c8) = *(const uint4*)(sT + row * ST_LD + c8);
  }
}
__device__ __forceinline__ void copyout_bf16_nt(const bfu* sT, bfu* dst, int ld) {
  const int tid = threadIdx.x;
#pragma unroll
  for (int i = 0; i < 8; ++i) {
    int id = tid + i * 256, row = id >> 4, c8 = (id & 15) * 8;
    nt_store_u4(dst + (size_t)row * ld + c8, *(const uint4*)(sT + row * ST_LD + c8));
  }
}
__device__ __forceinline__ void stage_rm(bfu* sT, const f32x16 (&acc)[2][2], float sc) {
  EPI_BEGIN
#pragma unroll
    for (int j = 0; j < 4; ++j) {
      sT[(r0 + j) * ST_LD + cl] = f2bf(acc[mi][0][q * 4 + j] * sc);
      sT[(r0 + j) * ST_LD + cl + 64] = f2bf(acc[mi][1][q * 4 + j] * sc);
    }
  EPI_END
}

__device__ __forceinline__ void tile_map(int L, int nM, int nN, int& pm, int& pn) {
  const int nwg = nM * nN;
  const int q = nwg >> 3, r = nwg & 7, xcd = L & 7, off = L >> 3;
  int wgid = (xcd < r ? xcd * (q + 1) : r * (q + 1) + (xcd - r) * q) + off;
  const int nig = 8 * nN, gid = wgid / nig, fm = gid * 8;
  const int gsz = (nM - fm) < 8 ? (nM - fm) : 8;
  pm = fm + (wgid % nig) % gsz;
  pn = (wgid % nig) / gsz;
}
__device__ void transpose_w(const float* __restrict__ src, int K, int N, int src_ld, bfu* __restrict__ dst,
                            int remap, int gtid, int gstride) {
  int total = N * (K / 8);
  for (int i = gtid; i < total; i += gstride) {
    int n = i % N, kg = i / N;
    int col = (remap && n >= 3584) ? n + 8 : n;
    float v[8];
#pragma unroll
    for (int j = 0; j < 8; ++j) v[j] = src[(size_t)(kg * 8 + j) * src_ld + col];
    uint4 o;
    o.x = pack2(v[0], v[1]); o.y = pack2(v[2], v[3]); o.z = pack2(v[4], v[5]); o.w = pack2(v[6], v[7]);
    *(uint4*)(dst + (size_t)n * K + kg * 8) = o;
  }
}
__device__ void transpose_w_lds(const float* __restrict__ src, int K, int N, int src_ld, bfu* __restrict__ dst,
                                int remap, float* st, int boff) {
  const int tid = threadIdx.x;
  const int tilesN = N >> 6, ntile = (K >> 6) * tilesN;
  for (int t = (int)((blockIdx.x + gridDim.x - (boff % gridDim.x)) % gridDim.x); t < ntile; t += gridDim.x) {
    const int kt = t / tilesN, nt = t - kt * tilesN;
    {
      const int row = tid >> 2, c16 = (tid & 3) * 16;
      const int n0 = nt * 64 + c16;
      const int col = (remap && n0 >= 3584) ? n0 + 8 : n0;
      const float* sp = src + (size_t)(kt * 64 + row) * src_ld + col;
#pragma unroll
      for (int j = 0; j < 4; ++j) {
        float4 v = *(const float4*)(sp + j * 4);
        float* d = st + row * 65 + c16 + j * 4;
        d[0] = v.x; d[1] = v.y; d[2] = v.z; d[3] = v.w;
      }
    }
    __syncthreads();
    {
      const int n = tid >> 2, kc = (tid & 3) * 16;
#pragma unroll
      for (int hf = 0; hf < 2; ++hf) {
        float f[8];
#pragma unroll
        for (int j = 0; j < 8; ++j) f[j] = st[(kc + hf * 8 + j) * 65 + n];
        uint4 o;
        o.x = pack2(f[0], f[1]); o.y = pack2(f[2], f[3]); o.z = pack2(f[4], f[5]); o.w = pack2(f[6], f[7]);
        *(uint4*)(dst + (size_t)(nt * 64 + n) * K + kt * 64 + kc + hf * 8) = o;
      }
    }
    __syncthreads();
  }
}
__device__ void convert_bf(const float* __restrict__ src, bfu* __restrict__ dst, size_t n8, int gtid, int gstride) {
  for (size_t i = gtid; i < n8; i += gstride) {
    float4 a = *(const float4*)(src + i * 8), b = *(const float4*)(src + i * 8 + 4);
    uint4 o;
    o.x = pack2(a.x, a.y); o.y = pack2(a.z, a.w); o.z = pack2(b.x, b.y); o.w = pack2(b.z, b.w);
    *(uint4*)(dst + i * 8) = o;
  }
}

__device__ void prep_rows(const Params& P) {
  const int lane = threadIdx.x & 63, w = threadIdx.x >> 6;
  bfu* hbuf = (bfu*)(P.ws + SLOT(0));
  float* gpre = (float*)(P.ws + O_GPRE);
  float4 wg0[16], wg1[16];
#pragma unroll
  for (int i = 0; i < 4; ++i)
#pragma unroll
    for (int j = 0; j < 4; ++j) {
      const float* wr = P.w_in + (size_t)(i * 256 + lane * 4 + j) * 5640 + 3584;
      wg0[i * 4 + j] = *(const float4*)wr; wg1[i * 4 + j] = *(const float4*)(wr + 4);
    }
  float4 gm[4];
#pragma unroll
  for (int i = 0; i < 4; ++i) gm[i] = *(const float4*)(P.g_mix + i * 256 + lane * 4);
  for (int r = blockIdx.x * 4 + w; r < MT; r += gridDim.x * 4) {
    const float* xr = xrow(P, r);
    float4 v[4];
    float ss = 0.f;
#pragma unroll
    for (int i = 0; i < 4; ++i) {
      v[i] = *(const float4*)(xr + i * 256 + lane * 4);
      ss += v[i].x * v[i].x + v[i].y * v[i].y + v[i].z * v[i].z + v[i].w * v[i].w;
    }
    ss = wave_sum(ss);
    float rstd = rsqrtf(ss * (1.f / 1024.f) + EPS);
    float ga[8];
#pragma unroll
    for (int j = 0; j < 8; ++j) ga[j] = 0.f;
#pragma unroll
    for (int i = 0; i < 4; ++i) {
      float hv[4] = {v[i].x * rstd * gm[i].x, v[i].y * rstd * gm[i].y, v[i].z * rstd * gm[i].z, v[i].w * rstd * gm[i].w};
      uint2 o; o.x = pack2(hv[0], hv[1]); o.y = pack2(hv[2], hv[3]);
      *(uint2*)(hbuf + (size_t)r * 1024 + i * 256 + lane * 4) = o;
#pragma unroll
      for (int j = 0; j < 4; ++j) {
        const float4 w0 = wg0[i * 4 + j], w1 = wg1[i * 4 + j];
        ga[0] += hv[j] * w0.x; ga[1] += hv[j] * w0.y; ga[2] += hv[j] * w0.z; ga[3] += hv[j] * w0.w;
        ga[4] += hv[j] * w1.x; ga[5] += hv[j] * w1.y; ga[6] += hv[j] * w1.z; ga[7] += hv[j] * w1.w;
      }
    }
    float si = reduce4(ga[0], ga[1], ga[2], ga[3]);
    float sf = reduce4(ga[4], ga[5], ga[6], ga[7]);
    if ((lane & 15) == 0) {
      int k = lane >> 4;
      gpre[(size_t)r * 8 + k] = si + P.b_i[k];
      gpre[(size_t)r * 8 + 4 + k] = sf + P.b_f[k];
    }
  }
}
__device__ void gate_scan(const Params& P) {
  const int lane = threadIdx.x & 63, w = threadIdx.x >> 6;
  const float* gpre = (const float*)(P.ws + O_GPRE);
  for (int item = blockIdx.x * 4 + w; item < 528 * 4; item += gridDim.x * 4) {
    int tile = item >> 2, h = item & 3;
    int row0, L;
    if (tile < 512) { row0 = tile * 64; L = 64; } else { row0 = MP + (tile - 512) * 32; L = 32; }
    const int s = lane;
    bool valid = s < L;
    float ig = valid ? gpre[(size_t)(row0 + s) * 8 + h] : -INFINITY;
    float fg = valid ? gpre[(size_t)(row0 + s) * 8 + 4 + h] : 0.f;
    float lf = valid ? (fminf(fg, 0.f) - log1pf(__expf(-fabsf(fg)))) : 0.f;
    float F = lf;
#pragma unroll
    for (int o = 1; o < 64; o <<= 1) { float t = __shfl_up(F, o); if (lane >= o) F += t; }
    float u = valid ? ig - F : -INFINITY;
    float cm = u;
#pragma unroll
    for (int o = 1; o < 64; o <<= 1) { float t = __shfl_up(cm, o); if (lane >= o) cm = fmaxf(cm, t); }
    if (valid) {
      size_t gi = (size_t)(row0 + s) * 4 + h;
      ((float*)(P.ws + O_FQ))[gi] = F;
      ((float*)(P.ws + O_UQ))[gi] = u;
      ((float*)(P.ws + O_CMQ))[gi] = cm;
      if (s == L - 1) {
        ((float*)(P.ws + O_FL))[tile * 4 + h] = F;
        ((float*)(P.ws + O_UC))[tile * 4 + h] = cm;
      }
    }
  }
}

__device__ void phase_prep(const Params& P, char* smem) {
  const int gtid = blockIdx.x * NTHREADS + threadIdx.x, gstride = gridDim.x * NTHREADS;
  prep_rows(P);
  transpose_w_lds(P.w_in, 1024, 5632, 5640, (bfu*)(P.ws + O_WT_IN), 1, (float*)smem, 0);
  transpose_w_lds(P.w_up_r, 512, 1024, 1024, (bfu*)(P.ws + O_WT_UPR), 0, (float*)smem, 1408);
  transpose_w_lds(P.w_up_m, 512, 1024, 1024, (bfu*)(P.ws + O_WT_UPM), 0, (float*)smem, 1536);
  transpose_w_lds(P.w_out, 1024, 1024, 1024, (bfu*)(P.ws + O_WT_OUT), 0, (float*)smem, 1664);
  transpose_w_lds(P.w_pq, 1024, 2048, 2048, (bfu*)(P.ws + O_WT_PQ), 0, (float*)smem, 1920);
  transpose_w_lds(P.w_pg, 1024, 1024, 1024, (bfu*)(P.ws + O_WT_PG), 0, (float*)smem, 2432);
  transpose_w_lds(P.w_ple, 256, 1024, 1024, (bfu*)(P.ws + O_WT_PLE), 0, (float*)smem, 2688);
  for (int h = 0; h < 4; ++h) {
    transpose_w_lds(P.w_mq + h * 16384, 128, 128, 128, (bfu*)(P.ws + O_WT_MQ) + h * 16384, 0, (float*)smem, 2752 + h * 8);
    transpose_w_lds(P.w_mk + h * 16384, 128, 128, 128, (bfu*)(P.ws + O_WT_MK) + h * 16384, 0, (float*)smem, 2756 + h * 8);
  }
  convert_bf(P.peer_keys, (bfu*)(P.ws + O_KEYS), 16 * 128 * 128 / 8, gtid, gstride);
  float* ct = (float*)(P.ws + O_COS); float* st = (float*)(P.ws + O_SIN);
  for (int i = gtid; i < 8192 * 64; i += gstride) {
    int pos = i >> 6, j = i & 63;
    float inv = exp2f(-(float)j * (13.287712379549449f / 64.f));
    float angf = (float)pos * inv;
    double a = (double)angf;
    double k = rint(a * 0.15915494309189535);
    float r = (float)(a - k * 6.283185307179586);
    ct[i] = __cosf(r); st[i] = __sinf(r);
  }
}

__device__ __forceinline__ void gemm_acc256(f32x16 (&acc)[4][2], const bfu* __restrict__ A, int lda,
                                            const bfu* __restrict__ Bt, int ldb, int K, char* sbase) {
  const int tid = threadIdx.x, lane = tid & 63, w = tid >> 6, wm = w & 1, wn = w >> 1;
  const int kc = ((tid & 3) ^ ((tid >> 4) & 3)) * 8;
  const bfu* Ap = A + (size_t)(tid >> 2) * lda + kc;
  const bfu* Bp = Bt + (size_t)(tid >> 2) * ldb + kc;
  const size_t a64 = (size_t)64 * lda, b64 = (size_t)64 * ldb;
  char* ldst = sbase + tid * 16;
#define GISSUE256(stage, k)                                                                                      \
  {                                                                                                              \
    char* d_ = ldst + (stage) * 24576;                                                                           \
    __builtin_amdgcn_global_load_lds((const unsigned*)(Ap + (k)), (LAS unsigned*)(d_), 16, 0, 0);                \
    __builtin_amdgcn_global_load_lds((const unsigned*)(Ap + a64 + (k)), (LAS unsigned*)(d_ + 4096), 16, 0, 0);   \
    __builtin_amdgcn_global_load_lds((const unsigned*)(Ap + 2 * a64 + (k)), (LAS unsigned*)(d_ + 8192), 16, 0, 0);  \
    __builtin_amdgcn_global_load_lds((const unsigned*)(Ap + 3 * a64 + (k)), (LAS unsigned*)(d_ + 12288), 16, 0, 0); \
    __builtin_amdgcn_global_load_lds((const unsigned*)(Bp + (k)), (LAS unsigned*)(d_ + 16384), 16, 0, 0);        \
    __builtin_amdgcn_global_load_lds((const unsigned*)(Bp + b64 + (k)), (LAS unsigned*)(d_ + 20480), 16, 0, 0);  \
  }
  const int sw = (lane >> 2) & 3, hh = lane >> 5;
  const int rowA = (wm * 64 + (lane & 31)) * 64, rowB = (wn * 32 + (lane & 31)) * 64;
  const int nk = K >> 5;
  __syncthreads();
  asm volatile("s_waitcnt vmcnt(0)" ::: "memory");
  GISSUE256(0, 0)
  if (nk > 1) GISSUE256(1, 32)
  int st = 0;
  for (int kt = 0; kt < nk; ++kt) {
    if (kt + 1 < nk) asm volatile("s_waitcnt vmcnt(6)" ::: "memory");
    else asm volatile("s_waitcnt vmcnt(0)" ::: "memory");
    asm volatile("s_waitcnt lgkmcnt(0)" ::: "memory");
    __builtin_amdgcn_s_barrier();
    asm volatile("" ::: "memory");
    if (kt + 2 < nk) { const int s2 = st >= 1 ? st - 1 : 2; GISSUE256(s2, (kt + 2) * 32) }
    const char* cA = sbase + st * 24576;
    const char* cB = cA + 16384;
    __builtin_amdgcn_s_setprio(1);
#pragma unroll
    for (int ks = 0; ks < 2; ++ks) {
      const int pos = ((2 * ks + hh) ^ sw) * 16;
      bf16x8 af[4], bfr[2];
#pragma unroll
      for (int mi = 0; mi < 4; ++mi) af[mi] = *(const bf16x8*)(cA + rowA + ((mi >> 1) * 128 + (mi & 1) * 32) * 64 + pos);
#pragma unroll
      for (int ni = 0; ni < 2; ++ni) bfr[ni] = *(const bf16x8*)(cB + rowB + ni * 64 * 64 + pos);
#pragma unroll
      for (int mi = 0; mi < 4; ++mi)
#pragma unroll
        for (int ni = 0; ni < 2; ++ni)
          acc[mi][ni] = __builtin_amdgcn_mfma_f32_32x32x16_bf16(af[mi], bfr[ni], acc[mi][ni], 0, 0, 0);
    }
    __builtin_amdgcn_s_setprio(0);
    st = st == 2 ? 0 : st + 1;
  }
}

__device__ __forceinline__ void gemm1_epilogue(const Params& P, char* smem, f32x16 (&acc)[2][2], const int rbase, const int nt,
                                               const float* ct, const float* stb) {
    const bool prompt = rbase < MP;
  int region = nt >> 2, hh = nt & 3;
  bfu* sT = (bfu*)smem;
  __syncthreads();
  if (region <= 1) {
    float sc = region == 1 ? 0.08838834764831845f : 1.f;
    EPI_BEGIN
#pragma unroll
      for (int j = 0; j < 4; ++j) {
        int rr = rbase + r0 + j;
        int pos = prompt ? (rr & 8191) : 2048 + ((rr - MP) & 31);
        float c = ct[pos * 64 + cl], sn = stb[pos * 64 + cl];
        float a = acc[mi][0][q * 4 + j], b = acc[mi][1][q * 4 + j];
        sT[(r0 + j) * ST_LD + cl] = f2bf((a * c - b * sn) * sc);
        sT[(r0 + j) * ST_LD + cl + 64] = f2bf((a * sn + b * c) * sc);
      }
    EPI_END
    __syncthreads();
    copyout_bf16_nt(sT, (bfu*)(P.ws + SLOT(2 + region)) + (size_t)rbase * 512 + hh * 128, 512);
  } else if (region == 2 || region == 5) {
    EPI_BEGIN
      uint2 va, vb;
      va.x = pack2(acc[mi][0][q * 4 + 0], acc[mi][0][q * 4 + 1]); va.y = pack2(acc[mi][0][q * 4 + 2], acc[mi][0][q * 4 + 3]);
      vb.x = pack2(acc[mi][1][q * 4 + 0], acc[mi][1][q * 4 + 1]); vb.y = pack2(acc[mi][1][q * 4 + 2], acc[mi][1][q * 4 + 3]);
      *(uint2*)(sT + cl * ST_LD + r0) = va;
      *(uint2*)(sT + (cl + 64) * ST_LD + r0) = vb;
    EPI_END
    __syncthreads();
    bfu* dst = (bfu*)(P.ws + SLOT(region == 2 ? 4 : 7));
#pragma unroll
    for (int i = 0; i < 8; ++i) {
      int id = threadIdx.x + i * 256, e = id >> 4, c8 = (id & 15) * 8;
      size_t o;
      if (prompt) { int bb = rbase >> 13, tt = (rbase & 8191) + c8; o = ((size_t)((bb * 4 + hh) * 128 + e)) * 8192 + tt; }
      else { int rs = rbase - MP + c8, bb = rs >> 5, tt = rs & 31; o = SB_T + ((size_t)((bb * 4 + hh) * 128 + e)) * 32 + tt; }
      nt_store_u4(dst + o, *(const uint4*)(sT + e * ST_LD + c8));
    }
  } else if (region == 3 || region == 4 || region == 6) {
    stage_rm(sT, acc, 1.f);
    __syncthreads();
    copyout_bf16_nt(sT, (bfu*)(P.ws + SLOT(region == 3 ? 5 : (region == 4 ? 6 : 8))) + (size_t)rbase * 512 + hh * 128, 512);
  } else {
    int gi = nt - 28;
    stage_rm(sT, acc, 1.f);
    __syncthreads();
    copyout_bf16_nt(sT, (bfu*)(P.ws + SLOT(gi < 8 ? 9 : 11)) + (size_t)rbase * 1024 + (gi & 7) * 128, 1024);
  }

}

__device__ void phase_gemm1(const Params& P, char* smem) {
  const bfu* hbuf = (const bfu*)(P.ws + SLOT(0));
  const bfu* wt = (const bfu*)(P.ws + O_WT_IN);
  const float* ct = (const float*)(P.ws + O_COS); const float* stb = (const float*)(P.ws + O_SIN);
  for (int t = blockIdx.x; t < 130 * 44; t += gridDim.x) {
    int mt, nt; tile_map(t, 130, 44, mt, nt);
    f32x16 acc[4][2];
#pragma unroll
    for (int a = 0; a < 4; ++a)
#pragma unroll
      for (int b = 0; b < 2; ++b)
#pragma unroll
        for (int i = 0; i < 16; ++i) acc[a][b][i] = 0.f;
    gemm_acc256(acc, hbuf + (size_t)mt * 256 * 1024, 1024, wt + (size_t)nt * 128 * 1024, 1024, 1024, smem);
    gemm1_epilogue(P, smem, reinterpret_cast<f32x16(&)[2][2]>(acc[0]), mt * 256, nt, ct, stb);
    gemm1_epilogue(P, smem, reinterpret_cast<f32x16(&)[2][2]>(acc[2]), mt * 256 + 128, nt, ct, stb);
  }
}

__device__ void phase_conv(const Params& P) {
  const int gtid = blockIdx.x * NTHREADS + threadIdx.x, gstride = gridDim.x * NTHREADS;
  const bfu* xm = (const bfu*)(P.ws + SLOT(6));
  bfu* cb = (bfu*)(P.ws + SLOT(0));
  for (int i = gtid; i < MT * 64; i += gstride) {
    int r = i >> 6, c0 = (i & 63) * 8;
    int t, T, bb; bool prompt = r < MP;
    if (prompt) { bb = r >> 13; t = r & 8191; T = 8192; } else { int rs = r - MP; bb = rs >> 5; t = rs & 31; T = 32; }
    float y[8];
#pragma unroll
    for (int j = 0; j < 8; ++j) y[j] = P.conv_b[c0 + j];
#pragma unroll
    for (int k = 0; k < 4; ++k) {
      int tt = t - 3 + k;
      float xv[8];
      if (tt >= 0) {
        uint4 v = *(const uint4*)(xm + (size_t)(r - 3 + k) * 512 + c0);
        xv[0] = bf2f(v.x & 0xffff); xv[1] = bf2f(v.x >> 16); xv[2] = bf2f(v.y & 0xffff); xv[3] = bf2f(v.y >> 16);
        xv[4] = bf2f(v.z & 0xffff); xv[5] = bf2f(v.z >> 16); xv[6] = bf2f(v.w & 0xffff); xv[7] = bf2f(v.w >> 16);
      } else if (!prompt) {
        const float* sp = P.st_conv + (size_t)(bb * 3 + (tt + 3)) * 512 + c0;
#pragma unroll
        for (int j = 0; j < 8; ++j) xv[j] = sp[j];
      } else {
#pragma unroll
        for (int j = 0; j < 8; ++j) xv[j] = 0.f;
      }
#pragma unroll
      for (int j = 0; j < 8; ++j) y[j] += xv[j] * P.conv_w[k * 512 + c0 + j];
    }
    if (t >= T - 3) {
      uint4 v = *(const uint4*)(xm + (size_t)r * 512 + c0);
      float* dst = (prompt ? P.out + OO_CONVP : P.out + OO_CONVS) + (size_t)(bb * 3 + (t - (T - 3))) * 512 + c0;
      dst[0] = bf2f(v.x & 0xffff); dst[1] = bf2f(v.x >> 16); dst[2] = bf2f(v.y & 0xffff); dst[3] = bf2f(v.y >> 16);
      dst[4] = bf2f(v.z & 0xffff); dst[5] = bf2f(v.z >> 16); dst[6] = bf2f(v.w & 0xffff); dst[7] = bf2f(v.w >> 16);
    }
    uint4 o;
#pragma unroll
    for (int j = 0; j < 8; ++j) y[j] = y[j] * sigmoidf_(y[j]);
    o.x = pack2(y[0], y[1]); o.y = pack2(y[2], y[3]); o.z = pack2(y[4], y[5]); o.w = pack2(y[6], y[7]);
    *(uint4*)(cb + (size_t)r * 512 + c0) = o;
  }
}

__device__ void m_fold(const Params& P) {
  const int lane = threadIdx.x & 63, w = threadIdx.x >> 6;
  const float* FL = (const float*)(P.ws + O_FL); const float* UC = (const float*)(P.ws + O_UC);
  float* MCS = (float*)(P.ws + O_MCS);
  const int slot = (int)gridDim.x - 1 - (int)blockIdx.x;
  if (w == 3 && slot < 16) {
    const int bh = slot, b = bh >> 2, h = bh & 3;
    const int c0 = 2 * lane;
    const float fl0 = FL[(b * 128 + c0) * 4 + h], uc0 = UC[(b * 128 + c0) * 4 + h];
    const float fl1 = FL[(b * 128 + c0 + 1) * 4 + h], uc1 = UC[(b * 128 + c0 + 1) * 4 + h];
    float a = fl0 + fl1, bb = fmaxf(fl0 + uc0 + fl1, fl1 + uc1);
#pragma unroll
    for (int o = 1; o < 64; o <<= 1) {
      float ap = __shfl_up(a, o), bp = __shfl_up(bb, o);
      if (lane >= o) { bb = fmaxf(bp + a, bb); a = ap + a; }
    }
    float ae = __shfl_up(a, 1), be = __shfl_up(bb, 1);
    float m0 = lane == 0 ? 0.f : fmaxf(ae, be);
    float m1 = fl0 + fmaxf(m0, uc0);
    MCS[bh * 128 + c0] = m0;
    MCS[bh * 128 + c0 + 1] = m1;
  }
  const int gtid = blockIdx.x * NTHREADS + threadIdx.x;
  if (gtid < 64) MCS[2048 + gtid] = P.st_m[gtid];
}
__device__ void phase_mqk(const Params& P, char* smem) {
  bfu* sA = (bfu*)smem; bfu* sB = sA + 128 * 72;
  const bfu* cb = (const bfu*)(P.ws + SLOT(0));
  for (int t = blockIdx.x; t < 260 * 8; t += gridDim.x) {
    int mt = t >> 3, which = (t >> 2) & 1, hh = t & 3;
    const bfu* wt = (const bfu*)(P.ws + (which ? O_WT_MK : O_WT_MQ)) + hh * 16384;
    f32x16 acc[2][2]; zero_acc(acc);
    gemm_acc(acc, cb + (size_t)mt * 128 * 512 + hh * 128, 512, wt, 128, 128, sA, sB);
    bfu* dst = (bfu*)(P.ws + SLOT(which ? 13 : 1));
    float sc = which ? 0.08838834764831845f : 1.f;
    bfu* sT = (bfu*)smem;
    __syncthreads();
    stage_rm(sT, acc, sc);
    __syncthreads();
    copyout_bf16(sT, dst + (size_t)mt * 128 * 512 + hh * 128, 512);
  }
}

struct Item { int b, h, c, row0, L, T, chunk, bh; bool prompt; size_t vt_off; };
__device__ __forceinline__ Item decode_item(int idx) {
  Item it;
  if (idx < 2048) {
    it.prompt = true; it.b = idx >> 9; it.h = (idx >> 7) & 3; it.c = idx & 127; it.row0 = it.b * 8192 + it.c * 64;
    it.L = 64; it.T = 8192; it.chunk = it.b * 128 + it.c; it.bh = it.b * 4 + it.h;
    it.vt_off = ((size_t)(it.bh * 128)) * 8192 + it.c * 64;
  } else {
    int si = idx - 2048; it.prompt = false; it.b = si >> 2; it.h = si & 3; it.c = 0; it.row0 = MP + it.b * 32;
    it.L = 32; it.T = 32; it.chunk = 512 + it.b; it.bh = it.b * 4 + it.h;
    it.vt_off = SB_T + ((size_t)(it.bh * 128)) * 32;
  }
  return it;
}
__device__ __forceinline__ bfu* ds_ptr(const Params& P, int mixer, int idx) {
  if (idx < 2048) return (bfu*)P.out + ((size_t)(mixer * 2048 + idx)) * 16384;
  return (bfu*)(P.ws + O_DSS) + ((size_t)(mixer * 64 + (idx - 2048))) * 16384;
}
__device__ __forceinline__ float ret_lg(int h) { return log1pf(-exp2f(-5.f - (float)h)); }

__device__ void phaseA_item(const Params& P, int mixer, int idx, char* smem) {
  const int tid = threadIdx.x, lane = tid & 63, w = tid >> 6, wm = w & 1, wn = w >> 1;
  Item it = decode_item(idx);
  bfu* sK = (bfu*)smem; bfu* sV = sK + 128 * 72;
  float* sw = (float*)(sV + 128 * 72);
  float* sm = sw + 64;
  const int L = it.L, h = it.h;
  const bfu* Ksrc = (const bfu*)(P.ws + SLOT(mixer == 0 ? 3 : 13)) + (size_t)it.row0 * 512 + h * 128;
  const bfu* Vsrc = (const bfu*)(P.ws + SLOT(mixer == 0 ? 4 : 7)) + it.vt_off;
  uint4 kreg[4], vreg[4];
#pragma unroll
  for (int i = 0; i < 4; ++i) {
    int id = tid + i * 256, s = id & 63, dc = (id >> 6) * 8;
    kreg[i] = make_uint4(0, 0, 0, 0);
    if (s < L) kreg[i] = *(const uint4*)(Ksrc + (size_t)s * 512 + dc);
    int e = id >> 3, sc = (id & 7) * 8;
    vreg[i] = make_uint4(0, 0, 0, 0);
    if (sc < L) vreg[i] = *(const uint4*)(Vsrc + (size_t)e * it.T + sc);
  }
  if (mixer == 0) {
    if (tid < 64) { float lg = ret_lg(h); sw[tid] = tid < L ? __expf(lg * (float)(L - 1 - tid)) : 0.f; }
  } else {
    const float* FL = (const float*)(P.ws + O_FL); const float* UC = (const float*)(P.ws + O_UC);
    float mc = ((const float*)(P.ws + O_MCS))[idx];
    float Ml = fmaxf(mc, UC[it.chunk * 4 + h]);
    if (tid < 64) sw[tid] = tid < L ? __expf(((const float*)(P.ws + O_UQ))[(size_t)(it.row0 + tid) * 4 + h] - Ml) : 0.f;
    if (tid == 0) {
      ((float*)(P.ws + O_AEND))[idx] = __expf(mc - Ml);
      if (!it.prompt) P.out[OO_MS + it.bh] = FL[it.chunk * 4 + h] + Ml;
      else if (it.c == 127) P.out[OO_MP + it.bh] = FL[it.chunk * 4 + h] + Ml;
    }
  }
  __syncthreads();
#pragma unroll
  for (int i = 0; i < 4; ++i) {
    int id = tid + i * 256, s = id & 63, dc = (id >> 6) * 8;
    uint4 v = kreg[i];
    float ww = sw[s];
    unsigned vv[4] = {v.x, v.y, v.z, v.w};
#pragma unroll
    for (int j = 0; j < 4; ++j) {
      sK[(dc + 2 * j) * 72 + s] = f2bf(bf2f(vv[j] & 0xffff) * ww);
      sK[(dc + 2 * j + 1) * 72 + s] = f2bf(bf2f(vv[j] >> 16) * ww);
    }
  }
#pragma unroll
  for (int i = 0; i < 4; ++i) {
    int id = tid + i * 256, e = id >> 3, sc = (id & 7) * 8;
    *(uint4*)(sV + e * 72 + sc) = vreg[i];
  }
  __syncthreads();
  f32x16 acc[2][2]; zero_acc(acc);
#pragma unroll
  for (int ks = 0; ks < 4; ++ks) {
    bf16x8 af[2], bfr[2];
#pragma unroll
    for (int mi = 0; mi < 2; ++mi)
      af[mi] = *(const bf16x8*)(sK + (wm * 64 + mi * 32 + (lane & 31)) * 72 + ks * 16 + (lane >> 5) * 8);
#pragma unroll
    for (int ni = 0; ni < 2; ++ni)
      bfr[ni] = *(const bf16x8*)(sV + (wn * 32 + ni * 64 + (lane & 31)) * 72 + ks * 16 + (lane >> 5) * 8);
#pragma unroll
    for (int mi = 0; mi < 2; ++mi)
#pragma unroll
      for (int ni = 0; ni < 2; ++ni)
        acc[mi][ni] = __builtin_amdgcn_mfma_f32_32x32x16_bf16(af[mi], bfr[ni], acc[mi][ni], 0, 0, 0);
  }
  bfu* dS = ds_ptr(P, mixer, idx);
  bfu* sD = (bfu*)(smem + 40960);
  {
    EPI_BEGIN
#pragma unroll
      for (int ni = 0; ni < 2; ++ni) {
        int e = cl + ni * 64;
        uint2 o; o.x = pack2(acc[mi][ni][q * 4 + 0], acc[mi][ni][q * 4 + 1]); o.y = pack2(acc[mi][ni][q * 4 + 2], acc[mi][ni][q * 4 + 3]);
        *(uint2*)(sD + e * 136 + r0) = o;
      }
    EPI_END
  }
  __syncthreads();
#pragma unroll
  for (int i = 0; i < 8; ++i) {
    int id = tid + i * 256, e = id >> 4, c8 = (id & 15) * 8;
    *(uint4*)(dS + e * 128 + c8) = *(const uint4*)(sD + e * 136 + c8);
  }
  if (mixer == 1 && tid < 128) {
    float s = 0.f;
#pragma unroll
    for (int j = 0; j < 8; ++j) { float f[8]; unpack8(*(const uint4*)(sK + tid * 72 + j * 8), f);
#pragma unroll
      for (int k = 0; k < 8; ++k) s += f[k]; }
    ((float*)(P.ws + O_DN))[(size_t)idx * 128 + tid] = s;
  }
  __syncthreads();
}

__device__ void phase_scan(const Params& P) {
  const int gtid = blockIdx.x * NTHREADS + threadIdx.x, gstride = gridDim.x * NTHREADS;
  const float* AE = (const float*)(P.ws + O_AEND);
  for (int i = gtid; i < 131072; i += gstride) {
    int mixer = i >> 16, bh = (i >> 12) & 15, eo = (i & 4095) * 4;
    int h = bh & 3;
    float gch = __expf(ret_lg(h) * 64.f);
    float st[4];
#pragma unroll
    for (int j = 0; j < 4; ++j) st[j] = 0.f;
    bfu* base = (bfu*)P.out + ((size_t)(mixer * 2048 + bh * 128)) * 16384 + eo;
    for (int c = 0; c < 128; c += 8) {
      uint2 v[8];
#pragma unroll
      for (int k = 0; k < 8; ++k) v[k] = *(const uint2*)(base + (size_t)(c + k) * 16384);
#pragma unroll
      for (int k = 0; k < 8; ++k) {
        float dec = mixer == 0 ? gch : AE[bh * 128 + c + k];
        float d0 = bf2f(v[k].x & 0xffff), d1 = bf2f(v[k].x >> 16), d2 = bf2f(v[k].y & 0xffff), d3 = bf2f(v[k].y >> 16);
        uint2 o; o.x = pack2(st[0], st[1]); o.y = pack2(st[2], st[3]);
        *(uint2*)(base + (size_t)(c + k) * 16384) = o;
        st[0] = dec * st[0] + d0; st[1] = dec * st[1] + d1; st[2] = dec * st[2] + d2; st[3] = dec * st[3] + d3;
      }
    }
    float* o = P.out + (mixer == 0 ? OO_RETP : OO_CP) + (size_t)bh * 16384;
    int e = eo >> 7, d0i = eo & 127;
#pragma unroll
    for (int j = 0; j < 4; ++j) o[(d0i + j) * 128 + e] = st[j];
  }
  for (int i = gtid; i < 2 * 64 * 2048; i += gstride) {
    int mixer = i >> 17, bh = (i >> 11) & 63, eo = (i & 2047) * 8;
    int h = bh & 3;
    int e = eo >> 7, d0 = eo & 127;
    const float* s0 = (mixer == 0 ? P.st_ret : P.st_C) + (size_t)bh * 16384;
    float st[8];
#pragma unroll
    for (int j = 0; j < 8; ++j) st[j] = s0[(d0 + j) * 128 + e];
    bfu* p = (bfu*)(P.ws + O_DSS) + ((size_t)(mixer * 64 + bh)) * 16384 + eo;
    float d[8]; unpack8(*(const uint4*)p, d);
    *(uint4*)p = pack8(st);
    float dec = mixer == 0 ? __expf(ret_lg(h) * 32.f) : AE[2048 + bh];
    float* o = P.out + (mixer == 0 ? OO_RETS : OO_CS) + (size_t)bh * 16384;
#pragma unroll
    for (int j = 0; j < 8; ++j) o[(d0 + j) * 128 + e] = dec * st[j] + d[j];
  }
  float* DN = (float*)(P.ws + O_DN);
  for (int i = gtid; i < 16 * 128; i += gstride) {
    int bh = i >> 7, d = i & 127;
    float n = 0.f;
    for (int c0 = 0; c0 < 128; c0 += 16) {
      float v[16], ae[16];
#pragma unroll
      for (int k = 0; k < 16; ++k) { v[k] = DN[(size_t)(bh * 128 + c0 + k) * 128 + d]; ae[k] = AE[bh * 128 + c0 + k]; }
#pragma unroll
      for (int k = 0; k < 16; ++k) { DN[(size_t)(bh * 128 + c0 + k) * 128 + d] = n; n = ae[k] * n + v[k]; }
    }
    P.out[OO_NP + i] = n;
  }
  for (int i = gtid; i < 64 * 128; i += gstride) {
    int bh = i >> 7, d = i & 127;
    size_t o = (size_t)(2048 + bh) * 128 + d;
    float n0 = P.st_n[i]; float v = DN[o]; DN[o] = n0;
    P.out[OO_NS + i] = AE[2048 + bh] * n0 + v;
  }
}

__device__ void phaseC_item(const Params& P, int mixer, int idx, char* smem) {
  const int tid = threadIdx.x, lane = tid & 63, w = tid >> 6;
  Item it = decode_item(idx);
  const int L = it.L, h = it.h;
  bfu* sQ = (bfu*)smem;
  bfu* sKV = sQ + 64 * 136;
  bfu* sP = sKV + 128 * 72;
  bfu* sS = sP + 64 * 72;
  float* sO = (float*)sS;
  float* sRow = (float*)(sS + 128 * 136);
  const bfu* Qsrc = (const bfu*)(P.ws + SLOT(mixer == 0 ? 2 : 1)) + (size_t)it.row0 * 512 + h * 128;
  const bfu* Ksrc = (const bfu*)(P.ws + SLOT(mixer == 0 ? 3 : 13)) + (size_t)it.row0 * 512 + h * 128;
  const bfu* Vsrc = (const bfu*)(P.ws + SLOT(mixer == 0 ? 4 : 7)) + it.vt_off;
  const bfu* Ssrc = ds_ptr(P, mixer, idx);
  const float lg = ret_lg(h);
  uint4 vpre[4];
#pragma unroll
  for (int i = 0; i < 4; ++i) {
    int id = tid + i * 256, e = id >> 3, sc = (id & 7) * 8;
    vpre[i] = make_uint4(0, 0, 0, 0);
    if (sc < L) vpre[i] = *(const uint4*)(Vsrc + (size_t)e * it.T + sc);
  }
#pragma unroll
  for (int i = 0; i < 4; ++i) {
    int id = tid + i * 256, s = id >> 4, dc = (id & 15) * 8;
    uint4 vq = make_uint4(0, 0, 0, 0), vk = vq;
    if (s < L) { vq = *(const uint4*)(Qsrc + (size_t)s * 512 + dc); vk = *(const uint4*)(Ksrc + (size_t)s * 512 + dc); }
    *(uint4*)(sQ + s * 136 + dc) = vq;
    *(uint4*)(sKV + s * 136 + dc) = vk;
  }
#pragma unroll
  for (int i = 0; i < 8; ++i) {
    int id = tid + i * 256, e = id >> 4, dc = (id & 15) * 8;
    *(uint4*)(sS + e * 136 + dc) = *(const uint4*)(Ssrc + e * 128 + dc);
  }
  if (tid < 64) {
    int i = tid;
    if (mixer == 0) {
      sRow[128 + i] = __expf(lg * (float)(i + 1));
    } else {
      float mc = ((const float*)(P.ws + O_MCS))[idx];
      size_t gi = (size_t)(it.row0 + i) * 4 + h;
      bool valid = i < L;
      float u = valid ? ((const float*)(P.ws + O_UQ))[gi] : -INFINITY;
      float M = valid ? fmaxf(mc, ((const float*)(P.ws + O_CMQ))[gi]) : 0.f;
      float F = valid ? ((const float*)(P.ws + O_FQ))[gi] : 0.f;
      sRow[i] = u; sRow[64 + i] = M; sRow[128 + i] = valid ? __expf(mc - M) : 0.f;
      sRow[256 + i] = __expf(-(F + M));
    }
  }
  __syncthreads();
  {
    const int mi = w & 1, ni = w >> 1;
    f32x16 acc;
#pragma unroll
    for (int i = 0; i < 16; ++i) acc[i] = 0.f;
#pragma unroll 2
    for (int ks = 0; ks < 8; ++ks) {
      bf16x8 af = *(const bf16x8*)(sQ + (mi * 32 + (lane & 31)) * 136 + ks * 16 + (lane >> 5) * 8);
      bf16x8 bfr = *(const bf16x8*)(sKV + (ni * 32 + (lane & 31)) * 136 + ks * 16 + (lane >> 5) * 8);
      acc = __builtin_amdgcn_mfma_f32_32x32x16_bf16(af, bfr, acc, 0, 0, 0);
    }
    const int s = ni * 32 + (lane & 31);
    float us = mixer ? sRow[s] : 0.f;
#pragma unroll
    for (int reg = 0; reg < 16; ++reg) {
      int i = mi * 32 + (reg & 3) + 8 * (reg >> 2) + 4 * (lane >> 5);
      float wgt;
      if (mixer == 0) wgt = (s <= i) ? __expf(lg * (float)(i - s)) : 0.f;
      else wgt = (s <= i && i < L) ? __expf(us - sRow[64 + i]) : 0.f;
      sP[i * 72 + s] = f2bf(acc[reg] * wgt);
    }
  }
  __syncthreads();
#pragma unroll
  for (int i = 0; i < 4; ++i) {
    int id = tid + i * 256, e = id >> 3, sc = (id & 7) * 8;
    *(uint4*)(sKV + e * 72 + sc) = vpre[i];
  }
  __syncthreads();
  f32x16 acc1[2], acc2[2];
  const int mi = w & 1, nj = w >> 1;
#pragma unroll
  for (int t = 0; t < 2; ++t)
#pragma unroll
    for (int i = 0; i < 16; ++i) { acc1[t][i] = 0.f; acc2[t][i] = 0.f; }
#pragma unroll 2
  for (int ks = 0; ks < 4; ++ks) {
    bf16x8 af = *(const bf16x8*)(sP + (mi * 32 + (lane & 31)) * 72 + ks * 16 + (lane >> 5) * 8);
#pragma unroll
    for (int t = 0; t < 2; ++t) {
      bf16x8 bfr = *(const bf16x8*)(sKV + (nj * 64 + t * 32 + (lane & 31)) * 72 + ks * 16 + (lane >> 5) * 8);
      acc1[t] = __builtin_amdgcn_mfma_f32_32x32x16_bf16(af, bfr, acc1[t], 0, 0, 0);
    }
  }
#pragma unroll 2
  for (int ks = 0; ks < 8; ++ks) {
    bf16x8 af = *(const bf16x8*)(sQ + (mi * 32 + (lane & 31)) * 136 + ks * 16 + (lane >> 5) * 8);
#pragma unroll
    for (int t = 0; t < 2; ++t) {
      bf16x8 bfr = *(const bf16x8*)(sS + (nj * 64 + t * 32 + (lane & 31)) * 136 + ks * 16 + (lane >> 5) * 8);
      acc2[t] = __builtin_amdgcn_mfma_f32_32x32x16_bf16(af, bfr, acc2[t], 0, 0, 0);
    }
  }
  if (mixer == 1) {
    int i = tid >> 2, part = tid & 3;
    const float* nprev = (const float*)(P.ws + O_DN) + (size_t)idx * 128;
    float dl = 0.f, qn = 0.f;
#pragma unroll 4
    for (int s = part * 16; s < part * 16 + 16; ++s) dl += bf2f(sP[i * 72 + s]);
#pragma unroll 4
    for (int d = part * 32; d < part * 32 + 32; ++d) qn += bf2f(sQ[i * 136 + d]) * nprev[d];
    dl += __shfl_xor(dl, 1); dl += __shfl_xor(dl, 2);
    qn += __shfl_xor(qn, 1); qn += __shfl_xor(qn, 2);
    if (part == 0) {
      float den = dl + sRow[128 + i] * qn;
      sRow[192 + i] = 1.f / fmaxf(fabsf(den), sRow[256 + i]);
    }
  }
  __syncthreads();
#pragma unroll
  for (int t = 0; t < 2; ++t) {
    int e = nj * 64 + t * 32 + (lane & 31);
#pragma unroll
    for (int reg = 0; reg < 16; ++reg) {
      int i = mi * 32 + (reg & 3) + 8 * (reg >> 2) + 4 * (lane >> 5);
      float o = acc1[t][reg] + sRow[128 + i] * acc2[t][reg];
      if (mixer == 1) o *= sRow[192 + i];
      sO[i * 132 + e] = o;
    }
  }
  __syncthreads();
  {
    int i = tid >> 2, part = tid & 3;
    float ss = 0.f;
#pragma unroll 4
    for (int e = part * 32; e < part * 32 + 32; ++e) { float v = sO[i * 132 + e]; ss += v * v; }
    ss += __shfl_xor(ss, 1); ss += __shfl_xor(ss, 2);
    float rstd = rsqrtf(ss * (1.f / 128.f) + EPS);
    if (i < L) {
      size_t ro = (size_t)(it.row0 + i) * 512 + h * 128 + part * 32;
      const float* so = sO + i * 132 + part * 32;
      if (mixer == 0) {
        bfu* y = (bfu*)(P.ws + SLOT(5)) + ro;
        const float* g = P.g_ret_gn + h * 128 + part * 32;
        uint4 gv[4];
#pragma unroll
        for (int k = 0; k < 4; ++k) gv[k] = *(const uint4*)(y + k * 8);
#pragma unroll
        for (int k = 0; k < 4; ++k) {
          float gt[8], o[8];
          unpack8(gv[k], gt);
#pragma unroll
          for (int j = 0; j < 8; ++j) o[j] = gt[j] * sigmoidf_(gt[j]) * so[k * 8 + j] * rstd * g[k * 8 + j];
          *(uint4*)(y + k * 8) = pack8(o);
        }
      } else {
        bfu* y = (bfu*)(P.ws + SLOT(8)) + ro;
        const bfu* cc = (const bfu*)(P.ws + SLOT(0)) + ro;
        const float* g = P.g_ml_gn + h * 128 + part * 32;
        const float* ws = P.w_skip + h * 128 + part * 32;
        uint4 gv[4], cv[4];
#pragma unroll
        for (int k = 0; k < 4; ++k) { gv[k] = *(const uint4*)(y + k * 8); cv[k] = *(const uint4*)(cc + k * 8); }
#pragma unroll
        for (int k = 0; k < 4; ++k) {
          float gt[8], c8[8], o[8];
          unpack8(gv[k], gt); unpack8(cv[k], c8);
#pragma unroll
          for (int j = 0; j < 8; ++j) o[j] = sigmoidf_(gt[j]) * (so[k * 8 + j] * rstd * g[k * 8 + j] + ws[k * 8 + j] * c8[j]);
          *(uint4*)(y + k * 8) = pack8(o);
        }
      }
    }
  }
  __syncthreads();
}

__device__ void phase_merge(const Params& P, char* smem) {
  bfu* sA = (bfu*)smem; bfu* sB = sA + 128 * 72;
  const bfu* yr = (const bfu*)(P.ws + SLOT(5)); const bfu* ym = (const bfu*)(P.ws + SLOT(8));
  const bfu* gr = (const bfu*)(P.ws + SLOT(9)); const bfu* gm = (const bfu*)(P.ws + SLOT(11));
  bfu* mg = (bfu*)(P.ws + SLOT(6));
  for (int t = blockIdx.x; t < 260 * 8; t += gridDim.x) {
    int mt, nt; tile_map(t, 260, 8, mt, nt);
    f32x16 acc[2][2]; zero_acc(acc);
    bfu* sT = (bfu*)smem;
    const size_t tbase = (size_t)mt * 128 * 1024 + nt * 128;
    uint4 t1[8];
    gemm_acc(acc, yr + (size_t)mt * 128 * 512, 512, (const bfu*)(P.ws + O_WT_UPR) + (size_t)nt * 128 * 512, 512, 512, sA, sB);
    __syncthreads();
    stage_rm(sT, acc, 1.f);
    __syncthreads();
#pragma unroll
    for (int i = 0; i < 8; ++i) {
      int id = threadIdx.x + i * 256, row = id >> 4, c8 = (id & 15) * 8;
      float a[8], g[8];
      unpack8(*(const uint4*)(sT + row * ST_LD + c8), a);
      unpack8(*(const uint4*)(gr + tbase + (size_t)row * 1024 + c8), g);
#pragma unroll
      for (int j = 0; j < 8; ++j) a[j] *= sigmoidf_(g[j]);
      t1[i] = pack8(a);
    }
    zero_acc(acc);
    gemm_acc(acc, ym + (size_t)mt * 128 * 512, 512, (const bfu*)(P.ws + O_WT_UPM) + (size_t)nt * 128 * 512, 512, 512, sA, sB);
    __syncthreads();
    stage_rm(sT, acc, 1.f);
    __syncthreads();
#pragma unroll
    for (int i = 0; i < 8; ++i) {
      int id = threadIdx.x + i * 256, row = id >> 4, c8 = (id & 15) * 8;
      float a[8], g[8], t[8];
      unpack8(*(const uint4*)(sT + row * ST_LD + c8), a);
      unpack8(*(const uint4*)(gm + tbase + (size_t)row * 1024 + c8), g);
      unpack8(t1[i], t);
#pragma unroll
      for (int j = 0; j < 8; ++j) a[j] = t[j] + a[j] * sigmoidf_(g[j]);
      *(uint4*)(mg + tbase + (size_t)row * 1024 + c8) = pack8(a);
    }
  }
}

__device__ void phase_outproj(const Params& P, char* smem) {
  bfu* sA = (bfu*)smem; bfu* sB = sA + 128 * 72;
  const bfu* mg = (const bfu*)(P.ws + SLOT(6));
  for (int t = blockIdx.x; t < 260 * 8; t += gridDim.x) {
    int mt, nt; tile_map(t, 260, 8, mt, nt);
    f32x16 acc[2][2]; zero_acc(acc);
    gemm_acc(acc, mg + (size_t)mt * 128 * 1024, 1024, (const bfu*)(P.ws + O_WT_OUT) + (size_t)nt * 128 * 1024, 1024, 1024, sA, sB);
    float* sT32 = (float*)smem;
    __syncthreads();
    {
      EPI_BEGIN
#pragma unroll
        for (int j = 0; j < 4; ++j) {
          sT32[(r0 + j) * ST32_LD + cl] = acc[mi][0][q * 4 + j];
          sT32[(r0 + j) * ST32_LD + cl + 64] = acc[mi][1][q * 4 + j];
        }
      EPI_END
    }
    __syncthreads();
#pragma unroll
    for (int i = 0; i < 16; ++i) {
      int id = threadIdx.x + i * 256, row = id >> 5, c4 = (id & 31) * 4;
      int r = mt * 128 + row;
      float4 a = *(const float4*)(sT32 + row * ST32_LD + c4);
      float4 x = *(const float4*)(xrow(P, r) + nt * 128 + c4);
      float4 o = make_float4(x.x + a.x, x.y + a.y, x.z + a.z, x.w + a.w);
      *(float4*)(P.out + (size_t)r * 1024 + nt * 128 + c4) = o;
      float4 g = *(const float4*)(P.g_ffn + nt * 128 + c4);
      uint2 hv; hv.x = pack2(o.x * g.x, o.y * g.y); hv.y = pack2(o.z * g.z, o.w * g.w);
      *(uint2*)((bfu*)(P.ws + SLOT(0)) + (size_t)r * 1024 + nt * 128 + c4) = hv;
      float ss = o.x * o.x + o.y * o.y + o.z * o.z + o.w * o.w;
      ss = dpp_ror_add(ss, 8); ss = dpp_ror_add(ss, 4); ss = dpp_ror_add(ss, 2); ss = dpp_ror_add(ss, 1);
      ss += __shfl_xor(ss, 16);
      if ((threadIdx.x & 31) == 0) ((float*)(P.ws + O_GPRE))[(size_t)r * 8 + nt] = ss;
    }
  }
}

__device__ void phase_norm_rows(const Params& P, const float* g, bfu* dst) {
  const int lane = threadIdx.x & 63, w = threadIdx.x >> 6;
  for (int r = blockIdx.x * 4 + w; r < MT; r += gridDim.x * 4) {
    const float* xr = P.out + (size_t)r * 1024;
    float4 v[4]; float ss = 0.f;
#pragma unroll
    for (int i = 0; i < 4; ++i) {
      v[i] = *(const float4*)(xr + i * 256 + lane * 4);
      ss += v[i].x * v[i].x + v[i].y * v[i].y + v[i].z * v[i].z + v[i].w * v[i].w;
    }
    ss = wave_sum(ss);
    float rstd = rsqrtf(ss * (1.f / 1024.f) + EPS);
#pragma unroll
    for (int i = 0; i < 4; ++i) {
      float4 gg = *(const float4*)(g + i * 256 + lane * 4);
      uint2 o; o.x = pack2(v[i].x * rstd * gg.x, v[i].y * rstd * gg.y); o.y = pack2(v[i].z * rstd * gg.z, v[i].w * rstd * gg.w);
      *(uint2*)(dst + (size_t)r * 1024 + i * 256 + lane * 4) = o;
    }
  }
}

__device__ void phase_pq(const Params& P, char* smem) {
  bfu* sA = (bfu*)smem; bfu* sB = sA + 128 * 72;
  const bfu* hq = (const bfu*)(P.ws + SLOT(0));
  bfu* qb = (bfu*)(P.ws + SLOT(9));
  for (int t = blockIdx.x; t < 260 * 16; t += gridDim.x) {
    int mt, nt; tile_map(t, 260, 16, mt, nt);
    f32x16 acc[2][2]; zero_acc(acc);
    float* sRstd = (float*)(smem + 66048);
    if (threadIdx.x < 128) {
      const float* pp = (const float*)(P.ws + O_GPRE) + (size_t)(mt * 128 + threadIdx.x) * 8;
      float4 p0 = *(const float4*)pp, p1 = *(const float4*)(pp + 4);
      sRstd[threadIdx.x] = rsqrtf((p0.x + p0.y + p0.z + p0.w + p1.x + p1.y + p1.z + p1.w) * (1.f / 1024.f) + EPS);
    }
    gemm_acc(acc, hq + (size_t)mt * 128 * 1024, 1024, (const bfu*)(P.ws + O_WT_PQ) + (size_t)nt * 128 * 1024, 1024, 1024, sA, sB);
    bfu* sT = (bfu*)smem;
    __syncthreads();
    {
      EPI_BEGIN
#pragma unroll
        for (int j = 0; j < 4; ++j) {
          const float rs = sRstd[r0 + j];
          sT[(r0 + j) * ST_LD + cl] = f2bf(acc[mi][0][q * 4 + j] * rs);
          sT[(r0 + j) * ST_LD + cl + 64] = f2bf(acc[mi][1][q * 4 + j] * rs);
        }
      EPI_END
    }
    __syncthreads();
    copyout_bf16(sT, qb + (size_t)mt * 128 * 2048 + nt * 128, 2048);
  }
}


template <bool DESC> __device__ __forceinline__ void cex(float& a, float& b) {
  float mx = fmaxf(a, b), mn = fminf(a, b);
  a = DESC ? mx : mn; b = DESC ? mn : mx;
}
template <int B, bool DESC> __device__ __forceinline__ void bmerge16(float (&v)[64]) {
#pragma unroll
  for (int j = 8; j > 0; j >>= 1)
#pragma unroll
    for (int i = 0; i < 16; ++i) { int l = i ^ j; if (l > i) cex<DESC>(v[B + i], v[B + l]); }
}
template <int B, bool DESC> __device__ __forceinline__ void bsort16(float (&v)[64]) {
#pragma unroll
  for (int k = 2; k <= 16; k <<= 1)
#pragma unroll
    for (int j = k >> 1; j > 0; j >>= 1)
#pragma unroll
      for (int i = 0; i < 16; ++i) {
        int l = i ^ j;
        if (l > i) {
          bool up = ((i & k) == 0) || (k == 16);
          if (up == true) { if (DESC) cex<true>(v[B + i], v[B + l]); else cex<false>(v[B + i], v[B + l]); }
          else { if (DESC) cex<false>(v[B + i], v[B + l]); else cex<true>(v[B + i], v[B + l]); }
        }
      }
}
__device__ __forceinline__ float pair_max(float v) {
  auto r = __builtin_amdgcn_permlane32_swap(__float_as_int(v), __float_as_int(v), false, false);
  return fmaxf(__int_as_float(r[0]), __int_as_float(r[1]));
}
__device__ void phase_topk(const Params& P, char* smem) {
  const int tid = threadIdx.x, lane = tid & 63, w = tid >> 6, r32 = lane & 31, hh = lane >> 5;
  unsigned* sL = (unsigned*)smem + w * 1664;
  unsigned* sW = sL + 32 * 33;
  const bfu* qb = (const bfu*)(P.ws + SLOT(9));
  const bfu* keys = (const bfu*)(P.ws + O_KEYS);
  int* ids = (int*)(P.ws + SLOT(4));
  float* gw = (float*)(P.ws + SLOT(13));
  bfu* sKey = (bfu*)(smem + 26624);
  for (int u = blockIdx.x; u < 2080; u += gridDim.x) {
    const int n = u & 7, tg = (u >> 3) * 4 + w, rowb = tg * 32;
#pragma unroll 1
    for (int half = 0; half < 2; ++half) {
      f32x16 acc[4];
#pragma unroll
      for (int c = 0; c < 4; ++c)
#pragma unroll
        for (int i = 0; i < 16; ++i) acc[c][i] = 0.f;
      __syncthreads();
      {
        const bfu* ksrc = keys + (size_t)(n * 2 + half) * 128 * 128;
#pragma unroll
        for (int i = 0; i < 8; ++i) {
          int id = tid + i * 256, row = id >> 4, c8 = (id & 15) * 8;
          *(uint4*)(sKey + row * 136 + c8) = *(const uint4*)(ksrc + row * 128 + c8);
        }
      }
      __syncthreads();
      const bfu* kp = sKey + r32 * 136 + hh * 8;
      const bfu* qp = qb + (size_t)(rowb + r32) * 2048 + n * 256 + half * 128 + hh * 8;
#pragma unroll
      for (int ks = 0; ks < 8; ++ks) {
        bf16x8 bfr = *(const bf16x8*)(qp + ks * 16);
#pragma unroll
        for (int c = 0; c < 4; ++c) {
          bf16x8 af = *(const bf16x8*)(kp + c * 32 * 136 + ks * 16);
          acc[c] = __builtin_amdgcn_mfma_f32_32x32x16_bf16(af, bfr, acc[c], 0, 0, 0);
        }
      }
      float kk[64];
#pragma unroll
      for (int c = 0; c < 4; ++c)
#pragma unroll
        for (int reg = 0; reg < 16; ++reg) {
          unsigned kidx = c * 32 + (reg & 3) + 8 * (reg >> 2) + 4 * hh;
          kk[c * 16 + reg] = __uint_as_float((__float_as_uint(acc[c][reg]) & ~127u) | kidx);
        }
      bsort16<0, true>(kk); bsort16<16, false>(kk); bsort16<32, false>(kk); bsort16<48, true>(kk);
#pragma unroll
      for (int i = 0; i < 16; ++i) { kk[i] = fmaxf(kk[i], kk[16 + i]); kk[32 + i] = fmaxf(kk[32 + i], kk[48 + i]); }
      bmerge16<0, true>(kk); bmerge16<32, false>(kk);
#pragma unroll
      for (int i = 0; i < 16; ++i) kk[i] = fmaxf(kk[i], kk[32 + i]);
      bmerge16<0, true>(kk);
      {
        float lo[16], hi[16];
#pragma unroll
        for (int i = 0; i < 16; ++i) {
          auto r = __builtin_amdgcn_permlane32_swap(__float_as_int(kk[i]), __float_as_int(kk[i]), false, false);
          lo[i] = __int_as_float(r[0]); hi[i] = __int_as_float(r[1]);
        }
#pragma unroll
        for (int i = 0; i < 16; ++i) kk[i] = fmaxf(lo[i], hi[15 - i]);
      }
      bmerge16<0, true>(kk);
      if (hh == 0) {
#pragma unroll
        for (int p = 0; p < 16; ++p) sL[r32 * 33 + half * 16 + p] = __float_as_uint(kk[p]);
      }
    }
    __builtin_amdgcn_fence(__ATOMIC_RELEASE, "workgroup");
    __builtin_amdgcn_wave_barrier();
    __builtin_amdgcn_fence(__ATOMIC_ACQUIRE, "workgroup");
    float x[4], y[16];
    {
      const unsigned* lx = sL + r32 * 33 + (hh ? 16 : 0);
      const unsigned* ly = sL + r32 * 33 + (hh ? 0 : 16);
#pragma unroll
      for (int i = 0; i < 4; ++i) x[i] = __uint_as_float(lx[i] & ~127u);
#pragma unroll
      for (int j = 0; j < 16; ++j) y[j] = __uint_as_float(ly[j] & ~127u);
    }
    float cd[25];
#define CAND(t, i, j) { float sv = x[i] + y[j]; unsigned code = hh ? ((j) << 4 | (i)) : ((i) << 4 | (j)); \
      cd[t] = __uint_as_float((__float_as_uint(sv) & ~255u) | code); }
    CAND(0, 0, 1) CAND(1, 0, 2) CAND(2, 0, 3) CAND(3, 0, 4) CAND(4, 0, 5) CAND(5, 0, 6) CAND(6, 0, 7) CAND(7, 0, 8)
    CAND(8, 0, 9) CAND(9, 0, 10) CAND(10, 0, 11) CAND(11, 0, 12) CAND(12, 0, 13) CAND(13, 0, 14) CAND(14, 0, 15)
    CAND(15, 1, 2) CAND(16, 1, 3) CAND(17, 1, 4) CAND(18, 1, 5) CAND(19, 1, 6) CAND(20, 1, 7) CAND(21, 2, 3) CAND(22, 2, 4)
    {
      float d0 = hh ? x[2] + y[2] : x[0] + y[0];
      float d1 = hh ? x[3] + y[3] : x[1] + y[1];
      unsigned c0 = hh ? 0x22u : 0x00u, c1 = hh ? 0x33u : 0x11u;
      cd[23] = __uint_as_float((__float_as_uint(d0) & ~255u) | c0);
      cd[24] = __uint_as_float((__float_as_uint(d1) & ~255u) | c1);
    }
    {
      float cv[64];
#pragma unroll
      for (int t = 0; t < 25; ++t) cv[t] = cd[t];
#pragma unroll
      for (int t = 25; t < 32; ++t) cv[t] = -INFINITY;
      bsort16<0, true>(cv); bsort16<16, false>(cv);
#pragma unroll
      for (int i = 0; i < 16; ++i) cv[i] = fmaxf(cv[i], cv[16 + i]);
      bmerge16<0, true>(cv);
      {
        float lo[16], hi[16];
#pragma unroll
        for (int i = 0; i < 16; ++i) {
          auto r = __builtin_amdgcn_permlane32_swap(__float_as_int(cv[i]), __float_as_int(cv[i]), false, false);
          lo[i] = __int_as_float(r[0]); hi[i] = __int_as_float(r[1]);
        }
#pragma unroll
        for (int i = 0; i < 16; ++i) cv[i] = fmaxf(lo[i], hi[15 - i]);
      }
      bmerge16<0, true>(cv);
      if (hh == 0) {
#pragma unroll
        for (int p = 0; p < 16; ++p) sW[r32 * 17 + p] = __float_as_uint(cv[p]);
      }
    }
    __builtin_amdgcn_fence(__ATOMIC_RELEASE, "workgroup");
    __builtin_amdgcn_wave_barrier();
    __builtin_amdgcn_fence(__ATOMIC_ACQUIRE, "workgroup");
    {
      const unsigned* la = sL + r32 * 33;
      unsigned c0 = sW[r32 * 17] & 255u;
      float scmax = __uint_as_float(la[c0 >> 4] & ~127u) + __uint_as_float(la[16 + (c0 & 15)] & ~127u);
      float ex[8]; int ee[8]; float sum = 0.f;
#pragma unroll
      for (int k = 0; k < 8; ++k) {
        unsigned code = sW[r32 * 17 + hh * 8 + k] & 255u;
        unsigned ka = la[code >> 4], kb = la[16 + (code & 15)];
        float sc = __uint_as_float(ka & ~127u) + __uint_as_float(kb & ~127u);
        ex[k] = __expf(sc - scmax);
        ee[k] = (int)((ka & 127u) * 128u + (kb & 127u));
        sum += ex[k];
      }
      sum += __shfl_xor(sum, 32);
      float inv = 1.f / sum;
      size_t o = (size_t)(rowb + r32) * 128 + n * 16 + hh * 8;
      *(int4*)(ids + o) = make_int4(ee[0], ee[1], ee[2], ee[3]);
      *(int4*)(ids + o + 4) = make_int4(ee[4], ee[5], ee[6], ee[7]);
      *(float4*)(gw + o) = make_float4(ex[0] * inv, ex[1] * inv, ex[2] * inv, ex[3] * inv);
      *(float4*)(gw + o + 4) = make_float4(ex[4] * inv, ex[5] * inv, ex[6] * inv, ex[7] * inv);
    }
    __builtin_amdgcn_wave_barrier();
  }
}

typedef float f2v __attribute__((ext_vector_type(2)));
#define U8_SCALE 512.f
#define V8_SCALE 128.f
__device__ void convert_fp8(const float* __restrict__ src, unsigned char* __restrict__ dst, size_t n16, float scale,
                            int gtid, int gstride) {
  for (size_t i = gtid; i < n16; i += gstride) {
    unsigned w[4];
#pragma unroll
    for (int k = 0; k < 4; ++k) {
      float4 a = *(const float4*)(src + i * 16 + k * 4);
      float v0 = fminf(fmaxf(a.x * scale, -448.f), 448.f), v1 = fminf(fmaxf(a.y * scale, -448.f), 448.f);
      float v2 = fminf(fmaxf(a.z * scale, -448.f), 448.f), v3 = fminf(fmaxf(a.w * scale, -448.f), 448.f);
      int t = 0;
      t = __builtin_amdgcn_cvt_pk_fp8_f32(v0, v1, t, false);
      t = __builtin_amdgcn_cvt_pk_fp8_f32(v2, v3, t, true);
      w[k] = (unsigned)t;
    }
    *(uint4*)(dst + i * 16) = make_uint4(w[0], w[1], w[2], w[3]);
  }
}
__device__ __forceinline__ float dot16_fp8(uint4 u, const f2v* x2) {
  f2v acc = __builtin_amdgcn_cvt_pk_f32_fp8((int)u.x, false) * x2[0];
  acc += __builtin_amdgcn_cvt_pk_f32_fp8((int)u.x, true) * x2[1];
  acc += __builtin_amdgcn_cvt_pk_f32_fp8((int)u.y, false) * x2[2];
  acc += __builtin_amdgcn_cvt_pk_f32_fp8((int)u.y, true) * x2[3];
  acc += __builtin_amdgcn_cvt_pk_f32_fp8((int)u.z, false) * x2[4];
  acc += __builtin_amdgcn_cvt_pk_f32_fp8((int)u.z, true) * x2[5];
  acc += __builtin_amdgcn_cvt_pk_f32_fp8((int)u.w, false) * x2[6];
  acc += __builtin_amdgcn_cvt_pk_f32_fp8((int)u.w, true) * x2[7];
  return acc.x + acc.y;
}
__device__ __forceinline__ void axpy16_fp8(f2v* o2, float cf, uint4 v) {
  f2v c = {cf, cf};
  o2[0] += c * __builtin_amdgcn_cvt_pk_f32_fp8((int)v.x, false);
  o2[1] += c * __builtin_amdgcn_cvt_pk_f32_fp8((int)v.x, true);
  o2[2] += c * __builtin_amdgcn_cvt_pk_f32_fp8((int)v.y, false);
  o2[3] += c * __builtin_amdgcn_cvt_pk_f32_fp8((int)v.y, true);
  o2[4] += c * __builtin_amdgcn_cvt_pk_f32_fp8((int)v.z, false);
  o2[5] += c * __builtin_amdgcn_cvt_pk_f32_fp8((int)v.z, true);
  o2[6] += c * __builtin_amdgcn_cvt_pk_f32_fp8((int)v.w, false);
  o2[7] += c * __builtin_amdgcn_cvt_pk_f32_fp8((int)v.w, true);
}
#define PEER_LOAD(u, v, b)                                                                   \
  _Pragma("unroll") for (int k = 0; k < 8; ++k) {                                            \
    int j = (b) * 8 + k;                                                                     \
    int e = __builtin_amdgcn_readlane((b) < 8 ? id0 : id1, j & 63);                          \
    u[k] = *(const uint4*)(U8 + (size_t)e * 1024 + lane * 16);                               \
    v[k] = *(const uint4*)(V8 + (size_t)e * 1024 + lane * 16);                               \
  }
#define PEER_COMP(u, v, b)                                                                   \
  _Pragma("unroll") for (int hf = 0; hf < 2; ++hf) {                                         \
    float s = reduce4(dot16_fp8(u[hf * 4 + 0], x2), dot16_fp8(u[hf * 4 + 1], x2),           \
                      dot16_fp8(u[hf * 4 + 2], x2), dot16_fp8(u[hf * 4 + 3], x2)) * xr_rstd; \
    float act = 0.5f * s * (1.f + erff(s * 0.7071067811865475f));                            \
    float gsel = __shfl((b) < 8 ? g0 : g1, ((b) * 8 + hf * 4 + (lane >> 4)) & 63);           \
    float cfv = act * gsel * (1.f / V8_SCALE);                                               \
    axpy16_fp8(o2, __int_as_float(__builtin_amdgcn_readlane(__float_as_int(cfv), 0)), v[hf * 4 + 0]);  \
    axpy16_fp8(o2, __int_as_float(__builtin_amdgcn_readlane(__float_as_int(cfv), 16)), v[hf * 4 + 1]); \
    axpy16_fp8(o2, __int_as_float(__builtin_amdgcn_readlane(__float_as_int(cfv), 32)), v[hf * 4 + 2]); \
    axpy16_fp8(o2, __int_as_float(__builtin_amdgcn_readlane(__float_as_int(cfv), 48)), v[hf * 4 + 3]); \
  }
__device__ void phase_peer(const Params& P) {
  const int lane = threadIdx.x & 63, w = threadIdx.x >> 6;
  bfu* hq = (bfu*)(P.ws + SLOT(0));
  const unsigned char* U8 = (const unsigned char*)(P.ws + SLOT(2));
  const unsigned char* V8 = (const unsigned char*)(P.ws + SLOT(3));
  const int* ids = (const int*)(P.ws + SLOT(4));
  const float* gw = (const float*)(P.ws + SLOT(13));
  bfu* pbf = (bfu*)(P.ws + SLOT(6));
  int nid0 = 0, nid1 = 0;
  if (blockIdx.x * 4 + w < MT) { nid0 = ids[(size_t)(blockIdx.x * 4 + w) * 128 + lane]; nid1 = ids[(size_t)(blockIdx.x * 4 + w) * 128 + 64 + lane]; }
  for (int r = blockIdx.x * 4 + w; r < MT; r += gridDim.x * 4) {
    f2v x2[8], o2[8];
    {
      uint4 v0 = *(const uint4*)(hq + (size_t)r * 1024 + lane * 16);
      uint4 v1 = *(const uint4*)(hq + (size_t)r * 1024 + lane * 16 + 8);
      float xf[16];
      unpack8(v0, xf); unpack8(v1, xf + 8);
#pragma unroll
      for (int j = 0; j < 8; ++j) { x2[j].x = xf[2 * j]; x2[j].y = xf[2 * j + 1]; o2[j].x = 0.f; o2[j].y = 0.f; }
    }
    const int id0 = nid0, id1 = nid1;
    float g0 = gw[(size_t)r * 128 + lane], g1 = gw[(size_t)r * 128 + 64 + lane];
    float xr_rstd;
    {
      const float* pp = (const float*)(P.ws + O_GPRE) + (size_t)r * 8;
      float4 p0 = *(const float4*)pp, p1 = *(const float4*)(pp + 4);
      xr_rstd = rsqrtf((p0.x + p0.y + p0.z + p0.w + p1.x + p1.y + p1.z + p1.w) * (1.f / 1024.f) + EPS) * (1.f / U8_SCALE);
    }
    uint4 uA[8], vA[8], uB[8], vB[8];
    PEER_LOAD(uA, vA, 0)
    for (int b = 0; b < 16; b += 2) {
      PEER_LOAD(uB, vB, b + 1)
      PEER_COMP(uA, vA, b)
      if (b + 2 < 16) { PEER_LOAD(uA, vA, b + 2) }
      PEER_COMP(uB, vB, b + 1)
    }
    asm volatile("" ::: "memory");
    {
      const int rn = r + (int)gridDim.x * 4;
      if (rn < MT) { nid0 = ids[(size_t)rn * 128 + lane]; nid1 = ids[(size_t)rn * 128 + 64 + lane]; }
    }
    float* xr = P.out + (size_t)r * 1024 + lane * 16;
    float x3[16];
    float ss = 0.f;
#pragma unroll
    for (int k = 0; k < 4; ++k) {
      float4 a = *(const float4*)(xr + k * 4);
      x3[k * 4 + 0] = a.x + o2[k * 2].x; x3[k * 4 + 1] = a.y + o2[k * 2].y;
      x3[k * 4 + 2] = a.z + o2[k * 2 + 1].x; x3[k * 4 + 3] = a.w + o2[k * 2 + 1].y;
      *(float4*)(xr + k * 4) = make_float4(x3[k * 4], x3[k * 4 + 1], x3[k * 4 + 2], x3[k * 4 + 3]);
    }
#pragma unroll
    for (int j = 0; j < 16; ++j) ss += x3[j] * x3[j];
    ss = wave_sum(ss);
    float rstd = rsqrtf(ss * (1.f / 1024.f) + EPS);
    float hv[16];
#pragma unroll
    for (int k = 0; k < 4; ++k) {
      float4 ga = *(const float4*)(P.g_ple + lane * 16 + k * 4);
      hv[k * 4] = x3[k * 4] * rstd * ga.x; hv[k * 4 + 1] = x3[k * 4 + 1] * rstd * ga.y;
      hv[k * 4 + 2] = x3[k * 4 + 2] * rstd * ga.z; hv[k * 4 + 3] = x3[k * 4 + 3] * rstd * ga.w;
    }
    *(uint4*)(hq + (size_t)r * 1024 + lane * 16) = pack8(hv);
    *(uint4*)(hq + (size_t)r * 1024 + lane * 16 + 8) = pack8(hv + 8);
    {
      const float* pr = r < MP ? P.pp + (size_t)r * 256 : P.ps + (size_t)(r - MP) * 256;
      float4 a = *(const float4*)(pr + lane * 4);
      uint2 ov; ov.x = pack2(a.x, a.y); ov.y = pack2(a.z, a.w);
      *(uint2*)(pbf + (size_t)r * 256 + lane * 4) = ov;
    }
  }
}

__device__ void phase_ple(const Params& P, char* smem) {
  bfu* sA = (bfu*)smem; bfu* sB = sA + 128 * 72;
  const bfu* hg = (const bfu*)(P.ws + SLOT(0));
  const bfu* pbf = (const bfu*)(P.ws + SLOT(6));
  for (int t = blockIdx.x; t < 260 * 8; t += gridDim.x) {
    int mt, nt; tile_map(t, 260, 8, mt, nt);
    f32x16 acc[2][2]; zero_acc(acc);
    bfu* sT = (bfu*)smem; float* sT32 = (float*)smem;
    uint2 pg[16];
    gemm_acc(acc, hg + (size_t)mt * 128 * 1024, 1024, (const bfu*)(P.ws + O_WT_PG) + (size_t)nt * 128 * 1024, 1024, 1024, sA, sB);
    __syncthreads();
    {
      EPI_BEGIN
#pragma unroll
        for (int j = 0; j < 4; ++j) {
          sT[(r0 + j) * ST_LD + cl] = f2bf(sigmoidf_(acc[mi][0][q * 4 + j]));
          sT[(r0 + j) * ST_LD + cl + 64] = f2bf(sigmoidf_(acc[mi][1][q * 4 + j]));
        }
      EPI_END
    }
    __syncthreads();
#pragma unroll
    for (int i = 0; i < 16; ++i) {
      int id = threadIdx.x + i * 256, row = id >> 5, c4 = (id & 31) * 4;
      pg[i] = *(const uint2*)(sT + row * ST_LD + c4);
    }
    zero_acc(acc);
    gemm_acc(acc, pbf + (size_t)mt * 128 * 256, 256, (const bfu*)(P.ws + O_WT_PLE) + (size_t)nt * 128 * 256, 256, 256, sA, sB);
    __syncthreads();
    {
      EPI_BEGIN
#pragma unroll
        for (int j = 0; j < 4; ++j) {
          sT32[(r0 + j) * ST32_LD + cl] = acc[mi][0][q * 4 + j];
          sT32[(r0 + j) * ST32_LD + cl + 64] = acc[mi][1][q * 4 + j];
        }
      EPI_END
    }
    __syncthreads();
#pragma unroll
    for (int i = 0; i < 16; ++i) {
      int id = threadIdx.x + i * 256, row = id >> 5, c4 = (id & 31) * 4;
      float4 a = *(const float4*)(sT32 + row * ST32_LD + c4);
      float* op = P.out + (size_t)(mt * 128 + row) * 1024 + nt * 128 + c4;
      float4 x = *(const float4*)op;
      float g0 = bf2f(pg[i].x & 0xffff), g1 = bf2f(pg[i].x >> 16), g2 = bf2f(pg[i].y & 0xffff), g3 = bf2f(pg[i].y >> 16);
      *(float4*)op = make_float4(x.x + a.x * g0, x.y + a.y * g1, x.z + a.z * g2, x.w + a.w * g3);
    }
  }
}

__device__ void phase_final(const Params& P) {
  const int lane = threadIdx.x & 63, w = threadIdx.x >> 6;
  for (int r = blockIdx.x * 4 + w; r < MT; r += gridDim.x * 4) {
    float* xr = P.out + (size_t)r * 1024;
    float4 v[4]; float ss = 0.f;
#pragma unroll
    for (int i = 0; i < 4; ++i) {
      v[i] = *(const float4*)(xr + i * 256 + lane * 4);
      ss += v[i].x * v[i].x + v[i].y * v[i].y + v[i].z * v[i].z + v[i].w * v[i].w;
    }
    ss = wave_sum(ss);
    float rstd = rsqrtf(ss * (1.f / 1024.f) + EPS);
#pragma unroll
    for (int i = 0; i < 4; ++i) {
      float4 gg = *(const float4*)(P.g_final + i * 256 + lane * 4);
      *(float4*)(xr + i * 256 + lane * 4) = make_float4(v[i].x * rstd * gg.x, v[i].y * rstd * gg.y, v[i].z * rstd * gg.z, v[i].w * rstd * gg.w);
    }
  }
}

__global__ void __launch_bounds__(NTHREADS, 2) fwd_megakernel(Params P) {
  extern __shared__ __attribute__((aligned(16))) char smem[];
  cg::grid_group grid = cg::this_grid();
  __shared__ uint4 xb_words;
  if (threadIdx.x == 0) xb_words = make_uint4(0u, 0u, 0u, 0u);
  __syncthreads();
  XcdBarrier xb = xcd_barrier_post((unsigned*)(P.ws + O_BAR), (volatile LAS unsigned*)&xb_words);
  if (P.out == nullptr) grid.sync();
  const int gtid = blockIdx.x * NTHREADS + threadIdx.x, gstride = gridDim.x * NTHREADS;
  phase_prep(P, smem);
  xcd_barrier(xb);
  phase_gemm1(P, smem);
  xcd_barrier(xb);
  phase_conv(P);
  gate_scan(P);
  xcd_barrier(xb);
  m_fold(P);
  phase_mqk(P, smem);
  xcd_barrier(xb);
  for (int t = blockIdx.x; t < 4224; t += gridDim.x) phaseA_item(P, t / 2112, t % 2112, smem);
  xcd_barrier(xb);
  phase_scan(P);
  xcd_barrier(xb);
  for (int t = blockIdx.x; t < 4224; t += gridDim.x) phaseC_item(P, t / 2112, t % 2112, smem);
  xcd_barrier(xb);
  phase_merge(P, smem);
  {
    const int extra = 2080 % (int)gridDim.x;
    if ((int)blockIdx.x >= extra) {
      const int cg_tid = ((int)blockIdx.x - extra) * NTHREADS + threadIdx.x, cg_str = ((int)gridDim.x - extra) * NTHREADS;
      convert_fp8(P.peer_u, (unsigned char*)(P.ws + SLOT(2)), 16384ull * 1024 / 16, U8_SCALE, cg_tid, cg_str);
      convert_fp8(P.peer_v, (unsigned char*)(P.ws + SLOT(3)), 16384ull * 1024 / 16, V8_SCALE, cg_tid, cg_str);
    }
  }
  xcd_barrier(xb);
  phase_outproj(P, smem);
  xcd_barrier(xb);
  phase_pq(P, smem);
  xcd_barrier(xb);
  phase_topk(P, smem);
  xcd_barrier(xb);
  phase_peer(P);
  xcd_barrier(xb);
  phase_ple(P, smem);
  xcd_barrier(xb);
  phase_final(P);
}

extern "C" void kernel_launch(void* const* d_in, const int* in_sizes, int n_in, void* d_out, int out_size,
                              void* d_ws, size_t ws_size, hipStream_t stream) {
  static int grid_blocks = 0;
  if (!grid_blocks) {
    hipFuncSetAttribute((const void*)fwd_megakernel, hipFuncAttributeMaxDynamicSharedMemorySize, SMEM_BYTES);
    int dev = 0, cus = 0, per_cu = 0;
    hipGetDevice(&dev);
    hipDeviceGetAttribute(&cus, hipDeviceAttributeMultiprocessorCount, dev);
    hipOccupancyMaxActiveBlocksPerMultiprocessor(&per_cu, fwd_megakernel, NTHREADS, SMEM_BYTES);
    if (per_cu > 2) per_cu = 2;
    if (per_cu < 1) per_cu = 1;
    grid_blocks = cus * per_cu;
  }
  Params p{};
  const float** pf = (const float**)&p;
  for (int i = 0; i < 32; ++i) pf[i] = (const float*)d_in[i];
  p.out = (float*)d_out;
  p.ws = (char*)d_ws;
  hipMemsetAsync((char*)d_ws + O_BAR, 0, XCD_BAR_WORDS * 4, stream);
  void* args[] = {&p};
  hipError_t e = hipLaunchCooperativeKernel((void*)fwd_megakernel, dim3(grid_blocks), dim3(NTHREADS), args, SMEM_BYTES, stream);
  if (e != hipSuccess) fprintf(stderr, "cooperative launch failed: %s (grid %d)\n", hipGetErrorString(e), grid_blocks);
}
```

```cpp
#include <hip/hip_runtime.h>
#include <hip/hip_cooperative_groups.h>
#include <cstdio>
namespace cg = cooperative_groups;

typedef unsigned short bfu;
typedef __attribute__((ext_vector_type(8))) short bf16x8;
typedef __attribute__((ext_vector_type(16))) float f32x16;

#define MT 33280
#define MP 32768
#define NTHREADS 256
#define EPS 1e-6f

struct Params {
  const float *xp, *xs, *pp, *ps, *st_ret, *st_C, *st_n, *st_m, *st_conv, *g_mix, *w_in, *g_ret_gn, *w_mq,
      *w_mk, *conv_w, *conv_b, *b_i, *b_f, *g_ml_gn, *w_skip, *w_up_r, *w_up_m, *w_out, *g_ffn, *w_pq,
      *peer_keys, *peer_u, *peer_v, *g_ple, *w_pg, *w_ple, *g_final;
  float* out;
  char* ws;
};

constexpr size_t O_WT_IN = 0;
constexpr size_t O_WT_UPR = O_WT_IN + 5632ull * 1024 * 2;
constexpr size_t O_WT_UPM = O_WT_UPR + 1024ull * 512 * 2;
constexpr size_t O_WT_OUT = O_WT_UPM + 1024ull * 512 * 2;
constexpr size_t O_WT_PQ = O_WT_OUT + 1024ull * 1024 * 2;
constexpr size_t O_WT_PG = O_WT_PQ + 2048ull * 1024 * 2;
constexpr size_t O_WT_PLE = O_WT_PG + 1024ull * 1024 * 2;
constexpr size_t O_KEYS = O_WT_PLE + 1024ull * 256 * 2;
constexpr size_t O_WT_MQ = O_KEYS + 16ull * 128 * 128 * 2;
constexpr size_t O_WT_MK = O_WT_MQ + 4ull * 128 * 128 * 2;
constexpr size_t O_COS = O_WT_MK + 4ull * 128 * 128 * 2;
constexpr size_t O_SIN = O_COS + 8192ull * 64 * 4;
constexpr size_t O_FQ = O_SIN + 8192ull * 64 * 4;
constexpr size_t O_UQ = O_FQ + (size_t)MT * 16;
constexpr size_t O_CMQ = O_UQ + (size_t)MT * 16;
constexpr size_t O_FL = O_CMQ + (size_t)MT * 16;
constexpr size_t O_UC = O_FL + 16384;
constexpr size_t O_AEND = O_UC + 16384;
constexpr size_t O_MCS = O_AEND + 16384;
constexpr size_t O_DN = O_MCS + 16384;
constexpr size_t O_DSS = O_DN + 2112ull * 128 * 4;
constexpr size_t O_GPRE = O_DSS + 2ull * 64 * 16384 * 2;
constexpr size_t O_BAR = O_GPRE + (size_t)MT * 32;
constexpr size_t O_SMALL_END = O_BAR + 16384;
constexpr size_t SLOT0 = 40ull << 20;
constexpr size_t USZ = (size_t)MT * 512 * 2;
static_assert(O_SMALL_END <= SLOT0, "small region overflow");
#define SLOT(i) (SLOT0 + (size_t)(i) * USZ)
constexpr size_t SB_T = 16ull * 128 * 8192;

constexpr size_t OO_Y = 0;
constexpr size_t OO_RETP = (size_t)MT * 1024;
constexpr size_t OO_CP = OO_RETP + 262144;
constexpr size_t OO_NP = OO_CP + 262144;
constexpr size_t OO_MP = OO_NP + 2048;
constexpr size_t OO_CONVP = OO_MP + 16;
constexpr size_t OO_RETS = OO_CONVP + 6144;
constexpr size_t OO_CS = OO_RETS + 1048576;
constexpr size_t OO_NS = OO_CS + 1048576;
constexpr size_t OO_MS = OO_NS + 8192;
constexpr size_t OO_CONVS = OO_MS + 64;

constexpr int SMEM_BYTES = 81152;

__device__ __forceinline__ bfu f2bf(float f) {
  unsigned u = __float_as_uint(f);
  u += 0x7fffu + ((u >> 16) & 1u);
  return (bfu)(u >> 16);
}
__device__ __forceinline__ float bf2f(bfu b) { return __uint_as_float(((unsigned)b) << 16); }
__device__ __forceinline__ unsigned pack2(float a, float b) { return (unsigned)f2bf(a) | ((unsigned)f2bf(b) << 16); }
__device__ __forceinline__ void unpack8(uint4 v, float* f) {
  f[0] = bf2f(v.x & 0xffff); f[1] = bf2f(v.x >> 16); f[2] = bf2f(v.y & 0xffff); f[3] = bf2f(v.y >> 16);
  f[4] = bf2f(v.z & 0xffff); f[5] = bf2f(v.z >> 16); f[6] = bf2f(v.w & 0xffff); f[7] = bf2f(v.w >> 16);
}
__device__ __forceinline__ uint4 pack8(const float* f) {
  uint4 o; o.x = pack2(f[0], f[1]); o.y = pack2(f[2], f[3]); o.z = pack2(f[4], f[5]); o.w = pack2(f[6], f[7]);
  return o;
}
__device__ __forceinline__ float wave_sum(float v) {
#pragma unroll
  for (int o = 32; o > 0; o >>= 1) v += __shfl_xor(v, o);
  return v;
}
__device__ __forceinline__ float wave_max(float v) {
#pragma unroll
  for (int o = 32; o > 0; o >>= 1) v = fmaxf(v, __shfl_xor(v, o));
  return v;
}
__device__ __forceinline__ float dpp_ror_add(float s, const int ctrl_sel) {
  int v = __float_as_int(s);
  int t;
  if (ctrl_sel == 8) t = __builtin_amdgcn_update_dpp(0, v, 0x128, 0xf, 0xf, false);
  else if (ctrl_sel == 4) t = __builtin_amdgcn_update_dpp(0, v, 0x124, 0xf, 0xf, false);
  else if (ctrl_sel == 2) t = __builtin_amdgcn_update_dpp(0, v, 0x122, 0xf, 0xf, false);
  else t = __builtin_amdgcn_update_dpp(0, v, 0x121, 0xf, 0xf, false);
  return s + __int_as_float(t);
}
__device__ __forceinline__ float reduce4(float p0, float p1, float p2, float p3) {
  auto r = __builtin_amdgcn_permlane32_swap(__float_as_int(p0), __float_as_int(p2), false, false);
  float sA = __int_as_float(r[0]) + __int_as_float(r[1]);
  r = __builtin_amdgcn_permlane32_swap(__float_as_int(p1), __float_as_int(p3), false, false);
  float sB = __int_as_float(r[0]) + __int_as_float(r[1]);
  r = __builtin_amdgcn_permlane16_swap(__float_as_int(sA), __float_as_int(sB), false, false);
  float s = __int_as_float(r[0]) + __int_as_float(r[1]);
  s = dpp_ror_add(s, 8); s = dpp_ror_add(s, 4); s = dpp_ror_add(s, 2); s = dpp_ror_add(s, 1);
  return s;
}
__device__ __forceinline__ float sigmoidf_(float x) { return 1.f / (1.f + __expf(-x)); }
__device__ __forceinline__ const float* xrow(const Params& P, int r) {
  return r < MP ? P.xp + (size_t)r * 1024 : P.xs + (size_t)(r - MP) * 1024;
}


#define XB_TMO      128
#define XB_XCNT(j)  (256  + 64 * (j))
#define XB_XSUB(j)  (1280 + 64 * (j))
#define XB_XGEN(j)  (2304 + 64 * (j))
#define XB_TOP      3328
#define XB_TOPGEN   3392
#define XCD_BAR_WORDS 3456
#define XB_SPIN_CAP (1u << 22)
#define LAS __attribute__((address_space(3)))
__device__ __forceinline__ unsigned xb_ld(unsigned* p) { return __hip_atomic_load(p, __ATOMIC_RELAXED, __HIP_MEMORY_SCOPE_AGENT); }
__device__ __forceinline__ unsigned xb_add(unsigned* p, unsigned v) { return __hip_atomic_fetch_add(p, v, __ATOMIC_RELAXED, __HIP_MEMORY_SCOPE_AGENT); }
__device__ __forceinline__ unsigned xb_xcc_id() { return (unsigned)__builtin_amdgcn_s_getreg((3 << 11) | 20) & 0xFu; }
#define XB_SPIN(cond, bar) do { unsigned _sp = 0; while (cond) { __builtin_amdgcn_s_sleep(1); \
    if ((++_sp & 255u) == 0u) { if (xb_ld(&(bar)[XB_TMO])) break; if (_sp > XB_SPIN_CAP) { atomicAdd(&(bar)[XB_TMO], 1u); break; } } } } while (0)
struct XcdBarrier { unsigned* bar; unsigned x; volatile LAS unsigned* st; };
__device__ __forceinline__ XcdBarrier xcd_barrier_post(unsigned* bar, volatile LAS unsigned* st) {
  XcdBarrier b; b.bar = bar; b.x = xb_xcc_id(); b.st = st;
  if (threadIdx.x == 0) (void)xb_add(&bar[XB_XCNT(b.x)], 1u);
  return b;
}
__device__ __forceinline__ void xcd_barrier_complete(unsigned* bar, unsigned x, unsigned& nloc, unsigned& nx) {
  const unsigned G = gridDim.x * gridDim.y * gridDim.z;
  unsigned sum, cnt, mine, sp = 0u;
  for (;;) {
    sum = 0u; cnt = 0u; mine = 0u;
#pragma unroll
    for (unsigned j = 0; j < 16; ++j) { const unsigned c = xb_ld(&bar[XB_XCNT(j)]); sum += c; cnt += (c > 0u) ? 1u : 0u; mine = (j == x) ? c : mine; }
    if (sum == G) break;
    __builtin_amdgcn_s_sleep(1);
    if ((++sp & 255u) == 0u) { if (xb_ld(&bar[XB_TMO])) break; if (sp > XB_SPIN_CAP) { atomicAdd(&bar[XB_TMO], 1u); break; } }
  }
  nloc = mine > 0u ? mine : 1u; nx = cnt > 0u ? cnt : 1u;
}
__device__ __forceinline__ void xcd_barrier(const XcdBarrier& b) {
  asm volatile("s_waitcnt vmcnt(0)" ::: "memory");
  __syncthreads();
  if (threadIdx.x == 0) {
    unsigned* bar = b.bar;
    __builtin_amdgcn_s_waitcnt(0);
    unsigned nloc = b.st[0], nx = b.st[1];
    if (nloc == 0u) { xcd_barrier_complete(bar, b.x, nloc, nx); b.st[0] = nloc; b.st[1] = nx; }
    const unsigned old = xb_add(&bar[XB_XSUB(b.x)], 1u);
    const unsigned gen = old / nloc;
    if (old + 1u == (gen + 1u) * nloc) {
      __builtin_amdgcn_fence(__ATOMIC_RELEASE, "agent");
      asm volatile("s_waitcnt vmcnt(0)" ::: "memory");
      const unsigned og = xb_add(&bar[XB_TOP], 1u);
      const unsigned tg = og / nx;
      if (og + 1u == (tg + 1u) * nx) xb_add(&bar[XB_TOPGEN], 1u);
      else XB_SPIN(xb_ld(&bar[XB_TOPGEN]) == tg, bar);
      __builtin_amdgcn_fence(__ATOMIC_ACQUIRE, "agent");
      xb_add(&bar[XB_XGEN(b.x)], 1u);
      asm volatile("s_waitcnt vmcnt(0)" ::: "memory");
    } else {
      XB_SPIN(xb_ld(&bar[XB_XGEN(b.x)]) == gen, bar);
      __builtin_amdgcn_fence(__ATOMIC_ACQUIRE, "agent");
      asm volatile("s_waitcnt vmcnt(0)" ::: "memory");
    }
  }
  __syncthreads();
}

__device__ __forceinline__ void gemm_acc(f32x16 (&acc)[2][2], const bfu* __restrict__ A, int lda,
                                         const bfu* __restrict__ Bt, int ldb, int K, bfu* sA, bfu*  ) {
  const int tid = threadIdx.x, lane = tid & 63, w = tid >> 6, wm = w & 1, wn = w >> 1;
  const int lr = tid >> 3;
  const int kc = ((tid & 7) ^ ((tid >> 4) & 7)) * 8;
  const bfu* Ap = A + (size_t)lr * lda + kc;
  const bfu* Bp = Bt + (size_t)lr * ldb + kc;
  const size_t a32 = (size_t)32 * lda, b32 = (size_t)32 * ldb;
  char* sbase = (char*)sA;
  char* ldst = sbase + tid * 16;
#define GISSUE(stage, k)                                                                                       \
  _Pragma("unroll") for (int i_ = 0; i_ < 4; ++i_) {                                                           \
    __builtin_amdgcn_global_load_lds((const unsigned*)(Ap + i_ * a32 + (k)),                                   \
                                     (LAS unsigned*)(ldst + (stage) * 32768 + i_ * 4096), 16, 0, 0);           \
    __builtin_amdgcn_global_load_lds((const unsigned*)(Bp + i_ * b32 + (k)),                                   \
                                     (LAS unsigned*)(ldst + (stage) * 32768 + 16384 + i_ * 4096), 16, 0, 0);   \
  }
  const int sw = (lane >> 1) & 7, hh = lane >> 5;
  const int rowA = (wm * 64 + (lane & 31)) * 128, rowB = (wn * 32 + (lane & 31)) * 128;
  __syncthreads();
  GISSUE(0, 0)
  int cur = 0;
  for (int k0 = 0; k0 < K; k0 += 64) {
    asm volatile("s_waitcnt vmcnt(0)" ::: "memory");
    __syncthreads();
    if (k0 + 64 < K) { GISSUE(cur ^ 1, k0 + 64) }
    const char* cA = sbase + cur * 32768;
    const char* cB = cA + 16384;
    __builtin_amdgcn_s_setprio(1);
#pragma unroll
    for (int ks = 0; ks < 4; ++ks) {
      const int pos = ((2 * ks + hh) ^ sw) * 16;
      bf16x8 af[2], bfr[2];
#pragma unroll
      for (int mi = 0; mi < 2; ++mi) af[mi] = *(const bf16x8*)(cA + rowA + mi * 32 * 128 + pos);
#pragma unroll
      for (int ni = 0; ni < 2; ++ni) bfr[ni] = *(const bf16x8*)(cB + rowB + ni * 64 * 128 + pos);
#pragma unroll
      for (int mi = 0; mi < 2; ++mi)
#pragma unroll
        for (int ni = 0; ni < 2; ++ni)
          acc[mi][ni] = __builtin_amdgcn_mfma_f32_32x32x16_bf16(af[mi], bfr[ni], acc[mi][ni], 0, 0, 0);
    }
    __builtin_amdgcn_s_setprio(0);
    cur ^= 1;
  }
}
#define gemm_acc1 gemm_acc
__device__ __forceinline__ void zero_acc(f32x16 (&acc)[2][2]) {
#pragma unroll
  for (int a = 0; a < 2; ++a)
#pragma unroll
    for (int b = 0; b < 2; ++b)
#pragma unroll
      for (int i = 0; i < 16; ++i) acc[a][b][i] = 0.f;
}
#define EPI_BEGIN                                                      \
  const int e_lane = threadIdx.x & 63, e_w = threadIdx.x >> 6;         \
  const int e_wm = e_w & 1, e_wn = e_w >> 1;                            \
  const int cl = e_wn * 32 + (e_lane & 31);                             \
  _Pragma("unroll") for (int mi = 0; mi < 2; ++mi)                      \
  _Pragma("unroll") for (int q = 0; q < 4; ++q) {                       \
    const int r0 = e_wm * 64 + mi * 32 + q * 8 + 4 * (e_lane >> 5);
#define EPI_END }

#define ST_LD 136
#define ST32_LD 132
typedef unsigned u32x4nt __attribute__((ext_vector_type(4)));
__device__ __forceinline__ void nt_store_u4(void* p, uint4 v) { u32x4nt t = {v.x, v.y, v.z, v.w}; __builtin_nontemporal_store(t, (u32x4nt*)p); }
__device__ __forceinline__ void copyout_bf16(const bfu* sT, bfu* dst, int ld) {
  const int tid = threadIdx.x;
#pragma unroll
  for (int i = 0; i < 8; ++i) {
    int id = tid + i * 256, row = id >> 4, c8 = (id & 15) * 8;
    *(uint4*)(dst + (size_t)row * ld + c8) = *(const uint4*)(sT + row * ST_LD + c8);
  }
}
__device__ __forceinline__ void copyout_bf16_nt(const bfu* sT, bfu* dst, int ld) {
  const int tid = threadIdx.x;
#pragma unroll
  for (int i = 0; i < 8; ++i) {
    int id = tid + i * 256, row = id >> 4, c8 = (id & 15) * 8;
    nt_store_u4(dst + (size_t)row * ld + c8, *(const uint4*)(sT + row * ST_LD + c8));
  }
}
__device__ __forceinline__ void stage_rm(bfu* sT, const f32x16 (&acc)[2][2], float sc) {
  EPI_BEGIN
#pragma unroll
    for (int j = 0; j < 4; ++j) {
      sT[(r0 + j) * ST_LD + cl] = f2bf(acc[mi][0][q * 4 + j] * sc);
      sT[(r0 + j) * ST_LD + cl + 64] = f2bf(acc[mi][1][q * 4 + j] * sc);
    }
  EPI_END
}

__device__ __forceinline__ void tile_map(int L, int nM, int nN, int& pm, int& pn) {
  const int nwg = nM * nN;
  const int q = nwg >> 3, r = nwg & 7, xcd = L & 7, off = L >> 3;
  int wgid = (xcd < r ? xcd * (q + 1) : r * (q + 1) + (xcd - r) * q) + off;
  const int nig = 8 * nN, gid = wgid / nig, fm = gid * 8;
  const int gsz = (nM - fm) < 8 ? (nM - fm) : 8;
  pm = fm + (wgid % nig) % gsz;
  pn = (wgid % nig) / gsz;
}
__device__ void transpose_w(const float* __restrict__ src, int K, int N, int src_ld, bfu* __restrict__ dst,
                            int remap, int gtid, int gstride) {
  int total = N * (K / 8);
  for (int i = gtid; i < total; i += gstride) {
    int n = i % N, kg = i / N;
    int col = (remap && n >= 3584) ? n + 8 : n;
    float v[8];
#pragma unroll
    for (int j = 0; j < 8; ++j) v[j] = src[(size_t)(kg * 8 + j) * src_ld + col];
    uint4 o;
    o.x = pack2(v[0], v[1]); o.y = pack2(v[2], v[3]); o.z = pack2(v[4], v[5]); o.w = pack2(v[6], v[7]);
    *(uint4*)(dst + (size_t)n * K + kg * 8) = o;
  }
}
__device__ void transpose_w_lds(const float* __restrict__ src, int K, int N, int src_ld, bfu* __restrict__ dst,
                                int remap, float* st, int boff) {
  const int tid = threadIdx.x;
  const int tilesN = N >> 6, ntile = (K >> 6) * tilesN;
  for (int t = (int)((blockIdx.x + gridDim.x - (boff % gridDim.x)) % gridDim.x); t < ntile; t += gridDim.x) {
    const int kt = t / tilesN, nt = t - kt * tilesN;
    {
      const int row = tid >> 2, c16 = (tid & 3) * 16;
      const int n0 = nt * 64 + c16;
      const int col = (remap && n0 >= 3584) ? n0 + 8 : n0;
      const float* sp = src + (size_t)(kt * 64 + row) * src_ld + col;
#pragma unroll
      for (int j = 0; j < 4; ++j) {
        float4 v = *(const float4*)(sp + j * 4);
        float* d = st + row * 65 + c16 + j * 4;
        d[0] = v.x; d[1] = v.y; d[2] = v.z; d[3] = v.w;
      }
    }
    __syncthreads();
    {
      const int n = tid >> 2, kc = (tid & 3) * 16;
#pragma unroll
      for (int hf = 0; hf < 2; ++hf) {
        float f[8];
#pragma unroll
        for (int j = 0; j < 8; ++j) f[j] = st[(kc + hf * 8 + j) * 65 + n];
        uint4 o;
        o.x = pack2(f[0], f[1]); o.y = pack2(f[2], f[3]); o.z = pack2(f[4], f[5]); o.w = pack2(f[6], f[7]);
        *(uint4*)(dst + (size_t)(nt * 64 + n) * K + kt * 64 + kc + hf * 8) = o;
      }
    }
    __syncthreads();
  }
}
__device__ void convert_bf(const float* __restrict__ src, bfu* __restrict__ dst, size_t n8, int gtid, int gstride) {
  for (size_t i = gtid; i < n8; i += gstride) {
    float4 a = *(const float4*)(src + i * 8), b = *(const float4*)(src + i * 8 + 4);
    uint4 o;
    o.x = pack2(a.x, a.y); o.y = pack2(a.z, a.w); o.z = pack2(b.x, b.y); o.w = pack2(b.z, b.w);
    *(uint4*)(dst + i * 8) = o;
  }
}

__device__ void prep_rows(const Params& P) {
  const int lane = threadIdx.x & 63, w = threadIdx.x >> 6;
  bfu* hbuf = (bfu*)(P.ws + SLOT(0));
  float* gpre = (float*)(P.ws + O_GPRE);
  float4 wg0[16], wg1[16];
#pragma unroll
  for (int i = 0; i < 4; ++i)
#pragma unroll
    for (int j = 0; j < 4; ++j) {
      const float* wr = P.w_in + (size_t)(i * 256 + lane * 4 + j) * 5640 + 3584;
      wg0[i * 4 + j] = *(const float4*)wr; wg1[i * 4 + j] = *(const float4*)(wr + 4);
    }
  float4 gm[4];
#pragma unroll
  for (int i = 0; i < 4; ++i) gm[i] = *(const float4*)(P.g_mix + i * 256 + lane * 4);
  for (int r = blockIdx.x * 4 + w; r < MT; r += gridDim.x * 4) {
    const float* xr = xrow(P, r);
    float4 v[4];
    float ss = 0.f;
#pragma unroll
    for (int i = 0; i < 4; ++i) {
      v[i] = *(const float4*)(xr + i * 256 + lane * 4);
      ss += v[i].x * v[i].x + v[i].y * v[i].y + v[i].z * v[i].z + v[i].w * v[i].w;
    }
    ss = wave_sum(ss);
    float rstd = rsqrtf(ss * (1.f / 1024.f) + EPS);
    float ga[8];
#pragma unroll
    for (int j = 0; j < 8; ++j) ga[j] = 0.f;
#pragma unroll
    for (int i = 0; i < 4; ++i) {
      float hv[4] = {v[i].x * rstd * gm[i].x, v[i].y * rstd * gm[i].y, v[i].z * rstd * gm[i].z, v[i].w * rstd * gm[i].w};
      uint2 o; o.x = pack2(hv[0], hv[1]); o.y = pack2(hv[2], hv[3]);
      *(uint2*)(hbuf + (size_t)r * 1024 + i * 256 + lane * 4) = o;
#pragma unroll
      for (int j = 0; j < 4; ++j) {
        const float4 w0 = wg0[i * 4 + j], w1 = wg1[i * 4 + j];
        ga[0] += hv[j] * w0.x; ga[1] += hv[j] * w0.y; ga[2] += hv[j] * w0.z; ga[3] += hv[j] * w0.w;
        ga[4] += hv[j] * w1.x; ga[5] += hv[j] * w1.y; ga[6] += hv[j] * w1.z; ga[7] += hv[j] * w1.w;
      }
    }
    float si = reduce4(ga[0], ga[1], ga[2], ga[3]);
    float sf = reduce4(ga[4], ga[5], ga[6], ga[7]);
    if ((lane & 15) == 0) {
      int k = lane >> 4;
      gpre[(size_t)r * 8 + k] = si + P.b_i[k];
      gpre[(size_t)r * 8 + 4 + k] = sf + P.b_f[k];
    }
  }
}
__device__ void gate_scan(const Params& P) {
  const int lane = threadIdx.x & 63, w = threadIdx.x >> 6;
  const float* gpre = (const float*)(P.ws + O_GPRE);
  for (int item = blockIdx.x * 4 + w; item < 528 * 4; item += gridDim.x * 4) {
    int tile = item >> 2, h = item & 3;
    int row0, L;
    if (tile < 512) { row0 = tile * 64; L = 64; } else { row0 = MP + (tile - 512) * 32; L = 32; }
    const int s = lane;
    bool valid = s < L;
    float ig = valid ? gpre[(size_t)(row0 + s) * 8 + h] : -INFINITY;
    float fg = valid ? gpre[(size_t)(row0 + s) * 8 + 4 + h] : 0.f;
    float lf = valid ? (fminf(fg, 0.f) - log1pf(__expf(-fabsf(fg)))) : 0.f;
    float F = lf;
#pragma unroll
    for (int o = 1; o < 64; o <<= 1) { float t = __shfl_up(F, o); if (lane >= o) F += t; }
    float u = valid ? ig - F : -INFINITY;
    float cm = u;
#pragma unroll
    for (int o = 1; o < 64; o <<= 1) { float t = __shfl_up(cm, o); if (lane >= o) cm = fmaxf(cm, t); }
    if (valid) {
      size_t gi = (size_t)(row0 + s) * 4 + h;
      ((float*)(P.ws + O_FQ))[gi] = F;
      ((float*)(P.ws + O_UQ))[gi] = u;
      ((float*)(P.ws + O_CMQ))[gi] = cm;
      if (s == L - 1) {
        ((float*)(P.ws + O_FL))[tile * 4 + h] = F;
        ((float*)(P.ws + O_UC))[tile * 4 + h] = cm;
      }
    }
  }
}

__device__ void phase_prep(const Params& P, char* smem) {
  const int gtid = blockIdx.x * NTHREADS + threadIdx.x, gstride = gridDim.x * NTHREADS;
  prep_rows(P);
  transpose_w_lds(P.w_in, 1024, 5632, 5640, (bfu*)(P.ws + O_WT_IN), 1, (float*)smem, 0);
  transpose_w_lds(P.w_up_r, 512, 1024, 1024, (bfu*)(P.ws + O_WT_UPR), 0, (float*)smem, 1408);
  transpose_w_lds(P.w_up_m, 512, 1024, 1024, (bfu*)(P.ws + O_WT_UPM), 0, (float*)smem, 1536);
  transpose_w_lds(P.w_out, 1024, 1024, 1024, (bfu*)(P.ws + O_WT_OUT), 0, (float*)smem, 1664);
  transpose_w_lds(P.w_pq, 1024, 2048, 2048, (bfu*)(P.ws + O_WT_PQ), 0, (float*)smem, 1920);
  transpose_w_lds(P.w_pg, 1024, 1024, 1024, (bfu*)(P.ws + O_WT_PG), 0, (float*)smem, 2432);
  transpose_w_lds(P.w_ple, 256, 1024, 1024, (bfu*)(P.ws + O_WT_PLE), 0, (float*)smem, 2688);
  for (int h = 0; h < 4; ++h) {
    transpose_w_lds(P.w_mq + h * 16384, 128, 128, 128, (bfu*)(P.ws + O_WT_MQ) + h * 16384, 0, (float*)smem, 2752 + h * 8);
    transpose_w_lds(P.w_mk + h * 16384, 128, 128, 128, (bfu*)(P.ws + O_WT_MK) + h * 16384, 0, (float*)smem, 2756 + h * 8);
  }
  convert_bf(P.peer_keys, (bfu*)(P.ws + O_KEYS), 16 * 128 * 128 / 8, gtid, gstride);
  float* ct = (float*)(P.ws + O_COS); float* st = (float*)(P.ws + O_SIN);
  for (int i = gtid; i < 8192 * 64; i += gstride) {
    int pos = i >> 6, j = i & 63;
    float inv = exp2f(-(float)j * (13.287712379549449f / 64.f));
    float angf = (float)pos * inv;
    double a = (double)angf;
    double k = rint(a * 0.15915494309189535);
    float r = (float)(a - k * 6.283185307179586);
    ct[i] = __cosf(r); st[i] = __sinf(r);
  }
}

__device__ __forceinline__ void gemm_acc256(f32x16 (&acc)[4][2], const bfu* __restrict__ A, int lda,
                                            const bfu* __restrict__ Bt, int ldb, int K, char* sbase) {
  const int tid = threadIdx.x, lane = tid & 63, w = tid >> 6, wm = w & 1, wn = w >> 1;
  const int kc = ((tid & 3) ^ ((tid >> 4) & 3)) * 8;
  const bfu* Ap = A + (size_t)(tid >> 2) * lda + kc;
  const bfu* Bp = Bt + (size_t)(tid >> 2) * ldb + kc;
  const size_t a64 = (size_t)64 * lda, b64 = (size_t)64 * ldb;
  char* ldst = sbase + tid * 16;
#define GISSUE256(stage, k)                                                                                      \
  {                                                                                                              \
    char* d_ = ldst + (stage) * 24576;                                                                           \
    __builtin_amdgcn_global_load_lds((const unsigned*)(Ap + (k)), (LAS unsigned*)(d_), 16, 0, 0);                \
    __builtin_amdgcn_global_load_lds((const unsigned*)(Ap + a64 + (k)), (LAS unsigned*)(d_ + 4096), 16, 0, 0);   \
    __builtin_amdgcn_global_load_lds((const unsigned*)(Ap + 2 * a64 + (k)), (LAS unsigned*)(d_ + 8192), 16, 0, 0);  \
    __builtin_amdgcn_global_load_lds((const unsigned*)(Ap + 3 * a64 + (k)), (LAS unsigned*)(d_ + 12288), 16, 0, 0); \
    __builtin_amdgcn_global_load_lds((const unsigned*)(Bp + (k)), (LAS unsigned*)(d_ + 16384), 16, 0, 0);        \
    __builtin_amdgcn_global_load_lds((const unsigned*)(Bp + b64 + (k)), (LAS unsigned*)(d_ + 20480), 16, 0, 0);  \
  }
  const int sw = (lane >> 2) & 3, hh = lane >> 5;
  const int rowA = (wm * 64 + (lane & 31)) * 64, rowB = (wn * 32 + (lane & 31)) * 64;
  const int nk = K >> 5;
  __syncthreads();
  asm volatile("s_waitcnt vmcnt(0)" ::: "memory");
  GISSUE256(0, 0)
  if (nk > 1) GISSUE256(1, 32)
  int st = 0;
  for (int kt = 0; kt < nk; ++kt) {
    if (kt + 1 < nk) asm volatile("s_waitcnt vmcnt(6)" ::: "memory");
    else asm volatile("s_waitcnt vmcnt(0)" ::: "memory");
    asm volatile("s_waitcnt lgkmcnt(0)" ::: "memory");
    __builtin_amdgcn_s_barrier();
    asm volatile("" ::: "memory");
    if (kt + 2 < nk) { const int s2 = st >= 1 ? st - 1 : 2; GISSUE256(s2, (kt + 2) * 32) }
    const char* cA = sbase + st * 24576;
    const char* cB = cA + 16384;
    __builtin_amdgcn_s_setprio(1);
#pragma unroll
    for (int ks = 0; ks < 2; ++ks) {
      const int pos = ((2 * ks + hh) ^ sw) * 16;
      bf16x8 af[4], bfr[2];
#pragma unroll
      for (int mi = 0; mi < 4; ++mi) af[mi] = *(const bf16x8*)(cA + rowA + ((mi >> 1) * 128 + (mi & 1) * 32) * 64 + pos);
#pragma unroll
      for (int ni = 0; ni < 2; ++ni) bfr[ni] = *(const bf16x8*)(cB + rowB + ni * 64 * 64 + pos);
#pragma unroll
      for (int mi = 0; mi < 4; ++mi)
#pragma unroll
        for (int ni = 0; ni < 2; ++ni)
          acc[mi][ni] = __builtin_amdgcn_mfma_f32_32x32x16_bf16(af[mi], bfr[ni], acc[mi][ni], 0, 0, 0);
    }
    __builtin_amdgcn_s_setprio(0);
    st = st == 2 ? 0 : st + 1;
  }
}

__device__ __forceinline__ void gemm1_epilogue(const Params& P, char* smem, f32x16 (&acc)[2][2], const int rbase, const int nt,
                                               const float* ct, const float* stb) {
    const bool prompt = rbase < MP;
  int region = nt >> 2, hh = nt & 3;
  bfu* sT = (bfu*)smem;
  __syncthreads();
  if (region <= 1) {
    float sc = region == 1 ? 0.08838834764831845f : 1.f;
    EPI_BEGIN
#pragma unroll
      for (int j = 0; j < 4; ++j) {
        int rr = rbase + r0 + j;
        int pos = prompt ? (rr & 8191) : 2048 + ((rr - MP) & 31);
        float c = ct[pos * 64 + cl], sn = stb[pos * 64 + cl];
        float a = acc[mi][0][q * 4 + j], b = acc[mi][1][q * 4 + j];
        sT[(r0 + j) * ST_LD + cl] = f2bf((a * c - b * sn) * sc);
        sT[(r0 + j) * ST_LD + cl + 64] = f2bf((a * sn + b * c) * sc);
      }
    EPI_END
    __syncthreads();
    copyout_bf16_nt(sT, (bfu*)(P.ws + SLOT(2 + region)) + (size_t)rbase * 512 + hh * 128, 512);
  } else if (region == 2 || region == 5) {
    EPI_BEGIN
      uint2 va, vb;
      va.x = pack2(acc[mi][0][q * 4 + 0], acc[mi][0][q * 4 + 1]); va.y = pack2(acc[mi][0][q * 4 + 2], acc[mi][0][q * 4 + 3]);
      vb.x = pack2(acc[mi][1][q * 4 + 0], acc[mi][1][q * 4 + 1]); vb.y = pack2(acc[mi][1][q * 4 + 2], acc[mi][1][q * 4 + 3]);
      *(uint2*)(sT + cl * ST_LD + r0) = va;
      *(uint2*)(sT + (cl + 64) * ST_LD + r0) = vb;
    EPI_END
    __syncthreads();
    bfu* dst = (bfu*)(P.ws + SLOT(region == 2 ? 4 : 7));
#pragma unroll
    for (int i = 0; i < 8; ++i) {
      int id = threadIdx.x + i * 256, e = id >> 4, c8 = (id & 15) * 8;
      size_t o;
      if (prompt) { int bb = rbase >> 13, tt = (rbase & 8191) + c8; o = ((size_t)((bb * 4 + hh) * 128 + e)) * 8192 + tt; }
      else { int rs = rbase - MP + c8, bb = rs >> 5, tt = rs & 31; o = SB_T + ((size_t)((bb * 4 + hh) * 128 + e)) * 32 + tt; }
      nt_store_u4(dst + o, *(const uint4*)(sT + e * ST_LD + c8));
    }
  } else if (region == 3 || region == 4 || region == 6) {
    stage_rm(sT, acc, 1.f);
    __syncthreads();
    copyout_bf16_nt(sT, (bfu*)(P.ws + SLOT(region == 3 ? 5 : (region == 4 ? 6 : 8))) + (size_t)rbase * 512 + hh * 128, 512);
  } else {
    int gi = nt - 28;
    stage_rm(sT, acc, 1.f);
    __syncthreads();
    copyout_bf16_nt(sT, (bfu*)(P.ws + SLOT(gi < 8 ? 9 : 11)) + (size_t)rbase * 1024 + (gi & 7) * 128, 1024);
  }

}

__device__ void phase_gemm1(const Params& P, char* smem) {
  const bfu* hbuf = (const bfu*)(P.ws + SLOT(0));
  const bfu* wt = (const bfu*)(P.ws + O_WT_IN);
  const float* ct = (const float*)(P.ws + O_COS); const float* stb = (const float*)(P.ws + O_SIN);
  for (int t = blockIdx.x; t < 130 * 44; t += gridDim.x) {
    int mt, nt; tile_map(t, 130, 44, mt, nt);
    f32x16 acc[4][2];
#pragma unroll
    for (int a = 0; a < 4; ++a)
#pragma unroll
      for (int b = 0; b < 2; ++b)
#pragma unroll
        for (int i = 0; i < 16; ++i) acc[a][b][i] = 0.f;
    gemm_acc256(acc, hbuf + (size_t)mt * 256 * 1024, 1024, wt + (size_t)nt * 128 * 1024, 1024, 1024, smem);
    gemm1_epilogue(P, smem, reinterpret_cast<f32x16(&)[2][2]>(acc[0]), mt * 256, nt, ct, stb);
    gemm1_epilogue(P, smem, reinterpret_cast<f32x16(&)[2][2]>(acc[2]), mt * 256 + 128, nt, ct, stb);
  }
}

__device__ void phase_conv(const Params& P) {
  const int gtid = blockIdx.x * NTHREADS + threadIdx.x, gstride = gridDim.x * NTHREADS;
  const bfu* xm = (const bfu*)(P.ws + SLOT(6));
  bfu* cb = (bfu*)(P.ws + SLOT(0));
  for (int i = gtid; i < MT * 64; i += gstride) {
    int r = i >> 6, c0 = (i & 63) * 8;
    int t, T, bb; bool prompt = r < MP;
    if (prompt) { bb = r >> 13; t = r & 8191; T = 8192; } else { int rs = r - MP; bb = rs >> 5; t = rs & 31; T = 32; }
    float y[8];
#pragma unroll
    for (int j = 0; j < 8; ++j) y[j] = P.conv_b[c0 + j];
#pragma unroll
    for (int k = 0; k < 4; ++k) {
      int tt = t - 3 + k;
      float xv[8];
      if (tt >= 0) {
        uint4 v = *(const uint4*)(xm + (size_t)(r - 3 + k) * 512 + c0);
        xv[0] = bf2f(v.x & 0xffff); xv[1] = bf2f(v.x >> 16); xv[2] = bf2f(v.y & 0xffff); xv[3] = bf2f(v.y >> 16);
        xv[4] = bf2f(v.z & 0xffff); xv[5] = bf2f(v.z >> 16); xv[6] = bf2f(v.w & 0xffff); xv[7] = bf2f(v.w >> 16);
      } else if (!prompt) {
        const float* sp = P.st_conv + (size_t)(bb * 3 + (tt + 3)) * 512 + c0;
#pragma unroll
        for (int j = 0; j < 8; ++j) xv[j] = sp[j];
      } else {
#pragma unroll
        for (int j = 0; j < 8; ++j) xv[j] = 0.f;
      }
#pragma unroll
      for (int j = 0; j < 8; ++j) y[j] += xv[j] * P.conv_w[k * 512 + c0 + j];
    }
    if (t >= T - 3) {
      uint4 v = *(const uint4*)(xm + (size_t)r * 512 + c0);
      float* dst = (prompt ? P.out + OO_CONVP : P.out + OO_CONVS) + (size_t)(bb * 3 + (t - (T - 3))) * 512 + c0;
      dst[0] = bf2f(v.x & 0xffff); dst[1] = bf2f(v.x >> 16); dst[2] = bf2f(v.y & 0xffff); dst[3] = bf2f(v.y >> 16);
      dst[4] = bf2f(v.z & 0xffff); dst[5] = bf2f(v.z >> 16); dst[6] = bf2f(v.w & 0xffff); dst[7] = bf2f(v.w >> 16);
    }
    uint4 o;
#pragma unroll
    for (int j = 0; j < 8; ++j) y[j] = y[j] * sigmoidf_(y[j]);
    o.x = pack2(y[0], y[1]); o.y = pack2(y[2], y[3]); o.z = pack2(y[4], y[5]); o.w = pack2(y[6], y[7]);
    *(uint4*)(cb + (size_t)r * 512 + c0) = o;
  }
}

__device__ void m_fold(const Params& P) {
  const int lane = threadIdx.x & 63, w = threadIdx.x >> 6;
  const float* FL = (const float*)(P.ws + O_FL); const float* UC = (const float*)(P.ws + O_UC);
  float* MCS = (float*)(P.ws + O_MCS);
  const int slot = (int)gridDim.x - 1 - (int)blockIdx.x;
  if (w == 3 && slot < 16) {
    const int bh = slot, b = bh >> 2, h = bh & 3;
    const int c0 = 2 * lane;
    const float fl0 = FL[(b * 128 + c0) * 4 + h], uc0 = UC[(b * 128 + c0) * 4 + h];
    const float fl1 = FL[(b * 128 + c0 + 1) * 4 + h], uc1 = UC[(b * 128 + c0 + 1) * 4 + h];
    float a = fl0 + fl1, bb = fmaxf(fl0 + uc0 + fl1, fl1 + uc1);
#pragma unroll
    for (int o = 1; o < 64; o <<= 1) {
      float ap = __shfl_up(a, o), bp = __shfl_up(bb, o);
      if (lane >= o) { bb = fmaxf(bp + a, bb); a = ap + a; }
    }
    float ae = __shfl_up(a, 1), be = __shfl_up(bb, 1);
    float m0 = lane == 0 ? 0.f : fmaxf(ae, be);
    float m1 = fl0 + fmaxf(m0, uc0);
    MCS[bh * 128 + c0] = m0;
    MCS[bh * 128 + c0 + 1] = m1;
  }
  const int gtid = blockIdx.x * NTHREADS + threadIdx.x;
  if (gtid < 64) MCS[2048 + gtid] = P.st_m[gtid];
}
__device__ void phase_mqk(const Params& P, char* smem) {
  bfu* sA = (bfu*)smem; bfu* sB = sA + 128 * 72;
  const bfu* cb = (const bfu*)(P.ws + SLOT(0));
  for (int t = blockIdx.x; t < 260 * 8; t += gridDim.x) {
    int mt = t >> 3, which = (t >> 2) & 1, hh = t & 3;
    const bfu* wt = (const bfu*)(P.ws + (which ? O_WT_MK : O_WT_MQ)) + hh * 16384;
    f32x16 acc[2][2]; zero_acc(acc);
    gemm_acc(acc, cb + (size_t)mt * 128 * 512 + hh * 128, 512, wt, 128, 128, sA, sB);
    bfu* dst = (bfu*)(P.ws + SLOT(which ? 13 : 1));
    float sc = which ? 0.08838834764831845f : 1.f;
    bfu* sT = (bfu*)smem;
    __syncthreads();
    stage_rm(sT, acc, sc);
    __syncthreads();
    copyout_bf16(sT, dst + (size_t)mt * 128 * 512 + hh * 128, 512);
  }
}

struct Item { int b, h, c, row0, L, T, chunk, bh; bool prompt; size_t vt_off; };
__device__ __forceinline__ Item decode_item(int idx) {
  Item it;
  if (idx < 2048) {
    it.prompt = true; it.b = idx >> 9; it.h = (idx >> 7) & 3; it.c = idx & 127; it.row0 = it.b * 8192 + it.c * 64;
    it.L = 64; it.T = 8192; it.chunk = it.b * 128 + it.c; it.bh = it.b * 4 + it.h;
    it.vt_off = ((size_t)(it.bh * 128)) * 8192 + it.c * 64;
  } else {
    int si = idx - 2048; it.prompt = false; it.b = si >> 2; it.h = si & 3; it.c = 0; it.row0 = MP + it.b * 32;
    it.L = 32; it.T = 32; it.chunk = 512 + it.b; it.bh = it.b * 4 + it.h;
    it.vt_off = SB_T + ((size_t)(it.bh * 128)) * 32;
  }
  return it;
}
__device__ __forceinline__ bfu* ds_ptr(const Params& P, int mixer, int idx) {
  if (idx < 2048) return (bfu*)P.out + ((size_t)(mixer * 2048 + idx)) * 16384;
  return (bfu*)(P.ws + O_DSS) + ((size_t)(mixer * 64 + (idx - 2048))) * 16384;
}
__device__ __forceinline__ float ret_lg(int h) { return log1pf(-exp2f(-5.f - (float)h)); }

__device__ void phaseA_item(const Params& P, int mixer, int idx, char* smem) {
  const int tid = threadIdx.x, lane = tid & 63, w = tid >> 6, wm = w & 1, wn = w >> 1;
  Item it = decode_item(idx);
  bfu* sK = (bfu*)smem; bfu* sV = sK + 128 * 72;
  float* sw = (float*)(sV + 128 * 72);
  float* sm = sw + 64;
  const int L = it.L, h = it.h;
  const bfu* Ksrc = (const bfu*)(P.ws + SLOT(mixer == 0 ? 3 : 13)) + (size_t)it.row0 * 512 + h * 128;
  const bfu* Vsrc = (const bfu*)(P.ws + SLOT(mixer == 0 ? 4 : 7)) + it.vt_off;
  uint4 kreg[4], vreg[4];
#pragma unroll
  for (int i = 0; i < 4; ++i) {
    int id = tid + i * 256, s = (id >> 2) & 63, dc = ((id & 3) + 4 * (id >> 8)) * 8;
    kreg[i] = make_uint4(0, 0, 0, 0);
    if (s < L) kreg[i] = *(const uint4*)(Ksrc + (size_t)s * 512 + dc);
    int e = id >> 3, sc = (id & 7) * 8;
    vreg[i] = make_uint4(0, 0, 0, 0);
    if (sc < L) vreg[i] = *(const uint4*)(Vsrc + (size_t)e * it.T + sc);
  }
  if (mixer == 0) {
    if (tid < 64) { float lg = ret_lg(h); sw[tid] = tid < L ? __expf(lg * (float)(L - 1 - tid)) : 0.f; }
  } else {
    const float* FL = (const float*)(P.ws + O_FL); const float* UC = (const float*)(P.ws + O_UC);
    float mc = ((const float*)(P.ws + O_MCS))[idx];
    float Ml = fmaxf(mc, UC[it.chunk * 4 + h]);
    if (tid < 64) sw[tid] = tid < L ? __expf(((const float*)(P.ws + O_UQ))[(size_t)(it.row0 + tid) * 4 + h] - Ml) : 0.f;
    if (tid == 0) {
      ((float*)(P.ws + O_AEND))[idx] = __expf(mc - Ml);
      if (!it.prompt) P.out[OO_MS + it.bh] = FL[it.chunk * 4 + h] + Ml;
      else if (it.c == 127) P.out[OO_MP + it.bh] = FL[it.chunk * 4 + h] + Ml;
    }
  }
  __syncthreads();
#pragma unroll
  for (int i = 0; i < 4; ++i) {
    int id = tid + i * 256, s = (id >> 2) & 63, dc = ((id & 3) + 4 * (id >> 8)) * 8;
    uint4 v = kreg[i];
    float ww = sw[s];
    unsigned vv[4] = {v.x, v.y, v.z, v.w};
#pragma unroll
    for (int j = 0; j < 4; ++j) {
      sK[(dc + 2 * j) * 72 + s] = f2bf(bf2f(vv[j] & 0xffff) * ww);
      sK[(dc + 2 * j + 1) * 72 + s] = f2bf(bf2f(vv[j] >> 16) * ww);
    }
  }
#pragma unroll
  for (int i = 0; i < 4; ++i) {
    int id = tid + i * 256, e = id >> 3, sc = (id & 7) * 8;
    *(uint4*)(sV + e * 72 + sc) = vreg[i];
  }
  __syncthreads();
  f32x16 acc[2][2]; zero_acc(acc);
#pragma unroll
  for (int ks = 0; ks < 4; ++ks) {
    bf16x8 af[2], bfr[2];
#pragma unroll
    for (int mi = 0; mi < 2; ++mi)
      af[mi] = *(const bf16x8*)(sK + (wm * 64 + mi * 32 + (lane & 31)) * 72 + ks * 16 + (lane >> 5) * 8);
#pragma unroll
    for (int ni = 0; ni < 2; ++ni)
      bfr[ni] = *(const bf16x8*)(sV + (wn * 32 + ni * 64 + (lane & 31)) * 72 + ks * 16 + (lane >> 5) * 8);
#pragma unroll
    for (int mi = 0; mi < 2; ++mi)
#pragma unroll
      for (int ni = 0; ni < 2; ++ni)
        acc[mi][ni] = __builtin_amdgcn_mfma_f32_32x32x16_bf16(af[mi], bfr[ni], acc[mi][ni], 0, 0, 0);
  }
  bfu* dS = ds_ptr(P, mixer, idx);
  bfu* sD = (bfu*)(smem + 40960);
  {
    EPI_BEGIN
#pragma unroll
      for (int ni = 0; ni < 2; ++ni) {
        int e = cl + ni * 64;
        uint2 o; o.x = pack2(acc[mi][ni][q * 4 + 0], acc[mi][ni][q * 4 + 1]); o.y = pack2(acc[mi][ni][q * 4 + 2], acc[mi][ni][q * 4 + 3]);
        *(uint2*)(sD + e * 136 + r0) = o;
      }
    EPI_END
  }
  __syncthreads();
#pragma unroll
  for (int i = 0; i < 8; ++i) {
    int id = tid + i * 256, e = id >> 4, c8 = (id & 15) * 8;
    *(uint4*)(dS + e * 128 + c8) = *(const uint4*)(sD + e * 136 + c8);
  }
  if (mixer == 1 && tid < 128) {
    float s = 0.f;
#pragma unroll
    for (int j = 0; j < 8; ++j) { float f[8]; unpack8(*(const uint4*)(sK + tid * 72 + j * 8), f);
#pragma unroll
      for (int k = 0; k < 8; ++k) s += f[k]; }
    ((float*)(P.ws + O_DN))[(size_t)idx * 128 + tid] = s;
  }
  __syncthreads();
}

__device__ void phase_scan(const Params& P) {
  const int gtid = blockIdx.x * NTHREADS + threadIdx.x, gstride = gridDim.x * NTHREADS;
  const float* AE = (const float*)(P.ws + O_AEND);
  for (int i = gtid; i < 131072; i += gstride) {
    int mixer = i >> 16, bh = (i >> 12) & 15, eo = (i & 4095) * 4;
    int h = bh & 3;
    float gch = __expf(ret_lg(h) * 64.f);
    float st[4];
#pragma unroll
    for (int j = 0; j < 4; ++j) st[j] = 0.f;
    bfu* base = (bfu*)P.out + ((size_t)(mixer * 2048 + bh * 128)) * 16384 + eo;
    for (int c = 0; c < 128; c += 8) {
      uint2 v[8];
#pragma unroll
      for (int k = 0; k < 8; ++k) v[k] = *(const uint2*)(base + (size_t)(c + k) * 16384);
#pragma unroll
      for (int k = 0; k < 8; ++k) {
        float dec = mixer == 0 ? gch : AE[bh * 128 + c + k];
        float d0 = bf2f(v[k].x & 0xffff), d1 = bf2f(v[k].x >> 16), d2 = bf2f(v[k].y & 0xffff), d3 = bf2f(v[k].y >> 16);
        uint2 o; o.x = pack2(st[0], st[1]); o.y = pack2(st[2], st[3]);
        *(uint2*)(base + (size_t)(c + k) * 16384) = o;
        st[0] = dec * st[0] + d0; st[1] = dec * st[1] + d1; st[2] = dec * st[2] + d2; st[3] = dec * st[3] + d3;
      }
    }
    float* o = P.out + (mixer == 0 ? OO_RETP : OO_CP) + (size_t)bh * 16384;
    int e = eo >> 7, d0i = eo & 127;
#pragma unroll
    for (int j = 0; j < 4; ++j) o[(d0i + j) * 128 + e] = st[j];
  }
  for (int i = gtid; i < 2 * 64 * 2048; i += gstride) {
    int mixer = i >> 17, bh = (i >> 11) & 63, eo = (i & 2047) * 8;
    int h = bh & 3;
    int e = eo >> 7, d0 = eo & 127;
    const float* s0 = (mixer == 0 ? P.st_ret : P.st_C) + (size_t)bh * 16384;
    float st[8];
#pragma unroll
    for (int j = 0; j < 8; ++j) st[j] = s0[(d0 + j) * 128 + e];
    bfu* p = (bfu*)(P.ws + O_DSS) + ((size_t)(mixer * 64 + bh)) * 16384 + eo;
    float d[8]; unpack8(*(const uint4*)p, d);
    *(uint4*)p = pack8(st);
    float dec = mixer == 0 ? __expf(ret_lg(h) * 32.f) : AE[2048 + bh];
    float* o = P.out + (mixer == 0 ? OO_RETS : OO_CS) + (size_t)bh * 16384;
#pragma unroll
    for (int j = 0; j < 8; ++j) o[(d0 + j) * 128 + e] = dec * st[j] + d[j];
  }
  float* DN = (float*)(P.ws + O_DN);
  for (int i = gtid; i < 16 * 128; i += gstride) {
    int bh = i >> 7, d = i & 127;
    float n = 0.f;
    for (int c0 = 0; c0 < 128; c0 += 16) {
      float v[16], ae[16];
#pragma unroll
      for (int k = 0; k < 16; ++k) { v[k] = DN[(size_t)(bh * 128 + c0 + k) * 128 + d]; ae[k] = AE[bh * 128 + c0 + k]; }
#pragma unroll
      for (int k = 0; k < 16; ++k) { DN[(size_t)(bh * 128 + c0 + k) * 128 + d] = n; n = ae[k] * n + v[k]; }
    }
    P.out[OO_NP + i] = n;
  }
  for (int i = gtid; i < 64 * 128; i += gstride) {
    int bh = i >> 7, d = i & 127;
    size_t o = (size_t)(2048 + bh) * 128 + d;
    float n0 = P.st_n[i]; float v = DN[o]; DN[o] = n0;
    P.out[OO_NS + i] = AE[2048 + bh] * n0 + v;
  }
}

__device__ void phaseC_item(const Params& P, int mixer, int idx, char* smem) {
  const int tid = threadIdx.x, lane = tid & 63, w = tid >> 6;
  Item it = decode_item(idx);
  const int L = it.L, h = it.h;
  bfu* sQ = (bfu*)smem;
  bfu* sKV = sQ + 64 * 136;
  bfu* sP = sKV + 128 * 72;
  bfu* sS = sP + 64 * 72;
  float* sO = (float*)sS;
  float* sRow = (float*)(sS + 128 * 136);
  const bfu* Qsrc = (const bfu*)(P.ws + SLOT(mixer == 0 ? 2 : 1)) + (size_t)it.row0 * 512 + h * 128;
  const bfu* Ksrc = (const bfu*)(P.ws + SLOT(mixer == 0 ? 3 : 13)) + (size_t)it.row0 * 512 + h * 128;
  const bfu* Vsrc = (const bfu*)(P.ws + SLOT(mixer == 0 ? 4 : 7)) + it.vt_off;
  const bfu* Ssrc = ds_ptr(P, mixer, idx);
  const float lg = ret_lg(h);
  uint4 vpre[4];
#pragma unroll
  for (int i = 0; i < 4; ++i) {
    int id = tid + i * 256, e = id >> 3, sc = (id & 7) * 8;
    vpre[i] = make_uint4(0, 0, 0, 0);
    if (sc < L) vpre[i] = *(const uint4*)(Vsrc + (size_t)e * it.T + sc);
  }
#pragma unroll
  for (int i = 0; i < 4; ++i) {
    int id = tid + i * 256, s = id >> 4, dc = (id & 15) * 8;
    uint4 vq = make_uint4(0, 0, 0, 0), vk = vq;
    if (s < L) { vq = *(const uint4*)(Qsrc + (size_t)s * 512 + dc); vk = *(const uint4*)(Ksrc + (size_t)s * 512 + dc); }
    *(uint4*)(sQ + s * 136 + dc) = vq;
    *(uint4*)(sKV + s * 136 + dc) = vk;
  }
#pragma unroll
  for (int i = 0; i < 8; ++i) {
    int id = tid + i * 256, e = id >> 4, dc = (id & 15) * 8;
    *(uint4*)(sS + e * 136 + dc) = *(const uint4*)(Ssrc + e * 128 + dc);
  }
  if (tid < 64) {
    int i = tid;
    if (mixer == 0) {
      sRow[128 + i] = __expf(lg * (float)(i + 1));
    } else {
      float mc = ((const float*)(P.ws + O_MCS))[idx];
      size_t gi = (size_t)(it.row0 + i) * 4 + h;
      bool valid = i < L;
      float u = valid ? ((const float*)(P.ws + O_UQ))[gi] : -INFINITY;
      float M = valid ? fmaxf(mc, ((const float*)(P.ws + O_CMQ))[gi]) : 0.f;
      float F = valid ? ((const float*)(P.ws + O_FQ))[gi] : 0.f;
      sRow[i] = u; sRow[64 + i] = M; sRow[128 + i] = valid ? __expf(mc - M) : 0.f;
      sRow[256 + i] = __expf(-(F + M));
    }
  }
  __syncthreads();
  {
    const int mi = w & 1, ni = w >> 1;
    f32x16 acc;
#pragma unroll
    for (int i = 0; i < 16; ++i) acc[i] = 0.f;
#pragma unroll 2
    for (int ks = 0; ks < 8; ++ks) {
      bf16x8 af = *(const bf16x8*)(sQ + (mi * 32 + (lane & 31)) * 136 + ks * 16 + (lane >> 5) * 8);
      bf16x8 bfr = *(const bf16x8*)(sKV + (ni * 32 + (lane & 31)) * 136 + ks * 16 + (lane >> 5) * 8);
      acc = __builtin_amdgcn_mfma_f32_32x32x16_bf16(af, bfr, acc, 0, 0, 0);
    }
    const int s = ni * 32 + (lane & 31);
    float us = mixer ? sRow[s] : 0.f;
#pragma unroll
    for (int reg = 0; reg < 16; ++reg) {
      int i = mi * 32 + (reg & 3) + 8 * (reg >> 2) + 4 * (lane >> 5);
      float wgt;
      if (mixer == 0) wgt = (s <= i) ? __expf(lg * (float)(i - s)) : 0.f;
      else wgt = (s <= i && i < L) ? __expf(us - sRow[64 + i]) : 0.f;
      sP[i * 72 + s] = f2bf(acc[reg] * wgt);
    }
  }
  __syncthreads();
#pragma unroll
  for (int i = 0; i < 4; ++i) {
    int id = tid + i * 256, e = id >> 3, sc = (id & 7) * 8;
    *(uint4*)(sKV + e * 72 + sc) = vpre[i];
  }
  __syncthreads();
  f32x16 acc1[2], acc2[2];
  const int mi = w & 1, nj = w >> 1;
#pragma unroll
  for (int t = 0; t < 2; ++t)
#pragma unroll
    for (int i = 0; i < 16; ++i) { acc1[t][i] = 0.f; acc2[t][i] = 0.f; }
#pragma unroll 2
  for (int ks = 0; ks < 4; ++ks) {
    bf16x8 af = *(const bf16x8*)(sP + (mi * 32 + (lane & 31)) * 72 + ks * 16 + (lane >> 5) * 8);
#pragma unroll
    for (int t = 0; t < 2; ++t) {
      bf16x8 bfr = *(const bf16x8*)(sKV + (nj * 64 + t * 32 + (lane & 31)) * 72 + ks * 16 + (lane >> 5) * 8);
      acc1[t] = __builtin_amdgcn_mfma_f32_32x32x16_bf16(af, bfr, acc1[t], 0, 0, 0);
    }
  }
#pragma unroll 2
  for (int ks = 0; ks < 8; ++ks) {
    bf16x8 af = *(const bf16x8*)(sQ + (mi * 32 + (lane & 31)) * 136 + ks * 16 + (lane >> 5) * 8);
#pragma unroll
    for (int t = 0; t < 2; ++t) {
      bf16x8 bfr = *(const bf16x8*)(sS + (nj * 64 + t * 32 + (lane & 31)) * 136 + ks * 16 + (lane >> 5) * 8);
      acc2[t] = __builtin_amdgcn_mfma_f32_32x32x16_bf16(af, bfr, acc2[t], 0, 0, 0);
    }
  }
  if (mixer == 1) {
    int i = tid >> 2, part = tid & 3;
    const float* nprev = (const float*)(P.ws + O_DN) + (size_t)idx * 128;
    float dl = 0.f, qn = 0.f;
#pragma unroll 4
    for (int s = part * 16; s < part * 16 + 16; ++s) dl += bf2f(sP[i * 72 + s]);
#pragma unroll 4
    for (int d = part * 32; d < part * 32 + 32; ++d) qn += bf2f(sQ[i * 136 + d]) * nprev[d];
    dl += __shfl_xor(dl, 1); dl += __shfl_xor(dl, 2);
    qn += __shfl_xor(qn, 1); qn += __shfl_xor(qn, 2);
    if (part == 0) {
      float den = dl + sRow[128 + i] * qn;
      sRow[192 + i] = 1.f / fmaxf(fabsf(den), sRow[256 + i]);
    }
  }
  __syncthreads();
#pragma unroll
  for (int t = 0; t < 2; ++t) {
    int e = nj * 64 + t * 32 + (lane & 31);
#pragma unroll
    for (int reg = 0; reg < 16; ++reg) {
      int i = mi * 32 + (reg & 3) + 8 * (reg >> 2) + 4 * (lane >> 5);
      float o = acc1[t][reg] + sRow[128 + i] * acc2[t][reg];
      if (mixer == 1) o *= sRow[192 + i];
      sO[i * 132 + e] = o;
    }
  }
  __syncthreads();
  {
    int i = tid >> 2, part = tid & 3;
    float ss = 0.f;
#pragma unroll 4
    for (int e = part * 32; e < part * 32 + 32; ++e) { float v = sO[i * 132 + e]; ss += v * v; }
    ss += __shfl_xor(ss, 1); ss += __shfl_xor(ss, 2);
    float rstd = rsqrtf(ss * (1.f / 128.f) + EPS);
    if (i < L) {
      size_t ro = (size_t)(it.row0 + i) * 512 + h * 128 + part * 32;
      const float* so = sO + i * 132 + part * 32;
      if (mixer == 0) {
        bfu* y = (bfu*)(P.ws + SLOT(5)) + ro;
        const float* g = P.g_ret_gn + h * 128 + part * 32;
        uint4 gv[4];
#pragma unroll
        for (int k = 0; k < 4; ++k) gv[k] = *(const uint4*)(y + k * 8);
#pragma unroll
        for (int k = 0; k < 4; ++k) {
          float gt[8], o[8];
          unpack8(gv[k], gt);
#pragma unroll
          for (int j = 0; j < 8; ++j) o[j] = gt[j] * sigmoidf_(gt[j]) * so[k * 8 + j] * rstd * g[k * 8 + j];
          *(uint4*)(y + k * 8) = pack8(o);
        }
      } else {
        bfu* y = (bfu*)(P.ws + SLOT(8)) + ro;
        const bfu* cc = (const bfu*)(P.ws + SLOT(0)) + ro;
        const float* g = P.g_ml_gn + h * 128 + part * 32;
        const float* ws = P.w_skip + h * 128 + part * 32;
        uint4 gv[4], cv[4];
#pragma unroll
        for (int k = 0; k < 4; ++k) { gv[k] = *(const uint4*)(y + k * 8); cv[k] = *(const uint4*)(cc + k * 8); }
#pragma unroll
        for (int k = 0; k < 4; ++k) {
          float gt[8], c8[8], o[8];
          unpack8(gv[k], gt); unpack8(cv[k], c8);
#pragma unroll
          for (int j = 0; j < 8; ++j) o[j] = sigmoidf_(gt[j]) * (so[k * 8 + j] * rstd * g[k * 8 + j] + ws[k * 8 + j] * c8[j]);
          *(uint4*)(y + k * 8) = pack8(o);
        }
      }
    }
  }
  __syncthreads();
}

__device__ void phase_merge(const Params& P, char* smem) {
  bfu* sA = (bfu*)smem; bfu* sB = sA + 128 * 72;
  const bfu* yr = (const bfu*)(P.ws + SLOT(5)); const bfu* ym = (const bfu*)(P.ws + SLOT(8));
  const bfu* gr = (const bfu*)(P.ws + SLOT(9)); const bfu* gm = (const bfu*)(P.ws + SLOT(11));
  bfu* mg = (bfu*)(P.ws + SLOT(6));
  for (int t = blockIdx.x; t < 260 * 8; t += gridDim.x) {
    int mt, nt; tile_map(t, 260, 8, mt, nt);
    f32x16 acc[2][2]; zero_acc(acc);
    bfu* sT = (bfu*)smem;
    const size_t tbase = (size_t)mt * 128 * 1024 + nt * 128;
    uint4 t1[8];
    gemm_acc(acc, yr + (size_t)mt * 128 * 512, 512, (const bfu*)(P.ws + O_WT_UPR) + (size_t)nt * 128 * 512, 512, 512, sA, sB);
    __syncthreads();
    stage_rm(sT, acc, 1.f);
    __syncthreads();
#pragma unroll
    for (int i = 0; i < 8; ++i) {
      int id = threadIdx.x + i * 256, row = id >> 4, c8 = (id & 15) * 8;
      float a[8], g[8];
      unpack8(*(const uint4*)(sT + row * ST_LD + c8), a);
      unpack8(*(const uint4*)(gr + tbase + (size_t)row * 1024 + c8), g);
#pragma unroll
      for (int j = 0; j < 8; ++j) a[j] *= sigmoidf_(g[j]);
      t1[i] = pack8(a);
    }
    zero_acc(acc);
    gemm_acc(acc, ym + (size_t)mt * 128 * 512, 512, (const bfu*)(P.ws + O_WT_UPM) + (size_t)nt * 128 * 512, 512, 512, sA, sB);
    __syncthreads();
    stage_rm(sT, acc, 1.f);
    __syncthreads();
#pragma unroll
    for (int i = 0; i < 8; ++i) {
      int id = threadIdx.x + i * 256, row = id >> 4, c8 = (id & 15) * 8;
      float a[8], g[8], t[8];
      unpack8(*(const uint4*)(sT + row * ST_LD + c8), a);
      unpack8(*(const uint4*)(gm + tbase + (size_t)row * 1024 + c8), g);
      unpack8(t1[i], t);
#pragma unroll
      for (int j = 0; j < 8; ++j) a[j] = t[j] + a[j] * sigmoidf_(g[j]);
      *(uint4*)(mg + tbase + (size_t)row * 1024 + c8) = pack8(a);
    }
  }
}

__device__ void phase_outproj(const Params& P, char* smem) {
  bfu* sA = (bfu*)smem; bfu* sB = sA + 128 * 72;
  const bfu* mg = (const bfu*)(P.ws + SLOT(6));
  for (int t = blockIdx.x; t < 260 * 8; t += gridDim.x) {
    int mt, nt; tile_map(t, 260, 8, mt, nt);
    f32x16 acc[2][2]; zero_acc(acc);
    gemm_acc(acc, mg + (size_t)mt * 128 * 1024, 1024, (const bfu*)(P.ws + O_WT_OUT) + (size_t)nt * 128 * 1024, 1024, 1024, sA, sB);
    float* sT32 = (float*)smem;
    __syncthreads();
    {
      EPI_BEGIN
#pragma unroll
        for (int j = 0; j < 4; ++j) {
          sT32[(r0 + j) * ST32_LD + cl] = acc[mi][0][q * 4 + j];
          sT32[(r0 + j) * ST32_LD + cl + 64] = acc[mi][1][q * 4 + j];
        }
      EPI_END
    }
    __syncthreads();
#pragma unroll
    for (int i = 0; i < 16; ++i) {
      int id = threadIdx.x + i * 256, row = id >> 5, c4 = (id & 31) * 4;
      int r = mt * 128 + row;
      float4 a = *(const float4*)(sT32 + row * ST32_LD + c4);
      float4 x = *(const float4*)(xrow(P, r) + nt * 128 + c4);
      float4 o = make_float4(x.x + a.x, x.y + a.y, x.z + a.z, x.w + a.w);
      *(float4*)(P.out + (size_t)r * 1024 + nt * 128 + c4) = o;
      float4 g = *(const float4*)(P.g_ffn + nt * 128 + c4);
      uint2 hv; hv.x = pack2(o.x * g.x, o.y * g.y); hv.y = pack2(o.z * g.z, o.w * g.w);
      *(uint2*)((bfu*)(P.ws + SLOT(0)) + (size_t)r * 1024 + nt * 128 + c4) = hv;
      float ss = o.x * o.x + o.y * o.y + o.z * o.z + o.w * o.w;
      ss = dpp_ror_add(ss, 8); ss = dpp_ror_add(ss, 4); ss = dpp_ror_add(ss, 2); ss = dpp_ror_add(ss, 1);
      ss += __shfl_xor(ss, 16);
      if ((threadIdx.x & 31) == 0) ((float*)(P.ws + O_GPRE))[(size_t)r * 8 + nt] = ss;
    }
  }
}

__device__ void phase_norm_rows(const Params& P, const float* g, bfu* dst) {
  const int lane = threadIdx.x & 63, w = threadIdx.x >> 6;
  for (int r = blockIdx.x * 4 + w; r < MT; r += gridDim.x * 4) {
    const float* xr = P.out + (size_t)r * 1024;
    float4 v[4]; float ss = 0.f;
#pragma unroll
    for (int i = 0; i < 4; ++i) {
      v[i] = *(const float4*)(xr + i * 256 + lane * 4);
      ss += v[i].x * v[i].x + v[i].y * v[i].y + v[i].z * v[i].z + v[i].w * v[i].w;
    }
    ss = wave_sum(ss);
    float rstd = rsqrtf(ss * (1.f / 1024.f) + EPS);
#pragma unroll
    for (int i = 0; i < 4; ++i) {
      float4 gg = *(const float4*)(g + i * 256 + lane * 4);
      uint2 o; o.x = pack2(v[i].x * rstd * gg.x, v[i].y * rstd * gg.y); o.y = pack2(v[i].z * rstd * gg.z, v[i].w * rstd * gg.w);
      *(uint2*)(dst + (size_t)r * 1024 + i * 256 + lane * 4) = o;
    }
  }
}

__device__ void phase_pq(const Params& P, char* smem) {
  bfu* sA = (bfu*)smem; bfu* sB = sA + 128 * 72;
  const bfu* hq = (const bfu*)(P.ws + SLOT(0));
  bfu* qb = (bfu*)(P.ws + SLOT(9));
  for (int t = blockIdx.x; t < 260 * 16; t += gridDim.x) {
    int mt, nt; tile_map(t, 260, 16, mt, nt);
    f32x16 acc[2][2]; zero_acc(acc);
    float* sRstd = (float*)(smem + 66048);
    if (threadIdx.x < 128) {
      const float* pp = (const float*)(P.ws + O_GPRE) + (size_t)(mt * 128 + threadIdx.x) * 8;
      float4 p0 = *(const float4*)pp, p1 = *(const float4*)(pp + 4);
      sRstd[threadIdx.x] = rsqrtf((p0.x + p0.y + p0.z + p0.w + p1.x + p1.y + p1.z + p1.w) * (1.f / 1024.f) + EPS);
    }
    gemm_acc(acc, hq + (size_t)mt * 128 * 1024, 1024, (const bfu*)(P.ws + O_WT_PQ) + (size_t)nt * 128 * 1024, 1024, 1024, sA, sB);
    bfu* sT = (bfu*)smem;
    __syncthreads();
    {
      EPI_BEGIN
#pragma unroll
        for (int j = 0; j < 4; ++j) {
          const float rs = sRstd[r0 + j];
          sT[(r0 + j) * ST_LD + cl] = f2bf(acc[mi][0][q * 4 + j] * rs);
          sT[(r0 + j) * ST_LD + cl + 64] = f2bf(acc[mi][1][q * 4 + j] * rs);
        }
      EPI_END
    }
    __syncthreads();
    copyout_bf16(sT, qb + (size_t)mt * 128 * 2048 + nt * 128, 2048);
  }
}


template <bool DESC> __device__ __forceinline__ void cex(float& a, float& b) {
  float mx = fmaxf(a, b), mn = fminf(a, b);
  a = DESC ? mx : mn; b = DESC ? mn : mx;
}
template <int B, bool DESC> __device__ __forceinline__ void bmerge16(float (&v)[64]) {
#pragma unroll
  for (int j = 8; j > 0; j >>= 1)
#pragma unroll
    for (int i = 0; i < 16; ++i) { int l = i ^ j; if (l > i) cex<DESC>(v[B + i], v[B + l]); }
}
template <int B, bool DESC> __device__ __forceinline__ void bsort16(float (&v)[64]) {
#pragma unroll
  for (int k = 2; k <= 16; k <<= 1)
#pragma unroll
    for (int j = k >> 1; j > 0; j >>= 1)
#pragma unroll
      for (int i = 0; i < 16; ++i) {
        int l = i ^ j;
        if (l > i) {
          bool up = ((i & k) == 0) || (k == 16);
          if (up == true) { if (DESC) cex<true>(v[B + i], v[B + l]); else cex<false>(v[B + i], v[B + l]); }
          else { if (DESC) cex<false>(v[B + i], v[B + l]); else cex<true>(v[B + i], v[B + l]); }
        }
      }
}
__device__ __forceinline__ float pair_max(float v) {
  auto r = __builtin_amdgcn_permlane32_swap(__float_as_int(v), __float_as_int(v), false, false);
  return fmaxf(__int_as_float(r[0]), __int_as_float(r[1]));
}
__device__ void phase_topk(const Params& P, char* smem) {
  const int tid = threadIdx.x, lane = tid & 63, w = tid >> 6, r32 = lane & 31, hh = lane >> 5;
  unsigned* sL = (unsigned*)smem + w * 1664;
  unsigned* sW = sL + 32 * 33;
  const bfu* qb = (const bfu*)(P.ws + SLOT(9));
  const bfu* keys = (const bfu*)(P.ws + O_KEYS);
  int* ids = (int*)(P.ws + SLOT(4));
  float* gw = (float*)(P.ws + SLOT(13));
  bfu* sKey = (bfu*)(smem + 26624);
  for (int u = blockIdx.x; u < 2080; u += gridDim.x) {
    const int n = u & 7, tg = (u >> 3) * 4 + w, rowb = tg * 32;
#pragma unroll 1
    for (int half = 0; half < 2; ++half) {
      f32x16 acc[4];
#pragma unroll
      for (int c = 0; c < 4; ++c)
#pragma unroll
        for (int i = 0; i < 16; ++i) acc[c][i] = 0.f;
      __syncthreads();
      {
        const bfu* ksrc = keys + (size_t)(n * 2 + half) * 128 * 128;
#pragma unroll
        for (int i = 0; i < 8; ++i) {
          int id = tid + i * 256, row = id >> 4, c8 = (id & 15) * 8;
          *(uint4*)(sKey + row * 136 + c8) = *(const uint4*)(ksrc + row * 128 + c8);
        }
      }
      __syncthreads();
      const bfu* kp = sKey + r32 * 136 + hh * 8;
      const bfu* qp = qb + (size_t)(rowb + r32) * 2048 + n * 256 + half * 128 + hh * 8;
#pragma unroll
      for (int ks = 0; ks < 8; ++ks) {
        bf16x8 bfr = *(const bf16x8*)(qp + ks * 16);
#pragma unroll
        for (int c = 0; c < 4; ++c) {
          bf16x8 af = *(const bf16x8*)(kp + c * 32 * 136 + ks * 16);
          acc[c] = __builtin_amdgcn_mfma_f32_32x32x16_bf16(af, bfr, acc[c], 0, 0, 0);
        }
      }
      float kk[64];
#pragma unroll
      for (int c = 0; c < 4; ++c)
#pragma unroll
        for (int reg = 0; reg < 16; ++reg) {
          unsigned kidx = c * 32 + (reg & 3) + 8 * (reg >> 2) + 4 * hh;
          kk[c * 16 + reg] = __uint_as_float((__float_as_uint(acc[c][reg]) & ~127u) | kidx);
        }
      bsort16<0, true>(kk); bsort16<16, false>(kk); bsort16<32, false>(kk); bsort16<48, true>(kk);
#pragma unroll
      for (int i = 0; i < 16; ++i) { kk[i] = fmaxf(kk[i], kk[16 + i]); kk[32 + i] = fmaxf(kk[32 + i], kk[48 + i]); }
      bmerge16<0, true>(kk); bmerge16<32, false>(kk);
#pragma unroll
      for (int i = 0; i < 16; ++i) kk[i] = fmaxf(kk[i], kk[32 + i]);
      bmerge16<0, true>(kk);
      {
        float lo[16], hi[16];
#pragma unroll
        for (int i = 0; i < 16; ++i) {
          auto r = __builtin_amdgcn_permlane32_swap(__float_as_int(kk[i]), __float_as_int(kk[i]), false, false);
          lo[i] = __int_as_float(r[0]); hi[i] = __int_as_float(r[1]);
        }
#pragma unroll
        for (int i = 0; i < 16; ++i) kk[i] = fmaxf(lo[i], hi[15 - i]);
      }
      bmerge16<0, true>(kk);
      if (hh == 0) {
#pragma unroll
        for (int p = 0; p < 16; ++p) sL[r32 * 33 + half * 16 + p] = __float_as_uint(kk[p]);
      }
    }
    __builtin_amdgcn_fence(__ATOMIC_RELEASE, "workgroup");
    __builtin_amdgcn_wave_barrier();
    __builtin_amdgcn_fence(__ATOMIC_ACQUIRE, "workgroup");
    float x[4], y[16];
    {
      const unsigned* lx = sL + r32 * 33 + (hh ? 16 : 0);
      const unsigned* ly = sL + r32 * 33 + (hh ? 0 : 16);
#pragma unroll
      for (int i = 0; i < 4; ++i) x[i] = __uint_as_float(lx[i] & ~127u);
#pragma unroll
      for (int j = 0; j < 16; ++j) y[j] = __uint_as_float(ly[j] & ~127u);
    }
    float cd[25];
#define CAND(t, i, j) { float sv = x[i] + y[j]; unsigned code = hh ? ((j) << 4 | (i)) : ((i) << 4 | (j)); \
      cd[t] = __uint_as_float((__float_as_uint(sv) & ~255u) | code); }
    CAND(0, 0, 1) CAND(1, 0, 2) CAND(2, 0, 3) CAND(3, 0, 4) CAND(4, 0, 5) CAND(5, 0, 6) CAND(6, 0, 7) CAND(7, 0, 8)
    CAND(8, 0, 9) CAND(9, 0, 10) CAND(10, 0, 11) CAND(11, 0, 12) CAND(12, 0, 13) CAND(13, 0, 14) CAND(14, 0, 15)
    CAND(15, 1, 2) CAND(16, 1, 3) CAND(17, 1, 4) CAND(18, 1, 5) CAND(19, 1, 6) CAND(20, 1, 7) CAND(21, 2, 3) CAND(22, 2, 4)
    {
      float d0 = hh ? x[2] + y[2] : x[0] + y[0];
      float d1 = hh ? x[3] + y[3] : x[1] + y[1];
      unsigned c0 = hh ? 0x22u : 0x00u, c1 = hh ? 0x33u : 0x11u;
      cd[23] = __uint_as_float((__float_as_uint(d0) & ~255u) | c0);
      cd[24] = __uint_as_float((__float_as_uint(d1) & ~255u) | c1);
    }
    {
      float cv[64];
#pragma unroll
      for (int t = 0; t < 25; ++t) cv[t] = cd[t];
#pragma unroll
      for (int t = 25; t < 32; ++t) cv[t] = -INFINITY;
      bsort16<0, true>(cv); bsort16<16, false>(cv);
#pragma unroll
      for (int i = 0; i < 16; ++i) cv[i] = fmaxf(cv[i], cv[16 + i]);
      bmerge16<0, true>(cv);
      {
        float lo[16], hi[16];
#pragma unroll
        for (int i = 0; i < 16; ++i) {
          auto r = __builtin_amdgcn_permlane32_swap(__float_as_int(cv[i]), __float_as_int(cv[i]), false, false);
          lo[i] = __int_as_float(r[0]); hi[i] = __int_as_float(r[1]);
        }
#pragma unroll
        for (int i = 0; i < 16; ++i) cv[i] = fmaxf(lo[i], hi[15 - i]);
      }
      bmerge16<0, true>(cv);
      if (hh == 0) {
#pragma unroll
        for (int p = 0; p < 16; ++p) sW[r32 * 17 + p] = __float_as_uint(cv[p]);
      }
    }
    __builtin_amdgcn_fence(__ATOMIC_RELEASE, "workgroup");
    __builtin_amdgcn_wave_barrier();
    __builtin_amdgcn_fence(__ATOMIC_ACQUIRE, "workgroup");
    {
      const unsigned* la = sL + r32 * 33;
      unsigned c0 = sW[r32 * 17] & 255u;
      float scmax = __uint_as_float(la[c0 >> 4] & ~127u) + __uint_as_float(la[16 + (c0 & 15)] & ~127u);
      float ex[8]; int ee[8]; float sum = 0.f;
#pragma unroll
      for (int k = 0; k < 8; ++k) {
        unsigned code = sW[r32 * 17 + hh * 8 + k] & 255u;
        unsigned ka = la[code >> 4], kb = la[16 + (code & 15)];
        float sc = __uint_as_float(ka & ~127u) + __uint_as_float(kb & ~127u);
        ex[k] = __expf(sc - scmax);
        ee[k] = (int)((ka & 127u) * 128u + (kb & 127u));
        sum += ex[k];
      }
      sum += __shfl_xor(sum, 32);
      float inv = 1.f / sum;
      size_t o = (size_t)(rowb + r32) * 128 + n * 16 + hh * 8;
      *(int4*)(ids + o) = make_int4(ee[0], ee[1], ee[2], ee[3]);
      *(int4*)(ids + o + 4) = make_int4(ee[4], ee[5], ee[6], ee[7]);
      *(float4*)(gw + o) = make_float4(ex[0] * inv, ex[1] * inv, ex[2] * inv, ex[3] * inv);
      *(float4*)(gw + o + 4) = make_float4(ex[4] * inv, ex[5] * inv, ex[6] * inv, ex[7] * inv);
    }
    __builtin_amdgcn_wave_barrier();
  }
}

typedef float f2v __attribute__((ext_vector_type(2)));
#define U8_SCALE 512.f
#define V8_SCALE 128.f
__device__ void convert_fp8(const float* __restrict__ src, unsigned char* __restrict__ dst, size_t n16, float scale,
                            int gtid, int gstride) {
  for (size_t i = gtid; i < n16; i += gstride) {
    unsigned w[4];
#pragma unroll
    for (int k = 0; k < 4; ++k) {
      float4 a = *(const float4*)(src + i * 16 + k * 4);
      float v0 = fminf(fmaxf(a.x * scale, -448.f), 448.f), v1 = fminf(fmaxf(a.y * scale, -448.f), 448.f);
      float v2 = fminf(fmaxf(a.z * scale, -448.f), 448.f), v3 = fminf(fmaxf(a.w * scale, -448.f), 448.f);
      int t = 0;
      t = __builtin_amdgcn_cvt_pk_fp8_f32(v0, v1, t, false);
      t = __builtin_amdgcn_cvt_pk_fp8_f32(v2, v3, t, true);
      w[k] = (unsigned)t;
    }
    *(uint4*)(dst + i * 16) = make_uint4(w[0], w[1], w[2], w[3]);
  }
}
__device__ __forceinline__ float dot16_fp8(uint4 u, const f2v* x2) {
  f2v acc = __builtin_amdgcn_cvt_pk_f32_fp8((int)u.x, false) * x2[0];
  acc += __builtin_amdgcn_cvt_pk_f32_fp8((int)u.x, true) * x2[1];
  acc += __builtin_amdgcn_cvt_pk_f32_fp8((int)u.y, false) * x2[2];
  acc += __builtin_amdgcn_cvt_pk_f32_fp8((int)u.y, true) * x2[3];
  acc += __builtin_amdgcn_cvt_pk_f32_fp8((int)u.z, false) * x2[4];
  acc += __builtin_amdgcn_cvt_pk_f32_fp8((int)u.z, true) * x2[5];
  acc += __builtin_amdgcn_cvt_pk_f32_fp8((int)u.w, false) * x2[6];
  acc += __builtin_amdgcn_cvt_pk_f32_fp8((int)u.w, true) * x2[7];
  return acc.x + acc.y;
}
__device__ __forceinline__ void axpy16_fp8(f2v* o2, float cf, uint4 v) {
  f2v c = {cf, cf};
  o2[0] += c * __builtin_amdgcn_cvt_pk_f32_fp8((int)v.x, false);
  o2[1] += c * __builtin_amdgcn_cvt_pk_f32_fp8((int)v.x, true);
  o2[2] += c * __builtin_amdgcn_cvt_pk_f32_fp8((int)v.y, false);
  o2[3] += c * __builtin_amdgcn_cvt_pk_f32_fp8((int)v.y, true);
  o2[4] += c * __builtin_amdgcn_cvt_pk_f32_fp8((int)v.z, false);
  o2[5] += c * __builtin_amdgcn_cvt_pk_f32_fp8((int)v.z, true);
  o2[6] += c * __builtin_amdgcn_cvt_pk_f32_fp8((int)v.w, false);
  o2[7] += c * __builtin_amdgcn_cvt_pk_f32_fp8((int)v.w, true);
}
#define PEER_LOAD(u, v, b)                                                                   \
  _Pragma("unroll") for (int k = 0; k < 8; ++k) {                                            \
    int j = (b) * 8 + k;                                                                     \
    int e = __builtin_amdgcn_readlane((b) < 8 ? id0 : id1, j & 63);                          \
    u[k] = *(const uint4*)(U8 + (size_t)e * 1024 + lane * 16);                               \
    v[k] = *(const uint4*)(V8 + (size_t)e * 1024 + lane * 16);                               \
  }
#define PEER_COMP(u, v, b)                                                                   \
  _Pragma("unroll") for (int hf = 0; hf < 2; ++hf) {                                         \
    float s = reduce4(dot16_fp8(u[hf * 4 + 0], x2), dot16_fp8(u[hf * 4 + 1], x2),           \
                      dot16_fp8(u[hf * 4 + 2], x2), dot16_fp8(u[hf * 4 + 3], x2)) * xr_rstd; \
    float act = 0.5f * s * (1.f + erff(s * 0.7071067811865475f));                            \
    float gsel = __shfl((b) < 8 ? g0 : g1, ((b) * 8 + hf * 4 + (lane >> 4)) & 63);           \
    float cfv = act * gsel * (1.f / V8_SCALE);                                               \
    axpy16_fp8(o2, __int_as_float(__builtin_amdgcn_readlane(__float_as_int(cfv), 0)), v[hf * 4 + 0]);  \
    axpy16_fp8(o2, __int_as_float(__builtin_amdgcn_readlane(__float_as_int(cfv), 16)), v[hf * 4 + 1]); \
    axpy16_fp8(o2, __int_as_float(__builtin_amdgcn_readlane(__float_as_int(cfv), 32)), v[hf * 4 + 2]); \
    axpy16_fp8(o2, __int_as_float(__builtin_amdgcn_readlane(__float_as_int(cfv), 48)), v[hf * 4 + 3]); \
  }
__device__ void phase_peer(const Params& P) {
  const int lane = threadIdx.x & 63, w = threadIdx.x >> 6;
  bfu* hq = (bfu*)(P.ws + SLOT(0));
  const unsigned char* U8 = (const unsigned char*)(P.ws + SLOT(2));
  const unsigned char* V8 = (const unsigned char*)(P.ws + SLOT(3));
  const int* ids = (const int*)(P.ws + SLOT(4));
  const float* gw = (const float*)(P.ws + SLOT(13));
  bfu* pbf = (bfu*)(P.ws + SLOT(6));
  int nid0 = 0, nid1 = 0;
  if (blockIdx.x * 4 + w < MT) { nid0 = ids[(size_t)(blockIdx.x * 4 + w) * 128 + lane]; nid1 = ids[(size_t)(blockIdx.x * 4 + w) * 128 + 64 + lane]; }
  for (int r = blockIdx.x * 4 + w; r < MT; r += gridDim.x * 4) {
    f2v x2[8], o2[8];
    {
      uint4 v0 = *(const uint4*)(hq + (size_t)r * 1024 + lane * 16);
      uint4 v1 = *(const uint4*)(hq + (size_t)r * 1024 + lane * 16 + 8);
      float xf[16];
      unpack8(v0, xf); unpack8(v1, xf + 8);
#pragma unroll
      for (int j = 0; j < 8; ++j) { x2[j].x = xf[2 * j]; x2[j].y = xf[2 * j + 1]; o2[j].x = 0.f; o2[j].y = 0.f; }
    }
    const int id0 = nid0, id1 = nid1;
    float g0 = gw[(size_t)r * 128 + lane], g1 = gw[(size_t)r * 128 + 64 + lane];
    float xr_rstd;
    {
      const float* pp = (const float*)(P.ws + O_GPRE) + (size_t)r * 8;
      float4 p0 = *(const float4*)pp, p1 = *(const float4*)(pp + 4);
      xr_rstd = rsqrtf((p0.x + p0.y + p0.z + p0.w + p1.x + p1.y + p1.z + p1.w) * (1.f / 1024.f) + EPS) * (1.f / U8_SCALE);
    }
    uint4 uA[8], vA[8], uB[8], vB[8];
    PEER_LOAD(uA, vA, 0)
    for (int b = 0; b < 16; b += 2) {
      PEER_LOAD(uB, vB, b + 1)
      PEER_COMP(uA, vA, b)
      if (b + 2 < 16) { PEER_LOAD(uA, vA, b + 2) }
      PEER_COMP(uB, vB, b + 1)
    }
    asm volatile("" ::: "memory");
    {
      const int rn = r + (int)gridDim.x * 4;
      if (rn < MT) { nid0 = ids[(size_t)rn * 128 + lane]; nid1 = ids[(size_t)rn * 128 + 64 + lane]; }
    }
    float* xr = P.out + (size_t)r * 1024 + lane * 16;
    float x3[16];
    float ss = 0.f;
#pragma unroll
    for (int k = 0; k < 4; ++k) {
      float4 a = *(const float4*)(xr + k * 4);
      x3[k * 4 + 0] = a.x + o2[k * 2].x; x3[k * 4 + 1] = a.y + o2[k * 2].y;
      x3[k * 4 + 2] = a.z + o2[k * 2 + 1].x; x3[k * 4 + 3] = a.w + o2[k * 2 + 1].y;
      *(float4*)(xr + k * 4) = make_float4(x3[k * 4], x3[k * 4 + 1], x3[k * 4 + 2], x3[k * 4 + 3]);
    }
#pragma unroll
    for (int j = 0; j < 16; ++j) ss += x3[j] * x3[j];
    ss = wave_sum(ss);
    float rstd = rsqrtf(ss * (1.f / 1024.f) + EPS);
    float hv[16];
#pragma unroll
    for (int k = 0; k < 4; ++k) {
      float4 ga = *(const float4*)(P.g_ple + lane * 16 + k * 4);
      hv[k * 4] = x3[k * 4] * rstd * ga.x; hv[k * 4 + 1] = x3[k * 4 + 1] * rstd * ga.y;
      hv[k * 4 + 2] = x3[k * 4 + 2] * rstd * ga.z; hv[k * 4 + 3] = x3[k * 4 + 3] * rstd * ga.w;
    }
    *(uint4*)(hq + (size_t)r * 1024 + lane * 16) = pack8(hv);
    *(uint4*)(hq + (size_t)r * 1024 + lane * 16 + 8) = pack8(hv + 8);
    {
      const float* pr = r < MP ? P.pp + (size_t)r * 256 : P.ps + (size_t)(r - MP) * 256;
      float4 a = *(const float4*)(pr + lane * 4);
      uint2 ov; ov.x = pack2(a.x, a.y); ov.y = pack2(a.z, a.w);
      *(uint2*)(pbf + (size_t)r * 256 + lane * 4) = ov;
    }
  }
}

__device__ void phase_ple(const Params& P, char* smem) {
  bfu* sA = (bfu*)smem; bfu* sB = sA + 128 * 72;
  const bfu* hg = (const bfu*)(P.ws + SLOT(0));
  const bfu* pbf = (const bfu*)(P.ws + SLOT(6));
  for (int t = blockIdx.x; t < 260 * 8; t += gridDim.x) {
    int mt, nt; tile_map(t, 260, 8, mt, nt);
    f32x16 acc[2][2]; zero_acc(acc);
    bfu* sT = (bfu*)smem; float* sT32 = (float*)smem;
    uint2 pg[16];
    gemm_acc(acc, hg + (size_t)mt * 128 * 1024, 1024, (const bfu*)(P.ws + O_WT_PG) + (size_t)nt * 128 * 1024, 1024, 1024, sA, sB);
    __syncthreads();
    {
      EPI_BEGIN
#pragma unroll
        for (int j = 0; j < 4; ++j) {
          sT[(r0 + j) * ST_LD + cl] = f2bf(sigmoidf_(acc[mi][0][q * 4 + j]));
          sT[(r0 + j) * ST_LD + cl + 64] = f2bf(sigmoidf_(acc[mi][1][q * 4 + j]));
        }
      EPI_END
    }
    __syncthreads();
#pragma unroll
    for (int i = 0; i < 16; ++i) {
      int id = threadIdx.x + i * 256, row = id >> 5, c4 = (id & 31) * 4;
      pg[i] = *(const uint2*)(sT + row * ST_LD + c4);
    }
    zero_acc(acc);
    gemm_acc(acc, pbf + (size_t)mt * 128 * 256, 256, (const bfu*)(P.ws + O_WT_PLE) + (size_t)nt * 128 * 256, 256, 256, sA, sB);
    __syncthreads();
    {
      EPI_BEGIN
#pragma unroll
        for (int j = 0; j < 4; ++j) {
          sT32[(r0 + j) * ST32_LD + cl] = acc[mi][0][q * 4 + j];
          sT32[(r0 + j) * ST32_LD + cl + 64] = acc[mi][1][q * 4 + j];
        }
      EPI_END
    }
    __syncthreads();
#pragma unroll
    for (int i = 0; i < 16; ++i) {
      int id = threadIdx.x + i * 256, row = id >> 5, c4 = (id & 31) * 4;
      float4 a = *(const float4*)(sT32 + row * ST32_LD + c4);
      float* op = P.out + (size_t)(mt * 128 + row) * 1024 + nt * 128 + c4;
      float4 x = *(const float4*)op;
      float g0 = bf2f(pg[i].x & 0xffff), g1 = bf2f(pg[i].x >> 16), g2 = bf2f(pg[i].y & 0xffff), g3 = bf2f(pg[i].y >> 16);
      *(float4*)op = make_float4(x.x + a.x * g0, x.y + a.y * g1, x.z + a.z * g2, x.w + a.w * g3);
    }
  }
}

__device__ void phase_final(const Params& P) {
  const int lane = threadIdx.x & 63, w = threadIdx.x >> 6;
  for (int r = blockIdx.x * 4 + w; r < MT; r += gridDim.x * 4) {
    float* xr = P.out + (size_t)r * 1024;
    float4 v[4]; float ss = 0.f;
#pragma unroll
    for (int i = 0; i < 4; ++i) {
      v[i] = *(const float4*)(xr + i * 256 + lane * 4);
      ss += v[i].x * v[i].x + v[i].y * v[i].y + v[i].z * v[i].z + v[i].w * v[i].w;
    }
    ss = wave_sum(ss);
    float rstd = rsqrtf(ss * (1.f / 1024.f) + EPS);
#pragma unroll
    for (int i = 0; i < 4; ++i) {
      float4 gg = *(const float4*)(P.g_final + i * 256 + lane * 4);
      *(float4*)(xr + i * 256 + lane * 4) = make_float4(v[i].x * rstd * gg.x, v[i].y * rstd * gg.y, v[i].z * rstd * gg.z, v[i].w * rstd * gg.w);
    }
  }
}

__global__ void __launch_bounds__(NTHREADS, 2) fwd_megakernel(Params P) {
  extern __shared__ __attribute__((aligned(16))) char smem[];
  cg::grid_group grid = cg::this_grid();
  __shared__ uint4 xb_words;
  if (threadIdx.x == 0) xb_words = make_uint4(0u, 0u, 0u, 0u);
  __syncthreads();
  XcdBarrier xb = xcd_barrier_post((unsigned*)(P.ws + O_BAR), (volatile LAS unsigned*)&xb_words);
  if (P.out == nullptr) grid.sync();
  const int gtid = blockIdx.x * NTHREADS + threadIdx.x, gstride = gridDim.x * NTHREADS;
  phase_prep(P, smem);
  xcd_barrier(xb);
  phase_gemm1(P, smem);
  xcd_barrier(xb);
  phase_conv(P);
  gate_scan(P);
  xcd_barrier(xb);
  m_fold(P);
  phase_mqk(P, smem);
  xcd_barrier(xb);
  for (int t = blockIdx.x; t < 4224; t += gridDim.x) phaseA_item(P, t / 2112, t % 2112, smem);
  xcd_barrier(xb);
  phase_scan(P);
  xcd_barrier(xb);
  for (int t = blockIdx.x; t < 4224; t += gridDim.x) phaseC_item(P, t / 2112, t % 2112, smem);
  xcd_barrier(xb);
  phase_merge(P, smem);
  {
    const int extra = 2080 % (int)gridDim.x;
    if ((int)blockIdx.x >= extra) {
      const int cg_tid = ((int)blockIdx.x - extra) * NTHREADS + threadIdx.x, cg_str = ((int)gridDim.x - extra) * NTHREADS;
      convert_fp8(P.peer_u, (unsigned char*)(P.ws + SLOT(2)), 16384ull * 1024 / 16, U8_SCALE, cg_tid, cg_str);
      convert_fp8(P.peer_v, (unsigned char*)(P.ws + SLOT(3)), 16384ull * 1024 / 16, V8_SCALE, cg_tid, cg_str);
    }
  }
  xcd_barrier(xb);
  phase_outproj(P, smem);
  xcd_barrier(xb);
  phase_pq(P, smem);
  xcd_barrier(xb);
  phase_topk(P, smem);
  xcd_barrier(xb);
  phase_peer(P);
  xcd_barrier(xb);
  phase_ple(P, smem);
  xcd_barrier(xb);
  phase_final(P);
}

extern "C" void kernel_launch(void* const* d_in, const int* in_sizes, int n_in, void* d_out, int out_size,
                              void* d_ws, size_t ws_size, hipStream_t stream) {
  static int grid_blocks = 0;
  if (!grid_blocks) {
    hipFuncSetAttribute((const void*)fwd_megakernel, hipFuncAttributeMaxDynamicSharedMemorySize, SMEM_BYTES);
    int dev = 0, cus = 0, per_cu = 0;
    hipGetDevice(&dev);
    hipDeviceGetAttribute(&cus, hipDeviceAttributeMultiprocessorCount, dev);
    hipOccupancyMaxActiveBlocksPerMultiprocessor(&per_cu, fwd_megakernel, NTHREADS, SMEM_BYTES);
    if (per_cu > 2) per_cu = 2;
    if (per_cu < 1) per_cu = 1;
    grid_blocks = cus * per_cu;
  }
  Params p{};
  const float** pf = (const float**)&p;
  for (int i = 0; i < 32; ++i) pf[i] = (const float*)d_in[i];
  p.out = (float*)d_out;
  p.ws = (char*)d_ws;
  hipMemsetAsync((char*)d_ws + O_BAR, 0, XCD_BAR_WORDS * 4, stream);
  void* args[] = {&p};
  hipError_t e = hipLaunchCooperativeKernel((void*)fwd_megakernel, dim3(grid_blocks), dim3(NTHREADS), args, SMEM_BYTES, stream);
  if (e != hipSuccess) fprintf(stderr, "cooperative launch failed: %s (grid %d)\n", hipGetErrorString(e), grid_blocks);
}
```
